# Optimizing an MI355X kernel written in HIP

```python
import math
import jax, jax.numpy as jnp
from jax import lax
import numpy as np

D_MODEL = 1024
BATCH = 4
SEQ = 4096
DEPTH = 2

MEM_LEN = 256
D_FF = 11 * D_MODEL // 4
NORM_EPS = 1e-6
FFN_HALF = 0.5
CHUNK = 64
N_BRANCH = 4
BRANCH_WIDTH = D_MODEL // 2

MLSTM_HEADS = 4
MLSTM_HEAD_DIM = BRANCH_WIDTH // MLSTM_HEADS
MLSTM_CONV = 4

S5_GROUP = 16
S5_GROUPS = BRANCH_WIDTH // S5_GROUP
S5_STATE = 64
S5_MIN_NEG = 1e-4

GLA_HEADS = 4
GLA_KEY_WIDTH = BRANCH_WIDTH // 2
GLA_HEAD_K = GLA_KEY_WIDTH // GLA_HEADS
GLA_HEAD_V = BRANCH_WIDTH // GLA_HEADS
GLA_GATE_RANK = 16
GLA_GATE_TAU = 16.0

RWKV_HEAD = 64
RWKV_HEADS = BRANCH_WIDTH // RWKV_HEAD
RWKV_DECAY_RANK = 64
RWKV_ICLR_RANK = 64
RWKV_GATE_RANK = 128
RWKV_GN_EPS = 64e-5
RWKV_WIDTHS = (BRANCH_WIDTH, BRANCH_WIDTH, BRANCH_WIDTH, RWKV_DECAY_RANK, RWKV_ICLR_RANK, RWKV_GATE_RANK)
RWKV_COLS = sum(RWKV_WIDTHS)
RWKV_SPLIT_POINTS = tuple(int(s) for s in np.cumsum(RWKV_WIDTHS)[:-1])

XATTN_HEADS = 4
XATTN_HEAD_DIM = D_MODEL // XATTN_HEADS

IN_WIDTHS = (
    BRANCH_WIDTH, BRANCH_WIDTH, MLSTM_HEADS, MLSTM_HEADS,
    BRANCH_WIDTH,
    GLA_KEY_WIDTH, GLA_KEY_WIDTH, BRANCH_WIDTH, BRANCH_WIDTH,
    GLA_GATE_RANK,
    RWKV_COLS,
    N_BRANCH * D_MODEL,
)
N_IN = sum(IN_WIDTHS)
IN_SPLIT_POINTS = tuple(int(s) for s in np.cumsum(IN_WIDTHS)[:-1])

kernel_name = "hybrid_parallel_gated_mixer_trunk"


def rms_norm(x, gain):
    x32 = x.astype(jnp.float32)
    y = x32 * lax.rsqrt(jnp.mean(x32 * x32, axis=-1, keepdims=True) + NORM_EPS)
    return (y * gain.astype(jnp.float32)).astype(x.dtype)


def head_rms_norm(x, gain, n_heads):
    shp = x.shape
    xh = x.astype(jnp.float32).reshape(shp[:-1] + (n_heads, -1))
    y = xh * lax.rsqrt(jnp.mean(xh * xh, axis=-1, keepdims=True) + NORM_EPS)
    return y.reshape(shp) * gain.astype(jnp.float32)


def head_group_norm(x, gain, n_heads, eps):
    shp = x.shape
    xh = x.astype(jnp.float32).reshape(shp[:-1] + (n_heads, -1))
    mu = jnp.mean(xh, axis=-1, keepdims=True)
    xc = xh - mu
    y = xc * lax.rsqrt(jnp.mean(xc * xc, axis=-1, keepdims=True) + eps)
    return y.reshape(shp) * gain.astype(jnp.float32)


def swiglu_ffn(x, w_gate, w_up, w_down):
    return (jax.nn.silu(x @ w_gate) * (x @ w_up)) @ w_down


def causal_depthwise_conv(x, w):
    k_len = w.shape[0]
    t = x.shape[1]
    xp = jnp.pad(x, ((0, 0), (k_len - 1, 0), (0, 0)))
    return sum(xp[:, j:j + t] * w[j] for j in range(k_len))


def token_shift(x):
    return jnp.pad(x, ((0, 0), (1, 0), (0, 0)))[:, :-1, :]


def to_chunks4(x):
    b, t, h, e = x.shape
    return x.reshape(b, t // CHUNK, CHUNK, h, e).transpose(1, 0, 3, 2, 4)


def to_chunks3(x):
    b, t, h = x.shape
    return x.reshape(b, t // CHUNK, CHUNK, h).transpose(1, 0, 3, 2)


def from_chunks4(y):
    nc, b, h, c, e = y.shape
    return y.transpose(1, 0, 3, 2, 4).reshape(b, nc * c, h, e)


def mlstm_chunkwise(q, k, v, log_i, log_f):
    bsz, _, n_h, e = q.shape
    mask = jnp.tril(jnp.ones((CHUNK, CHUNK), dtype=bool))

    def step(carry, xs):
        c_st, n_st, m_st = carry
        qc, kc, vc, ic, fc = xs
        b = jnp.cumsum(fc, axis=-1)
        d = jnp.where(mask, b[..., :, None] - b[..., None, :] + ic[..., None, :], -jnp.inf)
        m_inter = b + m_st[..., None]
        m_row = jnp.maximum(m_inter, jnp.max(d, axis=-1))
        w = jnp.exp(d - m_row[..., None]) * jnp.einsum('bhte,bhse->bhts', qc, kc)
        inter = jnp.exp(m_inter - m_row)
        num = inter[..., None] * jnp.einsum('bhte,bhev->bhtv', qc, c_st) + jnp.einsum('bhts,bhsv->bhtv', w, vc)
        den = inter * jnp.einsum('bhte,bhe->bht', qc, n_st) + jnp.sum(w, axis=-1)
        h = num / jnp.maximum(jnp.abs(den), jnp.exp(-m_row))[..., None]
        b_last = b[..., -1]
        m_new = jnp.maximum(b_last + m_st, jnp.max(b_last[..., None] - b + ic, axis=-1))
        decay = jnp.exp(b_last + m_st - m_new)
        wk = jnp.exp(b_last[..., None] - b + ic - m_new[..., None])
        c_new = decay[..., None, None] * c_st + jnp.einsum('bhs,bhse,bhsv->bhev', wk, kc, vc)
        n_new = decay[..., None] * n_st + jnp.einsum('bhs,bhse->bhe', wk, kc)
        return (c_new, n_new, m_new), h

    init = (jnp.zeros((bsz, n_h, e, e), jnp.float32),
            jnp.zeros((bsz, n_h, e), jnp.float32),
            jnp.zeros((bsz, n_h), jnp.float32))
    _, h = lax.scan(step, init, (to_chunks4(q), to_chunks4(k), to_chunks4(v),
                                 to_chunks3(log_i), to_chunks3(log_f)))
    return from_chunks4(h)


def gla_chunkwise(q, k, v, log_a):
    bsz, _, n_h, dk = q.shape
    dv = v.shape[-1]
    mask = jnp.tril(jnp.ones((CHUNK, CHUNK), dtype=bool))[..., None]

    def step(s_st, xs):
        qc, kc, vc, ac = xs
        b = jnp.cumsum(ac, axis=2)
        inter = jnp.einsum('bhtk,bhkv->bhtv', qc * jnp.exp(b), s_st)
        diff = jnp.where(mask, b[:, :, :, None, :] - b[:, :, None, :, :], -jnp.inf)
        attn = jnp.einsum('bhtk,bhsk,bhtsk->bhts', qc, kc, jnp.exp(diff))
        o = inter + jnp.einsum('bhts,bhsv->bhtv', attn, vc)
        b_last = b[:, :, -1:, :]
        s_new = (jnp.exp(b_last[:, :, 0, :])[..., None] * s_st
                 + jnp.einsum('bhsk,bhsv->bhkv', kc * jnp.exp(b_last - b), vc))
        return s_new, o

    init = jnp.zeros((bsz, n_h, dk, dv), jnp.float32)
    _, o = lax.scan(step, init, (to_chunks4(q), to_chunks4(k), to_chunks4(v), to_chunks4(log_a)))
    return from_chunks4(o)


def rwkv7_scan(r, w, k, v, a, b):
    bsz, _, n_h, n = r.shape

    def step(s, xs):
        rt, wt, kt, vt, at, bt = xs
        sa = jnp.einsum('bhij,bhj->bhi', s, at)
        s = s * wt[:, :, None, :] + sa[..., None] * bt[:, :, None, :] + vt[..., None] * kt[:, :, None, :]
        return s, jnp.einsum('bhij,bhj->bhi', s, rt)

    xs = tuple(jnp.moveaxis(z, 1, 0) for z in (r, w, k, v, a, b))
    _, y = lax.scan(step, jnp.zeros((bsz, n_h, n, n), jnp.float32), xs)
    return jnp.moveaxis(y, 0, 1)


def complex_affine_combine(e1, e2):
    a1r, a1i, b1r, b1i = e1
    a2r, a2i, b2r, b2i = e2
    return (a2r * a1r - a2i * a1i,
            a2r * a1i + a2i * a1r,
            a2r * b1r - a2i * b1i + b2r,
            a2r * b1i + a2i * b1r + b2i)


def mlstm_branch(u, o_pre, i_pre, f_pre, conv_w, wq, wk, wv, b_i, b_f, norm_g, proj):
    bsz, t, _ = u.shape
    f32 = jnp.float32
    uc = jax.nn.silu(causal_depthwise_conv(u, conv_w))
    uc_h = uc.reshape(bsz, t, MLSTM_HEADS, MLSTM_HEAD_DIM)
    u_h = u.reshape(bsz, t, MLSTM_HEADS, MLSTM_HEAD_DIM)
    q = jnp.einsum('bthe,hef->bthf', uc_h, wq).astype(f32)
    k = jnp.einsum('bthe,hef->bthf', uc_h, wk).astype(f32) * MLSTM_HEAD_DIM ** -0.5
    v = jnp.einsum('bthe,hef->bthf', u_h, wv).astype(f32)
    log_i = (i_pre + b_i).astype(f32)
    log_f = jax.nn.log_sigmoid((f_pre + b_f).astype(f32))
    h = mlstm_chunkwise(q, k, v, log_i, log_f).reshape(bsz, t, BRANCH_WIDTH)
    h = head_rms_norm(h, norm_g, MLSTM_HEADS) * jax.nn.sigmoid(o_pre.astype(f32))
    return h.astype(u.dtype) @ proj


def s5_branch(u, a_re, a_im, log_step, b_re, b_im, c_re, c_im, d_skip, glu_w1, glu_w2):
    bsz, t, _ = u.shape
    f32 = jnp.float32
    u32 = u.astype(f32)
    xg = u32.reshape(bsz, t, S5_GROUPS, S5_GROUP)
    step = jnp.exp(log_step.astype(f32))[:, None]
    lam_re = jnp.minimum(a_re.astype(f32), -S5_MIN_NEG)
    lam_im = a_im.astype(f32)
    mag = jnp.exp(lam_re * step)
    bar_re = mag * jnp.cos(lam_im * step)
    bar_im = mag * jnp.sin(lam_im * step)
    denom = lam_re * lam_re + lam_im * lam_im
    coef_re = ((bar_re - 1.0) * lam_re + bar_im * lam_im) / denom
    coef_im = (bar_im * lam_re - (bar_re - 1.0) * lam_im) / denom
    br, bi = b_re.astype(f32), b_im.astype(f32)
    bb_re = coef_re[..., None] * br - coef_im[..., None] * bi
    bb_im = coef_re[..., None] * bi + coef_im[..., None] * br
    bu_re = jnp.einsum('btgc,gpc->btgp', xg, bb_re)
    bu_im = jnp.einsum('btgc,gpc->btgp', xg, bb_im)
    lr = jnp.broadcast_to(bar_re, bu_re.shape)
    li = jnp.broadcast_to(bar_im, bu_im.shape)
    _, _, s_re, s_im = lax.associative_scan(complex_affine_combine, (lr, li, bu_re, bu_im), axis=1)
    y = (jnp.einsum('btgp,gcp->btgc', s_re, c_re.astype(f32))
         - jnp.einsum('btgp,gcp->btgc', s_im, c_im.astype(f32)))
    y = y.reshape(bsz, t, BRANCH_WIDTH) + d_skip.astype(f32) * u32
    z = jax.nn.gelu(y).astype(u.dtype)
    return (z @ glu_w1) * jax.nn.sigmoid(z @ glu_w2)


def gla_branch(q, k, v, g, a_low, a_up, a_bias, norm_g, proj):
    bsz, t, _ = q.shape
    f32 = jnp.float32
    qh = q.astype(f32).reshape(bsz, t, GLA_HEADS, GLA_HEAD_K) * GLA_HEAD_K ** -0.5
    kh = k.astype(f32).reshape(bsz, t, GLA_HEADS, GLA_HEAD_K)
    vh = v.astype(f32).reshape(bsz, t, GLA_HEADS, GLA_HEAD_V)
    log_a = jax.nn.log_sigmoid((a_low @ a_up + a_bias).astype(f32)) / GLA_GATE_TAU
    log_a = log_a.reshape(bsz, t, GLA_HEADS, GLA_HEAD_K)
    o = gla_chunkwise(qh, kh, vh, log_a).reshape(bsz, t, BRANCH_WIDTH)
    o = head_rms_norm(o, norm_g, GLA_HEADS) * jax.nn.silu(g.astype(f32))
    return o.astype(q.dtype) @ proj


def rwkv7_branch(z, mu, w0, w_up, a0, a_up, g_up, k_k, k_a, r_k, norm_g, proj):
    bsz, t, _ = z.shape
    f32 = jnp.float32
    z = z + mu * (token_shift(z) - z)
    r, k, v, xw, xa, xg = jnp.split(z, RWKV_SPLIT_POINTS, axis=-1)
    w_log = -jax.nn.softplus(-(w0 + jnp.tanh(xw) @ w_up).astype(f32)) - 0.5
    decay = jnp.exp(-jnp.exp(w_log))
    a = jax.nn.sigmoid((a0 + xa @ a_up).astype(f32))
    g = jax.nn.sigmoid(xg) @ g_up

    def heads(y):
        return y.astype(f32).reshape(bsz, t, RWKV_HEADS, RWKV_HEAD)

    kk = heads(k * k_k)
    kk = kk / jnp.maximum(jnp.linalg.norm(kk, axis=-1, keepdims=True), 1e-12)
    k_rep = heads(k.astype(f32) * (1.0 + (a - 1.0) * k_a.astype(f32)))
    rh, vh, ah = heads(r), heads(v), heads(a)
    y = rwkv7_scan(rh, heads(decay), k_rep, vh, -kk, kk * ah)
    y = head_group_norm(y.reshape(bsz, t, BRANCH_WIDTH), norm_g, RWKV_HEADS, RWKV_GN_EPS)
    bonus = jnp.sum(rh * k_rep * r_k.astype(f32), axis=-1, keepdims=True) * vh
    y = (y + bonus.reshape(bsz, t, BRANCH_WIDTH)) * g.astype(f32)
    return y.astype(z.dtype) @ proj


def memory_cross_attention(h, mem_n, wq, wk, wv, wo):
    bsz, t, _ = h.shape
    m_len = mem_n.shape[1]
    q = (h @ wq).reshape(bsz, t, XATTN_HEADS, XATTN_HEAD_DIM)
    k = (mem_n @ wk).reshape(bsz, m_len, XATTN_HEADS, XATTN_HEAD_DIM)
    v = (mem_n @ wv).reshape(bsz, m_len, XATTN_HEADS, XATTN_HEAD_DIM)
    s = jnp.einsum('bthd,bmhd->bhtm', q, k).astype(jnp.float32) * XATTN_HEAD_DIM ** -0.5
    p = jax.nn.softmax(s, axis=-1).astype(h.dtype)
    o = jnp.einsum('bhtm,bmhd->bthd', p, v).reshape(bsz, t, D_MODEL)
    return o @ wo


def setup_inputs(seed: int = 0) -> dict:
    key = jax.random.key(seed)
    ks = iter(jax.random.split(key, 80))
    f32 = jnp.float32
    L, D, W, F = DEPTH, D_MODEL, BRANCH_WIDTH, D_FF

    def nrm(shape, scale):
        return jax.random.normal(next(ks), shape, f32) * scale

    def gain(shape):
        return 1.0 + nrm(shape, 0.02)

    def unif(shape, lo, hi):
        return jax.random.uniform(next(ks), shape, f32, lo, hi)

    p = {}
    p["x"] = nrm((BATCH, SEQ, D), 1.0)
    p["mem"] = nrm((BATCH, MEM_LEN, D), 1.0)
    p["ffn1_norm"] = gain((L, D))
    p["ffn1_w_gate"] = nrm((L, D, F), D ** -0.5)
    p["ffn1_w_up"] = nrm((L, D, F), D ** -0.5)
    p["ffn1_w_down"] = nrm((L, F, D), F ** -0.5)
    p["mix_norm"] = gain((L, D))
    p["w_in"] = nrm((L, D, N_IN), D ** -0.5)
    p["gate_bias"] = nrm((L, N_BRANCH * D), 0.1)
    p["mlstm_conv"] = nrm((L, MLSTM_CONV, W), MLSTM_CONV ** -0.5)
    p["mlstm_wq"] = nrm((L, MLSTM_HEADS, MLSTM_HEAD_DIM, MLSTM_HEAD_DIM), MLSTM_HEAD_DIM ** -0.5)
    p["mlstm_wk"] = nrm((L, MLSTM_HEADS, MLSTM_HEAD_DIM, MLSTM_HEAD_DIM), MLSTM_HEAD_DIM ** -0.5)
    p["mlstm_wv"] = nrm((L, MLSTM_HEADS, MLSTM_HEAD_DIM, MLSTM_HEAD_DIM), MLSTM_HEAD_DIM ** -0.5)
    p["mlstm_b_i"] = nrm((L, MLSTM_HEADS), 0.1)
    p["mlstm_b_f"] = jnp.linspace(3.0, 6.0, MLSTM_HEADS, dtype=f32)[None, :] + nrm((L, MLSTM_HEADS), 0.1)
    p["mlstm_norm"] = gain((L, W))
    p["mlstm_proj"] = nrm((L, W, D), W ** -0.5)
    p["s5_a_re"] = -0.5 + nrm((L, S5_GROUPS, S5_STATE), 0.01)
    p["s5_a_im"] = (jnp.broadcast_to(math.pi * jnp.arange(S5_STATE, dtype=f32), (L, S5_GROUPS, S5_STATE))
                    + nrm((L, S5_GROUPS, S5_STATE), 0.01))
    p["s5_log_step"] = unif((L, S5_GROUPS), math.log(1e-3), math.log(1e-1))
    p["s5_b_re"] = nrm((L, S5_GROUPS, S5_STATE, S5_GROUP), (2 * S5_GROUP) ** -0.5)
    p["s5_b_im"] = nrm((L, S5_GROUPS, S5_STATE, S5_GROUP), (2 * S5_GROUP) ** -0.5)
    p["s5_c_re"] = nrm((L, S5_GROUPS, S5_GROUP, S5_STATE), S5_STATE ** -0.5)
    p["s5_c_im"] = nrm((L, S5_GROUPS, S5_GROUP, S5_STATE), S5_STATE ** -0.5)
    p["s5_d"] = nrm((L, W), 1.0)
    p["s5_glu_w1"] = nrm((L, W, D), W ** -0.5)
    p["s5_glu_w2"] = nrm((L, W, D), W ** -0.5)
    p["gla_a_up"] = nrm((L, GLA_GATE_RANK, GLA_KEY_WIDTH), GLA_GATE_RANK ** -0.5)
    p["gla_a_bias"] = nrm((L, GLA_KEY_WIDTH), 0.1)
    p["gla_norm"] = gain((L, W))
    p["gla_proj"] = nrm((L, W, D), W ** -0.5)
    p["rwkv_mu"] = unif((L, RWKV_COLS), 0.0, 1.0)
    p["rwkv_w0"] = jnp.linspace(-6.5, -1.5, W, dtype=f32)[None, :] + nrm((L, W), 0.1)
    p["rwkv_w_up"] = nrm((L, RWKV_DECAY_RANK, W), 0.1)
    p["rwkv_a0"] = nrm((L, W), 0.1)
    p["rwkv_a_up"] = nrm((L, RWKV_ICLR_RANK, W), 0.1)
    p["rwkv_g_up"] = nrm((L, RWKV_GATE_RANK, W), RWKV_GATE_RANK ** -0.5)
    p["rwkv_k_k"] = 0.85 + nrm((L, W), 0.02)
    p["rwkv_k_a"] = 1.0 + nrm((L, W), 0.02)
    p["rwkv_r_k"] = nrm((L, RWKV_HEADS, RWKV_HEAD), 0.1)
    p["rwkv_norm"] = gain((L, W))
    p["rwkv_proj"] = nrm((L, W, D), W ** -0.5)
    p["w_out"] = nrm((L, D, D), D ** -0.5)
    p["xattn_norm"] = gain((L, D))
    p["mem_norm"] = gain((L, D))
    p["xattn_wq"] = nrm((L, D, D), D ** -0.5)
    p["xattn_wk"] = nrm((L, D, D), D ** -0.5)
    p["xattn_wv"] = nrm((L, D, D), D ** -0.5)
    p["xattn_wo"] = nrm((L, D, D), D ** -0.5)
    p["ffn2_norm"] = gain((L, D))
    p["ffn2_w_gate"] = nrm((L, D, F), D ** -0.5)
    p["ffn2_w_up"] = nrm((L, D, F), D ** -0.5)
    p["ffn2_w_down"] = nrm((L, F, D), F ** -0.5)
    p["final_norm"] = gain((D,))
    return p


def reference(x, mem,
              ffn1_norm, ffn1_w_gate, ffn1_w_up, ffn1_w_down,
              mix_norm, w_in, gate_bias,
              mlstm_conv, mlstm_wq, mlstm_wk, mlstm_wv, mlstm_b_i, mlstm_b_f, mlstm_norm, mlstm_proj,
              s5_a_re, s5_a_im, s5_log_step, s5_b_re, s5_b_im, s5_c_re, s5_c_im, s5_d, s5_glu_w1, s5_glu_w2,
              gla_a_up, gla_a_bias, gla_norm, gla_proj,
              rwkv_mu, rwkv_w0, rwkv_w_up, rwkv_a0, rwkv_a_up, rwkv_g_up, rwkv_k_k, rwkv_k_a, rwkv_r_k,
              rwkv_norm, rwkv_proj,
              w_out,
              xattn_norm, mem_norm, xattn_wq, xattn_wk, xattn_wv, xattn_wo,
              ffn2_norm, ffn2_w_gate, ffn2_w_up, ffn2_w_down,
              final_norm):
    bsz, t, _ = x.shape
    dt = x.dtype
    for l in range(DEPTH):
        h = rms_norm(x, ffn1_norm[l])
        x = x + FFN_HALF * swiglu_ffn(h, ffn1_w_gate[l], ffn1_w_up[l], ffn1_w_down[l])

        h = rms_norm(x, mix_norm[l])
        z = h @ w_in[l]
        (a_u, a_o, a_i, a_f, b_u, c_q, c_k, c_v, c_g, c_a, d_z, gate_pre) = jnp.split(
            z, IN_SPLIT_POINTS, axis=-1)
        y_a = mlstm_branch(a_u, a_o, a_i, a_f, mlstm_conv[l], mlstm_wq[l], mlstm_wk[l], mlstm_wv[l],
                           mlstm_b_i[l], mlstm_b_f[l], mlstm_norm[l], mlstm_proj[l])
        y_b = s5_branch(b_u, s5_a_re[l], s5_a_im[l], s5_log_step[l], s5_b_re[l], s5_b_im[l],
                        s5_c_re[l], s5_c_im[l], s5_d[l], s5_glu_w1[l], s5_glu_w2[l])
        y_c = gla_branch(c_q, c_k, c_v, c_g, c_a, gla_a_up[l], gla_a_bias[l], gla_norm[l], gla_proj[l])
        y_d = rwkv7_branch(d_z, rwkv_mu[l], rwkv_w0[l], rwkv_w_up[l], rwkv_a0[l], rwkv_a_up[l],
                           rwkv_g_up[l], rwkv_k_k[l], rwkv_k_a[l], rwkv_r_k[l], rwkv_norm[l], rwkv_proj[l])
        gates = jax.nn.sigmoid((gate_pre + gate_bias[l]).astype(jnp.float32)).astype(dt)
        gates = gates.reshape(bsz, t, N_BRANCH, D_MODEL)
        merged = (gates[:, :, 0] * y_a + gates[:, :, 1] * y_b
                  + gates[:, :, 2] * y_c + gates[:, :, 3] * y_d)
        x = x + merged @ w_out[l]

        h = rms_norm(x, xattn_norm[l])
        m = rms_norm(mem, mem_norm[l])
        x = x + memory_cross_attention(h, m, xattn_wq[l], xattn_wk[l], xattn_wv[l], xattn_wo[l])

        h = rms_norm(x, ffn2_norm[l])
        x = x + FFN_HALF * swiglu_ffn(h, ffn2_w_gate[l], ffn2_w_up[l], ffn2_w_down[l])
    return rms_norm(x, final_norm)
```

```cpp
#include <hip/hip_runtime.h>
#include <cstdio>
#include <cstdint>

#define LAS __attribute__((address_space(3)))
#define GAS __attribute__((address_space(1)))
typedef unsigned short bf16;
typedef float f32x4 __attribute__((ext_vector_type(4)));
typedef float f32x2 __attribute__((ext_vector_type(2)));
typedef unsigned u32x4 __attribute__((ext_vector_type(4)));
typedef unsigned u32x2 __attribute__((ext_vector_type(2)));
typedef short bf16x8 __attribute__((ext_vector_type(8)));

constexpr int NB = 4, SEQ = 4096, M = NB * SEQ, D = 1024, FF = 2816, WB = 512, DEPTH = 2, MEML = 256, MMEM = NB * MEML;
constexpr int NZ = 4888, ZP = 4896, NINP = 5120, NIN = 8984;
constexpr int ZA_U = 0, ZA_O = 512, ZA_I = 1024, ZA_F = 1028, ZB_U = 1032, ZC_Q = 1544, ZC_K = 1800, ZC_V = 2056, ZC_G = 2568, ZC_A = 3080;
constexpr int ZD_R = 3096, ZD_K = 3608, ZD_V = 4120, ZD_XW = 4632, ZD_XA = 4696, ZD_XG = 4760, ZG = 4888;
constexpr float NORM_EPS = 1e-6f;

enum { I_X = 0, I_MEM, I_FFN1_NORM, I_FFN1_WG, I_FFN1_WU, I_FFN1_WD, I_MIX_NORM, I_W_IN, I_GATE_BIAS, I_ML_CONV, I_ML_WQ, I_ML_WK, I_ML_WV, I_ML_BI, I_ML_BF,
       I_ML_NORM, I_ML_PROJ, I_S5_ARE, I_S5_AIM, I_S5_LOGSTEP, I_S5_BRE, I_S5_BIM, I_S5_CRE, I_S5_CIM, I_S5_D, I_S5_W1, I_S5_W2, I_GLA_AUP, I_GLA_ABIAS,
       I_GLA_NORM, I_GLA_PROJ, I_RW_MU, I_RW_W0, I_RW_WUP, I_RW_A0, I_RW_AUP, I_RW_GUP, I_RW_KK, I_RW_KA, I_RW_RK, I_RW_NORM, I_RW_PROJ, I_W_OUT,
       I_XA_NORM, I_MEM_NORM, I_XA_WQ, I_XA_WK, I_XA_WV, I_XA_WO, I_FFN2_NORM, I_FFN2_WG, I_FFN2_WU, I_FFN2_WD, I_FINAL_NORM, N_INPUTS };

constexpr size_t MiB = 1u << 20;
constexpr size_t WS_CTL = 0, CTL_ZERO_BYTES = 64 * 1024;
constexpr size_t WS_SSQ = 1 * MiB;
constexpr size_t WS_MEMR = 256 * 1024;
constexpr size_t WS_XB = 2 * MiB;
constexpr size_t WS_MEMB = 34 * MiB;
constexpr size_t WS_KV = 36 * MiB;
constexpr size_t WS_SLOTA = 44 * MiB;
constexpr size_t WS_SLOTB = 55 * MiB;
constexpr size_t WS_SLOTC = 65 * MiB;
constexpr size_t WS_Z = 73 * MiB;
constexpr size_t Z_BYTES = (size_t)M * ZP * 2;
constexpr size_t WS_S = WS_Z + Z_BYTES;
constexpr size_t WS_END = 350110016;
static_assert(WS_S == 226 * MiB, "map");
constexpr size_t S_BYTES = WS_END - WS_S;
constexpr size_t WS_HID = WS_Z;
constexpr size_t WS_XQ = WS_Z, WS_XO = WS_Z + 32 * MiB, WS_XP = WS_Z + 64 * MiB;
constexpr size_t WS_GT = WS_S, WS_MF = WS_S + 32 * MiB;
static_assert(WS_MF + 64 * MiB <= WS_END, "merge stash");

constexpr int LDS_BYTES = 147456, RING_BYTES = 131072, MISC_OFF = RING_BYTES + 320;

#define RLX_AGENT __ATOMIC_RELAXED, __HIP_MEMORY_SCOPE_AGENT
#define LDS_WAIT() asm volatile("s_waitcnt lgkmcnt(0)" ::: "memory")
#define VM_WAIT() asm volatile("s_waitcnt vmcnt(0)" ::: "memory")
__device__ __forceinline__ unsigned f2bf(float f) { unsigned u = __builtin_bit_cast(unsigned, f); return (u + 0x7fffu + ((u >> 16) & 1u)) >> 16; }
__device__ __forceinline__ unsigned pk2(float lo, float hi) { return f2bf(lo) | (f2bf(hi) << 16); }
__device__ __forceinline__ float bf2f(unsigned h) { return __builtin_bit_cast(float, h << 16); }
__device__ __forceinline__ float bflo(unsigned w) { return __builtin_bit_cast(float, w << 16); }
__device__ __forceinline__ float bfhi(unsigned w) { return __builtin_bit_cast(float, w & 0xffff0000u); }
__device__ __forceinline__ float sigmoidf_(float x) { return 1.0f / (1.0f + __expf(-x)); }
__device__ __forceinline__ float siluf_(float x) { return x / (1.0f + __expf(-x)); }
__device__ __forceinline__ float softplusf_(float x) { return fmaxf(x, 0.f) + log1pf(__expf(-fabsf(x))); }
__device__ __forceinline__ float logsigmoidf_(float x) { return -softplusf_(-x); }
__device__ __forceinline__ float wave_sum(float v) {
#pragma unroll
    for (int o = 1; o < 64; o <<= 1) v += __shfl_xor(v, o);
    return v;
}

#define XB_TMO      128
#define XB_XCNT(j)  (256  + 64 * (j))
#define XB_XSUB(j)  (1280 + 64 * (j))
#define XB_XGEN(j)  (2304 + 64 * (j))
#define XB_TOP      3328
#define XB_TOPGEN   3392
#define XCD_BAR_WORDS 3456
#define XB_SPIN_CAP (1u << 20)
__device__ __forceinline__ unsigned xb_ld(unsigned* p)              { return __hip_atomic_load(p, __ATOMIC_RELAXED, __HIP_MEMORY_SCOPE_AGENT); }
__device__ __forceinline__ unsigned xb_add(unsigned* p, unsigned v) { return __hip_atomic_fetch_add(p, v, __ATOMIC_RELAXED, __HIP_MEMORY_SCOPE_AGENT); }
__device__ __forceinline__ unsigned xb_xcc_id() { return (unsigned)__builtin_amdgcn_s_getreg((3 << 11) | 20) & 0xFu; }
#define XB_SPIN(cond, bar) do { unsigned _sp = 0; while (cond) { __builtin_amdgcn_s_sleep(1); \
    if ((++_sp & 255u) == 0u) { if (xb_ld(&(bar)[XB_TMO])) break; if (_sp > XB_SPIN_CAP) { atomicAdd(&(bar)[XB_TMO], 1u); break; } } } } while (0)
struct XcdBarrier { unsigned* bar; unsigned x; volatile LAS unsigned* st; };
__device__ __forceinline__ XcdBarrier xcd_barrier_post(unsigned* bar, volatile LAS unsigned* st) {
    XcdBarrier b; b.bar = bar; b.x = xb_xcc_id(); b.st = st;
    if (threadIdx.x == 0) (void)xb_add(&bar[XB_XCNT(b.x)], 1u);
    return b;
}
__device__ __forceinline__ void xcd_barrier_complete(unsigned* bar, unsigned x, unsigned& nloc, unsigned& nx) {
    const unsigned G = gridDim.x * gridDim.y * gridDim.z;
    unsigned sum, cnt, mine, sp = 0u;
    for (;;) {
        sum = 0u; cnt = 0u; mine = 0u;
#pragma unroll
        for (unsigned j = 0; j < 16; ++j) { const unsigned c = xb_ld(&bar[XB_XCNT(j)]); sum += c; cnt += (c > 0u) ? 1u : 0u; mine = (j == x) ? c : mine; }
        if (sum == G) break;
        __builtin_amdgcn_s_sleep(1);
        if ((++sp & 255u) == 0u) { if (xb_ld(&bar[XB_TMO])) break; if (sp > XB_SPIN_CAP) { atomicAdd(&bar[XB_TMO], 1u); break; } }
    }
    nloc = mine > 0u ? mine : 1u; nx = cnt > 0u ? cnt : 1u;
}
__device__ __forceinline__ void xcd_barrier(const XcdBarrier& b) {
    asm volatile("s_waitcnt vmcnt(0)" ::: "memory");
    __syncthreads();
    if (threadIdx.x == 0) {
        unsigned* bar = b.bar;
        __builtin_amdgcn_s_waitcnt(0);
        unsigned nloc = b.st[0], nx = b.st[1];
        if (nloc == 0u) { xcd_barrier_complete(bar, b.x, nloc, nx); b.st[0] = nloc; b.st[1] = nx; }
        const unsigned old = xb_add(&bar[XB_XSUB(b.x)], 1u);
        const unsigned gen = old / nloc;
        if (old + 1u == (gen + 1u) * nloc) {
            __builtin_amdgcn_fence(__ATOMIC_RELEASE, "agent");
            asm volatile("s_waitcnt vmcnt(0)" ::: "memory");
            const unsigned og = xb_add(&bar[XB_TOP], 1u);
            const unsigned tg = og / nx;
            if (og + 1u == (tg + 1u) * nx) xb_add(&bar[XB_TOPGEN], 1u);
            else XB_SPIN(xb_ld(&bar[XB_TOPGEN]) == tg, bar);
            __builtin_amdgcn_fence(__ATOMIC_ACQUIRE, "agent");
            xb_add(&bar[XB_XGEN(b.x)], 1u);
            asm volatile("s_waitcnt vmcnt(0)" ::: "memory");
        } else {
            XB_SPIN(xb_ld(&bar[XB_XGEN(b.x)]) == gen, bar);
            __builtin_amdgcn_fence(__ATOMIC_ACQUIRE, "agent");
            asm volatile("s_waitcnt vmcnt(0)" ::: "memory");
        }
    }
    __syncthreads();
}
namespace pg8 {
#define PG8_LAS __attribute__((address_space(3)))
typedef unsigned short bf16_t;
typedef short bf16x8 __attribute__((ext_vector_type(8)));
typedef float f32x4 __attribute__((ext_vector_type(4)));
typedef unsigned u32x4 __attribute__((ext_vector_type(4)));
constexpr int BM = 256, BK = 64, HALF = 128, HTB = HALF * BK * 2  , STAGE_BYTES = 8 * HTB, NXCD = 8, WGM = 8;

__host__ __device__ __forceinline__ int lds_byte(int r, int c) { const int st = (r >> 4) * 2 + (c >> 5), rr = r & 15, cc = c & 31, ob = rr * 64 + cc * 2; return st * 1024 + (ob ^ (((ob >> 9) & 1) << 5)); }
__host__ __device__ __forceinline__ void stage_rc(int b, int& R, int& C) { const int st = b / 1024, sb = b % 1024, swz = sb ^ (((sb >> 9) & 1) << 5); R = (st >> 1) * 16 + swz / 64; C = (st & 1) * 32 + (swz % 64) / 2; }
__host__ __device__ __forceinline__ int perm32(int rho) { const int n = rho >> 4, i = rho & 15; return 8 * (i >> 2) + 4 * n + (i & 3); }

struct Unit { int pm, pn; };
struct Gemm { const bf16_t* A; const bf16_t* Bt; int M, N, K, lda, ldb; };

struct StaticOrder {
    int nM, nN, nwg, G, c;
    __host__ __device__ void init(int M, int N, int G_, int c_) { nM = M / BM; nN = N / BM; nwg = nM * nN; G = G_; c = c_; }
    __host__ __device__ bool next(int i, Unit& u) const {
        const long L = (long)i * G + c; if (L >= nwg) return false;
        int wgid = (int)L; { const int q = nwg / NXCD, r = nwg % NXCD, xcd = wgid % NXCD, off = wgid / NXCD; wgid = (xcd < r ? xcd * (q + 1) : r * (q + 1) + (xcd - r) * q) + off; }
        const int nig = WGM * nN, gid = wgid / nig, fm = gid * WGM, gsz = (nM - fm) < WGM ? (nM - fm) : WGM;
        u.pm = fm + ((wgid % nig) % gsz); u.pn = (wgid % nig) / gsz; return true;
    }
    __device__ __forceinline__ void a_ready(const Unit&) const {}
    __device__ __forceinline__ void done(const Unit&) const {}
};


struct SingleUnit {
    __device__ bool next(int i, Unit& u) const { if (i > 0) return false; u.pm = 0; u.pn = 0; return true; }
    __device__ __forceinline__ void a_ready(const Unit&) const {}
    __device__ __forceinline__ void done(const Unit&) const {}
};
__device__ __forceinline__ unsigned cvt_pk_bf16(float lo, float hi) { unsigned r; asm volatile("v_cvt_pk_bf16_f32 %0, %1, %2" : "=v"(r) : "v"(lo), "v"(hi)); return r; }
template <class Epi, class Sched, bool ALIGN_EPI = false, bool SP2 = false>
__device__ __forceinline__ void gemm_phase(PG8_LAS unsigned char* lds, const Gemm g, const Sched& S, const Epi& E) {
    int tid_ = threadIdx.x; asm volatile("" : "+v"(tid_));
    const int tid = tid_, wid = __builtin_amdgcn_readfirstlane(tid >> 6), lane = tid & 63, wr = wid >> 2, wc = wid & 3, fr = lane & 15, fq = lane >> 4;
    const int K = g.K, nt = K / BK, lda = g.lda, ldb = g.ldb;
    unsigned voffA[2], voffB[2];
#pragma unroll
    for (int i = 0; i < 2; ++i) { int R, C; stage_rc(tid * 16 + i * 8192, R, C); const int Rb = Epi::PERM ? ((R & ~31) + perm32(R & 31)) : R;
        voffA[i] = (unsigned)(R * lda + C) * 2u; voffB[i] = (unsigned)(Rb * ldb + C) * 2u; }
    const size_t kstep = (size_t)(BK * 2);
    const size_t hstepA = (size_t)HALF * lda * 2, hstepB = (size_t)HALF * ldb * 2;
    const size_t tstepA = 2 * hstepA, tstepB = 2 * hstepB;
    const unsigned ldsw = (unsigned)wid * 1024u;
    const int aoff = lds_byte(wr * 64 + fr, fq * 8), boff = lds_byte(wc * 32 + fr, fq * 8);
#define PG8_SA(b, h) (((b) * 2 + (h)) * HTB)
#define PG8_SB(b, h) ((4 + (b) * 2 + (h)) * HTB)
#define PG8_STAGE(bufoff, gbase, voff) do { _Pragma("unroll") for (int _i = 0; _i < 2; ++_i) \
        __builtin_amdgcn_global_load_lds((const unsigned*)((const char*)(gbase) + (voff)[_i]), (PG8_LAS unsigned*)(lds + (bufoff) + ldsw + _i * 8192), 16, 0, 0); } while (0)
#define PG8_LDA(dst, b, h) do { _Pragma("unroll") for (int m = 0; m < 4; ++m) _Pragma("unroll") for (int k = 0; k < 2; ++k) dst[m][k] = *(const PG8_LAS bf16x8*)(lds + PG8_SA(b, h) + aoff + m * 2048 + k * 1024); } while (0)
#define PG8_LDB(dst, b, h) do { _Pragma("unroll") for (int n = 0; n < 2; ++n) _Pragma("unroll") for (int k = 0; k < 2; ++k) dst[n][k] = *(const PG8_LAS bf16x8*)(lds + PG8_SB(b, h) + boff + n * 2048 + k * 1024); } while (0)
#define PG8_MMA(ai, bj, At, Bt) do { __builtin_amdgcn_s_setprio(1); _Pragma("unroll") for (int m = 0; m < 4; ++m) _Pragma("unroll") for (int n = 0; n < 2; ++n) _Pragma("unroll") for (int k = 0; k < 2; ++k) \
        acc[ai][bj][m][n] = __builtin_amdgcn_mfma_f32_16x16x32_bf16(Bt[n][k], At[m][k], acc[ai][bj][m][n], 0, 0, 0); __builtin_amdgcn_s_setprio(0); } while (0)
#define PG8_WAIT_V(n) asm volatile("s_waitcnt vmcnt(" #n ")" ::: "memory")
#define PG8_WAIT_L(n) asm volatile("s_waitcnt lgkmcnt(" #n ")" ::: "memory")
#define PG8_BAR __builtin_amdgcn_s_barrier()
#define PG8_SCHED __builtin_amdgcn_sched_barrier(0)
    Unit cur, nxt; int ui = 0;
    if (!S.next(0, cur)) return;
    f32x4 acc[2][2][4][2];
#pragma unroll
    for (int a = 0; a < 2; ++a)
#pragma unroll
        for (int b = 0; b < 2; ++b)
#pragma unroll
            for (int m = 0; m < 4; ++m)
#pragma unroll
                for (int n = 0; n < 2; ++n) acc[a][b][m][n] = (f32x4){0.f, 0.f, 0.f, 0.f};
    bf16x8 At[4][2], B0[2][2], B1[2][2];
    const char* cA = (const char*)g.A + (size_t)cur.pm * tstepA; const char* cB = (const char*)g.Bt + (size_t)cur.pn * tstepB;
    S.a_ready(cur);
    if constexpr (SP2) {
        PG8_STAGE(PG8_SB(0, 0), cB, voffB); PG8_STAGE(PG8_SB(0, 1), cB + hstepB, voffB); PG8_STAGE(PG8_SA(0, 0), cA, voffA); PG8_STAGE(PG8_SA(0, 1), cA + hstepA, voffA);
        if (wr == 1) PG8_BAR;
        PG8_WAIT_V(2); PG8_BAR;
        PG8_STAGE(PG8_SB(1, 0), cB + kstep, voffB); PG8_STAGE(PG8_SA(1, 0), cA + kstep, voffA); PG8_STAGE(PG8_SB(1, 1), cB + hstepB + kstep, voffB);
        PG8_WAIT_V(6); PG8_BAR;
    } else {
        PG8_STAGE(PG8_SB(0, 0), cB, voffB); PG8_STAGE(PG8_SA(0, 0), cA, voffA); PG8_STAGE(PG8_SB(0, 1), cB + hstepB, voffB); PG8_STAGE(PG8_SA(0, 1), cA + hstepA, voffA);
        if (wr == 1) PG8_BAR;
        PG8_WAIT_V(4); PG8_BAR;
        PG8_STAGE(PG8_SB(1, 0), cB + kstep, voffB); PG8_STAGE(PG8_SA(1, 0), cA + kstep, voffA); PG8_STAGE(PG8_SB(1, 1), cB + hstepB + kstep, voffB);
        PG8_WAIT_V(6); PG8_BAR;
    }
    for (;;) {
        const bool has_next = S.next(ui + 1, nxt);
        const char* nA = has_next ? (const char*)g.A + (size_t)nxt.pm * tstepA : cA; const char* nB = has_next ? (const char*)g.Bt + (size_t)nxt.pn * tstepB : cB;
        for (int t = 0; t < nt; t += 2) {
            const bool last = (t == nt - 2);
            const char* a1 = cA + (size_t)(t + 1) * kstep;
            const char* a2 = last ? nA : cA + (size_t)(t + 2) * kstep; const char* b2 = last ? nB : cB + (size_t)(t + 2) * kstep;
            const char* a3 = a2 + kstep; const char* b3 = b2 + kstep;
            if (last && has_next) S.a_ready(nxt);
            if constexpr (SP2) {
            PG8_LDB(B0, 0, 0); PG8_LDB(B1, 0, 1); PG8_SCHED; PG8_LDA(At, 0, 0); PG8_STAGE(PG8_SA(1, 1), a1 + hstepA, voffA);
            PG8_WAIT_V(8); PG8_WAIT_L(0); PG8_BAR; PG8_MMA(0, 0, At, B0); PG8_MMA(0, 1, At, B1); PG8_BAR; PG8_SCHED;
            PG8_LDA(At, 0, 1); PG8_STAGE(PG8_SB(0, 0), b2, voffB); PG8_STAGE(PG8_SB(0, 1), b2 + hstepB, voffB); PG8_STAGE(PG8_SA(0, 0), a2, voffA);
            PG8_WAIT_V(8); PG8_WAIT_L(0); PG8_BAR; PG8_MMA(1, 0, At, B0); PG8_MMA(1, 1, At, B1); PG8_BAR; PG8_SCHED;
            PG8_LDB(B0, 1, 0); PG8_LDB(B1, 1, 1); PG8_SCHED; PG8_LDA(At, 1, 0); PG8_STAGE(PG8_SA(0, 1), a2 + hstepA, voffA);
            PG8_WAIT_V(8); PG8_WAIT_L(0); PG8_BAR; PG8_MMA(0, 0, At, B0); PG8_MMA(0, 1, At, B1); PG8_BAR; PG8_SCHED;
            PG8_LDA(At, 1, 1); PG8_STAGE(PG8_SB(1, 0), b3, voffB); PG8_STAGE(PG8_SB(1, 1), b3 + hstepB, voffB); PG8_STAGE(PG8_SA(1, 0), a3, voffA);
            PG8_WAIT_V(8); PG8_WAIT_L(0); PG8_BAR; PG8_MMA(1, 0, At, B0); PG8_MMA(1, 1, At, B1); PG8_BAR; PG8_SCHED;
            } else {
            PG8_LDB(B0, 0, 0); PG8_SCHED; PG8_LDA(At, 0, 0); PG8_STAGE(PG8_SA(1, 1), a1 + hstepA, voffA);
            PG8_WAIT_L(8); PG8_BAR; PG8_WAIT_L(0); PG8_MMA(0, 0, At, B0); PG8_BAR; PG8_SCHED;
            PG8_LDB(B1, 0, 1); PG8_STAGE(PG8_SB(0, 0), b2, voffB);
            PG8_BAR; PG8_WAIT_L(0); PG8_MMA(0, 1, At, B1); PG8_BAR;
            PG8_LDA(At, 0, 1); PG8_STAGE(PG8_SA(0, 0), a2, voffA);
            PG8_BAR; PG8_WAIT_L(0); PG8_MMA(1, 0, At, B0); PG8_BAR; PG8_SCHED;
            PG8_STAGE(PG8_SB(0, 1), b2 + hstepB, voffB);
            PG8_WAIT_V(6); PG8_BAR; PG8_MMA(1, 1, At, B1); PG8_BAR;
            PG8_LDB(B0, 1, 0); PG8_SCHED; PG8_LDA(At, 1, 0); PG8_STAGE(PG8_SA(0, 1), a2 + hstepA, voffA);
            PG8_WAIT_L(8); PG8_BAR; PG8_WAIT_L(0); PG8_MMA(0, 0, At, B0); PG8_BAR; PG8_SCHED;
            PG8_LDB(B1, 1, 1); PG8_STAGE(PG8_SB(1, 0), b3, voffB);
            PG8_BAR; PG8_WAIT_L(0); PG8_MMA(0, 1, At, B1); PG8_BAR;
            PG8_LDA(At, 1, 1); PG8_STAGE(PG8_SA(1, 0), a3, voffA);
            PG8_BAR; PG8_WAIT_L(0); PG8_MMA(1, 0, At, B0); PG8_BAR; PG8_SCHED;
            PG8_STAGE(PG8_SB(1, 1), b3 + hstepB, voffB);
            PG8_WAIT_V(6); PG8_BAR; PG8_MMA(1, 1, At, B1); PG8_BAR;
            }
        }
        if constexpr (ALIGN_EPI) { if (wr == 0) PG8_BAR; }
        if constexpr (!Epi::AFTER_DRAIN) { E(acc, cur, wr, wc, fr, fq); S.done(cur); }
        if (!has_next) break;
#pragma unroll
        for (int a = 0; a < 2; ++a)
#pragma unroll
            for (int b = 0; b < 2; ++b)
#pragma unroll
                for (int m = 0; m < 4; ++m)
#pragma unroll
                    for (int n = 0; n < 2; ++n) acc[a][b][m][n] = (f32x4){0.f, 0.f, 0.f, 0.f};
        cur = nxt; cA = nA; cB = nB; ++ui;
        if constexpr (ALIGN_EPI) { if (wr == 1) PG8_BAR; }
    }
    PG8_WAIT_V(0);
    if constexpr (!ALIGN_EPI) { if (wr == 0) PG8_BAR; }
    PG8_BAR;
    if constexpr (Epi::AFTER_DRAIN) { E.fused(acc, cur, wr, wc, fr, fq, lds, wid, lane); S.done(cur); }
#undef PG8_SA
#undef PG8_SB
#undef PG8_STAGE
#undef PG8_LDA
#undef PG8_LDB
#undef PG8_MMA
#undef PG8_WAIT_V
#undef PG8_WAIT_L
#undef PG8_BAR
#undef PG8_SCHED
}
}

using pg8::Unit; using pg8::cvt_pk_bf16;
#define EPI_ARGS const f32x4 (&acc)[2][2][4][2], const Unit& u, int wr, int wc, int fr, int fq
__device__ __forceinline__ float row_rstd(const float* ssq, int row) {
    const f32x4* p = (const f32x4*)(ssq + (size_t)row * 16);
    const f32x4 a = p[0], b = p[1], c = p[2], d = p[3];
    const float s = ((a[0] + a[1]) + (a[2] + a[3])) + ((b[0] + b[1]) + (b[2] + b[3])) + ((c[0] + c[1]) + (c[2] + c[3])) + ((d[0] + d[1]) + (d[2] + d[3]));
    return 1.0f / sqrtf(s * (1.0f / D) + NORM_EPS);
}
struct EpiSwiglu {
    static constexpr bool PERM = false, AFTER_DRAIN = false;
    bf16* H; const float* ssq;
    __device__ __forceinline__ void operator()(EPI_ARGS) const {
#pragma unroll
        for (int ai = 0; ai < 2; ++ai)
#pragma unroll
            for (int m = 0; m < 4; ++m) {
                const int row = u.pm * 256 + ai * 128 + wr * 64 + m * 16 + fr; const float rs = row_rstd(ssq, row);
#pragma unroll
                for (int bj = 0; bj < 2; ++bj) {
                    const f32x4 g = acc[ai][bj][m][0] * rs, up = acc[ai][bj][m][1] * rs; float v[4];
#pragma unroll
                    for (int j = 0; j < 4; ++j) v[j] = siluf_(g[j]) * up[j];
                    u32x2 w; w.x = cvt_pk_bf16(v[0], v[1]); w.y = cvt_pk_bf16(v[2], v[3]);
                    *(u32x2*)(H + (size_t)row * FF + u.pn * 128 + bj * 64 + wc * 16 + fq * 4) = w;
                }
            }
    }
};
struct EpiResid {
    static constexpr bool PERM = false, AFTER_DRAIN = false;
    float* X; bf16* XB; float* ssq; float alpha;
    __device__ __forceinline__ void operator()(EPI_ARGS) const {
#pragma unroll
        for (int ai = 0; ai < 2; ++ai)
#pragma unroll
            for (int m = 0; m < 4; ++m) {
                const int row = u.pm * 256 + ai * 128 + wr * 64 + m * 16 + fr; float s = 0.f;
#pragma unroll
                for (int bj = 0; bj < 2; ++bj)
#pragma unroll
                    for (int n = 0; n < 2; ++n) {
                        const size_t off = (size_t)row * D + u.pn * 256 + bj * 128 + wc * 32 + n * 16 + fq * 4;
                        const f32x4 xn = *(const f32x4*)(X + off) + acc[ai][bj][m][n] * alpha;
                        *(f32x4*)(X + off) = xn;
                        u32x2 w; w.x = cvt_pk_bf16(xn[0], xn[1]); w.y = cvt_pk_bf16(xn[2], xn[3]);
                        *(u32x2*)(XB + off) = w;
                        s += (xn[0] * xn[0] + xn[1] * xn[1]) + (xn[2] * xn[2] + xn[3] * xn[3]);
                    }
                s += __shfl_xor(s, 16); s += __shfl_xor(s, 32);
                if (fq == 0) ssq[(size_t)row * 16 + u.pn * 4 + wc] = s;
            }
    }
};
struct EpiBf16 {
    static constexpr bool PERM = true, AFTER_DRAIN = false;
    bf16* O; int ldc; const float* ssq; float scale; int ncols;
    __device__ __forceinline__ void operator()(EPI_ARGS) const {
#pragma unroll
        for (int ai = 0; ai < 2; ++ai)
#pragma unroll
            for (int m = 0; m < 4; ++m) {
                const int row = u.pm * 256 + ai * 128 + wr * 64 + m * 16 + fr; const float rs = (ssq ? row_rstd(ssq, row) : 1.0f) * scale;
#pragma unroll
                for (int bj = 0; bj < 2; ++bj) {
                    const int col = u.pn * 256 + bj * 128 + wc * 32 + fq * 8;
                    if (col < ncols) {
                        const f32x4 v0 = acc[ai][bj][m][0] * rs, v1 = acc[ai][bj][m][1] * rs; u32x4 w;
                        w.x = cvt_pk_bf16(v0[0], v0[1]); w.y = cvt_pk_bf16(v0[2], v0[3]); w.z = cvt_pk_bf16(v1[0], v1[1]); w.w = cvt_pk_bf16(v1[2], v1[3]);
                        *(u32x4*)(O + (size_t)row * ldc + col) = w;
                    }
                }
            }
    }
};
struct EpiKV {
    static constexpr bool PERM = true, AFTER_DRAIN = false;
    bf16* Kd; bf16* VT; const float* rstd;
    __device__ __forceinline__ void operator()(EPI_ARGS) const {
#pragma unroll
        for (int ai = 0; ai < 2; ++ai)
#pragma unroll
            for (int m = 0; m < 4; ++m) {
                const int row = u.pm * 256 + ai * 128 + wr * 64 + m * 16 + fr; const float rs = rstd[row];
#pragma unroll
                for (int bj = 0; bj < 2; ++bj) {
                    const int col = u.pn * 256 + bj * 128 + wc * 32 + fq * 8;
                    const f32x4 v0 = acc[ai][bj][m][0] * rs, v1 = acc[ai][bj][m][1] * rs;
                    if (col < D) {
                        u32x4 w; w.x = cvt_pk_bf16(v0[0], v0[1]); w.y = cvt_pk_bf16(v0[2], v0[3]); w.z = cvt_pk_bf16(v1[0], v1[1]); w.w = cvt_pk_bf16(v1[2], v1[3]);
                        *(u32x4*)(Kd + (size_t)row * D + col) = w;
                    } else {
#pragma unroll
                        for (int j = 0; j < 4; ++j) { VT[(size_t)(col - D + j) * MMEM + row] = (bf16)f2bf(v0[j]); VT[(size_t)(col - D + 4 + j) * MMEM + row] = (bf16)f2bf(v1[j]); }
                    }
                }
            }
    }
};
template <int MODE> struct EpiGate {
    static constexpr bool PERM = true, AFTER_DRAIN = false;
    bf16* GT; const float* ssq; const float* bias;
    __device__ __forceinline__ void operator()(EPI_ARGS) const {
#pragma unroll
        for (int ai = 0; ai < 2; ++ai)
#pragma unroll
            for (int m = 0; m < 4; ++m) {
                const int row = u.pm * 256 + ai * 128 + wr * 64 + m * 16 + fr; const float rs = (MODE == 1) ? 1.0f : row_rstd(ssq, row);
#pragma unroll
                for (int bj = 0; bj < 2; ++bj) {
                    const int col = u.pn * 256 + bj * 128 + wc * 32 + fq * 8; float v[8];
#pragma unroll
                    for (int n = 0; n < 2; ++n) {
                        f32x4 b = (f32x4){0.f, 0.f, 0.f, 0.f}; if (MODE != 1) b = *(const f32x4*)(bias + col + 4 * n);
#pragma unroll
                        for (int j = 0; j < 4; ++j) v[4 * n + j] = sigmoidf_(acc[ai][bj][m][n][j] * rs + b[j]);
                    }
                    u32x4* p = (u32x4*)(GT + (size_t)row * D + col);
                    if (MODE == 2) { const u32x4 o = *p; v[0] *= bflo(o.x); v[1] *= bfhi(o.x); v[2] *= bflo(o.y); v[3] *= bfhi(o.y); v[4] *= bflo(o.z); v[5] *= bfhi(o.z); v[6] *= bflo(o.w); v[7] *= bfhi(o.w); }
                    u32x4 w; w.x = cvt_pk_bf16(v[0], v[1]); w.y = cvt_pk_bf16(v[2], v[3]); w.z = cvt_pk_bf16(v[4], v[5]); w.w = cvt_pk_bf16(v[6], v[7]);
                    *p = w;
                }
            }
    }
};
template <int MODE> struct EpiMerge {
    static constexpr bool PERM = true, AFTER_DRAIN = false;
    bf16* GT; float* MF;
    __device__ __forceinline__ void operator()(EPI_ARGS) const {
#pragma unroll
        for (int ai = 0; ai < 2; ++ai)
#pragma unroll
            for (int m = 0; m < 4; ++m) {
                const int row = u.pm * 256 + ai * 128 + wr * 64 + m * 16 + fr;
#pragma unroll
                for (int bj = 0; bj < 2; ++bj) {
                    const size_t off = (size_t)row * D + u.pn * 256 + bj * 128 + wc * 32 + fq * 8;
                    const u32x4 g = *(const u32x4*)(GT + off);
                    f32x4 v0 = acc[ai][bj][m][0], v1 = acc[ai][bj][m][1];
                    v0[0] *= bflo(g.x); v0[1] *= bfhi(g.x); v0[2] *= bflo(g.y); v0[3] *= bfhi(g.y); v1[0] *= bflo(g.z); v1[1] *= bfhi(g.z); v1[2] *= bflo(g.w); v1[3] *= bfhi(g.w);
                    if (MODE != 0) { v0 += *(const f32x4*)(MF + off); v1 += *(const f32x4*)(MF + off + 4); }
                    if (MODE != 2) { *(f32x4*)(MF + off) = v0; *(f32x4*)(MF + off + 4) = v1; }
                    else { u32x4 w; w.x = cvt_pk_bf16(v0[0], v0[1]); w.y = cvt_pk_bf16(v0[2], v0[3]); w.z = cvt_pk_bf16(v1[0], v1[1]); w.w = cvt_pk_bf16(v1[2], v1[3]); *(u32x4*)(GT + off) = w; }
                }
            }
    }
};
struct EpiSoftmaxP {
    static constexpr bool PERM = true, AFTER_DRAIN = true;
    bf16* P;
    __device__ __forceinline__ void fused(f32x4 (&acc)[2][2][4][2], const Unit& u, int wr, int wc, int fr, int fq, PG8_LAS unsigned char* lds, int wid, int lane) const {
        PG8_LAS float* RM = (PG8_LAS float*)lds;
        PG8_LAS float* RS = (PG8_LAS float*)(lds + 4096);
#pragma unroll
        for (int ai = 0; ai < 2; ++ai)
#pragma unroll
            for (int m = 0; m < 4; ++m) {
                float mx = -3.0e38f;
#pragma unroll
                for (int bj = 0; bj < 2; ++bj)
#pragma unroll
                    for (int n = 0; n < 2; ++n) { const f32x4 x = acc[ai][bj][m][n]; mx = fmaxf(mx, fmaxf(fmaxf(x[0], x[1]), fmaxf(x[2], x[3]))); }
                mx = fmaxf(mx, __shfl_xor(mx, 16)); mx = fmaxf(mx, __shfl_xor(mx, 32));
                if (fq == 0) RM[(ai * 128 + wr * 64 + m * 16 + fr) * 4 + wc] = mx;
            }
        asm volatile("s_waitcnt lgkmcnt(0)" ::: "memory"); __builtin_amdgcn_s_barrier(); asm volatile("" ::: "memory");
#pragma unroll
        for (int ai = 0; ai < 2; ++ai)
#pragma unroll
            for (int m = 0; m < 4; ++m) {
                const int rl = ai * 128 + wr * 64 + m * 16 + fr;
                const float mx = fmaxf(fmaxf(RM[rl * 4 + 0], RM[rl * 4 + 1]), fmaxf(RM[rl * 4 + 2], RM[rl * 4 + 3])); float s = 0.f;
#pragma unroll
                for (int bj = 0; bj < 2; ++bj)
#pragma unroll
                    for (int n = 0; n < 2; ++n)
#pragma unroll
                        for (int j = 0; j < 4; ++j) { const float p = exp2f(acc[ai][bj][m][n][j] - mx); acc[ai][bj][m][n][j] = p; s += p; }
                s += __shfl_xor(s, 16); s += __shfl_xor(s, 32);
                if (fq == 0) RS[rl * 4 + wc] = s;
            }
        asm volatile("s_waitcnt lgkmcnt(0)" ::: "memory"); __builtin_amdgcn_s_barrier(); asm volatile("" ::: "memory");
#pragma unroll
        for (int ai = 0; ai < 2; ++ai)
#pragma unroll
            for (int m = 0; m < 4; ++m) {
                const int rl = ai * 128 + wr * 64 + m * 16 + fr;
                const float inv = 1.0f / ((RS[rl * 4 + 0] + RS[rl * 4 + 1]) + (RS[rl * 4 + 2] + RS[rl * 4 + 3]));
#pragma unroll
                for (int bj = 0; bj < 2; ++bj) {
                    const f32x4 v0 = acc[ai][bj][m][0] * inv, v1 = acc[ai][bj][m][1] * inv; u32x4 w;
                    w.x = cvt_pk_bf16(v0[0], v0[1]); w.y = cvt_pk_bf16(v0[2], v0[3]); w.z = cvt_pk_bf16(v1[0], v1[1]); w.w = cvt_pk_bf16(v1[2], v1[3]);
                    *(u32x4*)(P + (size_t)rl * 256 + bj * 128 + wc * 32 + fq * 8) = w;
                }
            }
        asm volatile("s_waitcnt lgkmcnt(0)" ::: "memory"); __builtin_amdgcn_s_barrier(); asm volatile("" ::: "memory");
    }
};
struct SrcPlain { const float* W; int ld; int ncols; __device__ __forceinline__ const float* operator()(int n, int& l) const { l = ld; return n < ncols ? W + n : nullptr; } };
struct SrcGU {
    const float* WG; long dUp;
    __device__ __forceinline__ const float* operator()(int n, int& l) const { l = FF; const int t = n >> 8, cl = n & 255, h = t * 128 + ((cl >> 5) << 4) + (cl & 15); return WG + (h + ((cl & 16) ? dUp : 0l)); }
};
struct SrcKV { const float* WK; long dV; __device__ __forceinline__ const float* operator()(int n, int& l) const { l = D; return WK + (n < D ? (long)n : dV + (long)(n - D)); } };
template <class Src> __device__ __forceinline__ void conv_job(const Src src, const float* gain, int K, int NR, bf16* dst, LAS float* scr, int gw, int NGW, int lane) {
    const int nblk = NR / 32, nitems = (K / 64) * nblk;
    for (int it = gw; it < nitems; it += NGW) {
        const int kb = it / nblk, nb = it % nblk, k0 = 64 * kb, n0 = 32 * nb;
        int ld; const float* p = src(n0 + (lane & 31), ld);
#pragma unroll 8
        for (int i = 0; i < 32; ++i) { const int kk = 2 * i + (lane >> 5); float v = 0.f; if (p) { v = p[(size_t)(k0 + kk) * ld]; if (gain) v *= gain[k0 + kk]; } scr[kk * 33 + (lane & 31)] = v; }
        LDS_WAIT(); asm volatile("" ::: "memory");
        const int c = lane & 7;
#pragma unroll
        for (int j = 0; j < 4; ++j) { const int n = (lane >> 3) + 8 * j; const LAS float* s = scr + (8 * c) * 33 + n;
            u32x4 o; o.x = pk2(s[0 * 33], s[1 * 33]); o.y = pk2(s[2 * 33], s[3 * 33]); o.z = pk2(s[4 * 33], s[5 * 33]); o.w = pk2(s[6 * 33], s[7 * 33]);
            *(u32x4*)(dst + (size_t)(n0 + n) * K + k0 + 8 * c) = o; }
        LDS_WAIT(); asm volatile("" ::: "memory");
    }
}

struct Args { const float* in[N_INPUTS]; float* out; unsigned char* ws; };
typedef const float* cfptr;
typedef __attribute__((address_space(4))) const cfptr* kin_t;
struct Ctx {
    LAS unsigned char* lds; int tid, lane, wave, G, bid;
    kin_t in; float* X; unsigned char* ws;
    __device__ __forceinline__ const float* inp(int i, int l, size_t per_layer) const { return in[i] + (size_t)l * per_layer; }
};
__device__ __forceinline__ Ctx make_ctx() {
    extern __shared__ __attribute__((aligned(16))) unsigned char lds_raw[];
    Ctx C; int t = threadIdx.x; asm volatile("" : "+v"(t));
    kin_t k = (kin_t)__builtin_amdgcn_kernarg_segment_ptr(); asm volatile("" : "+s"(k));
    C.lds = (LAS unsigned char*)lds_raw; C.tid = t; C.lane = t & 63; C.wave = __builtin_amdgcn_readfirstlane(t >> 6);
    C.G = gridDim.x; C.bid = blockIdx.x; C.in = k;
    C.X = (float*)k[N_INPUTS]; C.ws = (unsigned char*)k[N_INPUTS + 1];
    return C;
}
enum ConvJob { CJ_GU1, CJ_D1, CJ_WIN, CJ_GATES, CJ_PROJ, CJ_XW, CJ_GU2, CJ_D2, CJ_XKV };
__device__ __forceinline__ void run_conv(const Ctx& C, int job, int l, int gw, int NGW) {
    LAS float* scr = (LAS float*)(C.lds + C.wave * 16384);
    unsigned char* ws = C.ws;
    switch (job) {
    case CJ_GU1: conv_job(SrcGU{C.inp(I_FFN1_WG, l, (size_t)D * FF), (long)(C.inp(I_FFN1_WU, l, (size_t)D * FF) - C.inp(I_FFN1_WG, l, (size_t)D * FF))}, C.inp(I_FFN1_NORM, l, D), D, 2 * FF, (bf16*)(ws + WS_SLOTA), scr, gw, NGW, C.lane); break;
    case CJ_GU2: conv_job(SrcGU{C.inp(I_FFN2_WG, l, (size_t)D * FF), (long)(C.inp(I_FFN2_WU, l, (size_t)D * FF) - C.inp(I_FFN2_WG, l, (size_t)D * FF))}, C.inp(I_FFN2_NORM, l, D), D, 2 * FF, (bf16*)(ws + WS_SLOTA), scr, gw, NGW, C.lane); break;
    case CJ_D1: conv_job(SrcPlain{C.inp(I_FFN1_WD, l, (size_t)D * FF), D, D}, nullptr, FF, D, (bf16*)(ws + WS_SLOTC), scr, gw, NGW, C.lane); break;
    case CJ_D2: conv_job(SrcPlain{C.inp(I_FFN2_WD, l, (size_t)D * FF), D, D}, nullptr, FF, D, (bf16*)(ws + WS_SLOTC), scr, gw, NGW, C.lane); break;
    case CJ_WIN: conv_job(SrcPlain{C.inp(I_W_IN, l, (size_t)D * NIN), NIN, NZ}, C.inp(I_MIX_NORM, l, D), D, NINP, (bf16*)(ws + WS_SLOTB), scr, gw, NGW, C.lane); break;
    case CJ_GATES: conv_job(SrcPlain{C.inp(I_W_IN, l, (size_t)D * NIN) + ZG, NIN, 4 * D}, C.inp(I_MIX_NORM, l, D), D, 4 * D, (bf16*)(ws + WS_SLOTA), scr, gw, NGW, C.lane); break;
    case CJ_PROJ: {
        const int idx[5] = {I_ML_PROJ, I_S5_W1, I_S5_W2, I_GLA_PROJ, I_RW_PROJ};
#pragma unroll
        for (int q = 0; q < 5; ++q) conv_job(SrcPlain{C.inp(idx[q], l, (size_t)WB * D), D, D}, nullptr, WB, D, (bf16*)(ws + WS_SLOTC + (size_t)q * MiB), scr, gw, NGW, C.lane);
    } break;
    case CJ_XW:
        conv_job(SrcPlain{C.inp(I_W_OUT, l, (size_t)D * D), D, D}, nullptr, D, D, (bf16*)(ws + WS_SLOTB), scr, gw, NGW, C.lane);
        conv_job(SrcPlain{C.inp(I_XA_WQ, l, (size_t)D * D), D, D}, C.inp(I_XA_NORM, l, D), D, D, (bf16*)(ws + WS_SLOTB + 2 * MiB), scr, gw, NGW, C.lane);
        conv_job(SrcPlain{C.inp(I_XA_WO, l, (size_t)D * D), D, D}, nullptr, D, D, (bf16*)(ws + WS_SLOTB + 4 * MiB), scr, gw, NGW, C.lane);
        break;
    case CJ_XKV: conv_job(SrcKV{C.inp(I_XA_WK, l, (size_t)D * D), (long)(C.inp(I_XA_WV, l, (size_t)D * D) - C.inp(I_XA_WK, l, (size_t)D * D))}, C.inp(I_MEM_NORM, l, D), D, 2 * D, (bf16*)(ws + WS_S + (size_t)l * 4 * MiB), scr, gw, NGW, C.lane); break;
    }
}

__device__ __forceinline__ void pro_rows(const Ctx& C) {
    const int gw = C.bid * 8 + C.wave, NGW = C.G * 8;
    const float* x = C.in[I_X]; bf16* XB = (bf16*)(C.ws + WS_XB); float* ssq = (float*)(C.ws + WS_SSQ);
    for (int m = gw; m < M; m += NGW) {
        const f32x4* xr = (const f32x4*)(x + (size_t)m * D) + C.lane; f32x4* orow = (f32x4*)(C.X + (size_t)m * D) + C.lane; u32x2* br = (u32x2*)(XB + (size_t)m * D) + C.lane;
        float s = 0.f;
#pragma unroll
        for (int j = 0; j < 4; ++j) { const f32x4 v = xr[64 * j]; orow[64 * j] = v; u32x2 w; w.x = pk2(v[0], v[1]); w.y = pk2(v[2], v[3]); br[64 * j] = w; s += (v[0] * v[0] + v[1] * v[1]) + (v[2] * v[2] + v[3] * v[3]); }
        s = wave_sum(s);
        if (C.lane < 16) ssq[(size_t)m * 16 + C.lane] = (C.lane == 0) ? s : 0.f;
    }
    const float* mem = C.in[I_MEM]; bf16* MB = (bf16*)(C.ws + WS_MEMB); float* memr = (float*)(C.ws + WS_MEMR);
    for (int m = gw; m < MMEM; m += NGW) {
        const f32x4* xr = (const f32x4*)(mem + (size_t)m * D) + C.lane; u32x2* br = (u32x2*)(MB + (size_t)m * D) + C.lane; float s = 0.f;
#pragma unroll
        for (int j = 0; j < 4; ++j) { const f32x4 v = xr[64 * j]; u32x2 w; w.x = pk2(v[0], v[1]); w.y = pk2(v[2], v[3]); br[64 * j] = w; s += (v[0] * v[0] + v[1] * v[1]) + (v[2] * v[2] + v[3] * v[3]); }
        s = wave_sum(s);
        if (C.lane == 0) memr[m] = 1.0f / sqrtf(s * (1.0f / D) + NORM_EPS);
    }
}
__device__ __forceinline__ void final_rows(const Ctx& C) {
    const int gw = C.bid * 8 + C.wave, NGW = C.G * 8; const float* ssq = (const float*)(C.ws + WS_SSQ); const float* g = C.in[I_FINAL_NORM];
    for (int m = gw; m < M; m += NGW) {
        const float rs = row_rstd(ssq, m); f32x4* orow = (f32x4*)(C.X + (size_t)m * D) + C.lane; const f32x4* gr = (const f32x4*)g + C.lane;
#pragma unroll
        for (int j = 0; j < 4; ++j) orow[64 * j] = orow[64 * j] * rs * gr[64 * j];
    }
}
constexpr int CH = 16;
__device__ __forceinline__ float ldz(const bf16* Z, int row, int col) { return bf2f(Z[(size_t)row * ZP + col]); }

__device__ __forceinline__ void mlstm_naive(const Ctx& C, int l, int b, int h) {
    bf16* Z = (bf16*)(C.ws + WS_Z);
    LAS float* Us = (LAS float*)C.lds;
    LAS float* UC = Us + 19 * 128;
    LAS float* Qs = UC + 16 * 128;
    LAS float* Ks = Qs + 16 * 128;
    LAS float* Vs = Ks + 16 * 128;
    LAS float* NUM = Vs + 16 * 128;
    LAS float* DEN = NUM + 4 * 16 * 128;
    LAS float* GI = DEN + 64;
    LAS float* GF = GI + 16;
    const int tid = C.tid, v = tid & 127, eq = tid >> 7;
    const float* conv = C.inp(I_ML_CONV, l, 4 * WB) + h * 128;
    const float* wq = C.inp(I_ML_WQ, l, 4 * 128 * 128) + (size_t)h * 128 * 128;
    const float* wk = C.inp(I_ML_WK, l, 4 * 128 * 128) + (size_t)h * 128 * 128;
    const float* wv = C.inp(I_ML_WV, l, 4 * 128 * 128) + (size_t)h * 128 * 128;
    const float bi = C.inp(I_ML_BI, l, 4)[h], bff = C.inp(I_ML_BF, l, 4)[h];
    const float ng = C.inp(I_ML_NORM, l, WB)[h * 128 + v];
    float Cst[32]; float nst = 0.f;
#pragma unroll
    for (int e = 0; e < 32; ++e) Cst[e] = 0.f;
    for (int c = 0; c < SEQ / CH; ++c) {
        const int t0 = c * CH, rowb = b * SEQ + t0;
        for (int i = tid; i < 19 * 128; i += 512) { const int r = i >> 7, cc = i & 127, t = t0 - 3 + r; Us[i] = (t >= 0) ? ldz(Z, b * SEQ + t, ZA_U + h * 128 + cc) : 0.f; }
        if (tid < CH) { GI[tid] = __expf(ldz(Z, rowb + tid, ZA_I + h) + bi); GF[tid] = sigmoidf_(ldz(Z, rowb + tid, ZA_F + h) + bff); }
        __syncthreads();
        for (int i = tid; i < CH * 128; i += 512) { const int t = i >> 7, cc = i & 127; float s = 0.f;
#pragma unroll
            for (int j = 0; j < 4; ++j) s += conv[j * WB + cc] * Us[(t + j) * 128 + cc];
            UC[i] = siluf_(s); }
        __syncthreads();
        {
            float aq[4] = {0.f, 0.f, 0.f, 0.f}, ak[4] = {0.f, 0.f, 0.f, 0.f}, av[4] = {0.f, 0.f, 0.f, 0.f};
            for (int k = 0; k < 128; ++k) {
                const float wqv = wq[k * 128 + v], wkv = wk[k * 128 + v], wvv = wv[k * 128 + v];
#pragma unroll
                for (int i = 0; i < 4; ++i) { const float uc = UC[(4 * eq + i) * 128 + k], ur = Us[(4 * eq + i + 3) * 128 + k]; aq[i] += uc * wqv; ak[i] += uc * wkv; av[i] += ur * wvv; }
            }
#pragma unroll
            for (int i = 0; i < 4; ++i) { Qs[(4 * eq + i) * 128 + v] = aq[i]; Ks[(4 * eq + i) * 128 + v] = ak[i] * 0.08838834764831845f; Vs[(4 * eq + i) * 128 + v] = av[i]; }
        }
        __syncthreads();
        for (int t = 0; t < CH; ++t) {
            const float f = GF[t], ig = GI[t], vv = Vs[t * 128 + v] * ig; float part = 0.f;
#pragma unroll
            for (int e = 0; e < 32; ++e) { Cst[e] = f * Cst[e] + Ks[t * 128 + 32 * eq + e] * vv; part += Qs[t * 128 + 32 * eq + e] * Cst[e]; }
            NUM[(eq * CH + t) * 128 + v] = part;
            if (v < 32) {
                nst = f * nst + ig * Ks[t * 128 + 32 * eq + v]; float dp = Qs[t * 128 + 32 * eq + v] * nst;
#pragma unroll
                for (int o = 1; o < 32; o <<= 1) dp += __shfl_xor(dp, o);
                if (v == 0) DEN[eq * CH + t] = dp;
            }
        }
        __syncthreads();
#pragma unroll
        for (int i = 0; i < 4; ++i) { const int t = 4 * eq + i;
            const float num = (NUM[(0 * CH + t) * 128 + v] + NUM[(1 * CH + t) * 128 + v]) + (NUM[(2 * CH + t) * 128 + v] + NUM[(3 * CH + t) * 128 + v]);
            const float den = (DEN[t] + DEN[CH + t]) + (DEN[2 * CH + t] + DEN[3 * CH + t]);
            UC[t * 128 + v] = num / fmaxf(fabsf(den), 1.0f); }
        __syncthreads();
        {
            const int w = C.wave, lane = C.lane;
#pragma unroll
            for (int i = 0; i < 2; ++i) { const int t = 2 * w + i; const float h0 = UC[t * 128 + lane], h1 = UC[t * 128 + lane + 64];
                const float rs = 1.0f / sqrtf(wave_sum(h0 * h0 + h1 * h1) * (1.0f / 128) + NORM_EPS);
                bf16* zo = Z + (size_t)(rowb + t) * ZP + ZA_O + h * 128;
                const float g0 = C.inp(I_ML_NORM, l, WB)[h * 128 + lane], g1 = C.inp(I_ML_NORM, l, WB)[h * 128 + lane + 64];
                zo[lane] = (bf16)f2bf(h0 * rs * g0 * sigmoidf_(bf2f(zo[lane]))); zo[lane + 64] = (bf16)f2bf(h1 * rs * g1 * sigmoidf_(bf2f(zo[lane + 64]))); }
        }
        __syncthreads();
    }
    (void)ng;
}

__device__ __forceinline__ void gla_naive(const Ctx& C, int l, int b, int h) {
    bf16* Z = (bf16*)(C.ws + WS_Z);
    LAS float* Qs = (LAS float*)C.lds;
    LAS float* Ks = Qs + 16 * 64;
    LAS float* AL = Ks + 16 * 64;
    LAS float* Vs = AL + 16 * 64;
    LAS float* ALOW = Vs + 16 * 128;
    LAS float* OP = ALOW + 256;
    LAS float* Hs = OP + 4 * 16 * 128;
    const int tid = C.tid, v = tid & 127, kq = tid >> 7;
    const float* aup = C.inp(I_GLA_AUP, l, 16 * 256) + h * 64;
    const float* abias = C.inp(I_GLA_ABIAS, l, 256) + h * 64;
    float S[16];
#pragma unroll
    for (int e = 0; e < 16; ++e) S[e] = 0.f;
    for (int c = 0; c < SEQ / CH; ++c) {
        const int rowb = b * SEQ + c * CH;
        for (int i = tid; i < CH * 64; i += 512) { const int t = i >> 6, cc = i & 63; Qs[i] = ldz(Z, rowb + t, ZC_Q + h * 64 + cc) * 0.125f; Ks[i] = ldz(Z, rowb + t, ZC_K + h * 64 + cc); }
        for (int i = tid; i < CH * 128; i += 512) { const int t = i >> 7, cc = i & 127; Vs[i] = ldz(Z, rowb + t, ZC_V + h * 128 + cc); }
        if (tid < 256) ALOW[tid] = ldz(Z, rowb + (tid >> 4), ZC_A + (tid & 15));
        __syncthreads();
        for (int i = tid; i < CH * 64; i += 512) { const int t = i >> 6, k = i & 63; float s = abias[k];
#pragma unroll
            for (int r = 0; r < 16; ++r) s += ALOW[t * 16 + r] * aup[r * 256 + k];
            AL[i] = __expf(logsigmoidf_(s) * (1.0f / 16.0f)); }
        __syncthreads();
        for (int t = 0; t < CH; ++t) {
            const float vv = Vs[t * 128 + v]; float part = 0.f;
#pragma unroll
            for (int e = 0; e < 16; ++e) { const int k = 16 * kq + e; S[e] = AL[t * 64 + k] * S[e] + Ks[t * 64 + k] * vv; part += Qs[t * 64 + k] * S[e]; }
            OP[(kq * CH + t) * 128 + v] = part;
        }
        __syncthreads();
#pragma unroll
        for (int i = 0; i < 4; ++i) { const int t = 4 * kq + i; Hs[t * 128 + v] = (OP[(0 * CH + t) * 128 + v] + OP[(1 * CH + t) * 128 + v]) + (OP[(2 * CH + t) * 128 + v] + OP[(3 * CH + t) * 128 + v]); }
        __syncthreads();
        {
            const int w = C.wave, lane = C.lane;
#pragma unroll
            for (int i = 0; i < 2; ++i) { const int t = 2 * w + i; const float h0 = Hs[t * 128 + lane], h1 = Hs[t * 128 + lane + 64];
                const float rs = 1.0f / sqrtf(wave_sum(h0 * h0 + h1 * h1) * (1.0f / 128) + NORM_EPS);
                bf16* zo = Z + (size_t)(rowb + t) * ZP + ZC_G + h * 128;
                const float g0 = C.inp(I_GLA_NORM, l, WB)[h * 128 + lane], g1 = C.inp(I_GLA_NORM, l, WB)[h * 128 + lane + 64];
                zo[lane] = (bf16)f2bf(h0 * rs * g0 * siluf_(bf2f(zo[lane]))); zo[lane + 64] = (bf16)f2bf(h1 * rs * g1 * siluf_(bf2f(zo[lane + 64]))); }
        }
        __syncthreads();
    }
}

__device__ __forceinline__ void rwkv_naive(const Ctx& C, int l, int b, int h) {
    bf16* Z = (bf16*)(C.ws + WS_Z);
    LAS float* Rs = (LAS float*)C.lds;
    LAS float* Ks = Rs + 1024;
    LAS float* Vs = Ks + 1024;
    LAS float* XW = Vs + 1024;
    LAS float* XA = XW + 1024;
    LAS float* XG = XA + 1024;
    LAS float* GT = XG + 2048;
    LAS float* AV = GT + 1024;
    LAS float* BV = AV + 1024;
    LAS float* WD = BV + 1024;
    LAS float* AA = WD + 1024;
    LAS float* Y = AA + 1024;
    LAS float* RHO = Y + 1024;
    LAS float* PR = RHO + 16;
    const int tid = C.tid, lane = C.lane, w = C.wave, hc0 = h * 64;
    const float* mu = C.inp(I_RW_MU, l, 1792);
    const float* w0 = C.inp(I_RW_W0, l, WB) + hc0; const float* wup = C.inp(I_RW_WUP, l, 64 * WB) + hc0;
    const float* a0 = C.inp(I_RW_A0, l, WB) + hc0; const float* aup = C.inp(I_RW_AUP, l, 64 * WB) + hc0;
    const float* gup = C.inp(I_RW_GUP, l, 128 * WB) + hc0;
    const float* kkw = C.inp(I_RW_KK, l, WB) + hc0; const float* kaw = C.inp(I_RW_KA, l, WB) + hc0;
    const float* rkw = C.inp(I_RW_RK, l, WB) + hc0; const float* gnw = C.inp(I_RW_NORM, l, WB) + hc0;
    const int il = lane >> 3, jq = lane & 7, irow = 8 * w + il;
    float S[8];
#pragma unroll
    for (int e = 0; e < 8; ++e) S[e] = 0.f;
    for (int c = 0; c < SEQ / CH; ++c) {
        const int t0 = c * CH, rowb = b * SEQ + t0; const int par = c & 1;
        for (int i = tid; i < CH * 64; i += 512) { const int t = i >> 6, cc = i & 63; const int row = rowb + t;
            {   const int col = ZD_R + hc0 + cc; const float z = ldz(Z, row, col); float zp;
                if (t > 0) zp = ldz(Z, row - 1, col); else zp = (c > 0) ? PR[(par ^ 1) * 64 + cc] : 0.f;
                if (t == CH - 1) PR[par * 64 + cc] = z;
                Rs[i] = z + mu[hc0 + cc] * (zp - z); }
            {   const int col = ZD_K + hc0 + cc; const float z = ldz(Z, row, col), zp = (t0 + t > 0) ? ldz(Z, row - 1, col) : 0.f; Ks[i] = z + mu[512 + hc0 + cc] * (zp - z); }
            {   const int col = ZD_V + hc0 + cc; const float z = ldz(Z, row, col), zp = (t0 + t > 0) ? ldz(Z, row - 1, col) : 0.f; Vs[i] = z + mu[1024 + hc0 + cc] * (zp - z); }
            {   const int col = ZD_XW + cc; const float z = ldz(Z, row, col), zp = (t0 + t > 0) ? ldz(Z, row - 1, col) : 0.f; XW[i] = tanhf(z + mu[1536 + cc] * (zp - z)); }
            {   const int col = ZD_XA + cc; const float z = ldz(Z, row, col), zp = (t0 + t > 0) ? ldz(Z, row - 1, col) : 0.f; XA[i] = z + mu[1600 + cc] * (zp - z); }
        }
        for (int i = tid; i < CH * 128; i += 512) { const int t = i >> 7, cc = i & 127; const int row = rowb + t, col = ZD_XG + cc;
            const float z = ldz(Z, row, col), zp = (t0 + t > 0) ? ldz(Z, row - 1, col) : 0.f; XG[i] = sigmoidf_(z + mu[1664 + cc] * (zp - z)); }
        __syncthreads();
        {
            const int cc = tid & 63, tq = tid >> 6; float sw[2] = {w0[cc], w0[cc]}, sa[2] = {a0[cc], a0[cc]}, sg[2] = {0.f, 0.f};
            for (int j = 0; j < 64; ++j) { const float wu = wup[j * WB + cc], au = aup[j * WB + cc];
#pragma unroll
                for (int i = 0; i < 2; ++i) { sw[i] += XW[(2 * tq + i) * 64 + j] * wu; sa[i] += XA[(2 * tq + i) * 64 + j] * au; } }
            for (int j = 0; j < 128; ++j) { const float gu = gup[j * WB + cc];
#pragma unroll
                for (int i = 0; i < 2; ++i) sg[i] += XG[(2 * tq + i) * 128 + j] * gu; }
#pragma unroll
            for (int i = 0; i < 2; ++i) { const int t = 2 * tq + i;
                const float wlog = -softplusf_(-sw[i]) - 0.5f; WD[t * 64 + cc] = __expf(-__expf(wlog)); AA[t * 64 + cc] = sigmoidf_(sa[i]); GT[t * 64 + cc] = sg[i]; }
        }
        __syncthreads();
        {
#pragma unroll
            for (int i = 0; i < 2; ++i) { const int t = 2 * w + i; const float k = Ks[t * 64 + lane], a = AA[t * 64 + lane];
                const float kr = k * kkw[lane]; const float nrm = sqrtf(wave_sum(kr * kr)); const float kk = kr / fmaxf(nrm, 1e-12f);
                const float krep = k * (1.0f + (a - 1.0f) * kaw[lane]);
                const float rho = wave_sum(Rs[t * 64 + lane] * krep * rkw[lane]);
                AV[t * 64 + lane] = -kk; BV[t * 64 + lane] = kk * a; Ks[t * 64 + lane] = krep; if (lane == 0) RHO[t] = rho; }
        }
        __syncthreads();
        for (int t = 0; t < CH; ++t) {
            float sa = 0.f;
#pragma unroll
            for (int e = 0; e < 8; ++e) sa += S[e] * AV[t * 64 + 8 * jq + e];
            sa += __shfl_xor(sa, 1); sa += __shfl_xor(sa, 2); sa += __shfl_xor(sa, 4);
            const float vi = Vs[t * 64 + irow]; float yp = 0.f;
#pragma unroll
            for (int e = 0; e < 8; ++e) { const int j = 8 * jq + e; S[e] = S[e] * WD[t * 64 + j] + sa * BV[t * 64 + j] + vi * Ks[t * 64 + j]; yp += S[e] * Rs[t * 64 + j]; }
            yp += __shfl_xor(yp, 1); yp += __shfl_xor(yp, 2); yp += __shfl_xor(yp, 4);
            if (jq == 0) Y[t * 64 + irow] = yp;
        }
        __syncthreads();
        {
#pragma unroll
            for (int i = 0; i < 2; ++i) { const int t = 2 * w + i; const float y = Y[t * 64 + lane];
                const float mean = wave_sum(y) * (1.0f / 64); const float d = y - mean; const float var = wave_sum(d * d) * (1.0f / 64);
                const float yn = d * (1.0f / sqrtf(var + 64e-5f)) * gnw[lane];
                const float o = (yn + RHO[t] * Vs[t * 64 + lane]) * GT[t * 64 + lane];
                Z[(size_t)(rowb + t) * ZP + ZD_R + hc0 + lane] = (bf16)f2bf(o); }
        }
        __syncthreads();
    }
}

__device__ __forceinline__ float gelu_tanh(float y) { const float t = 0.7978845608028654f * (y + 0.044715f * y * y * y); return 0.5f * y * (1.0f + tanhf(t)); }
__device__ __forceinline__ void s5_naive(const Ctx& C, int l, int b, int g) {
    bf16* Z = (bf16*)(C.ws + WS_Z);
    LAS float* Uw = (LAS float*)(C.lds + C.wave * 16384);
    LAS float* ST = Uw + 256;
    const int p = C.lane, lane = C.lane;
    const float are = C.inp(I_S5_ARE, l, 32 * 64)[g * 64 + p], aim = C.inp(I_S5_AIM, l, 32 * 64)[g * 64 + p];
    const float step = expf(C.inp(I_S5_LOGSTEP, l, 32)[g]);
    const float lre = fminf(are, -1e-4f), lim = aim;
    const float mag = expf(lre * step), bre = mag * cosf(lim * step), bim = mag * sinf(lim * step);
    const float den = lre * lre + lim * lim;
    const float cre = ((bre - 1.0f) * lre + bim * lim) / den, cim = (bim * lre - (bre - 1.0f) * lim) / den;
    float bbr[16], bbi[16];
    {   const float* br = C.inp(I_S5_BRE, l, 32 * 64 * 16) + (size_t)(g * 64 + p) * 16; const float* bi = C.inp(I_S5_BIM, l, 32 * 64 * 16) + (size_t)(g * 64 + p) * 16;
#pragma unroll
        for (int c = 0; c < 16; ++c) { bbr[c] = cre * br[c] - cim * bi[c]; bbi[c] = cre * bi[c] + cim * br[c]; } }
    const float* cr = C.inp(I_S5_CRE, l, 32 * 16 * 64) + (size_t)g * 16 * 64; const float* ci = C.inp(I_S5_CIM, l, 32 * 16 * 64) + (size_t)g * 16 * 64;
    const float* dsk = C.inp(I_S5_D, l, WB) + g * 16;
    float sr = 0.f, si = 0.f;
    const int ty = lane >> 2, cq = lane & 3;
    for (int c = 0; c < SEQ / CH; ++c) {
        const int rowb = b * SEQ + c * CH;
#pragma unroll
        for (int i = 0; i < 4; ++i) { const int idx = lane + 64 * i; Uw[idx] = ldz(Z, rowb + (idx >> 4), ZB_U + g * 16 + (idx & 15)); }
        LDS_WAIT(); __builtin_amdgcn_wave_barrier();
        for (int t = 0; t < CH; ++t) {
            float ur = 0.f, ui = 0.f;
#pragma unroll
            for (int cc = 0; cc < 16; ++cc) { const float uu = Uw[t * 16 + cc]; ur += bbr[cc] * uu; ui += bbi[cc] * uu; }
            const float nr = bre * sr - bim * si + ur, ni = bre * si + bim * sr + ui; sr = nr; si = ni;
            ST[(t * 64 + p) * 2] = sr; ST[(t * 64 + p) * 2 + 1] = si;
        }
        LDS_WAIT(); __builtin_amdgcn_wave_barrier();
        float y[4] = {0.f, 0.f, 0.f, 0.f};
        for (int q = 0; q < 64; ++q) { const float s_r = ST[(ty * 64 + q) * 2], s_i = ST[(ty * 64 + q) * 2 + 1];
#pragma unroll
            for (int j = 0; j < 4; ++j) y[j] += cr[(4 * cq + j) * 64 + q] * s_r - ci[(4 * cq + j) * 64 + q] * s_i; }
        u32x2 o; float z[4];
#pragma unroll
        for (int j = 0; j < 4; ++j) z[j] = gelu_tanh(y[j] + dsk[4 * cq + j] * Uw[ty * 16 + 4 * cq + j]);
        o.x = pk2(z[0], z[1]); o.y = pk2(z[2], z[3]);
        *(u32x2*)(Z + (size_t)(rowb + ty) * ZP + ZB_U + g * 16 + 4 * cq) = o;
        LDS_WAIT(); __builtin_amdgcn_wave_barrier();
    }
}
template <class Epi, bool ALIGN> __device__ __forceinline__ void run_gemm(const Ctx& C, const bf16* A, int lda, const bf16* Bt, int ldb, int Mr, int N, int K, const Epi& E, int Gv = 0, int cv = 0) {
    if (Gv == 0) { Gv = C.G; cv = C.bid; }
    if (cv < 0 || cv >= Gv) return;
    pg8::Gemm g{A, Bt, Mr, N, K, lda, ldb}; pg8::StaticOrder S; S.init(Mr, N, Gv, cv);
    pg8::gemm_phase<Epi, pg8::StaticOrder, ALIGN, true>(C.lds, g, S, E);
}

#define GRID_BAR() do { const Ctx Cb = make_ctx(); XcdBarrier b_; b_.bar = (unsigned*)(Cb.ws + WS_CTL) + 4096; b_.x = xb_xcc_id(); b_.st = (volatile LAS unsigned*)(Cb.lds + MISC_OFF) + 8; xcd_barrier(b_); } while (0)
#define PHASE_CTX() const Ctx C = make_ctx(); unsigned char* const ws = C.ws; bf16* const XB = (bf16*)(ws + WS_XB); float* const SSQ = (float*)(ws + WS_SSQ); bf16* const Z = (bf16*)(ws + WS_Z); \
    const int gw = C.bid * 8 + C.wave, NGW = C.G * 8; (void)XB; (void)SSQ; (void)Z; (void)gw; (void)NGW
#ifndef STOP_AFTER
#define STOP_AFTER 1000
#endif
#define PH_ON(n) ((l) * 20 + (n) <= STOP_AFTER)
template <int l> __device__ __forceinline__ void layer_fwd() {
        if (PH_ON(1)) {   PHASE_CTX();
            if (l > 0) { run_conv(C, CJ_D1, l, gw, NGW); __syncthreads(); }
            { EpiSwiglu E{(bf16*)(ws + WS_HID), SSQ}; run_gemm<EpiSwiglu, true>(C, XB, D, (const bf16*)(ws + WS_SLOTA), D, M, 2 * FF, D, E); }
            if (l == 0) {
                for (int q = 0; q < DEPTH; ++q) { EpiKV E{(bf16*)(ws + WS_KV + (size_t)q * 4 * MiB), (bf16*)(ws + WS_KV + (size_t)q * 4 * MiB + 2 * MiB), (const float*)(ws + WS_MEMR)};
                    run_gemm<EpiKV, true>(C, (const bf16*)(ws + WS_MEMB), D, (const bf16*)(ws + WS_S + (size_t)q * 4 * MiB), D, MMEM, 2 * D, D, E, 32, C.bid - 128 - 32 * q); }
            }
        }
        GRID_BAR();
        if (PH_ON(2)) {   PHASE_CTX();
            run_conv(C, CJ_GATES, l, gw, NGW); __syncthreads();
            { EpiResid E{C.X, XB, SSQ, 0.5f}; run_gemm<EpiResid, false>(C, (const bf16*)(ws + WS_HID), FF, (const bf16*)(ws + WS_SLOTC), FF, M, D, FF, E); }
        }
        GRID_BAR();
        if (PH_ON(3)) {   PHASE_CTX();
            run_conv(C, CJ_PROJ, l, gw, NGW); __syncthreads();
            { EpiBf16 E{Z, ZP, SSQ, 1.0f, NZ}; run_gemm<EpiBf16, true>(C, XB, D, (const bf16*)(ws + WS_SLOTB), D, M, NINP, D, E); }
        }
        GRID_BAR();
        if (PH_ON(4)) {   PHASE_CTX();
            if (C.bid < 16) mlstm_naive(C, l, C.bid >> 2, C.bid & 3);
            else if (C.bid < 32) gla_naive(C, l, (C.bid - 16) >> 2, (C.bid - 16) & 3);
            else if (C.bid < 64) rwkv_naive(C, l, (C.bid - 32) >> 3, (C.bid - 32) & 7);
            else if (C.bid < 80) { const int id = (C.bid - 64) * 8 + C.wave; s5_naive(C, l, id >> 5, id & 31); }
            else run_conv(C, CJ_XW, l, (C.bid - 80) * 8 + C.wave, (C.G - 80) * 8);
        }
        GRID_BAR();
#define SUBSYNC() do { VM_WAIT(); __syncthreads(); } while (0)
#define MERGE_PTRS() bf16* const GT = (bf16*)(ws + WS_GT); float* const MF = (float*)(ws + WS_MF); const bf16* const WG = (const bf16*)(ws + WS_SLOTA); const bf16* const WP = (const bf16*)(ws + WS_SLOTC); \
    const float* const gb = C.inp(I_GATE_BIAS, l, 4 * D); (void)GT; (void)MF; (void)WG; (void)WP; (void)gb
        if (PH_ON(5)) { PHASE_CTX(); MERGE_PTRS(); EpiGate<0> E{GT, SSQ, gb}; run_gemm<EpiGate<0>, false>(C, XB, D, WG, D, M, D, D, E); } SUBSYNC();
        if (PH_ON(5)) { PHASE_CTX(); MERGE_PTRS(); EpiMerge<0> E{GT, MF}; run_gemm<EpiMerge<0>, false>(C, Z + ZA_O, ZP, WP, WB, M, D, WB, E); } SUBSYNC();
        if (PH_ON(5)) { PHASE_CTX(); MERGE_PTRS(); EpiGate<1> E{GT, SSQ, gb}; run_gemm<EpiGate<1>, false>(C, Z + ZB_U, ZP, WP + 2 * (size_t)D * WB, WB, M, D, WB, E); } SUBSYNC();
        if (PH_ON(5)) { PHASE_CTX(); MERGE_PTRS(); EpiGate<2> E{GT, SSQ, gb + D}; run_gemm<EpiGate<2>, false>(C, XB, D, WG + (size_t)D * D, D, M, D, D, E); } SUBSYNC();
        if (PH_ON(5)) { PHASE_CTX(); MERGE_PTRS(); EpiMerge<1> E{GT, MF}; run_gemm<EpiMerge<1>, false>(C, Z + ZB_U, ZP, WP + (size_t)D * WB, WB, M, D, WB, E); } SUBSYNC();
        if (PH_ON(5)) { PHASE_CTX(); MERGE_PTRS(); EpiGate<0> E{GT, SSQ, gb + 2 * D}; run_gemm<EpiGate<0>, false>(C, XB, D, WG + 2 * (size_t)D * D, D, M, D, D, E); } SUBSYNC();
        if (PH_ON(5)) { PHASE_CTX(); MERGE_PTRS(); EpiMerge<1> E{GT, MF}; run_gemm<EpiMerge<1>, false>(C, Z + ZC_G, ZP, WP + 3 * (size_t)D * WB, WB, M, D, WB, E); } SUBSYNC();
        if (PH_ON(5)) { PHASE_CTX(); MERGE_PTRS(); EpiGate<0> E{GT, SSQ, gb + 3 * D}; run_gemm<EpiGate<0>, false>(C, XB, D, WG + 3 * (size_t)D * D, D, M, D, D, E); } SUBSYNC();
        if (PH_ON(5)) { PHASE_CTX(); MERGE_PTRS(); EpiMerge<2> E{GT, MF}; run_gemm<EpiMerge<2>, false>(C, Z + ZD_R, ZP, WP + 4 * (size_t)D * WB, WB, M, D, WB, E); }
        GRID_BAR();
        if (PH_ON(6)) {   PHASE_CTX();
            run_conv(C, CJ_GU2, l, gw, NGW); run_conv(C, CJ_D2, l, gw, NGW); __syncthreads();
            { EpiResid E{C.X, XB, SSQ, 1.0f}; run_gemm<EpiResid, false>(C, (const bf16*)(ws + WS_GT), D, (const bf16*)(ws + WS_SLOTB), D, M, D, D, E); }
        }
        GRID_BAR();
        if (PH_ON(7)) {   PHASE_CTX();
            EpiBf16 E{(bf16*)(ws + WS_XQ), D, SSQ, 0.0625f * 1.4426950408889634f, D}; run_gemm<EpiBf16, false>(C, XB, D, (const bf16*)(ws + WS_SLOTB + 2 * MiB), D, M, D, D, E);
        }
        GRID_BAR();
        {
            const int un = blockIdx.x; const int pm = un >> 2, hh = un & 3, bb = pm >> 4;
            if (PH_ON(8)) {   PHASE_CTX();
                const bf16* Q = (const bf16*)(ws + WS_XQ) + (size_t)pm * 256 * D + hh * 256;
                const bf16* Kd = (const bf16*)(ws + WS_KV + (size_t)l * 4 * MiB) + (size_t)bb * 256 * D + hh * 256;
                bf16* P = (bf16*)(ws + WS_XP) + (size_t)C.bid * 65536;
                pg8::Gemm g{Q, Kd, 256, 256, 256, D, D}; pg8::SingleUnit S; EpiSoftmaxP E{P}; pg8::gemm_phase<EpiSoftmaxP, pg8::SingleUnit, false, true>(C.lds, g, S, E);
            }
            SUBSYNC();
            if (PH_ON(8)) {   PHASE_CTX();
                const bf16* VT = (const bf16*)(ws + WS_KV + (size_t)l * 4 * MiB + 2 * MiB) + (size_t)hh * 256 * MMEM + bb * 256;
                const bf16* P = (const bf16*)(ws + WS_XP) + (size_t)C.bid * 65536;
                pg8::Gemm g{P, VT, 256, 256, 256, 256, MMEM}; pg8::SingleUnit S; EpiBf16 E{(bf16*)(ws + WS_XO) + (size_t)pm * 256 * D + hh * 256, D, nullptr, 1.0f, 256};
                pg8::gemm_phase<EpiBf16, pg8::SingleUnit, false, true>(C.lds, g, S, E);
            }
            SUBSYNC();
        }
        GRID_BAR();
        if (PH_ON(9)) {   PHASE_CTX();
            EpiResid E{C.X, XB, SSQ, 1.0f}; run_gemm<EpiResid, false>(C, (const bf16*)(ws + WS_XO), D, (const bf16*)(ws + WS_SLOTB + 4 * MiB), D, M, D, D, E);
        }
        GRID_BAR();
        if (PH_ON(10)) {   PHASE_CTX();
            if (l + 1 < DEPTH) { run_conv(C, CJ_WIN, l + 1, gw, NGW); __syncthreads(); }
            { EpiSwiglu E{(bf16*)(ws + WS_HID), SSQ}; run_gemm<EpiSwiglu, true>(C, XB, D, (const bf16*)(ws + WS_SLOTA), D, M, 2 * FF, D, E); }
        }
        GRID_BAR();
        if (PH_ON(11)) {   PHASE_CTX();
            if (l + 1 < DEPTH) { run_conv(C, CJ_GU1, l + 1, gw, NGW); __syncthreads(); }
            { EpiResid E{C.X, XB, SSQ, 0.5f}; run_gemm<EpiResid, false>(C, (const bf16*)(ws + WS_HID), FF, (const bf16*)(ws + WS_SLOTC), FF, M, D, FF, E); }
        }
        GRID_BAR();
    }

__global__ void __launch_bounds__(512, 2) fwd_kernel(Args args) {
    extern __shared__ __attribute__((aligned(16))) unsigned char lds_raw[];
    (void)args;
    {
        const Ctx C = make_ctx();
        volatile LAS unsigned* MISC = (volatile LAS unsigned*)(C.lds + MISC_OFF);
        for (int u = C.tid; u < (LDS_BYTES - RING_BYTES) / 4; u += 512) ((LAS unsigned*)(C.lds + RING_BYTES))[u] = 0u;
        __syncthreads();
        (void)xcd_barrier_post((unsigned*)(C.ws + WS_CTL) + 4096, MISC + 8);
    }

    {   PHASE_CTX();
        pro_rows(C);
        run_conv(C, CJ_GU1, 0, gw, NGW); run_conv(C, CJ_D1, 0, gw, NGW); run_conv(C, CJ_WIN, 0, gw, NGW); run_conv(C, CJ_XKV, 0, gw, NGW); run_conv(C, CJ_XKV, 1, gw, NGW);
    }
    GRID_BAR();

    layer_fwd<0>();
    layer_fwd<1>();
    {   PHASE_CTX();
        final_rows(C);
        if (xb_ld((unsigned*)(ws + WS_CTL) + 4096 + XB_TMO) != 0u) {
            for (size_t i = (size_t)C.bid * 512 + C.tid; i < (size_t)M * D; i += (size_t)C.G * 512) C.X[i] = __builtin_nanf("");
        }
    }
}

extern "C" void kernel_launch(void* const* d_in, const int* in_sizes, int n_in, void* d_out, int out_size, void* d_ws, size_t ws_size, hipStream_t stream) {
    static int grid = 0;
    if (grid == 0) {
        if (n_in != N_INPUTS || out_size != M * D || ws_size < WS_END) { fprintf(stderr, "kernel_launch: unexpected shapes: n_in %d out %d ws %zu (need %zu)\n", n_in, out_size, ws_size, (size_t)WS_END); grid = -1; return; }
        int dev = 0, cus = 0, per_cu = 0;
        if (hipGetDevice(&dev) != hipSuccess || hipDeviceGetAttribute(&cus, hipDeviceAttributeMultiprocessorCount, dev) != hipSuccess) { grid = -1; return; }
        if (hipFuncSetAttribute((const void*)fwd_kernel, hipFuncAttributeMaxDynamicSharedMemorySize, LDS_BYTES) != hipSuccess) { fprintf(stderr, "kernel_launch: hipFuncSetAttribute failed\n"); grid = -1; return; }
        if (hipOccupancyMaxActiveBlocksPerMultiprocessor(&per_cu, (const void*)fwd_kernel, 512, LDS_BYTES) != hipSuccess || per_cu < 1) { fprintf(stderr, "kernel_launch: occupancy query says %d workgroups per CU\n", per_cu); (void)hipGetLastError(); grid = -1; return; }
        if (cus < 256) { fprintf(stderr, "kernel_launch: built for a 256-CU device (got %d)\n", cus); grid = -1; return; }
        grid = 256;
    }
    if (grid < 0) return;
    if (hipMemsetAsync((char*)d_ws + WS_CTL, 0, CTL_ZERO_BYTES, stream) != hipSuccess) return;
    Args a{};
    for (int i = 0; i < N_INPUTS; ++i) a.in[i] = (const float*)d_in[i];
    a.out = (float*)d_out; a.ws = (unsigned char*)d_ws;
    hipLaunchKernelGGL(fwd_kernel, dim3(grid), dim3(512), LDS_BYTES, stream, a);
}
```

```cpp
#include <hip/hip_runtime.h>
#include <cstdio>
#include <cstdint>

#define LAS __attribute__((address_space(3)))
#define GAS __attribute__((address_space(1)))
typedef unsigned short bf16;
typedef float f32x4 __attribute__((ext_vector_type(4)));
typedef float f32x2 __attribute__((ext_vector_type(2)));
typedef unsigned u32x4 __attribute__((ext_vector_type(4)));
typedef unsigned u32x2 __attribute__((ext_vector_type(2)));
typedef short bf16x8 __attribute__((ext_vector_type(8)));

constexpr int NB = 4, SEQ = 4096, M = NB * SEQ, D = 1024, FF = 2816, WB = 512, DEPTH = 2, MEML = 256, MMEM = NB * MEML;
constexpr int NZ = 4888, ZP = 4896, NINP = 5120, NIN = 8984;
constexpr int ZA_U = 0, ZA_O = 512, ZA_I = 1024, ZA_F = 1028, ZB_U = 1032, ZC_Q = 1544, ZC_K = 1800, ZC_V = 2056, ZC_G = 2568, ZC_A = 3080;
constexpr int ZD_R = 3096, ZD_K = 3608, ZD_V = 4120, ZD_XW = 4632, ZD_XA = 4696, ZD_XG = 4760, ZG = 4888;
constexpr float NORM_EPS = 1e-6f;

enum { I_X = 0, I_MEM, I_FFN1_NORM, I_FFN1_WG, I_FFN1_WU, I_FFN1_WD, I_MIX_NORM, I_W_IN, I_GATE_BIAS, I_ML_CONV, I_ML_WQ, I_ML_WK, I_ML_WV, I_ML_BI, I_ML_BF,
       I_ML_NORM, I_ML_PROJ, I_S5_ARE, I_S5_AIM, I_S5_LOGSTEP, I_S5_BRE, I_S5_BIM, I_S5_CRE, I_S5_CIM, I_S5_D, I_S5_W1, I_S5_W2, I_GLA_AUP, I_GLA_ABIAS,
       I_GLA_NORM, I_GLA_PROJ, I_RW_MU, I_RW_W0, I_RW_WUP, I_RW_A0, I_RW_AUP, I_RW_GUP, I_RW_KK, I_RW_KA, I_RW_RK, I_RW_NORM, I_RW_PROJ, I_W_OUT,
       I_XA_NORM, I_MEM_NORM, I_XA_WQ, I_XA_WK, I_XA_WV, I_XA_WO, I_FFN2_NORM, I_FFN2_WG, I_FFN2_WU, I_FFN2_WD, I_FINAL_NORM, N_INPUTS };

constexpr size_t MiB = 1u << 20;
constexpr size_t WS_CTL = 0, CTL_ZERO_BYTES = 64 * 1024;
constexpr size_t WS_SSQ = 1 * MiB;
constexpr size_t WS_MEMR = 256 * 1024;
constexpr size_t WS_XB = 2 * MiB;
constexpr size_t WS_MEMB = 34 * MiB;
constexpr size_t WS_KV = 36 * MiB;
constexpr size_t WS_SLOTA = 44 * MiB;
constexpr size_t WS_SLOTB = 55 * MiB;
constexpr size_t WS_SLOTC = 65 * MiB;
constexpr size_t WS_Z = 73 * MiB;
constexpr size_t Z_BYTES = (size_t)M * ZP * 2;
constexpr size_t WS_S = WS_Z + Z_BYTES;
constexpr size_t WS_END = 350110016;
static_assert(WS_S == 226 * MiB, "map");
constexpr size_t S_BYTES = WS_END - WS_S;
constexpr size_t WS_HID = WS_Z;
constexpr size_t WS_XQ = WS_Z, WS_XO = WS_Z + 32 * MiB, WS_XP = WS_Z + 64 * MiB;
constexpr size_t WS_GT = WS_S, WS_MF = WS_S + 32 * MiB;
static_assert(WS_MF + 64 * MiB <= WS_END, "merge stash");

constexpr int LDS_BYTES = 147456, RING_BYTES = 131072, MISC_OFF = RING_BYTES + 320;

#define RLX_AGENT __ATOMIC_RELAXED, __HIP_MEMORY_SCOPE_AGENT
#define LDS_WAIT() asm volatile("s_waitcnt lgkmcnt(0)" ::: "memory")
#define VM_WAIT() asm volatile("s_waitcnt vmcnt(0)" ::: "memory")
__device__ __forceinline__ unsigned f2bf(float f) { unsigned u = __builtin_bit_cast(unsigned, f); return (u + 0x7fffu + ((u >> 16) & 1u)) >> 16; }
__device__ __forceinline__ unsigned pk2(float lo, float hi) { return f2bf(lo) | (f2bf(hi) << 16); }
__device__ __forceinline__ float bf2f(unsigned h) { return __builtin_bit_cast(float, h << 16); }
__device__ __forceinline__ float bflo(unsigned w) { return __builtin_bit_cast(float, w << 16); }
__device__ __forceinline__ float bfhi(unsigned w) { return __builtin_bit_cast(float, w & 0xffff0000u); }
__device__ __forceinline__ float sigmoidf_(float x) { return 1.0f / (1.0f + __expf(-x)); }
__device__ __forceinline__ float siluf_(float x) { return x / (1.0f + __expf(-x)); }
__device__ __forceinline__ float softplusf_(float x) { return fmaxf(x, 0.f) + log1pf(__expf(-fabsf(x))); }
__device__ __forceinline__ float logsigmoidf_(float x) { return -softplusf_(-x); }
__device__ __forceinline__ float shx(float v, int mask, int lane) { return __builtin_bit_cast(float, __builtin_amdgcn_ds_bpermute((lane ^ mask) << 2, __builtin_bit_cast(int, v))); }
__device__ __forceinline__ float wave_sum(float v, int lane) {
#pragma unroll
    for (int o = 1; o < 64; o <<= 1) v += shx(v, o, lane);
    return v;
}

#define XB_TMO      128
#define XB_XCNT(j)  (256  + 64 * (j))
#define XB_XSUB(j)  (1280 + 64 * (j))
#define XB_XGEN(j)  (2304 + 64 * (j))
#define XB_TOP      3328
#define XB_TOPGEN   3392
#define XCD_BAR_WORDS 3456
#define XB_SPIN_CAP (1u << 20)
__device__ __forceinline__ unsigned xb_ld(unsigned* p)              { return __hip_atomic_load(p, __ATOMIC_RELAXED, __HIP_MEMORY_SCOPE_AGENT); }
__device__ __forceinline__ unsigned xb_add(unsigned* p, unsigned v) { return __hip_atomic_fetch_add(p, v, __ATOMIC_RELAXED, __HIP_MEMORY_SCOPE_AGENT); }
__device__ __forceinline__ unsigned xb_xcc_id() { return (unsigned)__builtin_amdgcn_s_getreg((3 << 11) | 20) & 0xFu; }
#define XB_SPIN(cond, bar) do { unsigned _sp = 0; while (cond) { __builtin_amdgcn_s_sleep(1); \
    if ((++_sp & 255u) == 0u) { if (xb_ld(&(bar)[XB_TMO])) break; if (_sp > XB_SPIN_CAP) { atomicAdd(&(bar)[XB_TMO], 1u); break; } } } } while (0)
struct XcdBarrier { unsigned* bar; unsigned x; volatile LAS unsigned* st; };
__device__ __forceinline__ XcdBarrier xcd_barrier_post(unsigned* bar, volatile LAS unsigned* st) {
    XcdBarrier b; b.bar = bar; b.x = xb_xcc_id(); b.st = st;
    if (threadIdx.x == 0) (void)xb_add(&bar[XB_XCNT(b.x)], 1u);
    return b;
}
__device__ __forceinline__ void xcd_barrier_complete(unsigned* bar, unsigned x, unsigned& nloc, unsigned& nx) {
    const unsigned G = gridDim.x * gridDim.y * gridDim.z;
    unsigned sum, cnt, mine, sp = 0u;
    for (;;) {
        sum = 0u; cnt = 0u; mine = 0u;
#pragma unroll
        for (unsigned j = 0; j < 16; ++j) { const unsigned c = xb_ld(&bar[XB_XCNT(j)]); sum += c; cnt += (c > 0u) ? 1u : 0u; mine = (j == x) ? c : mine; }
        if (sum == G) break;
        __builtin_amdgcn_s_sleep(1);
        if ((++sp & 255u) == 0u) { if (xb_ld(&bar[XB_TMO])) break; if (sp > XB_SPIN_CAP) { atomicAdd(&bar[XB_TMO], 1u); break; } }
    }
    nloc = mine > 0u ? mine : 1u; nx = cnt > 0u ? cnt : 1u;
}
__device__ __forceinline__ void xcd_barrier(const XcdBarrier& b) {
    asm volatile("s_waitcnt vmcnt(0)" ::: "memory");
    __syncthreads();
    if (threadIdx.x == 0) {
        unsigned* bar = b.bar;
        __builtin_amdgcn_s_waitcnt(0);
        unsigned nloc = b.st[0], nx = b.st[1];
        if (nloc == 0u) { xcd_barrier_complete(bar, b.x, nloc, nx); b.st[0] = nloc; b.st[1] = nx; }
        const unsigned old = xb_add(&bar[XB_XSUB(b.x)], 1u);
        const unsigned gen = old / nloc;
        if (old + 1u == (gen + 1u) * nloc) {
            __builtin_amdgcn_fence(__ATOMIC_RELEASE, "agent");
            asm volatile("s_waitcnt vmcnt(0)" ::: "memory");
            const unsigned og = xb_add(&bar[XB_TOP], 1u);
            const unsigned tg = og / nx;
            if (og + 1u == (tg + 1u) * nx) xb_add(&bar[XB_TOPGEN], 1u);
            else XB_SPIN(xb_ld(&bar[XB_TOPGEN]) == tg, bar);
            __builtin_amdgcn_fence(__ATOMIC_ACQUIRE, "agent");
            xb_add(&bar[XB_XGEN(b.x)], 1u);
            asm volatile("s_waitcnt vmcnt(0)" ::: "memory");
        } else {
            XB_SPIN(xb_ld(&bar[XB_XGEN(b.x)]) == gen, bar);
            __builtin_amdgcn_fence(__ATOMIC_ACQUIRE, "agent");
            asm volatile("s_waitcnt vmcnt(0)" ::: "memory");
        }
    }
    __syncthreads();
}
namespace pg8 {
#define PG8_LAS __attribute__((address_space(3)))
typedef unsigned short bf16_t;
typedef short bf16x8 __attribute__((ext_vector_type(8)));
typedef float f32x4 __attribute__((ext_vector_type(4)));
typedef unsigned u32x4 __attribute__((ext_vector_type(4)));
constexpr int BM = 256, BK = 64, HALF = 128, HTB = HALF * BK * 2  , STAGE_BYTES = 8 * HTB, NXCD = 8, WGM = 8;

__host__ __device__ __forceinline__ int lds_byte(int r, int c) { const int st = (r >> 4) * 2 + (c >> 5), rr = r & 15, cc = c & 31, ob = rr * 64 + cc * 2; return st * 1024 + (ob ^ (((ob >> 9) & 1) << 5)); }
__host__ __device__ __forceinline__ void stage_rc(int b, int& R, int& C) { const int st = b / 1024, sb = b % 1024, swz = sb ^ (((sb >> 9) & 1) << 5); R = (st >> 1) * 16 + swz / 64; C = (st & 1) * 32 + (swz % 64) / 2; }
__host__ __device__ __forceinline__ int perm32(int rho) { const int n = rho >> 4, i = rho & 15; return 8 * (i >> 2) + 4 * n + (i & 3); }

struct Unit { int pm, pn; };
struct Gemm { const bf16_t* A; const bf16_t* Bt; int M, N, K, lda, ldb; };

struct StaticOrder {
    int nM, nN, nwg, G, c;
    __host__ __device__ void init(int M, int N, int G_, int c_) { nM = M / BM; nN = N / BM; nwg = nM * nN; G = G_; c = c_; }
    __host__ __device__ bool next(int i, Unit& u) const {
        const long L = (long)i * G + c; if (L >= nwg) return false;
        int wgid = (int)L; { const int q = nwg / NXCD, r = nwg % NXCD, xcd = wgid % NXCD, off = wgid / NXCD; wgid = (xcd < r ? xcd * (q + 1) : r * (q + 1) + (xcd - r) * q) + off; }
        const int nig = WGM * nN, gid = wgid / nig, fm = gid * WGM, gsz = (nM - fm) < WGM ? (nM - fm) : WGM;
        u.pm = fm + ((wgid % nig) % gsz); u.pn = (wgid % nig) / gsz; return true;
    }
    __device__ __forceinline__ void a_ready(const Unit&) const {}
    __device__ __forceinline__ void done(const Unit&) const {}
};


struct SingleUnit {
    __device__ bool next(int i, Unit& u) const { if (i > 0) return false; u.pm = 0; u.pn = 0; return true; }
    __device__ __forceinline__ void a_ready(const Unit&) const {}
    __device__ __forceinline__ void done(const Unit&) const {}
};
__device__ __forceinline__ unsigned cvt_pk_bf16(float lo, float hi) { unsigned r; asm volatile("v_cvt_pk_bf16_f32 %0, %1, %2" : "=v"(r) : "v"(lo), "v"(hi)); return r; }
template <class Epi, class Sched, bool ALIGN_EPI = false, bool SP2 = false>
__device__ __forceinline__ void gemm_phase(PG8_LAS unsigned char* lds, const Gemm g, const Sched& S, const Epi& E) {
    int tid_ = threadIdx.x; asm volatile("" : "+v"(tid_));
    const int tid = tid_, wid = __builtin_amdgcn_readfirstlane(tid >> 6), lane = tid & 63, wr = wid >> 2, wc = wid & 3, fr = lane & 15, fq = lane >> 4;
    const int K = g.K, nt = K / BK, lda = g.lda, ldb = g.ldb;
    unsigned voffA[2], voffB[2];
#pragma unroll
    for (int i = 0; i < 2; ++i) { int R, C; stage_rc(tid * 16 + i * 8192, R, C); const int Rb = Epi::PERM ? ((R & ~31) + perm32(R & 31)) : R;
        voffA[i] = (unsigned)(R * lda + C) * 2u; voffB[i] = (unsigned)(Rb * ldb + C) * 2u; }
    const size_t kstep = (size_t)(BK * 2);
    const size_t hstepA = (size_t)HALF * lda * 2, hstepB = (size_t)HALF * ldb * 2;
    const size_t tstepA = 2 * hstepA, tstepB = 2 * hstepB;
    const unsigned ldsw = (unsigned)wid * 1024u;
    const int aoff = lds_byte(wr * 64 + fr, fq * 8), boff = lds_byte(wc * 32 + fr, fq * 8);
#define PG8_SA(b, h) (((b) * 2 + (h)) * HTB)
#define PG8_SB(b, h) ((4 + (b) * 2 + (h)) * HTB)
#define PG8_STAGE(bufoff, gbase, voff) do { _Pragma("unroll") for (int _i = 0; _i < 2; ++_i) \
        __builtin_amdgcn_global_load_lds((const unsigned*)((const char*)(gbase) + (voff)[_i]), (PG8_LAS unsigned*)(lds + (bufoff) + ldsw + _i * 8192), 16, 0, 0); } while (0)
#define PG8_LDA(dst, b, h) do { _Pragma("unroll") for (int m = 0; m < 4; ++m) _Pragma("unroll") for (int k = 0; k < 2; ++k) dst[m][k] = *(const PG8_LAS bf16x8*)(lds + PG8_SA(b, h) + aoff + m * 2048 + k * 1024); } while (0)
#define PG8_LDB(dst, b, h) do { _Pragma("unroll") for (int n = 0; n < 2; ++n) _Pragma("unroll") for (int k = 0; k < 2; ++k) dst[n][k] = *(const PG8_LAS bf16x8*)(lds + PG8_SB(b, h) + boff + n * 2048 + k * 1024); } while (0)
#define PG8_MMA(ai, bj, At, Bt) do { __builtin_amdgcn_s_setprio(1); _Pragma("unroll") for (int m = 0; m < 4; ++m) _Pragma("unroll") for (int n = 0; n < 2; ++n) _Pragma("unroll") for (int k = 0; k < 2; ++k) \
        acc[ai][bj][m][n] = __builtin_amdgcn_mfma_f32_16x16x32_bf16(Bt[n][k], At[m][k], acc[ai][bj][m][n], 0, 0, 0); __builtin_amdgcn_s_setprio(0); } while (0)
#define PG8_WAIT_V(n) asm volatile("s_waitcnt vmcnt(" #n ")" ::: "memory")
#define PG8_WAIT_L(n) asm volatile("s_waitcnt lgkmcnt(" #n ")" ::: "memory")
#define PG8_BAR __builtin_amdgcn_s_barrier()
#define PG8_SCHED __builtin_amdgcn_sched_barrier(0)
    Unit cur, nxt; int ui = 0;
    if (!S.next(0, cur)) return;
    f32x4 acc[2][2][4][2];
#pragma unroll
    for (int a = 0; a < 2; ++a)
#pragma unroll
        for (int b = 0; b < 2; ++b)
#pragma unroll
            for (int m = 0; m < 4; ++m)
#pragma unroll
                for (int n = 0; n < 2; ++n) acc[a][b][m][n] = (f32x4){0.f, 0.f, 0.f, 0.f};
    bf16x8 At[4][2], B0[2][2], B1[2][2];
    const char* cA = (const char*)g.A + (size_t)cur.pm * tstepA; const char* cB = (const char*)g.Bt + (size_t)cur.pn * tstepB;
    S.a_ready(cur);
    if constexpr (SP2) {
        PG8_STAGE(PG8_SB(0, 0), cB, voffB); PG8_STAGE(PG8_SB(0, 1), cB + hstepB, voffB); PG8_STAGE(PG8_SA(0, 0), cA, voffA); PG8_STAGE(PG8_SA(0, 1), cA + hstepA, voffA);
        if (wr == 1) PG8_BAR;
        PG8_WAIT_V(2); PG8_BAR;
        PG8_STAGE(PG8_SB(1, 0), cB + kstep, voffB); PG8_STAGE(PG8_SA(1, 0), cA + kstep, voffA); PG8_STAGE(PG8_SB(1, 1), cB + hstepB + kstep, voffB);
        PG8_WAIT_V(6); PG8_BAR;
    } else {
        PG8_STAGE(PG8_SB(0, 0), cB, voffB); PG8_STAGE(PG8_SA(0, 0), cA, voffA); PG8_STAGE(PG8_SB(0, 1), cB + hstepB, voffB); PG8_STAGE(PG8_SA(0, 1), cA + hstepA, voffA);
        if (wr == 1) PG8_BAR;
        PG8_WAIT_V(4); PG8_BAR;
        PG8_STAGE(PG8_SB(1, 0), cB + kstep, voffB); PG8_STAGE(PG8_SA(1, 0), cA + kstep, voffA); PG8_STAGE(PG8_SB(1, 1), cB + hstepB + kstep, voffB);
        PG8_WAIT_V(6); PG8_BAR;
    }
    for (;;) {
        const bool has_next = S.next(ui + 1, nxt);
        const char* nA = has_next ? (const char*)g.A + (size_t)nxt.pm * tstepA : cA; const char* nB = has_next ? (const char*)g.Bt + (size_t)nxt.pn * tstepB : cB;
        for (int t = 0; t < nt; t += 2) {
            const bool last = (t == nt - 2);
            const char* a1 = cA + (size_t)(t + 1) * kstep;
            const char* a2 = last ? nA : cA + (size_t)(t + 2) * kstep; const char* b2 = last ? nB : cB + (size_t)(t + 2) * kstep;
            const char* a3 = a2 + kstep; const char* b3 = b2 + kstep;
            if (last && has_next) S.a_ready(nxt);
            if constexpr (SP2) {
            PG8_LDB(B0, 0, 0); PG8_LDB(B1, 0, 1); PG8_SCHED; PG8_LDA(At, 0, 0); PG8_STAGE(PG8_SA(1, 1), a1 + hstepA, voffA);
            PG8_WAIT_V(8); PG8_WAIT_L(0); PG8_BAR; PG8_MMA(0, 0, At, B0); PG8_MMA(0, 1, At, B1); PG8_BAR; PG8_SCHED;
            PG8_LDA(At, 0, 1); PG8_STAGE(PG8_SB(0, 0), b2, voffB); PG8_STAGE(PG8_SB(0, 1), b2 + hstepB, voffB); PG8_STAGE(PG8_SA(0, 0), a2, voffA);
            PG8_WAIT_V(8); PG8_WAIT_L(0); PG8_BAR; PG8_MMA(1, 0, At, B0); PG8_MMA(1, 1, At, B1); PG8_BAR; PG8_SCHED;
            PG8_LDB(B0, 1, 0); PG8_LDB(B1, 1, 1); PG8_SCHED; PG8_LDA(At, 1, 0); PG8_STAGE(PG8_SA(0, 1), a2 + hstepA, voffA);
            PG8_WAIT_V(8); PG8_WAIT_L(0); PG8_BAR; PG8_MMA(0, 0, At, B0); PG8_MMA(0, 1, At, B1); PG8_BAR; PG8_SCHED;
            PG8_LDA(At, 1, 1); PG8_STAGE(PG8_SB(1, 0), b3, voffB); PG8_STAGE(PG8_SB(1, 1), b3 + hstepB, voffB); PG8_STAGE(PG8_SA(1, 0), a3, voffA);
            PG8_WAIT_V(8); PG8_WAIT_L(0); PG8_BAR; PG8_MMA(1, 0, At, B0); PG8_MMA(1, 1, At, B1); PG8_BAR; PG8_SCHED;
            } else {
            PG8_LDB(B0, 0, 0); PG8_SCHED; PG8_LDA(At, 0, 0); PG8_STAGE(PG8_SA(1, 1), a1 + hstepA, voffA);
            PG8_WAIT_L(8); PG8_BAR; PG8_WAIT_L(0); PG8_MMA(0, 0, At, B0); PG8_BAR; PG8_SCHED;
            PG8_LDB(B1, 0, 1); PG8_STAGE(PG8_SB(0, 0), b2, voffB);
            PG8_BAR; PG8_WAIT_L(0); PG8_MMA(0, 1, At, B1); PG8_BAR;
            PG8_LDA(At, 0, 1); PG8_STAGE(PG8_SA(0, 0), a2, voffA);
            PG8_BAR; PG8_WAIT_L(0); PG8_MMA(1, 0, At, B0); PG8_BAR; PG8_SCHED;
            PG8_STAGE(PG8_SB(0, 1), b2 + hstepB, voffB);
            PG8_WAIT_V(6); PG8_BAR; PG8_MMA(1, 1, At, B1); PG8_BAR;
            PG8_LDB(B0, 1, 0); PG8_SCHED; PG8_LDA(At, 1, 0); PG8_STAGE(PG8_SA(0, 1), a2 + hstepA, voffA);
            PG8_WAIT_L(8); PG8_BAR; PG8_WAIT_L(0); PG8_MMA(0, 0, At, B0); PG8_BAR; PG8_SCHED;
            PG8_LDB(B1, 1, 1); PG8_STAGE(PG8_SB(1, 0), b3, voffB);
            PG8_BAR; PG8_WAIT_L(0); PG8_MMA(0, 1, At, B1); PG8_BAR;
            PG8_LDA(At, 1, 1); PG8_STAGE(PG8_SA(1, 0), a3, voffA);
            PG8_BAR; PG8_WAIT_L(0); PG8_MMA(1, 0, At, B0); PG8_BAR; PG8_SCHED;
            PG8_STAGE(PG8_SB(1, 1), b3 + hstepB, voffB);
            PG8_WAIT_V(6); PG8_BAR; PG8_MMA(1, 1, At, B1); PG8_BAR;
            }
        }
        if constexpr (ALIGN_EPI) { if (wr == 0) PG8_BAR; }
        if constexpr (!Epi::AFTER_DRAIN) { E(acc, cur, wr, wc, fr, fq); S.done(cur); }
        if (!has_next) break;
#pragma unroll
        for (int a = 0; a < 2; ++a)
#pragma unroll
            for (int b = 0; b < 2; ++b)
#pragma unroll
                for (int m = 0; m < 4; ++m)
#pragma unroll
                    for (int n = 0; n < 2; ++n) acc[a][b][m][n] = (f32x4){0.f, 0.f, 0.f, 0.f};
        cur = nxt; cA = nA; cB = nB; ++ui;
        if constexpr (ALIGN_EPI) { if (wr == 1) PG8_BAR; }
    }
    PG8_WAIT_V(0);
    if constexpr (!ALIGN_EPI) { if (wr == 0) PG8_BAR; }
    PG8_BAR;
    if constexpr (Epi::AFTER_DRAIN) { E.fused(acc, cur, wr, wc, fr, fq, lds, wid, lane); S.done(cur); }
#undef PG8_SA
#undef PG8_SB
#undef PG8_STAGE
#undef PG8_LDA
#undef PG8_LDB
#undef PG8_MMA
#undef PG8_WAIT_V
#undef PG8_WAIT_L
#undef PG8_BAR
#undef PG8_SCHED
}
}

using pg8::Unit; using pg8::cvt_pk_bf16;
#define EPI_ARGS const f32x4 (&acc)[2][2][4][2], const Unit& u, int wr, int wc, int fr, int fq
__device__ __forceinline__ float row_rstd(const float* ssq, int row) {
    const f32x4* p = (const f32x4*)(ssq + (size_t)row * 16);
    const f32x4 a = p[0], b = p[1], c = p[2], d = p[3];
    const float s = ((a[0] + a[1]) + (a[2] + a[3])) + ((b[0] + b[1]) + (b[2] + b[3])) + ((c[0] + c[1]) + (c[2] + c[3])) + ((d[0] + d[1]) + (d[2] + d[3]));
    return 1.0f / sqrtf(s * (1.0f / D) + NORM_EPS);
}
struct EpiSwiglu {
    static constexpr bool PERM = false, AFTER_DRAIN = false;
    bf16* H; const float* ssq;
    __device__ __forceinline__ void operator()(EPI_ARGS) const {
#pragma unroll
        for (int ai = 0; ai < 2; ++ai)
#pragma unroll
            for (int m = 0; m < 4; ++m) {
                const int row = u.pm * 256 + ai * 128 + wr * 64 + m * 16 + fr; const float rs = row_rstd(ssq, row);
#pragma unroll
                for (int bj = 0; bj < 2; ++bj) {
                    const f32x4 g = acc[ai][bj][m][0] * rs, up = acc[ai][bj][m][1] * rs; float v[4];
#pragma unroll
                    for (int j = 0; j < 4; ++j) v[j] = siluf_(g[j]) * up[j];
                    u32x2 w; w.x = cvt_pk_bf16(v[0], v[1]); w.y = cvt_pk_bf16(v[2], v[3]);
                    *(u32x2*)(H + (size_t)row * FF + u.pn * 128 + bj * 64 + wc * 16 + fq * 4) = w;
                }
            }
    }
};
struct EpiResid {
    static constexpr bool PERM = false, AFTER_DRAIN = false;
    float* X; bf16* XB; float* ssq; float alpha;
    __device__ __forceinline__ void operator()(EPI_ARGS) const {
#pragma unroll
        for (int ai = 0; ai < 2; ++ai)
#pragma unroll
            for (int m = 0; m < 4; ++m) {
                const int row = u.pm * 256 + ai * 128 + wr * 64 + m * 16 + fr; float s = 0.f;
#pragma unroll
                for (int bj = 0; bj < 2; ++bj)
#pragma unroll
                    for (int n = 0; n < 2; ++n) {
                        const size_t off = (size_t)row * D + u.pn * 256 + bj * 128 + wc * 32 + n * 16 + fq * 4;
                        const f32x4 xn = *(const f32x4*)(X + off) + acc[ai][bj][m][n] * alpha;
                        *(f32x4*)(X + off) = xn;
                        u32x2 w; w.x = cvt_pk_bf16(xn[0], xn[1]); w.y = cvt_pk_bf16(xn[2], xn[3]);
                        *(u32x2*)(XB + off) = w;
                        s += (xn[0] * xn[0] + xn[1] * xn[1]) + (xn[2] * xn[2] + xn[3] * xn[3]);
                    }
                s += shx(s, 16, fq * 16 + fr); s += shx(s, 32, fq * 16 + fr);
                if (fq == 0) ssq[(size_t)row * 16 + u.pn * 4 + wc] = s;
            }
    }
};
struct EpiBf16 {
    static constexpr bool PERM = true, AFTER_DRAIN = false;
    bf16* O; int ldc; const float* ssq; float scale; int ncols;
    __device__ __forceinline__ void operator()(EPI_ARGS) const {
#pragma unroll
        for (int ai = 0; ai < 2; ++ai)
#pragma unroll
            for (int m = 0; m < 4; ++m) {
                const int row = u.pm * 256 + ai * 128 + wr * 64 + m * 16 + fr; const float rs = (ssq ? row_rstd(ssq, row) : 1.0f) * scale;
#pragma unroll
                for (int bj = 0; bj < 2; ++bj) {
                    const int col = u.pn * 256 + bj * 128 + wc * 32 + fq * 8;
                    if (col < ncols) {
                        const f32x4 v0 = acc[ai][bj][m][0] * rs, v1 = acc[ai][bj][m][1] * rs; u32x4 w;
                        w.x = cvt_pk_bf16(v0[0], v0[1]); w.y = cvt_pk_bf16(v0[2], v0[3]); w.z = cvt_pk_bf16(v1[0], v1[1]); w.w = cvt_pk_bf16(v1[2], v1[3]);
                        *(u32x4*)(O + (size_t)row * ldc + col) = w;
                    }
                }
            }
    }
};
struct EpiZ {
    static constexpr bool PERM = true, AFTER_DRAIN = false;
    bf16* O; const float* ssq; bf16* HALO;
    __device__ __forceinline__ void operator()(EPI_ARGS) const {
#pragma unroll
        for (int ai = 0; ai < 2; ++ai)
#pragma unroll
            for (int m = 0; m < 4; ++m) {
                const int row = u.pm * 256 + ai * 128 + wr * 64 + m * 16 + fr; const float rs = row_rstd(ssq, row);
#pragma unroll
                for (int bj = 0; bj < 2; ++bj) {
                    const int col = u.pn * 256 + bj * 128 + wc * 32 + fq * 8;
                    if (col < NZ) {
                        const f32x4 v0 = acc[ai][bj][m][0] * rs, v1 = acc[ai][bj][m][1] * rs; u32x4 w;
                        w.x = cvt_pk_bf16(v0[0], v0[1]); w.y = cvt_pk_bf16(v0[2], v0[3]); w.z = cvt_pk_bf16(v1[0], v1[1]); w.w = cvt_pk_bf16(v1[2], v1[3]);
                        *(u32x4*)(O + (size_t)row * ZP + col) = w;
                        if ((row & 63) == 63 && col >= ZD_R && col < ZD_V) *(u32x4*)(HALO + (size_t)(row >> 6) * 1024 + (col - ZD_R)) = w;
                    }
                }
            }
    }
};
struct EpiKV {
    static constexpr bool PERM = true, AFTER_DRAIN = false;
    bf16* Kd; bf16* VT; const float* rstd;
    __device__ __forceinline__ void operator()(EPI_ARGS) const {
#pragma unroll
        for (int ai = 0; ai < 2; ++ai)
#pragma unroll
            for (int m = 0; m < 4; ++m) {
                const int row = u.pm * 256 + ai * 128 + wr * 64 + m * 16 + fr; const float rs = rstd[row];
#pragma unroll
                for (int bj = 0; bj < 2; ++bj) {
                    const int col = u.pn * 256 + bj * 128 + wc * 32 + fq * 8;
                    const f32x4 v0 = acc[ai][bj][m][0] * rs, v1 = acc[ai][bj][m][1] * rs;
                    if (col < D) {
                        u32x4 w; w.x = cvt_pk_bf16(v0[0], v0[1]); w.y = cvt_pk_bf16(v0[2], v0[3]); w.z = cvt_pk_bf16(v1[0], v1[1]); w.w = cvt_pk_bf16(v1[2], v1[3]);
                        *(u32x4*)(Kd + (size_t)row * D + col) = w;
                    } else {
#pragma unroll
                        for (int j = 0; j < 4; ++j) { VT[(size_t)(col - D + j) * MMEM + row] = (bf16)f2bf(v0[j]); VT[(size_t)(col - D + 4 + j) * MMEM + row] = (bf16)f2bf(v1[j]); }
                    }
                }
            }
    }
};
template <int MODE> struct EpiGate {
    static constexpr bool PERM = true, AFTER_DRAIN = false;
    bf16* GT; const float* ssq; const float* bias;
    __device__ __forceinline__ void operator()(EPI_ARGS) const {
#pragma unroll
        for (int ai = 0; ai < 2; ++ai)
#pragma unroll
            for (int m = 0; m < 4; ++m) {
                const int row = u.pm * 256 + ai * 128 + wr * 64 + m * 16 + fr; const float rs = (MODE == 1) ? 1.0f : row_rstd(ssq, row);
#pragma unroll
                for (int bj = 0; bj < 2; ++bj) {
                    const int col = u.pn * 256 + bj * 128 + wc * 32 + fq * 8; float v[8];
#pragma unroll
                    for (int n = 0; n < 2; ++n) {
                        f32x4 b = (f32x4){0.f, 0.f, 0.f, 0.f}; if (MODE != 1) b = *(const f32x4*)(bias + col + 4 * n);
#pragma unroll
                        for (int j = 0; j < 4; ++j) v[4 * n + j] = sigmoidf_(acc[ai][bj][m][n][j] * rs + b[j]);
                    }
                    u32x4* p = (u32x4*)(GT + (size_t)row * D + col);
                    if (MODE == 2) { const u32x4 o = *p; v[0] *= bflo(o.x); v[1] *= bfhi(o.x); v[2] *= bflo(o.y); v[3] *= bfhi(o.y); v[4] *= bflo(o.z); v[5] *= bfhi(o.z); v[6] *= bflo(o.w); v[7] *= bfhi(o.w); }
                    u32x4 w; w.x = cvt_pk_bf16(v[0], v[1]); w.y = cvt_pk_bf16(v[2], v[3]); w.z = cvt_pk_bf16(v[4], v[5]); w.w = cvt_pk_bf16(v[6], v[7]);
                    *p = w;
                }
            }
    }
};
template <int MODE> struct EpiMerge {
    static constexpr bool PERM = true, AFTER_DRAIN = false;
    bf16* GT; float* MF;
    __device__ __forceinline__ void operator()(EPI_ARGS) const {
#pragma unroll
        for (int ai = 0; ai < 2; ++ai)
#pragma unroll
            for (int m = 0; m < 4; ++m) {
                const int row = u.pm * 256 + ai * 128 + wr * 64 + m * 16 + fr;
#pragma unroll
                for (int bj = 0; bj < 2; ++bj) {
                    const size_t off = (size_t)row * D + u.pn * 256 + bj * 128 + wc * 32 + fq * 8;
                    const u32x4 g = *(const u32x4*)(GT + off);
                    f32x4 v0 = acc[ai][bj][m][0], v1 = acc[ai][bj][m][1];
                    v0[0] *= bflo(g.x); v0[1] *= bfhi(g.x); v0[2] *= bflo(g.y); v0[3] *= bfhi(g.y); v1[0] *= bflo(g.z); v1[1] *= bfhi(g.z); v1[2] *= bflo(g.w); v1[3] *= bfhi(g.w);
                    if (MODE != 0) { v0 += *(const f32x4*)(MF + off); v1 += *(const f32x4*)(MF + off + 4); }
                    if (MODE != 2) { *(f32x4*)(MF + off) = v0; *(f32x4*)(MF + off + 4) = v1; }
                    else { u32x4 w; w.x = cvt_pk_bf16(v0[0], v0[1]); w.y = cvt_pk_bf16(v0[2], v0[3]); w.z = cvt_pk_bf16(v1[0], v1[1]); w.w = cvt_pk_bf16(v1[2], v1[3]); *(u32x4*)(GT + off) = w; }
                }
            }
    }
};
struct EpiSoftmaxP {
    static constexpr bool PERM = true, AFTER_DRAIN = true;
    bf16* P;
    __device__ __forceinline__ void fused(f32x4 (&acc)[2][2][4][2], const Unit& u, int wr, int wc, int fr, int fq, PG8_LAS unsigned char* lds, int wid, int lane) const {
        PG8_LAS float* RM = (PG8_LAS float*)lds;
        PG8_LAS float* RS = (PG8_LAS float*)(lds + 4096);
#pragma unroll
        for (int ai = 0; ai < 2; ++ai)
#pragma unroll
            for (int m = 0; m < 4; ++m) {
                float mx = -3.0e38f;
#pragma unroll
                for (int bj = 0; bj < 2; ++bj)
#pragma unroll
                    for (int n = 0; n < 2; ++n) { const f32x4 x = acc[ai][bj][m][n]; mx = fmaxf(mx, fmaxf(fmaxf(x[0], x[1]), fmaxf(x[2], x[3]))); }
                mx = fmaxf(mx, shx(mx, 16, fq * 16 + fr)); mx = fmaxf(mx, shx(mx, 32, fq * 16 + fr));
                if (fq == 0) RM[(ai * 128 + wr * 64 + m * 16 + fr) * 4 + wc] = mx;
            }
        asm volatile("s_waitcnt lgkmcnt(0)" ::: "memory"); __builtin_amdgcn_s_barrier(); asm volatile("" ::: "memory");
#pragma unroll
        for (int ai = 0; ai < 2; ++ai)
#pragma unroll
            for (int m = 0; m < 4; ++m) {
                const int rl = ai * 128 + wr * 64 + m * 16 + fr;
                const float mx = fmaxf(fmaxf(RM[rl * 4 + 0], RM[rl * 4 + 1]), fmaxf(RM[rl * 4 + 2], RM[rl * 4 + 3])); float s = 0.f;
#pragma unroll
                for (int bj = 0; bj < 2; ++bj)
#pragma unroll
                    for (int n = 0; n < 2; ++n)
#pragma unroll
                        for (int j = 0; j < 4; ++j) { const float p = exp2f(acc[ai][bj][m][n][j] - mx); acc[ai][bj][m][n][j] = p; s += p; }
                s += shx(s, 16, fq * 16 + fr); s += shx(s, 32, fq * 16 + fr);
                if (fq == 0) RS[rl * 4 + wc] = s;
            }
        asm volatile("s_waitcnt lgkmcnt(0)" ::: "memory"); __builtin_amdgcn_s_barrier(); asm volatile("" ::: "memory");
#pragma unroll
        for (int ai = 0; ai < 2; ++ai)
#pragma unroll
            for (int m = 0; m < 4; ++m) {
                const int rl = ai * 128 + wr * 64 + m * 16 + fr;
                const float inv = 1.0f / ((RS[rl * 4 + 0] + RS[rl * 4 + 1]) + (RS[rl * 4 + 2] + RS[rl * 4 + 3]));
#pragma unroll
                for (int bj = 0; bj < 2; ++bj) {
                    const f32x4 v0 = acc[ai][bj][m][0] * inv, v1 = acc[ai][bj][m][1] * inv; u32x4 w;
                    w.x = cvt_pk_bf16(v0[0], v0[1]); w.y = cvt_pk_bf16(v0[2], v0[3]); w.z = cvt_pk_bf16(v1[0], v1[1]); w.w = cvt_pk_bf16(v1[2], v1[3]);
                    *(u32x4*)(P + (size_t)rl * 256 + bj * 128 + wc * 32 + fq * 8) = w;
                }
            }
        asm volatile("s_waitcnt lgkmcnt(0)" ::: "memory"); __builtin_amdgcn_s_barrier(); asm volatile("" ::: "memory");
    }
};
struct SrcPlain { const float* W; int ld; int ncols; __device__ __forceinline__ const float* operator()(int n, int& l) const { l = ld; return n < ncols ? W + n : nullptr; } };
struct SrcGU {
    const float* WG; long dUp;
    __device__ __forceinline__ const float* operator()(int n, int& l) const { l = FF; const int t = n >> 8, cl = n & 255, h = t * 128 + ((cl >> 5) << 4) + (cl & 15); return WG + (h + ((cl & 16) ? dUp : 0l)); }
};
struct SrcKV { const float* WK; long dV; __device__ __forceinline__ const float* operator()(int n, int& l) const { l = D; return WK + (n < D ? (long)n : dV + (long)(n - D)); } };
template <class Src> __device__ __forceinline__ void conv_job(const Src src, const float* gain, int K, int NR, bf16* dst, LAS float* scr, int gw, int NGW, int lane) {
    const int nblk = NR / 32, nitems = (K / 64) * nblk;
    for (int it = gw; it < nitems; it += NGW) {
        const int kb = it / nblk, nb = it % nblk, k0 = 64 * kb, n0 = 32 * nb;
        int ld; const float* p = src(n0 + (lane & 31), ld);
#pragma unroll 8
        for (int i = 0; i < 32; ++i) { const int kk = 2 * i + (lane >> 5); float v = 0.f; if (p) { v = p[(size_t)(k0 + kk) * ld]; if (gain) v *= gain[k0 + kk]; } scr[kk * 33 + (lane & 31)] = v; }
        LDS_WAIT(); asm volatile("" ::: "memory");
        const int c = lane & 7;
#pragma unroll
        for (int j = 0; j < 4; ++j) { const int n = (lane >> 3) + 8 * j; const LAS float* s = scr + (8 * c) * 33 + n;
            u32x4 o; o.x = pk2(s[0 * 33], s[1 * 33]); o.y = pk2(s[2 * 33], s[3 * 33]); o.z = pk2(s[4 * 33], s[5 * 33]); o.w = pk2(s[6 * 33], s[7 * 33]);
            *(u32x4*)(dst + (size_t)(n0 + n) * K + k0 + 8 * c) = o; }
        LDS_WAIT(); asm volatile("" ::: "memory");
    }
}

struct Args { const float* in[N_INPUTS]; float* out; unsigned char* ws; };
typedef const float* cfptr;
typedef __attribute__((address_space(4))) const cfptr* kin_t;
struct Ctx {
    LAS unsigned char* lds; int tid, lane, wave, G, bid;
    kin_t in; float* X; unsigned char* ws;
    __device__ __forceinline__ const float* inp(int i, int l, size_t per_layer) const { return in[i] + (size_t)l * per_layer; }
};
__device__ __forceinline__ Ctx make_ctx() {
    extern __shared__ __attribute__((aligned(16))) unsigned char lds_raw[];
    Ctx C; int t = threadIdx.x; asm volatile("" : "+v"(t));
    kin_t k = (kin_t)__builtin_amdgcn_kernarg_segment_ptr(); asm volatile("" : "+s"(k));
    C.lds = (LAS unsigned char*)lds_raw; C.tid = t; C.lane = t & 63; C.wave = __builtin_amdgcn_readfirstlane(t >> 6);
    C.G = gridDim.x; C.bid = blockIdx.x; C.in = k;
    C.X = (float*)k[N_INPUTS]; C.ws = (unsigned char*)k[N_INPUTS + 1];
    return C;
}
constexpr size_t RWW_OFF = 93 * MiB;
enum ConvJob { CJ_GU1, CJ_D1, CJ_WIN, CJ_GATES, CJ_PROJ, CJ_XW, CJ_GU2, CJ_D2, CJ_XKV, CJ_MLW, CJ_RWW };
__device__ __forceinline__ void run_conv(const Ctx& C, int job, int l, int gw, int NGW) {
    LAS float* scr = (LAS float*)(C.lds + C.wave * 16384);
    unsigned char* ws = C.ws;
    switch (job) {
    case CJ_GU1: conv_job(SrcGU{C.inp(I_FFN1_WG, l, (size_t)D * FF), (long)(C.inp(I_FFN1_WU, l, (size_t)D * FF) - C.inp(I_FFN1_WG, l, (size_t)D * FF))}, C.inp(I_FFN1_NORM, l, D), D, 2 * FF, (bf16*)(ws + WS_SLOTA), scr, gw, NGW, C.lane); break;
    case CJ_GU2: conv_job(SrcGU{C.inp(I_FFN2_WG, l, (size_t)D * FF), (long)(C.inp(I_FFN2_WU, l, (size_t)D * FF) - C.inp(I_FFN2_WG, l, (size_t)D * FF))}, C.inp(I_FFN2_NORM, l, D), D, 2 * FF, (bf16*)(ws + WS_SLOTA), scr, gw, NGW, C.lane); break;
    case CJ_D1: conv_job(SrcPlain{C.inp(I_FFN1_WD, l, (size_t)D * FF), D, D}, nullptr, FF, D, (bf16*)(ws + WS_SLOTC), scr, gw, NGW, C.lane); break;
    case CJ_D2: conv_job(SrcPlain{C.inp(I_FFN2_WD, l, (size_t)D * FF), D, D}, nullptr, FF, D, (bf16*)(ws + WS_SLOTC), scr, gw, NGW, C.lane); break;
    case CJ_WIN: conv_job(SrcPlain{C.inp(I_W_IN, l, (size_t)D * NIN), NIN, NZ}, C.inp(I_MIX_NORM, l, D), D, NINP, (bf16*)(ws + WS_SLOTB), scr, gw, NGW, C.lane); break;
    case CJ_GATES: conv_job(SrcPlain{C.inp(I_W_IN, l, (size_t)D * NIN) + ZG, NIN, 4 * D}, C.inp(I_MIX_NORM, l, D), D, 4 * D, (bf16*)(ws + WS_SLOTA), scr, gw, NGW, C.lane); break;
    case CJ_PROJ: {
        const int idx[5] = {I_ML_PROJ, I_S5_W1, I_S5_W2, I_GLA_PROJ, I_RW_PROJ};
#pragma unroll
        for (int q = 0; q < 5; ++q) conv_job(SrcPlain{C.inp(idx[q], l, (size_t)WB * D), D, D}, nullptr, WB, D, (bf16*)(ws + WS_SLOTC + (size_t)q * MiB), scr, gw, NGW, C.lane);
    } break;
    case CJ_XW:
        conv_job(SrcPlain{C.inp(I_W_OUT, l, (size_t)D * D), D, D}, nullptr, D, D, (bf16*)(ws + WS_SLOTB), scr, gw, NGW, C.lane);
        conv_job(SrcPlain{C.inp(I_XA_WQ, l, (size_t)D * D), D, D}, C.inp(I_XA_NORM, l, D), D, D, (bf16*)(ws + WS_SLOTB + 2 * MiB), scr, gw, NGW, C.lane);
        conv_job(SrcPlain{C.inp(I_XA_WO, l, (size_t)D * D), D, D}, nullptr, D, D, (bf16*)(ws + WS_SLOTB + 4 * MiB), scr, gw, NGW, C.lane);
        break;
    case CJ_MLW: {
        const int idx[3] = {I_ML_WQ, I_ML_WK, I_ML_WV};
#pragma unroll
        for (int q = 0; q < 3; ++q)
#pragma unroll
            for (int hh = 0; hh < 4; ++hh) conv_job(SrcPlain{C.inp(idx[q], l, 4 * 16384) + hh * 16384, 128, 128}, nullptr, 128, 128, (bf16*)(ws + 512 * 1024) + (size_t)(q * 4 + hh) * 16384, scr, gw, NGW, C.lane);
    } break;
    case CJ_RWW: {
        bf16* dst = (bf16*)(ws + WS_S + RWW_OFF);
        conv_job(SrcPlain{C.inp(I_RW_WUP, l, 64 * WB), WB, WB}, nullptr, 64, WB, dst, scr, gw, NGW, C.lane);
        conv_job(SrcPlain{C.inp(I_RW_AUP, l, 64 * WB), WB, WB}, nullptr, 64, WB, dst + 512 * 64, scr, gw, NGW, C.lane);
        conv_job(SrcPlain{C.inp(I_RW_GUP, l, 128 * WB), WB, WB}, nullptr, 128, WB, dst + 2 * 512 * 64, scr, gw, NGW, C.lane);
    } break;
    case CJ_XKV: conv_job(SrcKV{C.inp(I_XA_WK, l, (size_t)D * D), (long)(C.inp(I_XA_WV, l, (size_t)D * D) - C.inp(I_XA_WK, l, (size_t)D * D))}, C.inp(I_MEM_NORM, l, D), D, 2 * D, (bf16*)(ws + WS_S + (size_t)l * 4 * MiB), scr, gw, NGW, C.lane); break;
    }
}

__device__ __forceinline__ void pro_rows(const Ctx& C) {
    const int gw = C.bid * 8 + C.wave, NGW = C.G * 8;
    const float* x = C.in[I_X]; bf16* XB = (bf16*)(C.ws + WS_XB); float* ssq = (float*)(C.ws + WS_SSQ);
    for (int m = gw; m < M; m += NGW) {
        const f32x4* xr = (const f32x4*)(x + (size_t)m * D) + C.lane; f32x4* orow = (f32x4*)(C.X + (size_t)m * D) + C.lane; u32x2* br = (u32x2*)(XB + (size_t)m * D) + C.lane;
        float s = 0.f;
#pragma unroll
        for (int j = 0; j < 4; ++j) { const f32x4 v = xr[64 * j]; orow[64 * j] = v; u32x2 w; w.x = pk2(v[0], v[1]); w.y = pk2(v[2], v[3]); br[64 * j] = w; s += (v[0] * v[0] + v[1] * v[1]) + (v[2] * v[2] + v[3] * v[3]); }
        s = wave_sum(s, C.lane);
        if (C.lane < 16) ssq[(size_t)m * 16 + C.lane] = (C.lane == 0) ? s : 0.f;
    }
    const float* mem = C.in[I_MEM]; bf16* MB = (bf16*)(C.ws + WS_MEMB); float* memr = (float*)(C.ws + WS_MEMR);
    for (int m = gw; m < MMEM; m += NGW) {
        const f32x4* xr = (const f32x4*)(mem + (size_t)m * D) + C.lane; u32x2* br = (u32x2*)(MB + (size_t)m * D) + C.lane; float s = 0.f;
#pragma unroll
        for (int j = 0; j < 4; ++j) { const f32x4 v = xr[64 * j]; u32x2 w; w.x = pk2(v[0], v[1]); w.y = pk2(v[2], v[3]); br[64 * j] = w; s += (v[0] * v[0] + v[1] * v[1]) + (v[2] * v[2] + v[3] * v[3]); }
        s = wave_sum(s, C.lane);
        if (C.lane == 0) memr[m] = 1.0f / sqrtf(s * (1.0f / D) + NORM_EPS);
    }
}
__device__ __forceinline__ void final_rows(const Ctx& C) {
    const int gw = C.bid * 8 + C.wave, NGW = C.G * 8; const float* ssq = (const float*)(C.ws + WS_SSQ); const float* g = C.in[I_FINAL_NORM];
    for (int m = gw; m < M; m += NGW) {
        const float rs = row_rstd(ssq, m); f32x4* orow = (f32x4*)(C.X + (size_t)m * D) + C.lane; const f32x4* gr = (const f32x4*)g + C.lane;
#pragma unroll
        for (int j = 0; j < 4; ++j) orow[64 * j] = orow[64 * j] * rs * gr[64 * j];
    }
}
__device__ __forceinline__ float ldz(const bf16* Z, int row, int col) { return bf2f(Z[(size_t)row * ZP + col]); }
__device__ __forceinline__ float gelu_tanh(float y) { const float t = 0.7978845608028654f * (y + 0.044715f * y * y * y); return 0.5f * y * (1.0f + tanhf(t)); }
constexpr int LCH = 64, NCH = SEQ / LCH;
constexpr size_t SO_GLA_ST = 0;
constexpr size_t SO_GLA_G = SO_GLA_ST + 16 * MiB;
constexpr size_t SO_ML_ST = SO_GLA_G + 512 * 1024;
constexpr size_t SO_ML_G = SO_ML_ST + 36 * MiB;
constexpr size_t SO_END0 = SO_ML_G + 512 * 1024;
static_assert(WS_S + SO_END0 <= WS_END, "state region");

__device__ __forceinline__ bf16x8 ld8(const LAS bf16* p) { return *(const LAS bf16x8*)p; }
__device__ __forceinline__ bf16x8 ld8(const bf16* p) { return *(const bf16x8*)p; }
template <int K, class PA, class PB> __device__ __forceinline__ f32x4 tile_mm(PA A, int lda, PB B, int ldb, f32x4 acc, int fr, int fq) {
#pragma unroll
    for (int k0 = 0; k0 < K; k0 += 32) {
        const bf16x8 a = ld8(A + fr * lda + k0 + 8 * fq);
        const bf16x8 b = ld8(B + fr * ldb + k0 + 8 * fq);
        acc = __builtin_amdgcn_mfma_f32_16x16x32_bf16(a, b, acc, 0, 0, 0);
    }
    return acc;
}
#define F4Z ((f32x4){0.f, 0.f, 0.f, 0.f})
__device__ __forceinline__ u32x2 pack4(f32x4 v) { u32x2 w; w.x = pk2(v[0], v[1]); w.y = pk2(v[2], v[3]); return w; }
__device__ __forceinline__ void unpack8(u32x4 w, float* f) { f[0] = bflo(w.x); f[1] = bfhi(w.x); f[2] = bflo(w.y); f[3] = bfhi(w.y); f[4] = bflo(w.z); f[5] = bfhi(w.z); f[6] = bflo(w.w); f[7] = bfhi(w.w); }

__device__ __forceinline__ void gla_cumdecay(const Ctx& C, int l, int h, int rowb, LAS float* ALOW, LAS float* LA, LAS float* SEG) {
    const bf16* Z = (const bf16*)(C.ws + WS_Z);
    const float* aup = C.inp(I_GLA_AUP, l, 16 * 256) + h * 64; const float* abias = C.inp(I_GLA_ABIAS, l, 256) + h * 64;
    const int tid = C.tid;
    for (int i = tid; i < 64 * 16; i += 512) ALOW[i] = ldz(Z, rowb + (i >> 4), ZC_A + (i & 15));
    __syncthreads();
    {   const int k = tid & 63, seg = tid >> 6; float au[16], run = 0.f, v[8];
#pragma unroll
        for (int r = 0; r < 16; ++r) au[r] = aup[r * 256 + k];
        const float bk = abias[k];
#pragma unroll
        for (int i = 0; i < 8; ++i) { const int t = seg * 8 + i; float s = bk;
#pragma unroll
            for (int r = 0; r < 16; ++r) s += ALOW[t * 16 + r] * au[r];
            run += logsigmoidf_(s) * (1.0f / 16.0f); v[i] = run; }
        SEG[seg * 64 + k] = run;
        __syncthreads();
        float off = 0.f;
        for (int s2 = 0; s2 < seg; ++s2) off += SEG[s2 * 64 + k];
#pragma unroll
        for (int i = 0; i < 8; ++i) LA[(seg * 8 + i) * 64 + k] = v[i] + off;
    }
    __syncthreads();
}
constexpr int LDT = 72;
__device__ __forceinline__ void gla_passA(const Ctx& C, int l, int item) {
    const int bh = item >> 6, c = item & 63, b = bh >> 2, h = bh & 3, rowb = b * SEQ + c * LCH;
    const bf16* Z = (const bf16*)(C.ws + WS_Z);
    LAS float* ALOW = (LAS float*)C.lds; LAS float* LA = ALOW + 1024; LAS float* SEG = LA + 4096;
    LAS bf16* VT = (LAS bf16*)(SEG + 512);
    LAS bf16* KT = VT + 128 * LDT;
    const int tid = C.tid, lane = C.lane, w = C.wave, fr = lane & 15, fq = lane >> 4;
    gla_cumdecay(C, l, h, rowb, ALOW, LA, SEG);
    for (int i = tid; i < 64 * 16; i += 512) { const int t = i >> 4, v0 = (i & 15) * 8; float f[8];
        unpack8(*(const u32x4*)(Z + (size_t)(rowb + t) * ZP + ZC_V + h * 128 + v0), f);
#pragma unroll
        for (int j = 0; j < 8; ++j) VT[(v0 + j) * LDT + t] = (bf16)f2bf(f[j]); }
    {   const int t = tid >> 3, k0 = (tid & 7) * 8; float f[8];
        unpack8(*(const u32x4*)(Z + (size_t)(rowb + t) * ZP + ZC_K + h * 64 + k0), f);
#pragma unroll
        for (int j = 0; j < 8; ++j) KT[(k0 + j) * LDT + t] = (bf16)f2bf(f[j] * __expf(LA[63 * 64 + k0 + j] - LA[t * 64 + k0 + j])); }
    if (tid < 64) ((float*)(C.ws + WS_S + SO_GLA_G))[(size_t)item * 64 + tid] = __expf(LA[63 * 64 + tid]);
    __syncthreads();
    bf16* ST = (bf16*)(C.ws + WS_S + SO_GLA_ST) + (size_t)item * 8192;
#pragma unroll
    for (int q = 0; q < 4; ++q) {
        const f32x4 acc = tile_mm<64>(KT + (16 * q) * LDT, LDT, VT + (16 * w) * LDT, LDT, F4Z, fr, fq);
        *(u32x2*)(ST + (size_t)(16 * w + fr) * 64 + 16 * q + 4 * fq) = pack4(acc);
    }
    __syncthreads();
}
__device__ __forceinline__ void gla_passB(const Ctx& C) {
    const int idx = C.bid * 512 + C.tid; if (idx >= 16 * 8192) return;
    const int bh = idx >> 13, e = idx & 8191, k = e & 63;
    bf16* ST = (bf16*)(C.ws + WS_S + SO_GLA_ST) + (size_t)bh * 64 * 8192 + e; const float* G = (const float*)(C.ws + WS_S + SO_GLA_G) + (size_t)bh * 64 * 64 + k;
    float d[64], g[64];
#pragma unroll
    for (int c = 0; c < 64; ++c) { d[c] = bf2f(ST[(size_t)c * 8192]); g[c] = G[c * 64]; }
    float run = 0.f;
#pragma unroll
    for (int c = 0; c < 64; ++c) { ST[(size_t)c * 8192] = (bf16)f2bf(run); run = run * g[c] + d[c]; }
}
__device__ __forceinline__ void gla_passC(const Ctx& C, int l, int item) {
    const int bh = item >> 6, c = item & 63, b = bh >> 2, h = bh & 3, rowb = b * SEQ + c * LCH;
    bf16* Z = (bf16*)(C.ws + WS_Z);
    LAS float* ALOW = (LAS float*)C.lds; LAS float* LA = ALOW + 1024; LAS float* SEG = LA + 4096;
    LAS bf16* VT = (LAS bf16*)(SEG + 512);
    LAS bf16* QP = VT + 128 * LDT;
    LAS bf16* KP = QP + 64 * LDT;
    LAS bf16* ATT = KP + 64 * LDT;
    LAS float* O = (LAS float*)(ATT + 64 * LDT);
    LAS float* RSQ = O + 64 * 132;
    const int tid = C.tid, lane = C.lane, w = C.wave, fr = lane & 15, fq = lane >> 4;
    gla_cumdecay(C, l, h, rowb, ALOW, LA, SEG);
    for (int i = tid; i < 64 * 16; i += 512) { const int t = i >> 4, v0 = (i & 15) * 8; float f[8];
        unpack8(*(const u32x4*)(Z + (size_t)(rowb + t) * ZP + ZC_V + h * 128 + v0), f);
#pragma unroll
        for (int j = 0; j < 8; ++j) VT[(v0 + j) * LDT + t] = (bf16)f2bf(f[j]); }
    {   const int t = tid >> 3, k0 = (tid & 7) * 8; float fq_[8], fk_[8];
        unpack8(*(const u32x4*)(Z + (size_t)(rowb + t) * ZP + ZC_Q + h * 64 + k0), fq_);
        unpack8(*(const u32x4*)(Z + (size_t)(rowb + t) * ZP + ZC_K + h * 64 + k0), fk_);
        u32x4 wq, wk; float eq[8], ek[8];
#pragma unroll
        for (int j = 0; j < 8; ++j) { const float bb = LA[t * 64 + k0 + j]; eq[j] = fq_[j] * 0.125f * __expf(bb); ek[j] = fk_[j] * __expf(-bb); }
        wq.x = pk2(eq[0], eq[1]); wq.y = pk2(eq[2], eq[3]); wq.z = pk2(eq[4], eq[5]); wq.w = pk2(eq[6], eq[7]);
        wk.x = pk2(ek[0], ek[1]); wk.y = pk2(ek[2], ek[3]); wk.z = pk2(ek[4], ek[5]); wk.w = pk2(ek[6], ek[7]);
        *(LAS u32x4*)(QP + t * LDT + k0) = wq; *(LAS u32x4*)(KP + t * LDT + k0) = wk; }
    __syncthreads();
#pragma unroll
    for (int q = 0; q < 2; ++q) {
        const int id = 2 * w + q, tt = id >> 2, ss = id & 3; f32x4 acc = F4Z;
        if (ss <= tt) acc = tile_mm<64>(KP + (16 * ss) * LDT, LDT, QP + (16 * tt) * LDT, LDT, acc, fr, fq);
        const int t = 16 * tt + fr, s0 = 16 * ss + 4 * fq;
#pragma unroll
        for (int r = 0; r < 4; ++r) if (s0 + r > t) acc[r] = 0.f;
        *(LAS u32x2*)(ATT + t * LDT + s0) = pack4(acc);
    }
    __syncthreads();
    const bf16* ST = (const bf16*)(C.ws + WS_S + SO_GLA_ST) + (size_t)item * 8192;
#pragma unroll
    for (int q = 0; q < 4; ++q) {
        const int id = 4 * w + q, tt = id & 3, vv = id >> 2;
        f32x4 acc = tile_mm<64>(ST + (size_t)(16 * vv) * 64, 64, QP + (16 * tt) * LDT, LDT, F4Z, fr, fq);
        acc = tile_mm<64>(VT + (16 * vv) * LDT, LDT, ATT + (16 * tt) * LDT, LDT, acc, fr, fq);
        *(LAS f32x4*)(O + (16 * tt + fr) * 132 + 16 * vv + 4 * fq) = acc;
    }
    __syncthreads();
    {
#pragma unroll
        for (int i = 0; i < 8; ++i) { const int t = 8 * w + i; const float h0 = O[t * 132 + lane], h1 = O[t * 132 + lane + 64];
            const float ss = wave_sum(h0 * h0 + h1 * h1, lane); if (lane == 0) RSQ[t] = 1.0f / sqrtf(ss * (1.0f / 128) + NORM_EPS); }
    }
    __syncthreads();
    for (int i = tid; i < 64 * 16; i += 512) { const int t = i >> 4, v0 = (i & 15) * 8; float g[8]; const float rs = RSQ[t];
        bf16* zp = Z + (size_t)(rowb + t) * ZP + ZC_G + h * 128 + v0; unpack8(*(const u32x4*)zp, g);
        const float* gn = C.inp(I_GLA_NORM, l, WB) + h * 128 + v0; float o[8];
#pragma unroll
        for (int j = 0; j < 8; ++j) o[j] = O[t * 132 + v0 + j] * rs * gn[j] * siluf_(g[j]);
        u32x4 wv; wv.x = pk2(o[0], o[1]); wv.y = pk2(o[2], o[3]); wv.z = pk2(o[4], o[5]); wv.w = pk2(o[6], o[7]);
        *(u32x4*)zp = wv; }
    __syncthreads();
}

constexpr size_t WS_MLW = 512 * 1024;
constexpr int LDU = 152, LDE = 136;
__device__ __forceinline__ float wave_incl_scan(float v, int lane) {
#pragma unroll
    for (int o = 1; o < 64; o <<= 1) { const float n = __builtin_bit_cast(float, __builtin_amdgcn_ds_bpermute(((lane - o) & 63) << 2, __builtin_bit_cast(int, v))); if (lane >= o) v += n; }
    return v;
}
__device__ __forceinline__ void ml_front(const Ctx& C, int l, int b, int h, int c, LAS bf16* UC, LAS bf16* U, LAS float* GB, LAS float* GI) {
    const bf16* Z = (const bf16*)(C.ws + WS_Z); const int t0 = c * LCH, rowb = b * SEQ + t0, tid = C.tid;
    const float* conv = C.inp(I_ML_CONV, l, 4 * WB) + h * 128;
    for (int i = tid; i < 64 * 16; i += 512) { const int t = i >> 4, e0 = (i & 15) * 8; float s[8], x[8];
#pragma unroll
        for (int j = 0; j < 8; ++j) s[j] = 0.f;
#pragma unroll
        for (int d = 0; d < 4; ++d) {
            if (t0 + t - 3 + d >= 0) { unpack8(*(const u32x4*)(Z + (size_t)(rowb + t - 3 + d) * ZP + ZA_U + h * 128 + e0), x);
#pragma unroll
                for (int j = 0; j < 8; ++j) s[j] += conv[d * WB + e0 + j] * x[j]; }
        }
        u32x4 wu, wc; wu.x = pk2(x[0], x[1]); wu.y = pk2(x[2], x[3]); wu.z = pk2(x[4], x[5]); wu.w = pk2(x[6], x[7]);
#pragma unroll
        for (int j = 0; j < 8; ++j) s[j] = siluf_(s[j]);
        wc.x = pk2(s[0], s[1]); wc.y = pk2(s[2], s[3]); wc.z = pk2(s[4], s[5]); wc.w = pk2(s[6], s[7]);
        *(LAS u32x4*)(U + t * LDU + e0) = wu; *(LAS u32x4*)(UC + t * LDU + e0) = wc; }
    if (C.wave == 0) { const int t = C.lane;
        const float li = ldz(Z, rowb + t, ZA_I + h) + C.inp(I_ML_BI, l, 4)[h]; const float lf = logsigmoidf_(ldz(Z, rowb + t, ZA_F + h) + C.inp(I_ML_BF, l, 4)[h]);
        GB[t] = wave_incl_scan(lf, C.lane); GI[t] = li; }
    __syncthreads();
}
__device__ __forceinline__ void ml_passA(const Ctx& C, int l, int item) {
    const int bh = item >> 6, c = item & 63, b = bh >> 2, h = bh & 3;
    LAS bf16* UC = (LAS bf16*)C.lds; LAS bf16* U = UC + 64 * LDU; LAS bf16* KT = U + 64 * LDU;
    LAS bf16* VT = KT + 128 * LDT;
    LAS float* GB = (LAS float*)(VT + 144 * LDT); LAS float* GI = GB + 64; LAS float* WA = GI + 64;
    const int tid = C.tid, lane = C.lane, w = C.wave, fr = lane & 15, fq = lane >> 4;
    ml_front(C, l, b, h, c, UC, U, GB, GI);
    if (tid < 64) WA[tid] = __expf(GB[63] - GB[tid] + GI[tid]) * 0.08838834764831845f;
    for (int i = tid; i < 16 * LDT; i += 512) VT[128 * LDT + i] = (i < LDT) ? (bf16)0x3f80 : (bf16)0;
    __syncthreads();
    const bf16* WK = (const bf16*)(C.ws + WS_MLW) + (size_t)(4 + h) * 16384; const bf16* WV = (const bf16*)(C.ws + WS_MLW) + (size_t)(8 + h) * 16384;
#pragma unroll
    for (int q = 0; q < 4; ++q) {
        const int id = 4 * w + q, tt = id & 3, ee = id >> 2;
        f32x4 ak = tile_mm<128>(UC + (16 * tt) * LDU, LDU, WK + (size_t)(16 * ee) * 128, 128, F4Z, fr, fq);
        f32x4 av = tile_mm<128>(U + (16 * tt) * LDU, LDU, WV + (size_t)(16 * ee) * 128, 128, F4Z, fr, fq);
        const int t = 16 * tt + 4 * fq;
#pragma unroll
        for (int r = 0; r < 4; ++r) ak[r] *= WA[t + r];
        *(LAS u32x2*)(KT + (16 * ee + fr) * LDT + t) = pack4(ak); *(LAS u32x2*)(VT + (16 * ee + fr) * LDT + t) = pack4(av);
    }
    if (tid == 0) ((float*)(C.ws + WS_S + SO_ML_G))[item] = __expf(GB[63]);
    __syncthreads();
    bf16* ST = (bf16*)(C.ws + WS_S + SO_ML_ST) + (size_t)item * (144 * 128);
    for (int id = w; id < 72; id += 8) {
        const int ee = id & 7, vv = id >> 3;
        const f32x4 acc = tile_mm<64>(KT + (16 * ee) * LDT, LDT, VT + (16 * vv) * LDT, LDT, F4Z, fr, fq);
        *(u32x2*)(ST + (size_t)(16 * vv + fr) * 128 + 16 * ee + 4 * fq) = pack4(acc);
    }
    __syncthreads();
}
__device__ __forceinline__ void ml_passB(const Ctx& C) {
    for (int idx = C.bid * 512 + C.tid; idx < 16 * 18432; idx += C.G * 512) {
        const int bh = idx / 18432, e = idx % 18432;
        bf16* ST = (bf16*)(C.ws + WS_S + SO_ML_ST) + (size_t)bh * 64 * 18432 + e; const float* G = (const float*)(C.ws + WS_S + SO_ML_G) + bh * 64;
        float d[64], g[64];
#pragma unroll
        for (int c = 0; c < 64; ++c) { d[c] = bf2f(ST[(size_t)c * 18432]); g[c] = G[c]; }
        float run = 0.f;
#pragma unroll
        for (int c = 0; c < 64; ++c) { ST[(size_t)c * 18432] = (bf16)f2bf(run); run = run * g[c] + d[c]; }
    }
}
__device__ __forceinline__ void ml_passC(const Ctx& C, int l, int item) {
    const int bh = item >> 6, c = item & 63, b = bh >> 2, h = bh & 3, rowb = b * SEQ + c * LCH;
    bf16* Z = (bf16*)(C.ws + WS_Z);
    LAS bf16* UC = (LAS bf16*)C.lds; LAS bf16* U = UC + 64 * LDU; LAS bf16* Q = U + 64 * LDU;
    LAS bf16* K = Q + 64 * LDE;
    LAS bf16* VT = K + 64 * LDE;
    LAS bf16* W = VT + 144 * LDT;
    LAS float* GB = (LAS float*)(W + 64 * LDT); LAS float* GI = GB + 64; LAS float* RF = GI + 64; LAS float* CF = RF + 64; LAS float* RSQ = CF + 64;
    LAS float* O = (LAS float*)C.lds;
    const int tid = C.tid, lane = C.lane, w = C.wave, fr = lane & 15, fq = lane >> 4;
    ml_front(C, l, b, h, c, UC, U, GB, GI);
    if (tid < 64) { RF[tid] = __expf(GB[tid]); CF[tid] = __expf(GI[tid] - GB[tid]) * 0.08838834764831845f; }
    for (int i = tid; i < 16 * LDT; i += 512) VT[128 * LDT + i] = (i < LDT) ? (bf16)0x3f80 : (bf16)0;
    const bf16* WQ = (const bf16*)(C.ws + WS_MLW) + (size_t)h * 16384; const bf16* WK = WQ + 4 * 16384; const bf16* WV = WQ + 8 * 16384;
#pragma unroll
    for (int q = 0; q < 4; ++q) {
        const int id = 4 * w + q, tt = id & 3, ee = id >> 2;
        const f32x4 aq = tile_mm<128>(WQ + (size_t)(16 * ee) * 128, 128, UC + (16 * tt) * LDU, LDU, F4Z, fr, fq);
        const f32x4 ak = tile_mm<128>(WK + (size_t)(16 * ee) * 128, 128, UC + (16 * tt) * LDU, LDU, F4Z, fr, fq);
        *(LAS u32x2*)(Q + (16 * tt + fr) * LDE + 16 * ee + 4 * fq) = pack4(aq); *(LAS u32x2*)(K + (16 * tt + fr) * LDE + 16 * ee + 4 * fq) = pack4(ak);
        const f32x4 av = tile_mm<128>(U + (16 * tt) * LDU, LDU, WV + (size_t)(16 * ee) * 128, 128, F4Z, fr, fq);
        *(LAS u32x2*)(VT + (16 * ee + fr) * LDT + 16 * tt + 4 * fq) = pack4(av);
    }
    __syncthreads();
#pragma unroll
    for (int q = 0; q < 2; ++q) {
        const int id = 2 * w + q, tt = id >> 2, ss = id & 3; f32x4 acc = F4Z;
        if (ss <= tt) acc = tile_mm<128>(K + (16 * ss) * LDE, LDE, Q + (16 * tt) * LDE, LDE, acc, fr, fq);
        const int t = 16 * tt + fr, s0 = 16 * ss + 4 * fq; const float rf = RF[t];
#pragma unroll
        for (int r = 0; r < 4; ++r) acc[r] = (s0 + r > t) ? 0.f : acc[r] * rf * CF[s0 + r];
        *(LAS u32x2*)(W + t * LDT + s0) = pack4(acc);
    }
    __syncthreads();
    const bf16* ST = (const bf16*)(C.ws + WS_S + SO_ML_ST) + (size_t)item * (144 * 128);
    f32x4 res[5];
#pragma unroll
    for (int q = 0; q < 5; ++q) {
        const int id = w + 8 * q, tt = id & 3, vv = id >> 2; res[q] = F4Z;
        if (id < 36) {
            f32x4 acc = tile_mm<128>(ST + (size_t)(16 * vv) * 128, 128, Q + (16 * tt) * LDE, LDE, F4Z, fr, fq);
            acc *= RF[16 * tt + fr];
            res[q] = tile_mm<64>(VT + (16 * vv) * LDT, LDT, W + (16 * tt) * LDT, LDT, acc, fr, fq);
        }
    }
    __syncthreads();
#pragma unroll
    for (int q = 0; q < 5; ++q) { const int id = w + 8 * q, tt = id & 3, vv = id >> 2; if (id < 36) *(LAS f32x4*)(O + (16 * tt + fr) * 148 + 16 * vv + 4 * fq) = res[q]; }
    __syncthreads();
    {
#pragma unroll
        for (int i = 0; i < 8; ++i) { const int t = 8 * w + i; const float inv = 1.0f / fmaxf(fabsf(O[t * 148 + 128]), 1.0f);
            const float h0 = O[t * 148 + lane] * inv, h1 = O[t * 148 + lane + 64] * inv;
            const float ss = wave_sum(h0 * h0 + h1 * h1, lane); if (lane == 0) RSQ[t] = inv / sqrtf(ss * (1.0f / 128) + NORM_EPS); }
    }
    __syncthreads();
    for (int i = tid; i < 64 * 16; i += 512) { const int t = i >> 4, v0 = (i & 15) * 8; float g[8]; const float rs = RSQ[t];
        bf16* zp = Z + (size_t)(rowb + t) * ZP + ZA_O + h * 128 + v0; unpack8(*(const u32x4*)zp, g);
        const float* gn = C.inp(I_ML_NORM, l, WB) + h * 128 + v0; float o[8];
#pragma unroll
        for (int j = 0; j < 8; ++j) o[j] = O[t * 148 + v0 + j] * rs * gn[j] * sigmoidf_(g[j]);
        u32x4 wv; wv.x = pk2(o[0], o[1]); wv.y = pk2(o[2], o[3]); wv.z = pk2(o[4], o[5]); wv.w = pk2(o[6], o[7]);
        *(u32x4*)zp = wv; }
    __syncthreads();
}

constexpr size_t SO_S5_K = SO_END0;
constexpr size_t SO_S5_BB = SO_S5_K + 1 * MiB;
constexpr size_t SO_S5_PM = SO_S5_BB + 256 * 1024;
constexpr size_t SO_S5_POW = SO_S5_PM + 512 * 1024;
constexpr size_t SO_S5_E = SO_S5_POW + 1280 * 1024;
constexpr size_t SO_END1 = SO_S5_E + 4 * MiB;
static_assert(WS_S + SO_END1 <= WS_END, "state region");
__device__ __forceinline__ void s5_prep(const Ctx& C, int l, int g) {
    LAS float* BBr = (LAS float*)C.lds; LAS float* BBi = BBr + 1024; LAS float* PW = BBi + 1024; LAS float* CR = PW + 65 * 128; LAS float* CI = CR + 1024;
    const int tid = C.tid;
    if (tid < 64) { const int p = tid;
        const float are = C.inp(I_S5_ARE, l, 32 * 64)[g * 64 + p], aim = C.inp(I_S5_AIM, l, 32 * 64)[g * 64 + p];
        const float step = expf(C.inp(I_S5_LOGSTEP, l, 32)[g]); const float lre = fminf(are, -1e-4f), lim = aim;
        const float mag = expf(lre * step), bre = mag * cosf(lim * step), bim = mag * sinf(lim * step), den = lre * lre + lim * lim;
        const float cre = ((bre - 1.0f) * lre + bim * lim) / den, cim = (bim * lre - (bre - 1.0f) * lim) / den;
        const float* br = C.inp(I_S5_BRE, l, 32 * 64 * 16) + (size_t)(g * 64 + p) * 16; const float* bi = C.inp(I_S5_BIM, l, 32 * 64 * 16) + (size_t)(g * 64 + p) * 16;
        for (int c = 0; c < 16; ++c) { BBr[p * 16 + c] = cre * br[c] - cim * bi[c]; BBi[p * 16 + c] = cre * bi[c] + cim * br[c]; }
        float pr = 1.f, pi = 0.f;
        for (int n = 0; n <= 64; ++n) { PW[(n * 64 + p) * 2] = pr; PW[(n * 64 + p) * 2 + 1] = pi; const float nr = pr * bre - pi * bim, ni = pr * bim + pi * bre; pr = nr; pi = ni; }
    }
    for (int i = tid; i < 1024; i += 512) { CR[i] = C.inp(I_S5_CRE, l, 32 * 1024)[g * 1024 + i]; CI[i] = C.inp(I_S5_CIM, l, 32 * 1024)[g * 1024 + i]; }
    __syncthreads();
    unsigned char* S = C.ws + WS_S;
    float* POW = (float*)(S + SO_S5_POW) + (size_t)g * 65 * 128;
    for (int i = tid; i < 65 * 128; i += 512) POW[i] = PW[i];
    bf16* BB = (bf16*)(S + SO_S5_BB) + (size_t)g * 128 * 32;
    for (int i = tid; i < 128 * 32; i += 512) { const int row = i >> 5, c = i & 31, pp = row >> 5, ri = (row >> 4) & 1, p = 16 * pp + (row & 15);
        BB[i] = (bf16)f2bf(c < 16 ? (ri ? BBi[p * 16 + c] : BBr[p * 16 + c]) : 0.f); }
    bf16* PM = (bf16*)(S + SO_S5_PM) + (size_t)g * 64 * 128;
    for (int i = tid; i < 64 * 128; i += 512) { const int t = i >> 7, k = i & 127, ri = k >> 6, p = k & 63;
        PM[i] = (bf16)f2bf(ri ? -PW[((t + 1) * 64 + p) * 2 + 1] : PW[((t + 1) * 64 + p) * 2]); }
    bf16* KM = (bf16*)(S + SO_S5_K) + (size_t)g * 16 * 1024;
    for (int i = tid; i < 16 * 1024; i += 512) { const int cp = i >> 10, k = i & 1023, tau = k >> 4, c = k & 15; float s = 0.f;
        for (int p = 0; p < 64; ++p) { const float cr = CR[cp * 64 + p], ci = CI[cp * 64 + p], pr = PW[(tau * 64 + p) * 2], pi = PW[(tau * 64 + p) * 2 + 1];
            const float wr = cr * pr - ci * pi, wi = cr * pi + ci * pr; s += wr * BBr[p * 16 + c] - wi * BBi[p * 16 + c]; }
        KM[i] = (bf16)f2bf(s); }
    __syncthreads();
}
__device__ __forceinline__ void s5_passA(const Ctx& C, int item) {
    const int bg = item >> 6, c = item & 63, b = bg >> 5, g = bg & 31, rowb = b * SEQ + c * LCH, lane = C.lane, fr = lane & 15, fq = lane >> 4;
    const bf16* Z = (const bf16*)(C.ws + WS_Z); unsigned char* S = C.ws + WS_S;
    LAS bf16* UA = (LAS bf16*)(C.lds + C.wave * 16384);
    {   const u32x4* src = (const u32x4*)(Z + (size_t)(rowb + lane) * ZP + ZB_U + g * 16); const u32x4 z4 = (u32x4){0u, 0u, 0u, 0u};
        LAS u32x4* dst = (LAS u32x4*)(UA + lane * 40); dst[0] = src[0]; dst[1] = src[1]; dst[2] = z4; dst[3] = z4; }
    LDS_WAIT(); __builtin_amdgcn_wave_barrier();
    const bf16* BB = (const bf16*)(S + SO_S5_BB) + (size_t)g * 128 * 32; const float* POW = (const float*)(S + SO_S5_POW) + (size_t)g * 65 * 128;
    float* E = (float*)(S + SO_S5_E) + (size_t)item * 128;
#pragma unroll
    for (int pp = 0; pp < 4; ++pp) { float er = 0.f, ei = 0.f; const int p = 16 * pp + fr;
#pragma unroll
        for (int tt = 0; tt < 4; ++tt) {
            const f32x4 br = tile_mm<32>(UA + (16 * tt) * 40, 40, BB + (size_t)(pp * 32) * 32, 32, F4Z, fr, fq);
            const f32x4 bi = tile_mm<32>(UA + (16 * tt) * 40, 40, BB + (size_t)(pp * 32 + 16) * 32, 32, F4Z, fr, fq);
#pragma unroll
            for (int r = 0; r < 4; ++r) { const int t = 16 * tt + 4 * fq + r; const f32x2 pw = *(const f32x2*)(POW + ((63 - t) * 64 + p) * 2);
                er += pw.x * br[r] - pw.y * bi[r]; ei += pw.x * bi[r] + pw.y * br[r]; }
        }
        er += shx(er, 16, lane); er += shx(er, 32, lane); ei += shx(ei, 16, lane); ei += shx(ei, 32, lane);
        if (fq == 0) { E[p] = er; E[64 + p] = ei; }
    }
    LDS_WAIT(); __builtin_amdgcn_wave_barrier();
}
__device__ __forceinline__ void s5_passB(const Ctx& C) {
    const int idx = C.bid * 512 + C.tid; if (idx >= 8192) return;
    const int bg = idx >> 6, p = idx & 63, g = bg & 31; unsigned char* S = C.ws + WS_S;
    const f32x2 l64 = *(const f32x2*)((const float*)(S + SO_S5_POW) + (size_t)g * 65 * 128 + (64 * 64 + p) * 2);
    float* E = (float*)(S + SO_S5_E) + (size_t)bg * 64 * 128 + p;
    float er[64], ei[64];
#pragma unroll
    for (int c = 0; c < 64; ++c) { er[c] = E[c * 128]; ei[c] = E[c * 128 + 64]; }
    float rr = 0.f, ri = 0.f;
#pragma unroll
    for (int c = 0; c < 64; ++c) { E[c * 128] = rr; E[c * 128 + 64] = ri; const float nr = l64.x * rr - l64.y * ri + er[c], ni = l64.x * ri + l64.y * rr + ei[c]; rr = nr; ri = ni; }
}
__device__ __forceinline__ void s5_passC(const Ctx& C, int l, int item) {
    const int bg = item >> 6, c = item & 63, b = bg >> 5, g = bg & 31, rowb = b * SEQ + c * LCH, lane = C.lane, fr = lane & 15, fq = lane >> 4;
    bf16* Z = (bf16*)(C.ws + WS_Z); unsigned char* S = C.ws + WS_S;
    LAS bf16* UP = (LAS bf16*)(C.lds + C.wave * 16384);
    LAS bf16* WV = UP + 128 * 16;
    {   const u32x4* src = (const u32x4*)(Z + (size_t)(rowb + lane) * ZP + ZB_U + g * 16); const u32x4 z4 = (u32x4){0u, 0u, 0u, 0u};
        LAS u32x4* dz = (LAS u32x4*)(UP + lane * 16); dz[0] = z4; dz[1] = z4; LAS u32x4* dst = (LAS u32x4*)(UP + (64 + lane) * 16); dst[0] = src[0]; dst[1] = src[1]; }
    {   const float* E = (const float*)(S + SO_S5_E) + (size_t)item * 128; const int cp = lane >> 2, pq = lane & 3;
        const float* cr = C.inp(I_S5_CRE, l, 32 * 1024) + (size_t)g * 1024 + cp * 64 + 16 * pq; const float* ci = C.inp(I_S5_CIM, l, 32 * 1024) + (size_t)g * 1024 + cp * 64 + 16 * pq;
#pragma unroll
        for (int j = 0; j < 16; j += 2) { const int p = 16 * pq + j;
            const float a0 = cr[j] * E[p] - ci[j] * E[64 + p], b0 = cr[j] * E[64 + p] + ci[j] * E[p], a1 = cr[j + 1] * E[p + 1] - ci[j + 1] * E[65 + p], b1 = cr[j + 1] * E[65 + p] + ci[j + 1] * E[p + 1];
            *(LAS unsigned*)(WV + cp * 136 + p) = pk2(a0, a1); *(LAS unsigned*)(WV + cp * 136 + 64 + p) = pk2(b0, b1); }
    }
    LDS_WAIT(); __builtin_amdgcn_wave_barrier();
    const bf16* KM = (const bf16*)(S + SO_S5_K) + (size_t)g * 16 * 1024; const bf16* PM = (const bf16*)(S + SO_S5_PM) + (size_t)g * 64 * 128;
    const float* dsk = C.inp(I_S5_D, l, WB) + g * 16;
#pragma unroll
    for (int tt = 0; tt < 4; ++tt) {
        f32x4 acc = F4Z; const int t = 16 * tt + fr;
        for (int ks = 0; ks < 8 * (tt + 1); ++ks) {
            const bf16x8 a = ld8(KM + (size_t)fr * 1024 + 32 * ks + 8 * fq);
            const bf16x8 bb = ld8(UP + (64 + t - 2 * ks - (fq >> 1)) * 16 + 8 * (fq & 1));
            acc = __builtin_amdgcn_mfma_f32_16x16x32_bf16(a, bb, acc, 0, 0, 0);
        }
        acc = tile_mm<128>(WV, 136, PM + (size_t)(16 * tt) * 128, 128, acc, fr, fq);
        float y[4];
#pragma unroll
        for (int r = 0; r < 4; ++r) { const int cp = 4 * fq + r; y[r] = gelu_tanh(acc[r] + dsk[cp] * bf2f(UP[(64 + t) * 16 + cp])); }
        u32x2 o; o.x = pk2(y[0], y[1]); o.y = pk2(y[2], y[3]);
        *(u32x2*)(Z + (size_t)(rowb + t) * ZP + ZB_U + g * 16 + 4 * fq) = o;
    }
    LDS_WAIT(); __builtin_amdgcn_wave_barrier();
}

constexpr size_t SO_RW_PQ = SO_END1;
constexpr size_t SO_RW_RHO = SO_RW_PQ + 32 * MiB;
constexpr size_t SO_RW_HALO = SO_RW_RHO + 512 * 1024;
constexpr size_t SO_RW_W = SO_RW_HALO + 512 * 1024;
constexpr size_t SO_END2 = SO_RW_W + 256 * 1024;
static_assert(WS_S + SO_END2 <= WS_END, "state region");
static_assert(SO_RW_W == RWW_OFF, "RWW_OFF");
__device__ __forceinline__ void shift8(const u32x4 cur, const u32x4 prev, const float* mu, float* o) {
    float a[8], p[8]; unpack8(cur, a); unpack8(prev, p);
#pragma unroll
    for (int j = 0; j < 8; ++j) o[j] = a[j] + mu[j] * (p[j] - a[j]);
}
__device__ __forceinline__ u32x4 pack8(const float* f) { u32x4 w; w.x = pk2(f[0], f[1]); w.y = pk2(f[2], f[3]); w.z = pk2(f[4], f[5]); w.w = pk2(f[6], f[7]); return w; }

__device__ __forceinline__ void rw_passA(const Ctx& C, int l, int item) {
    const int bh = item >> 6, c = item & 63, b = bh >> 3, h = bh & 7, hc0 = h * 64, rowb = b * SEQ + c * LCH;
    bf16* Z = (bf16*)(C.ws + WS_Z); unsigned char* S = C.ws + WS_S;
    LAS unsigned char* L = C.lds;
    LAS bf16* XW = (LAS bf16*)L; LAS bf16* XA = (LAS bf16*)(L + 9216); LAS float* WARG = (LAS float*)(L + 18432);
    LAS bf16* TAB = (LAS bf16*)L; LAS bf16* TAK = (LAS bf16*)(L + 9216); LAS bf16* MRB = (LAS bf16*)(L + 18432); LAS bf16* MRK = (LAS bf16*)(L + 27648);
    LAS float* AARG = (LAS float*)(L + 36864); LAS float* LW = AARG; LAS bf16* XT = (LAS bf16*)(L + 36864);
    LAS bf16* AT = (LAS bf16*)(L + 55296); LAS bf16* RT = (LAS bf16*)(L + 64512); LAS bf16* BT = (LAS bf16*)(L + 73728); LAS bf16* KT = (LAS bf16*)(L + 82944);
    LAS float* RHSV = (LAS float*)(L + 73728);
    LAS bf16* BBT = (LAS bf16*)(L + 92160); LAS bf16* KBT = (LAS bf16*)(L + 101376); LAS bf16* VT = (LAS bf16*)(L + 110592);
    LAS float* CUML = (LAS float*)(L + 119808); LAS float* GL = CUML + 64; LAS float* SEG = GL + 64; LAS float* UPD = SEG;
    const int tid = C.tid, lane = C.lane, w = C.wave, fr = lane & 15, fq = lane >> 4;
    const int t = tid >> 3, c0 = (tid & 7) * 8, row = rowb + t;
    const float* mu = C.inp(I_RW_MU, l, 1792);
    const bf16* HALO = (const bf16*)(S + SO_RW_HALO) + (size_t)(b * 64 + c - 1) * 1024;
    const u32x4 z4 = (u32x4){0u, 0u, 0u, 0u};
    {   float f[8];
        const u32x4 cw = *(const u32x4*)(Z + (size_t)row * ZP + ZD_XW + c0), pw = (c * LCH + t > 0) ? *(const u32x4*)(Z + (size_t)(row - 1) * ZP + ZD_XW + c0) : z4;
        shift8(cw, pw, mu + 1536 + c0, f);
#pragma unroll
        for (int j = 0; j < 8; ++j) f[j] = tanhf(f[j]);
        *(LAS u32x4*)(XW + t * LDT + c0) = pack8(f);
        const u32x4 ca = *(const u32x4*)(Z + (size_t)row * ZP + ZD_XA + c0), pa = (c * LCH + t > 0) ? *(const u32x4*)(Z + (size_t)(row - 1) * ZP + ZD_XA + c0) : z4;
        shift8(ca, pa, mu + 1600 + c0, f);
        *(LAS u32x4*)(XA + t * LDT + c0) = pack8(f);
    }
    __syncthreads();
    {   const bf16* WUP = (const bf16*)(S + SO_RW_W) + (size_t)hc0 * 64; const bf16* AUP = WUP + 512 * 64;
#pragma unroll
        for (int q = 0; q < 2; ++q) { const int id = 2 * w + q, tt = id >> 2, cc = id & 3;
            const f32x4 aw = tile_mm<64>(XW + (16 * tt) * LDT, LDT, WUP + (size_t)(16 * cc) * 64, 64, F4Z, fr, fq);
            const f32x4 aa = tile_mm<64>(XA + (16 * tt) * LDT, LDT, AUP + (size_t)(16 * cc) * 64, 64, F4Z, fr, fq);
#pragma unroll
            for (int r = 0; r < 4; ++r) { WARG[(16 * tt + 4 * fq + r) * 65 + 16 * cc + fr] = aw[r]; AARG[(16 * tt + 4 * fq + r) * 65 + 16 * cc + fr] = aa[r]; } }
    }
    __syncthreads();
    float lw[8], av[8], bv[8], kr[8], rr[8], vv[8];
    {   float kk[8], aa[8];
        const bool first = (c * LCH + t == 0);
        const u32x4 cr = *(const u32x4*)(Z + (size_t)row * ZP + ZD_R + hc0 + c0), ck = *(const u32x4*)(Z + (size_t)row * ZP + ZD_K + hc0 + c0), cv = *(const u32x4*)(Z + (size_t)row * ZP + ZD_V + hc0 + c0);
        u32x4 pr = z4, pk = z4, pv = z4;
        if (!first) { pv = *(const u32x4*)(Z + (size_t)(row - 1) * ZP + ZD_V + hc0 + c0);
            if (t > 0) { pr = *(const u32x4*)(Z + (size_t)(row - 1) * ZP + ZD_R + hc0 + c0); pk = *(const u32x4*)(Z + (size_t)(row - 1) * ZP + ZD_K + hc0 + c0); }
            else { pr = *(const u32x4*)(HALO + hc0 + c0); pk = *(const u32x4*)(HALO + 512 + hc0 + c0); } }
        shift8(cr, pr, mu + hc0 + c0, rr); shift8(ck, pk, mu + 512 + hc0 + c0, kk); shift8(cv, pv, mu + 1024 + hc0 + c0, vv);
        const float* w0 = C.inp(I_RW_W0, l, WB) + hc0 + c0; const float* a0 = C.inp(I_RW_A0, l, WB) + hc0 + c0;
        const float* kkw = C.inp(I_RW_KK, l, WB) + hc0 + c0; const float* kaw = C.inp(I_RW_KA, l, WB) + hc0 + c0; const float* rkw = C.inp(I_RW_RK, l, WB) + hc0 + c0;
        float n2 = 0.f, rho = 0.f;
#pragma unroll
        for (int j = 0; j < 8; ++j) {
            const float wl = -softplusf_(-(WARG[t * 65 + c0 + j] + w0[j])) - 0.5f; lw[j] = -__expf(wl);
            aa[j] = sigmoidf_(AARG[t * 65 + c0 + j] + a0[j]);
            const float kn = kk[j] * kkw[j]; n2 += kn * kn; av[j] = kn;
            kr[j] = kk[j] * (1.0f + (aa[j] - 1.0f) * kaw[j]); rho += rr[j] * kr[j] * rkw[j];
        }
        n2 += shx(n2, 1, lane); n2 += shx(n2, 2, lane); n2 += shx(n2, 4, lane);
        rho += shx(rho, 1, lane); rho += shx(rho, 2, lane); rho += shx(rho, 4, lane);
        const float inv = 1.0f / fmaxf(sqrtf(n2), 1e-12f);
#pragma unroll
        for (int j = 0; j < 8; ++j) { const float kkn = av[j] * inv; av[j] = -kkn; bv[j] = kkn * aa[j]; }
        if ((tid & 7) == 0) ((float*)(S + SO_RW_RHO))[(size_t)row * 8 + h] = rho;
    }
    __syncthreads();
#pragma unroll
    for (int j = 0; j < 8; ++j) LW[t * 64 + c0 + j] = lw[j];
    __syncthreads();
    {   const int cc = tid & 63, seg = tid >> 6; float run = 0.f, v8[8];
#pragma unroll
        for (int i = 0; i < 8; ++i) { run += LW[(seg * 8 + i) * 64 + cc]; v8[i] = run; }
        SEG[seg * 64 + cc] = run;
        __syncthreads();
        float off = 0.f;
        for (int s2 = 0; s2 < seg; ++s2) off += SEG[s2 * 64 + cc];
#pragma unroll
        for (int i = 0; i < 8; ++i) LW[(seg * 8 + i) * 64 + cc] = v8[i] + off;
        if (seg == 7) { CUML[cc] = v8[7] + off; GL[cc] = __expf(v8[7] + off); }
    }
    __syncthreads();
    {   float fa[8], fb[8], fk[8], fr_[8];
#pragma unroll
        for (int j = 0; j < 8; ++j) { const float cm = LW[t * 64 + c0 + j], en = __expf(-cm), el = __expf(CUML[c0 + j] - cm);
            fa[j] = av[j] * __expf(cm - lw[j]); fb[j] = bv[j] * en; fk[j] = kr[j] * en; fr_[j] = rr[j] * __expf(cm);
            BBT[(c0 + j) * LDT + t] = (bf16)f2bf(bv[j] * el); KBT[(c0 + j) * LDT + t] = (bf16)f2bf(kr[j] * el); VT[(c0 + j) * LDT + t] = (bf16)f2bf(vv[j]); }
        *(LAS u32x4*)(AT + t * LDT + c0) = pack8(fa); *(LAS u32x4*)(BT + t * LDT + c0) = pack8(fb); *(LAS u32x4*)(KT + t * LDT + c0) = pack8(fk); *(LAS u32x4*)(RT + t * LDT + c0) = pack8(fr_);
    }
    __syncthreads();
#pragma unroll
    for (int q = 0; q < 2; ++q) { const int id = 2 * w + q, tt = id >> 2, ss = id & 3; f32x4 ab = F4Z, ak = F4Z, rb = F4Z, rk = F4Z;
        if (ss <= tt) {
            ab = tile_mm<64>(BT + (16 * ss) * LDT, LDT, AT + (16 * tt) * LDT, LDT, ab, fr, fq); ak = tile_mm<64>(KT + (16 * ss) * LDT, LDT, AT + (16 * tt) * LDT, LDT, ak, fr, fq);
            rb = tile_mm<64>(BT + (16 * ss) * LDT, LDT, RT + (16 * tt) * LDT, LDT, rb, fr, fq); rk = tile_mm<64>(KT + (16 * ss) * LDT, LDT, RT + (16 * tt) * LDT, LDT, rk, fr, fq);
        }
        const int tq = 16 * tt + fr, s0 = 16 * ss + 4 * fq;
#pragma unroll
        for (int r = 0; r < 4; ++r) { if (s0 + r >= tq) { ab[r] = 0.f; ak[r] = 0.f; } if (s0 + r > tq) { rb[r] = 0.f; rk[r] = 0.f; } }
        *(LAS u32x2*)(TAB + tq * LDT + s0) = pack4(ab); *(LAS u32x2*)(TAK + tq * LDT + s0) = pack4(ak); *(LAS u32x2*)(MRB + tq * LDT + s0) = pack4(rb); *(LAS u32x2*)(MRK + tq * LDT + s0) = pack4(rk);
    }
    __syncthreads();
#pragma unroll
    for (int q = 0; q < 2; ++q) { const int id = 2 * w + q, vb = id >> 2, tt = id & 3;
        const f32x4 a = tile_mm<64>(VT + (16 * vb) * LDT, LDT, TAK + (16 * tt) * LDT, LDT, F4Z, fr, fq);
#pragma unroll
        for (int r = 0; r < 4; ++r) RHSV[(16 * vb + 4 * fq + r) * 65 + 16 * tt + fr] = a[r]; }
    for (int i = tid; i < 128 * LDT / 8; i += 512) ((LAS u32x4*)XT)[i] = z4;
    __syncthreads();
#pragma unroll
    for (int bi = 0; bi < 4; ++bi) {
        if (bi > 0) {
            const f32x4 u = tile_mm<64>(XT + (16 * w) * LDT, LDT, TAB + (16 * bi) * LDT, LDT, F4Z, fr, fq);
#pragma unroll
            for (int r = 0; r < 4; ++r) UPD[(16 * w + 4 * fq + r) * 17 + fr] = u[r];
            __syncthreads();
        }
        if (tid < 128) { const int col = tid; float x[16];
#pragma unroll
            for (int i = 0; i < 16; ++i) { const int tr = 16 * bi + i;
                float s = (col < 64) ? bf2f(AT[tr * LDT + col]) : RHSV[(col - 64) * 65 + tr];
                if (bi > 0) s += UPD[col * 17 + i];
                float tf[16];
                if (i > 0) unpack8(*(const LAS u32x4*)(TAB + tr * LDT + 16 * bi), tf);
                if (i > 8) unpack8(*(const LAS u32x4*)(TAB + tr * LDT + 16 * bi + 8), tf + 8);
#pragma unroll
                for (int i2 = 0; i2 < i; ++i2) s += tf[i2] * x[i2];
                x[i] = s; asm volatile("" ::: "memory"); }
            *(LAS u32x4*)(XT + col * LDT + 16 * bi) = pack8(x); *(LAS u32x4*)(XT + col * LDT + 16 * bi + 8) = pack8(x + 8);
        }
        __syncthreads();
    }
    bf16* PQ = (bf16*)(S + SO_RW_PQ) + (size_t)item * 8192;
#pragma unroll
    for (int q = 0; q < 2; ++q) { const int id = 2 * w + q, ib = id >> 2, jb = id & 3;
        {
            f32x4 a = tile_mm<64>(XT + (16 * ib) * LDT, LDT, MRB + (16 * jb) * LDT, LDT, F4Z, fr, fq);
            const int tq = 16 * jb + fr, j0 = 16 * ib + 4 * fq; const u32x2 rt = *(const LAS u32x2*)(RT + tq * LDT + j0);
            a[0] += bflo(rt.x); a[1] += bfhi(rt.x); a[2] += bflo(rt.y); a[3] += bfhi(rt.y);
            *(u32x2*)(Z + (size_t)(rowb + tq) * ZP + ZD_R + hc0 + j0) = pack4(a); }
        {
            f32x4 a = tile_mm<64>(XT + (64 + 16 * ib) * LDT, LDT, MRB + (16 * jb) * LDT, LDT, F4Z, fr, fq);
            a = tile_mm<64>(VT + (16 * ib) * LDT, LDT, MRK + (16 * jb) * LDT, LDT, a, fr, fq);
            *(u32x2*)(Z + (size_t)(rowb + 16 * jb + fr) * ZP + ZD_K + hc0 + 16 * ib + 4 * fq) = pack4(a); }
        {
            f32x4 a = tile_mm<64>(XT + (16 * ib) * LDT, LDT, BBT + (16 * jb) * LDT, LDT, F4Z, fr, fq);
            const int k = 16 * jb + fr, j0 = 16 * ib + 4 * fq;
#pragma unroll
            for (int r = 0; r < 4; ++r) if (j0 + r == k) a[r] += GL[k];
            *(u32x2*)(PQ + (size_t)k * 64 + j0) = pack4(a); }
        {
            f32x4 a = tile_mm<64>(BBT + (16 * ib) * LDT, LDT, XT + (64 + 16 * jb) * LDT, LDT, F4Z, fr, fq);
            a = tile_mm<64>(KBT + (16 * ib) * LDT, LDT, VT + (16 * jb) * LDT, LDT, a, fr, fq);
            *(u32x2*)(PQ + 4096 + (size_t)(16 * jb + fr) * 64 + 16 * ib + 4 * fq) = pack4(a); }
    }
    __syncthreads();
}
__device__ __forceinline__ void rw_passB(const Ctx& C, int unit) {
    const int bh = unit >> 2, vg = unit & 3, lane = C.lane, fr = lane & 15, fq = lane >> 4;
    LAS bf16* SL = (LAS bf16*)(C.lds + C.wave * 16384);
    bf16* PQ0 = (bf16*)(C.ws + WS_S + SO_RW_PQ) + (size_t)bh * 64 * 8192;
    for (int i = lane; i < 16 * LDT / 8; i += 64) ((LAS u32x4*)SL)[i] = (u32x4){0u, 0u, 0u, 0u};
    LDS_WAIT(); __builtin_amdgcn_wave_barrier();
    bf16x8 pa[4][2], pn[4][2]; u32x2 qa[4], qn[4];
    {   const bf16* P = PQ0; const bf16* QT = P + 4096 + (size_t)(16 * vg) * 64;
#pragma unroll
        for (int kk = 0; kk < 4; ++kk) { pa[kk][0] = ld8(P + (size_t)(16 * kk + fr) * 64 + 8 * fq); pa[kk][1] = ld8(P + (size_t)(16 * kk + fr) * 64 + 32 + 8 * fq); qa[kk] = *(const u32x2*)(QT + (size_t)fr * 64 + 16 * kk + 4 * fq); } }
    for (int c = 0; c < 64; ++c) {
        bf16* QT = PQ0 + (size_t)c * 8192 + 4096 + (size_t)(16 * vg) * 64;
        {   const int cn = (c < 63) ? c + 1 : c; const bf16* P = PQ0 + (size_t)cn * 8192; const bf16* QN = P + 4096 + (size_t)(16 * vg) * 64;
#pragma unroll
            for (int kk = 0; kk < 4; ++kk) { pn[kk][0] = ld8(P + (size_t)(16 * kk + fr) * 64 + 8 * fq); pn[kk][1] = ld8(P + (size_t)(16 * kk + fr) * 64 + 32 + 8 * fq); qn[kk] = *(const u32x2*)(QN + (size_t)fr * 64 + 16 * kk + 4 * fq); } }
        const bf16x8 b0 = ld8(SL + fr * LDT + 8 * fq), b1 = ld8(SL + fr * LDT + 32 + 8 * fq);
        const u32x4 s0 = *(const LAS u32x4*)(SL + (lane >> 2) * LDT + (lane & 3) * 16), s1 = *(const LAS u32x4*)(SL + (lane >> 2) * LDT + (lane & 3) * 16 + 8);
        f32x4 acc[4];
#pragma unroll
        for (int kk = 0; kk < 4; ++kk) {
            f32x4 a; a[0] = bflo(qa[kk].x); a[1] = bfhi(qa[kk].x); a[2] = bflo(qa[kk].y); a[3] = bfhi(qa[kk].y);
            a = __builtin_amdgcn_mfma_f32_16x16x32_bf16(pa[kk][0], b0, a, 0, 0, 0);
            acc[kk] = __builtin_amdgcn_mfma_f32_16x16x32_bf16(pa[kk][1], b1, a, 0, 0, 0);
        }
        LDS_WAIT(); __builtin_amdgcn_wave_barrier();
        *(u32x4*)(QT + (size_t)(lane >> 2) * 64 + (lane & 3) * 16) = s0; *(u32x4*)(QT + (size_t)(lane >> 2) * 64 + (lane & 3) * 16 + 8) = s1;
#pragma unroll
        for (int kk = 0; kk < 4; ++kk) *(LAS u32x2*)(SL + fr * LDT + 16 * kk + 4 * fq) = pack4(acc[kk]);
        LDS_WAIT(); __builtin_amdgcn_wave_barrier();
#pragma unroll
        for (int kk = 0; kk < 4; ++kk) { pa[kk][0] = pn[kk][0]; pa[kk][1] = pn[kk][1]; qa[kk] = qn[kk]; }
    }
}
__device__ __forceinline__ void rw_passC(const Ctx& C, int l, int item) {
    const int bh = item >> 6, c = item & 63, b = bh >> 3, h = bh & 7, hc0 = h * 64, rowb = b * SEQ + c * LCH;
    bf16* Z = (bf16*)(C.ws + WS_Z); unsigned char* S = C.ws + WS_S;
    const int grp = C.wave >> 2, tt = C.wave & 3, lane = C.lane, fr = lane & 15, fq = lane >> 4, t = 16 * tt + fr, row = rowb + t;
    LAS bf16* XG = (LAS bf16*)(C.lds + grp * 32768 + tt * 4608);
    const float* mu = C.inp(I_RW_MU, l, 1792); const u32x4 z4 = (u32x4){0u, 0u, 0u, 0u};
    {
        const int tl = lane >> 2, rw = rowb + 16 * tt + tl; const bool first = (c * LCH + 16 * tt + tl == 0);
#pragma unroll
        for (int q = 0; q < 4; ++q) { const int j0 = (lane & 3) * 32 + q * 8; float f[8];
            const u32x4 cg = *(const u32x4*)(Z + (size_t)rw * ZP + ZD_XG + j0), pg = first ? z4 : *(const u32x4*)(Z + (size_t)(rw - 1) * ZP + ZD_XG + j0);
            shift8(cg, pg, mu + 1664 + j0, f);
#pragma unroll
            for (int j = 0; j < 8; ++j) f[j] = sigmoidf_(f[j]);
            *(LAS u32x4*)(XG + tl * 136 + j0) = pack8(f); }
    }
    LDS_WAIT(); __builtin_amdgcn_wave_barrier();
    const bf16* SST = (const bf16*)(S + SO_RW_PQ) + (size_t)item * 8192 + 4096;
    const bf16* GUP = (const bf16*)(S + SO_RW_W) + 2 * 512 * 64 + (size_t)hc0 * 128;
    f32x4 y[4], g[4];
#pragma unroll
    for (int vb = 0; vb < 4; ++vb) {
        y[vb] = tile_mm<64>(SST + (size_t)(16 * vb) * 64, 64, Z + (size_t)(rowb + 16 * tt) * ZP + ZD_R + hc0, ZP, F4Z, fr, fq);
        const u32x2 yl = *(const u32x2*)(Z + (size_t)row * ZP + ZD_K + hc0 + 16 * vb + 4 * fq);
        y[vb][0] += bflo(yl.x); y[vb][1] += bfhi(yl.x); y[vb][2] += bflo(yl.y); y[vb][3] += bfhi(yl.y);
        g[vb] = tile_mm<128>(GUP + (size_t)(16 * vb) * 128, 128, XG, 136, F4Z, fr, fq);
    }
    float s1 = 0.f;
#pragma unroll
    for (int vb = 0; vb < 4; ++vb) s1 += (y[vb][0] + y[vb][1]) + (y[vb][2] + y[vb][3]);
    s1 += shx(s1, 16, lane); s1 += shx(s1, 32, lane);
    const float mean = s1 * (1.0f / 64); float s2 = 0.f;
#pragma unroll
    for (int vb = 0; vb < 4; ++vb)
#pragma unroll
        for (int r = 0; r < 4; ++r) { const float d = y[vb][r] - mean; y[vb][r] = d; s2 += d * d; }
    s2 += shx(s2, 16, lane); s2 += shx(s2, 32, lane);
    const float rs = 1.0f / sqrtf(s2 * (1.0f / 64) + 64e-5f);
    const float rho = ((const float*)(S + SO_RW_RHO))[(size_t)row * 8 + h];
    const bool first = (c * LCH + t == 0);
#pragma unroll
    for (int vb = 0; vb < 4; ++vb) { const int v0 = 16 * vb + 4 * fq;
        const u32x2 cv = *(const u32x2*)(Z + (size_t)row * ZP + ZD_V + hc0 + v0); u32x2 pv; pv.x = 0u; pv.y = 0u;
        if (!first) pv = *(const u32x2*)(Z + (size_t)(row - 1) * ZP + ZD_V + hc0 + v0);
        const float cvf[4] = {bflo(cv.x), bfhi(cv.x), bflo(cv.y), bfhi(cv.y)}, pvf[4] = {bflo(pv.x), bfhi(pv.x), bflo(pv.y), bfhi(pv.y)};
        const float* gn = C.inp(I_RW_NORM, l, WB) + hc0 + v0; const float* mv = mu + 1024 + hc0 + v0; f32x4 o;
#pragma unroll
        for (int r = 0; r < 4; ++r) { const float vs = cvf[r] + mv[r] * (pvf[r] - cvf[r]); o[r] = (y[vb][r] * rs * gn[r] + rho * vs) * g[vb][r]; }
        y[vb] = o; }
    asm volatile("s_waitcnt vmcnt(0)" ::: "memory"); __builtin_amdgcn_wave_barrier();
#pragma unroll
    for (int vb = 0; vb < 4; ++vb) *(u32x2*)(Z + (size_t)row * ZP + ZD_R + hc0 + 16 * vb + 4 * fq) = pack4(y[vb]);
    LDS_WAIT(); __builtin_amdgcn_wave_barrier();
}
template <class Epi, bool ALIGN> __device__ __forceinline__ void run_gemm(const Ctx& C, const bf16* A, int lda, const bf16* Bt, int ldb, int Mr, int N, int K, const Epi& E, int Gv = 0, int cv = 0) {
    if (Gv == 0) { Gv = C.G; cv = C.bid; }
    if (cv < 0 || cv >= Gv) return;
    pg8::Gemm g{A, Bt, Mr, N, K, lda, ldb}; pg8::StaticOrder S; S.init(Mr, N, Gv, cv);
    pg8::gemm_phase<Epi, pg8::StaticOrder, ALIGN, true>(C.lds, g, S, E);
}

#define GRID_BAR() do { const Ctx Cb = make_ctx(); XcdBarrier b_; b_.bar = (unsigned*)(Cb.ws + WS_CTL) + 4096; b_.x = xb_xcc_id(); b_.st = (volatile LAS unsigned*)(Cb.lds + MISC_OFF) + 8; xcd_barrier(b_); } while (0)
#define PHASE_CTX() const Ctx C = make_ctx(); unsigned char* const ws = C.ws; bf16* const XB = (bf16*)(ws + WS_XB); float* const SSQ = (float*)(ws + WS_SSQ); bf16* const Z = (bf16*)(ws + WS_Z); \
    const int gw = C.bid * 8 + C.wave, NGW = C.G * 8; (void)XB; (void)SSQ; (void)Z; (void)gw; (void)NGW
#ifndef STOP_AFTER
#define STOP_AFTER 1000
#endif
#define PH_ON(n) ((l) * 20 + (n) <= STOP_AFTER)
template <int l> __device__ __forceinline__ void layer_fwd() {
        if (PH_ON(1)) {   PHASE_CTX();
            if (l > 0) { run_conv(C, CJ_D1, l, gw, NGW); __syncthreads(); }
            { EpiSwiglu E{(bf16*)(ws + WS_HID), SSQ}; run_gemm<EpiSwiglu, true>(C, XB, D, (const bf16*)(ws + WS_SLOTA), D, M, 2 * FF, D, E); }
            if (l == 0) {
                for (int q = 0; q < DEPTH; ++q) { EpiKV E{(bf16*)(ws + WS_KV + (size_t)q * 4 * MiB), (bf16*)(ws + WS_KV + (size_t)q * 4 * MiB + 2 * MiB), (const float*)(ws + WS_MEMR)};
                    run_gemm<EpiKV, true>(C, (const bf16*)(ws + WS_MEMB), D, (const bf16*)(ws + WS_S + (size_t)q * 4 * MiB), D, MMEM, 2 * D, D, E, 32, C.bid - 128 - 32 * q); }
            }
        }
        GRID_BAR();
        if (PH_ON(2)) {   PHASE_CTX();
            run_conv(C, CJ_GATES, l, gw, NGW); __syncthreads();
            { EpiResid E{C.X, XB, SSQ, 0.5f}; run_gemm<EpiResid, false>(C, (const bf16*)(ws + WS_HID), FF, (const bf16*)(ws + WS_SLOTC), FF, M, D, FF, E); }
        }
        GRID_BAR();
        if (PH_ON(3)) {   PHASE_CTX();
            run_conv(C, CJ_PROJ, l, gw, NGW); run_conv(C, CJ_MLW, l, gw, NGW); run_conv(C, CJ_RWW, l, gw, NGW); __syncthreads();
            if (C.bid < 32) s5_prep(C, l, C.bid);
            { EpiZ E{Z, SSQ, (bf16*)(ws + WS_S + RWW_OFF - 512 * 1024)}; run_gemm<EpiZ, true>(C, XB, D, (const bf16*)(ws + WS_SLOTB), D, M, NINP, D, E); }
        }
        GRID_BAR();
        if (PH_ON(4)) {   PHASE_CTX();
            run_conv(C, CJ_XW, l, gw, NGW); __syncthreads();
            for (int it = blockIdx.x; it < 2048; it += gridDim.x) { const Ctx Ci = make_ctx(); rw_passA(Ci, l, it); }
        }
        if (PH_ON(4)) {   PHASE_CTX();
            for (int it = blockIdx.x; it < 1024; it += gridDim.x) { const Ctx Ci = make_ctx(); ml_passA(Ci, l, it); }
        }
        if (PH_ON(4)) {   PHASE_CTX();
            for (int it = blockIdx.x; it < 1024; it += gridDim.x) { const Ctx Ci = make_ctx(); gla_passA(Ci, l, it); }
            for (int it = gw; it < 8192; it += NGW) { const Ctx Ci = make_ctx(); s5_passA(Ci, it); }
        }
        GRID_BAR();
        if (PH_ON(4)) {   PHASE_CTX();
            if ((gw & 15) == 0 && (gw >> 4) < 128) rw_passB(C, gw >> 4);
        }
        if (PH_ON(4)) {   PHASE_CTX();
            ml_passB(C);
        }
        if (PH_ON(4)) {   PHASE_CTX();
            gla_passB(C);
        }
        if (PH_ON(4)) {   PHASE_CTX();
            s5_passB(C);
        }
        GRID_BAR();
        if (PH_ON(4)) {   PHASE_CTX();
            for (int it = C.bid * 2 + (C.wave >> 2); it < 2048; it += C.G * 2) { const Ctx Ci = make_ctx(); rw_passC(Ci, l, it); }
        }
        __syncthreads();
        if (PH_ON(4)) {   PHASE_CTX();
            for (int it = blockIdx.x; it < 1024; it += gridDim.x) { const Ctx Ci = make_ctx(); ml_passC(Ci, l, it); }
        }
        if (PH_ON(4)) {   PHASE_CTX();
            for (int it = blockIdx.x; it < 1024; it += gridDim.x) { const Ctx Ci = make_ctx(); gla_passC(Ci, l, it); }
        }
        if (PH_ON(4)) {   PHASE_CTX();
            for (int it = gw; it < 8192; it += NGW) { const Ctx Ci = make_ctx(); s5_passC(Ci, l, it); }
        }
        GRID_BAR();
#define SUBSYNC() do { VM_WAIT(); __syncthreads(); } while (0)
#define MERGE_PTRS() bf16* const GT = (bf16*)(ws + WS_GT); float* const MF = (float*)(ws + WS_MF); const bf16* const WG = (const bf16*)(ws + WS_SLOTA); const bf16* const WP = (const bf16*)(ws + WS_SLOTC); \
    const float* const gb = C.inp(I_GATE_BIAS, l, 4 * D); (void)GT; (void)MF; (void)WG; (void)WP; (void)gb
        if (PH_ON(5)) { PHASE_CTX(); MERGE_PTRS(); EpiGate<0> E{GT, SSQ, gb}; run_gemm<EpiGate<0>, false>(C, XB, D, WG, D, M, D, D, E); } SUBSYNC();
        if (PH_ON(5)) { PHASE_CTX(); MERGE_PTRS(); EpiMerge<0> E{GT, MF}; run_gemm<EpiMerge<0>, false>(C, Z + ZA_O, ZP, WP, WB, M, D, WB, E); } SUBSYNC();
        if (PH_ON(5)) { PHASE_CTX(); MERGE_PTRS(); EpiGate<1> E{GT, SSQ, gb}; run_gemm<EpiGate<1>, false>(C, Z + ZB_U, ZP, WP + 2 * (size_t)D * WB, WB, M, D, WB, E); } SUBSYNC();
        if (PH_ON(5)) { PHASE_CTX(); MERGE_PTRS(); EpiGate<2> E{GT, SSQ, gb + D}; run_gemm<EpiGate<2>, false>(C, XB, D, WG + (size_t)D * D, D, M, D, D, E); } SUBSYNC();
        if (PH_ON(5)) { PHASE_CTX(); MERGE_PTRS(); EpiMerge<1> E{GT, MF}; run_gemm<EpiMerge<1>, false>(C, Z + ZB_U, ZP, WP + (size_t)D * WB, WB, M, D, WB, E); } SUBSYNC();
        if (PH_ON(5)) { PHASE_CTX(); MERGE_PTRS(); EpiGate<0> E{GT, SSQ, gb + 2 * D}; run_gemm<EpiGate<0>, false>(C, XB, D, WG + 2 * (size_t)D * D, D, M, D, D, E); } SUBSYNC();
        if (PH_ON(5)) { PHASE_CTX(); MERGE_PTRS(); EpiMerge<1> E{GT, MF}; run_gemm<EpiMerge<1>, false>(C, Z + ZC_G, ZP, WP + 3 * (size_t)D * WB, WB, M, D, WB, E); } SUBSYNC();
        if (PH_ON(5)) { PHASE_CTX(); MERGE_PTRS(); EpiGate<0> E{GT, SSQ, gb + 3 * D}; run_gemm<EpiGate<0>, false>(C, XB, D, WG + 3 * (size_t)D * D, D, M, D, D, E); } SUBSYNC();
        if (PH_ON(5)) { PHASE_CTX(); MERGE_PTRS(); EpiMerge<2> E{GT, MF}; run_gemm<EpiMerge<2>, false>(C, Z + ZD_R, ZP, WP + 4 * (size_t)D * WB, WB, M, D, WB, E); }
        GRID_BAR();
        if (PH_ON(6)) {   PHASE_CTX();
            run_conv(C, CJ_GU2, l, gw, NGW); run_conv(C, CJ_D2, l, gw, NGW); __syncthreads();
            { EpiResid E{C.X, XB, SSQ, 1.0f}; run_gemm<EpiResid, false>(C, (const bf16*)(ws + WS_GT), D, (const bf16*)(ws + WS_SLOTB), D, M, D, D, E); }
        }
        GRID_BAR();
        if (PH_ON(7)) {   PHASE_CTX();
            EpiBf16 E{(bf16*)(ws + WS_XQ), D, SSQ, 0.0625f * 1.4426950408889634f, D}; run_gemm<EpiBf16, false>(C, XB, D, (const bf16*)(ws + WS_SLOTB + 2 * MiB), D, M, D, D, E);
        }
        GRID_BAR();
        {
            const int un = blockIdx.x; const int pm = un >> 2, hh = un & 3, bb = pm >> 4;
            if (PH_ON(8)) {   PHASE_CTX();
                const bf16* Q = (const bf16*)(ws + WS_XQ) + (size_t)pm * 256 * D + hh * 256;
                const bf16* Kd = (const bf16*)(ws + WS_KV + (size_t)l * 4 * MiB) + (size_t)bb * 256 * D + hh * 256;
                bf16* P = (bf16*)(ws + WS_XP) + (size_t)C.bid * 65536;
                pg8::Gemm g{Q, Kd, 256, 256, 256, D, D}; pg8::SingleUnit S; EpiSoftmaxP E{P}; pg8::gemm_phase<EpiSoftmaxP, pg8::SingleUnit, false, true>(C.lds, g, S, E);
            }
            SUBSYNC();
            if (PH_ON(8)) {   PHASE_CTX();
                const bf16* VT = (const bf16*)(ws + WS_KV + (size_t)l * 4 * MiB + 2 * MiB) + (size_t)hh * 256 * MMEM + bb * 256;
                const bf16* P = (const bf16*)(ws + WS_XP) + (size_t)C.bid * 65536;
                pg8::Gemm g{P, VT, 256, 256, 256, 256, MMEM}; pg8::SingleUnit S; EpiBf16 E{(bf16*)(ws + WS_XO) + (size_t)pm * 256 * D + hh * 256, D, nullptr, 1.0f, 256};
                pg8::gemm_phase<EpiBf16, pg8::SingleUnit, false, true>(C.lds, g, S, E);
            }
            SUBSYNC();
        }
        GRID_BAR();
        if (PH_ON(9)) {   PHASE_CTX();
            EpiResid E{C.X, XB, SSQ, 1.0f}; run_gemm<EpiResid, false>(C, (const bf16*)(ws + WS_XO), D, (const bf16*)(ws + WS_SLOTB + 4 * MiB), D, M, D, D, E);
        }
        GRID_BAR();
        if (PH_ON(10)) {   PHASE_CTX();
            if (l + 1 < DEPTH) { run_conv(C, CJ_WIN, l + 1, gw, NGW); __syncthreads(); }
            { EpiSwiglu E{(bf16*)(ws + WS_HID), SSQ}; run_gemm<EpiSwiglu, true>(C, XB, D, (const bf16*)(ws + WS_SLOTA), D, M, 2 * FF, D, E); }
        }
        GRID_BAR();
        if (PH_ON(11)) {   PHASE_CTX();
            if (l + 1 < DEPTH) { run_conv(C, CJ_GU1, l + 1, gw, NGW); __syncthreads(); }
            { EpiResid E{C.X, XB, SSQ, 0.5f}; run_gemm<EpiResid, false>(C, (const bf16*)(ws + WS_HID), FF, (const bf16*)(ws + WS_SLOTC), FF, M, D, FF, E); }
        }
        GRID_BAR();
    }

__global__ void __launch_bounds__(512, 2) fwd_kernel(Args args) {
    extern __shared__ __attribute__((aligned(16))) unsigned char lds_raw[];
    (void)args;
    {
        const Ctx C = make_ctx();
        volatile LAS unsigned* MISC = (volatile LAS unsigned*)(C.lds + MISC_OFF);
        for (int u = C.tid; u < (LDS_BYTES - RING_BYTES) / 4; u += 512) ((LAS unsigned*)(C.lds + RING_BYTES))[u] = 0u;
        __syncthreads();
        (void)xcd_barrier_post((unsigned*)(C.ws + WS_CTL) + 4096, MISC + 8);
    }

    {   PHASE_CTX();
        pro_rows(C);
        run_conv(C, CJ_GU1, 0, gw, NGW); run_conv(C, CJ_D1, 0, gw, NGW); run_conv(C, CJ_WIN, 0, gw, NGW); run_conv(C, CJ_XKV, 0, gw, NGW); run_conv(C, CJ_XKV, 1, gw, NGW);
    }
    GRID_BAR();

    layer_fwd<0>();
    layer_fwd<1>();
    {   PHASE_CTX();
        final_rows(C);
        if (xb_ld((unsigned*)(ws + WS_CTL) + 4096 + XB_TMO) != 0u) {
            for (size_t i = (size_t)C.bid * 512 + C.tid; i < (size_t)M * D; i += (size_t)C.G * 512) C.X[i] = __builtin_nanf("");
        }
    }
}

extern "C" void kernel_launch(void* const* d_in, const int* in_sizes, int n_in, void* d_out, int out_size, void* d_ws, size_t ws_size, hipStream_t stream) {
    static int grid = 0;
    if (grid == 0) {
        if (n_in != N_INPUTS || out_size != M * D || ws_size < WS_END) { fprintf(stderr, "kernel_launch: unexpected shapes: n_in %d out %d ws %zu (need %zu)\n", n_in, out_size, ws_size, (size_t)WS_END); grid = -1; return; }
        int dev = 0, cus = 0, per_cu = 0;
        if (hipGetDevice(&dev) != hipSuccess || hipDeviceGetAttribute(&cus, hipDeviceAttributeMultiprocessorCount, dev) != hipSuccess) { grid = -1; return; }
        if (hipFuncSetAttribute((const void*)fwd_kernel, hipFuncAttributeMaxDynamicSharedMemorySize, LDS_BYTES) != hipSuccess) { fprintf(stderr, "kernel_launch: hipFuncSetAttribute failed\n"); grid = -1; return; }
        if (hipOccupancyMaxActiveBlocksPerMultiprocessor(&per_cu, (const void*)fwd_kernel, 512, LDS_BYTES) != hipSuccess || per_cu < 1) { fprintf(stderr, "kernel_launch: occupancy query says %d workgroups per CU\n", per_cu); (void)hipGetLastError(); grid = -1; return; }
        if (cus < 256) { fprintf(stderr, "kernel_launch: built for a 256-CU device (got %d)\n", cus); grid = -1; return; }
        grid = 256;
    }
    if (grid < 0) return;
    if (hipMemsetAsync((char*)d_ws + WS_CTL, 0, CTL_ZERO_BYTES, stream) != hipSuccess) return;
    Args a{};
    for (int i = 0; i < N_INPUTS; ++i) a.in[i] = (const float*)d_in[i];
    a.out = (float*)d_out; a.ws = (unsigned char*)d_ws;
    hipLaunchKernelGGL(fwd_kernel, dim3(grid), dim3(512), LDS_BYTES, stream, a);
}
```

```cpp
#include <hip/hip_runtime.h>
#include <cstdio>
#include <cstdint>

#define LAS __attribute__((address_space(3)))
#define GAS __attribute__((address_space(1)))
typedef unsigned short bf16;
typedef float f32x4 __attribute__((ext_vector_type(4)));
typedef float f32x2 __attribute__((ext_vector_type(2)));
typedef unsigned u32x4 __attribute__((ext_vector_type(4)));
typedef unsigned u32x2 __attribute__((ext_vector_type(2)));
typedef short bf16x8 __attribute__((ext_vector_type(8)));

constexpr int NB = 4, SEQ = 4096, M = NB * SEQ, D = 1024, FF = 2816, WB = 512, DEPTH = 2, MEML = 256, MMEM = NB * MEML;
constexpr int NZ = 4888, ZP = 4896, NINP = 5120, NIN = 8984;
constexpr int ZA_U = 0, ZA_O = 512, ZA_I = 1024, ZA_F = 1028, ZB_U = 1032, ZC_Q = 1544, ZC_K = 1800, ZC_V = 2056, ZC_G = 2568, ZC_A = 3080;
constexpr int ZD_R = 3096, ZD_K = 3608, ZD_V = 4120, ZD_XW = 4632, ZD_XA = 4696, ZD_XG = 4760, ZG = 4888;
constexpr float NORM_EPS = 1e-6f;

enum { I_X = 0, I_MEM, I_FFN1_NORM, I_FFN1_WG, I_FFN1_WU, I_FFN1_WD, I_MIX_NORM, I_W_IN, I_GATE_BIAS, I_ML_CONV, I_ML_WQ, I_ML_WK, I_ML_WV, I_ML_BI, I_ML_BF,
       I_ML_NORM, I_ML_PROJ, I_S5_ARE, I_S5_AIM, I_S5_LOGSTEP, I_S5_BRE, I_S5_BIM, I_S5_CRE, I_S5_CIM, I_S5_D, I_S5_W1, I_S5_W2, I_GLA_AUP, I_GLA_ABIAS,
       I_GLA_NORM, I_GLA_PROJ, I_RW_MU, I_RW_W0, I_RW_WUP, I_RW_A0, I_RW_AUP, I_RW_GUP, I_RW_KK, I_RW_KA, I_RW_RK, I_RW_NORM, I_RW_PROJ, I_W_OUT,
       I_XA_NORM, I_MEM_NORM, I_XA_WQ, I_XA_WK, I_XA_WV, I_XA_WO, I_FFN2_NORM, I_FFN2_WG, I_FFN2_WU, I_FFN2_WD, I_FINAL_NORM, N_INPUTS };

constexpr size_t MiB = 1u << 20;
constexpr size_t WS_CTL = 0, CTL_ZERO_BYTES = 64 * 1024;
constexpr size_t WS_SSQ = 1 * MiB;
constexpr size_t WS_MEMR = 256 * 1024;
constexpr size_t WS_XB = 2 * MiB;
constexpr size_t WS_MEMB = 34 * MiB;
constexpr size_t WS_KV = 36 * MiB;
constexpr size_t WS_SLOTA = 44 * MiB;
constexpr size_t WS_SLOTB = 55 * MiB;
constexpr size_t WS_SLOTC = 65 * MiB;
constexpr size_t WS_Z = 73 * MiB;
constexpr size_t Z_BYTES = (size_t)M * ZP * 2;
constexpr size_t WS_S = WS_Z + Z_BYTES;
constexpr size_t WS_END = 350110016;
static_assert(WS_S == 226 * MiB, "map");
constexpr size_t S_BYTES = WS_END - WS_S;
constexpr size_t WS_HID = WS_Z;
constexpr size_t WS_XQ = WS_Z, WS_XO = WS_Z + 32 * MiB, WS_XP = WS_Z + 64 * MiB;
constexpr size_t WS_G8 = WS_S, WS_MF = WS_S + 64 * MiB;
static_assert(WS_MF + 32 * MiB <= WS_END, "merge stash");

constexpr int LDS_BYTES = 147456, RING_BYTES = 131072, MISC_OFF = RING_BYTES + 320;

#define RLX_AGENT __ATOMIC_RELAXED, __HIP_MEMORY_SCOPE_AGENT
#define LDS_WAIT() asm volatile("s_waitcnt lgkmcnt(0)" ::: "memory")
#define VM_WAIT() asm volatile("s_waitcnt vmcnt(0)" ::: "memory")
__device__ __forceinline__ unsigned f2bf(float f) { unsigned u = __builtin_bit_cast(unsigned, f); return (u + 0x7fffu + ((u >> 16) & 1u)) >> 16; }
__device__ __forceinline__ unsigned pk2(float lo, float hi) { return f2bf(lo) | (f2bf(hi) << 16); }
__device__ __forceinline__ float bf2f(unsigned h) { return __builtin_bit_cast(float, h << 16); }
__device__ __forceinline__ float bflo(unsigned w) { return __builtin_bit_cast(float, w << 16); }
__device__ __forceinline__ float bfhi(unsigned w) { return __builtin_bit_cast(float, w & 0xffff0000u); }
__device__ __forceinline__ float sigmoidf_(float x) { return 1.0f / (1.0f + __expf(-x)); }
__device__ __forceinline__ float siluf_(float x) { return x / (1.0f + __expf(-x)); }
__device__ __forceinline__ float softplusf_(float x) { return fmaxf(x, 0.f) + __logf(1.0f + __expf(-fabsf(x))); }
__device__ __forceinline__ float tanhf_(float x) { const float e = __expf(-2.0f * fabsf(x)); const float t = (1.0f - e) / (1.0f + e); return x < 0.f ? -t : t; }
__device__ __forceinline__ float logsigmoidf_(float x) { return -softplusf_(-x); }
__device__ __forceinline__ float shx(float v, int mask, int lane) { return __builtin_bit_cast(float, __builtin_amdgcn_ds_bpermute((lane ^ mask) << 2, __builtin_bit_cast(int, v))); }
__device__ __forceinline__ float wave_sum(float v, int lane) {
#pragma unroll
    for (int o = 1; o < 64; o <<= 1) v += shx(v, o, lane);
    return v;
}

#define XB_TMO      128
#define XB_XCNT(j)  (256  + 64 * (j))
#define XB_XSUB(j)  (1280 + 64 * (j))
#define XB_XGEN(j)  (2304 + 64 * (j))
#define XB_TOP      3328
#define XB_TOPGEN   3392
#define XCD_BAR_WORDS 3456
#define XB_SPIN_CAP (1u << 20)
__device__ __forceinline__ unsigned xb_ld(unsigned* p)              { return __hip_atomic_load(p, __ATOMIC_RELAXED, __HIP_MEMORY_SCOPE_AGENT); }
__device__ __forceinline__ unsigned xb_add(unsigned* p, unsigned v) { return __hip_atomic_fetch_add(p, v, __ATOMIC_RELAXED, __HIP_MEMORY_SCOPE_AGENT); }
__device__ __forceinline__ unsigned xb_xcc_id() { return (unsigned)__builtin_amdgcn_s_getreg((3 << 11) | 20) & 0xFu; }
#define XB_SPIN(cond, bar) do { unsigned _sp = 0; while (cond) { __builtin_amdgcn_s_sleep(1); \
    if ((++_sp & 255u) == 0u) { if (xb_ld(&(bar)[XB_TMO])) break; if (_sp > XB_SPIN_CAP) { atomicAdd(&(bar)[XB_TMO], 1u); break; } } } } while (0)
struct XcdBarrier { unsigned* bar; unsigned x; volatile LAS unsigned* st; };
__device__ __forceinline__ XcdBarrier xcd_barrier_post(unsigned* bar, volatile LAS unsigned* st) {
    XcdBarrier b; b.bar = bar; b.x = xb_xcc_id(); b.st = st;
    if (threadIdx.x == 0) (void)xb_add(&bar[XB_XCNT(b.x)], 1u);
    return b;
}
__device__ __forceinline__ void xcd_barrier_complete(unsigned* bar, unsigned x, unsigned& nloc, unsigned& nx) {
    const unsigned G = gridDim.x * gridDim.y * gridDim.z;
    unsigned sum, cnt, mine, sp = 0u;
    for (;;) {
        sum = 0u; cnt = 0u; mine = 0u;
#pragma unroll
        for (unsigned j = 0; j < 16; ++j) { const unsigned c = xb_ld(&bar[XB_XCNT(j)]); sum += c; cnt += (c > 0u) ? 1u : 0u; mine = (j == x) ? c : mine; }
        if (sum == G) break;
        __builtin_amdgcn_s_sleep(1);
        if ((++sp & 255u) == 0u) { if (xb_ld(&bar[XB_TMO])) break; if (sp > XB_SPIN_CAP) { atomicAdd(&bar[XB_TMO], 1u); break; } }
    }
    nloc = mine > 0u ? mine : 1u; nx = cnt > 0u ? cnt : 1u;
}
__device__ __forceinline__ void xcd_barrier(const XcdBarrier& b) {
    asm volatile("s_waitcnt vmcnt(0)" ::: "memory");
    __syncthreads();
    if (threadIdx.x == 0) {
        unsigned* bar = b.bar;
        __builtin_amdgcn_s_waitcnt(0);
        unsigned nloc = b.st[0], nx = b.st[1];
        if (nloc == 0u) { xcd_barrier_complete(bar, b.x, nloc, nx); b.st[0] = nloc; b.st[1] = nx; }
        const unsigned old = xb_add(&bar[XB_XSUB(b.x)], 1u);
        const unsigned gen = old / nloc;
        if (old + 1u == (gen + 1u) * nloc) {
            __builtin_amdgcn_fence(__ATOMIC_RELEASE, "agent");
            asm volatile("s_waitcnt vmcnt(0)" ::: "memory");
            const unsigned og = xb_add(&bar[XB_TOP], 1u);
            const unsigned tg = og / nx;
            if (og + 1u == (tg + 1u) * nx) xb_add(&bar[XB_TOPGEN], 1u);
            else XB_SPIN(xb_ld(&bar[XB_TOPGEN]) == tg, bar);
            __builtin_amdgcn_fence(__ATOMIC_ACQUIRE, "agent");
            xb_add(&bar[XB_XGEN(b.x)], 1u);
            asm volatile("s_waitcnt vmcnt(0)" ::: "memory");
        } else {
            XB_SPIN(xb_ld(&bar[XB_XGEN(b.x)]) == gen, bar);
            __builtin_amdgcn_fence(__ATOMIC_ACQUIRE, "agent");
            asm volatile("s_waitcnt vmcnt(0)" ::: "memory");
        }
    }
    __syncthreads();
}
namespace pg8 {
#define PG8_LAS __attribute__((address_space(3)))
typedef unsigned short bf16_t;
typedef short bf16x8 __attribute__((ext_vector_type(8)));
typedef float f32x4 __attribute__((ext_vector_type(4)));
typedef unsigned u32x4 __attribute__((ext_vector_type(4)));
constexpr int BM = 256, BK = 64, HALF = 128, HTB = HALF * BK * 2  , STAGE_BYTES = 8 * HTB, NXCD = 8, WGM = 8;

__host__ __device__ __forceinline__ int lds_byte(int r, int c) { const int st = (r >> 4) * 2 + (c >> 5), rr = r & 15, cc = c & 31, ob = rr * 64 + cc * 2; return st * 1024 + (ob ^ (((ob >> 9) & 1) << 5)); }
__host__ __device__ __forceinline__ void stage_rc(int b, int& R, int& C) { const int st = b / 1024, sb = b % 1024, swz = sb ^ (((sb >> 9) & 1) << 5); R = (st >> 1) * 16 + swz / 64; C = (st & 1) * 32 + (swz % 64) / 2; }
__host__ __device__ __forceinline__ int perm32(int rho) { const int n = rho >> 4, i = rho & 15; return 8 * (i >> 2) + 4 * n + (i & 3); }

struct Unit { int pm, pn; };
struct Gemm { const bf16_t* A; const bf16_t* Bt; int M, N, K, lda, ldb; };

struct StaticOrder {
    int nM, nN, nwg, G, c;
    __host__ __device__ void init(int M, int N, int G_, int c_) { nM = M / BM; nN = N / BM; nwg = nM * nN; G = G_; c = c_; }
    __host__ __device__ __forceinline__ bool next(int i, Unit& u) const {
        const long L = (long)i * G + c; if (L >= nwg) return false;
        int wgid = (int)L; { const int q = nwg / NXCD, r = nwg % NXCD, xcd = wgid % NXCD, off = wgid / NXCD; wgid = (xcd < r ? xcd * (q + 1) : r * (q + 1) + (xcd - r) * q) + off; }
        const int nig = WGM * nN, gid = wgid / nig, fm = gid * WGM, gsz = (nM - fm) < WGM ? (nM - fm) : WGM;
        u.pm = fm + ((wgid % nig) % gsz); u.pn = (wgid % nig) / gsz; return true;
    }
    __device__ __forceinline__ void a_ready(const Unit&) const {}
    __device__ __forceinline__ void done(const Unit&) const {}
};


struct SingleUnit {
    __device__ __forceinline__ bool next(int i, Unit& u) const { if (i > 0) return false; u.pm = 0; u.pn = 0; return true; }
    __device__ __forceinline__ void a_ready(const Unit&) const {}
    __device__ __forceinline__ void done(const Unit&) const {}
};
__device__ __forceinline__ unsigned cvt_pk_bf16(float lo, float hi) { unsigned r; asm volatile("v_cvt_pk_bf16_f32 %0, %1, %2" : "=v"(r) : "v"(lo), "v"(hi)); return r; }
template <class Epi, class Sched, bool ALIGN_EPI = false, bool SP2 = false>
__device__ __forceinline__ void gemm_phase(PG8_LAS unsigned char* lds, const Gemm g, const Sched& S, const Epi& E) {
    int tid_ = threadIdx.x; asm volatile("" : "+v"(tid_));
    const int tid = tid_, wid = __builtin_amdgcn_readfirstlane(tid >> 6), lane = tid & 63, wr = wid >> 2, wc = wid & 3, fr = lane & 15, fq = lane >> 4;
    const int K = g.K, nt = K / BK, lda = g.lda, ldb = g.ldb;
    unsigned voffA[2], voffB[2];
#pragma unroll
    for (int i = 0; i < 2; ++i) { int R, C; stage_rc(tid * 16 + i * 8192, R, C); const int Rb = Epi::PERM ? ((R & ~31) + perm32(R & 31)) : R;
        voffA[i] = (unsigned)(R * lda + C) * 2u; voffB[i] = (unsigned)(Rb * ldb + C) * 2u; }
    const size_t kstep = (size_t)(BK * 2);
    const size_t hstepA = (size_t)HALF * lda * 2, hstepB = (size_t)HALF * ldb * 2;
    const size_t tstepA = 2 * hstepA, tstepB = 2 * hstepB;
    const unsigned ldsw = (unsigned)wid * 1024u;
    const int aoff = lds_byte(wr * 64 + fr, fq * 8), boff = lds_byte(wc * 32 + fr, fq * 8);
#define PG8_SA(b, h) (((b) * 2 + (h)) * HTB)
#define PG8_SB(b, h) ((4 + (b) * 2 + (h)) * HTB)
#define PG8_STAGE(bufoff, gbase, voff) do { _Pragma("unroll") for (int _i = 0; _i < 2; ++_i) \
        __builtin_amdgcn_global_load_lds((const unsigned*)((const char*)(gbase) + (voff)[_i]), (PG8_LAS unsigned*)(lds + (bufoff) + ldsw + _i * 8192), 16, 0, 0); } while (0)
#define PG8_LDA(dst, b, h) do { _Pragma("unroll") for (int m = 0; m < 4; ++m) _Pragma("unroll") for (int k = 0; k < 2; ++k) dst[m][k] = *(const PG8_LAS bf16x8*)(lds + PG8_SA(b, h) + aoff + m * 2048 + k * 1024); } while (0)
#define PG8_LDB(dst, b, h) do { _Pragma("unroll") for (int n = 0; n < 2; ++n) _Pragma("unroll") for (int k = 0; k < 2; ++k) dst[n][k] = *(const PG8_LAS bf16x8*)(lds + PG8_SB(b, h) + boff + n * 2048 + k * 1024); } while (0)
#define PG8_MMA(ai, bj, At, Bt) do { __builtin_amdgcn_s_setprio(1); _Pragma("unroll") for (int m = 0; m < 4; ++m) _Pragma("unroll") for (int n = 0; n < 2; ++n) _Pragma("unroll") for (int k = 0; k < 2; ++k) \
        acc[ai][bj][m][n] = __builtin_amdgcn_mfma_f32_16x16x32_bf16(Bt[n][k], At[m][k], acc[ai][bj][m][n], 0, 0, 0); __builtin_amdgcn_s_setprio(0); } while (0)
#define PG8_WAIT_V(n) asm volatile("s_waitcnt vmcnt(" #n ")" ::: "memory")
#define PG8_WAIT_L(n) asm volatile("s_waitcnt lgkmcnt(" #n ")" ::: "memory")
#define PG8_BAR __builtin_amdgcn_s_barrier()
#define PG8_SCHED __builtin_amdgcn_sched_barrier(0)
    Unit cur, nxt; int ui = 0;
    if (!S.next(0, cur)) return;
    f32x4 acc[2][2][4][2];
#pragma unroll
    for (int a = 0; a < 2; ++a)
#pragma unroll
        for (int b = 0; b < 2; ++b)
#pragma unroll
            for (int m = 0; m < 4; ++m)
#pragma unroll
                for (int n = 0; n < 2; ++n) acc[a][b][m][n] = (f32x4){0.f, 0.f, 0.f, 0.f};
    bf16x8 At[4][2], B0[2][2], B1[2][2];
    const char* cA = (const char*)g.A + (size_t)cur.pm * tstepA; const char* cB = (const char*)g.Bt + (size_t)cur.pn * tstepB;
    S.a_ready(cur);
    if constexpr (SP2) {
        PG8_STAGE(PG8_SB(0, 0), cB, voffB); PG8_STAGE(PG8_SB(0, 1), cB + hstepB, voffB); PG8_STAGE(PG8_SA(0, 0), cA, voffA); PG8_STAGE(PG8_SA(0, 1), cA + hstepA, voffA);
        if (wr == 1) PG8_BAR;
        PG8_WAIT_V(2); PG8_BAR;
        PG8_STAGE(PG8_SB(1, 0), cB + kstep, voffB); PG8_STAGE(PG8_SA(1, 0), cA + kstep, voffA); PG8_STAGE(PG8_SB(1, 1), cB + hstepB + kstep, voffB);
        PG8_WAIT_V(6); PG8_BAR;
    } else {
        PG8_STAGE(PG8_SB(0, 0), cB, voffB); PG8_STAGE(PG8_SA(0, 0), cA, voffA); PG8_STAGE(PG8_SB(0, 1), cB + hstepB, voffB); PG8_STAGE(PG8_SA(0, 1), cA + hstepA, voffA);
        if (wr == 1) PG8_BAR;
        PG8_WAIT_V(4); PG8_BAR;
        PG8_STAGE(PG8_SB(1, 0), cB + kstep, voffB); PG8_STAGE(PG8_SA(1, 0), cA + kstep, voffA); PG8_STAGE(PG8_SB(1, 1), cB + hstepB + kstep, voffB);
        PG8_WAIT_V(6); PG8_BAR;
    }
    for (;;) {
        const bool has_next = S.next(ui + 1, nxt);
        const char* nA = has_next ? (const char*)g.A + (size_t)nxt.pm * tstepA : cA; const char* nB = has_next ? (const char*)g.Bt + (size_t)nxt.pn * tstepB : cB;
        for (int t = 0; t < nt; t += 2) {
            const bool last = (t == nt - 2);
            const char* a1 = cA + (size_t)(t + 1) * kstep;
            const char* a2 = last ? nA : cA + (size_t)(t + 2) * kstep; const char* b2 = last ? nB : cB + (size_t)(t + 2) * kstep;
            const char* a3 = a2 + kstep; const char* b3 = b2 + kstep;
            if (last && has_next) S.a_ready(nxt);
            if constexpr (SP2) {
            PG8_LDB(B0, 0, 0); PG8_LDB(B1, 0, 1); PG8_SCHED; PG8_LDA(At, 0, 0); PG8_STAGE(PG8_SA(1, 1), a1 + hstepA, voffA);
            PG8_WAIT_V(8); PG8_WAIT_L(0); PG8_BAR; PG8_MMA(0, 0, At, B0); PG8_MMA(0, 1, At, B1); PG8_BAR; PG8_SCHED;
            PG8_LDA(At, 0, 1); PG8_STAGE(PG8_SB(0, 0), b2, voffB); PG8_STAGE(PG8_SB(0, 1), b2 + hstepB, voffB); PG8_STAGE(PG8_SA(0, 0), a2, voffA);
            PG8_WAIT_V(8); PG8_WAIT_L(0); PG8_BAR; PG8_MMA(1, 0, At, B0); PG8_MMA(1, 1, At, B1); PG8_BAR; PG8_SCHED;
            PG8_LDB(B0, 1, 0); PG8_LDB(B1, 1, 1); PG8_SCHED; PG8_LDA(At, 1, 0); PG8_STAGE(PG8_SA(0, 1), a2 + hstepA, voffA);
            PG8_WAIT_V(8); PG8_WAIT_L(0); PG8_BAR; PG8_MMA(0, 0, At, B0); PG8_MMA(0, 1, At, B1); PG8_BAR; PG8_SCHED;
            PG8_LDA(At, 1, 1); PG8_STAGE(PG8_SB(1, 0), b3, voffB); PG8_STAGE(PG8_SB(1, 1), b3 + hstepB, voffB); PG8_STAGE(PG8_SA(1, 0), a3, voffA);
            PG8_WAIT_V(8); PG8_WAIT_L(0); PG8_BAR; PG8_MMA(1, 0, At, B0); PG8_MMA(1, 1, At, B1); PG8_BAR; PG8_SCHED;
            } else {
            PG8_LDB(B0, 0, 0); PG8_SCHED; PG8_LDA(At, 0, 0); PG8_STAGE(PG8_SA(1, 1), a1 + hstepA, voffA);
            PG8_WAIT_L(8); PG8_BAR; PG8_WAIT_L(0); PG8_MMA(0, 0, At, B0); PG8_BAR; PG8_SCHED;
            PG8_LDB(B1, 0, 1); PG8_STAGE(PG8_SB(0, 0), b2, voffB);
            PG8_BAR; PG8_WAIT_L(0); PG8_MMA(0, 1, At, B1); PG8_BAR;
            PG8_LDA(At, 0, 1); PG8_STAGE(PG8_SA(0, 0), a2, voffA);
            PG8_BAR; PG8_WAIT_L(0); PG8_MMA(1, 0, At, B0); PG8_BAR; PG8_SCHED;
            PG8_STAGE(PG8_SB(0, 1), b2 + hstepB, voffB);
            PG8_WAIT_V(6); PG8_BAR; PG8_MMA(1, 1, At, B1); PG8_BAR;
            PG8_LDB(B0, 1, 0); PG8_SCHED; PG8_LDA(At, 1, 0); PG8_STAGE(PG8_SA(0, 1), a2 + hstepA, voffA);
            PG8_WAIT_L(8); PG8_BAR; PG8_WAIT_L(0); PG8_MMA(0, 0, At, B0); PG8_BAR; PG8_SCHED;
            PG8_LDB(B1, 1, 1); PG8_STAGE(PG8_SB(1, 0), b3, voffB);
            PG8_BAR; PG8_WAIT_L(0); PG8_MMA(0, 1, At, B1); PG8_BAR;
            PG8_LDA(At, 1, 1); PG8_STAGE(PG8_SA(1, 0), a3, voffA);
            PG8_BAR; PG8_WAIT_L(0); PG8_MMA(1, 0, At, B0); PG8_BAR; PG8_SCHED;
            PG8_STAGE(PG8_SB(1, 1), b3 + hstepB, voffB);
            PG8_WAIT_V(6); PG8_BAR; PG8_MMA(1, 1, At, B1); PG8_BAR;
            }
        }
        if constexpr (ALIGN_EPI) { if (wr == 0) PG8_BAR; }
        if constexpr (!Epi::AFTER_DRAIN) { E(acc, cur, wr, wc, fr, fq); S.done(cur); }
        if (!has_next) break;
#pragma unroll
        for (int a = 0; a < 2; ++a)
#pragma unroll
            for (int b = 0; b < 2; ++b)
#pragma unroll
                for (int m = 0; m < 4; ++m)
#pragma unroll
                    for (int n = 0; n < 2; ++n) acc[a][b][m][n] = (f32x4){0.f, 0.f, 0.f, 0.f};
        cur = nxt; cA = nA; cB = nB; ++ui;
        if constexpr (ALIGN_EPI) { if (wr == 1) PG8_BAR; }
    }
    PG8_WAIT_V(0);
    if constexpr (!ALIGN_EPI) { if (wr == 0) PG8_BAR; }
    PG8_BAR;
    if constexpr (Epi::AFTER_DRAIN) { E.fused(acc, cur, wr, wc, fr, fq, lds, wid, lane); S.done(cur); }
#undef PG8_SA
#undef PG8_SB
#undef PG8_STAGE
#undef PG8_LDA
#undef PG8_LDB
#undef PG8_MMA
#undef PG8_WAIT_V
#undef PG8_WAIT_L
#undef PG8_BAR
#undef PG8_SCHED
}
}

using pg8::Unit; using pg8::cvt_pk_bf16;
#define EPI_ARGS const f32x4 (&acc)[2][2][4][2], const Unit& u, int wr, int wc, int fr, int fq
__device__ __forceinline__ float row_rstd(const float* ssq, int row) {
    const f32x4* p = (const f32x4*)(ssq + (size_t)row * 16);
    const f32x4 a = p[0], b = p[1], c = p[2], d = p[3];
    const float s = ((a[0] + a[1]) + (a[2] + a[3])) + ((b[0] + b[1]) + (b[2] + b[3])) + ((c[0] + c[1]) + (c[2] + c[3])) + ((d[0] + d[1]) + (d[2] + d[3]));
    return 1.0f / sqrtf(s * (1.0f / D) + NORM_EPS);
}
struct EpiSwiglu {
    static constexpr bool PERM = true, AFTER_DRAIN = false;
    bf16* H; const float* ssq;
    __device__ __forceinline__ void operator()(EPI_ARGS) const {
#pragma unroll
        for (int ai = 0; ai < 2; ++ai)
#pragma unroll
            for (int m = 0; m < 4; ++m) {
                const int row = u.pm * 256 + ai * 128 + wr * 64 + m * 16 + fr; const float rs = row_rstd(ssq, row); float v[8];
#pragma unroll
                for (int n = 0; n < 2; ++n) { const f32x4 g = acc[ai][0][m][n] * rs, up = acc[ai][1][m][n] * rs;
#pragma unroll
                    for (int j = 0; j < 4; ++j) v[4 * n + j] = siluf_(g[j]) * up[j]; }
                u32x4 w; w.x = cvt_pk_bf16(v[0], v[1]); w.y = cvt_pk_bf16(v[2], v[3]); w.z = cvt_pk_bf16(v[4], v[5]); w.w = cvt_pk_bf16(v[6], v[7]);
                *(u32x4*)(H + (size_t)row * FF + u.pn * 128 + wc * 32 + fq * 8) = w;
            }
    }
};
struct EpiResid {
    static constexpr bool PERM = false, AFTER_DRAIN = false;
    const float* Xin; float* X; bf16* XB; float* ssq; float alpha;
    __device__ __forceinline__ void operator()(EPI_ARGS) const {
#pragma unroll
        for (int ai = 0; ai < 2; ++ai)
#pragma unroll
            for (int m = 0; m < 4; ++m) {
                const int row = u.pm * 256 + ai * 128 + wr * 64 + m * 16 + fr; float s = 0.f;
#pragma unroll
                for (int bj = 0; bj < 2; ++bj)
#pragma unroll
                    for (int n = 0; n < 2; ++n) {
                        const size_t off = (size_t)row * D + u.pn * 256 + bj * 128 + wc * 32 + n * 16 + fq * 4;
                        const f32x4 xn = *(const f32x4*)(Xin + off) + acc[ai][bj][m][n] * alpha;
                        *(f32x4*)(X + off) = xn;
                        u32x2 w; w.x = cvt_pk_bf16(xn[0], xn[1]); w.y = cvt_pk_bf16(xn[2], xn[3]);
                        *(u32x2*)(XB + off) = w;
                        s += (xn[0] * xn[0] + xn[1] * xn[1]) + (xn[2] * xn[2] + xn[3] * xn[3]);
                    }
                s += shx(s, 16, fq * 16 + fr); s += shx(s, 32, fq * 16 + fr);
                if (fq == 0) ssq[(size_t)row * 16 + u.pn * 4 + wc] = s;
            }
    }
};
struct EpiBf16 {
    static constexpr bool PERM = true, AFTER_DRAIN = false;
    bf16* O; int ldc; const float* ssq; float scale; int ncols;
    __device__ __forceinline__ void operator()(EPI_ARGS) const {
#pragma unroll
        for (int ai = 0; ai < 2; ++ai)
#pragma unroll
            for (int m = 0; m < 4; ++m) {
                const int row = u.pm * 256 + ai * 128 + wr * 64 + m * 16 + fr; const float rs = (ssq ? row_rstd(ssq, row) : 1.0f) * scale;
#pragma unroll
                for (int bj = 0; bj < 2; ++bj) {
                    const int col = u.pn * 256 + bj * 128 + wc * 32 + fq * 8;
                    if (col < ncols) {
                        const f32x4 v0 = acc[ai][bj][m][0] * rs, v1 = acc[ai][bj][m][1] * rs; u32x4 w;
                        w.x = cvt_pk_bf16(v0[0], v0[1]); w.y = cvt_pk_bf16(v0[2], v0[3]); w.z = cvt_pk_bf16(v1[0], v1[1]); w.w = cvt_pk_bf16(v1[2], v1[3]);
                        *(u32x4*)(O + (size_t)row * ldc + col) = w;
                    }
                }
            }
    }
};
struct EpiZ {
    static constexpr bool PERM = true, AFTER_DRAIN = false;
    bf16* O; const float* ssq; bf16* HALO;
    __device__ __forceinline__ void operator()(EPI_ARGS) const {
#pragma unroll
        for (int ai = 0; ai < 2; ++ai)
#pragma unroll
            for (int m = 0; m < 4; ++m) {
                const int row = u.pm * 256 + ai * 128 + wr * 64 + m * 16 + fr; const float rs = row_rstd(ssq, row);
#pragma unroll
                for (int bj = 0; bj < 2; ++bj) {
                    const int col = u.pn * 256 + bj * 128 + wc * 32 + fq * 8;
                    if (col < NZ) {
                        const f32x4 v0 = acc[ai][bj][m][0] * rs, v1 = acc[ai][bj][m][1] * rs; u32x4 w;
                        w.x = cvt_pk_bf16(v0[0], v0[1]); w.y = cvt_pk_bf16(v0[2], v0[3]); w.z = cvt_pk_bf16(v1[0], v1[1]); w.w = cvt_pk_bf16(v1[2], v1[3]);
                        *(u32x4*)(O + (size_t)row * ZP + col) = w;
                        if ((row & 63) == 63 && col >= ZD_R && col < ZD_V) *(u32x4*)(HALO + (size_t)(row >> 6) * 1024 + (col - ZD_R)) = w;
                    }
                }
            }
    }
};
struct EpiKV {
    static constexpr bool PERM = true, AFTER_DRAIN = false;
    bf16* Kd; bf16* VT; const float* rstd;
    __device__ __forceinline__ void operator()(EPI_ARGS) const {
#pragma unroll
        for (int ai = 0; ai < 2; ++ai)
#pragma unroll
            for (int m = 0; m < 4; ++m) {
                const int row = u.pm * 256 + ai * 128 + wr * 64 + m * 16 + fr; const float rs = rstd[row];
#pragma unroll
                for (int bj = 0; bj < 2; ++bj) {
                    const int col = u.pn * 256 + bj * 128 + wc * 32 + fq * 8;
                    const f32x4 v0 = acc[ai][bj][m][0] * rs, v1 = acc[ai][bj][m][1] * rs;
                    if (col < D) {
                        u32x4 w; w.x = cvt_pk_bf16(v0[0], v0[1]); w.y = cvt_pk_bf16(v0[2], v0[3]); w.z = cvt_pk_bf16(v1[0], v1[1]); w.w = cvt_pk_bf16(v1[2], v1[3]);
                        *(u32x4*)(Kd + (size_t)row * D + col) = w;
                    } else {
#pragma unroll
                        for (int j = 0; j < 4; ++j) { VT[(size_t)(col - D + j) * MMEM + row] = (bf16)f2bf(v0[j]); VT[(size_t)(col - D + 4 + j) * MMEM + row] = (bf16)f2bf(v1[j]); }
                    }
                }
            }
    }
};
__device__ __forceinline__ size_t stash_idx(int T, int ai, int m, int bj, int wr, int wc, int fr, int fq) { return (size_t)(T * 16 + (ai * 4 + m) * 2 + bj) * 512 + (size_t)((wr * 4 + wc) * 64 + fq * 16 + fr); }
__device__ __forceinline__ u32x2 pack_u8(const float* v) {
    unsigned b[8];
#pragma unroll
    for (int j = 0; j < 8; ++j) b[j] = (unsigned)(v[j] * 255.0f + 0.5f);
    u32x2 w; w.x = b[0] | (b[1] << 8) | (b[2] << 16) | (b[3] << 24); w.y = b[4] | (b[5] << 8) | (b[6] << 16) | (b[7] << 24); return w;
}
__device__ __forceinline__ void unpack_u8(u32x2 w, float* v) {
#pragma unroll
    for (int j = 0; j < 4; ++j) { v[j] = (float)((w.x >> (8 * j)) & 255u) * (1.0f / 255.0f); v[4 + j] = (float)((w.y >> (8 * j)) & 255u) * (1.0f / 255.0f); }
}
struct OwnTile4 {
    int pm, pn0;
    __device__ __forceinline__ bool next(int i, Unit& u) const { if (i >= 4) return false; u.pm = pm; u.pn = 4 * i + pn0; return true; }
    __device__ __forceinline__ void a_ready(const Unit&) const {}
    __device__ __forceinline__ void done(const Unit&) const {}
};
struct EpiGate8 {
    static constexpr bool PERM = true, AFTER_DRAIN = false;
    unsigned char* G8; const float* ssq; const float* bias;
    __device__ __forceinline__ void operator()(EPI_ARGS) const {
        const int br = u.pn >> 2, T = u.pm * 4 + (u.pn & 3);
#pragma unroll
        for (int ai = 0; ai < 2; ++ai)
#pragma unroll
            for (int m = 0; m < 4; ++m) {
                const int row = u.pm * 256 + ai * 128 + wr * 64 + m * 16 + fr; const float rs = row_rstd(ssq, row);
#pragma unroll
                for (int bj = 0; bj < 2; ++bj) {
                    const int col = u.pn * 256 + bj * 128 + wc * 32 + fq * 8; float v[8];
#pragma unroll
                    for (int n = 0; n < 2; ++n) { const f32x4 b = *(const f32x4*)(bias + col + 4 * n);
#pragma unroll
                        for (int j = 0; j < 4; ++j) v[4 * n + j] = sigmoidf_(acc[ai][bj][m][n][j] * rs + b[j]); }
                    *(u32x2*)(G8 + ((size_t)br * 256 * 16 * 512 + stash_idx(T, ai, m, bj, wr, wc, fr, fq)) * 8) = pack_u8(v);
                }
            }
    }
};
struct EpiGlu8 {
    static constexpr bool PERM = true, AFTER_DRAIN = false;
    unsigned char* G8;
    __device__ __forceinline__ void operator()(EPI_ARGS) const {
        const int T = u.pm * 4 + u.pn;
#pragma unroll
        for (int ai = 0; ai < 2; ++ai)
#pragma unroll
            for (int m = 0; m < 4; ++m)
#pragma unroll
                for (int bj = 0; bj < 2; ++bj) {
                    u32x2* p = (u32x2*)(G8 + ((size_t)1 * 256 * 16 * 512 + stash_idx(T, ai, m, bj, wr, wc, fr, fq)) * 8); float g[8]; unpack_u8(*p, g);
#pragma unroll
                    for (int n = 0; n < 2; ++n)
#pragma unroll
                        for (int j = 0; j < 4; ++j) g[4 * n + j] *= sigmoidf_(acc[ai][bj][m][n][j]);
                    *p = pack_u8(g);
                }
    }
};
template <int MODE> struct EpiMerge8 {
    static constexpr bool PERM = true, AFTER_DRAIN = false;
    const unsigned char* G8; int br; bf16* MF; bf16* MG; int ldg;
    __device__ __forceinline__ void operator()(EPI_ARGS) const {
        const int T = u.pm * 4 + u.pn;
#pragma unroll
        for (int ai = 0; ai < 2; ++ai)
#pragma unroll
            for (int m = 0; m < 4; ++m) {
                const int row = u.pm * 256 + ai * 128 + wr * 64 + m * 16 + fr;
#pragma unroll
                for (int bj = 0; bj < 2; ++bj) {
                    const size_t si = stash_idx(T, ai, m, bj, wr, wc, fr, fq); float g[8];
                    unpack_u8(*(const u32x2*)(G8 + ((size_t)br * 256 * 16 * 512 + si) * 8), g);
                    f32x4 v0 = acc[ai][bj][m][0], v1 = acc[ai][bj][m][1];
#pragma unroll
                    for (int j = 0; j < 4; ++j) { v0[j] *= g[j]; v1[j] *= g[4 + j]; }
                    if (MODE != 0) { const u32x4 o = *(const u32x4*)(MF + si * 8); v0[0] += bflo(o.x); v0[1] += bfhi(o.x); v0[2] += bflo(o.y); v0[3] += bfhi(o.y); v1[0] += bflo(o.z); v1[1] += bfhi(o.z); v1[2] += bflo(o.w); v1[3] += bfhi(o.w); }
                    u32x4 w; w.x = cvt_pk_bf16(v0[0], v0[1]); w.y = cvt_pk_bf16(v0[2], v0[3]); w.z = cvt_pk_bf16(v1[0], v1[1]); w.w = cvt_pk_bf16(v1[2], v1[3]);
                    if (MODE != 2) *(u32x4*)(MF + si * 8) = w;
                    else *(u32x4*)(MG + (size_t)row * ldg + u.pn * 256 + bj * 128 + wc * 32 + fq * 8) = w;
                }
            }
    }
};
struct EpiSoftmaxP {
    static constexpr bool PERM = true, AFTER_DRAIN = true;
    bf16* P;
    __device__ __forceinline__ void fused(f32x4 (&acc)[2][2][4][2], const Unit& u, int wr, int wc, int fr, int fq, PG8_LAS unsigned char* lds, int wid, int lane) const {
        PG8_LAS float* RM = (PG8_LAS float*)lds;
        PG8_LAS float* RS = (PG8_LAS float*)(lds + 4096);
#pragma unroll
        for (int ai = 0; ai < 2; ++ai)
#pragma unroll
            for (int m = 0; m < 4; ++m) {
                float mx = -3.0e38f;
#pragma unroll
                for (int bj = 0; bj < 2; ++bj)
#pragma unroll
                    for (int n = 0; n < 2; ++n) { const f32x4 x = acc[ai][bj][m][n]; mx = fmaxf(mx, fmaxf(fmaxf(x[0], x[1]), fmaxf(x[2], x[3]))); }
                mx = fmaxf(mx, shx(mx, 16, fq * 16 + fr)); mx = fmaxf(mx, shx(mx, 32, fq * 16 + fr));
                if (fq == 0) RM[(ai * 128 + wr * 64 + m * 16 + fr) * 4 + wc] = mx;
            }
        asm volatile("s_waitcnt lgkmcnt(0)" ::: "memory"); __builtin_amdgcn_s_barrier(); asm volatile("" ::: "memory");
#pragma unroll
        for (int ai = 0; ai < 2; ++ai)
#pragma unroll
            for (int m = 0; m < 4; ++m) {
                const int rl = ai * 128 + wr * 64 + m * 16 + fr;
                const float mx = fmaxf(fmaxf(RM[rl * 4 + 0], RM[rl * 4 + 1]), fmaxf(RM[rl * 4 + 2], RM[rl * 4 + 3])); float s = 0.f;
#pragma unroll
                for (int bj = 0; bj < 2; ++bj)
#pragma unroll
                    for (int n = 0; n < 2; ++n)
#pragma unroll
                        for (int j = 0; j < 4; ++j) { const float p = exp2f(acc[ai][bj][m][n][j] - mx); acc[ai][bj][m][n][j] = p; s += p; }
                s += shx(s, 16, fq * 16 + fr); s += shx(s, 32, fq * 16 + fr);
                if (fq == 0) RS[rl * 4 + wc] = s;
            }
        asm volatile("s_waitcnt lgkmcnt(0)" ::: "memory"); __builtin_amdgcn_s_barrier(); asm volatile("" ::: "memory");
#pragma unroll
        for (int ai = 0; ai < 2; ++ai)
#pragma unroll
            for (int m = 0; m < 4; ++m) {
                const int rl = ai * 128 + wr * 64 + m * 16 + fr;
                const float inv = 1.0f / ((RS[rl * 4 + 0] + RS[rl * 4 + 1]) + (RS[rl * 4 + 2] + RS[rl * 4 + 3]));
#pragma unroll
                for (int bj = 0; bj < 2; ++bj) {
                    const f32x4 v0 = acc[ai][bj][m][0] * inv, v1 = acc[ai][bj][m][1] * inv; u32x4 w;
                    w.x = cvt_pk_bf16(v0[0], v0[1]); w.y = cvt_pk_bf16(v0[2], v0[3]); w.z = cvt_pk_bf16(v1[0], v1[1]); w.w = cvt_pk_bf16(v1[2], v1[3]);
                    *(u32x4*)(P + (size_t)rl * 256 + bj * 128 + wc * 32 + fq * 8) = w;
                }
            }
        asm volatile("s_waitcnt lgkmcnt(0)" ::: "memory"); __builtin_amdgcn_s_barrier(); asm volatile("" ::: "memory");
    }
};
struct Args { const float* in[N_INPUTS]; float* out; unsigned char* ws; };
typedef const float* cfptr;
typedef __attribute__((address_space(4))) const cfptr* kin_t;
struct Ctx {
    LAS unsigned char* lds; int tid, lane, wave, G, bid;
    kin_t in; float* X; unsigned char* ws;
    __device__ __forceinline__ const float* inp(int i, int l, size_t per_layer) const { return in[i] + (size_t)l * per_layer; }
};
__device__ __forceinline__ Ctx make_ctx() {
    extern __shared__ __attribute__((aligned(16))) unsigned char lds_raw[];
    Ctx C; int t = threadIdx.x; asm volatile("" : "+v"(t));
    kin_t k = (kin_t)__builtin_amdgcn_kernarg_segment_ptr(); asm volatile("" : "+s"(k));
    C.lds = (LAS unsigned char*)lds_raw; C.tid = t; C.lane = t & 63; C.wave = __builtin_amdgcn_readfirstlane(t >> 6);
    C.G = gridDim.x; C.bid = blockIdx.x; C.in = k;
    C.X = (float*)k[N_INPUTS]; C.ws = (unsigned char*)k[N_INPUTS + 1];
    return C;
}
constexpr size_t RWW_OFF = 93 * MiB;
struct ConvDesc { const float* W; const float* gain; bf16* dst; long alt; int ld, ncols, K, NR, kind, item0; };
constexpr int CD_OFF = 124 * 1024, CD_MAX = 24;
enum ConvJob { CJ_GU1 = 1, CJ_D1 = 2, CJ_WIN = 4, CJ_GATES = 8, CJ_PROJ = 16, CJ_XW = 32, CJ_GU2 = 64, CJ_D2 = 128, CJ_XKV0 = 256, CJ_XKV1 = 512, CJ_MLW = 1024, CJ_RWW = 2048 };
__device__ __forceinline__ void cd_put(const Ctx& C, int& n, int& items, const float* W, const float* gain, bf16* dst, long alt, int ld, int ncols, int K, int NR, int kind) {
    if (C.tid == 0) { LAS ConvDesc* d = (LAS ConvDesc*)(C.lds + CD_OFF) + n; d->W = W; d->gain = gain; d->dst = dst; d->alt = alt; d->ld = ld; d->ncols = ncols; d->K = K; d->NR = NR; d->kind = kind; d->item0 = items; }
    items += (K / 64) * (NR / 32); ++n;
}
__device__ __forceinline__ void conv_item(const LAS ConvDesc* d, int it, LAS float* scr, int lane) {
    const int K = d->K, NR = d->NR, kind = d->kind, ld = d->ld, ncols = d->ncols; const float* W = d->W; const float* gain = d->gain; bf16* dst = d->dst; const long alt = d->alt;
    const int nblk = NR / 32, kb = it / nblk, nb = it % nblk, k0 = 64 * kb, n0 = 32 * nb, n = n0 + (lane & 31);
    const float* p = nullptr;
    if (kind == 0) { if (n < ncols) p = W + n; }
    else if (kind == 1) { const int t = n >> 8, cl = n & 255, h = t * 128 + (cl & 127); p = W + (h + ((cl & 128) ? alt : 0l)); }
    else p = W + (n < D ? (long)n : alt + (long)(n - D));
    float v[32];
    if (p) { const float* q = p + (size_t)(k0 + (lane >> 5)) * ld;
#pragma unroll
        for (int i = 0; i < 32; ++i) v[i] = q[(size_t)(2 * i) * ld];
        if (gain) {
#pragma unroll
            for (int i = 0; i < 32; ++i) v[i] *= gain[k0 + 2 * i + (lane >> 5)]; }
    } else {
#pragma unroll
        for (int i = 0; i < 32; ++i) v[i] = 0.f; }
#pragma unroll
    for (int i = 0; i < 32; ++i) scr[(2 * i + (lane >> 5)) * 33 + (lane & 31)] = v[i];
    LDS_WAIT(); asm volatile("" ::: "memory");
    const int c = lane & 7;
#pragma unroll
    for (int j = 0; j < 4; ++j) { const int nn = (lane >> 3) + 8 * j; const LAS float* s = scr + (8 * c) * 33 + nn;
        u32x4 o; o.x = pk2(s[0 * 33], s[1 * 33]); o.y = pk2(s[2 * 33], s[3 * 33]); o.z = pk2(s[4 * 33], s[5 * 33]); o.w = pk2(s[6 * 33], s[7 * 33]);
        *(u32x4*)(dst + (size_t)(n0 + nn) * K + k0 + 8 * c) = o; }
    LDS_WAIT(); asm volatile("" ::: "memory");
}
__device__ __forceinline__ void run_conv(const Ctx& C, int jobs, int l, int gw, int NGW) {
    unsigned char* ws = C.ws; int n = 0, items = 0;
    __syncthreads();
    if (jobs & CJ_GU1) cd_put(C, n, items, C.inp(I_FFN1_WG, l, (size_t)D * FF), C.inp(I_FFN1_NORM, l, D), (bf16*)(ws + WS_SLOTA), (long)(C.inp(I_FFN1_WU, l, (size_t)D * FF) - C.inp(I_FFN1_WG, l, (size_t)D * FF)), FF, 2 * FF, D, 2 * FF, 1);
    if (jobs & CJ_GU2) cd_put(C, n, items, C.inp(I_FFN2_WG, l, (size_t)D * FF), C.inp(I_FFN2_NORM, l, D), (bf16*)(ws + WS_SLOTA), (long)(C.inp(I_FFN2_WU, l, (size_t)D * FF) - C.inp(I_FFN2_WG, l, (size_t)D * FF)), FF, 2 * FF, D, 2 * FF, 1);
    if (jobs & CJ_D1) cd_put(C, n, items, C.inp(I_FFN1_WD, l, (size_t)D * FF), nullptr, (bf16*)(ws + WS_SLOTC), 0, D, D, FF, D, 0);
    if (jobs & CJ_D2) cd_put(C, n, items, C.inp(I_FFN2_WD, l, (size_t)D * FF), nullptr, (bf16*)(ws + WS_SLOTC), 0, D, D, FF, D, 0);
    if (jobs & CJ_WIN) cd_put(C, n, items, C.inp(I_W_IN, l, (size_t)D * NIN), C.inp(I_MIX_NORM, l, D), (bf16*)(ws + WS_SLOTB), 0, NIN, NZ, D, NINP, 0);
    if (jobs & CJ_GATES) cd_put(C, n, items, C.inp(I_W_IN, l, (size_t)D * NIN) + ZG, C.inp(I_MIX_NORM, l, D), (bf16*)(ws + WS_SLOTA), 0, NIN, 4 * D, D, 4 * D, 0);
    if (jobs & CJ_PROJ) {
        cd_put(C, n, items, C.inp(I_ML_PROJ, l, (size_t)WB * D), nullptr, (bf16*)(ws + WS_SLOTC), 0, D, D, WB, D, 0);
        cd_put(C, n, items, C.inp(I_S5_W1, l, (size_t)WB * D), nullptr, (bf16*)(ws + WS_SLOTC + 1 * MiB), 0, D, D, WB, D, 0);
        cd_put(C, n, items, C.inp(I_S5_W2, l, (size_t)WB * D), nullptr, (bf16*)(ws + WS_SLOTC + 2 * MiB), 0, D, D, WB, D, 0);
        cd_put(C, n, items, C.inp(I_GLA_PROJ, l, (size_t)WB * D), nullptr, (bf16*)(ws + WS_SLOTC + 3 * MiB), 0, D, D, WB, D, 0);
        cd_put(C, n, items, C.inp(I_RW_PROJ, l, (size_t)WB * D), nullptr, (bf16*)(ws + WS_SLOTC + 4 * MiB), 0, D, D, WB, D, 0);
    }
    if (jobs & CJ_XW) {
        cd_put(C, n, items, C.inp(I_W_OUT, l, (size_t)D * D), nullptr, (bf16*)(ws + WS_SLOTB), 0, D, D, D, D, 0);
        cd_put(C, n, items, C.inp(I_XA_WQ, l, (size_t)D * D), C.inp(I_XA_NORM, l, D), (bf16*)(ws + WS_SLOTB + 2 * MiB), 0, D, D, D, D, 0);
        cd_put(C, n, items, C.inp(I_XA_WO, l, (size_t)D * D), nullptr, (bf16*)(ws + WS_SLOTB + 4 * MiB), 0, D, D, D, D, 0);
    }
    if (jobs & CJ_XKV0) cd_put(C, n, items, C.inp(I_XA_WK, 0, (size_t)D * D), C.inp(I_MEM_NORM, 0, D), (bf16*)(ws + WS_S), (long)(C.inp(I_XA_WV, 0, (size_t)D * D) - C.inp(I_XA_WK, 0, (size_t)D * D)), D, 2 * D, D, 2 * D, 2);
    if (jobs & CJ_XKV1) cd_put(C, n, items, C.inp(I_XA_WK, 1, (size_t)D * D), C.inp(I_MEM_NORM, 1, D), (bf16*)(ws + WS_S + 4 * MiB), (long)(C.inp(I_XA_WV, 1, (size_t)D * D) - C.inp(I_XA_WK, 1, (size_t)D * D)), D, 2 * D, D, 2 * D, 2);
    if (jobs & CJ_MLW) {
#pragma unroll
        for (int q = 0; q < 3; ++q)
#pragma unroll
            for (int hh = 0; hh < 4; ++hh) cd_put(C, n, items, C.inp(q == 0 ? I_ML_WQ : (q == 1 ? I_ML_WK : I_ML_WV), l, 4 * 16384) + hh * 16384, nullptr, (bf16*)(ws + 512 * 1024) + (size_t)(q * 4 + hh) * 16384, 0, 128, 128, 128, 128, 0);
    }
    if (jobs & CJ_RWW) {
        bf16* dst = (bf16*)(ws + WS_S + RWW_OFF);
        cd_put(C, n, items, C.inp(I_RW_WUP, l, 64 * WB), nullptr, dst, 0, WB, WB, 64, WB, 0);
        cd_put(C, n, items, C.inp(I_RW_AUP, l, 64 * WB), nullptr, dst + 512 * 64, 0, WB, WB, 64, WB, 0);
        cd_put(C, n, items, C.inp(I_RW_GUP, l, 128 * WB), nullptr, dst + 2 * 512 * 64, 0, WB, WB, 128, WB, 0);
    }
    __syncthreads();
    LAS float* scr = (LAS float*)(C.lds + C.wave * 15360);
    const LAS ConvDesc* cd = (const LAS ConvDesc*)(C.lds + CD_OFF);
    for (int it = gw; it < items; it += NGW) {
        int j = 0;
        for (int q = 1; q < n; ++q) if (it >= cd[q].item0) j = q;
        conv_item(cd + j, it - cd[j].item0, scr, C.lane);
    }
    __syncthreads();
}

__device__ __forceinline__ void pro_rows(const Ctx& C) {
    const int gw = C.bid * 8 + C.wave, NGW = C.G * 8;
    const float* x = C.in[I_X]; bf16* XB = (bf16*)(C.ws + WS_XB); float* ssq = (float*)(C.ws + WS_SSQ);
    for (int m = gw; m < M; m += NGW) {
        const f32x4* xr = (const f32x4*)(x + (size_t)m * D) + C.lane; u32x2* br = (u32x2*)(XB + (size_t)m * D) + C.lane;
        float s = 0.f;
#pragma unroll
        for (int j = 0; j < 4; ++j) { const f32x4 v = xr[64 * j]; u32x2 w; w.x = pk2(v[0], v[1]); w.y = pk2(v[2], v[3]); br[64 * j] = w; s += (v[0] * v[0] + v[1] * v[1]) + (v[2] * v[2] + v[3] * v[3]); }
        s = wave_sum(s, C.lane);
        if (C.lane < 16) ssq[(size_t)m * 16 + C.lane] = (C.lane == 0) ? s : 0.f;
    }
    const float* mem = C.in[I_MEM]; bf16* MB = (bf16*)(C.ws + WS_MEMB); float* memr = (float*)(C.ws + WS_MEMR);
    for (int m = gw; m < MMEM; m += NGW) {
        const f32x4* xr = (const f32x4*)(mem + (size_t)m * D) + C.lane; u32x2* br = (u32x2*)(MB + (size_t)m * D) + C.lane; float s = 0.f;
#pragma unroll
        for (int j = 0; j < 4; ++j) { const f32x4 v = xr[64 * j]; u32x2 w; w.x = pk2(v[0], v[1]); w.y = pk2(v[2], v[3]); br[64 * j] = w; s += (v[0] * v[0] + v[1] * v[1]) + (v[2] * v[2] + v[3] * v[3]); }
        s = wave_sum(s, C.lane);
        if (C.lane == 0) memr[m] = 1.0f / sqrtf(s * (1.0f / D) + NORM_EPS);
    }
}
__device__ __forceinline__ void final_rows(const Ctx& C) {
    const int gw = C.bid * 8 + C.wave, NGW = C.G * 8; const float* ssq = (const float*)(C.ws + WS_SSQ); const float* g = C.in[I_FINAL_NORM];
    for (int m = gw; m < M; m += NGW) {
        const float rs = row_rstd(ssq, m); f32x4* orow = (f32x4*)(C.X + (size_t)m * D) + C.lane; const f32x4* gr = (const f32x4*)g + C.lane;
#pragma unroll
        for (int j = 0; j < 4; ++j) orow[64 * j] = orow[64 * j] * rs * gr[64 * j];
    }
}
__device__ __forceinline__ float ldz(const bf16* Z, int row, int col) { return bf2f(Z[(size_t)row * ZP + col]); }
__device__ __forceinline__ float gelu_tanh(float y) { const float t = 0.7978845608028654f * (y + 0.044715f * y * y * y); return 0.5f * y * (1.0f + tanhf_(t)); }
constexpr int LCH = 64, NCH = SEQ / LCH;
constexpr size_t SO_GLA_ST = 0;
constexpr size_t SO_GLA_G = SO_GLA_ST + 16 * MiB;
constexpr size_t SO_ML_ST = SO_GLA_G + 512 * 1024;
constexpr size_t SO_ML_G = SO_ML_ST + 36 * MiB;
constexpr size_t SO_END0 = SO_ML_G + 512 * 1024;
static_assert(WS_S + SO_END0 <= WS_END, "state region");

__device__ __forceinline__ bf16x8 ld8(const LAS bf16* p) { return *(const LAS bf16x8*)p; }
__device__ __forceinline__ bf16x8 ld8(const bf16* p) { return *(const bf16x8*)p; }
template <int K, class PA, class PB> __device__ __forceinline__ f32x4 tile_mm(PA A, int lda, PB B, int ldb, f32x4 acc, int fr, int fq) {
#pragma unroll
    for (int k0 = 0; k0 < K; k0 += 32) {
        const bf16x8 a = ld8(A + fr * lda + k0 + 8 * fq);
        const bf16x8 b = ld8(B + fr * ldb + k0 + 8 * fq);
        acc = __builtin_amdgcn_mfma_f32_16x16x32_bf16(a, b, acc, 0, 0, 0);
    }
    return acc;
}
#define F4Z ((f32x4){0.f, 0.f, 0.f, 0.f})
__device__ __forceinline__ u32x2 pack4(f32x4 v) { u32x2 w; w.x = pk2(v[0], v[1]); w.y = pk2(v[2], v[3]); return w; }
__device__ __forceinline__ void unpack8(u32x4 w, float* f) { f[0] = bflo(w.x); f[1] = bfhi(w.x); f[2] = bflo(w.y); f[3] = bfhi(w.y); f[4] = bflo(w.z); f[5] = bfhi(w.z); f[6] = bflo(w.w); f[7] = bfhi(w.w); }

__device__ __forceinline__ void gla_cumdecay(const Ctx& C, int l, int h, int rowb, LAS float* ALOW, LAS float* LA, LAS float* SEG) {
    const bf16* Z = (const bf16*)(C.ws + WS_Z);
    const float* aup = C.inp(I_GLA_AUP, l, 16 * 256) + h * 64; const float* abias = C.inp(I_GLA_ABIAS, l, 256) + h * 64;
    const int tid = C.tid;
    for (int i = tid; i < 64 * 16; i += 512) ALOW[i] = ldz(Z, rowb + (i >> 4), ZC_A + (i & 15));
    __syncthreads();
    {   const int k = tid & 63, seg = tid >> 6; float au[16], run = 0.f, v[8];
#pragma unroll
        for (int r = 0; r < 16; ++r) au[r] = aup[r * 256 + k];
        const float bk = abias[k];
#pragma unroll
        for (int i = 0; i < 8; ++i) { const int t = seg * 8 + i; float s = bk;
#pragma unroll
            for (int r = 0; r < 16; ++r) s += ALOW[t * 16 + r] * au[r];
            run += logsigmoidf_(s) * (1.0f / 16.0f); v[i] = run; }
        SEG[seg * 64 + k] = run;
        __syncthreads();
        float off = 0.f;
        for (int s2 = 0; s2 < seg; ++s2) off += SEG[s2 * 64 + k];
#pragma unroll
        for (int i = 0; i < 8; ++i) LA[(seg * 8 + i) * 64 + k] = v[i] + off;
    }
    __syncthreads();
}
constexpr int LDT = 72;
__device__ __forceinline__ void gla_passA(const Ctx& C, int l, int item) {
    const int bh = item >> 6, c = item & 63, b = bh >> 2, h = bh & 3, rowb = b * SEQ + c * LCH;
    const bf16* Z = (const bf16*)(C.ws + WS_Z);
    LAS float* ALOW = (LAS float*)C.lds; LAS float* LA = ALOW + 1024; LAS float* SEG = LA + 4096;
    LAS bf16* VT = (LAS bf16*)(SEG + 512);
    LAS bf16* KT = VT + 128 * LDT;
    const int tid = C.tid, lane = C.lane, w = C.wave, fr = lane & 15, fq = lane >> 4;
    gla_cumdecay(C, l, h, rowb, ALOW, LA, SEG);
    for (int i = tid; i < 64 * 16; i += 512) { const int t = i >> 4, v0 = (i & 15) * 8; float f[8];
        unpack8(*(const u32x4*)(Z + (size_t)(rowb + t) * ZP + ZC_V + h * 128 + v0), f);
#pragma unroll
        for (int j = 0; j < 8; ++j) VT[(v0 + j) * LDT + t] = (bf16)f2bf(f[j]); }
    {   const int t = tid >> 3, k0 = (tid & 7) * 8; float f[8];
        unpack8(*(const u32x4*)(Z + (size_t)(rowb + t) * ZP + ZC_K + h * 64 + k0), f);
#pragma unroll
        for (int j = 0; j < 8; ++j) KT[(k0 + j) * LDT + t] = (bf16)f2bf(f[j] * __expf(LA[63 * 64 + k0 + j] - LA[t * 64 + k0 + j])); }
    if (tid < 64) ((float*)(C.ws + WS_S + SO_GLA_G))[(size_t)item * 64 + tid] = __expf(LA[63 * 64 + tid]);
    __syncthreads();
    bf16* ST = (bf16*)(C.ws + WS_S + SO_GLA_ST) + (size_t)item * 8192;
#pragma unroll
    for (int q = 0; q < 4; ++q) {
        const f32x4 acc = tile_mm<64>(KT + (16 * q) * LDT, LDT, VT + (16 * w) * LDT, LDT, F4Z, fr, fq);
        *(u32x2*)(ST + (size_t)(16 * w + fr) * 64 + 16 * q + 4 * fq) = pack4(acc);
    }
    __syncthreads();
}
__device__ __forceinline__ void gla_passB(const Ctx& C) {
    const int idx = C.bid * 512 + C.tid; if (idx >= 16 * 8192) return;
    const int bh = idx >> 13, e = idx & 8191, k = e & 63;
    bf16* ST = (bf16*)(C.ws + WS_S + SO_GLA_ST) + (size_t)bh * 64 * 8192 + e; const float* G = (const float*)(C.ws + WS_S + SO_GLA_G) + (size_t)bh * 64 * 64 + k;
    float d[64], g[64];
#pragma unroll
    for (int c = 0; c < 64; ++c) { d[c] = bf2f(ST[(size_t)c * 8192]); g[c] = G[c * 64]; }
    float run = 0.f;
#pragma unroll
    for (int c = 0; c < 64; ++c) { ST[(size_t)c * 8192] = (bf16)f2bf(run); run = run * g[c] + d[c]; }
}
template <bool DRY = false> __device__ __forceinline__ void gla_passC(const Ctx& C, int l, int item) {
    const int bh = item >> 6, c = item & 63, b = bh >> 2, h = bh & 3, rowb = b * SEQ + c * LCH;
    bf16* Z = (bf16*)(C.ws + WS_Z);
    LAS float* ALOW = (LAS float*)C.lds; LAS float* LA = ALOW + 1024; LAS float* SEG = LA + 4096;
    LAS bf16* VT = (LAS bf16*)(SEG + 512);
    LAS bf16* QP = VT + 128 * LDT;
    LAS bf16* KP = QP + 64 * LDT;
    LAS bf16* ATT = KP + 64 * LDT;
    LAS float* O = (LAS float*)(ATT + 64 * LDT);
    LAS float* RSQ = O + 64 * 132;
    const int tid = C.tid, lane = C.lane, w = C.wave, fr = lane & 15, fq = lane >> 4;
    gla_cumdecay(C, l, h, rowb, ALOW, LA, SEG);
    for (int i = tid; i < 64 * 16; i += 512) { const int t = i >> 4, v0 = (i & 15) * 8; float f[8];
        unpack8(*(const u32x4*)(Z + (size_t)(rowb + t) * ZP + ZC_V + h * 128 + v0), f);
#pragma unroll
        for (int j = 0; j < 8; ++j) VT[(v0 + j) * LDT + t] = (bf16)f2bf(f[j]); }
    {   const int t = tid >> 3, k0 = (tid & 7) * 8; float fq_[8], fk_[8];
        unpack8(*(const u32x4*)(Z + (size_t)(rowb + t) * ZP + ZC_Q + h * 64 + k0), fq_);
        unpack8(*(const u32x4*)(Z + (size_t)(rowb + t) * ZP + ZC_K + h * 64 + k0), fk_);
        u32x4 wq, wk; float eq[8], ek[8];
#pragma unroll
        for (int j = 0; j < 8; ++j) { const float bb = LA[t * 64 + k0 + j]; eq[j] = fq_[j] * 0.125f * __expf(bb); ek[j] = fk_[j] * __expf(-bb); }
        wq.x = pk2(eq[0], eq[1]); wq.y = pk2(eq[2], eq[3]); wq.z = pk2(eq[4], eq[5]); wq.w = pk2(eq[6], eq[7]);
        wk.x = pk2(ek[0], ek[1]); wk.y = pk2(ek[2], ek[3]); wk.z = pk2(ek[4], ek[5]); wk.w = pk2(ek[6], ek[7]);
        *(LAS u32x4*)(QP + t * LDT + k0) = wq; *(LAS u32x4*)(KP + t * LDT + k0) = wk; }
    __syncthreads();
#pragma unroll
    for (int q = 0; q < 2; ++q) {
        const int id = 2 * w + q, tt = id >> 2, ss = id & 3; f32x4 acc = F4Z;
        if (ss <= tt) acc = tile_mm<64>(KP + (16 * ss) * LDT, LDT, QP + (16 * tt) * LDT, LDT, acc, fr, fq);
        const int t = 16 * tt + fr, s0 = 16 * ss + 4 * fq;
#pragma unroll
        for (int r = 0; r < 4; ++r) if (s0 + r > t) acc[r] = 0.f;
        *(LAS u32x2*)(ATT + t * LDT + s0) = pack4(acc);
    }
    __syncthreads();
    const bf16* ST = (const bf16*)(C.ws + WS_S + SO_GLA_ST) + (size_t)item * 8192;
#pragma unroll
    for (int q = 0; q < 4; ++q) {
        const int id = 4 * w + q, tt = id & 3, vv = id >> 2;
        f32x4 acc = tile_mm<64>(ST + (size_t)(16 * vv) * 64, 64, QP + (16 * tt) * LDT, LDT, F4Z, fr, fq);
        acc = tile_mm<64>(VT + (16 * vv) * LDT, LDT, ATT + (16 * tt) * LDT, LDT, acc, fr, fq);
        *(LAS f32x4*)(O + (16 * tt + fr) * 132 + 16 * vv + 4 * fq) = acc;
    }
    __syncthreads();
    {
#pragma unroll
        for (int i = 0; i < 8; ++i) { const int t = 8 * w + i; const float h0 = O[t * 132 + lane], h1 = O[t * 132 + lane + 64];
            const float ss = wave_sum(h0 * h0 + h1 * h1, lane); if (lane == 0) RSQ[t] = 1.0f / sqrtf(ss * (1.0f / 128) + NORM_EPS); }
    }
    __syncthreads();
    for (int i = tid; i < 64 * 16; i += 512) { const int t = i >> 4, v0 = (i & 15) * 8; float g[8]; const float rs = RSQ[t];
        bf16* zp = Z + (size_t)(rowb + t) * ZP + ZC_G + h * 128 + v0; unpack8(*(const u32x4*)zp, g);
        const float* gn = C.inp(I_GLA_NORM, l, WB) + h * 128 + v0; float o[8];
#pragma unroll
        for (int j = 0; j < 8; ++j) o[j] = O[t * 132 + v0 + j] * rs * gn[j] * siluf_(g[j]);
        u32x4 wv; wv.x = pk2(o[0], o[1]); wv.y = pk2(o[2], o[3]); wv.z = pk2(o[4], o[5]); wv.w = pk2(o[6], o[7]);
        if (!DRY) *(u32x4*)zp = wv; else asm volatile("" :: "v"(wv)); }
    __syncthreads();
}

constexpr size_t WS_MLW = 512 * 1024;
constexpr int LDU = 152, LDE = 136;
__device__ __forceinline__ float wave_incl_scan(float v, int lane) {
#pragma unroll
    for (int o = 1; o < 64; o <<= 1) { const float n = __builtin_bit_cast(float, __builtin_amdgcn_ds_bpermute(((lane - o) & 63) << 2, __builtin_bit_cast(int, v))); if (lane >= o) v += n; }
    return v;
}
__device__ __forceinline__ void ml_front(const Ctx& C, int l, int b, int h, int c, LAS bf16* UC, LAS bf16* U, LAS float* GB, LAS float* GI) {
    const bf16* Z = (const bf16*)(C.ws + WS_Z); const int t0 = c * LCH, rowb = b * SEQ + t0, tid = C.tid;
    const float* conv = C.inp(I_ML_CONV, l, 4 * WB) + h * 128;
    for (int i = tid; i < 64 * 16; i += 512) { const int t = i >> 4, e0 = (i & 15) * 8; float s[8], x[8];
#pragma unroll
        for (int j = 0; j < 8; ++j) s[j] = 0.f;
#pragma unroll
        for (int d = 0; d < 4; ++d) {
            if (t0 + t - 3 + d >= 0) { unpack8(*(const u32x4*)(Z + (size_t)(rowb + t - 3 + d) * ZP + ZA_U + h * 128 + e0), x);
#pragma unroll
                for (int j = 0; j < 8; ++j) s[j] += conv[d * WB + e0 + j] * x[j]; }
        }
        u32x4 wu, wc; wu.x = pk2(x[0], x[1]); wu.y = pk2(x[2], x[3]); wu.z = pk2(x[4], x[5]); wu.w = pk2(x[6], x[7]);
#pragma unroll
        for (int j = 0; j < 8; ++j) s[j] = siluf_(s[j]);
        wc.x = pk2(s[0], s[1]); wc.y = pk2(s[2], s[3]); wc.z = pk2(s[4], s[5]); wc.w = pk2(s[6], s[7]);
        *(LAS u32x4*)(U + t * LDU + e0) = wu; *(LAS u32x4*)(UC + t * LDU + e0) = wc; }
    if (C.wave == 0) { const int t = C.lane;
        const float li = ldz(Z, rowb + t, ZA_I + h) + C.inp(I_ML_BI, l, 4)[h]; const float lf = logsigmoidf_(ldz(Z, rowb + t, ZA_F + h) + C.inp(I_ML_BF, l, 4)[h]);
        GB[t] = wave_incl_scan(lf, C.lane); GI[t] = li; }
    __syncthreads();
}
__device__ __forceinline__ void ml_passA(const Ctx& C, int l, int item) {
    const int bh = item >> 6, c = item & 63, b = bh >> 2, h = bh & 3;
    LAS bf16* UC = (LAS bf16*)C.lds; LAS bf16* U = UC + 64 * LDU; LAS bf16* KT = U + 64 * LDU;
    LAS bf16* VT = KT + 128 * LDT;
    LAS float* GB = (LAS float*)(VT + 144 * LDT); LAS float* GI = GB + 64; LAS float* WA = GI + 64;
    const int tid = C.tid, lane = C.lane, w = C.wave, fr = lane & 15, fq = lane >> 4;
    ml_front(C, l, b, h, c, UC, U, GB, GI);
    if (tid < 64) WA[tid] = __expf(GB[63] - GB[tid] + GI[tid]) * 0.08838834764831845f;
    for (int i = tid; i < 16 * LDT; i += 512) VT[128 * LDT + i] = (i < LDT) ? (bf16)0x3f80 : (bf16)0;
    __syncthreads();
    const bf16* WK = (const bf16*)(C.ws + WS_MLW) + (size_t)(4 + h) * 16384; const bf16* WV = (const bf16*)(C.ws + WS_MLW) + (size_t)(8 + h) * 16384;
#pragma unroll
    for (int q = 0; q < 4; ++q) {
        const int id = 4 * w + q, tt = id & 3, ee = id >> 2;
        f32x4 ak = tile_mm<128>(UC + (16 * tt) * LDU, LDU, WK + (size_t)(16 * ee) * 128, 128, F4Z, fr, fq);
        f32x4 av = tile_mm<128>(U + (16 * tt) * LDU, LDU, WV + (size_t)(16 * ee) * 128, 128, F4Z, fr, fq);
        const int t = 16 * tt + 4 * fq;
#pragma unroll
        for (int r = 0; r < 4; ++r) ak[r] *= WA[t + r];
        *(LAS u32x2*)(KT + (16 * ee + fr) * LDT + t) = pack4(ak); *(LAS u32x2*)(VT + (16 * ee + fr) * LDT + t) = pack4(av);
    }
    if (tid == 0) ((float*)(C.ws + WS_S + SO_ML_G))[item] = __expf(GB[63]);
    __syncthreads();
    bf16* ST = (bf16*)(C.ws + WS_S + SO_ML_ST) + (size_t)item * (144 * 128);
    for (int id = w; id < 72; id += 8) {
        const int ee = id & 7, vv = id >> 3;
        const f32x4 acc = tile_mm<64>(KT + (16 * ee) * LDT, LDT, VT + (16 * vv) * LDT, LDT, F4Z, fr, fq);
        *(u32x2*)(ST + (size_t)(16 * vv + fr) * 128 + 16 * ee + 4 * fq) = pack4(acc);
    }
    __syncthreads();
}
__device__ __forceinline__ void ml_passB(const Ctx& C) {
    for (int idx = C.bid * 512 + C.tid; idx < 16 * 18432; idx += C.G * 512) {
        const int bh = idx / 18432, e = idx % 18432;
        bf16* ST = (bf16*)(C.ws + WS_S + SO_ML_ST) + (size_t)bh * 64 * 18432 + e; const float* G = (const float*)(C.ws + WS_S + SO_ML_G) + bh * 64;
        float d[64], g[64];
#pragma unroll
        for (int c = 0; c < 64; ++c) { d[c] = bf2f(ST[(size_t)c * 18432]); g[c] = G[c]; }
        float run = 0.f;
#pragma unroll
        for (int c = 0; c < 64; ++c) { ST[(size_t)c * 18432] = (bf16)f2bf(run); run = run * g[c] + d[c]; }
    }
}
template <bool DRY = false> __device__ __forceinline__ void ml_passC(const Ctx& C, int l, int item) {
    const int bh = item >> 6, c = item & 63, b = bh >> 2, h = bh & 3, rowb = b * SEQ + c * LCH;
    bf16* Z = (bf16*)(C.ws + WS_Z);
    LAS bf16* UC = (LAS bf16*)C.lds; LAS bf16* U = UC + 64 * LDU; LAS bf16* Q = U + 64 * LDU;
    LAS bf16* K = Q + 64 * LDE;
    LAS bf16* VT = K + 64 * LDE;
    LAS bf16* W = VT + 144 * LDT;
    LAS float* GB = (LAS float*)(W + 64 * LDT); LAS float* GI = GB + 64; LAS float* RF = GI + 64; LAS float* CF = RF + 64; LAS float* RSQ = CF + 64;
    LAS float* O = (LAS float*)C.lds;
    const int tid = C.tid, lane = C.lane, w = C.wave, fr = lane & 15, fq = lane >> 4;
    ml_front(C, l, b, h, c, UC, U, GB, GI);
    if (tid < 64) { RF[tid] = __expf(GB[tid]); CF[tid] = __expf(GI[tid] - GB[tid]) * 0.08838834764831845f; }
    for (int i = tid; i < 16 * LDT; i += 512) VT[128 * LDT + i] = (i < LDT) ? (bf16)0x3f80 : (bf16)0;
    const bf16* WQ = (const bf16*)(C.ws + WS_MLW) + (size_t)h * 16384; const bf16* WK = WQ + 4 * 16384; const bf16* WV = WQ + 8 * 16384;
#pragma unroll
    for (int q = 0; q < 4; ++q) {
        const int id = 4 * w + q, tt = id & 3, ee = id >> 2;
        const f32x4 aq = tile_mm<128>(WQ + (size_t)(16 * ee) * 128, 128, UC + (16 * tt) * LDU, LDU, F4Z, fr, fq);
        const f32x4 ak = tile_mm<128>(WK + (size_t)(16 * ee) * 128, 128, UC + (16 * tt) * LDU, LDU, F4Z, fr, fq);
        *(LAS u32x2*)(Q + (16 * tt + fr) * LDE + 16 * ee + 4 * fq) = pack4(aq); *(LAS u32x2*)(K + (16 * tt + fr) * LDE + 16 * ee + 4 * fq) = pack4(ak);
        const f32x4 av = tile_mm<128>(U + (16 * tt) * LDU, LDU, WV + (size_t)(16 * ee) * 128, 128, F4Z, fr, fq);
        *(LAS u32x2*)(VT + (16 * ee + fr) * LDT + 16 * tt + 4 * fq) = pack4(av);
    }
    __syncthreads();
#pragma unroll
    for (int q = 0; q < 2; ++q) {
        const int id = 2 * w + q, tt = id >> 2, ss = id & 3; f32x4 acc = F4Z;
        if (ss <= tt) acc = tile_mm<128>(K + (16 * ss) * LDE, LDE, Q + (16 * tt) * LDE, LDE, acc, fr, fq);
        const int t = 16 * tt + fr, s0 = 16 * ss + 4 * fq; const float rf = RF[t];
#pragma unroll
        for (int r = 0; r < 4; ++r) acc[r] = (s0 + r > t) ? 0.f : acc[r] * rf * CF[s0 + r];
        *(LAS u32x2*)(W + t * LDT + s0) = pack4(acc);
    }
    __syncthreads();
    const bf16* ST = (const bf16*)(C.ws + WS_S + SO_ML_ST) + (size_t)item * (144 * 128);
    f32x4 res[5];
#pragma unroll
    for (int q = 0; q < 5; ++q) {
        const int id = w + 8 * q, tt = id & 3, vv = id >> 2; res[q] = F4Z;
        if (id < 36) {
            f32x4 acc = tile_mm<128>(ST + (size_t)(16 * vv) * 128, 128, Q + (16 * tt) * LDE, LDE, F4Z, fr, fq);
            acc *= RF[16 * tt + fr];
            res[q] = tile_mm<64>(VT + (16 * vv) * LDT, LDT, W + (16 * tt) * LDT, LDT, acc, fr, fq);
        }
    }
    __syncthreads();
#pragma unroll
    for (int q = 0; q < 5; ++q) { const int id = w + 8 * q, tt = id & 3, vv = id >> 2; if (id < 36) *(LAS f32x4*)(O + (16 * tt + fr) * 148 + 16 * vv + 4 * fq) = res[q]; }
    __syncthreads();
    {
#pragma unroll
        for (int i = 0; i < 8; ++i) { const int t = 8 * w + i; const float inv = 1.0f / fmaxf(fabsf(O[t * 148 + 128]), 1.0f);
            const float h0 = O[t * 148 + lane] * inv, h1 = O[t * 148 + lane + 64] * inv;
            const float ss = wave_sum(h0 * h0 + h1 * h1, lane); if (lane == 0) RSQ[t] = inv / sqrtf(ss * (1.0f / 128) + NORM_EPS); }
    }
    __syncthreads();
    for (int i = tid; i < 64 * 16; i += 512) { const int t = i >> 4, v0 = (i & 15) * 8; float g[8]; const float rs = RSQ[t];
        bf16* zp = Z + (size_t)(rowb + t) * ZP + ZA_O + h * 128 + v0; unpack8(*(const u32x4*)zp, g);
        const float* gn = C.inp(I_ML_NORM, l, WB) + h * 128 + v0; float o[8];
#pragma unroll
        for (int j = 0; j < 8; ++j) o[j] = O[t * 148 + v0 + j] * rs * gn[j] * sigmoidf_(g[j]);
        u32x4 wv; wv.x = pk2(o[0], o[1]); wv.y = pk2(o[2], o[3]); wv.z = pk2(o[4], o[5]); wv.w = pk2(o[6], o[7]);
        if (!DRY) *(u32x4*)zp = wv; else asm volatile("" :: "v"(wv)); }
    __syncthreads();
}

constexpr size_t SO_S5_K = SO_END0;
constexpr size_t SO_S5_BB = SO_S5_K + 1 * MiB;
constexpr size_t SO_S5_PM = SO_S5_BB + 256 * 1024;
constexpr size_t SO_S5_POW = SO_S5_PM + 512 * 1024;
constexpr size_t SO_S5_E = SO_S5_POW + 1280 * 1024;
constexpr size_t SO_END1 = SO_S5_E + 4 * MiB;
static_assert(WS_S + SO_END1 <= WS_END, "state region");
__device__ __forceinline__ void s5_prep(const Ctx& C, int l, int g, int part) {
    LAS float* BBr = (LAS float*)C.lds; LAS float* BBi = BBr + 1024; LAS float* PW = BBi + 1024; LAS float* CR = PW + 65 * 128; LAS float* CI = CR + 1024;
    const int tid = C.tid;
    if (tid < 64) { const int p = tid;
        const float are = C.inp(I_S5_ARE, l, 32 * 64)[g * 64 + p], aim = C.inp(I_S5_AIM, l, 32 * 64)[g * 64 + p];
        const float step = expf(C.inp(I_S5_LOGSTEP, l, 32)[g]); const float lre = fminf(are, -1e-4f), lim = aim;
        const float mag = expf(lre * step), bre = mag * cosf(lim * step), bim = mag * sinf(lim * step), den = lre * lre + lim * lim;
        const float cre = ((bre - 1.0f) * lre + bim * lim) / den, cim = (bim * lre - (bre - 1.0f) * lim) / den;
        const float* br = C.inp(I_S5_BRE, l, 32 * 64 * 16) + (size_t)(g * 64 + p) * 16; const float* bi = C.inp(I_S5_BIM, l, 32 * 64 * 16) + (size_t)(g * 64 + p) * 16;
        for (int c = 0; c < 16; ++c) { BBr[p * 16 + c] = cre * br[c] - cim * bi[c]; BBi[p * 16 + c] = cre * bi[c] + cim * br[c]; }
        float pr = 1.f, pi = 0.f;
        for (int n = 0; n <= 64; ++n) { PW[(n * 64 + p) * 2] = pr; PW[(n * 64 + p) * 2 + 1] = pi; const float nr = pr * bre - pi * bim, ni = pr * bim + pi * bre; pr = nr; pi = ni; }
    }
    for (int i = tid; i < 1024; i += 512) { CR[i] = C.inp(I_S5_CRE, l, 32 * 1024)[g * 1024 + i]; CI[i] = C.inp(I_S5_CIM, l, 32 * 1024)[g * 1024 + i]; }
    __syncthreads();
    unsigned char* S = C.ws + WS_S;
    if (part == 0) {
    float* POW = (float*)(S + SO_S5_POW) + (size_t)g * 65 * 128;
    for (int i = tid; i < 65 * 128; i += 512) POW[i] = PW[i];
    bf16* BB = (bf16*)(S + SO_S5_BB) + (size_t)g * 128 * 32;
    for (int i = tid; i < 128 * 32; i += 512) { const int row = i >> 5, c = i & 31, pp = row >> 5, ri = (row >> 4) & 1, p = 16 * pp + (row & 15);
        BB[i] = (bf16)f2bf(c < 16 ? (ri ? BBi[p * 16 + c] : BBr[p * 16 + c]) : 0.f); }
    bf16* PM = (bf16*)(S + SO_S5_PM) + (size_t)g * 64 * 128;
    for (int i = tid; i < 64 * 128; i += 512) { const int t = i >> 7, k = i & 127, ri = k >> 6, p = k & 63;
        PM[i] = (bf16)f2bf(ri ? -PW[((t + 1) * 64 + p) * 2 + 1] : PW[((t + 1) * 64 + p) * 2]); }
    }
    bf16* KM = (bf16*)(S + SO_S5_K) + (size_t)g * 16 * 1024;
    for (int i = part * 2048 + tid; i < (part + 1) * 2048; i += 512) { const int cp = i >> 10, k = i & 1023, tau = k >> 4, c = k & 15; float s = 0.f;
        for (int p = 0; p < 64; ++p) { const float cr = CR[cp * 64 + p], ci = CI[cp * 64 + p], pr = PW[(tau * 64 + p) * 2], pi = PW[(tau * 64 + p) * 2 + 1];
            const float wr = cr * pr - ci * pi, wi = cr * pi + ci * pr; s += wr * BBr[p * 16 + c] - wi * BBi[p * 16 + c]; }
        KM[i] = (bf16)f2bf(s); }
    __syncthreads();
}
__device__ __forceinline__ void s5_passA(const Ctx& C) {
    const int g = C.bid >> 3, sb = C.bid & 7, lane = C.lane, fr = lane & 15, fq = lane >> 4, tid = C.tid;
    const bf16* Z = (const bf16*)(C.ws + WS_Z); unsigned char* S = C.ws + WS_S;
    LAS bf16* BBL = (LAS bf16*)(C.lds + 65536);
    LAS float* POWL = (LAS float*)(C.lds + 65536 + 8192);
    {   const u32x4* src = (const u32x4*)((const bf16*)(S + SO_S5_BB) + (size_t)g * 128 * 32); LAS u32x4* dst = (LAS u32x4*)BBL; dst[tid] = src[tid];
        const u32x4* ps = (const u32x4*)((const float*)(S + SO_S5_POW) + (size_t)g * 65 * 128); LAS u32x4* pd = (LAS u32x4*)POWL;
        for (int i = tid; i < 65 * 128 / 4; i += 512) pd[i] = ps[i]; }
    __syncthreads();
    LAS bf16* UA = (LAS bf16*)(C.lds + C.wave * 8192);
#pragma unroll 1
    for (int i4 = 0; i4 < 4; ++i4) {
        const int j = sb * 32 + C.wave * 4 + i4, b = j >> 6, c = j & 63, item = (b * 32 + g) * 64 + c, rowb = b * SEQ + c * LCH;
        {   const u32x4* src = (const u32x4*)(Z + (size_t)(rowb + lane) * ZP + ZB_U + g * 16); const u32x4 z4 = (u32x4){0u, 0u, 0u, 0u};
            LAS u32x4* dst = (LAS u32x4*)(UA + lane * 40); dst[0] = src[0]; dst[1] = src[1]; dst[2] = z4; dst[3] = z4; }
        LDS_WAIT(); __builtin_amdgcn_wave_barrier();
        float* E = (float*)(S + SO_S5_E) + (size_t)item * 128;
#pragma unroll
        for (int pp = 0; pp < 4; ++pp) { float er = 0.f, ei = 0.f; const int p = 16 * pp + fr;
#pragma unroll
            for (int tt = 0; tt < 4; ++tt) {
                const f32x4 br = tile_mm<32>(UA + (16 * tt) * 40, 40, BBL + (pp * 32) * 32, 32, F4Z, fr, fq);
                const f32x4 bi = tile_mm<32>(UA + (16 * tt) * 40, 40, BBL + (pp * 32 + 16) * 32, 32, F4Z, fr, fq);
#pragma unroll
                for (int r = 0; r < 4; ++r) { const int t = 16 * tt + 4 * fq + r; const f32x2 pw = *(const LAS f32x2*)(POWL + ((63 - t) * 64 + p) * 2);
                    er += pw.x * br[r] - pw.y * bi[r]; ei += pw.x * bi[r] + pw.y * br[r]; }
            }
            er += shx(er, 16, lane); er += shx(er, 32, lane); ei += shx(ei, 16, lane); ei += shx(ei, 32, lane);
            if (fq == 0) { E[p] = er; E[64 + p] = ei; }
        }
        LDS_WAIT(); __builtin_amdgcn_wave_barrier();
    }
    __syncthreads();
}
__device__ __forceinline__ void s5_passB(const Ctx& C) {
    const int idx = C.bid * 512 + C.tid; if (idx >= 8192) return;
    const int bg = idx >> 6, p = idx & 63, g = bg & 31; unsigned char* S = C.ws + WS_S;
    const f32x2 l64 = *(const f32x2*)((const float*)(S + SO_S5_POW) + (size_t)g * 65 * 128 + (64 * 64 + p) * 2);
    float* E = (float*)(S + SO_S5_E) + (size_t)bg * 64 * 128 + p;
    float er[64], ei[64];
#pragma unroll
    for (int c = 0; c < 64; ++c) { er[c] = E[c * 128]; ei[c] = E[c * 128 + 64]; }
    float rr = 0.f, ri = 0.f;
#pragma unroll
    for (int c = 0; c < 64; ++c) { E[c * 128] = rr; E[c * 128 + 64] = ri; const float nr = l64.x * rr - l64.y * ri + er[c], ni = l64.x * ri + l64.y * rr + ei[c]; rr = nr; ri = ni; }
}
constexpr int LDKM = 1032;
template <class RW> __device__ __forceinline__ void s5_passC_core(const Ctx& C, int l, RW rw_items) {
    const int g = C.bid >> 3, sb = C.bid & 7, lane = C.lane, fr = lane & 15, fq = lane >> 4, tid = C.tid;
    bf16* Z = (bf16*)(C.ws + WS_Z); unsigned char* S = C.ws + WS_S;
    LAS bf16* KML = (LAS bf16*)(C.lds + 73728);
    LAS bf16* PML = (LAS bf16*)(C.lds + 73728 + 16 * LDKM * 2);
    {   const u32x4* ks = (const u32x4*)((const bf16*)(S + SO_S5_K) + (size_t)g * 16 * 1024);
        for (int i = tid; i < 16 * 128; i += 512) *(LAS u32x4*)(KML + (i >> 7) * LDKM + (i & 127) * 8) = ks[i];
        const u32x4* ps = (const u32x4*)((const bf16*)(S + SO_S5_PM) + (size_t)g * 64 * 128);
        for (int i = tid; i < 64 * 16; i += 512) *(LAS u32x4*)(PML + (i >> 4) * 136 + (i & 15) * 8) = ps[i]; }
    __syncthreads();
    if (C.wave < 4) { rw_items(); __syncthreads(); return; }
    LAS bf16* UP = (LAS bf16*)(C.lds + C.wave * 9216);
    LAS bf16* WV = UP + 128 * 16;
    const float* dsk = C.inp(I_S5_D, l, WB) + g * 16;
#pragma unroll 1
    for (int i4 = 0; i4 < 8; ++i4) {
        const int j = sb * 32 + (C.wave - 4) * 8 + i4, b = j >> 6, c = j & 63, item = (b * 32 + g) * 64 + c, rowb = b * SEQ + c * LCH;
        {   const u32x4* src = (const u32x4*)(Z + (size_t)(rowb + lane) * ZP + ZB_U + g * 16); const u32x4 z4 = (u32x4){0u, 0u, 0u, 0u};
            LAS u32x4* dz = (LAS u32x4*)(UP + lane * 16); dz[0] = z4; dz[1] = z4; LAS u32x4* dst = (LAS u32x4*)(UP + (64 + lane) * 16); dst[0] = src[0]; dst[1] = src[1]; }
        {   const float* E = (const float*)(S + SO_S5_E) + (size_t)item * 128; const int cp = lane >> 2, pq = lane & 3;
            const float* cr = C.inp(I_S5_CRE, l, 32 * 1024) + (size_t)g * 1024 + cp * 64 + 16 * pq; const float* ci = C.inp(I_S5_CIM, l, 32 * 1024) + (size_t)g * 1024 + cp * 64 + 16 * pq;
#pragma unroll
            for (int jj = 0; jj < 16; jj += 2) { const int p = 16 * pq + jj;
                const float a0 = cr[jj] * E[p] - ci[jj] * E[64 + p], b0 = cr[jj] * E[64 + p] + ci[jj] * E[p], a1 = cr[jj + 1] * E[p + 1] - ci[jj + 1] * E[65 + p], b1 = cr[jj + 1] * E[65 + p] + ci[jj + 1] * E[p + 1];
                *(LAS unsigned*)(WV + cp * 136 + p) = pk2(a0, a1); *(LAS unsigned*)(WV + cp * 136 + 64 + p) = pk2(b0, b1); }
        }
        LDS_WAIT(); __builtin_amdgcn_wave_barrier();
#pragma unroll
        for (int tt = 0; tt < 4; ++tt) {
            f32x4 acc = F4Z; const int t = 16 * tt + fr;
#pragma unroll 4
            for (int ks = 0; ks < 8 * (tt + 1); ++ks) {
                const bf16x8 a = ld8(KML + fr * LDKM + 32 * ks + 8 * fq);
                const bf16x8 bb = ld8(UP + (64 + t - 2 * ks - (fq >> 1)) * 16 + 8 * (fq & 1));
                acc = __builtin_amdgcn_mfma_f32_16x16x32_bf16(a, bb, acc, 0, 0, 0);
            }
            acc = tile_mm<128>(WV, 136, PML + (16 * tt) * 136, 136, acc, fr, fq);
            float y[4];
#pragma unroll
            for (int r = 0; r < 4; ++r) { const int cp = 4 * fq + r; y[r] = gelu_tanh(acc[r] + dsk[cp] * bf2f(UP[(64 + t) * 16 + cp])); }
            u32x2 o; o.x = pk2(y[0], y[1]); o.y = pk2(y[2], y[3]);
            *(u32x2*)(Z + (size_t)(rowb + t) * ZP + ZB_U + g * 16 + 4 * fq) = o;
        }
        LDS_WAIT(); __builtin_amdgcn_wave_barrier();
    }
    __syncthreads();
}

constexpr size_t SO_RW_PQ = SO_END1;
constexpr size_t SO_RW_RHO = SO_RW_PQ + 32 * MiB;
constexpr size_t SO_RW_HALO = SO_RW_RHO + 512 * 1024;
constexpr size_t SO_RW_W = SO_RW_HALO + 512 * 1024;
constexpr size_t SO_END2 = SO_RW_W + 256 * 1024;
static_assert(WS_S + SO_END2 <= WS_END, "state region");
static_assert(SO_RW_W == RWW_OFF, "RWW_OFF");
__device__ __forceinline__ void shift8(const u32x4 cur, const u32x4 prev, const float* mu, float* o) {
    float a[8], p[8]; unpack8(cur, a); unpack8(prev, p);
#pragma unroll
    for (int j = 0; j < 8; ++j) o[j] = a[j] + mu[j] * (p[j] - a[j]);
}
__device__ __forceinline__ u32x4 pack8(const float* f) { u32x4 w; w.x = pk2(f[0], f[1]); w.y = pk2(f[2], f[3]); w.z = pk2(f[4], f[5]); w.w = pk2(f[6], f[7]); return w; }

template <bool DRY = false> __device__ __forceinline__ void rw_passA(const Ctx& C, int l, int item) {
    const int bh = item >> 6, c = item & 63, b = bh >> 3, h = bh & 7, hc0 = h * 64, rowb = b * SEQ + c * LCH;
    bf16* Z = (bf16*)(C.ws + WS_Z); unsigned char* S = C.ws + WS_S;
    LAS unsigned char* L = C.lds;
    LAS bf16* XW = (LAS bf16*)L; LAS bf16* XA = (LAS bf16*)(L + 9216); LAS float* WARG = (LAS float*)(L + 18432);
    LAS bf16* TAB = (LAS bf16*)L; LAS bf16* TAK = (LAS bf16*)(L + 9216); LAS bf16* MRB = (LAS bf16*)(L + 18432); LAS bf16* MRK = (LAS bf16*)(L + 27648);
    LAS float* AARG = (LAS float*)(L + 36864); LAS float* LW = AARG; LAS bf16* XT = (LAS bf16*)(L + 36864);
    LAS bf16* AT = (LAS bf16*)(L + 55296); LAS bf16* RT = (LAS bf16*)(L + 64512); LAS bf16* BT = (LAS bf16*)(L + 73728); LAS bf16* KT = (LAS bf16*)(L + 82944);
    LAS float* RHSV = (LAS float*)(L + 73728);
    LAS bf16* BBT = (LAS bf16*)(L + 92160); LAS bf16* KBT = (LAS bf16*)(L + 101376); LAS bf16* VT = (LAS bf16*)(L + 110592);
    LAS float* CUML = (LAS float*)(L + 119808); LAS float* GL = CUML + 64; LAS float* SEG = GL + 64; LAS float* UPD = SEG;
    const int tid = C.tid, lane = C.lane, w = C.wave, fr = lane & 15, fq = lane >> 4;
    const int t = tid >> 3, c0 = (tid & 7) * 8, row = rowb + t;
    const float* mu = C.inp(I_RW_MU, l, 1792);
    const bf16* HALO = (const bf16*)(S + SO_RW_HALO) + (size_t)(b * 64 + c - 1) * 1024;
    const u32x4 z4 = (u32x4){0u, 0u, 0u, 0u};
    {   float f[8];
        const u32x4 cw = *(const u32x4*)(Z + (size_t)row * ZP + ZD_XW + c0), pw = (c * LCH + t > 0) ? *(const u32x4*)(Z + (size_t)(row - 1) * ZP + ZD_XW + c0) : z4;
        shift8(cw, pw, mu + 1536 + c0, f);
#pragma unroll
        for (int j = 0; j < 8; ++j) f[j] = tanhf_(f[j]);
        *(LAS u32x4*)(XW + t * LDT + c0) = pack8(f);
        const u32x4 ca = *(const u32x4*)(Z + (size_t)row * ZP + ZD_XA + c0), pa = (c * LCH + t > 0) ? *(const u32x4*)(Z + (size_t)(row - 1) * ZP + ZD_XA + c0) : z4;
        shift8(ca, pa, mu + 1600 + c0, f);
        *(LAS u32x4*)(XA + t * LDT + c0) = pack8(f);
    }
    __syncthreads();
    {   const bf16* WUP = (const bf16*)(S + SO_RW_W) + (size_t)hc0 * 64; const bf16* AUP = WUP + 512 * 64;
#pragma unroll
        for (int q = 0; q < 2; ++q) { const int id = 2 * w + q, tt = id >> 2, cc = id & 3;
            const f32x4 aw = tile_mm<64>(XW + (16 * tt) * LDT, LDT, WUP + (size_t)(16 * cc) * 64, 64, F4Z, fr, fq);
            const f32x4 aa = tile_mm<64>(XA + (16 * tt) * LDT, LDT, AUP + (size_t)(16 * cc) * 64, 64, F4Z, fr, fq);
#pragma unroll
            for (int r = 0; r < 4; ++r) { WARG[(16 * tt + 4 * fq + r) * 65 + 16 * cc + fr] = aw[r]; AARG[(16 * tt + 4 * fq + r) * 65 + 16 * cc + fr] = aa[r]; } }
    }
    __syncthreads();
    float lw[8], av[8], bv[8], kr[8], rr[8], vv[8];
    {   float kk[8], aa[8];
        const bool first = (c * LCH + t == 0);
        const u32x4 cr = *(const u32x4*)(Z + (size_t)row * ZP + ZD_R + hc0 + c0), ck = *(const u32x4*)(Z + (size_t)row * ZP + ZD_K + hc0 + c0), cv = *(const u32x4*)(Z + (size_t)row * ZP + ZD_V + hc0 + c0);
        u32x4 pr = z4, pk = z4, pv = z4;
        if (!first) { pv = *(const u32x4*)(Z + (size_t)(row - 1) * ZP + ZD_V + hc0 + c0);
            if (t > 0) { pr = *(const u32x4*)(Z + (size_t)(row - 1) * ZP + ZD_R + hc0 + c0); pk = *(const u32x4*)(Z + (size_t)(row - 1) * ZP + ZD_K + hc0 + c0); }
            else { pr = *(const u32x4*)(HALO + hc0 + c0); pk = *(const u32x4*)(HALO + 512 + hc0 + c0); } }
        shift8(cr, pr, mu + hc0 + c0, rr); shift8(ck, pk, mu + 512 + hc0 + c0, kk); shift8(cv, pv, mu + 1024 + hc0 + c0, vv);
        const float* w0 = C.inp(I_RW_W0, l, WB) + hc0 + c0; const float* a0 = C.inp(I_RW_A0, l, WB) + hc0 + c0;
        const float* kkw = C.inp(I_RW_KK, l, WB) + hc0 + c0; const float* kaw = C.inp(I_RW_KA, l, WB) + hc0 + c0; const float* rkw = C.inp(I_RW_RK, l, WB) + hc0 + c0;
        float n2 = 0.f, rho = 0.f;
#pragma unroll
        for (int j = 0; j < 8; ++j) {
            const float wl = -softplusf_(-(WARG[t * 65 + c0 + j] + w0[j])) - 0.5f; lw[j] = -__expf(wl);
            aa[j] = sigmoidf_(AARG[t * 65 + c0 + j] + a0[j]);
            const float kn = kk[j] * kkw[j]; n2 += kn * kn; av[j] = kn;
            kr[j] = kk[j] * (1.0f + (aa[j] - 1.0f) * kaw[j]); rho += rr[j] * kr[j] * rkw[j];
        }
        n2 += shx(n2, 1, lane); n2 += shx(n2, 2, lane); n2 += shx(n2, 4, lane);
        rho += shx(rho, 1, lane); rho += shx(rho, 2, lane); rho += shx(rho, 4, lane);
        const float inv = 1.0f / fmaxf(sqrtf(n2), 1e-12f);
#pragma unroll
        for (int j = 0; j < 8; ++j) { const float kkn = av[j] * inv; av[j] = -kkn; bv[j] = kkn * aa[j]; }
        if (!DRY && (tid & 7) == 0) ((float*)(S + SO_RW_RHO))[(size_t)row * 8 + h] = rho;
    }
    __syncthreads();
#pragma unroll
    for (int j = 0; j < 8; ++j) LW[t * 64 + c0 + j] = lw[j];
    __syncthreads();
    {   const int cc = tid & 63, seg = tid >> 6; float run = 0.f, v8[8];
#pragma unroll
        for (int i = 0; i < 8; ++i) { run += LW[(seg * 8 + i) * 64 + cc]; v8[i] = run; }
        SEG[seg * 64 + cc] = run;
        __syncthreads();
        float off = 0.f;
        for (int s2 = 0; s2 < seg; ++s2) off += SEG[s2 * 64 + cc];
#pragma unroll
        for (int i = 0; i < 8; ++i) LW[(seg * 8 + i) * 64 + cc] = v8[i] + off;
        if (seg == 7) { CUML[cc] = v8[7] + off; GL[cc] = __expf(v8[7] + off); }
    }
    __syncthreads();
    {   float fa[8], fb[8], fk[8], fr_[8];
#pragma unroll
        for (int j = 0; j < 8; ++j) { const float cm = LW[t * 64 + c0 + j], en = __expf(-cm), el = __expf(CUML[c0 + j] - cm);
            fa[j] = av[j] * __expf(cm - lw[j]); fb[j] = bv[j] * en; fk[j] = kr[j] * en; fr_[j] = rr[j] * __expf(cm);
            BBT[(c0 + j) * LDT + t] = (bf16)f2bf(bv[j] * el); KBT[(c0 + j) * LDT + t] = (bf16)f2bf(kr[j] * el); VT[(c0 + j) * LDT + t] = (bf16)f2bf(vv[j]); }
        *(LAS u32x4*)(AT + t * LDT + c0) = pack8(fa); *(LAS u32x4*)(BT + t * LDT + c0) = pack8(fb); *(LAS u32x4*)(KT + t * LDT + c0) = pack8(fk); *(LAS u32x4*)(RT + t * LDT + c0) = pack8(fr_);
    }
    __syncthreads();
#pragma unroll
    for (int q = 0; q < 2; ++q) { const int id = 2 * w + q, tt = id >> 2, ss = id & 3; f32x4 ab = F4Z, ak = F4Z, rb = F4Z, rk = F4Z;
        if (ss <= tt) {
            ab = tile_mm<64>(BT + (16 * ss) * LDT, LDT, AT + (16 * tt) * LDT, LDT, ab, fr, fq); ak = tile_mm<64>(KT + (16 * ss) * LDT, LDT, AT + (16 * tt) * LDT, LDT, ak, fr, fq);
            rb = tile_mm<64>(BT + (16 * ss) * LDT, LDT, RT + (16 * tt) * LDT, LDT, rb, fr, fq); rk = tile_mm<64>(KT + (16 * ss) * LDT, LDT, RT + (16 * tt) * LDT, LDT, rk, fr, fq);
        }
        const int tq = 16 * tt + fr, s0 = 16 * ss + 4 * fq;
#pragma unroll
        for (int r = 0; r < 4; ++r) { if (s0 + r >= tq) { ab[r] = 0.f; ak[r] = 0.f; } if (s0 + r > tq) { rb[r] = 0.f; rk[r] = 0.f; } }
        *(LAS u32x2*)(TAB + tq * LDT + s0) = pack4(ab); *(LAS u32x2*)(TAK + tq * LDT + s0) = pack4(ak); *(LAS u32x2*)(MRB + tq * LDT + s0) = pack4(rb); *(LAS u32x2*)(MRK + tq * LDT + s0) = pack4(rk);
    }
    __syncthreads();
#pragma unroll
    for (int q = 0; q < 2; ++q) { const int id = 2 * w + q, vb = id >> 2, tt = id & 3;
        const f32x4 a = tile_mm<64>(VT + (16 * vb) * LDT, LDT, TAK + (16 * tt) * LDT, LDT, F4Z, fr, fq);
#pragma unroll
        for (int r = 0; r < 4; ++r) RHSV[(16 * vb + 4 * fq + r) * 65 + 16 * tt + fr] = a[r]; }
    for (int i = tid; i < 128 * LDT / 8; i += 512) ((LAS u32x4*)XT)[i] = z4;
    __syncthreads();
#pragma unroll
    for (int bi = 0; bi < 4; ++bi) {
        if (bi > 0) {
            const f32x4 u = tile_mm<64>(XT + (16 * w) * LDT, LDT, TAB + (16 * bi) * LDT, LDT, F4Z, fr, fq);
#pragma unroll
            for (int r = 0; r < 4; ++r) UPD[(16 * w + 4 * fq + r) * 17 + fr] = u[r];
            __syncthreads();
        }
        if (tid < 128) { const int col = tid; float x[16];
#pragma unroll
            for (int i = 0; i < 16; ++i) { const int tr = 16 * bi + i;
                float s = (col < 64) ? bf2f(AT[tr * LDT + col]) : RHSV[(col - 64) * 65 + tr];
                if (bi > 0) s += UPD[col * 17 + i];
                float tf[16];
                if (i > 0) unpack8(*(const LAS u32x4*)(TAB + tr * LDT + 16 * bi), tf);
                if (i > 8) unpack8(*(const LAS u32x4*)(TAB + tr * LDT + 16 * bi + 8), tf + 8);
#pragma unroll
                for (int i2 = 0; i2 < i; ++i2) s += tf[i2] * x[i2];
                x[i] = s; asm volatile("" ::: "memory"); }
            *(LAS u32x4*)(XT + col * LDT + 16 * bi) = pack8(x); *(LAS u32x4*)(XT + col * LDT + 16 * bi + 8) = pack8(x + 8);
        }
        __syncthreads();
    }
    bf16* PQ = (bf16*)(S + SO_RW_PQ) + (size_t)item * 8192;
#pragma unroll
    for (int q = 0; q < 2; ++q) { const int id = 2 * w + q, ib = id >> 2, jb = id & 3;
        {
            f32x4 a = tile_mm<64>(XT + (16 * ib) * LDT, LDT, MRB + (16 * jb) * LDT, LDT, F4Z, fr, fq);
            const int tq = 16 * jb + fr, j0 = 16 * ib + 4 * fq; const u32x2 rt = *(const LAS u32x2*)(RT + tq * LDT + j0);
            a[0] += bflo(rt.x); a[1] += bfhi(rt.x); a[2] += bflo(rt.y); a[3] += bfhi(rt.y);
            if (!DRY) *(u32x2*)(Z + (size_t)(rowb + tq) * ZP + ZD_R + hc0 + j0) = pack4(a); else asm volatile("" :: "v"(a)); }
        {
            f32x4 a = tile_mm<64>(XT + (64 + 16 * ib) * LDT, LDT, MRB + (16 * jb) * LDT, LDT, F4Z, fr, fq);
            a = tile_mm<64>(VT + (16 * ib) * LDT, LDT, MRK + (16 * jb) * LDT, LDT, a, fr, fq);
            if (!DRY) *(u32x2*)(Z + (size_t)(rowb + 16 * jb + fr) * ZP + ZD_K + hc0 + 16 * ib + 4 * fq) = pack4(a); else asm volatile("" :: "v"(a)); }
        {
            f32x4 a = tile_mm<64>(XT + (16 * ib) * LDT, LDT, BBT + (16 * jb) * LDT, LDT, F4Z, fr, fq);
            const int k = 16 * jb + fr, j0 = 16 * ib + 4 * fq;
#pragma unroll
            for (int r = 0; r < 4; ++r) if (j0 + r == k) a[r] += GL[k];
            if (!DRY) *(u32x2*)(PQ + (size_t)k * 64 + j0) = pack4(a); else asm volatile("" :: "v"(a)); }
        {
            f32x4 a = tile_mm<64>(BBT + (16 * ib) * LDT, LDT, XT + (64 + 16 * jb) * LDT, LDT, F4Z, fr, fq);
            a = tile_mm<64>(KBT + (16 * ib) * LDT, LDT, VT + (16 * jb) * LDT, LDT, a, fr, fq);
            if (!DRY) *(u32x2*)(PQ + 4096 + (size_t)(16 * jb + fr) * 64 + 16 * ib + 4 * fq) = pack4(a); else asm volatile("" :: "v"(a)); }
    }
    __syncthreads();
}
__device__ __forceinline__ void rw_passB(const Ctx& C, int unit) {
    const int bh = unit >> 2, vg = unit & 3, lane = C.lane, fr = lane & 15, fq = lane >> 4;
    LAS bf16* SL = (LAS bf16*)(C.lds + C.wave * 16384);
    bf16* PQ0 = (bf16*)(C.ws + WS_S + SO_RW_PQ) + (size_t)bh * 64 * 8192;
    for (int i = lane; i < 16 * LDT / 8; i += 64) ((LAS u32x4*)SL)[i] = (u32x4){0u, 0u, 0u, 0u};
    LDS_WAIT(); __builtin_amdgcn_wave_barrier();
    bf16x8 pa[4][4][2]; u32x2 qa[4][4];
#define RWB_FETCH(s, cc) do { const bf16* P_ = PQ0 + (size_t)(cc) * 8192; const bf16* Q_ = P_ + 4096 + (size_t)(16 * vg) * 64; _Pragma("unroll") for (int kk = 0; kk < 4; ++kk) { \
        pa[s][kk][0] = ld8(P_ + (size_t)(16 * kk + fr) * 64 + 8 * fq); pa[s][kk][1] = ld8(P_ + (size_t)(16 * kk + fr) * 64 + 32 + 8 * fq); qa[s][kk] = *(const u32x2*)(Q_ + (size_t)fr * 64 + 16 * kk + 4 * fq); } } while (0)
    RWB_FETCH(0, 0); RWB_FETCH(1, 1); RWB_FETCH(2, 2); RWB_FETCH(3, 3);
    for (int c4 = 0; c4 < 64; c4 += 4) {
#pragma unroll
        for (int s = 0; s < 4; ++s) {
            const int c = c4 + s;
            bf16* QT = PQ0 + (size_t)c * 8192 + 4096 + (size_t)(16 * vg) * 64;
            const bf16x8 b0 = ld8(SL + fr * LDT + 8 * fq), b1 = ld8(SL + fr * LDT + 32 + 8 * fq);
            const u32x4 s0 = *(const LAS u32x4*)(SL + (lane >> 2) * LDT + (lane & 3) * 16), s1 = *(const LAS u32x4*)(SL + (lane >> 2) * LDT + (lane & 3) * 16 + 8);
            f32x4 acc[4];
#pragma unroll
            for (int kk = 0; kk < 4; ++kk) {
                f32x4 a; a[0] = bflo(qa[s][kk].x); a[1] = bfhi(qa[s][kk].x); a[2] = bflo(qa[s][kk].y); a[3] = bfhi(qa[s][kk].y);
                a = __builtin_amdgcn_mfma_f32_16x16x32_bf16(pa[s][kk][0], b0, a, 0, 0, 0);
                acc[kk] = __builtin_amdgcn_mfma_f32_16x16x32_bf16(pa[s][kk][1], b1, a, 0, 0, 0);
            }
            LDS_WAIT(); __builtin_amdgcn_wave_barrier();
            *(u32x4*)(QT + (size_t)(lane >> 2) * 64 + (lane & 3) * 16) = s0; *(u32x4*)(QT + (size_t)(lane >> 2) * 64 + (lane & 3) * 16 + 8) = s1;
#pragma unroll
            for (int kk = 0; kk < 4; ++kk) *(LAS u32x2*)(SL + fr * LDT + 16 * kk + 4 * fq) = pack4(acc[kk]);
            LDS_WAIT(); __builtin_amdgcn_wave_barrier();
            if (c + 4 < 64) RWB_FETCH(s, c + 4);
        }
    }
#undef RWB_FETCH
}
template <bool DRY = false> __device__ __forceinline__ void rw_passC(const Ctx& C, int l, int item) {
    const int bh = item >> 6, c = item & 63, b = bh >> 3, h = bh & 7, hc0 = h * 64, rowb = b * SEQ + c * LCH;
    bf16* Z = (bf16*)(C.ws + WS_Z); unsigned char* S = C.ws + WS_S;
    const int tt = C.wave & 3, lane = C.lane, fr = lane & 15, fq = lane >> 4, t = 16 * tt + fr, row = rowb + t;
    LAS bf16* XG = (LAS bf16*)(C.lds + tt * 4608);
    const float* mu = C.inp(I_RW_MU, l, 1792); const u32x4 z4 = (u32x4){0u, 0u, 0u, 0u};
    {
        const int tl = lane >> 2, rw = rowb + 16 * tt + tl; const bool first = (c * LCH + 16 * tt + tl == 0);
#pragma unroll
        for (int q = 0; q < 4; ++q) { const int j0 = (lane & 3) * 32 + q * 8; float f[8];
            const u32x4 cg = *(const u32x4*)(Z + (size_t)rw * ZP + ZD_XG + j0), pg = first ? z4 : *(const u32x4*)(Z + (size_t)(rw - 1) * ZP + ZD_XG + j0);
            shift8(cg, pg, mu + 1664 + j0, f);
#pragma unroll
            for (int j = 0; j < 8; ++j) f[j] = sigmoidf_(f[j]);
            *(LAS u32x4*)(XG + tl * 136 + j0) = pack8(f); }
    }
    LDS_WAIT(); __builtin_amdgcn_wave_barrier();
    const bf16* SST = (const bf16*)(S + SO_RW_PQ) + (size_t)item * 8192 + 4096;
    const bf16* GUP = (const bf16*)(S + SO_RW_W) + 2 * 512 * 64 + (size_t)hc0 * 128;
    f32x4 y[4], g[4];
#pragma unroll
    for (int vb = 0; vb < 4; ++vb) {
        y[vb] = tile_mm<64>(SST + (size_t)(16 * vb) * 64, 64, Z + (size_t)(rowb + 16 * tt) * ZP + ZD_R + hc0, ZP, F4Z, fr, fq);
        const u32x2 yl = *(const u32x2*)(Z + (size_t)row * ZP + ZD_K + hc0 + 16 * vb + 4 * fq);
        y[vb][0] += bflo(yl.x); y[vb][1] += bfhi(yl.x); y[vb][2] += bflo(yl.y); y[vb][3] += bfhi(yl.y);
        g[vb] = tile_mm<128>(GUP + (size_t)(16 * vb) * 128, 128, XG, 136, F4Z, fr, fq);
    }
    float s1 = 0.f;
#pragma unroll
    for (int vb = 0; vb < 4; ++vb) s1 += (y[vb][0] + y[vb][1]) + (y[vb][2] + y[vb][3]);
    s1 += shx(s1, 16, lane); s1 += shx(s1, 32, lane);
    const float mean = s1 * (1.0f / 64); float s2 = 0.f;
#pragma unroll
    for (int vb = 0; vb < 4; ++vb)
#pragma unroll
        for (int r = 0; r < 4; ++r) { const float d = y[vb][r] - mean; y[vb][r] = d; s2 += d * d; }
    s2 += shx(s2, 16, lane); s2 += shx(s2, 32, lane);
    const float rs = 1.0f / sqrtf(s2 * (1.0f / 64) + 64e-5f);
    const float rho = ((const float*)(S + SO_RW_RHO))[(size_t)row * 8 + h];
    const bool first = (c * LCH + t == 0);
#pragma unroll
    for (int vb = 0; vb < 4; ++vb) { const int v0 = 16 * vb + 4 * fq;
        const u32x2 cv = *(const u32x2*)(Z + (size_t)row * ZP + ZD_V + hc0 + v0); u32x2 pv; pv.x = 0u; pv.y = 0u;
        if (!first) pv = *(const u32x2*)(Z + (size_t)(row - 1) * ZP + ZD_V + hc0 + v0);
        const float cvf[4] = {bflo(cv.x), bfhi(cv.x), bflo(cv.y), bfhi(cv.y)}, pvf[4] = {bflo(pv.x), bfhi(pv.x), bflo(pv.y), bfhi(pv.y)};
        const float* gn = C.inp(I_RW_NORM, l, WB) + hc0 + v0; const float* mv = mu + 1024 + hc0 + v0; f32x4 o;
#pragma unroll
        for (int r = 0; r < 4; ++r) { const float vs = cvf[r] + mv[r] * (pvf[r] - cvf[r]); o[r] = (y[vb][r] * rs * gn[r] + rho * vs) * g[vb][r]; }
        y[vb] = o; }
    asm volatile("s_waitcnt vmcnt(0)" ::: "memory"); __builtin_amdgcn_wave_barrier();
#pragma unroll
    for (int vb = 0; vb < 4; ++vb) { if (!DRY) *(u32x2*)(Z + (size_t)row * ZP + ZD_R + hc0 + 16 * vb + 4 * fq) = pack4(y[vb]); else asm volatile("" :: "v"(y[vb])); }
    LDS_WAIT(); __builtin_amdgcn_wave_barrier();
}

__device__ __forceinline__ void rw_s5_passC(const Ctx& C, int l) {
    s5_passC_core(C, l, [&]() {
#pragma unroll 1
        for (int i = 0; i < 8; ++i) { const Ctx Ci = make_ctx(); rw_passC(Ci, l, (int)blockIdx.x + 256 * i); }
    });
}
template <class Epi, bool ALIGN> __device__ __forceinline__ void run_gemm(const Ctx& C, const bf16* A, int lda, const bf16* Bt, int ldb, int Mr, int N, int K, const Epi& E, int Gv = 0, int cv = 0) {
    if (Gv == 0) { Gv = C.G; cv = C.bid; }
    if (cv < 0 || cv >= Gv) return;
    pg8::Gemm g{A, Bt, Mr, N, K, lda, ldb}; pg8::StaticOrder S; S.init(Mr, N, Gv, cv);
    pg8::gemm_phase<Epi, pg8::StaticOrder, ALIGN, true>(C.lds, g, S, E);
}

#ifdef PROBE_LO
#define PROBE_STAMP(Cb) do { if (blockIdx.x == 0 && (Cb).tid == 0) { volatile LAS unsigned* m_ = (volatile LAS unsigned*)((Cb).lds + MISC_OFF); const unsigned i_ = m_[16]; m_[16] = i_ + 1u; \
    __hip_atomic_store((unsigned long long*)((Cb).ws + WS_CTL + 32768) + i_, (unsigned long long)__builtin_amdgcn_s_memrealtime(), __ATOMIC_RELAXED, __HIP_MEMORY_SCOPE_AGENT); } } while (0)
#else
#define PROBE_STAMP(Cb) do { } while (0)
#endif
#define GRID_BAR() do { const Ctx Cb = make_ctx(); XcdBarrier b_; b_.bar = (unsigned*)(Cb.ws + WS_CTL) + 4096; b_.x = xb_xcc_id(); b_.st = (volatile LAS unsigned*)(Cb.lds + MISC_OFF) + 8; xcd_barrier(b_); PROBE_STAMP(Cb); } while (0)
#define PHASE_CTX() const Ctx C = make_ctx(); unsigned char* const ws = C.ws; bf16* const XB = (bf16*)(ws + WS_XB); float* const SSQ = (float*)(ws + WS_SSQ); bf16* const Z = (bf16*)(ws + WS_Z); \
    const int gw = C.bid * 8 + C.wave, NGW = C.G * 8; (void)XB; (void)SSQ; (void)Z; (void)gw; (void)NGW
#define SUBSYNC() do { VM_WAIT(); __syncthreads(); } while (0)
#define MERGE_PTRS() unsigned char* const G8 = ws + WS_G8; bf16* const MF = (bf16*)(ws + WS_MF); bf16* const MG = Z + ZC_Q; const bf16* const WG = (const bf16*)(ws + WS_SLOTA); const bf16* const WP = (const bf16*)(ws + WS_SLOTC); \
    const float* const gb = C.inp(I_GATE_BIAS, l, 4 * D); (void)G8; (void)MF; (void)MG; (void)WG; (void)WP; (void)gb
#define PHM_IN() \
        if (PH_ON(3)) {   PHASE_CTX(); \
            run_conv(C, CJ_PROJ | CJ_MLW | CJ_RWW, l, gw, NGW); \
            s5_prep(C, l, C.bid >> 3, C.bid & 7); \
            { EpiZ E{Z, SSQ, (bf16*)(ws + WS_S + RWW_OFF - 512 * 1024)}; run_gemm<EpiZ, true>(C, XB, D, (const bf16*)(ws + WS_SLOTB), D, M, NINP, D, E); } \
        } \
        GRID_BAR();
#define PHM_MIXA() \
        if (PH_ON(4)) {   PHASE_CTX(); \
            run_conv(C, CJ_XW, l, gw, NGW); \
            if (DUPM == 10 && l == 0) for (int it = blockIdx.x; it < 2048; it += gridDim.x) { const Ctx Ci = make_ctx(); rw_passA<true>(Ci, l, it); } \
            for (int it = blockIdx.x; it < 2048; it += gridDim.x) { const Ctx Ci = make_ctx(); rw_passA(Ci, l, it); } \
        } \
        if (PH_ON(4)) {   PHASE_CTX(); \
            for (int it = blockIdx.x; it < 1024; it += gridDim.x) { const Ctx Ci = make_ctx(); ml_passA(Ci, l, it); } \
            if (DUPM == 7 && l == 0) for (int it = blockIdx.x; it < 1024; it += gridDim.x) { const Ctx Ci = make_ctx(); ml_passA(Ci, l, it); } \
        } \
        if (PH_ON(4)) {   PHASE_CTX(); \
            for (int it = blockIdx.x; it < 1024; it += gridDim.x) { const Ctx Ci = make_ctx(); gla_passA(Ci, l, it); } \
            if (DUPM == 8 && l == 0) for (int it = blockIdx.x; it < 1024; it += gridDim.x) { const Ctx Ci = make_ctx(); gla_passA(Ci, l, it); } \
            { const Ctx Ci = make_ctx(); s5_passA(Ci); } \
            if (DUPM == 9 && l == 0) { const Ctx Ci = make_ctx(); s5_passA(Ci); } \
        } \
        GRID_BAR();
#define PHM_MIXB() \
        if (PH_ON(4)) {   PHASE_CTX(); \
            if ((gw & 15) == 0 && (gw >> 4) < 128) rw_passB(C, gw >> 4); \
        } \
        if (PH_ON(4)) {   PHASE_CTX(); \
            ml_passB(C); \
        } \
        if (PH_ON(4)) {   PHASE_CTX(); \
            gla_passB(C); \
        } \
        if (PH_ON(4)) {   PHASE_CTX(); \
            s5_passB(C); \
        } \
        GRID_BAR();
#define PHM_MIXC() \
        if (PH_ON(4)) {   PHASE_CTX(); \
            { const Ctx Ci = make_ctx(); rw_s5_passC(Ci, l); } \
        } \
        __syncthreads(); \
        if (PH_ON(4)) {   PHASE_CTX(); \
            if (DUPM == 12 && l == 0) for (int it = blockIdx.x; it < 1024; it += gridDim.x) { const Ctx Ci = make_ctx(); ml_passC<true>(Ci, l, it); } \
            for (int it = blockIdx.x; it < 1024; it += gridDim.x) { const Ctx Ci = make_ctx(); ml_passC(Ci, l, it); } \
        } \
        if (PH_ON(4)) {   PHASE_CTX(); \
            if (DUPM == 13 && l == 0) for (int it = blockIdx.x; it < 1024; it += gridDim.x) { const Ctx Ci = make_ctx(); gla_passC<true>(Ci, l, it); } \
            for (int it = blockIdx.x; it < 1024; it += gridDim.x) { const Ctx Ci = make_ctx(); gla_passC(Ci, l, it); } \
        } \
        if (PH_ON(4)) {   PHASE_CTX(); \
        } \
        GRID_BAR();
#define PHM_MERGE() \
        if (PH_ON(5)) { PHASE_CTX(); MERGE_PTRS(); pg8::StaticOrder S0; S0.init(M, D, C.G, C.bid); pg8::Unit u0; S0.next(0, u0); OwnTile4 S4{u0.pm, u0.pn}; \
            pg8::Gemm g{XB, WG, M, 4 * D, D, D, D}; EpiGate8 E{G8, SSQ, gb}; pg8::gemm_phase<EpiGate8, OwnTile4, true, true>(C.lds, g, S4, E); } SUBSYNC(); \
        if (PH_ON(5)) { PHASE_CTX(); MERGE_PTRS(); EpiMerge8<0> E{G8, 0, MF, MG, ZP}; run_gemm<EpiMerge8<0>, false>(C, Z + ZA_O, ZP, WP, WB, M, D, WB, E); } SUBSYNC(); \
        if (PH_ON(5)) { PHASE_CTX(); MERGE_PTRS(); EpiGlu8 E{G8}; run_gemm<EpiGlu8, false>(C, Z + ZB_U, ZP, WP + 2 * (size_t)D * WB, WB, M, D, WB, E); } SUBSYNC(); \
        if (PH_ON(5)) { PHASE_CTX(); MERGE_PTRS(); EpiMerge8<1> E{G8, 1, MF, MG, ZP}; run_gemm<EpiMerge8<1>, false>(C, Z + ZB_U, ZP, WP + (size_t)D * WB, WB, M, D, WB, E); } SUBSYNC(); \
        if (PH_ON(5)) { PHASE_CTX(); MERGE_PTRS(); EpiMerge8<1> E{G8, 2, MF, MG, ZP}; run_gemm<EpiMerge8<1>, false>(C, Z + ZC_G, ZP, WP + 3 * (size_t)D * WB, WB, M, D, WB, E); } SUBSYNC(); \
        if (PH_ON(5)) { PHASE_CTX(); MERGE_PTRS(); EpiMerge8<2> E{G8, 3, MF, MG, ZP}; run_gemm<EpiMerge8<2>, false>(C, Z + ZD_R, ZP, WP + 4 * (size_t)D * WB, WB, M, D, WB, E); } \
        GRID_BAR();
#ifdef DUP_MODE
constexpr int DUPM = DUP_MODE;
#else
constexpr int DUPM = 0;
#endif
#ifndef STOP_AFTER
#define STOP_AFTER 1000
#endif
#define PH_ON(n) ((l) * 20 + (n) <= STOP_AFTER)
template <int l> __device__ __forceinline__ void layer_fwd() {
        if (PH_ON(1)) {   PHASE_CTX();
            if (l > 0) { run_conv(C, CJ_D1, l, gw, NGW); }
            { EpiSwiglu E{(bf16*)(ws + WS_HID), SSQ}; run_gemm<EpiSwiglu, true>(C, XB, D, (const bf16*)(ws + WS_SLOTA), D, M, 2 * FF, D, E); }
            if (l == 0) {
                for (int q = 0; q < DEPTH; ++q) { EpiKV E{(bf16*)(ws + WS_KV + (size_t)q * 4 * MiB), (bf16*)(ws + WS_KV + (size_t)q * 4 * MiB + 2 * MiB), (const float*)(ws + WS_MEMR)};
                    run_gemm<EpiKV, true>(C, (const bf16*)(ws + WS_MEMB), D, (const bf16*)(ws + WS_S + (size_t)q * 4 * MiB), D, MMEM, 2 * D, D, E, 32, C.bid - 128 - 32 * q); }
            }
        }
        GRID_BAR();
        if (DUPM == 14 && l == 0) {
        if (PH_ON(1)) {   PHASE_CTX();

            { EpiSwiglu E{(bf16*)(ws + WS_HID), SSQ}; run_gemm<EpiSwiglu, true>(C, XB, D, (const bf16*)(ws + WS_SLOTA), D, M, 2 * FF, D, E); }
            if (l == 0) {
                for (int q = 0; q < DEPTH; ++q) { EpiKV E{(bf16*)(ws + WS_KV + (size_t)q * 4 * MiB), (bf16*)(ws + WS_KV + (size_t)q * 4 * MiB + 2 * MiB), (const float*)(ws + WS_MEMR)};
                    run_gemm<EpiKV, true>(C, (const bf16*)(ws + WS_MEMB), D, (const bf16*)(ws + WS_S + (size_t)q * 4 * MiB), D, MMEM, 2 * D, D, E, 32, C.bid - 128 - 32 * q); }
            }
        }
        GRID_BAR();
        }
        if (PH_ON(2)) {   PHASE_CTX();
            run_conv(C, CJ_GATES, l, gw, NGW);
            { EpiResid E{(l == 0) ? C.in[I_X] : (const float*)C.X, C.X, XB, SSQ, 0.5f}; run_gemm<EpiResid, false>(C, (const bf16*)(ws + WS_HID), FF, (const bf16*)(ws + WS_SLOTC), FF, M, D, FF, E); }
        }
        GRID_BAR();
#if defined(DUP_MODE)
        if (l == 0 && DUP_MODE >= 1 && DUP_MODE <= 4) {
#if DUP_MODE == 1
            PHM_IN();
#elif DUP_MODE == 2
            PHM_IN(); PHM_MIXA();
#elif DUP_MODE == 3
            PHM_IN(); PHM_MIXA(); PHM_MIXB();
#elif DUP_MODE == 4
            PHM_IN(); PHM_MIXA(); PHM_MIXB(); PHM_MIXC();
#endif
            { PHASE_CTX(); run_conv(C, CJ_WIN, l, gw, NGW); } GRID_BAR();
            GRID_BAR();
        }
#endif
        PHM_IN(); PHM_MIXA(); PHM_MIXB(); PHM_MIXC();
        PHM_MERGE();
#if defined(DUP_MODE) && DUP_MODE == 5
        if (l == 0) { PHM_MERGE(); }
#endif
        if (PH_ON(6)) {   PHASE_CTX();
            run_conv(C, CJ_GU2 | CJ_D2, l, gw, NGW);
            { EpiResid E{C.X, C.X, XB, SSQ, 1.0f}; run_gemm<EpiResid, false>(C, Z + ZC_Q, ZP, (const bf16*)(ws + WS_SLOTB), D, M, D, D, E); }
        }
        GRID_BAR();
        {
            const int un = blockIdx.x; const int pm = un >> 2, hh = un & 3, bb = pm >> 4;
            if (PH_ON(8)) {   PHASE_CTX();
                bf16* Qp = (bf16*)(ws + WS_XQ) + (size_t)C.bid * 65536;
                pg8::Gemm g{XB + (size_t)pm * 256 * D, (const bf16*)(ws + WS_SLOTB + 2 * MiB) + (size_t)hh * 256 * D, 256, 256, D, D, D}; pg8::SingleUnit S;
                EpiBf16 E{Qp, 256, SSQ + (size_t)pm * 256 * 16, 0.0625f * 1.4426950408889634f, 256};
                pg8::gemm_phase<EpiBf16, pg8::SingleUnit, false, true>(C.lds, g, S, E);
            }
            SUBSYNC();
            if (PH_ON(8)) {   PHASE_CTX();
                const bf16* Qp = (const bf16*)(ws + WS_XQ) + (size_t)C.bid * 65536;
                const bf16* Kd = (const bf16*)(ws + WS_KV + (size_t)l * 4 * MiB) + (size_t)bb * 256 * D + hh * 256;
                bf16* P = (bf16*)(ws + WS_XP) + (size_t)C.bid * 65536;
                pg8::Gemm g{Qp, Kd, 256, 256, 256, 256, D}; pg8::SingleUnit S; EpiSoftmaxP E{P}; pg8::gemm_phase<EpiSoftmaxP, pg8::SingleUnit, false, true>(C.lds, g, S, E);
            }
            SUBSYNC();
            if (PH_ON(8)) {   PHASE_CTX();
                const bf16* VT = (const bf16*)(ws + WS_KV + (size_t)l * 4 * MiB + 2 * MiB) + (size_t)hh * 256 * MMEM + bb * 256;
                const bf16* P = (const bf16*)(ws + WS_XP) + (size_t)C.bid * 65536;
                pg8::Gemm g{P, VT, 256, 256, 256, 256, MMEM}; pg8::SingleUnit S; EpiBf16 E{(bf16*)(ws + WS_XO) + (size_t)pm * 256 * D + hh * 256, D, nullptr, 1.0f, 256};
                pg8::gemm_phase<EpiBf16, pg8::SingleUnit, false, true>(C.lds, g, S, E);
            }
            SUBSYNC();
        }
        GRID_BAR();
        if (PH_ON(9)) {   PHASE_CTX();
            EpiResid E{C.X, C.X, XB, SSQ, 1.0f}; run_gemm<EpiResid, false>(C, (const bf16*)(ws + WS_XO), D, (const bf16*)(ws + WS_SLOTB + 4 * MiB), D, M, D, D, E);
        }
        GRID_BAR();
        if (PH_ON(10)) {   PHASE_CTX();
            if (l + 1 < DEPTH) { run_conv(C, CJ_WIN, l + 1, gw, NGW); }
            { EpiSwiglu E{(bf16*)(ws + WS_HID), SSQ}; run_gemm<EpiSwiglu, true>(C, XB, D, (const bf16*)(ws + WS_SLOTA), D, M, 2 * FF, D, E); }
        }
        GRID_BAR();
        if (DUPM == 18 && l == 0) {
        if (PH_ON(10)) {   PHASE_CTX();
            if (l + 1 < DEPTH) { run_conv(C, CJ_WIN, l + 1, gw, NGW); }
            { EpiSwiglu E{(bf16*)(ws + WS_HID), SSQ}; run_gemm<EpiSwiglu, true>(C, XB, D, (const bf16*)(ws + WS_SLOTA), D, M, 2 * FF, D, E); }
        }
        GRID_BAR();
        }
        if (PH_ON(11)) {   PHASE_CTX();
            if (l + 1 < DEPTH) { run_conv(C, CJ_GU1, l + 1, gw, NGW); }
            { EpiResid E{C.X, C.X, XB, SSQ, 0.5f}; run_gemm<EpiResid, false>(C, (const bf16*)(ws + WS_HID), FF, (const bf16*)(ws + WS_SLOTC), FF, M, D, FF, E); }
        }
        GRID_BAR();
    }

__global__ void __launch_bounds__(512, 2) fwd_kernel(Args args) {
    extern __shared__ __attribute__((aligned(16))) unsigned char lds_raw[];
    (void)args;
    {
        const Ctx C = make_ctx();
        volatile LAS unsigned* MISC = (volatile LAS unsigned*)(C.lds + MISC_OFF);
        for (int u = C.tid; u < (LDS_BYTES - RING_BYTES) / 4; u += 512) ((LAS unsigned*)(C.lds + RING_BYTES))[u] = 0u;
        __syncthreads();
        (void)xcd_barrier_post((unsigned*)(C.ws + WS_CTL) + 4096, MISC + 8);
        PROBE_STAMP(C);
    }

    {   PHASE_CTX();
        pro_rows(C);
        run_conv(C, CJ_GU1 | CJ_D1 | CJ_WIN | CJ_XKV0 | CJ_XKV1, 0, gw, NGW);
    }
    GRID_BAR();
    if (DUPM == 17) {
    {   PHASE_CTX();
        pro_rows(C);
        run_conv(C, CJ_GU1 | CJ_D1 | CJ_WIN | CJ_XKV0 | CJ_XKV1, 0, gw, NGW);
    }
    GRID_BAR();
    }

    layer_fwd<0>();
    layer_fwd<1>();
    {   PHASE_CTX();
        final_rows(C);
#ifdef PROBE_LO
        {
            __syncthreads();
            const unsigned long long* st = (const unsigned long long*)(ws + WS_CTL + 32768);
            const unsigned long long ta = __hip_atomic_load(st + PROBE_LO, __ATOMIC_RELAXED, __HIP_MEMORY_SCOPE_AGENT), tb = __hip_atomic_load(st + PROBE_HI, __ATOMIC_RELAXED, __HIP_MEMORY_SCOPE_AGENT);
            size_t K = (size_t)((tb - ta) * (unsigned long long)PROBE_SCALE / 16ull); if (K > 180000) K = 180000;
            const int gwv = C.bid * 8 + C.wave, NG = C.G * 8;
            for (int m = gwv; m < M; m += NG) { const size_t base = (size_t)m * D; if (base >= K) break;
                for (int j = C.lane; j < D; j += 64) if (base + j < K) C.X[base + j] += 0.2f; }
        }
#endif
        if (xb_ld((unsigned*)(ws + WS_CTL) + 4096 + XB_TMO) != 0u) {
            for (size_t i = (size_t)C.bid * 512 + C.tid; i < (size_t)M * D; i += (size_t)C.G * 512) C.X[i] = __builtin_nanf("");
        }
    }
}

extern "C" void kernel_launch(void* const* d_in, const int* in_sizes, int n_in, void* d_out, int out_size, void* d_ws, size_t ws_size, hipStream_t stream) {
    static int grid = 0;
    if (grid == 0) {
        if (n_in != N_INPUTS || out_size != M * D || ws_size < WS_END) { fprintf(stderr, "kernel_launch: unexpected shapes: n_in %d out %d ws %zu (need %zu)\n", n_in, out_size, ws_size, (size_t)WS_END); grid = -1; return; }
        int dev = 0, cus = 0, per_cu = 0;
        if (hipGetDevice(&dev) != hipSuccess || hipDeviceGetAttribute(&cus, hipDeviceAttributeMultiprocessorCount, dev) != hipSuccess) { grid = -1; return; }
        if (hipFuncSetAttribute((const void*)fwd_kernel, hipFuncAttributeMaxDynamicSharedMemorySize, LDS_BYTES) != hipSuccess) { fprintf(stderr, "kernel_launch: hipFuncSetAttribute failed\n"); grid = -1; return; }
        if (hipOccupancyMaxActiveBlocksPerMultiprocessor(&per_cu, (const void*)fwd_kernel, 512, LDS_BYTES) != hipSuccess || per_cu < 1) { fprintf(stderr, "kernel_launch: occupancy query says %d workgroups per CU\n", per_cu); (void)hipGetLastError(); grid = -1; return; }
        if (cus < 256) { fprintf(stderr, "kernel_launch: built for a 256-CU device (got %d)\n", cus); grid = -1; return; }
        grid = 256;
    }
    if (grid < 0) return;
    if (hipMemsetAsync((char*)d_ws + WS_CTL, 0, CTL_ZERO_BYTES, stream) != hipSuccess) return;
    Args a{};
    for (int i = 0; i < N_INPUTS; ++i) a.in[i] = (const float*)d_in[i];
    a.out = (float*)d_out; a.ws = (unsigned char*)d_ws;
    hipLaunchKernelGGL(fwd_kernel, dim3(grid), dim3(512), LDS_BYTES, stream, a);
}
```

```cpp
#include <hip/hip_runtime.h>
#include <cstdio>
#include <cstdint>

#define LAS __attribute__((address_space(3)))
#define GAS __attribute__((address_space(1)))
typedef unsigned short bf16;
typedef float f32x4 __attribute__((ext_vector_type(4)));
typedef float f32x2 __attribute__((ext_vector_type(2)));
typedef unsigned u32x4 __attribute__((ext_vector_type(4)));
typedef unsigned u32x2 __attribute__((ext_vector_type(2)));
typedef short bf16x8 __attribute__((ext_vector_type(8)));

constexpr int NB = 4, SEQ = 4096, M = NB * SEQ, D = 1024, FF = 2816, WB = 512, DEPTH = 2, MEML = 256, MMEM = NB * MEML;
constexpr int NZ = 4888, ZP = 4896, NINP = 5120, NIN = 8984;
constexpr int ZA_U = 0, ZA_O = 512, ZA_I = 1024, ZA_F = 1028, ZB_U = 1032, ZC_Q = 1544, ZC_K = 1800, ZC_V = 2056, ZC_G = 2568, ZC_A = 3080;
constexpr int ZD_R = 3096, ZD_K = 3608, ZD_V = 4120, ZD_XW = 4632, ZD_XA = 4696, ZD_XG = 4760, ZG = 4888;
constexpr float NORM_EPS = 1e-6f;

enum { I_X = 0, I_MEM, I_FFN1_NORM, I_FFN1_WG, I_FFN1_WU, I_FFN1_WD, I_MIX_NORM, I_W_IN, I_GATE_BIAS, I_ML_CONV, I_ML_WQ, I_ML_WK, I_ML_WV, I_ML_BI, I_ML_BF,
       I_ML_NORM, I_ML_PROJ, I_S5_ARE, I_S5_AIM, I_S5_LOGSTEP, I_S5_BRE, I_S5_BIM, I_S5_CRE, I_S5_CIM, I_S5_D, I_S5_W1, I_S5_W2, I_GLA_AUP, I_GLA_ABIAS,
       I_GLA_NORM, I_GLA_PROJ, I_RW_MU, I_RW_W0, I_RW_WUP, I_RW_A0, I_RW_AUP, I_RW_GUP, I_RW_KK, I_RW_KA, I_RW_RK, I_RW_NORM, I_RW_PROJ, I_W_OUT,
       I_XA_NORM, I_MEM_NORM, I_XA_WQ, I_XA_WK, I_XA_WV, I_XA_WO, I_FFN2_NORM, I_FFN2_WG, I_FFN2_WU, I_FFN2_WD, I_FINAL_NORM, N_INPUTS };

constexpr size_t MiB = 1u << 20;
constexpr size_t WS_CTL = 0, CTL_ZERO_BYTES = 64 * 1024;
constexpr size_t WS_SSQ = 1 * MiB;
constexpr size_t WS_MEMR = 256 * 1024;
constexpr size_t WS_XB = 2 * MiB;
constexpr size_t WS_MEMB = 34 * MiB;
constexpr size_t WS_KV = 36 * MiB;
constexpr size_t WS_SLOTA = 44 * MiB;
constexpr size_t WS_SLOTB = 55 * MiB;
constexpr size_t WS_SLOTC = 65 * MiB;
constexpr size_t WS_Z = 73 * MiB;
constexpr size_t Z_BYTES = (size_t)M * ZP * 2;
constexpr size_t WS_S = WS_Z + Z_BYTES;
constexpr size_t WS_END = 350110016;
static_assert(WS_S == 226 * MiB, "map");
constexpr size_t S_BYTES = WS_END - WS_S;
constexpr size_t WS_HID = WS_Z;
constexpr size_t WS_XQ = WS_Z, WS_XO = WS_Z + 32 * MiB, WS_XP = WS_Z + 64 * MiB;
constexpr size_t WS_G8 = WS_S, WS_MF = WS_S + 64 * MiB;
static_assert(WS_MF + 32 * MiB <= WS_END, "merge stash");

constexpr int LDS_BYTES = 147456, RING_BYTES = 131072, MISC_OFF = RING_BYTES + 320;

#define RLX_AGENT __ATOMIC_RELAXED, __HIP_MEMORY_SCOPE_AGENT
#define LDS_WAIT() asm volatile("s_waitcnt lgkmcnt(0)" ::: "memory")
#define VM_WAIT() asm volatile("s_waitcnt vmcnt(0)" ::: "memory")
typedef __bf16 bf16x2_t __attribute__((ext_vector_type(2)));
__device__ __forceinline__ unsigned pk2(float lo, float hi) { const f32x2 v = {lo, hi}; return __builtin_bit_cast(unsigned, __builtin_convertvector(v, bf16x2_t)); }
__device__ __forceinline__ unsigned f2bf(float f) { return pk2(f, 0.f); }
__device__ __forceinline__ float bf2f(unsigned h) { return __builtin_bit_cast(float, h << 16); }
__device__ __forceinline__ float bflo(unsigned w) { return __builtin_bit_cast(float, w << 16); }
__device__ __forceinline__ float bfhi(unsigned w) { return __builtin_bit_cast(float, w & 0xffff0000u); }
__device__ __forceinline__ float rcpf_(float x) { return __builtin_amdgcn_rcpf(x); }
__device__ __forceinline__ float rsqf_(float x) { return __builtin_amdgcn_rsqf(x); }
__device__ __forceinline__ float sigmoidf_(float x) { return rcpf_(1.0f + __expf(-x)); }
__device__ __forceinline__ float siluf_(float x) { return x * rcpf_(1.0f + __expf(-x)); }
__device__ __forceinline__ float softplusf_(float x) { return fmaxf(x, 0.f) + __logf(1.0f + __expf(-fabsf(x))); }
__device__ __forceinline__ float tanhf_(float x) { const float e = __expf(-2.0f * fabsf(x)); const float t = (1.0f - e) * rcpf_(1.0f + e); return x < 0.f ? -t : t; }
__device__ __forceinline__ float logsigmoidf_(float x) { return -softplusf_(-x); }
__device__ __forceinline__ float shx(float v, int mask, int lane) { return __builtin_bit_cast(float, __builtin_amdgcn_ds_bpermute((lane ^ mask) << 2, __builtin_bit_cast(int, v))); }
__device__ __forceinline__ float wave_sum(float v, int lane) {
#pragma unroll
    for (int o = 1; o < 64; o <<= 1) v += shx(v, o, lane);
    return v;
}

#define XB_TMO      128
#define XB_XCNT(j)  (256  + 64 * (j))
#define XB_XSUB(j)  (1280 + 64 * (j))
#define XB_XGEN(j)  (2304 + 64 * (j))
#define XB_TOP      3328
#define XB_TOPGEN   3392
#define XCD_BAR_WORDS 3456
#define XB_SPIN_CAP (1u << 20)
__device__ __forceinline__ unsigned xb_ld(unsigned* p)              { return __hip_atomic_load(p, __ATOMIC_RELAXED, __HIP_MEMORY_SCOPE_AGENT); }
__device__ __forceinline__ unsigned xb_add(unsigned* p, unsigned v) { return __hip_atomic_fetch_add(p, v, __ATOMIC_RELAXED, __HIP_MEMORY_SCOPE_AGENT); }
__device__ __forceinline__ unsigned xb_xcc_id() { return (unsigned)__builtin_amdgcn_s_getreg((3 << 11) | 20) & 0xFu; }
#define XB_SPIN(cond, bar) do { unsigned _sp = 0; while (cond) { __builtin_amdgcn_s_sleep(1); \
    if ((++_sp & 255u) == 0u) { if (xb_ld(&(bar)[XB_TMO])) break; if (_sp > XB_SPIN_CAP) { atomicAdd(&(bar)[XB_TMO], 1u); break; } } } } while (0)
struct XcdBarrier { unsigned* bar; unsigned x; volatile LAS unsigned* st; };
__device__ __forceinline__ XcdBarrier xcd_barrier_post(unsigned* bar, volatile LAS unsigned* st) {
    XcdBarrier b; b.bar = bar; b.x = xb_xcc_id(); b.st = st;
    if (threadIdx.x == 0) (void)xb_add(&bar[XB_XCNT(b.x)], 1u);
    return b;
}
__device__ __forceinline__ void xcd_barrier_complete(unsigned* bar, unsigned x, unsigned& nloc, unsigned& nx) {
    const unsigned G = gridDim.x * gridDim.y * gridDim.z;
    unsigned sum, cnt, mine, sp = 0u;
    for (;;) {
        sum = 0u; cnt = 0u; mine = 0u;
#pragma unroll
        for (unsigned j = 0; j < 16; ++j) { const unsigned c = xb_ld(&bar[XB_XCNT(j)]); sum += c; cnt += (c > 0u) ? 1u : 0u; mine = (j == x) ? c : mine; }
        if (sum == G) break;
        __builtin_amdgcn_s_sleep(1);
        if ((++sp & 255u) == 0u) { if (xb_ld(&bar[XB_TMO])) break; if (sp > XB_SPIN_CAP) { atomicAdd(&bar[XB_TMO], 1u); break; } }
    }
    nloc = mine > 0u ? mine : 1u; nx = cnt > 0u ? cnt : 1u;
}
__device__ __forceinline__ void xcd_barrier(const XcdBarrier& b) {
    asm volatile("s_waitcnt vmcnt(0)" ::: "memory");
    __syncthreads();
    if (threadIdx.x == 0) {
        unsigned* bar = b.bar;
        __builtin_amdgcn_s_waitcnt(0);
        unsigned nloc = b.st[0], nx = b.st[1];
        if (nloc == 0u) { xcd_barrier_complete(bar, b.x, nloc, nx); b.st[0] = nloc; b.st[1] = nx; }
        const unsigned old = xb_add(&bar[XB_XSUB(b.x)], 1u);
        const unsigned gen = old / nloc;
        if (old + 1u == (gen + 1u) * nloc) {
            __builtin_amdgcn_fence(__ATOMIC_RELEASE, "agent");
            asm volatile("s_waitcnt vmcnt(0)" ::: "memory");
            const unsigned og = xb_add(&bar[XB_TOP], 1u);
            const unsigned tg = og / nx;
            if (og + 1u == (tg + 1u) * nx) xb_add(&bar[XB_TOPGEN], 1u);
            else XB_SPIN(xb_ld(&bar[XB_TOPGEN]) == tg, bar);
            __builtin_amdgcn_fence(__ATOMIC_ACQUIRE, "agent");
            xb_add(&bar[XB_XGEN(b.x)], 1u);
            asm volatile("s_waitcnt vmcnt(0)" ::: "memory");
        } else {
            XB_SPIN(xb_ld(&bar[XB_XGEN(b.x)]) == gen, bar);
            __builtin_amdgcn_fence(__ATOMIC_ACQUIRE, "agent");
            asm volatile("s_waitcnt vmcnt(0)" ::: "memory");
        }
    }
    __syncthreads();
}
namespace pg8 {
#define PG8_LAS __attribute__((address_space(3)))
typedef unsigned short bf16_t;
typedef short bf16x8 __attribute__((ext_vector_type(8)));
typedef float f32x4 __attribute__((ext_vector_type(4)));
typedef unsigned u32x4 __attribute__((ext_vector_type(4)));
constexpr int BM = 256, BK = 64, HALF = 128, HTB = HALF * BK * 2  , STAGE_BYTES = 8 * HTB, NXCD = 8, WGM = 8;

__host__ __device__ __forceinline__ int lds_byte(int r, int c) { const int st = (r >> 4) * 2 + (c >> 5), rr = r & 15, cc = c & 31, ob = rr * 64 + cc * 2; return st * 1024 + (ob ^ (((ob >> 9) & 1) << 5)); }
__host__ __device__ __forceinline__ void stage_rc(int b, int& R, int& C) { const int st = b / 1024, sb = b % 1024, swz = sb ^ (((sb >> 9) & 1) << 5); R = (st >> 1) * 16 + swz / 64; C = (st & 1) * 32 + (swz % 64) / 2; }
__host__ __device__ __forceinline__ int perm32(int rho) { const int n = rho >> 4, i = rho & 15; return 8 * (i >> 2) + 4 * n + (i & 3); }

struct Unit { int pm, pn; };
struct Gemm { const bf16_t* A; const bf16_t* Bt; int M, N, K, lda, ldb; };

struct StaticOrder {
    int nM, nN, nwg, G, c;
    __host__ __device__ void init(int M, int N, int G_, int c_) { nM = M / BM; nN = N / BM; nwg = nM * nN; G = G_; c = c_; }
    __host__ __device__ __forceinline__ bool next(int i, Unit& u) const {
        const long L = (long)i * G + c; if (L >= nwg) return false;
        int wgid = (int)L; { const int q = nwg / NXCD, r = nwg % NXCD, xcd = wgid % NXCD, off = wgid / NXCD; wgid = (xcd < r ? xcd * (q + 1) : r * (q + 1) + (xcd - r) * q) + off; }
        const int nig = WGM * nN, gid = wgid / nig, fm = gid * WGM, gsz = (nM - fm) < WGM ? (nM - fm) : WGM;
        u.pm = fm + ((wgid % nig) % gsz); u.pn = (wgid % nig) / gsz; return true;
    }
    __device__ __forceinline__ void a_ready(const Unit&) const {}
    __device__ __forceinline__ void done(const Unit&) const {}
};


struct SingleUnit {
    __device__ __forceinline__ bool next(int i, Unit& u) const { if (i > 0) return false; u.pm = 0; u.pn = 0; return true; }
    __device__ __forceinline__ void a_ready(const Unit&) const {}
    __device__ __forceinline__ void done(const Unit&) const {}
};
typedef __bf16 bf16x2_cv __attribute__((ext_vector_type(2))); typedef float f32x2_cv __attribute__((ext_vector_type(2)));
__device__ __forceinline__ unsigned cvt_pk_bf16(float lo, float hi) { const f32x2_cv v = {lo, hi}; return __builtin_bit_cast(unsigned, __builtin_convertvector(v, bf16x2_cv)); }
template <class Epi, class Sched, bool ALIGN_EPI = false, bool SP2 = false>
__device__ __forceinline__ void gemm_phase(PG8_LAS unsigned char* lds, const Gemm g, const Sched& S, const Epi& E) {
    int tid_ = threadIdx.x; asm volatile("" : "+v"(tid_));
    const int tid = tid_, wid = __builtin_amdgcn_readfirstlane(tid >> 6), lane = tid & 63, wr = wid >> 2, wc = wid & 3, fr = lane & 15, fq = lane >> 4;
    const int K = g.K, nt = K / BK, lda = g.lda, ldb = g.ldb;
    unsigned voffA[2], voffB[2];
#pragma unroll
    for (int i = 0; i < 2; ++i) { int R, C; stage_rc(tid * 16 + i * 8192, R, C); const int Rb = Epi::PERM ? ((R & ~31) + perm32(R & 31)) : R;
        voffA[i] = (unsigned)(R * lda + C) * 2u; voffB[i] = (unsigned)(Rb * ldb + C) * 2u; }
    const size_t kstep = (size_t)(BK * 2);
    const size_t hstepA = (size_t)HALF * lda * 2, hstepB = (size_t)HALF * ldb * 2;
    const size_t tstepA = 2 * hstepA, tstepB = 2 * hstepB;
    const unsigned ldsw = (unsigned)wid * 1024u;
    const int aoff = lds_byte(wr * 64 + fr, fq * 8), boff = lds_byte(wc * 32 + fr, fq * 8);
#define PG8_SA(b, h) (((b) * 2 + (h)) * HTB)
#define PG8_SB(b, h) ((4 + (b) * 2 + (h)) * HTB)
#define PG8_STAGE(bufoff, gbase, voff) do { _Pragma("unroll") for (int _i = 0; _i < 2; ++_i) \
        __builtin_amdgcn_global_load_lds((const unsigned*)((const char*)(gbase) + (voff)[_i]), (PG8_LAS unsigned*)(lds + (bufoff) + ldsw + _i * 8192), 16, 0, 0); } while (0)
#define PG8_LDA(dst, b, h) do { _Pragma("unroll") for (int m = 0; m < 4; ++m) _Pragma("unroll") for (int k = 0; k < 2; ++k) dst[m][k] = *(const PG8_LAS bf16x8*)(lds + PG8_SA(b, h) + aoff + m * 2048 + k * 1024); } while (0)
#define PG8_LDB(dst, b, h) do { _Pragma("unroll") for (int n = 0; n < 2; ++n) _Pragma("unroll") for (int k = 0; k < 2; ++k) dst[n][k] = *(const PG8_LAS bf16x8*)(lds + PG8_SB(b, h) + boff + n * 2048 + k * 1024); } while (0)
#define PG8_MMA(ai, bj, At, Bt) do { __builtin_amdgcn_s_setprio(1); _Pragma("unroll") for (int m = 0; m < 4; ++m) _Pragma("unroll") for (int n = 0; n < 2; ++n) _Pragma("unroll") for (int k = 0; k < 2; ++k) \
        acc[ai][bj][m][n] = __builtin_amdgcn_mfma_f32_16x16x32_bf16(Bt[n][k], At[m][k], acc[ai][bj][m][n], 0, 0, 0); __builtin_amdgcn_s_setprio(0); } while (0)
#define PG8_WAIT_V(n) asm volatile("s_waitcnt vmcnt(" #n ")" ::: "memory")
#define PG8_WAIT_L(n) asm volatile("s_waitcnt lgkmcnt(" #n ")" ::: "memory")
#define PG8_BAR __builtin_amdgcn_s_barrier()
#define PG8_SCHED __builtin_amdgcn_sched_barrier(0)
    Unit cur, nxt; int ui = 0;
    if (!S.next(0, cur)) return;
    f32x4 acc[2][2][4][2];
#pragma unroll
    for (int a = 0; a < 2; ++a)
#pragma unroll
        for (int b = 0; b < 2; ++b)
#pragma unroll
            for (int m = 0; m < 4; ++m)
#pragma unroll
                for (int n = 0; n < 2; ++n) acc[a][b][m][n] = (f32x4){0.f, 0.f, 0.f, 0.f};
    bf16x8 At[4][2], B0[2][2], B1[2][2];
    const char* cA = (const char*)g.A + (size_t)cur.pm * tstepA; const char* cB = (const char*)g.Bt + (size_t)cur.pn * tstepB;
    S.a_ready(cur);
    if constexpr (SP2) {
        PG8_STAGE(PG8_SB(0, 0), cB, voffB); PG8_STAGE(PG8_SB(0, 1), cB + hstepB, voffB); PG8_STAGE(PG8_SA(0, 0), cA, voffA); PG8_STAGE(PG8_SA(0, 1), cA + hstepA, voffA);
        if (wr == 1) PG8_BAR;
        PG8_WAIT_V(2); PG8_BAR;
        PG8_STAGE(PG8_SB(1, 0), cB + kstep, voffB); PG8_STAGE(PG8_SA(1, 0), cA + kstep, voffA); PG8_STAGE(PG8_SB(1, 1), cB + hstepB + kstep, voffB);
        PG8_WAIT_V(6); PG8_BAR;
    } else {
        PG8_STAGE(PG8_SB(0, 0), cB, voffB); PG8_STAGE(PG8_SA(0, 0), cA, voffA); PG8_STAGE(PG8_SB(0, 1), cB + hstepB, voffB); PG8_STAGE(PG8_SA(0, 1), cA + hstepA, voffA);
        if (wr == 1) PG8_BAR;
        PG8_WAIT_V(4); PG8_BAR;
        PG8_STAGE(PG8_SB(1, 0), cB + kstep, voffB); PG8_STAGE(PG8_SA(1, 0), cA + kstep, voffA); PG8_STAGE(PG8_SB(1, 1), cB + hstepB + kstep, voffB);
        PG8_WAIT_V(6); PG8_BAR;
    }
    for (;;) {
        const bool has_next = S.next(ui + 1, nxt);
        const char* nA = has_next ? (const char*)g.A + (size_t)nxt.pm * tstepA : cA; const char* nB = has_next ? (const char*)g.Bt + (size_t)nxt.pn * tstepB : cB;
        for (int t = 0; t < nt; t += 2) {
            const bool last = (t == nt - 2);
            const char* a1 = cA + (size_t)(t + 1) * kstep;
            const char* a2 = last ? nA : cA + (size_t)(t + 2) * kstep; const char* b2 = last ? nB : cB + (size_t)(t + 2) * kstep;
            const char* a3 = a2 + kstep; const char* b3 = b2 + kstep;
            if (last && has_next) S.a_ready(nxt);
            if constexpr (SP2) {
            PG8_LDB(B0, 0, 0); PG8_LDB(B1, 0, 1); PG8_SCHED; PG8_LDA(At, 0, 0); PG8_STAGE(PG8_SA(1, 1), a1 + hstepA, voffA);
            PG8_WAIT_V(8); PG8_WAIT_L(0); PG8_BAR; PG8_MMA(0, 0, At, B0); PG8_MMA(0, 1, At, B1); PG8_BAR; PG8_SCHED;
            PG8_LDA(At, 0, 1); PG8_STAGE(PG8_SB(0, 0), b2, voffB); PG8_STAGE(PG8_SB(0, 1), b2 + hstepB, voffB); PG8_STAGE(PG8_SA(0, 0), a2, voffA);
            PG8_WAIT_V(8); PG8_WAIT_L(0); PG8_BAR; PG8_MMA(1, 0, At, B0); PG8_MMA(1, 1, At, B1); PG8_BAR; PG8_SCHED;
            PG8_LDB(B0, 1, 0); PG8_LDB(B1, 1, 1); PG8_SCHED; PG8_LDA(At, 1, 0); PG8_STAGE(PG8_SA(0, 1), a2 + hstepA, voffA);
            PG8_WAIT_V(8); PG8_WAIT_L(0); PG8_BAR; PG8_MMA(0, 0, At, B0); PG8_MMA(0, 1, At, B1); PG8_BAR; PG8_SCHED;
            PG8_LDA(At, 1, 1); PG8_STAGE(PG8_SB(1, 0), b3, voffB); PG8_STAGE(PG8_SB(1, 1), b3 + hstepB, voffB); PG8_STAGE(PG8_SA(1, 0), a3, voffA);
            PG8_WAIT_V(8); PG8_WAIT_L(0); PG8_BAR; PG8_MMA(1, 0, At, B0); PG8_MMA(1, 1, At, B1); PG8_BAR; PG8_SCHED;
            } else {
            PG8_LDB(B0, 0, 0); PG8_SCHED; PG8_LDA(At, 0, 0); PG8_STAGE(PG8_SA(1, 1), a1 + hstepA, voffA);
            PG8_WAIT_L(8); PG8_BAR; PG8_WAIT_L(0); PG8_MMA(0, 0, At, B0); PG8_BAR; PG8_SCHED;
            PG8_LDB(B1, 0, 1); PG8_STAGE(PG8_SB(0, 0), b2, voffB);
            PG8_BAR; PG8_WAIT_L(0); PG8_MMA(0, 1, At, B1); PG8_BAR;
            PG8_LDA(At, 0, 1); PG8_STAGE(PG8_SA(0, 0), a2, voffA);
            PG8_BAR; PG8_WAIT_L(0); PG8_MMA(1, 0, At, B0); PG8_BAR; PG8_SCHED;
            PG8_STAGE(PG8_SB(0, 1), b2 + hstepB, voffB);
            PG8_WAIT_V(6); PG8_BAR; PG8_MMA(1, 1, At, B1); PG8_BAR;
            PG8_LDB(B0, 1, 0); PG8_SCHED; PG8_LDA(At, 1, 0); PG8_STAGE(PG8_SA(0, 1), a2 + hstepA, voffA);
            PG8_WAIT_L(8); PG8_BAR; PG8_WAIT_L(0); PG8_MMA(0, 0, At, B0); PG8_BAR; PG8_SCHED;
            PG8_LDB(B1, 1, 1); PG8_STAGE(PG8_SB(1, 0), b3, voffB);
            PG8_BAR; PG8_WAIT_L(0); PG8_MMA(0, 1, At, B1); PG8_BAR;
            PG8_LDA(At, 1, 1); PG8_STAGE(PG8_SA(1, 0), a3, voffA);
            PG8_BAR; PG8_WAIT_L(0); PG8_MMA(1, 0, At, B0); PG8_BAR; PG8_SCHED;
            PG8_STAGE(PG8_SB(1, 1), b3 + hstepB, voffB);
            PG8_WAIT_V(6); PG8_BAR; PG8_MMA(1, 1, At, B1); PG8_BAR;
            }
        }
        if constexpr (ALIGN_EPI) { if (wr == 0) PG8_BAR; }
        if constexpr (!Epi::AFTER_DRAIN) { E(acc, cur, wr, wc, fr, fq); S.done(cur); }
        if (!has_next) break;
#pragma unroll
        for (int a = 0; a < 2; ++a)
#pragma unroll
            for (int b = 0; b < 2; ++b)
#pragma unroll
                for (int m = 0; m < 4; ++m)
#pragma unroll
                    for (int n = 0; n < 2; ++n) acc[a][b][m][n] = (f32x4){0.f, 0.f, 0.f, 0.f};
        cur = nxt; cA = nA; cB = nB; ++ui;
        if constexpr (ALIGN_EPI) { if (wr == 1) PG8_BAR; }
    }
    PG8_WAIT_V(0);
    if constexpr (!ALIGN_EPI) { if (wr == 0) PG8_BAR; }
    PG8_BAR;
    if constexpr (Epi::AFTER_DRAIN) { E.fused(acc, cur, wr, wc, fr, fq, lds, wid, lane); S.done(cur); }
#undef PG8_SA
#undef PG8_SB
#undef PG8_STAGE
#undef PG8_LDA
#undef PG8_LDB
#undef PG8_MMA
#undef PG8_WAIT_V
#undef PG8_WAIT_L
#undef PG8_BAR
#undef PG8_SCHED
}
}

using pg8::Unit; using pg8::cvt_pk_bf16;
#define EPI_ARGS const f32x4 (&acc)[2][2][4][2], const Unit& u, int wr, int wc, int fr, int fq
__device__ __forceinline__ float row_rstd(const float* ssq, int row) {
    const f32x4* p = (const f32x4*)(ssq + (size_t)row * 16);
    const f32x4 a = p[0], b = p[1], c = p[2], d = p[3];
    const float s = ((a[0] + a[1]) + (a[2] + a[3])) + ((b[0] + b[1]) + (b[2] + b[3])) + ((c[0] + c[1]) + (c[2] + c[3])) + ((d[0] + d[1]) + (d[2] + d[3]));
    return rsqf_(s * (1.0f / D) + NORM_EPS);
}
struct EpiSwiglu {
    static constexpr bool PERM = true, AFTER_DRAIN = false;
    bf16* H; const float* ssq;
    __device__ __forceinline__ void operator()(EPI_ARGS) const {
#pragma unroll
        for (int ai = 0; ai < 2; ++ai)
#pragma unroll
            for (int m = 0; m < 4; ++m) {
                const int row = u.pm * 256 + ai * 128 + wr * 64 + m * 16 + fr; const float rs = row_rstd(ssq, row); float v[8];
#pragma unroll
                for (int n = 0; n < 2; ++n) { const f32x4 g = acc[ai][0][m][n] * rs, up = acc[ai][1][m][n] * rs;
#pragma unroll
                    for (int j = 0; j < 4; ++j) v[4 * n + j] = siluf_(g[j]) * up[j]; }
                u32x4 w; w.x = cvt_pk_bf16(v[0], v[1]); w.y = cvt_pk_bf16(v[2], v[3]); w.z = cvt_pk_bf16(v[4], v[5]); w.w = cvt_pk_bf16(v[6], v[7]);
                *(u32x4*)(H + (size_t)row * FF + u.pn * 128 + wc * 32 + fq * 8) = w;
            }
    }
};
struct EpiResid {
    static constexpr bool PERM = false, AFTER_DRAIN = false;
    const float* Xin; float* X; bf16* XB; float* ssq; float alpha;
    __device__ __forceinline__ void operator()(EPI_ARGS) const {
#pragma unroll
        for (int ai = 0; ai < 2; ++ai)
#pragma unroll
            for (int m = 0; m < 4; ++m) {
                const int row = u.pm * 256 + ai * 128 + wr * 64 + m * 16 + fr; float s = 0.f;
#pragma unroll
                for (int bj = 0; bj < 2; ++bj)
#pragma unroll
                    for (int n = 0; n < 2; ++n) {
                        const size_t off = (size_t)row * D + u.pn * 256 + bj * 128 + wc * 32 + n * 16 + fq * 4;
                        const f32x4 xn = *(const f32x4*)(Xin + off) + acc[ai][bj][m][n] * alpha;
                        *(f32x4*)(X + off) = xn;
                        u32x2 w; w.x = cvt_pk_bf16(xn[0], xn[1]); w.y = cvt_pk_bf16(xn[2], xn[3]);
                        *(u32x2*)(XB + off) = w;
                        s += (xn[0] * xn[0] + xn[1] * xn[1]) + (xn[2] * xn[2] + xn[3] * xn[3]);
                    }
                s += shx(s, 16, fq * 16 + fr); s += shx(s, 32, fq * 16 + fr);
                if (fq == 0) ssq[(size_t)row * 16 + u.pn * 4 + wc] = s;
            }
    }
};
struct EpiBf16 {
    static constexpr bool PERM = true, AFTER_DRAIN = false;
    bf16* O; int ldc; const float* ssq; float scale; int ncols;
    __device__ __forceinline__ void operator()(EPI_ARGS) const {
#pragma unroll
        for (int ai = 0; ai < 2; ++ai)
#pragma unroll
            for (int m = 0; m < 4; ++m) {
                const int row = u.pm * 256 + ai * 128 + wr * 64 + m * 16 + fr; const float rs = (ssq ? row_rstd(ssq, row) : 1.0f) * scale;
#pragma unroll
                for (int bj = 0; bj < 2; ++bj) {
                    const int col = u.pn * 256 + bj * 128 + wc * 32 + fq * 8;
                    if (col < ncols) {
                        const f32x4 v0 = acc[ai][bj][m][0] * rs, v1 = acc[ai][bj][m][1] * rs; u32x4 w;
                        w.x = cvt_pk_bf16(v0[0], v0[1]); w.y = cvt_pk_bf16(v0[2], v0[3]); w.z = cvt_pk_bf16(v1[0], v1[1]); w.w = cvt_pk_bf16(v1[2], v1[3]);
                        *(u32x4*)(O + (size_t)row * ldc + col) = w;
                    }
                }
            }
    }
};
struct EpiZ {
    static constexpr bool PERM = true, AFTER_DRAIN = false;
    bf16* O; const float* ssq; bf16* HALO;
    __device__ __forceinline__ void operator()(EPI_ARGS) const {
#pragma unroll
        for (int ai = 0; ai < 2; ++ai)
#pragma unroll
            for (int m = 0; m < 4; ++m) {
                const int row = u.pm * 256 + ai * 128 + wr * 64 + m * 16 + fr; const float rs = row_rstd(ssq, row);
#pragma unroll
                for (int bj = 0; bj < 2; ++bj) {
                    const int col = u.pn * 256 + bj * 128 + wc * 32 + fq * 8;
                    if (col < NZ) {
                        const f32x4 v0 = acc[ai][bj][m][0] * rs, v1 = acc[ai][bj][m][1] * rs; u32x4 w;
                        w.x = cvt_pk_bf16(v0[0], v0[1]); w.y = cvt_pk_bf16(v0[2], v0[3]); w.z = cvt_pk_bf16(v1[0], v1[1]); w.w = cvt_pk_bf16(v1[2], v1[3]);
                        *(u32x4*)(O + (size_t)row * ZP + col) = w;
                        if ((row & 63) == 63 && col >= ZD_R && col < ZD_V) *(u32x4*)(HALO + (size_t)(row >> 6) * 1024 + (col - ZD_R)) = w;
                    }
                }
            }
    }
};
struct EpiKV {
    static constexpr bool PERM = true, AFTER_DRAIN = false;
    bf16* Kd; bf16* VT; const float* rstd;
    __device__ __forceinline__ void operator()(EPI_ARGS) const {
#pragma unroll
        for (int ai = 0; ai < 2; ++ai)
#pragma unroll
            for (int m = 0; m < 4; ++m) {
                const int row = u.pm * 256 + ai * 128 + wr * 64 + m * 16 + fr; const float rs = rstd[row];
#pragma unroll
                for (int bj = 0; bj < 2; ++bj) {
                    const int col = u.pn * 256 + bj * 128 + wc * 32 + fq * 8;
                    const f32x4 v0 = acc[ai][bj][m][0] * rs, v1 = acc[ai][bj][m][1] * rs;
                    if (col < D) {
                        u32x4 w; w.x = cvt_pk_bf16(v0[0], v0[1]); w.y = cvt_pk_bf16(v0[2], v0[3]); w.z = cvt_pk_bf16(v1[0], v1[1]); w.w = cvt_pk_bf16(v1[2], v1[3]);
                        *(u32x4*)(Kd + (size_t)row * D + col) = w;
                    } else {
#pragma unroll
                        for (int j = 0; j < 4; ++j) { VT[(size_t)(col - D + j) * MMEM + row] = (bf16)f2bf(v0[j]); VT[(size_t)(col - D + 4 + j) * MMEM + row] = (bf16)f2bf(v1[j]); }
                    }
                }
            }
    }
};
__device__ __forceinline__ size_t stash_idx(int T, int ai, int m, int bj, int wr, int wc, int fr, int fq) { return (size_t)(T * 16 + (ai * 4 + m) * 2 + bj) * 512 + (size_t)((wr * 4 + wc) * 64 + fq * 16 + fr); }
__device__ __forceinline__ u32x2 pack_u8(const float* v) {
    unsigned b[8];
#pragma unroll
    for (int j = 0; j < 8; ++j) b[j] = (unsigned)(v[j] * 255.0f + 0.5f);
    u32x2 w; w.x = b[0] | (b[1] << 8) | (b[2] << 16) | (b[3] << 24); w.y = b[4] | (b[5] << 8) | (b[6] << 16) | (b[7] << 24); return w;
}
__device__ __forceinline__ void unpack_u8(u32x2 w, float* v) {
#pragma unroll
    for (int j = 0; j < 4; ++j) { v[j] = (float)((w.x >> (8 * j)) & 255u) * (1.0f / 255.0f); v[4 + j] = (float)((w.y >> (8 * j)) & 255u) * (1.0f / 255.0f); }
}
struct OwnTile4 {
    int pm, pn0;
    __device__ __forceinline__ bool next(int i, Unit& u) const { if (i >= 4) return false; u.pm = pm; u.pn = 4 * i + pn0; return true; }
    __device__ __forceinline__ void a_ready(const Unit&) const {}
    __device__ __forceinline__ void done(const Unit&) const {}
};
struct EpiGate8 {
    static constexpr bool PERM = true, AFTER_DRAIN = false;
    unsigned char* G8; const float* ssq; const float* bias;
    __device__ __forceinline__ void operator()(EPI_ARGS) const {
        const int br = u.pn >> 2, T = u.pm * 4 + (u.pn & 3);
#pragma unroll
        for (int ai = 0; ai < 2; ++ai)
#pragma unroll
            for (int m = 0; m < 4; ++m) {
                const int row = u.pm * 256 + ai * 128 + wr * 64 + m * 16 + fr; const float rs = row_rstd(ssq, row);
#pragma unroll
                for (int bj = 0; bj < 2; ++bj) {
                    const int col = u.pn * 256 + bj * 128 + wc * 32 + fq * 8; float v[8];
#pragma unroll
                    for (int n = 0; n < 2; ++n) { const f32x4 b = *(const f32x4*)(bias + col + 4 * n);
#pragma unroll
                        for (int j = 0; j < 4; ++j) v[4 * n + j] = sigmoidf_(acc[ai][bj][m][n][j] * rs + b[j]); }
                    *(u32x2*)(G8 + ((size_t)br * 256 * 16 * 512 + stash_idx(T, ai, m, bj, wr, wc, fr, fq)) * 8) = pack_u8(v);
                }
            }
    }
};
struct EpiGlu8 {
    static constexpr bool PERM = true, AFTER_DRAIN = false;
    unsigned char* G8;
    __device__ __forceinline__ void operator()(EPI_ARGS) const {
        const int T = u.pm * 4 + u.pn;
#pragma unroll
        for (int ai = 0; ai < 2; ++ai)
#pragma unroll
            for (int m = 0; m < 4; ++m)
#pragma unroll
                for (int bj = 0; bj < 2; ++bj) {
                    u32x2* p = (u32x2*)(G8 + ((size_t)1 * 256 * 16 * 512 + stash_idx(T, ai, m, bj, wr, wc, fr, fq)) * 8); float g[8]; unpack_u8(*p, g);
#pragma unroll
                    for (int n = 0; n < 2; ++n)
#pragma unroll
                        for (int j = 0; j < 4; ++j) g[4 * n + j] *= sigmoidf_(acc[ai][bj][m][n][j]);
                    *p = pack_u8(g);
                }
    }
};
template <int MODE> struct EpiMerge8 {
    static constexpr bool PERM = true, AFTER_DRAIN = false;
    const unsigned char* G8; int br; bf16* MF; bf16* MG; int ldg;
    __device__ __forceinline__ void operator()(EPI_ARGS) const {
        const int T = u.pm * 4 + u.pn;
#pragma unroll
        for (int ai = 0; ai < 2; ++ai)
#pragma unroll
            for (int m = 0; m < 4; ++m) {
                const int row = u.pm * 256 + ai * 128 + wr * 64 + m * 16 + fr;
#pragma unroll
                for (int bj = 0; bj < 2; ++bj) {
                    const size_t si = stash_idx(T, ai, m, bj, wr, wc, fr, fq); float g[8];
                    unpack_u8(*(const u32x2*)(G8 + ((size_t)br * 256 * 16 * 512 + si) * 8), g);
                    f32x4 v0 = acc[ai][bj][m][0], v1 = acc[ai][bj][m][1];
#pragma unroll
                    for (int j = 0; j < 4; ++j) { v0[j] *= g[j]; v1[j] *= g[4 + j]; }
                    if (MODE != 0) { const u32x4 o = *(const u32x4*)(MF + si * 8); v0[0] += bflo(o.x); v0[1] += bfhi(o.x); v0[2] += bflo(o.y); v0[3] += bfhi(o.y); v1[0] += bflo(o.z); v1[1] += bfhi(o.z); v1[2] += bflo(o.w); v1[3] += bfhi(o.w); }
                    u32x4 w; w.x = cvt_pk_bf16(v0[0], v0[1]); w.y = cvt_pk_bf16(v0[2], v0[3]); w.z = cvt_pk_bf16(v1[0], v1[1]); w.w = cvt_pk_bf16(v1[2], v1[3]);
                    if (MODE != 2) *(u32x4*)(MF + si * 8) = w;
                    else *(u32x4*)(MG + (size_t)row * ldg + u.pn * 256 + bj * 128 + wc * 32 + fq * 8) = w;
                }
            }
    }
};
struct EpiSoftmaxP {
    static constexpr bool PERM = true, AFTER_DRAIN = true;
    bf16* P;
    __device__ __forceinline__ void fused(f32x4 (&acc)[2][2][4][2], const Unit& u, int wr, int wc, int fr, int fq, PG8_LAS unsigned char* lds, int wid, int lane) const {
        PG8_LAS float* RM = (PG8_LAS float*)lds;
        PG8_LAS float* RS = (PG8_LAS float*)(lds + 4096);
#pragma unroll
        for (int ai = 0; ai < 2; ++ai)
#pragma unroll
            for (int m = 0; m < 4; ++m) {
                float mx = -3.0e38f;
#pragma unroll
                for (int bj = 0; bj < 2; ++bj)
#pragma unroll
                    for (int n = 0; n < 2; ++n) { const f32x4 x = acc[ai][bj][m][n]; mx = fmaxf(mx, fmaxf(fmaxf(x[0], x[1]), fmaxf(x[2], x[3]))); }
                mx = fmaxf(mx, shx(mx, 16, fq * 16 + fr)); mx = fmaxf(mx, shx(mx, 32, fq * 16 + fr));
                if (fq == 0) RM[(ai * 128 + wr * 64 + m * 16 + fr) * 4 + wc] = mx;
            }
        asm volatile("s_waitcnt lgkmcnt(0)" ::: "memory"); __builtin_amdgcn_s_barrier(); asm volatile("" ::: "memory");
#pragma unroll
        for (int ai = 0; ai < 2; ++ai)
#pragma unroll
            for (int m = 0; m < 4; ++m) {
                const int rl = ai * 128 + wr * 64 + m * 16 + fr;
                const float mx = fmaxf(fmaxf(RM[rl * 4 + 0], RM[rl * 4 + 1]), fmaxf(RM[rl * 4 + 2], RM[rl * 4 + 3])); float s = 0.f;
#pragma unroll
                for (int bj = 0; bj < 2; ++bj)
#pragma unroll
                    for (int n = 0; n < 2; ++n)
#pragma unroll
                        for (int j = 0; j < 4; ++j) { const float p = __builtin_amdgcn_exp2f(acc[ai][bj][m][n][j] - mx); acc[ai][bj][m][n][j] = p; s += p; }
                s += shx(s, 16, fq * 16 + fr); s += shx(s, 32, fq * 16 + fr);
                if (fq == 0) RS[rl * 4 + wc] = s;
            }
        asm volatile("s_waitcnt lgkmcnt(0)" ::: "memory"); __builtin_amdgcn_s_barrier(); asm volatile("" ::: "memory");
#pragma unroll
        for (int ai = 0; ai < 2; ++ai)
#pragma unroll
            for (int m = 0; m < 4; ++m) {
                const int rl = ai * 128 + wr * 64 + m * 16 + fr;
                const float inv = rcpf_((RS[rl * 4 + 0] + RS[rl * 4 + 1]) + (RS[rl * 4 + 2] + RS[rl * 4 + 3]));
#pragma unroll
                for (int bj = 0; bj < 2; ++bj) {
                    const f32x4 v0 = acc[ai][bj][m][0] * inv, v1 = acc[ai][bj][m][1] * inv; u32x4 w;
                    w.x = cvt_pk_bf16(v0[0], v0[1]); w.y = cvt_pk_bf16(v0[2], v0[3]); w.z = cvt_pk_bf16(v1[0], v1[1]); w.w = cvt_pk_bf16(v1[2], v1[3]);
                    *(u32x4*)(P + (size_t)rl * 256 + bj * 128 + wc * 32 + fq * 8) = w;
                }
            }
        asm volatile("s_waitcnt lgkmcnt(0)" ::: "memory"); __builtin_amdgcn_s_barrier(); asm volatile("" ::: "memory");
    }
};
struct Args { const float* in[N_INPUTS]; float* out; unsigned char* ws; };
typedef const float* cfptr;
typedef __attribute__((address_space(4))) const cfptr* kin_t;
struct Ctx {
    LAS unsigned char* lds; int tid, lane, wave, G, bid;
    kin_t in; float* X; unsigned char* ws;
    __device__ __forceinline__ const float* inp(int i, int l, size_t per_layer) const { return in[i] + (size_t)l * per_layer; }
};
__device__ __forceinline__ Ctx make_ctx() {
    extern __shared__ __attribute__((aligned(16))) unsigned char lds_raw[];
    Ctx C; int t = threadIdx.x; asm volatile("" : "+v"(t));
    kin_t k = (kin_t)__builtin_amdgcn_kernarg_segment_ptr(); asm volatile("" : "+s"(k));
    C.lds = (LAS unsigned char*)lds_raw; C.tid = t; C.lane = t & 63; C.wave = __builtin_amdgcn_readfirstlane(t >> 6);
    C.G = gridDim.x; C.bid = blockIdx.x; C.in = k;
    C.X = (float*)k[N_INPUTS]; C.ws = (unsigned char*)k[N_INPUTS + 1];
    return C;
}
constexpr size_t RWW_OFF = 93 * MiB;
struct ConvDesc { const float* W; const float* gain; bf16* dst; long alt; int ld, ncols, K, NR, kind, item0; };
constexpr int CD_OFF = 124 * 1024, CD_MAX = 24;
enum ConvJob { CJ_GU1 = 1, CJ_D1 = 2, CJ_WIN = 4, CJ_GATES = 8, CJ_PROJ = 16, CJ_XW = 32, CJ_GU2 = 64, CJ_D2 = 128, CJ_XKV0 = 256, CJ_XKV1 = 512, CJ_MLW = 1024, CJ_RWW = 2048 };
__device__ __forceinline__ void cd_put(const Ctx& C, int& n, int& items, const float* W, const float* gain, bf16* dst, long alt, int ld, int ncols, int K, int NR, int kind) {
    if (C.tid == 0) { LAS ConvDesc* d = (LAS ConvDesc*)(C.lds + CD_OFF) + n; d->W = W; d->gain = gain; d->dst = dst; d->alt = alt; d->ld = ld; d->ncols = ncols; d->K = K; d->NR = NR; d->kind = kind; d->item0 = items; }
    items += (K / 64) * (NR / 32); ++n;
}
__device__ __forceinline__ void conv_item(const LAS ConvDesc* d, int it, LAS float* scr, int lane) {
    const int K = d->K, NR = d->NR, kind = d->kind, ld = d->ld, ncols = d->ncols; const float* W = d->W; const float* gain = d->gain; bf16* dst = d->dst; const long alt = d->alt;
    const int nblk = NR / 32, kb = it / nblk, nb = it % nblk, k0 = 64 * kb, n0 = 32 * nb, n = n0 + (lane & 31);
    const float* p = nullptr;
    if (kind == 0) { if (n < ncols) p = W + n; }
    else if (kind == 1) { const int t = n >> 8, cl = n & 255, h = t * 128 + (cl & 127); p = W + (h + ((cl & 128) ? alt : 0l)); }
    else p = W + (n < D ? (long)n : alt + (long)(n - D));
    float v[32];
    if (p) { const float* q = p + (size_t)(k0 + (lane >> 5)) * ld;
#pragma unroll
        for (int i = 0; i < 32; ++i) v[i] = q[(size_t)(2 * i) * ld];
        if (gain) {
#pragma unroll
            for (int i = 0; i < 32; ++i) v[i] *= gain[k0 + 2 * i + (lane >> 5)]; }
    } else {
#pragma unroll
        for (int i = 0; i < 32; ++i) v[i] = 0.f; }
#pragma unroll
    for (int i = 0; i < 32; ++i) scr[(2 * i + (lane >> 5)) * 33 + (lane & 31)] = v[i];
    LDS_WAIT(); asm volatile("" ::: "memory");
    const int c = lane & 7;
#pragma unroll
    for (int j = 0; j < 4; ++j) { const int nn = (lane >> 3) + 8 * j; const LAS float* s = scr + (8 * c) * 33 + nn;
        u32x4 o; o.x = pk2(s[0 * 33], s[1 * 33]); o.y = pk2(s[2 * 33], s[3 * 33]); o.z = pk2(s[4 * 33], s[5 * 33]); o.w = pk2(s[6 * 33], s[7 * 33]);
        *(u32x4*)(dst + (size_t)(n0 + nn) * K + k0 + 8 * c) = o; }
    LDS_WAIT(); asm volatile("" ::: "memory");
}
__device__ __forceinline__ void run_conv(const Ctx& C, int jobs, int l, int gw, int NGW) {
    unsigned char* ws = C.ws; int n = 0, items = 0;
    __syncthreads();
    if (jobs & CJ_GU1) cd_put(C, n, items, C.inp(I_FFN1_WG, l, (size_t)D * FF), C.inp(I_FFN1_NORM, l, D), (bf16*)(ws + WS_SLOTA), (long)(C.inp(I_FFN1_WU, l, (size_t)D * FF) - C.inp(I_FFN1_WG, l, (size_t)D * FF)), FF, 2 * FF, D, 2 * FF, 1);
    if (jobs & CJ_GU2) cd_put(C, n, items, C.inp(I_FFN2_WG, l, (size_t)D * FF), C.inp(I_FFN2_NORM, l, D), (bf16*)(ws + WS_SLOTA), (long)(C.inp(I_FFN2_WU, l, (size_t)D * FF) - C.inp(I_FFN2_WG, l, (size_t)D * FF)), FF, 2 * FF, D, 2 * FF, 1);
    if (jobs & CJ_D1) cd_put(C, n, items, C.inp(I_FFN1_WD, l, (size_t)D * FF), nullptr, (bf16*)(ws + WS_SLOTC), 0, D, D, FF, D, 0);
    if (jobs & CJ_D2) cd_put(C, n, items, C.inp(I_FFN2_WD, l, (size_t)D * FF), nullptr, (bf16*)(ws + WS_SLOTC), 0, D, D, FF, D, 0);
    if (jobs & CJ_WIN) cd_put(C, n, items, C.inp(I_W_IN, l, (size_t)D * NIN), C.inp(I_MIX_NORM, l, D), (bf16*)(ws + WS_SLOTB), 0, NIN, NZ, D, NINP, 0);
    if (jobs & CJ_GATES) cd_put(C, n, items, C.inp(I_W_IN, l, (size_t)D * NIN) + ZG, C.inp(I_MIX_NORM, l, D), (bf16*)(ws + WS_SLOTA), 0, NIN, 4 * D, D, 4 * D, 0);
    if (jobs & CJ_PROJ) {
        cd_put(C, n, items, C.inp(I_ML_PROJ, l, (size_t)WB * D), nullptr, (bf16*)(ws + WS_SLOTC), 0, D, D, WB, D, 0);
        cd_put(C, n, items, C.inp(I_S5_W1, l, (size_t)WB * D), nullptr, (bf16*)(ws + WS_SLOTC + 1 * MiB), 0, D, D, WB, D, 0);
        cd_put(C, n, items, C.inp(I_S5_W2, l, (size_t)WB * D), nullptr, (bf16*)(ws + WS_SLOTC + 2 * MiB), 0, D, D, WB, D, 0);
        cd_put(C, n, items, C.inp(I_GLA_PROJ, l, (size_t)WB * D), nullptr, (bf16*)(ws + WS_SLOTC + 3 * MiB), 0, D, D, WB, D, 0);
        cd_put(C, n, items, C.inp(I_RW_PROJ, l, (size_t)WB * D), nullptr, (bf16*)(ws + WS_SLOTC + 4 * MiB), 0, D, D, WB, D, 0);
    }
    if (jobs & CJ_XW) {
        cd_put(C, n, items, C.inp(I_W_OUT, l, (size_t)D * D), nullptr, (bf16*)(ws + WS_SLOTB), 0, D, D, D, D, 0);
        cd_put(C, n, items, C.inp(I_XA_WQ, l, (size_t)D * D), C.inp(I_XA_NORM, l, D), (bf16*)(ws + WS_SLOTB + 2 * MiB), 0, D, D, D, D, 0);
        cd_put(C, n, items, C.inp(I_XA_WO, l, (size_t)D * D), nullptr, (bf16*)(ws + WS_SLOTB + 4 * MiB), 0, D, D, D, D, 0);
    }
    if (jobs & CJ_XKV0) cd_put(C, n, items, C.inp(I_XA_WK, 0, (size_t)D * D), C.inp(I_MEM_NORM, 0, D), (bf16*)(ws + WS_S), (long)(C.inp(I_XA_WV, 0, (size_t)D * D) - C.inp(I_XA_WK, 0, (size_t)D * D)), D, 2 * D, D, 2 * D, 2);
    if (jobs & CJ_XKV1) cd_put(C, n, items, C.inp(I_XA_WK, 1, (size_t)D * D), C.inp(I_MEM_NORM, 1, D), (bf16*)(ws + WS_S + 4 * MiB), (long)(C.inp(I_XA_WV, 1, (size_t)D * D) - C.inp(I_XA_WK, 1, (size_t)D * D)), D, 2 * D, D, 2 * D, 2);
    if (jobs & CJ_MLW) {
#pragma unroll
        for (int q = 0; q < 3; ++q)
#pragma unroll
            for (int hh = 0; hh < 4; ++hh) cd_put(C, n, items, C.inp(q == 0 ? I_ML_WQ : (q == 1 ? I_ML_WK : I_ML_WV), l, 4 * 16384) + hh * 16384, nullptr, (bf16*)(ws + 512 * 1024) + (size_t)(q * 4 + hh) * 16384, 0, 128, 128, 128, 128, 0);
    }
    if (jobs & CJ_RWW) {
        bf16* dst = (bf16*)(ws + WS_S + RWW_OFF);
        cd_put(C, n, items, C.inp(I_RW_WUP, l, 64 * WB), nullptr, dst, 0, WB, WB, 64, WB, 0);
        cd_put(C, n, items, C.inp(I_RW_AUP, l, 64 * WB), nullptr, dst + 512 * 64, 0, WB, WB, 64, WB, 0);
        cd_put(C, n, items, C.inp(I_RW_GUP, l, 128 * WB), nullptr, dst + 2 * 512 * 64, 0, WB, WB, 128, WB, 0);
    }
    __syncthreads();
    LAS float* scr = (LAS float*)(C.lds + C.wave * 15360);
    const LAS ConvDesc* cd = (const LAS ConvDesc*)(C.lds + CD_OFF);
    for (int it = gw; it < items; it += NGW) {
        int j = 0;
        for (int q = 1; q < n; ++q) if (it >= cd[q].item0) j = q;
        conv_item(cd + j, it - cd[j].item0, scr, C.lane);
    }
    __syncthreads();
}

__device__ __forceinline__ void pro_rows(const Ctx& C) {
    const int gw = C.bid * 8 + C.wave, NGW = C.G * 8;
    const float* x = C.in[I_X]; bf16* XB = (bf16*)(C.ws + WS_XB); float* ssq = (float*)(C.ws + WS_SSQ);
    for (int m = gw; m < M; m += NGW) {
        const f32x4* xr = (const f32x4*)(x + (size_t)m * D) + C.lane; u32x2* br = (u32x2*)(XB + (size_t)m * D) + C.lane;
        float s = 0.f;
#pragma unroll
        for (int j = 0; j < 4; ++j) { const f32x4 v = xr[64 * j]; u32x2 w; w.x = pk2(v[0], v[1]); w.y = pk2(v[2], v[3]); br[64 * j] = w; s += (v[0] * v[0] + v[1] * v[1]) + (v[2] * v[2] + v[3] * v[3]); }
        s = wave_sum(s, C.lane);
        if (C.lane < 16) ssq[(size_t)m * 16 + C.lane] = (C.lane == 0) ? s : 0.f;
    }
    const float* mem = C.in[I_MEM]; bf16* MB = (bf16*)(C.ws + WS_MEMB); float* memr = (float*)(C.ws + WS_MEMR);
    for (int m = gw; m < MMEM; m += NGW) {
        const f32x4* xr = (const f32x4*)(mem + (size_t)m * D) + C.lane; u32x2* br = (u32x2*)(MB + (size_t)m * D) + C.lane; float s = 0.f;
#pragma unroll
        for (int j = 0; j < 4; ++j) { const f32x4 v = xr[64 * j]; u32x2 w; w.x = pk2(v[0], v[1]); w.y = pk2(v[2], v[3]); br[64 * j] = w; s += (v[0] * v[0] + v[1] * v[1]) + (v[2] * v[2] + v[3] * v[3]); }
        s = wave_sum(s, C.lane);
        if (C.lane == 0) memr[m] = 1.0f / sqrtf(s * (1.0f / D) + NORM_EPS);
    }
}
__device__ __forceinline__ void final_rows(const Ctx& C) {
    const int gw = C.bid * 8 + C.wave, NGW = C.G * 8; const float* ssq = (const float*)(C.ws + WS_SSQ); const float* g = C.in[I_FINAL_NORM];
    for (int m = gw; m < M; m += NGW) {
        const float rs = row_rstd(ssq, m); f32x4* orow = (f32x4*)(C.X + (size_t)m * D) + C.lane; const f32x4* gr = (const f32x4*)g + C.lane;
#pragma unroll
        for (int j = 0; j < 4; ++j) orow[64 * j] = orow[64 * j] * rs * gr[64 * j];
    }
}
__device__ __forceinline__ float ldz(const bf16* Z, int row, int col) { return bf2f(Z[(size_t)row * ZP + col]); }
__device__ __forceinline__ float gelu_tanh(float y) { const float t = 0.7978845608028654f * (y + 0.044715f * y * y * y); return 0.5f * y * (1.0f + tanhf_(t)); }
constexpr int LCH = 64, NCH = SEQ / LCH;
constexpr size_t SO_GLA_ST = 0;
constexpr size_t SO_GLA_G = SO_GLA_ST + 16 * MiB;
constexpr size_t SO_ML_ST = SO_GLA_G + 512 * 1024;
constexpr size_t SO_ML_G = SO_ML_ST + 36 * MiB;
constexpr size_t SO_END0 = SO_ML_G + 512 * 1024;
static_assert(WS_S + SO_END0 <= WS_END, "state region");

__device__ __forceinline__ bf16x8 ld8(const LAS bf16* p) { return *(const LAS bf16x8*)p; }
__device__ __forceinline__ bf16x8 ld8(const bf16* p) { return *(const bf16x8*)p; }
template <int K, class PA, class PB> __device__ __forceinline__ f32x4 tile_mm(PA A, int lda, PB B, int ldb, f32x4 acc, int fr, int fq) {
#pragma unroll
    for (int k0 = 0; k0 < K; k0 += 32) {
        const bf16x8 a = ld8(A + fr * lda + k0 + 8 * fq);
        const bf16x8 b = ld8(B + fr * ldb + k0 + 8 * fq);
        acc = __builtin_amdgcn_mfma_f32_16x16x32_bf16(a, b, acc, 0, 0, 0);
    }
    return acc;
}
#define F4Z ((f32x4){0.f, 0.f, 0.f, 0.f})
__device__ __forceinline__ u32x2 pack4(f32x4 v) { u32x2 w; w.x = pk2(v[0], v[1]); w.y = pk2(v[2], v[3]); return w; }
__device__ __forceinline__ void unpack8(u32x4 w, float* f) { f[0] = bflo(w.x); f[1] = bfhi(w.x); f[2] = bflo(w.y); f[3] = bfhi(w.y); f[4] = bflo(w.z); f[5] = bfhi(w.z); f[6] = bflo(w.w); f[7] = bfhi(w.w); }

__device__ __forceinline__ void gla_cumdecay(const Ctx& C, int l, int h, int rowb, LAS float* ALOW, LAS float* LA, LAS float* SEG) {
    const bf16* Z = (const bf16*)(C.ws + WS_Z);
    const float* aup = C.inp(I_GLA_AUP, l, 16 * 256) + h * 64; const float* abias = C.inp(I_GLA_ABIAS, l, 256) + h * 64;
    const int tid = C.tid;
    for (int i = tid; i < 64 * 16; i += 512) ALOW[i] = ldz(Z, rowb + (i >> 4), ZC_A + (i & 15));
    __syncthreads();
    {   const int k = tid & 63, seg = tid >> 6; float au[16], run = 0.f, v[8];
#pragma unroll
        for (int r = 0; r < 16; ++r) au[r] = aup[r * 256 + k];
        const float bk = abias[k];
#pragma unroll
        for (int i = 0; i < 8; ++i) { const int t = seg * 8 + i; float s = bk;
#pragma unroll
            for (int r = 0; r < 16; ++r) s += ALOW[t * 16 + r] * au[r];
            run += logsigmoidf_(s) * (1.0f / 16.0f); v[i] = run; }
        SEG[seg * 64 + k] = run;
        __syncthreads();
        float off = 0.f;
        for (int s2 = 0; s2 < seg; ++s2) off += SEG[s2 * 64 + k];
#pragma unroll
        for (int i = 0; i < 8; ++i) LA[(seg * 8 + i) * 64 + k] = v[i] + off;
    }
    __syncthreads();
}
constexpr int LDT = 72;
__device__ __forceinline__ void gla_passA(const Ctx& C, int l, int item) {
    const int bh = item >> 6, c = item & 63, b = bh >> 2, h = bh & 3, rowb = b * SEQ + c * LCH;
    const bf16* Z = (const bf16*)(C.ws + WS_Z);
    LAS float* ALOW = (LAS float*)C.lds; LAS float* LA = ALOW + 1024; LAS float* SEG = LA + 4096;
    LAS bf16* VT = (LAS bf16*)(SEG + 512);
    LAS bf16* KT = VT + 128 * LDT;
    const int tid = C.tid, lane = C.lane, w = C.wave, fr = lane & 15, fq = lane >> 4;
    gla_cumdecay(C, l, h, rowb, ALOW, LA, SEG);
    for (int i = tid; i < 64 * 16; i += 512) { const int t = i >> 4, v0 = (i & 15) * 8; float f[8];
        unpack8(*(const u32x4*)(Z + (size_t)(rowb + t) * ZP + ZC_V + h * 128 + v0), f);
#pragma unroll
        for (int j = 0; j < 8; ++j) VT[(v0 + j) * LDT + t] = (bf16)f2bf(f[j]); }
    {   const int t = tid >> 3, k0 = (tid & 7) * 8; float f[8];
        unpack8(*(const u32x4*)(Z + (size_t)(rowb + t) * ZP + ZC_K + h * 64 + k0), f);
#pragma unroll
        for (int j = 0; j < 8; ++j) KT[(k0 + j) * LDT + t] = (bf16)f2bf(f[j] * __expf(LA[63 * 64 + k0 + j] - LA[t * 64 + k0 + j])); }
    if (tid < 64) ((float*)(C.ws + WS_S + SO_GLA_G))[(size_t)item * 64 + tid] = __expf(LA[63 * 64 + tid]);
    __syncthreads();
    bf16* ST = (bf16*)(C.ws + WS_S + SO_GLA_ST) + (size_t)item * 8192;
#pragma unroll
    for (int q = 0; q < 4; ++q) {
        const f32x4 acc = tile_mm<64>(KT + (16 * q) * LDT, LDT, VT + (16 * w) * LDT, LDT, F4Z, fr, fq);
        *(u32x2*)(ST + (size_t)(16 * w + fr) * 64 + 16 * q + 4 * fq) = pack4(acc);
    }
    __syncthreads();
}
__device__ __forceinline__ void gla_passB(const Ctx& C) {
    const int idx = C.bid * 512 + C.tid; if (idx >= 16 * 8192) return;
    const int bh = idx >> 13, e = idx & 8191, k = e & 63;
    bf16* ST = (bf16*)(C.ws + WS_S + SO_GLA_ST) + (size_t)bh * 64 * 8192 + e; const float* G = (const float*)(C.ws + WS_S + SO_GLA_G) + (size_t)bh * 64 * 64 + k;
    float d[64], g[64];
#pragma unroll
    for (int c = 0; c < 64; ++c) { d[c] = bf2f(ST[(size_t)c * 8192]); g[c] = G[c * 64]; }
    float run = 0.f;
#pragma unroll
    for (int c = 0; c < 64; ++c) { ST[(size_t)c * 8192] = (bf16)f2bf(run); run = run * g[c] + d[c]; }
}
template <bool DRY = false> __device__ __forceinline__ void gla_passC(const Ctx& C, int l, int item) {
    const int bh = item >> 6, c = item & 63, b = bh >> 2, h = bh & 3, rowb = b * SEQ + c * LCH;
    bf16* Z = (bf16*)(C.ws + WS_Z);
    LAS float* ALOW = (LAS float*)C.lds; LAS float* LA = ALOW + 1024; LAS float* SEG = LA + 4096;
    LAS bf16* VT = (LAS bf16*)(SEG + 512);
    LAS bf16* QP = VT + 128 * LDT;
    LAS bf16* KP = QP + 64 * LDT;
    LAS bf16* ATT = KP + 64 * LDT;
    LAS float* O = (LAS float*)(ATT + 64 * LDT);
    LAS float* RSQ = O + 64 * 132;
    const int tid = C.tid, lane = C.lane, w = C.wave, fr = lane & 15, fq = lane >> 4;
    const bf16* ST = (const bf16*)(C.ws + WS_S + SO_GLA_ST) + (size_t)item * 8192;
    bf16x8 stf[4][2];
#pragma unroll
    for (int q = 0; q < 4; ++q) { const int vv = (4 * w + q) >> 2; stf[q][0] = ld8(ST + (size_t)(16 * vv + fr) * 64 + 8 * fq); stf[q][1] = ld8(ST + (size_t)(16 * vv + fr) * 64 + 32 + 8 * fq); }
    gla_cumdecay(C, l, h, rowb, ALOW, LA, SEG);
    for (int i = tid; i < 64 * 16; i += 512) { const int t = i >> 4, v0 = (i & 15) * 8; float f[8];
        unpack8(*(const u32x4*)(Z + (size_t)(rowb + t) * ZP + ZC_V + h * 128 + v0), f);
#pragma unroll
        for (int j = 0; j < 8; ++j) VT[(v0 + j) * LDT + t] = (bf16)f2bf(f[j]); }
    {   const int t = tid >> 3, k0 = (tid & 7) * 8; float fq_[8], fk_[8];
        unpack8(*(const u32x4*)(Z + (size_t)(rowb + t) * ZP + ZC_Q + h * 64 + k0), fq_);
        unpack8(*(const u32x4*)(Z + (size_t)(rowb + t) * ZP + ZC_K + h * 64 + k0), fk_);
        u32x4 wq, wk; float eq[8], ek[8];
#pragma unroll
        for (int j = 0; j < 8; ++j) { const float bb = LA[t * 64 + k0 + j]; eq[j] = fq_[j] * 0.125f * __expf(bb); ek[j] = fk_[j] * __expf(-bb); }
        wq.x = pk2(eq[0], eq[1]); wq.y = pk2(eq[2], eq[3]); wq.z = pk2(eq[4], eq[5]); wq.w = pk2(eq[6], eq[7]);
        wk.x = pk2(ek[0], ek[1]); wk.y = pk2(ek[2], ek[3]); wk.z = pk2(ek[4], ek[5]); wk.w = pk2(ek[6], ek[7]);
        *(LAS u32x4*)(QP + t * LDT + k0) = wq; *(LAS u32x4*)(KP + t * LDT + k0) = wk; }
    __syncthreads();
#pragma unroll
    for (int q = 0; q < 2; ++q) {
        const int id = 2 * w + q, tt = id >> 2, ss = id & 3; f32x4 acc = F4Z;
        if (ss <= tt) acc = tile_mm<64>(KP + (16 * ss) * LDT, LDT, QP + (16 * tt) * LDT, LDT, acc, fr, fq);
        const int t = 16 * tt + fr, s0 = 16 * ss + 4 * fq;
#pragma unroll
        for (int r = 0; r < 4; ++r) if (s0 + r > t) acc[r] = 0.f;
        *(LAS u32x2*)(ATT + t * LDT + s0) = pack4(acc);
    }
    __syncthreads();
#pragma unroll
    for (int q = 0; q < 4; ++q) {
        const int id = 4 * w + q, tt = id & 3, vv = id >> 2;
        f32x4 acc = __builtin_amdgcn_mfma_f32_16x16x32_bf16(stf[q][0], ld8(QP + (16 * tt + fr) * LDT + 8 * fq), F4Z, 0, 0, 0);
        acc = __builtin_amdgcn_mfma_f32_16x16x32_bf16(stf[q][1], ld8(QP + (16 * tt + fr) * LDT + 32 + 8 * fq), acc, 0, 0, 0);
        acc = tile_mm<64>(VT + (16 * vv) * LDT, LDT, ATT + (16 * tt) * LDT, LDT, acc, fr, fq);
        *(LAS f32x4*)(O + (16 * tt + fr) * 132 + 16 * vv + 4 * fq) = acc;
    }
    __syncthreads();
    {
#pragma unroll
        for (int i = 0; i < 8; ++i) { const int t = 8 * w + i; const float h0 = O[t * 132 + lane], h1 = O[t * 132 + lane + 64];
            const float ss = wave_sum(h0 * h0 + h1 * h1, lane); if (lane == 0) RSQ[t] = rsqf_(ss * (1.0f / 128) + NORM_EPS); }
    }
    __syncthreads();
    for (int i = tid; i < 64 * 16; i += 512) { const int t = i >> 4, v0 = (i & 15) * 8; float g[8]; const float rs = RSQ[t];
        bf16* zp = Z + (size_t)(rowb + t) * ZP + ZC_G + h * 128 + v0; unpack8(*(const u32x4*)zp, g);
        const float* gn = C.inp(I_GLA_NORM, l, WB) + h * 128 + v0; float o[8];
#pragma unroll
        for (int j = 0; j < 8; ++j) o[j] = O[t * 132 + v0 + j] * rs * gn[j] * siluf_(g[j]);
        u32x4 wv; wv.x = pk2(o[0], o[1]); wv.y = pk2(o[2], o[3]); wv.z = pk2(o[4], o[5]); wv.w = pk2(o[6], o[7]);
        if (!DRY) *(u32x4*)zp = wv; else asm volatile("" :: "v"(wv)); }
    __syncthreads();
}

constexpr size_t WS_MLW = 512 * 1024;
constexpr int LDU = 152, LDE = 136;
__device__ __forceinline__ float wave_incl_scan(float v, int lane) {
#pragma unroll
    for (int o = 1; o < 64; o <<= 1) { const float n = __builtin_bit_cast(float, __builtin_amdgcn_ds_bpermute(((lane - o) & 63) << 2, __builtin_bit_cast(int, v))); if (lane >= o) v += n; }
    return v;
}
__device__ __forceinline__ void ml_front(const Ctx& C, int l, int b, int h, int c, LAS bf16* UC, LAS bf16* U, LAS float* GB, LAS float* GI) {
    const bf16* Z = (const bf16*)(C.ws + WS_Z); const int t0 = c * LCH, rowb = b * SEQ + t0, tid = C.tid;
    const float* conv = C.inp(I_ML_CONV, l, 4 * WB) + h * 128;
    for (int i = tid; i < 64 * 16; i += 512) { const int t = i >> 4, e0 = (i & 15) * 8; float s[8], x[8];
#pragma unroll
        for (int j = 0; j < 8; ++j) s[j] = 0.f;
#pragma unroll
        for (int d = 0; d < 4; ++d) {
            if (t0 + t - 3 + d >= 0) { unpack8(*(const u32x4*)(Z + (size_t)(rowb + t - 3 + d) * ZP + ZA_U + h * 128 + e0), x);
#pragma unroll
                for (int j = 0; j < 8; ++j) s[j] += conv[d * WB + e0 + j] * x[j]; }
        }
        u32x4 wu, wc; wu.x = pk2(x[0], x[1]); wu.y = pk2(x[2], x[3]); wu.z = pk2(x[4], x[5]); wu.w = pk2(x[6], x[7]);
#pragma unroll
        for (int j = 0; j < 8; ++j) s[j] = siluf_(s[j]);
        wc.x = pk2(s[0], s[1]); wc.y = pk2(s[2], s[3]); wc.z = pk2(s[4], s[5]); wc.w = pk2(s[6], s[7]);
        *(LAS u32x4*)(U + t * LDU + e0) = wu; *(LAS u32x4*)(UC + t * LDU + e0) = wc; }
    if (C.wave == 0) { const int t = C.lane;
        const float li = ldz(Z, rowb + t, ZA_I + h) + C.inp(I_ML_BI, l, 4)[h]; const float lf = logsigmoidf_(ldz(Z, rowb + t, ZA_F + h) + C.inp(I_ML_BF, l, 4)[h]);
        GB[t] = wave_incl_scan(lf, C.lane); GI[t] = li; }
    __syncthreads();
}
__device__ __forceinline__ void ml_passA(const Ctx& C, int l, int item) {
    const int bh = item >> 6, c = item & 63, b = bh >> 2, h = bh & 3;
    LAS bf16* UC = (LAS bf16*)C.lds; LAS bf16* U = UC + 64 * LDU; LAS bf16* KT = U + 64 * LDU;
    LAS bf16* VT = KT + 128 * LDT;
    LAS float* GB = (LAS float*)(VT + 144 * LDT); LAS float* GI = GB + 64; LAS float* WA = GI + 64;
    const int tid = C.tid, lane = C.lane, w = C.wave, fr = lane & 15, fq = lane >> 4;
    ml_front(C, l, b, h, c, UC, U, GB, GI);
    if (tid < 64) WA[tid] = __expf(GB[63] - GB[tid] + GI[tid]) * 0.08838834764831845f;
    for (int i = tid; i < 16 * LDT; i += 512) VT[128 * LDT + i] = (i < LDT) ? (bf16)0x3f80 : (bf16)0;
    __syncthreads();
    const bf16* WK = (const bf16*)(C.ws + WS_MLW) + (size_t)(4 + h) * 16384; const bf16* WV = (const bf16*)(C.ws + WS_MLW) + (size_t)(8 + h) * 16384;
#pragma unroll
    for (int q = 0; q < 4; ++q) {
        const int id = 4 * w + q, tt = id & 3, ee = id >> 2;
        f32x4 ak = tile_mm<128>(UC + (16 * tt) * LDU, LDU, WK + (size_t)(16 * ee) * 128, 128, F4Z, fr, fq);
        f32x4 av = tile_mm<128>(U + (16 * tt) * LDU, LDU, WV + (size_t)(16 * ee) * 128, 128, F4Z, fr, fq);
        const int t = 16 * tt + 4 * fq;
#pragma unroll
        for (int r = 0; r < 4; ++r) ak[r] *= WA[t + r];
        *(LAS u32x2*)(KT + (16 * ee + fr) * LDT + t) = pack4(ak); *(LAS u32x2*)(VT + (16 * ee + fr) * LDT + t) = pack4(av);
    }
    if (tid == 0) ((float*)(C.ws + WS_S + SO_ML_G))[item] = __expf(GB[63]);
    __syncthreads();
    bf16* ST = (bf16*)(C.ws + WS_S + SO_ML_ST) + (size_t)item * (144 * 128);
    for (int id = w; id < 72; id += 8) {
        const int ee = id & 7, vv = id >> 3;
        const f32x4 acc = tile_mm<64>(KT + (16 * ee) * LDT, LDT, VT + (16 * vv) * LDT, LDT, F4Z, fr, fq);
        *(u32x2*)(ST + (size_t)(16 * vv + fr) * 128 + 16 * ee + 4 * fq) = pack4(acc);
    }
    __syncthreads();
}
__device__ __forceinline__ void ml_passB(const Ctx& C) {
    for (int idx = C.bid * 512 + C.tid; idx < 16 * 18432; idx += C.G * 512) {
        const int bh = idx / 18432, e = idx % 18432;
        bf16* ST = (bf16*)(C.ws + WS_S + SO_ML_ST) + (size_t)bh * 64 * 18432 + e; const float* G = (const float*)(C.ws + WS_S + SO_ML_G) + bh * 64;
        float d[64], g[64];
#pragma unroll
        for (int c = 0; c < 64; ++c) { d[c] = bf2f(ST[(size_t)c * 18432]); g[c] = G[c]; }
        float run = 0.f;
#pragma unroll
        for (int c = 0; c < 64; ++c) { ST[(size_t)c * 18432] = (bf16)f2bf(run); run = run * g[c] + d[c]; }
    }
}
template <bool DRY = false> __device__ __forceinline__ void ml_passC(const Ctx& C, int l, int item) {
    const int bh = item >> 6, c = item & 63, b = bh >> 2, h = bh & 3, rowb = b * SEQ + c * LCH;
    bf16* Z = (bf16*)(C.ws + WS_Z);
    LAS bf16* UC = (LAS bf16*)C.lds; LAS bf16* U = UC + 64 * LDU; LAS bf16* Q = U + 64 * LDU;
    LAS bf16* K = Q + 64 * LDE;
    LAS bf16* VT = K + 64 * LDE;
    LAS bf16* W = VT + 144 * LDT;
    LAS float* GB = (LAS float*)(W + 64 * LDT); LAS float* GI = GB + 64; LAS float* RF = GI + 64; LAS float* CF = RF + 64; LAS float* RSQ = CF + 64;
    LAS float* O = (LAS float*)C.lds;
    const int tid = C.tid, lane = C.lane, w = C.wave, fr = lane & 15, fq = lane >> 4;
    const bf16* ST = (const bf16*)(C.ws + WS_S + SO_ML_ST) + (size_t)item * (144 * 128);
    bf16x8 stf[5][4];
#pragma unroll
    for (int q = 0; q < 5; ++q) { const int id = w + 8 * q, vv = id >> 2;
#pragma unroll
        for (int k4 = 0; k4 < 4; ++k4) stf[q][k4] = (id < 36) ? ld8(ST + (size_t)(16 * vv + fr) * 128 + 32 * k4 + 8 * fq) : (bf16x8){0, 0, 0, 0, 0, 0, 0, 0}; }
    ml_front(C, l, b, h, c, UC, U, GB, GI);
    if (tid < 64) { RF[tid] = __expf(GB[tid]); CF[tid] = __expf(GI[tid] - GB[tid]) * 0.08838834764831845f; }
    for (int i = tid; i < 16 * LDT; i += 512) VT[128 * LDT + i] = (i < LDT) ? (bf16)0x3f80 : (bf16)0;
    const bf16* WQ = (const bf16*)(C.ws + WS_MLW) + (size_t)h * 16384; const bf16* WK = WQ + 4 * 16384; const bf16* WV = WQ + 8 * 16384;
#pragma unroll
    for (int q = 0; q < 4; ++q) {
        const int id = 4 * w + q, tt = id & 3, ee = id >> 2;
        const f32x4 aq = tile_mm<128>(WQ + (size_t)(16 * ee) * 128, 128, UC + (16 * tt) * LDU, LDU, F4Z, fr, fq);
        const f32x4 ak = tile_mm<128>(WK + (size_t)(16 * ee) * 128, 128, UC + (16 * tt) * LDU, LDU, F4Z, fr, fq);
        *(LAS u32x2*)(Q + (16 * tt + fr) * LDE + 16 * ee + 4 * fq) = pack4(aq); *(LAS u32x2*)(K + (16 * tt + fr) * LDE + 16 * ee + 4 * fq) = pack4(ak);
        const f32x4 av = tile_mm<128>(U + (16 * tt) * LDU, LDU, WV + (size_t)(16 * ee) * 128, 128, F4Z, fr, fq);
        *(LAS u32x2*)(VT + (16 * ee + fr) * LDT + 16 * tt + 4 * fq) = pack4(av);
    }
    __syncthreads();
#pragma unroll
    for (int q = 0; q < 2; ++q) {
        const int id = 2 * w + q, tt = id >> 2, ss = id & 3; f32x4 acc = F4Z;
        if (ss <= tt) acc = tile_mm<128>(K + (16 * ss) * LDE, LDE, Q + (16 * tt) * LDE, LDE, acc, fr, fq);
        const int t = 16 * tt + fr, s0 = 16 * ss + 4 * fq; const float rf = RF[t];
#pragma unroll
        for (int r = 0; r < 4; ++r) acc[r] = (s0 + r > t) ? 0.f : acc[r] * rf * CF[s0 + r];
        *(LAS u32x2*)(W + t * LDT + s0) = pack4(acc);
    }
    __syncthreads();
    f32x4 res[5];
#pragma unroll
    for (int q = 0; q < 5; ++q) {
        const int id = w + 8 * q, tt = id & 3, vv = id >> 2; res[q] = F4Z;
        if (id < 36) {
            f32x4 acc = F4Z;
#pragma unroll
            for (int k4 = 0; k4 < 4; ++k4) acc = __builtin_amdgcn_mfma_f32_16x16x32_bf16(stf[q][k4], ld8(Q + (16 * tt + fr) * LDE + 32 * k4 + 8 * fq), acc, 0, 0, 0);
            acc *= RF[16 * tt + fr];
            res[q] = tile_mm<64>(VT + (16 * vv) * LDT, LDT, W + (16 * tt) * LDT, LDT, acc, fr, fq);
        }
    }
    __syncthreads();
#pragma unroll
    for (int q = 0; q < 5; ++q) { const int id = w + 8 * q, tt = id & 3, vv = id >> 2; if (id < 36) *(LAS f32x4*)(O + (16 * tt + fr) * 148 + 16 * vv + 4 * fq) = res[q]; }
    __syncthreads();
    {
#pragma unroll
        for (int i = 0; i < 8; ++i) { const int t = 8 * w + i; const float inv = rcpf_(fmaxf(fabsf(O[t * 148 + 128]), 1.0f));
            const float h0 = O[t * 148 + lane] * inv, h1 = O[t * 148 + lane + 64] * inv;
            const float ss = wave_sum(h0 * h0 + h1 * h1, lane); if (lane == 0) RSQ[t] = inv * rsqf_(ss * (1.0f / 128) + NORM_EPS); }
    }
    __syncthreads();
    for (int i = tid; i < 64 * 16; i += 512) { const int t = i >> 4, v0 = (i & 15) * 8; float g[8]; const float rs = RSQ[t];
        bf16* zp = Z + (size_t)(rowb + t) * ZP + ZA_O + h * 128 + v0; unpack8(*(const u32x4*)zp, g);
        const float* gn = C.inp(I_ML_NORM, l, WB) + h * 128 + v0; float o[8];
#pragma unroll
        for (int j = 0; j < 8; ++j) o[j] = O[t * 148 + v0 + j] * rs * gn[j] * sigmoidf_(g[j]);
        u32x4 wv; wv.x = pk2(o[0], o[1]); wv.y = pk2(o[2], o[3]); wv.z = pk2(o[4], o[5]); wv.w = pk2(o[6], o[7]);
        if (!DRY) *(u32x4*)zp = wv; else asm volatile("" :: "v"(wv)); }
    __syncthreads();
}

constexpr size_t SO_S5_K = SO_END0;
constexpr size_t SO_S5_BB = SO_S5_K + 1 * MiB;
constexpr size_t SO_S5_PM = SO_S5_BB + 256 * 1024;
constexpr size_t SO_S5_POW = SO_S5_PM + 512 * 1024;
constexpr size_t SO_S5_E = SO_S5_POW + 1280 * 1024;
constexpr size_t SO_END1 = SO_S5_E + 4 * MiB;
static_assert(WS_S + SO_END1 <= WS_END, "state region");
__device__ __forceinline__ void s5_prep(const Ctx& C, int l, int g, int part) {
    LAS float* BBr = (LAS float*)C.lds; LAS float* BBi = BBr + 1024; LAS float* PW = BBi + 1024; LAS float* CR = PW + 65 * 128; LAS float* CI = CR + 1024;
    const int tid = C.tid;
    if (tid < 64) { const int p = tid;
        const float are = C.inp(I_S5_ARE, l, 32 * 64)[g * 64 + p], aim = C.inp(I_S5_AIM, l, 32 * 64)[g * 64 + p];
        const float step = expf(C.inp(I_S5_LOGSTEP, l, 32)[g]); const float lre = fminf(are, -1e-4f), lim = aim;
        const float mag = expf(lre * step), bre = mag * cosf(lim * step), bim = mag * sinf(lim * step), den = lre * lre + lim * lim;
        const float cre = ((bre - 1.0f) * lre + bim * lim) / den, cim = (bim * lre - (bre - 1.0f) * lim) / den;
        const float* br = C.inp(I_S5_BRE, l, 32 * 64 * 16) + (size_t)(g * 64 + p) * 16; const float* bi = C.inp(I_S5_BIM, l, 32 * 64 * 16) + (size_t)(g * 64 + p) * 16;
        for (int c = 0; c < 16; ++c) { BBr[p * 16 + c] = cre * br[c] - cim * bi[c]; BBi[p * 16 + c] = cre * bi[c] + cim * br[c]; }
        float pr = 1.f, pi = 0.f;
        for (int n = 0; n <= 64; ++n) { PW[(n * 64 + p) * 2] = pr; PW[(n * 64 + p) * 2 + 1] = pi; const float nr = pr * bre - pi * bim, ni = pr * bim + pi * bre; pr = nr; pi = ni; }
    }
    for (int i = tid; i < 1024; i += 512) { CR[i] = C.inp(I_S5_CRE, l, 32 * 1024)[g * 1024 + i]; CI[i] = C.inp(I_S5_CIM, l, 32 * 1024)[g * 1024 + i]; }
    __syncthreads();
    unsigned char* S = C.ws + WS_S;
    if (part == 0) {
    float* POW = (float*)(S + SO_S5_POW) + (size_t)g * 65 * 128;
    for (int i = tid; i < 65 * 128; i += 512) POW[i] = PW[i];
    bf16* BB = (bf16*)(S + SO_S5_BB) + (size_t)g * 128 * 32;
    for (int i = tid; i < 128 * 32; i += 512) { const int row = i >> 5, c = i & 31, pp = row >> 5, ri = (row >> 4) & 1, p = 16 * pp + (row & 15);
        BB[i] = (bf16)f2bf(c < 16 ? (ri ? BBi[p * 16 + c] : BBr[p * 16 + c]) : 0.f); }
    bf16* PM = (bf16*)(S + SO_S5_PM) + (size_t)g * 64 * 128;
    for (int i = tid; i < 64 * 128; i += 512) { const int t = i >> 7, k = i & 127, ri = k >> 6, p = k & 63;
        PM[i] = (bf16)f2bf(ri ? -PW[((t + 1) * 64 + p) * 2 + 1] : PW[((t + 1) * 64 + p) * 2]); }
    }
    bf16* KM = (bf16*)(S + SO_S5_K) + (size_t)g * 16 * 1024;
    for (int i = part * 2048 + tid; i < (part + 1) * 2048; i += 512) { const int cp = i >> 10, k = i & 1023, tau = k >> 4, c = k & 15; float s = 0.f;
        for (int p = 0; p < 64; ++p) { const float cr = CR[cp * 64 + p], ci = CI[cp * 64 + p], pr = PW[(tau * 64 + p) * 2], pi = PW[(tau * 64 + p) * 2 + 1];
            const float wr = cr * pr - ci * pi, wi = cr * pi + ci * pr; s += wr * BBr[p * 16 + c] - wi * BBi[p * 16 + c]; }
        KM[i] = (bf16)f2bf(s); }
    __syncthreads();
}
__device__ __forceinline__ void s5_passA(const Ctx& C) {
    const int g = C.bid >> 3, sb = C.bid & 7, lane = C.lane, fr = lane & 15, fq = lane >> 4, tid = C.tid;
    const bf16* Z = (const bf16*)(C.ws + WS_Z); unsigned char* S = C.ws + WS_S;
    LAS bf16* BBL = (LAS bf16*)(C.lds + 65536);
    LAS float* POWL = (LAS float*)(C.lds + 65536 + 8192);
    {   const u32x4* src = (const u32x4*)((const bf16*)(S + SO_S5_BB) + (size_t)g * 128 * 32); LAS u32x4* dst = (LAS u32x4*)BBL; dst[tid] = src[tid];
        const u32x4* ps = (const u32x4*)((const float*)(S + SO_S5_POW) + (size_t)g * 65 * 128); LAS u32x4* pd = (LAS u32x4*)POWL;
        for (int i = tid; i < 65 * 128 / 4; i += 512) pd[i] = ps[i]; }
    __syncthreads();
    LAS bf16* UA = (LAS bf16*)(C.lds + C.wave * 8192);
#pragma unroll 1
    for (int i4 = 0; i4 < 4; ++i4) {
        const int j = sb * 32 + C.wave * 4 + i4, b = j >> 6, c = j & 63, item = (b * 32 + g) * 64 + c, rowb = b * SEQ + c * LCH;
        {   const u32x4* src = (const u32x4*)(Z + (size_t)(rowb + lane) * ZP + ZB_U + g * 16); const u32x4 z4 = (u32x4){0u, 0u, 0u, 0u};
            LAS u32x4* dst = (LAS u32x4*)(UA + lane * 40); dst[0] = src[0]; dst[1] = src[1]; dst[2] = z4; dst[3] = z4; }
        LDS_WAIT(); __builtin_amdgcn_wave_barrier();
        float* E = (float*)(S + SO_S5_E) + (size_t)item * 128;
#pragma unroll
        for (int pp = 0; pp < 4; ++pp) { float er = 0.f, ei = 0.f; const int p = 16 * pp + fr;
#pragma unroll
            for (int tt = 0; tt < 4; ++tt) {
                const f32x4 br = tile_mm<32>(UA + (16 * tt) * 40, 40, BBL + (pp * 32) * 32, 32, F4Z, fr, fq);
                const f32x4 bi = tile_mm<32>(UA + (16 * tt) * 40, 40, BBL + (pp * 32 + 16) * 32, 32, F4Z, fr, fq);
#pragma unroll
                for (int r = 0; r < 4; ++r) { const int t = 16 * tt + 4 * fq + r; const f32x2 pw = *(const LAS f32x2*)(POWL + ((63 - t) * 64 + p) * 2);
                    er += pw.x * br[r] - pw.y * bi[r]; ei += pw.x * bi[r] + pw.y * br[r]; }
            }
            er += shx(er, 16, lane); er += shx(er, 32, lane); ei += shx(ei, 16, lane); ei += shx(ei, 32, lane);
            if (fq == 0) { E[p] = er; E[64 + p] = ei; }
        }
        LDS_WAIT(); __builtin_amdgcn_wave_barrier();
    }
    __syncthreads();
}
__device__ __forceinline__ void s5_passB(const Ctx& C) {
    const int idx = C.bid * 512 + C.tid; if (idx >= 8192) return;
    const int bg = idx >> 6, p = idx & 63, g = bg & 31; unsigned char* S = C.ws + WS_S;
    const f32x2 l64 = *(const f32x2*)((const float*)(S + SO_S5_POW) + (size_t)g * 65 * 128 + (64 * 64 + p) * 2);
    float* E = (float*)(S + SO_S5_E) + (size_t)bg * 64 * 128 + p;
    float er[64], ei[64];
#pragma unroll
    for (int c = 0; c < 64; ++c) { er[c] = E[c * 128]; ei[c] = E[c * 128 + 64]; }
    float rr = 0.f, ri = 0.f;
#pragma unroll
    for (int c = 0; c < 64; ++c) { E[c * 128] = rr; E[c * 128 + 64] = ri; const float nr = l64.x * rr - l64.y * ri + er[c], ni = l64.x * ri + l64.y * rr + ei[c]; rr = nr; ri = ni; }
}
constexpr int LDKM = 1032;
template <class RW> __device__ __forceinline__ void s5_passC_core(const Ctx& C, int l, RW rw_items) {
    const int g = C.bid >> 3, sb = C.bid & 7, lane = C.lane, fr = lane & 15, fq = lane >> 4, tid = C.tid;
    bf16* Z = (bf16*)(C.ws + WS_Z); unsigned char* S = C.ws + WS_S;
    LAS bf16* KML = (LAS bf16*)(C.lds + 73728);
    LAS bf16* PML = (LAS bf16*)(C.lds + 73728 + 16 * LDKM * 2);
    {   const u32x4* ks = (const u32x4*)((const bf16*)(S + SO_S5_K) + (size_t)g * 16 * 1024);
        for (int i = tid; i < 16 * 128; i += 512) *(LAS u32x4*)(KML + (i >> 7) * LDKM + (i & 127) * 8) = ks[i];
        const u32x4* ps = (const u32x4*)((const bf16*)(S + SO_S5_PM) + (size_t)g * 64 * 128);
        for (int i = tid; i < 64 * 16; i += 512) *(LAS u32x4*)(PML + (i >> 4) * 136 + (i & 15) * 8) = ps[i]; }
    __syncthreads();
    if (C.wave < 4) { rw_items(); __syncthreads(); return; }
    LAS bf16* UP = (LAS bf16*)(C.lds + C.wave * 9216);
    LAS bf16* WV = UP + 128 * 16;
    const float* dsk = C.inp(I_S5_D, l, WB) + g * 16;
#pragma unroll 1
    for (int i4 = 0; i4 < 8; ++i4) {
        const int j = sb * 32 + (C.wave - 4) * 8 + i4, b = j >> 6, c = j & 63, item = (b * 32 + g) * 64 + c, rowb = b * SEQ + c * LCH;
        {   const u32x4* src = (const u32x4*)(Z + (size_t)(rowb + lane) * ZP + ZB_U + g * 16); const u32x4 z4 = (u32x4){0u, 0u, 0u, 0u};
            LAS u32x4* dz = (LAS u32x4*)(UP + lane * 16); dz[0] = z4; dz[1] = z4; LAS u32x4* dst = (LAS u32x4*)(UP + (64 + lane) * 16); dst[0] = src[0]; dst[1] = src[1]; }
        {   const float* E = (const float*)(S + SO_S5_E) + (size_t)item * 128; const int cp = lane >> 2, pq = lane & 3;
            const float* cr = C.inp(I_S5_CRE, l, 32 * 1024) + (size_t)g * 1024 + cp * 64 + 16 * pq; const float* ci = C.inp(I_S5_CIM, l, 32 * 1024) + (size_t)g * 1024 + cp * 64 + 16 * pq;
#pragma unroll
            for (int jj = 0; jj < 16; jj += 2) { const int p = 16 * pq + jj;
                const float a0 = cr[jj] * E[p] - ci[jj] * E[64 + p], b0 = cr[jj] * E[64 + p] + ci[jj] * E[p], a1 = cr[jj + 1] * E[p + 1] - ci[jj + 1] * E[65 + p], b1 = cr[jj + 1] * E[65 + p] + ci[jj + 1] * E[p + 1];
                *(LAS unsigned*)(WV + cp * 136 + p) = pk2(a0, a1); *(LAS unsigned*)(WV + cp * 136 + 64 + p) = pk2(b0, b1); }
        }
        LDS_WAIT(); __builtin_amdgcn_wave_barrier();
#pragma unroll
        for (int tt = 0; tt < 4; ++tt) {
            f32x4 acc = F4Z; const int t = 16 * tt + fr;
#pragma unroll 4
            for (int ks = 0; ks < 8 * (tt + 1); ++ks) {
                const bf16x8 a = ld8(KML + fr * LDKM + 32 * ks + 8 * fq);
                const bf16x8 bb = ld8(UP + (64 + t - 2 * ks - (fq >> 1)) * 16 + 8 * (fq & 1));
                acc = __builtin_amdgcn_mfma_f32_16x16x32_bf16(a, bb, acc, 0, 0, 0);
            }
            acc = tile_mm<128>(WV, 136, PML + (16 * tt) * 136, 136, acc, fr, fq);
            float y[4];
#pragma unroll
            for (int r = 0; r < 4; ++r) { const int cp = 4 * fq + r; y[r] = gelu_tanh(acc[r] + dsk[cp] * bf2f(UP[(64 + t) * 16 + cp])); }
            u32x2 o; o.x = pk2(y[0], y[1]); o.y = pk2(y[2], y[3]);
            *(u32x2*)(Z + (size_t)(rowb + t) * ZP + ZB_U + g * 16 + 4 * fq) = o;
        }
        LDS_WAIT(); __builtin_amdgcn_wave_barrier();
    }
    __syncthreads();
}

constexpr size_t SO_RW_PQ = SO_END1;
constexpr size_t SO_RW_RHO = SO_RW_PQ + 32 * MiB;
constexpr size_t SO_RW_HALO = SO_RW_RHO + 512 * 1024;
constexpr size_t SO_RW_W = SO_RW_HALO + 512 * 1024;
constexpr size_t SO_END2 = SO_RW_W + 256 * 1024;
static_assert(WS_S + SO_END2 <= WS_END, "state region");
static_assert(SO_RW_W == RWW_OFF, "RWW_OFF");
__device__ __forceinline__ void shift8(const u32x4 cur, const u32x4 prev, const float* mu, float* o) {
    float a[8], p[8]; unpack8(cur, a); unpack8(prev, p);
#pragma unroll
    for (int j = 0; j < 8; ++j) o[j] = a[j] + mu[j] * (p[j] - a[j]);
}
__device__ __forceinline__ u32x4 pack8(const float* f) { u32x4 w; w.x = pk2(f[0], f[1]); w.y = pk2(f[2], f[3]); w.z = pk2(f[4], f[5]); w.w = pk2(f[6], f[7]); return w; }

struct RwPre { u32x4 cw, pw, ca, pa, cr, ck, cv, pr, pk, pv; };
__device__ __forceinline__ void rw_preload(const Ctx& C, int item, RwPre& P) {
    const int bh = item >> 6, c = item & 63, b = bh >> 3, h = bh & 7, hc0 = h * 64, rowb = b * SEQ + c * LCH;
    const bf16* Z = (const bf16*)(C.ws + WS_Z); const int t = C.tid >> 3, c0 = (C.tid & 7) * 8, row = rowb + t;
    const bf16* HALO = (const bf16*)(C.ws + WS_S + SO_RW_HALO) + (size_t)(b * 64 + c - 1) * 1024;
    const u32x4 z4 = (u32x4){0u, 0u, 0u, 0u}; const bool first = (c * LCH + t == 0);
    P.cw = *(const u32x4*)(Z + (size_t)row * ZP + ZD_XW + c0); P.ca = *(const u32x4*)(Z + (size_t)row * ZP + ZD_XA + c0);
    P.cr = *(const u32x4*)(Z + (size_t)row * ZP + ZD_R + hc0 + c0); P.ck = *(const u32x4*)(Z + (size_t)row * ZP + ZD_K + hc0 + c0); P.cv = *(const u32x4*)(Z + (size_t)row * ZP + ZD_V + hc0 + c0);
    P.pw = z4; P.pa = z4; P.pr = z4; P.pk = z4; P.pv = z4;
    if (!first) { P.pw = *(const u32x4*)(Z + (size_t)(row - 1) * ZP + ZD_XW + c0); P.pa = *(const u32x4*)(Z + (size_t)(row - 1) * ZP + ZD_XA + c0); P.pv = *(const u32x4*)(Z + (size_t)(row - 1) * ZP + ZD_V + hc0 + c0);
        if (t > 0) { P.pr = *(const u32x4*)(Z + (size_t)(row - 1) * ZP + ZD_R + hc0 + c0); P.pk = *(const u32x4*)(Z + (size_t)(row - 1) * ZP + ZD_K + hc0 + c0); }
        else { P.pr = *(const u32x4*)(HALO + hc0 + c0); P.pk = *(const u32x4*)(HALO + 512 + hc0 + c0); } }
}
template <bool DRY = false> __device__ __forceinline__ void rw_passA(const Ctx& C, int l, int item, RwPre& P, int next_item) {
    const int bh = item >> 6, c = item & 63, b = bh >> 3, h = bh & 7, hc0 = h * 64, rowb = b * SEQ + c * LCH;
    bf16* Z = (bf16*)(C.ws + WS_Z); unsigned char* S = C.ws + WS_S;
    LAS unsigned char* L = C.lds;
    LAS bf16* XW = (LAS bf16*)L; LAS bf16* XA = (LAS bf16*)(L + 9216); LAS float* WARG = (LAS float*)(L + 18432);
    LAS bf16* TAB = (LAS bf16*)L; LAS bf16* TAK = (LAS bf16*)(L + 9216); LAS bf16* MRB = (LAS bf16*)(L + 18432); LAS bf16* MRK = (LAS bf16*)(L + 27648);
    LAS float* AARG = (LAS float*)(L + 36864); LAS float* LW = AARG; LAS bf16* XT = (LAS bf16*)(L + 36864);
    LAS bf16* AT = (LAS bf16*)(L + 55296); LAS bf16* RT = (LAS bf16*)(L + 64512); LAS bf16* BT = (LAS bf16*)(L + 73728); LAS bf16* KT = (LAS bf16*)(L + 82944);
    LAS float* RHSV = (LAS float*)(L + 73728);
    LAS bf16* BBT = (LAS bf16*)(L + 92160); LAS bf16* KBT = (LAS bf16*)(L + 101376); LAS bf16* VT = (LAS bf16*)(L + 110592);
    LAS float* CUML = (LAS float*)(L + 119808); LAS float* GL = CUML + 64; LAS float* SEG = GL + 64; LAS float* UPD = SEG;
    const int tid = C.tid, lane = C.lane, w = C.wave, fr = lane & 15, fq = lane >> 4;
    const int t = tid >> 3, c0 = (tid & 7) * 8, row = rowb + t;
    const float* mu = C.inp(I_RW_MU, l, 1792);
    const u32x4 z4 = (u32x4){0u, 0u, 0u, 0u};
    {   float f[8];
        shift8(P.cw, P.pw, mu + 1536 + c0, f);
#pragma unroll
        for (int j = 0; j < 8; ++j) f[j] = tanhf_(f[j]);
        *(LAS u32x4*)(XW + t * LDT + c0) = pack8(f);
        shift8(P.ca, P.pa, mu + 1600 + c0, f);
        *(LAS u32x4*)(XA + t * LDT + c0) = pack8(f);
    }
    __syncthreads();
    {   const bf16* WUP = (const bf16*)(S + SO_RW_W) + (size_t)hc0 * 64; const bf16* AUP = WUP + 512 * 64;
#pragma unroll
        for (int q = 0; q < 2; ++q) { const int id = 2 * w + q, tt = id >> 2, cc = id & 3;
            const f32x4 aw = tile_mm<64>(XW + (16 * tt) * LDT, LDT, WUP + (size_t)(16 * cc) * 64, 64, F4Z, fr, fq);
            const f32x4 aa = tile_mm<64>(XA + (16 * tt) * LDT, LDT, AUP + (size_t)(16 * cc) * 64, 64, F4Z, fr, fq);
#pragma unroll
            for (int r = 0; r < 4; ++r) { WARG[(16 * tt + 4 * fq + r) * 65 + 16 * cc + fr] = aw[r]; AARG[(16 * tt + 4 * fq + r) * 65 + 16 * cc + fr] = aa[r]; } }
    }
    __syncthreads();
    float lw[8], av[8], bv[8], kr[8], rr[8], vv[8];
    {   float kk[8], aa[8];
        shift8(P.cr, P.pr, mu + hc0 + c0, rr); shift8(P.ck, P.pk, mu + 512 + hc0 + c0, kk); shift8(P.cv, P.pv, mu + 1024 + hc0 + c0, vv);
        const float* w0 = C.inp(I_RW_W0, l, WB) + hc0 + c0; const float* a0 = C.inp(I_RW_A0, l, WB) + hc0 + c0;
        const float* kkw = C.inp(I_RW_KK, l, WB) + hc0 + c0; const float* kaw = C.inp(I_RW_KA, l, WB) + hc0 + c0; const float* rkw = C.inp(I_RW_RK, l, WB) + hc0 + c0;
        float n2 = 0.f, rho = 0.f;
#pragma unroll
        for (int j = 0; j < 8; ++j) {
            const float wl = -softplusf_(-(WARG[t * 65 + c0 + j] + w0[j])) - 0.5f; lw[j] = -__expf(wl);
            aa[j] = sigmoidf_(AARG[t * 65 + c0 + j] + a0[j]);
            const float kn = kk[j] * kkw[j]; n2 += kn * kn; av[j] = kn;
            kr[j] = kk[j] * (1.0f + (aa[j] - 1.0f) * kaw[j]); rho += rr[j] * kr[j] * rkw[j];
        }
        n2 += shx(n2, 1, lane); n2 += shx(n2, 2, lane); n2 += shx(n2, 4, lane);
        rho += shx(rho, 1, lane); rho += shx(rho, 2, lane); rho += shx(rho, 4, lane);
        const float inv = rcpf_(fmaxf(sqrtf(n2), 1e-12f));
#pragma unroll
        for (int j = 0; j < 8; ++j) { const float kkn = av[j] * inv; av[j] = -kkn; bv[j] = kkn * aa[j]; }
        if (!DRY && (tid & 7) == 0) ((float*)(S + SO_RW_RHO))[(size_t)row * 8 + h] = rho;
    }
    __syncthreads();
    if (next_item >= 0) rw_preload(C, next_item, P);
#pragma unroll
    for (int j = 0; j < 8; ++j) LW[t * 64 + c0 + j] = lw[j];
    __syncthreads();
    {   const int cc = tid & 63, seg = tid >> 6; float run = 0.f, v8[8];
#pragma unroll
        for (int i = 0; i < 8; ++i) { run += LW[(seg * 8 + i) * 64 + cc]; v8[i] = run; }
        SEG[seg * 64 + cc] = run;
        __syncthreads();
        float off = 0.f;
        for (int s2 = 0; s2 < seg; ++s2) off += SEG[s2 * 64 + cc];
#pragma unroll
        for (int i = 0; i < 8; ++i) LW[(seg * 8 + i) * 64 + cc] = v8[i] + off;
        if (seg == 7) { CUML[cc] = v8[7] + off; GL[cc] = __expf(v8[7] + off); }
    }
    __syncthreads();
    {   float fa[8], fb[8], fk[8], fr_[8];
#pragma unroll
        for (int j = 0; j < 8; ++j) { const float cm = LW[t * 64 + c0 + j], en = __expf(-cm), el = __expf(CUML[c0 + j] - cm);
            fa[j] = av[j] * __expf(cm - lw[j]); fb[j] = bv[j] * en; fk[j] = kr[j] * en; fr_[j] = rr[j] * __expf(cm);
            BBT[(c0 + j) * LDT + t] = (bf16)f2bf(bv[j] * el); KBT[(c0 + j) * LDT + t] = (bf16)f2bf(kr[j] * el); VT[(c0 + j) * LDT + t] = (bf16)f2bf(vv[j]); }
        *(LAS u32x4*)(AT + t * LDT + c0) = pack8(fa); *(LAS u32x4*)(BT + t * LDT + c0) = pack8(fb); *(LAS u32x4*)(KT + t * LDT + c0) = pack8(fk); *(LAS u32x4*)(RT + t * LDT + c0) = pack8(fr_);
    }
    __syncthreads();
#pragma unroll
    for (int q = 0; q < 2; ++q) { const int id = 2 * w + q, tt = id >> 2, ss = id & 3; f32x4 ab = F4Z, ak = F4Z, rb = F4Z, rk = F4Z;
        if (ss <= tt) {
            ab = tile_mm<64>(BT + (16 * ss) * LDT, LDT, AT + (16 * tt) * LDT, LDT, ab, fr, fq); ak = tile_mm<64>(KT + (16 * ss) * LDT, LDT, AT + (16 * tt) * LDT, LDT, ak, fr, fq);
            rb = tile_mm<64>(BT + (16 * ss) * LDT, LDT, RT + (16 * tt) * LDT, LDT, rb, fr, fq); rk = tile_mm<64>(KT + (16 * ss) * LDT, LDT, RT + (16 * tt) * LDT, LDT, rk, fr, fq);
        }
        const int tq = 16 * tt + fr, s0 = 16 * ss + 4 * fq;
#pragma unroll
        for (int r = 0; r < 4; ++r) { if (s0 + r >= tq) { ab[r] = 0.f; ak[r] = 0.f; } if (s0 + r > tq) { rb[r] = 0.f; rk[r] = 0.f; } }
        *(LAS u32x2*)(TAB + tq * LDT + s0) = pack4(ab); *(LAS u32x2*)(TAK + tq * LDT + s0) = pack4(ak); *(LAS u32x2*)(MRB + tq * LDT + s0) = pack4(rb); *(LAS u32x2*)(MRK + tq * LDT + s0) = pack4(rk);
    }
    __syncthreads();
#pragma unroll
    for (int q = 0; q < 2; ++q) { const int id = 2 * w + q, vb = id >> 2, tt = id & 3;
        const f32x4 a = tile_mm<64>(VT + (16 * vb) * LDT, LDT, TAK + (16 * tt) * LDT, LDT, F4Z, fr, fq);
#pragma unroll
        for (int r = 0; r < 4; ++r) RHSV[(16 * vb + 4 * fq + r) * 65 + 16 * tt + fr] = a[r]; }
    for (int i = tid; i < 128 * LDT / 8; i += 512) ((LAS u32x4*)XT)[i] = z4;
    __syncthreads();
#pragma unroll
    for (int bi = 0; bi < 4; ++bi) {
        if (bi > 0) {
            const f32x4 u = tile_mm<64>(XT + (16 * w) * LDT, LDT, TAB + (16 * bi) * LDT, LDT, F4Z, fr, fq);
#pragma unroll
            for (int r = 0; r < 4; ++r) UPD[(16 * w + 4 * fq + r) * 17 + fr] = u[r];
            __syncthreads();
        }
        if (tid < 128) { const int col = tid; float x[16];
#pragma unroll
            for (int i = 0; i < 16; ++i) { const int tr = 16 * bi + i;
                float s = (col < 64) ? bf2f(AT[tr * LDT + col]) : RHSV[(col - 64) * 65 + tr];
                if (bi > 0) s += UPD[col * 17 + i];
                float tf[16];
                if (i > 0) unpack8(*(const LAS u32x4*)(TAB + tr * LDT + 16 * bi), tf);
                if (i > 8) unpack8(*(const LAS u32x4*)(TAB + tr * LDT + 16 * bi + 8), tf + 8);
#pragma unroll
                for (int i2 = 0; i2 < i; ++i2) s += tf[i2] * x[i2];
                x[i] = s; asm volatile("" ::: "memory"); }
            *(LAS u32x4*)(XT + col * LDT + 16 * bi) = pack8(x); *(LAS u32x4*)(XT + col * LDT + 16 * bi + 8) = pack8(x + 8);
        }
        __syncthreads();
    }
    bf16* PQ = (bf16*)(S + SO_RW_PQ) + (size_t)item * 8192;
#pragma unroll
    for (int q = 0; q < 2; ++q) { const int id = 2 * w + q, ib = id >> 2, jb = id & 3;
        {
            f32x4 a = tile_mm<64>(XT + (16 * ib) * LDT, LDT, MRB + (16 * jb) * LDT, LDT, F4Z, fr, fq);
            const int tq = 16 * jb + fr, j0 = 16 * ib + 4 * fq; const u32x2 rt = *(const LAS u32x2*)(RT + tq * LDT + j0);
            a[0] += bflo(rt.x); a[1] += bfhi(rt.x); a[2] += bflo(rt.y); a[3] += bfhi(rt.y);
            if (!DRY) *(u32x2*)(Z + (size_t)(rowb + tq) * ZP + ZD_R + hc0 + j0) = pack4(a); else asm volatile("" :: "v"(a)); }
        {
            f32x4 a = tile_mm<64>(XT + (64 + 16 * ib) * LDT, LDT, MRB + (16 * jb) * LDT, LDT, F4Z, fr, fq);
            a = tile_mm<64>(VT + (16 * ib) * LDT, LDT, MRK + (16 * jb) * LDT, LDT, a, fr, fq);
            if (!DRY) *(u32x2*)(Z + (size_t)(rowb + 16 * jb + fr) * ZP + ZD_K + hc0 + 16 * ib + 4 * fq) = pack4(a); else asm volatile("" :: "v"(a)); }
        {
            f32x4 a = tile_mm<64>(XT + (16 * ib) * LDT, LDT, BBT + (16 * jb) * LDT, LDT, F4Z, fr, fq);
            const int k = 16 * jb + fr, j0 = 16 * ib + 4 * fq;
#pragma unroll
            for (int r = 0; r < 4; ++r) if (j0 + r == k) a[r] += GL[k];
            if (!DRY) *(u32x2*)(PQ + (size_t)k * 64 + j0) = pack4(a); else asm volatile("" :: "v"(a)); }
        {
            f32x4 a = tile_mm<64>(BBT + (16 * ib) * LDT, LDT, XT + (64 + 16 * jb) * LDT, LDT, F4Z, fr, fq);
            a = tile_mm<64>(KBT + (16 * ib) * LDT, LDT, VT + (16 * jb) * LDT, LDT, a, fr, fq);
            if (!DRY) *(u32x2*)(PQ + 4096 + (size_t)(16 * jb + fr) * 64 + 16 * ib + 4 * fq) = pack4(a); else asm volatile("" :: "v"(a)); }
    }
    __syncthreads();
}
__device__ __forceinline__ void rw_passB(const Ctx& C, int unit) {
    const int bh = unit >> 2, vg = unit & 3, lane = C.lane, fr = lane & 15, fq = lane >> 4;
    LAS bf16* SL = (LAS bf16*)(C.lds + C.wave * 16384);
    bf16* PQ0 = (bf16*)(C.ws + WS_S + SO_RW_PQ) + (size_t)bh * 64 * 8192;
    for (int i = lane; i < 16 * LDT / 8; i += 64) ((LAS u32x4*)SL)[i] = (u32x4){0u, 0u, 0u, 0u};
    LDS_WAIT(); __builtin_amdgcn_wave_barrier();
    bf16x8 pa[4][4][2]; u32x2 qa[4][4];
#define RWB_FETCH(s, cc) do { const bf16* P_ = PQ0 + (size_t)(cc) * 8192; const bf16* Q_ = P_ + 4096 + (size_t)(16 * vg) * 64; _Pragma("unroll") for (int kk = 0; kk < 4; ++kk) { \
        pa[s][kk][0] = ld8(P_ + (size_t)(16 * kk + fr) * 64 + 8 * fq); pa[s][kk][1] = ld8(P_ + (size_t)(16 * kk + fr) * 64 + 32 + 8 * fq); qa[s][kk] = *(const u32x2*)(Q_ + (size_t)fr * 64 + 16 * kk + 4 * fq); } } while (0)
    RWB_FETCH(0, 0); RWB_FETCH(1, 1); RWB_FETCH(2, 2); RWB_FETCH(3, 3);
    for (int c4 = 0; c4 < 64; c4 += 4) {
#pragma unroll
        for (int s = 0; s < 4; ++s) {
            const int c = c4 + s;
            bf16* QT = PQ0 + (size_t)c * 8192 + 4096 + (size_t)(16 * vg) * 64;
            const bf16x8 b0 = ld8(SL + fr * LDT + 8 * fq), b1 = ld8(SL + fr * LDT + 32 + 8 * fq);
            const u32x4 s0 = *(const LAS u32x4*)(SL + (lane >> 2) * LDT + (lane & 3) * 16), s1 = *(const LAS u32x4*)(SL + (lane >> 2) * LDT + (lane & 3) * 16 + 8);
            f32x4 acc[4];
#pragma unroll
            for (int kk = 0; kk < 4; ++kk) {
                f32x4 a; a[0] = bflo(qa[s][kk].x); a[1] = bfhi(qa[s][kk].x); a[2] = bflo(qa[s][kk].y); a[3] = bfhi(qa[s][kk].y);
                a = __builtin_amdgcn_mfma_f32_16x16x32_bf16(pa[s][kk][0], b0, a, 0, 0, 0);
                acc[kk] = __builtin_amdgcn_mfma_f32_16x16x32_bf16(pa[s][kk][1], b1, a, 0, 0, 0);
            }
            LDS_WAIT(); __builtin_amdgcn_wave_barrier();
            *(u32x4*)(QT + (size_t)(lane >> 2) * 64 + (lane & 3) * 16) = s0; *(u32x4*)(QT + (size_t)(lane >> 2) * 64 + (lane & 3) * 16 + 8) = s1;
#pragma unroll
            for (int kk = 0; kk < 4; ++kk) *(LAS u32x2*)(SL + fr * LDT + 16 * kk + 4 * fq) = pack4(acc[kk]);
            LDS_WAIT(); __builtin_amdgcn_wave_barrier();
            if (c + 4 < 64) RWB_FETCH(s, c + 4);
        }
    }
#undef RWB_FETCH
}
template <bool DRY = false> __device__ __forceinline__ void rw_passC(const Ctx& C, int l, int item) {
    const int bh = item >> 6, c = item & 63, b = bh >> 3, h = bh & 7, hc0 = h * 64, rowb = b * SEQ + c * LCH;
    bf16* Z = (bf16*)(C.ws + WS_Z); unsigned char* S = C.ws + WS_S;
    const int tt = C.wave & 3, lane = C.lane, fr = lane & 15, fq = lane >> 4, t = 16 * tt + fr, row = rowb + t;
    LAS bf16* XG = (LAS bf16*)(C.lds + tt * 4608);
    const float* mu = C.inp(I_RW_MU, l, 1792); const u32x4 z4 = (u32x4){0u, 0u, 0u, 0u};
    {
        const int tl = lane >> 2, rw = rowb + 16 * tt + tl; const bool first = (c * LCH + 16 * tt + tl == 0);
#pragma unroll
        for (int q = 0; q < 4; ++q) { const int j0 = (lane & 3) * 32 + q * 8; float f[8];
            const u32x4 cg = *(const u32x4*)(Z + (size_t)rw * ZP + ZD_XG + j0), pg = first ? z4 : *(const u32x4*)(Z + (size_t)(rw - 1) * ZP + ZD_XG + j0);
            shift8(cg, pg, mu + 1664 + j0, f);
#pragma unroll
            for (int j = 0; j < 8; ++j) f[j] = sigmoidf_(f[j]);
            *(LAS u32x4*)(XG + tl * 136 + j0) = pack8(f); }
    }
    LDS_WAIT(); __builtin_amdgcn_wave_barrier();
    const bf16* SST = (const bf16*)(S + SO_RW_PQ) + (size_t)item * 8192 + 4096;
    const bf16* GUP = (const bf16*)(S + SO_RW_W) + 2 * 512 * 64 + (size_t)hc0 * 128;
    f32x4 y[4], g[4];
#pragma unroll
    for (int vb = 0; vb < 4; ++vb) {
        y[vb] = tile_mm<64>(SST + (size_t)(16 * vb) * 64, 64, Z + (size_t)(rowb + 16 * tt) * ZP + ZD_R + hc0, ZP, F4Z, fr, fq);
        const u32x2 yl = *(const u32x2*)(Z + (size_t)row * ZP + ZD_K + hc0 + 16 * vb + 4 * fq);
        y[vb][0] += bflo(yl.x); y[vb][1] += bfhi(yl.x); y[vb][2] += bflo(yl.y); y[vb][3] += bfhi(yl.y);
        g[vb] = tile_mm<128>(GUP + (size_t)(16 * vb) * 128, 128, XG, 136, F4Z, fr, fq);
    }
    float s1 = 0.f;
#pragma unroll
    for (int vb = 0; vb < 4; ++vb) s1 += (y[vb][0] + y[vb][1]) + (y[vb][2] + y[vb][3]);
    s1 += shx(s1, 16, lane); s1 += shx(s1, 32, lane);
    const float mean = s1 * (1.0f / 64); float s2 = 0.f;
#pragma unroll
    for (int vb = 0; vb < 4; ++vb)
#pragma unroll
        for (int r = 0; r < 4; ++r) { const float d = y[vb][r] - mean; y[vb][r] = d; s2 += d * d; }
    s2 += shx(s2, 16, lane); s2 += shx(s2, 32, lane);
    const float rs = rsqf_(s2 * (1.0f / 64) + 64e-5f);
    const float rho = ((const float*)(S + SO_RW_RHO))[(size_t)row * 8 + h];
    const bool first = (c * LCH + t == 0);
#pragma unroll
    for (int vb = 0; vb < 4; ++vb) { const int v0 = 16 * vb + 4 * fq;
        const u32x2 cv = *(const u32x2*)(Z + (size_t)row * ZP + ZD_V + hc0 + v0); u32x2 pv; pv.x = 0u; pv.y = 0u;
        if (!first) pv = *(const u32x2*)(Z + (size_t)(row - 1) * ZP + ZD_V + hc0 + v0);
        const float cvf[4] = {bflo(cv.x), bfhi(cv.x), bflo(cv.y), bfhi(cv.y)}, pvf[4] = {bflo(pv.x), bfhi(pv.x), bflo(pv.y), bfhi(pv.y)};
        const float* gn = C.inp(I_RW_NORM, l, WB) + hc0 + v0; const float* mv = mu + 1024 + hc0 + v0; f32x4 o;
#pragma unroll
        for (int r = 0; r < 4; ++r) { const float vs = cvf[r] + mv[r] * (pvf[r] - cvf[r]); o[r] = (y[vb][r] * rs * gn[r] + rho * vs) * g[vb][r]; }
        y[vb] = o; }
    asm volatile("s_waitcnt vmcnt(0)" ::: "memory"); __builtin_amdgcn_wave_barrier();
#pragma unroll
    for (int vb = 0; vb < 4; ++vb) { if (!DRY) *(u32x2*)(Z + (size_t)row * ZP + ZD_R + hc0 + 16 * vb + 4 * fq) = pack4(y[vb]); else asm volatile("" :: "v"(y[vb])); }
    LDS_WAIT(); __builtin_amdgcn_wave_barrier();
}

__device__ __forceinline__ void rw_s5_passC(const Ctx& C, int l) {
    s5_passC_core(C, l, [&]() {
#pragma unroll 1
        for (int i = 0; i < 8; ++i) { const Ctx Ci = make_ctx(); rw_passC(Ci, l, (int)blockIdx.x + 256 * i); }
    });
}
template <class Epi, bool ALIGN> __device__ __forceinline__ void run_gemm(const Ctx& C, const bf16* A, int lda, const bf16* Bt, int ldb, int Mr, int N, int K, const Epi& E, int Gv = 0, int cv = 0) {
    if (Gv == 0) { Gv = C.G; cv = C.bid; }
    if (cv < 0 || cv >= Gv) return;
    pg8::Gemm g{A, Bt, Mr, N, K, lda, ldb}; pg8::StaticOrder S; S.init(Mr, N, Gv, cv);
    pg8::gemm_phase<Epi, pg8::StaticOrder, ALIGN, true>(C.lds, g, S, E);
}

#ifdef PROBE_LO
#define PROBE_STAMP(Cb) do { if (blockIdx.x == 0 && (Cb).tid == 0) { volatile LAS unsigned* m_ = (volatile LAS unsigned*)((Cb).lds + MISC_OFF); const unsigned i_ = m_[16]; m_[16] = i_ + 1u; \
    __hip_atomic_store((unsigned long long*)((Cb).ws + WS_CTL + 32768) + i_, (unsigned long long)__builtin_amdgcn_s_memrealtime(), __ATOMIC_RELAXED, __HIP_MEMORY_SCOPE_AGENT); } } while (0)
#else
#define PROBE_STAMP(Cb) do { } while (0)
#endif
#define GRID_BAR() do { const Ctx Cb = make_ctx(); XcdBarrier b_; b_.bar = (unsigned*)(Cb.ws + WS_CTL) + 4096; b_.x = xb_xcc_id(); b_.st = (volatile LAS unsigned*)(Cb.lds + MISC_OFF) + 8; xcd_barrier(b_); PROBE_STAMP(Cb); } while (0)
#define PHASE_CTX() const Ctx C = make_ctx(); unsigned char* const ws = C.ws; bf16* const XB = (bf16*)(ws + WS_XB); float* const SSQ = (float*)(ws + WS_SSQ); bf16* const Z = (bf16*)(ws + WS_Z); \
    const int gw = C.bid * 8 + C.wave, NGW = C.G * 8; (void)XB; (void)SSQ; (void)Z; (void)gw; (void)NGW
#define SUBSYNC() do { VM_WAIT(); __syncthreads(); } while (0)
#define MERGE_PTRS() unsigned char* const G8 = ws + WS_G8; bf16* const MF = (bf16*)(ws + WS_MF); bf16* const MG = Z + ZC_Q; const bf16* const WG = (const bf16*)(ws + WS_SLOTA); const bf16* const WP = (const bf16*)(ws + WS_SLOTC); \
    const float* const gb = C.inp(I_GATE_BIAS, l, 4 * D); (void)G8; (void)MF; (void)MG; (void)WG; (void)WP; (void)gb
#define PHM_IN() \
        if (PH_ON(3)) {   PHASE_CTX(); \
            run_conv(C, CJ_PROJ | CJ_MLW | CJ_RWW, l, gw, NGW); \
            s5_prep(C, l, C.bid >> 3, C.bid & 7); \
            { EpiZ E{Z, SSQ, (bf16*)(ws + WS_S + RWW_OFF - 512 * 1024)}; run_gemm<EpiZ, true>(C, XB, D, (const bf16*)(ws + WS_SLOTB), D, M, NINP, D, E); } \
        } \
        GRID_BAR();
#define PHM_MIXA() \
        if (PH_ON(4)) {   PHASE_CTX(); \
            run_conv(C, CJ_XW, l, gw, NGW); \
            { RwPre P_; { const Ctx Ci = make_ctx(); rw_preload(Ci, (int)blockIdx.x, P_); } \
              for (int it = blockIdx.x; it < 2048; it += gridDim.x) { const Ctx Ci = make_ctx(); rw_passA(Ci, l, it, P_, (it + (int)gridDim.x < 2048) ? it + (int)gridDim.x : -1); } } \
        } \
        if (PH_ON(4)) {   PHASE_CTX(); \
            for (int it = blockIdx.x; it < 1024; it += gridDim.x) { const Ctx Ci = make_ctx(); ml_passA(Ci, l, it); } \
            if (DUPM == 7 && l == 0) for (int it = blockIdx.x; it < 1024; it += gridDim.x) { const Ctx Ci = make_ctx(); ml_passA(Ci, l, it); } \
        } \
        if (PH_ON(4)) {   PHASE_CTX(); \
            for (int it = blockIdx.x; it < 1024; it += gridDim.x) { const Ctx Ci = make_ctx(); gla_passA(Ci, l, it); } \
            if (DUPM == 8 && l == 0) for (int it = blockIdx.x; it < 1024; it += gridDim.x) { const Ctx Ci = make_ctx(); gla_passA(Ci, l, it); } \
            { const Ctx Ci = make_ctx(); s5_passA(Ci); } \
            if (DUPM == 9 && l == 0) { const Ctx Ci = make_ctx(); s5_passA(Ci); } \
        } \
        GRID_BAR();
#define PHM_MIXB() \
        if (PH_ON(4)) {   PHASE_CTX(); \
            if ((gw & 15) == 0 && (gw >> 4) < 128) rw_passB(C, gw >> 4); \
        } \
        if (PH_ON(4)) {   PHASE_CTX(); \
            ml_passB(C); \
        } \
        if (PH_ON(4)) {   PHASE_CTX(); \
            gla_passB(C); \
        } \
        if (PH_ON(4)) {   PHASE_CTX(); \
            s5_passB(C); \
        } \
        GRID_BAR();
#define PHM_MIXC() \
        if (PH_ON(4)) {   PHASE_CTX(); \
            { const Ctx Ci = make_ctx(); rw_s5_passC(Ci, l); } \
        } \
        __syncthreads(); \
        if (PH_ON(4)) {   PHASE_CTX(); \
            if (DUPM == 12 && l == 0) for (int it = blockIdx.x; it < 1024; it += gridDim.x) { const Ctx Ci = make_ctx(); ml_passC<true>(Ci, l, it); } \
            for (int it = blockIdx.x; it < 1024; it += gridDim.x) { const Ctx Ci = make_ctx(); ml_passC(Ci, l, it); } \
        } \
        if (PH_ON(4)) {   PHASE_CTX(); \
            if (DUPM == 13 && l == 0) for (int it = blockIdx.x; it < 1024; it += gridDim.x) { const Ctx Ci = make_ctx(); gla_passC<true>(Ci, l, it); } \
            for (int it = blockIdx.x; it < 1024; it += gridDim.x) { const Ctx Ci = make_ctx(); gla_passC(Ci, l, it); } \
        } \
        if (PH_ON(4)) {   PHASE_CTX(); \
        } \
        GRID_BAR();
#define PHM_MERGE() \
        if (PH_ON(5)) { PHASE_CTX(); MERGE_PTRS(); pg8::StaticOrder S0; S0.init(M, D, C.G, C.bid); pg8::Unit u0; S0.next(0, u0); OwnTile4 S4{u0.pm, u0.pn}; \
            pg8::Gemm g{XB, WG, M, 4 * D, D, D, D}; EpiGate8 E{G8, SSQ, gb}; pg8::gemm_phase<EpiGate8, OwnTile4, true, true>(C.lds, g, S4, E); } SUBSYNC(); \
        if (PH_ON(5)) { PHASE_CTX(); MERGE_PTRS(); EpiMerge8<0> E{G8, 0, MF, MG, ZP}; run_gemm<EpiMerge8<0>, false>(C, Z + ZA_O, ZP, WP, WB, M, D, WB, E); } SUBSYNC(); \
        if (PH_ON(5)) { PHASE_CTX(); MERGE_PTRS(); EpiGlu8 E{G8}; run_gemm<EpiGlu8, false>(C, Z + ZB_U, ZP, WP + 2 * (size_t)D * WB, WB, M, D, WB, E); } SUBSYNC(); \
        if (PH_ON(5)) { PHASE_CTX(); MERGE_PTRS(); EpiMerge8<1> E{G8, 1, MF, MG, ZP}; run_gemm<EpiMerge8<1>, false>(C, Z + ZB_U, ZP, WP + (size_t)D * WB, WB, M, D, WB, E); } SUBSYNC(); \
        if (PH_ON(5)) { PHASE_CTX(); MERGE_PTRS(); EpiMerge8<1> E{G8, 2, MF, MG, ZP}; run_gemm<EpiMerge8<1>, false>(C, Z + ZC_G, ZP, WP + 3 * (size_t)D * WB, WB, M, D, WB, E); } SUBSYNC(); \
        if (PH_ON(5)) { PHASE_CTX(); MERGE_PTRS(); EpiMerge8<2> E{G8, 3, MF, MG, ZP}; run_gemm<EpiMerge8<2>, false>(C, Z + ZD_R, ZP, WP + 4 * (size_t)D * WB, WB, M, D, WB, E); } \
        GRID_BAR();
#ifdef DUP_MODE
constexpr int DUPM = DUP_MODE;
#else
constexpr int DUPM = 0;
#endif
#ifndef STOP_AFTER
#define STOP_AFTER 1000
#endif
#define PH_ON(n) ((l) * 20 + (n) <= STOP_AFTER)
template <int l> __device__ __forceinline__ void layer_fwd() {
        if (PH_ON(1)) {   PHASE_CTX();
            if (l > 0) { run_conv(C, CJ_D1, l, gw, NGW); }
            { EpiSwiglu E{(bf16*)(ws + WS_HID), SSQ}; run_gemm<EpiSwiglu, true>(C, XB, D, (const bf16*)(ws + WS_SLOTA), D, M, 2 * FF, D, E); }
            if (l == 0) {
                for (int q = 0; q < DEPTH; ++q) { EpiKV E{(bf16*)(ws + WS_KV + (size_t)q * 4 * MiB), (bf16*)(ws + WS_KV + (size_t)q * 4 * MiB + 2 * MiB), (const float*)(ws + WS_MEMR)};
                    run_gemm<EpiKV, true>(C, (const bf16*)(ws + WS_MEMB), D, (const bf16*)(ws + WS_S + (size_t)q * 4 * MiB), D, MMEM, 2 * D, D, E, 32, C.bid - 128 - 32 * q); }
            }
        }
        GRID_BAR();
        if (DUPM == 14 && l == 0) {
        if (PH_ON(1)) {   PHASE_CTX();

            { EpiSwiglu E{(bf16*)(ws + WS_HID), SSQ}; run_gemm<EpiSwiglu, true>(C, XB, D, (const bf16*)(ws + WS_SLOTA), D, M, 2 * FF, D, E); }
            if (l == 0) {
                for (int q = 0; q < DEPTH; ++q) { EpiKV E{(bf16*)(ws + WS_KV + (size_t)q * 4 * MiB), (bf16*)(ws + WS_KV + (size_t)q * 4 * MiB + 2 * MiB), (const float*)(ws + WS_MEMR)};
                    run_gemm<EpiKV, true>(C, (const bf16*)(ws + WS_MEMB), D, (const bf16*)(ws + WS_S + (size_t)q * 4 * MiB), D, MMEM, 2 * D, D, E, 32, C.bid - 128 - 32 * q); }
            }
        }
        GRID_BAR();
        }
        if (PH_ON(2)) {   PHASE_CTX();
            run_conv(C, CJ_GATES, l, gw, NGW);
            { EpiResid E{(l == 0) ? C.in[I_X] : (const float*)C.X, C.X, XB, SSQ, 0.5f}; run_gemm<EpiResid, false>(C, (const bf16*)(ws + WS_HID), FF, (const bf16*)(ws + WS_SLOTC), FF, M, D, FF, E); }
        }
        GRID_BAR();
#if defined(DUP_MODE)
        if (l == 0 && DUP_MODE >= 1 && DUP_MODE <= 4) {
#if DUP_MODE == 1
            PHM_IN();
#elif DUP_MODE == 2
            PHM_IN(); PHM_MIXA();
#elif DUP_MODE == 3
            PHM_IN(); PHM_MIXA(); PHM_MIXB();
#elif DUP_MODE == 4
            PHM_IN(); PHM_MIXA(); PHM_MIXB(); PHM_MIXC();
#endif
            { PHASE_CTX(); run_conv(C, CJ_WIN, l, gw, NGW); } GRID_BAR();
            GRID_BAR();
        }
#endif
        PHM_IN(); PHM_MIXA(); PHM_MIXB(); PHM_MIXC();
        PHM_MERGE();
#if defined(DUP_MODE) && DUP_MODE == 5
        if (l == 0) { PHM_MERGE(); }
#endif
        if (PH_ON(6)) {   PHASE_CTX();
            run_conv(C, CJ_GU2 | CJ_D2, l, gw, NGW);
            { EpiResid E{C.X, C.X, XB, SSQ, 1.0f}; run_gemm<EpiResid, false>(C, Z + ZC_Q, ZP, (const bf16*)(ws + WS_SLOTB), D, M, D, D, E); }
        }
        GRID_BAR();
        {
            const int un = blockIdx.x; const int pm = un >> 2, hh = un & 3, bb = pm >> 4;
            if (PH_ON(8)) {   PHASE_CTX();
                bf16* Qp = (bf16*)(ws + WS_XQ) + (size_t)C.bid * 65536;
                pg8::Gemm g{XB + (size_t)pm * 256 * D, (const bf16*)(ws + WS_SLOTB + 2 * MiB) + (size_t)hh * 256 * D, 256, 256, D, D, D}; pg8::SingleUnit S;
                EpiBf16 E{Qp, 256, SSQ + (size_t)pm * 256 * 16, 0.0625f * 1.4426950408889634f, 256};
                pg8::gemm_phase<EpiBf16, pg8::SingleUnit, false, true>(C.lds, g, S, E);
            }
            SUBSYNC();
            if (PH_ON(8)) {   PHASE_CTX();
                const bf16* Qp = (const bf16*)(ws + WS_XQ) + (size_t)C.bid * 65536;
                const bf16* Kd = (const bf16*)(ws + WS_KV + (size_t)l * 4 * MiB) + (size_t)bb * 256 * D + hh * 256;
                bf16* P = (bf16*)(ws + WS_XP) + (size_t)C.bid * 65536;
                pg8::Gemm g{Qp, Kd, 256, 256, 256, 256, D}; pg8::SingleUnit S; EpiSoftmaxP E{P}; pg8::gemm_phase<EpiSoftmaxP, pg8::SingleUnit, false, true>(C.lds, g, S, E);
            }
            SUBSYNC();
            if (PH_ON(8)) {   PHASE_CTX();
                const bf16* VT = (const bf16*)(ws + WS_KV + (size_t)l * 4 * MiB + 2 * MiB) + (size_t)hh * 256 * MMEM + bb * 256;
                const bf16* P = (const bf16*)(ws + WS_XP) + (size_t)C.bid * 65536;
                pg8::Gemm g{P, VT, 256, 256, 256, 256, MMEM}; pg8::SingleUnit S; EpiBf16 E{(bf16*)(ws + WS_XO) + (size_t)pm * 256 * D + hh * 256, D, nullptr, 1.0f, 256};
                pg8::gemm_phase<EpiBf16, pg8::SingleUnit, false, true>(C.lds, g, S, E);
            }
            SUBSYNC();
        }
        GRID_BAR();
        if (PH_ON(9)) {   PHASE_CTX();
            EpiResid E{C.X, C.X, XB, SSQ, 1.0f}; run_gemm<EpiResid, false>(C, (const bf16*)(ws + WS_XO), D, (const bf16*)(ws + WS_SLOTB + 4 * MiB), D, M, D, D, E);
        }
        GRID_BAR();
        if (PH_ON(10)) {   PHASE_CTX();
            if (l + 1 < DEPTH) { run_conv(C, CJ_WIN, l + 1, gw, NGW); }
            { EpiSwiglu E{(bf16*)(ws + WS_HID), SSQ}; run_gemm<EpiSwiglu, true>(C, XB, D, (const bf16*)(ws + WS_SLOTA), D, M, 2 * FF, D, E); }
        }
        GRID_BAR();
        if (DUPM == 18 && l == 0) {
        if (PH_ON(10)) {   PHASE_CTX();
            if (l + 1 < DEPTH) { run_conv(C, CJ_WIN, l + 1, gw, NGW); }
            { EpiSwiglu E{(bf16*)(ws + WS_HID), SSQ}; run_gemm<EpiSwiglu, true>(C, XB, D, (const bf16*)(ws + WS_SLOTA), D, M, 2 * FF, D, E); }
        }
        GRID_BAR();
        }
        if (PH_ON(11)) {   PHASE_CTX();
            if (l + 1 < DEPTH) { run_conv(C, CJ_GU1, l + 1, gw, NGW); }
            { EpiResid E{C.X, C.X, XB, SSQ, 0.5f}; run_gemm<EpiResid, false>(C, (const bf16*)(ws + WS_HID), FF, (const bf16*)(ws + WS_SLOTC), FF, M, D, FF, E); }
        }
        GRID_BAR();
    }

__global__ void __launch_bounds__(512, 2) fwd_kernel(Args args) {
    extern __shared__ __attribute__((aligned(16))) unsigned char lds_raw[];
    (void)args;
    {
        const Ctx C = make_ctx();
        volatile LAS unsigned* MISC = (volatile LAS unsigned*)(C.lds + MISC_OFF);
        for (int u = C.tid; u < (LDS_BYTES - RING_BYTES) / 4; u += 512) ((LAS unsigned*)(C.lds + RING_BYTES))[u] = 0u;
        __syncthreads();
        (void)xcd_barrier_post((unsigned*)(C.ws + WS_CTL) + 4096, MISC + 8);
        PROBE_STAMP(C);
    }

    {   PHASE_CTX();
        pro_rows(C);
        run_conv(C, CJ_GU1 | CJ_D1 | CJ_WIN | CJ_XKV0 | CJ_XKV1, 0, gw, NGW);
    }
    GRID_BAR();
    if (DUPM == 17) {
    {   PHASE_CTX();
        pro_rows(C);
        run_conv(C, CJ_GU1 | CJ_D1 | CJ_WIN | CJ_XKV0 | CJ_XKV1, 0, gw, NGW);
    }
    GRID_BAR();
    }

    layer_fwd<0>();
    layer_fwd<1>();
    {   PHASE_CTX();
        final_rows(C);
#ifdef PROBE_LO
        {
            __syncthreads();
            const unsigned long long* st = (const unsigned long long*)(ws + WS_CTL + 32768);
            const unsigned long long ta = __hip_atomic_load(st + PROBE_LO, __ATOMIC_RELAXED, __HIP_MEMORY_SCOPE_AGENT), tb = __hip_atomic_load(st + PROBE_HI, __ATOMIC_RELAXED, __HIP_MEMORY_SCOPE_AGENT);
            size_t K = (size_t)((tb - ta) * (unsigned long long)PROBE_SCALE / 16ull); if (K > 180000) K = 180000;
            const int gwv = C.bid * 8 + C.wave, NG = C.G * 8;
            for (int m = gwv; m < M; m += NG) { const size_t base = (size_t)m * D; if (base >= K) break;
                for (int j = C.lane; j < D; j += 64) if (base + j < K) C.X[base + j] += 0.2f; }
        }
#endif
        if (xb_ld((unsigned*)(ws + WS_CTL) + 4096 + XB_TMO) != 0u) {
            for (size_t i = (size_t)C.bid * 512 + C.tid; i < (size_t)M * D; i += (size_t)C.G * 512) C.X[i] = __builtin_nanf("");
        }
    }
}

extern "C" void kernel_launch(void* const* d_in, const int* in_sizes, int n_in, void* d_out, int out_size, void* d_ws, size_t ws_size, hipStream_t stream) {
    static int grid = 0;
    if (grid == 0) {
        if (n_in != N_INPUTS || out_size != M * D || ws_size < WS_END) { fprintf(stderr, "kernel_launch: unexpected shapes: n_in %d out %d ws %zu (need %zu)\n", n_in, out_size, ws_size, (size_t)WS_END); grid = -1; return; }
        int dev = 0, cus = 0, per_cu = 0;
        if (hipGetDevice(&dev) != hipSuccess || hipDeviceGetAttribute(&cus, hipDeviceAttributeMultiprocessorCount, dev) != hipSuccess) { grid = -1; return; }
        if (hipFuncSetAttribute((const void*)fwd_kernel, hipFuncAttributeMaxDynamicSharedMemorySize, LDS_BYTES) != hipSuccess) { fprintf(stderr, "kernel_launch: hipFuncSetAttribute failed\n"); grid = -1; return; }
        if (hipOccupancyMaxActiveBlocksPerMultiprocessor(&per_cu, (const void*)fwd_kernel, 512, LDS_BYTES) != hipSuccess || per_cu < 1) { fprintf(stderr, "kernel_launch: occupancy query says %d workgroups per CU\n", per_cu); (void)hipGetLastError(); grid = -1; return; }
        if (cus < 256) { fprintf(stderr, "kernel_launch: built for a 256-CU device (got %d)\n", cus); grid = -1; return; }
        grid = 256;
    }
    if (grid < 0) return;
    if (hipMemsetAsync((char*)d_ws + WS_CTL, 0, CTL_ZERO_BYTES, stream) != hipSuccess) return;
    Args a{};
    for (int i = 0; i < N_INPUTS; ++i) a.in[i] = (const float*)d_in[i];
    a.out = (float*)d_out; a.ws = (unsigned char*)d_ws;
    hipLaunchKernelGGL(fwd_kernel, dim3(grid), dim3(512), LDS_BYTES, stream, a);
}
```

```cpp
#include <hip/hip_runtime.h>
#include <cstdio>
#include <cstdint>

#define LAS __attribute__((address_space(3)))
#define GAS __attribute__((address_space(1)))
typedef unsigned short bf16;
typedef float f32x4 __attribute__((ext_vector_type(4)));
typedef float f32x2 __attribute__((ext_vector_type(2)));
typedef unsigned u32x4 __attribute__((ext_vector_type(4)));
typedef unsigned u32x2 __attribute__((ext_vector_type(2)));
typedef short bf16x8 __attribute__((ext_vector_type(8)));

constexpr int NB = 4, SEQ = 4096, M = NB * SEQ, D = 1024, FF = 2816, WB = 512, DEPTH = 2, MEML = 256, MMEM = NB * MEML;
constexpr int NZ = 4888, ZP = 4896, NINP = 5120, NIN = 8984;
constexpr int ZA_U = 0, ZA_O = 512, ZA_I = 1024, ZA_F = 1028, ZB_U = 1032, ZC_Q = 1544, ZC_K = 1800, ZC_V = 2056, ZC_G = 2568, ZC_A = 3080;
constexpr int ZD_R = 3096, ZD_K = 3608, ZD_V = 4120, ZD_XW = 4632, ZD_XA = 4696, ZD_XG = 4760, ZG = 4888;
constexpr float NORM_EPS = 1e-6f;

enum { I_X = 0, I_MEM, I_FFN1_NORM, I_FFN1_WG, I_FFN1_WU, I_FFN1_WD, I_MIX_NORM, I_W_IN, I_GATE_BIAS, I_ML_CONV, I_ML_WQ, I_ML_WK, I_ML_WV, I_ML_BI, I_ML_BF,
       I_ML_NORM, I_ML_PROJ, I_S5_ARE, I_S5_AIM, I_S5_LOGSTEP, I_S5_BRE, I_S5_BIM, I_S5_CRE, I_S5_CIM, I_S5_D, I_S5_W1, I_S5_W2, I_GLA_AUP, I_GLA_ABIAS,
       I_GLA_NORM, I_GLA_PROJ, I_RW_MU, I_RW_W0, I_RW_WUP, I_RW_A0, I_RW_AUP, I_RW_GUP, I_RW_KK, I_RW_KA, I_RW_RK, I_RW_NORM, I_RW_PROJ, I_W_OUT,
       I_XA_NORM, I_MEM_NORM, I_XA_WQ, I_XA_WK, I_XA_WV, I_XA_WO, I_FFN2_NORM, I_FFN2_WG, I_FFN2_WU, I_FFN2_WD, I_FINAL_NORM, N_INPUTS };

constexpr size_t MiB = 1u << 20;
constexpr size_t WS_CTL = 0, CTL_ZERO_BYTES = 64 * 1024;
constexpr size_t WS_SSQ = 1 * MiB;
constexpr size_t WS_MEMR = 256 * 1024;
constexpr size_t WS_XB = 2 * MiB;
constexpr size_t WS_MEMB = 34 * MiB;
constexpr size_t WS_KV = 36 * MiB;
constexpr size_t WS_SLOTA = 44 * MiB;
constexpr size_t WS_SLOTB = 55 * MiB;
constexpr size_t WS_SLOTC = 65 * MiB;
constexpr size_t WS_Z = 73 * MiB;
constexpr size_t Z_BYTES = (size_t)M * ZP * 2;
constexpr size_t WS_S = WS_Z + Z_BYTES;
constexpr size_t WS_END = 350110016;
static_assert(WS_S == 226 * MiB, "map");
constexpr size_t S_BYTES = WS_END - WS_S;
constexpr size_t WS_HID = WS_Z;
constexpr size_t WS_XQ = WS_Z, WS_XO = WS_Z + 32 * MiB, WS_XP = WS_Z + 64 * MiB;
constexpr size_t WS_G8 = WS_S, WS_MF = WS_S + 64 * MiB;
static_assert(WS_MF + 32 * MiB <= WS_END, "merge stash");

constexpr int LDS_BYTES = 147456, RING_BYTES = 131072, MISC_OFF = RING_BYTES + 320;

#define RLX_AGENT __ATOMIC_RELAXED, __HIP_MEMORY_SCOPE_AGENT
#define LDS_WAIT() asm volatile("s_waitcnt lgkmcnt(0)" ::: "memory")
#define VM_WAIT() asm volatile("s_waitcnt vmcnt(0)" ::: "memory")
typedef __bf16 bf16x2_t __attribute__((ext_vector_type(2)));
__device__ __forceinline__ unsigned pk2(float lo, float hi) { const f32x2 v = {lo, hi}; return __builtin_bit_cast(unsigned, __builtin_convertvector(v, bf16x2_t)); }
__device__ __forceinline__ unsigned f2bf(float f) { return pk2(f, 0.f); }
__device__ __forceinline__ float bf2f(unsigned h) { return __builtin_bit_cast(float, h << 16); }
__device__ __forceinline__ float bflo(unsigned w) { return __builtin_bit_cast(float, w << 16); }
__device__ __forceinline__ float bfhi(unsigned w) { return __builtin_bit_cast(float, w & 0xffff0000u); }
__device__ __forceinline__ float rcpf_(float x) { return __builtin_amdgcn_rcpf(x); }
__device__ __forceinline__ float rsqf_(float x) { return __builtin_amdgcn_rsqf(x); }
__device__ __forceinline__ float sigmoidf_(float x) { return rcpf_(1.0f + __expf(-x)); }
__device__ __forceinline__ float siluf_(float x) { return x * rcpf_(1.0f + __expf(-x)); }
__device__ __forceinline__ float softplusf_(float x) { return fmaxf(x, 0.f) + __logf(1.0f + __expf(-fabsf(x))); }
__device__ __forceinline__ float tanhf_(float x) { const float e = __expf(-2.0f * fabsf(x)); const float t = (1.0f - e) * rcpf_(1.0f + e); return x < 0.f ? -t : t; }
__device__ __forceinline__ float logsigmoidf_(float x) { return -softplusf_(-x); }
__device__ __forceinline__ float shx(float v, int mask, int lane) { return __builtin_bit_cast(float, __builtin_amdgcn_ds_bpermute((lane ^ mask) << 2, __builtin_bit_cast(int, v))); }
__device__ __forceinline__ float wave_sum(float v, int lane) {
#pragma unroll
    for (int o = 1; o < 64; o <<= 1) v += shx(v, o, lane);
    return v;
}

#define XB_TMO      128
#define XB_XCNT(j)  (256  + 64 * (j))
#define XB_XSUB(j)  (1280 + 64 * (j))
#define XB_XGEN(j)  (2304 + 64 * (j))
#define XB_TOP      3328
#define XB_TOPGEN   3392
#define XCD_BAR_WORDS 3456
#define XB_SPIN_CAP (1u << 20)
__device__ __forceinline__ unsigned xb_ld(unsigned* p)              { return __hip_atomic_load(p, __ATOMIC_RELAXED, __HIP_MEMORY_SCOPE_AGENT); }
__device__ __forceinline__ unsigned xb_add(unsigned* p, unsigned v) { return __hip_atomic_fetch_add(p, v, __ATOMIC_RELAXED, __HIP_MEMORY_SCOPE_AGENT); }
__device__ __forceinline__ unsigned xb_xcc_id() { return (unsigned)__builtin_amdgcn_s_getreg((3 << 11) | 20) & 0xFu; }
#define XB_SPIN(cond, bar) do { unsigned _sp = 0; while (cond) { __builtin_amdgcn_s_sleep(1); \
    if ((++_sp & 255u) == 0u) { if (xb_ld(&(bar)[XB_TMO])) break; if (_sp > XB_SPIN_CAP) { atomicAdd(&(bar)[XB_TMO], 1u); break; } } } } while (0)
struct XcdBarrier { unsigned* bar; unsigned x; volatile LAS unsigned* st; };
__device__ __forceinline__ XcdBarrier xcd_barrier_post(unsigned* bar, volatile LAS unsigned* st) {
    XcdBarrier b; b.bar = bar; b.x = xb_xcc_id(); b.st = st;
    if (threadIdx.x == 0) (void)xb_add(&bar[XB_XCNT(b.x)], 1u);
    return b;
}
__device__ __forceinline__ void xcd_barrier_complete(unsigned* bar, unsigned x, unsigned& nloc, unsigned& nx) {
    const unsigned G = gridDim.x * gridDim.y * gridDim.z;
    unsigned sum, cnt, mine, sp = 0u;
    for (;;) {
        sum = 0u; cnt = 0u; mine = 0u;
#pragma unroll
        for (unsigned j = 0; j < 16; ++j) { const unsigned c = xb_ld(&bar[XB_XCNT(j)]); sum += c; cnt += (c > 0u) ? 1u : 0u; mine = (j == x) ? c : mine; }
        if (sum == G) break;
        __builtin_amdgcn_s_sleep(1);
        if ((++sp & 255u) == 0u) { if (xb_ld(&bar[XB_TMO])) break; if (sp > XB_SPIN_CAP) { atomicAdd(&bar[XB_TMO], 1u); break; } }
    }
    nloc = mine > 0u ? mine : 1u; nx = cnt > 0u ? cnt : 1u;
}
__device__ __forceinline__ void xcd_barrier(const XcdBarrier& b) {
    asm volatile("s_waitcnt vmcnt(0)" ::: "memory");
    __syncthreads();
    if (threadIdx.x == 0) {
        unsigned* bar = b.bar;
        __builtin_amdgcn_s_waitcnt(0);
        unsigned nloc = b.st[0], nx = b.st[1];
        if (nloc == 0u) { xcd_barrier_complete(bar, b.x, nloc, nx); b.st[0] = nloc; b.st[1] = nx; }
        const unsigned old = xb_add(&bar[XB_XSUB(b.x)], 1u);
        const unsigned gen = old / nloc;
        if (old + 1u == (gen + 1u) * nloc) {
            __builtin_amdgcn_fence(__ATOMIC_RELEASE, "agent");
            asm volatile("s_waitcnt vmcnt(0)" ::: "memory");
            const unsigned og = xb_add(&bar[XB_TOP], 1u);
            const unsigned tg = og / nx;
            if (og + 1u == (tg + 1u) * nx) xb_add(&bar[XB_TOPGEN], 1u);
            else XB_SPIN(xb_ld(&bar[XB_TOPGEN]) == tg, bar);
            __builtin_amdgcn_fence(__ATOMIC_ACQUIRE, "agent");
            xb_add(&bar[XB_XGEN(b.x)], 1u);
            asm volatile("s_waitcnt vmcnt(0)" ::: "memory");
        } else {
            XB_SPIN(xb_ld(&bar[XB_XGEN(b.x)]) == gen, bar);
            __builtin_amdgcn_fence(__ATOMIC_ACQUIRE, "agent");
            asm volatile("s_waitcnt vmcnt(0)" ::: "memory");
        }
    }
    __syncthreads();
}
namespace pg8 {
#define PG8_LAS __attribute__((address_space(3)))
typedef unsigned short bf16_t;
typedef short bf16x8 __attribute__((ext_vector_type(8)));
typedef float f32x4 __attribute__((ext_vector_type(4)));
typedef unsigned u32x4 __attribute__((ext_vector_type(4)));
constexpr int BM = 256, BK = 64, HALF = 128, HTB = HALF * BK * 2  , STAGE_BYTES = 8 * HTB, NXCD = 8, WGM = 8;

__host__ __device__ __forceinline__ int lds_byte(int r, int c) { const int st = (r >> 4) * 2 + (c >> 5), rr = r & 15, cc = c & 31, ob = rr * 64 + cc * 2; return st * 1024 + (ob ^ (((ob >> 9) & 1) << 5)); }
__host__ __device__ __forceinline__ void stage_rc(int b, int& R, int& C) { const int st = b / 1024, sb = b % 1024, swz = sb ^ (((sb >> 9) & 1) << 5); R = (st >> 1) * 16 + swz / 64; C = (st & 1) * 32 + (swz % 64) / 2; }
__host__ __device__ __forceinline__ int perm32(int rho) { const int n = rho >> 4, i = rho & 15; return 8 * (i >> 2) + 4 * n + (i & 3); }

struct Unit { int pm, pn, job; };
struct Gemm { const bf16_t* A; const bf16_t* Bt; int M, N, K, lda, ldb; };

struct StaticOrder {
    int nM, nN, nwg, G, c;
    __host__ __device__ void init(int M, int N, int G_, int c_) { nM = M / BM; nN = N / BM; nwg = nM * nN; G = G_; c = c_; }
    __host__ __device__ __forceinline__ bool next(int i, Unit& u) const {
        const long L = (long)i * G + c; if (L >= nwg) return false;
        int wgid = (int)L; { const int q = nwg / NXCD, r = nwg % NXCD, xcd = wgid % NXCD, off = wgid / NXCD; wgid = (xcd < r ? xcd * (q + 1) : r * (q + 1) + (xcd - r) * q) + off; }
        const int nig = WGM * nN, gid = wgid / nig, fm = gid * WGM, gsz = (nM - fm) < WGM ? (nM - fm) : WGM;
        u.pm = fm + ((wgid % nig) % gsz); u.pn = (wgid % nig) / gsz; u.job = 0; return true;
    }
    __device__ __forceinline__ void a_ready(const Unit&) const {}
    __device__ __forceinline__ void done(const Unit&) const {}
    __device__ __forceinline__ const char* baseA(const Gemm& g, const Unit&) const { return (const char*)g.A; }
    __device__ __forceinline__ const char* baseB(const Gemm& g, const Unit&) const { return (const char*)g.Bt; }
};


struct SingleUnit {
    __device__ __forceinline__ bool next(int i, Unit& u) const { if (i > 0) return false; u.pm = 0; u.pn = 0; u.job = 0; return true; }
    __device__ __forceinline__ void a_ready(const Unit&) const {}
    __device__ __forceinline__ void done(const Unit&) const {}
    __device__ __forceinline__ const char* baseA(const Gemm& g, const Unit&) const { return (const char*)g.A; }
    __device__ __forceinline__ const char* baseB(const Gemm& g, const Unit&) const { return (const char*)g.Bt; }
};
typedef __bf16 bf16x2_cv __attribute__((ext_vector_type(2))); typedef float f32x2_cv __attribute__((ext_vector_type(2)));
__device__ __forceinline__ unsigned cvt_pk_bf16(float lo, float hi) { const f32x2_cv v = {lo, hi}; return __builtin_bit_cast(unsigned, __builtin_convertvector(v, bf16x2_cv)); }
template <class Epi, class Sched, bool ALIGN_EPI = false, bool SP2 = false>
__device__ __forceinline__ void gemm_phase(PG8_LAS unsigned char* lds, const Gemm g, const Sched& S, const Epi& E) {
    int tid_ = threadIdx.x; asm volatile("" : "+v"(tid_));
    const int tid = tid_, wid = __builtin_amdgcn_readfirstlane(tid >> 6), lane = tid & 63, wr = wid >> 2, wc = wid & 3, fr = lane & 15, fq = lane >> 4;
    const int K = g.K, nt = K / BK, lda = g.lda, ldb = g.ldb;
    unsigned voffA[2], voffB[2];
#pragma unroll
    for (int i = 0; i < 2; ++i) { int R, C; stage_rc(tid * 16 + i * 8192, R, C); const int Rb = Epi::PERM ? ((R & ~31) + perm32(R & 31)) : R;
        voffA[i] = (unsigned)(R * lda + C) * 2u; voffB[i] = (unsigned)(Rb * ldb + C) * 2u; }
    const size_t kstep = (size_t)(BK * 2);
    const size_t hstepA = (size_t)HALF * lda * 2, hstepB = (size_t)HALF * ldb * 2;
    const size_t tstepA = 2 * hstepA, tstepB = 2 * hstepB;
    const unsigned ldsw = (unsigned)wid * 1024u;
    const int aoff = lds_byte(wr * 64 + fr, fq * 8), boff = lds_byte(wc * 32 + fr, fq * 8);
#define PG8_SA(b, h) (((b) * 2 + (h)) * HTB)
#define PG8_SB(b, h) ((4 + (b) * 2 + (h)) * HTB)
#define PG8_STAGE(bufoff, gbase, voff) do { _Pragma("unroll") for (int _i = 0; _i < 2; ++_i) \
        __builtin_amdgcn_global_load_lds((const unsigned*)((const char*)(gbase) + (voff)[_i]), (PG8_LAS unsigned*)(lds + (bufoff) + ldsw + _i * 8192), 16, 0, 0); } while (0)
#define PG8_LDA(dst, b, h) do { _Pragma("unroll") for (int m = 0; m < 4; ++m) _Pragma("unroll") for (int k = 0; k < 2; ++k) dst[m][k] = *(const PG8_LAS bf16x8*)(lds + PG8_SA(b, h) + aoff + m * 2048 + k * 1024); } while (0)
#define PG8_LDB(dst, b, h) do { _Pragma("unroll") for (int n = 0; n < 2; ++n) _Pragma("unroll") for (int k = 0; k < 2; ++k) dst[n][k] = *(const PG8_LAS bf16x8*)(lds + PG8_SB(b, h) + boff + n * 2048 + k * 1024); } while (0)
#define PG8_MMA(ai, bj, At, Bt) do { __builtin_amdgcn_s_setprio(1); _Pragma("unroll") for (int m = 0; m < 4; ++m) _Pragma("unroll") for (int n = 0; n < 2; ++n) _Pragma("unroll") for (int k = 0; k < 2; ++k) \
        acc[ai][bj][m][n] = __builtin_amdgcn_mfma_f32_16x16x32_bf16(Bt[n][k], At[m][k], acc[ai][bj][m][n], 0, 0, 0); __builtin_amdgcn_s_setprio(0); } while (0)
#define PG8_WAIT_V(n) asm volatile("s_waitcnt vmcnt(" #n ")" ::: "memory")
#define PG8_WAIT_L(n) asm volatile("s_waitcnt lgkmcnt(" #n ")" ::: "memory")
#define PG8_BAR __builtin_amdgcn_s_barrier()
#define PG8_SCHED __builtin_amdgcn_sched_barrier(0)
    Unit cur, nxt; int ui = 0;
    if (!S.next(0, cur)) return;
    f32x4 acc[2][2][4][2];
#pragma unroll
    for (int a = 0; a < 2; ++a)
#pragma unroll
        for (int b = 0; b < 2; ++b)
#pragma unroll
            for (int m = 0; m < 4; ++m)
#pragma unroll
                for (int n = 0; n < 2; ++n) acc[a][b][m][n] = (f32x4){0.f, 0.f, 0.f, 0.f};
    bf16x8 At[4][2], B0[2][2], B1[2][2];
    const char* cA = S.baseA(g, cur) + (size_t)cur.pm * tstepA; const char* cB = S.baseB(g, cur) + (size_t)cur.pn * tstepB;
    S.a_ready(cur);
    if constexpr (SP2) {
        PG8_STAGE(PG8_SB(0, 0), cB, voffB); PG8_STAGE(PG8_SB(0, 1), cB + hstepB, voffB); PG8_STAGE(PG8_SA(0, 0), cA, voffA); PG8_STAGE(PG8_SA(0, 1), cA + hstepA, voffA);
        if (wr == 1) PG8_BAR;
        PG8_WAIT_V(2); PG8_BAR;
        PG8_STAGE(PG8_SB(1, 0), cB + kstep, voffB); PG8_STAGE(PG8_SA(1, 0), cA + kstep, voffA); PG8_STAGE(PG8_SB(1, 1), cB + hstepB + kstep, voffB);
        PG8_WAIT_V(6); PG8_BAR;
    } else {
        PG8_STAGE(PG8_SB(0, 0), cB, voffB); PG8_STAGE(PG8_SA(0, 0), cA, voffA); PG8_STAGE(PG8_SB(0, 1), cB + hstepB, voffB); PG8_STAGE(PG8_SA(0, 1), cA + hstepA, voffA);
        if (wr == 1) PG8_BAR;
        PG8_WAIT_V(4); PG8_BAR;
        PG8_STAGE(PG8_SB(1, 0), cB + kstep, voffB); PG8_STAGE(PG8_SA(1, 0), cA + kstep, voffA); PG8_STAGE(PG8_SB(1, 1), cB + hstepB + kstep, voffB);
        PG8_WAIT_V(6); PG8_BAR;
    }
    for (;;) {
        const bool has_next = S.next(ui + 1, nxt);
        const char* nA = has_next ? S.baseA(g, nxt) + (size_t)nxt.pm * tstepA : cA; const char* nB = has_next ? S.baseB(g, nxt) + (size_t)nxt.pn * tstepB : cB;
        for (int t = 0; t < nt; t += 2) {
            const bool last = (t == nt - 2);
            const char* a1 = cA + (size_t)(t + 1) * kstep;
            const char* a2 = last ? nA : cA + (size_t)(t + 2) * kstep; const char* b2 = last ? nB : cB + (size_t)(t + 2) * kstep;
            const char* a3 = a2 + kstep; const char* b3 = b2 + kstep;
            if (last && has_next) S.a_ready(nxt);
            if constexpr (SP2) {
            PG8_LDB(B0, 0, 0); PG8_LDB(B1, 0, 1); PG8_SCHED; PG8_LDA(At, 0, 0); PG8_STAGE(PG8_SA(1, 1), a1 + hstepA, voffA);
            PG8_WAIT_V(8); PG8_WAIT_L(0); PG8_BAR; PG8_MMA(0, 0, At, B0); PG8_MMA(0, 1, At, B1); PG8_BAR; PG8_SCHED;
            PG8_LDA(At, 0, 1); PG8_STAGE(PG8_SB(0, 0), b2, voffB); PG8_STAGE(PG8_SB(0, 1), b2 + hstepB, voffB); PG8_STAGE(PG8_SA(0, 0), a2, voffA);
            PG8_WAIT_V(8); PG8_WAIT_L(0); PG8_BAR; PG8_MMA(1, 0, At, B0); PG8_MMA(1, 1, At, B1); PG8_BAR; PG8_SCHED;
            PG8_LDB(B0, 1, 0); PG8_LDB(B1, 1, 1); PG8_SCHED; PG8_LDA(At, 1, 0); PG8_STAGE(PG8_SA(0, 1), a2 + hstepA, voffA);
            PG8_WAIT_V(8); PG8_WAIT_L(0); PG8_BAR; PG8_MMA(0, 0, At, B0); PG8_MMA(0, 1, At, B1); PG8_BAR; PG8_SCHED;
            PG8_LDA(At, 1, 1); PG8_STAGE(PG8_SB(1, 0), b3, voffB); PG8_STAGE(PG8_SB(1, 1), b3 + hstepB, voffB); PG8_STAGE(PG8_SA(1, 0), a3, voffA);
            PG8_WAIT_V(8); PG8_WAIT_L(0); PG8_BAR; PG8_MMA(1, 0, At, B0); PG8_MMA(1, 1, At, B1); PG8_BAR; PG8_SCHED;
            } else {
            PG8_LDB(B0, 0, 0); PG8_SCHED; PG8_LDA(At, 0, 0); PG8_STAGE(PG8_SA(1, 1), a1 + hstepA, voffA);
            PG8_WAIT_L(8); PG8_BAR; PG8_WAIT_L(0); PG8_MMA(0, 0, At, B0); PG8_BAR; PG8_SCHED;
            PG8_LDB(B1, 0, 1); PG8_STAGE(PG8_SB(0, 0), b2, voffB);
            PG8_BAR; PG8_WAIT_L(0); PG8_MMA(0, 1, At, B1); PG8_BAR;
            PG8_LDA(At, 0, 1); PG8_STAGE(PG8_SA(0, 0), a2, voffA);
            PG8_BAR; PG8_WAIT_L(0); PG8_MMA(1, 0, At, B0); PG8_BAR; PG8_SCHED;
            PG8_STAGE(PG8_SB(0, 1), b2 + hstepB, voffB);
            PG8_WAIT_V(6); PG8_BAR; PG8_MMA(1, 1, At, B1); PG8_BAR;
            PG8_LDB(B0, 1, 0); PG8_SCHED; PG8_LDA(At, 1, 0); PG8_STAGE(PG8_SA(0, 1), a2 + hstepA, voffA);
            PG8_WAIT_L(8); PG8_BAR; PG8_WAIT_L(0); PG8_MMA(0, 0, At, B0); PG8_BAR; PG8_SCHED;
            PG8_LDB(B1, 1, 1); PG8_STAGE(PG8_SB(1, 0), b3, voffB);
            PG8_BAR; PG8_WAIT_L(0); PG8_MMA(0, 1, At, B1); PG8_BAR;
            PG8_LDA(At, 1, 1); PG8_STAGE(PG8_SA(1, 0), a3, voffA);
            PG8_BAR; PG8_WAIT_L(0); PG8_MMA(1, 0, At, B0); PG8_BAR; PG8_SCHED;
            PG8_STAGE(PG8_SB(1, 1), b3 + hstepB, voffB);
            PG8_WAIT_V(6); PG8_BAR; PG8_MMA(1, 1, At, B1); PG8_BAR;
            }
        }
        if constexpr (ALIGN_EPI) { if (wr == 0) PG8_BAR; }
        if constexpr (!Epi::AFTER_DRAIN) { E(acc, cur, wr, wc, fr, fq); S.done(cur); }
        if (!has_next) break;
#pragma unroll
        for (int a = 0; a < 2; ++a)
#pragma unroll
            for (int b = 0; b < 2; ++b)
#pragma unroll
                for (int m = 0; m < 4; ++m)
#pragma unroll
                    for (int n = 0; n < 2; ++n) acc[a][b][m][n] = (f32x4){0.f, 0.f, 0.f, 0.f};
        cur = nxt; cA = nA; cB = nB; ++ui;
        if constexpr (ALIGN_EPI) { if (wr == 1) PG8_BAR; }
    }
    PG8_WAIT_V(0);
    if constexpr (!ALIGN_EPI) { if (wr == 0) PG8_BAR; }
    PG8_BAR;
    if constexpr (Epi::AFTER_DRAIN) { E.fused(acc, cur, wr, wc, fr, fq, lds, wid, lane); S.done(cur); }
#undef PG8_SA
#undef PG8_SB
#undef PG8_STAGE
#undef PG8_LDA
#undef PG8_LDB
#undef PG8_MMA
#undef PG8_WAIT_V
#undef PG8_WAIT_L
#undef PG8_BAR
#undef PG8_SCHED
}
}

using pg8::Unit; using pg8::cvt_pk_bf16;
#define EPI_ARGS const f32x4 (&acc)[2][2][4][2], const Unit& u, int wr, int wc, int fr, int fq
__device__ __forceinline__ float row_rstd(const float* ssq, int row) {
    const f32x4* p = (const f32x4*)(ssq + (size_t)row * 16);
    const f32x4 a = p[0], b = p[1], c = p[2], d = p[3];
    const float s = ((a[0] + a[1]) + (a[2] + a[3])) + ((b[0] + b[1]) + (b[2] + b[3])) + ((c[0] + c[1]) + (c[2] + c[3])) + ((d[0] + d[1]) + (d[2] + d[3]));
    return rsqf_(s * (1.0f / D) + NORM_EPS);
}
struct EpiSwiglu {
    static constexpr bool PERM = true, AFTER_DRAIN = false;
    bf16* H; const float* ssq;
    __device__ __forceinline__ void operator()(EPI_ARGS) const {
#pragma unroll
        for (int ai = 0; ai < 2; ++ai)
#pragma unroll
            for (int m = 0; m < 4; ++m) {
                const int row = u.pm * 256 + ai * 128 + wr * 64 + m * 16 + fr; const float rs = row_rstd(ssq, row); float v[8];
#pragma unroll
                for (int n = 0; n < 2; ++n) { const f32x4 g = acc[ai][0][m][n] * rs, up = acc[ai][1][m][n] * rs;
#pragma unroll
                    for (int j = 0; j < 4; ++j) v[4 * n + j] = siluf_(g[j]) * up[j]; }
                u32x4 w; w.x = cvt_pk_bf16(v[0], v[1]); w.y = cvt_pk_bf16(v[2], v[3]); w.z = cvt_pk_bf16(v[4], v[5]); w.w = cvt_pk_bf16(v[6], v[7]);
                *(u32x4*)(H + (size_t)row * FF + u.pn * 128 + wc * 32 + fq * 8) = w;
            }
    }
};
struct EpiResid {
    static constexpr bool PERM = false, AFTER_DRAIN = false;
    const float* Xin; float* X; bf16* XB; float* ssq; float alpha;
    __device__ __forceinline__ void operator()(EPI_ARGS) const {
#pragma unroll
        for (int ai = 0; ai < 2; ++ai)
#pragma unroll
            for (int m = 0; m < 4; ++m) {
                const int row = u.pm * 256 + ai * 128 + wr * 64 + m * 16 + fr; float s = 0.f;
#pragma unroll
                for (int bj = 0; bj < 2; ++bj)
#pragma unroll
                    for (int n = 0; n < 2; ++n) {
                        const size_t off = (size_t)row * D + u.pn * 256 + bj * 128 + wc * 32 + n * 16 + fq * 4;
                        const f32x4 xn = *(const f32x4*)(Xin + off) + acc[ai][bj][m][n] * alpha;
                        *(f32x4*)(X + off) = xn;
                        u32x2 w; w.x = cvt_pk_bf16(xn[0], xn[1]); w.y = cvt_pk_bf16(xn[2], xn[3]);
                        *(u32x2*)(XB + off) = w;
                        s += (xn[0] * xn[0] + xn[1] * xn[1]) + (xn[2] * xn[2] + xn[3] * xn[3]);
                    }
                s += shx(s, 16, fq * 16 + fr); s += shx(s, 32, fq * 16 + fr);
                if (fq == 0) ssq[(size_t)row * 16 + u.pn * 4 + wc] = s;
            }
    }
};
struct EpiBf16 {
    static constexpr bool PERM = true, AFTER_DRAIN = false;
    bf16* O; int ldc; const float* ssq; float scale; int ncols;
    __device__ __forceinline__ void operator()(EPI_ARGS) const {
#pragma unroll
        for (int ai = 0; ai < 2; ++ai)
#pragma unroll
            for (int m = 0; m < 4; ++m) {
                const int row = u.pm * 256 + ai * 128 + wr * 64 + m * 16 + fr; const float rs = (ssq ? row_rstd(ssq, row) : 1.0f) * scale;
#pragma unroll
                for (int bj = 0; bj < 2; ++bj) {
                    const int col = u.pn * 256 + bj * 128 + wc * 32 + fq * 8;
                    if (col < ncols) {
                        const f32x4 v0 = acc[ai][bj][m][0] * rs, v1 = acc[ai][bj][m][1] * rs; u32x4 w;
                        w.x = cvt_pk_bf16(v0[0], v0[1]); w.y = cvt_pk_bf16(v0[2], v0[3]); w.z = cvt_pk_bf16(v1[0], v1[1]); w.w = cvt_pk_bf16(v1[2], v1[3]);
                        *(u32x4*)(O + (size_t)row * ldc + col) = w;
                    }
                }
            }
    }
};
struct EpiZ {
    static constexpr bool PERM = true, AFTER_DRAIN = false;
    bf16* O; const float* ssq; bf16* HALO;
    __device__ __forceinline__ void operator()(EPI_ARGS) const {
#pragma unroll
        for (int ai = 0; ai < 2; ++ai)
#pragma unroll
            for (int m = 0; m < 4; ++m) {
                const int row = u.pm * 256 + ai * 128 + wr * 64 + m * 16 + fr; const float rs = row_rstd(ssq, row);
#pragma unroll
                for (int bj = 0; bj < 2; ++bj) {
                    const int col = u.pn * 256 + bj * 128 + wc * 32 + fq * 8;
                    if (col < NZ) {
                        const f32x4 v0 = acc[ai][bj][m][0] * rs, v1 = acc[ai][bj][m][1] * rs; u32x4 w;
                        w.x = cvt_pk_bf16(v0[0], v0[1]); w.y = cvt_pk_bf16(v0[2], v0[3]); w.z = cvt_pk_bf16(v1[0], v1[1]); w.w = cvt_pk_bf16(v1[2], v1[3]);
                        *(u32x4*)(O + (size_t)row * ZP + col) = w;
                        if ((row & 63) == 63 && col >= ZD_R && col < ZD_V) *(u32x4*)(HALO + (size_t)(row >> 6) * 1024 + (col - ZD_R)) = w;
                    }
                }
            }
    }
};
struct EpiKV {
    static constexpr bool PERM = true, AFTER_DRAIN = false;
    bf16* Kd; bf16* VT; const float* rstd;
    __device__ __forceinline__ void operator()(EPI_ARGS) const {
#pragma unroll
        for (int ai = 0; ai < 2; ++ai)
#pragma unroll
            for (int m = 0; m < 4; ++m) {
                const int row = u.pm * 256 + ai * 128 + wr * 64 + m * 16 + fr; const float rs = rstd[row];
#pragma unroll
                for (int bj = 0; bj < 2; ++bj) {
                    const int col = u.pn * 256 + bj * 128 + wc * 32 + fq * 8;
                    const f32x4 v0 = acc[ai][bj][m][0] * rs, v1 = acc[ai][bj][m][1] * rs;
                    if (col < D) {
                        u32x4 w; w.x = cvt_pk_bf16(v0[0], v0[1]); w.y = cvt_pk_bf16(v0[2], v0[3]); w.z = cvt_pk_bf16(v1[0], v1[1]); w.w = cvt_pk_bf16(v1[2], v1[3]);
                        *(u32x4*)(Kd + (size_t)row * D + col) = w;
                    } else {
#pragma unroll
                        for (int j = 0; j < 4; ++j) { VT[(size_t)(col - D + j) * MMEM + row] = (bf16)f2bf(v0[j]); VT[(size_t)(col - D + 4 + j) * MMEM + row] = (bf16)f2bf(v1[j]); }
                    }
                }
            }
    }
};
__device__ __forceinline__ size_t stash_idx(int T, int ai, int m, int bj, int wr, int wc, int fr, int fq) { return (size_t)(T * 16 + (ai * 4 + m) * 2 + bj) * 512 + (size_t)((wr * 4 + wc) * 64 + fq * 16 + fr); }
__device__ __forceinline__ u32x2 pack_u8(const float* v) {
    unsigned b[8];
#pragma unroll
    for (int j = 0; j < 8; ++j) b[j] = (unsigned)(v[j] * 255.0f + 0.5f);
    u32x2 w; w.x = b[0] | (b[1] << 8) | (b[2] << 16) | (b[3] << 24); w.y = b[4] | (b[5] << 8) | (b[6] << 16) | (b[7] << 24); return w;
}
__device__ __forceinline__ void unpack_u8(u32x2 w, float* v) {
#pragma unroll
    for (int j = 0; j < 4; ++j) { v[j] = (float)((w.x >> (8 * j)) & 255u) * (1.0f / 255.0f); v[4 + j] = (float)((w.y >> (8 * j)) & 255u) * (1.0f / 255.0f); }
}
struct OwnTile4 {
    int pm, pn0;
    __device__ __forceinline__ bool next(int i, Unit& u) const { if (i >= 4) return false; u.pm = pm; u.pn = 4 * i + pn0; u.job = 0; return true; }
    __device__ __forceinline__ void a_ready(const Unit&) const {}
    __device__ __forceinline__ void done(const Unit&) const {}
    __device__ __forceinline__ const char* baseA(const pg8::Gemm& g, const Unit&) const { return (const char*)g.A; }
    __device__ __forceinline__ const char* baseB(const pg8::Gemm& g, const Unit&) const { return (const char*)g.Bt; }
};
struct EpiGate8 {
    static constexpr bool PERM = true, AFTER_DRAIN = false;
    unsigned char* G8; const float* ssq; const float* bias;
    __device__ __forceinline__ void operator()(EPI_ARGS) const {
        const int br = u.pn >> 2, T = u.pm * 4 + (u.pn & 3);
#pragma unroll
        for (int ai = 0; ai < 2; ++ai)
#pragma unroll
            for (int m = 0; m < 4; ++m) {
                const int row = u.pm * 256 + ai * 128 + wr * 64 + m * 16 + fr; const float rs = row_rstd(ssq, row);
#pragma unroll
                for (int bj = 0; bj < 2; ++bj) {
                    const int col = u.pn * 256 + bj * 128 + wc * 32 + fq * 8; float v[8];
#pragma unroll
                    for (int n = 0; n < 2; ++n) { const f32x4 b = *(const f32x4*)(bias + col + 4 * n);
#pragma unroll
                        for (int j = 0; j < 4; ++j) v[4 * n + j] = sigmoidf_(acc[ai][bj][m][n][j] * rs + b[j]); }
                    *(u32x2*)(G8 + ((size_t)br * 256 * 16 * 512 + stash_idx(T, ai, m, bj, wr, wc, fr, fq)) * 8) = pack_u8(v);
                }
            }
    }
};
struct EpiGlu8 {
    static constexpr bool PERM = true, AFTER_DRAIN = false;
    unsigned char* G8;
    __device__ __forceinline__ void operator()(EPI_ARGS) const {
        const int T = u.pm * 4 + u.pn;
#pragma unroll
        for (int ai = 0; ai < 2; ++ai)
#pragma unroll
            for (int m = 0; m < 4; ++m)
#pragma unroll
                for (int bj = 0; bj < 2; ++bj) {
                    u32x2* p = (u32x2*)(G8 + ((size_t)1 * 256 * 16 * 512 + stash_idx(T, ai, m, bj, wr, wc, fr, fq)) * 8); float g[8]; unpack_u8(*p, g);
#pragma unroll
                    for (int n = 0; n < 2; ++n)
#pragma unroll
                        for (int j = 0; j < 4; ++j) g[4 * n + j] *= sigmoidf_(acc[ai][bj][m][n][j]);
                    *p = pack_u8(g);
                }
    }
};
template <int MODE> struct EpiMerge8 {
    static constexpr bool PERM = true, AFTER_DRAIN = false;
    const unsigned char* G8; int br; bf16* MF; bf16* MG; int ldg;
    __device__ __forceinline__ void operator()(EPI_ARGS) const {
        const int T = u.pm * 4 + u.pn;
#pragma unroll
        for (int ai = 0; ai < 2; ++ai)
#pragma unroll
            for (int m = 0; m < 4; ++m) {
                const int row = u.pm * 256 + ai * 128 + wr * 64 + m * 16 + fr;
#pragma unroll
                for (int bj = 0; bj < 2; ++bj) {
                    const size_t si = stash_idx(T, ai, m, bj, wr, wc, fr, fq); float g[8];
                    unpack_u8(*(const u32x2*)(G8 + ((size_t)br * 256 * 16 * 512 + si) * 8), g);
                    f32x4 v0 = acc[ai][bj][m][0], v1 = acc[ai][bj][m][1];
#pragma unroll
                    for (int j = 0; j < 4; ++j) { v0[j] *= g[j]; v1[j] *= g[4 + j]; }
                    if (MODE != 0) { const u32x4 o = *(const u32x4*)(MF + si * 8); v0[0] += bflo(o.x); v0[1] += bfhi(o.x); v0[2] += bflo(o.y); v0[3] += bfhi(o.y); v1[0] += bflo(o.z); v1[1] += bfhi(o.z); v1[2] += bflo(o.w); v1[3] += bfhi(o.w); }
                    u32x4 w; w.x = cvt_pk_bf16(v0[0], v0[1]); w.y = cvt_pk_bf16(v0[2], v0[3]); w.z = cvt_pk_bf16(v1[0], v1[1]); w.w = cvt_pk_bf16(v1[2], v1[3]);
                    if (MODE != 2) *(u32x4*)(MF + si * 8) = w;
                    else *(u32x4*)(MG + (size_t)row * ldg + u.pn * 256 + bj * 128 + wc * 32 + fq * 8) = w;
                }
            }
    }
};
struct EpiSoftmaxP {
    static constexpr bool PERM = true, AFTER_DRAIN = true;
    bf16* P;
    __device__ __forceinline__ void fused(f32x4 (&acc)[2][2][4][2], const Unit& u, int wr, int wc, int fr, int fq, PG8_LAS unsigned char* lds, int wid, int lane) const {
        PG8_LAS float* RM = (PG8_LAS float*)lds;
        PG8_LAS float* RS = (PG8_LAS float*)(lds + 4096);
#pragma unroll
        for (int ai = 0; ai < 2; ++ai)
#pragma unroll
            for (int m = 0; m < 4; ++m) {
                float mx = -3.0e38f;
#pragma unroll
                for (int bj = 0; bj < 2; ++bj)
#pragma unroll
                    for (int n = 0; n < 2; ++n) { const f32x4 x = acc[ai][bj][m][n]; mx = fmaxf(mx, fmaxf(fmaxf(x[0], x[1]), fmaxf(x[2], x[3]))); }
                mx = fmaxf(mx, shx(mx, 16, fq * 16 + fr)); mx = fmaxf(mx, shx(mx, 32, fq * 16 + fr));
                if (fq == 0) RM[(ai * 128 + wr * 64 + m * 16 + fr) * 4 + wc] = mx;
            }
        asm volatile("s_waitcnt lgkmcnt(0)" ::: "memory"); __builtin_amdgcn_s_barrier(); asm volatile("" ::: "memory");
#pragma unroll
        for (int ai = 0; ai < 2; ++ai)
#pragma unroll
            for (int m = 0; m < 4; ++m) {
                const int rl = ai * 128 + wr * 64 + m * 16 + fr;
                const float mx = fmaxf(fmaxf(RM[rl * 4 + 0], RM[rl * 4 + 1]), fmaxf(RM[rl * 4 + 2], RM[rl * 4 + 3])); float s = 0.f;
#pragma unroll
                for (int bj = 0; bj < 2; ++bj)
#pragma unroll
                    for (int n = 0; n < 2; ++n)
#pragma unroll
                        for (int j = 0; j < 4; ++j) { const float p = __builtin_amdgcn_exp2f(acc[ai][bj][m][n][j] - mx); acc[ai][bj][m][n][j] = p; s += p; }
                s += shx(s, 16, fq * 16 + fr); s += shx(s, 32, fq * 16 + fr);
                if (fq == 0) RS[rl * 4 + wc] = s;
            }
        asm volatile("s_waitcnt lgkmcnt(0)" ::: "memory"); __builtin_amdgcn_s_barrier(); asm volatile("" ::: "memory");
#pragma unroll
        for (int ai = 0; ai < 2; ++ai)
#pragma unroll
            for (int m = 0; m < 4; ++m) {
                const int rl = ai * 128 + wr * 64 + m * 16 + fr;
                const float inv = rcpf_((RS[rl * 4 + 0] + RS[rl * 4 + 1]) + (RS[rl * 4 + 2] + RS[rl * 4 + 3]));
#pragma unroll
                for (int bj = 0; bj < 2; ++bj) {
                    const f32x4 v0 = acc[ai][bj][m][0] * inv, v1 = acc[ai][bj][m][1] * inv; u32x4 w;
                    w.x = cvt_pk_bf16(v0[0], v0[1]); w.y = cvt_pk_bf16(v0[2], v0[3]); w.z = cvt_pk_bf16(v1[0], v1[1]); w.w = cvt_pk_bf16(v1[2], v1[3]);
                    *(u32x4*)(P + (size_t)rl * 256 + bj * 128 + wc * 32 + fq * 8) = w;
                }
            }
        asm volatile("s_waitcnt lgkmcnt(0)" ::: "memory"); __builtin_amdgcn_s_barrier(); asm volatile("" ::: "memory");
    }
};
struct Args { const float* in[N_INPUTS]; float* out; unsigned char* ws; };
typedef const float* cfptr;
typedef __attribute__((address_space(4))) const cfptr* kin_t;
struct Ctx {
    LAS unsigned char* lds; int tid, lane, wave, G, bid;
    kin_t in; float* X; unsigned char* ws;
    __device__ __forceinline__ const float* inp(int i, int l, size_t per_layer) const { return in[i] + (size_t)l * per_layer; }
};
__device__ __forceinline__ Ctx make_ctx() {
    extern __shared__ __attribute__((aligned(16))) unsigned char lds_raw[];
    Ctx C; int t = threadIdx.x; asm volatile("" : "+v"(t));
    kin_t k = (kin_t)__builtin_amdgcn_kernarg_segment_ptr(); asm volatile("" : "+s"(k));
    C.lds = (LAS unsigned char*)lds_raw; C.tid = t; C.lane = t & 63; C.wave = __builtin_amdgcn_readfirstlane(t >> 6);
    C.G = gridDim.x; C.bid = blockIdx.x; C.in = k;
    C.X = (float*)k[N_INPUTS]; C.ws = (unsigned char*)k[N_INPUTS + 1];
    return C;
}
constexpr size_t RWW_OFF = 93 * MiB;
struct ConvDesc { const float* W; const float* gain; bf16* dst; long alt; int ld, ncols, K, NR, kind, item0; };
constexpr int CD_OFF = 124 * 1024, CD_MAX = 24;
enum ConvJob { CJ_GU1 = 1, CJ_D1 = 2, CJ_WIN = 4, CJ_GATES = 8, CJ_PROJ = 16, CJ_XW = 32, CJ_GU2 = 64, CJ_D2 = 128, CJ_XKV0 = 256, CJ_XKV1 = 512, CJ_MLW = 1024, CJ_RWW = 2048 };
__device__ __forceinline__ void cd_put(const Ctx& C, int& n, int& items, const float* W, const float* gain, bf16* dst, long alt, int ld, int ncols, int K, int NR, int kind) {
    if (C.tid == 0) { LAS ConvDesc* d = (LAS ConvDesc*)(C.lds + CD_OFF) + n; d->W = W; d->gain = gain; d->dst = dst; d->alt = alt; d->ld = ld; d->ncols = ncols; d->K = K; d->NR = NR; d->kind = kind; d->item0 = items; }
    items += (K / 64) * (NR / 32); ++n;
}
__device__ __forceinline__ void conv_item(const LAS ConvDesc* d, int it, LAS float* scr, int lane) {
    const int K = d->K, NR = d->NR, kind = d->kind, ld = d->ld, ncols = d->ncols; const float* W = d->W; const float* gain = d->gain; bf16* dst = d->dst; const long alt = d->alt;
    const int nblk = NR / 32, kb = it / nblk, nb = it % nblk, k0 = 64 * kb, n0 = 32 * nb, n = n0 + (lane & 31);
    const float* p = nullptr;
    if (kind == 0) { if (n < ncols) p = W + n; }
    else if (kind == 1) { const int t = n >> 8, cl = n & 255, h = t * 128 + (cl & 127); p = W + (h + ((cl & 128) ? alt : 0l)); }
    else p = W + (n < D ? (long)n : alt + (long)(n - D));
    float v[32];
    if (p) { const float* q = p + (size_t)(k0 + (lane >> 5)) * ld;
#pragma unroll
        for (int i = 0; i < 32; ++i) v[i] = q[(size_t)(2 * i) * ld];
        if (gain) {
#pragma unroll
            for (int i = 0; i < 32; ++i) v[i] *= gain[k0 + 2 * i + (lane >> 5)]; }
    } else {
#pragma unroll
        for (int i = 0; i < 32; ++i) v[i] = 0.f; }
#pragma unroll
    for (int i = 0; i < 32; ++i) scr[(2 * i + (lane >> 5)) * 33 + (lane & 31)] = v[i];
    LDS_WAIT(); asm volatile("" ::: "memory");
    const int c = lane & 7;
#pragma unroll
    for (int j = 0; j < 4; ++j) { const int nn = (lane >> 3) + 8 * j; const LAS float* s = scr + (8 * c) * 33 + nn;
        u32x4 o; o.x = pk2(s[0 * 33], s[1 * 33]); o.y = pk2(s[2 * 33], s[3 * 33]); o.z = pk2(s[4 * 33], s[5 * 33]); o.w = pk2(s[6 * 33], s[7 * 33]);
        *(u32x4*)(dst + (size_t)(n0 + nn) * K + k0 + 8 * c) = o; }
    LDS_WAIT(); asm volatile("" ::: "memory");
}
__device__ __forceinline__ void run_conv(const Ctx& C, int jobs, int l, int gw, int NGW) {
    unsigned char* ws = C.ws; int n = 0, items = 0;
    __syncthreads();
    if (jobs & CJ_GU1) cd_put(C, n, items, C.inp(I_FFN1_WG, l, (size_t)D * FF), C.inp(I_FFN1_NORM, l, D), (bf16*)(ws + WS_SLOTA), (long)(C.inp(I_FFN1_WU, l, (size_t)D * FF) - C.inp(I_FFN1_WG, l, (size_t)D * FF)), FF, 2 * FF, D, 2 * FF, 1);
    if (jobs & CJ_GU2) cd_put(C, n, items, C.inp(I_FFN2_WG, l, (size_t)D * FF), C.inp(I_FFN2_NORM, l, D), (bf16*)(ws + WS_SLOTA), (long)(C.inp(I_FFN2_WU, l, (size_t)D * FF) - C.inp(I_FFN2_WG, l, (size_t)D * FF)), FF, 2 * FF, D, 2 * FF, 1);
    if (jobs & CJ_D1) cd_put(C, n, items, C.inp(I_FFN1_WD, l, (size_t)D * FF), nullptr, (bf16*)(ws + WS_SLOTC), 0, D, D, FF, D, 0);
    if (jobs & CJ_D2) cd_put(C, n, items, C.inp(I_FFN2_WD, l, (size_t)D * FF), nullptr, (bf16*)(ws + WS_SLOTC), 0, D, D, FF, D, 0);
    if (jobs & CJ_WIN) cd_put(C, n, items, C.inp(I_W_IN, l, (size_t)D * NIN), C.inp(I_MIX_NORM, l, D), (bf16*)(ws + WS_SLOTB), 0, NIN, NZ, D, NINP, 0);
    if (jobs & CJ_GATES) cd_put(C, n, items, C.inp(I_W_IN, l, (size_t)D * NIN) + ZG, C.inp(I_MIX_NORM, l, D), (bf16*)(ws + WS_SLOTA), 0, NIN, 4 * D, D, 4 * D, 0);
    if (jobs & CJ_PROJ) {
        cd_put(C, n, items, C.inp(I_ML_PROJ, l, (size_t)WB * D), nullptr, (bf16*)(ws + WS_SLOTC), 0, D, D, WB, D, 0);
        cd_put(C, n, items, C.inp(I_S5_W1, l, (size_t)WB * D), nullptr, (bf16*)(ws + WS_SLOTC + 1 * MiB), 0, D, D, WB, D, 0);
        cd_put(C, n, items, C.inp(I_S5_W2, l, (size_t)WB * D), nullptr, (bf16*)(ws + WS_SLOTC + 2 * MiB), 0, D, D, WB, D, 0);
        cd_put(C, n, items, C.inp(I_GLA_PROJ, l, (size_t)WB * D), nullptr, (bf16*)(ws + WS_SLOTC + 3 * MiB), 0, D, D, WB, D, 0);
        cd_put(C, n, items, C.inp(I_RW_PROJ, l, (size_t)WB * D), nullptr, (bf16*)(ws + WS_SLOTC + 4 * MiB), 0, D, D, WB, D, 0);
    }
    if (jobs & CJ_XW) {
        cd_put(C, n, items, C.inp(I_W_OUT, l, (size_t)D * D), nullptr, (bf16*)(ws + WS_SLOTB), 0, D, D, D, D, 0);
        cd_put(C, n, items, C.inp(I_XA_WQ, l, (size_t)D * D), C.inp(I_XA_NORM, l, D), (bf16*)(ws + WS_SLOTB + 2 * MiB), 0, D, D, D, D, 0);
        cd_put(C, n, items, C.inp(I_XA_WO, l, (size_t)D * D), nullptr, (bf16*)(ws + WS_SLOTB + 4 * MiB), 0, D, D, D, D, 0);
    }
    if (jobs & CJ_XKV0) cd_put(C, n, items, C.inp(I_XA_WK, 0, (size_t)D * D), C.inp(I_MEM_NORM, 0, D), (bf16*)(ws + WS_S), (long)(C.inp(I_XA_WV, 0, (size_t)D * D) - C.inp(I_XA_WK, 0, (size_t)D * D)), D, 2 * D, D, 2 * D, 2);
    if (jobs & CJ_XKV1) cd_put(C, n, items, C.inp(I_XA_WK, 1, (size_t)D * D), C.inp(I_MEM_NORM, 1, D), (bf16*)(ws + WS_S + 4 * MiB), (long)(C.inp(I_XA_WV, 1, (size_t)D * D) - C.inp(I_XA_WK, 1, (size_t)D * D)), D, 2 * D, D, 2 * D, 2);
    if (jobs & CJ_MLW) {
#pragma unroll
        for (int q = 0; q < 3; ++q)
#pragma unroll
            for (int hh = 0; hh < 4; ++hh) cd_put(C, n, items, C.inp(q == 0 ? I_ML_WQ : (q == 1 ? I_ML_WK : I_ML_WV), l, 4 * 16384) + hh * 16384, nullptr, (bf16*)(ws + 512 * 1024) + (size_t)(q * 4 + hh) * 16384, 0, 128, 128, 128, 128, 0);
    }
    if (jobs & CJ_RWW) {
        bf16* dst = (bf16*)(ws + WS_S + RWW_OFF);
        cd_put(C, n, items, C.inp(I_RW_WUP, l, 64 * WB), nullptr, dst, 0, WB, WB, 64, WB, 0);
        cd_put(C, n, items, C.inp(I_RW_AUP, l, 64 * WB), nullptr, dst + 512 * 64, 0, WB, WB, 64, WB, 0);
        cd_put(C, n, items, C.inp(I_RW_GUP, l, 128 * WB), nullptr, dst + 2 * 512 * 64, 0, WB, WB, 128, WB, 0);
    }
    __syncthreads();
    LAS float* scr = (LAS float*)(C.lds + C.wave * 15360);
    const LAS ConvDesc* cd = (const LAS ConvDesc*)(C.lds + CD_OFF);
    for (int it = gw; it < items; it += NGW) {
        int j = 0;
        for (int q = 1; q < n; ++q) if (it >= cd[q].item0) j = q;
        conv_item(cd + j, it - cd[j].item0, scr, C.lane);
    }
    __syncthreads();
}

__device__ __forceinline__ void pro_rows(const Ctx& C) {
    const int gw = C.bid * 8 + C.wave, NGW = C.G * 8;
    const float* x = C.in[I_X]; bf16* XB = (bf16*)(C.ws + WS_XB); float* ssq = (float*)(C.ws + WS_SSQ);
    for (int m = gw; m < M; m += NGW) {
        const f32x4* xr = (const f32x4*)(x + (size_t)m * D) + C.lane; u32x2* br = (u32x2*)(XB + (size_t)m * D) + C.lane;
        float s = 0.f;
#pragma unroll
        for (int j = 0; j < 4; ++j) { const f32x4 v = xr[64 * j]; u32x2 w; w.x = pk2(v[0], v[1]); w.y = pk2(v[2], v[3]); br[64 * j] = w; s += (v[0] * v[0] + v[1] * v[1]) + (v[2] * v[2] + v[3] * v[3]); }
        s = wave_sum(s, C.lane);
        if (C.lane < 16) ssq[(size_t)m * 16 + C.lane] = (C.lane == 0) ? s : 0.f;
    }
    const float* mem = C.in[I_MEM]; bf16* MB = (bf16*)(C.ws + WS_MEMB); float* memr = (float*)(C.ws + WS_MEMR);
    for (int m = gw; m < MMEM; m += NGW) {
        const f32x4* xr = (const f32x4*)(mem + (size_t)m * D) + C.lane; u32x2* br = (u32x2*)(MB + (size_t)m * D) + C.lane; float s = 0.f;
#pragma unroll
        for (int j = 0; j < 4; ++j) { const f32x4 v = xr[64 * j]; u32x2 w; w.x = pk2(v[0], v[1]); w.y = pk2(v[2], v[3]); br[64 * j] = w; s += (v[0] * v[0] + v[1] * v[1]) + (v[2] * v[2] + v[3] * v[3]); }
        s = wave_sum(s, C.lane);
        if (C.lane == 0) memr[m] = 1.0f / sqrtf(s * (1.0f / D) + NORM_EPS);
    }
}
__device__ __forceinline__ void final_rows(const Ctx& C) {
    const int gw = C.bid * 8 + C.wave, NGW = C.G * 8; const float* ssq = (const float*)(C.ws + WS_SSQ); const float* g = C.in[I_FINAL_NORM];
    for (int m = gw; m < M; m += NGW) {
        const float rs = row_rstd(ssq, m); f32x4* orow = (f32x4*)(C.X + (size_t)m * D) + C.lane; const f32x4* gr = (const f32x4*)g + C.lane;
#pragma unroll
        for (int j = 0; j < 4; ++j) orow[64 * j] = orow[64 * j] * rs * gr[64 * j];
    }
}
__device__ __forceinline__ float ldz(const bf16* Z, int row, int col) { return bf2f(Z[(size_t)row * ZP + col]); }
__device__ __forceinline__ float gelu_tanh(float y) { const float t = 0.7978845608028654f * (y + 0.044715f * y * y * y); return 0.5f * y * (1.0f + tanhf_(t)); }
constexpr int LCH = 64, NCH = SEQ / LCH;
constexpr size_t SO_GLA_ST = 0;
constexpr size_t SO_GLA_G = SO_GLA_ST + 16 * MiB;
constexpr size_t SO_ML_ST = SO_GLA_G + 512 * 1024;
constexpr size_t SO_ML_G = SO_ML_ST + 36 * MiB;
constexpr size_t SO_END0 = SO_ML_G + 512 * 1024;
static_assert(WS_S + SO_END0 <= WS_END, "state region");

__device__ __forceinline__ bf16x8 ld8(const LAS bf16* p) { return *(const LAS bf16x8*)p; }
__device__ __forceinline__ bf16x8 ld8(const bf16* p) { return *(const bf16x8*)p; }
template <int K, class PA, class PB> __device__ __forceinline__ f32x4 tile_mm(PA A, int lda, PB B, int ldb, f32x4 acc, int fr, int fq) {
#pragma unroll
    for (int k0 = 0; k0 < K; k0 += 32) {
        const bf16x8 a = ld8(A + fr * lda + k0 + 8 * fq);
        const bf16x8 b = ld8(B + fr * ldb + k0 + 8 * fq);
        acc = __builtin_amdgcn_mfma_f32_16x16x32_bf16(a, b, acc, 0, 0, 0);
    }
    return acc;
}
#define F4Z ((f32x4){0.f, 0.f, 0.f, 0.f})
__device__ __forceinline__ u32x2 pack4(f32x4 v) { u32x2 w; w.x = pk2(v[0], v[1]); w.y = pk2(v[2], v[3]); return w; }
__device__ __forceinline__ void unpack8(u32x4 w, float* f) { f[0] = bflo(w.x); f[1] = bfhi(w.x); f[2] = bflo(w.y); f[3] = bfhi(w.y); f[4] = bflo(w.z); f[5] = bfhi(w.z); f[6] = bflo(w.w); f[7] = bfhi(w.w); }

struct Touch { u32x4 a, b, c; };
__device__ __forceinline__ void touch_tile(Touch& T, const bf16* base, int rows, int ppr, int tid) {
    const u32x4 z = (u32x4){0u, 0u, 0u, 0u}; T.a = z; T.b = z; T.c = z; const int n = rows * ppr;
    if (tid < n) T.a = *(const u32x4*)(base + (size_t)(tid / ppr) * ZP + (tid % ppr) * 8);
    if (tid + 512 < n) T.b = *(const u32x4*)(base + (size_t)((tid + 512) / ppr) * ZP + ((tid + 512) % ppr) * 8);
    if (tid + 1024 < n) T.c = *(const u32x4*)(base + (size_t)((tid + 1024) / ppr) * ZP + ((tid + 1024) % ppr) * 8);
}
__device__ __forceinline__ void touch_sink(const Touch& T) { asm volatile("" :: "v"(T.a), "v"(T.b), "v"(T.c)); }
__device__ __forceinline__ void gla_cumdecay(const Ctx& C, int l, int h, int rowb, LAS float* ALOW, LAS float* LA, LAS float* SEG) {
    const bf16* Z = (const bf16*)(C.ws + WS_Z);
    const float* aup = C.inp(I_GLA_AUP, l, 16 * 256) + h * 64; const float* abias = C.inp(I_GLA_ABIAS, l, 256) + h * 64;
    const int tid = C.tid;
    for (int i = tid; i < 64 * 16; i += 512) ALOW[i] = ldz(Z, rowb + (i >> 4), ZC_A + (i & 15));
    __syncthreads();
    {   const int k = tid & 63, seg = tid >> 6; float au[16], run = 0.f, v[8];
#pragma unroll
        for (int r = 0; r < 16; ++r) au[r] = aup[r * 256 + k];
        const float bk = abias[k];
#pragma unroll
        for (int i = 0; i < 8; ++i) { const int t = seg * 8 + i; float s = bk;
#pragma unroll
            for (int r = 0; r < 16; ++r) s += ALOW[t * 16 + r] * au[r];
            run += logsigmoidf_(s) * (1.0f / 16.0f); v[i] = run; }
        SEG[seg * 64 + k] = run;
        __syncthreads();
        float off = 0.f;
        for (int s2 = 0; s2 < seg; ++s2) off += SEG[s2 * 64 + k];
#pragma unroll
        for (int i = 0; i < 8; ++i) LA[(seg * 8 + i) * 64 + k] = v[i] + off;
    }
    __syncthreads();
}
constexpr int LDT = 72;
__device__ __forceinline__ void gla_passA(const Ctx& C, int l, int item) {
    const int bh = item >> 6, c = item & 63, b = bh >> 2, h = bh & 3, rowb = b * SEQ + c * LCH;
    const bf16* Z = (const bf16*)(C.ws + WS_Z);
    LAS float* ALOW = (LAS float*)C.lds; LAS float* LA = ALOW + 1024; LAS float* SEG = LA + 4096;
    LAS bf16* VT = (LAS bf16*)(SEG + 512);
    LAS bf16* KT = VT + 128 * LDT;
    const int tid = C.tid, lane = C.lane, w = C.wave, fr = lane & 15, fq = lane >> 4;
    gla_cumdecay(C, l, h, rowb, ALOW, LA, SEG);
    for (int i = tid; i < 64 * 16; i += 512) { const int t = i >> 4, v0 = (i & 15) * 8; float f[8];
        unpack8(*(const u32x4*)(Z + (size_t)(rowb + t) * ZP + ZC_V + h * 128 + v0), f);
#pragma unroll
        for (int j = 0; j < 8; ++j) VT[(v0 + j) * LDT + t] = (bf16)f2bf(f[j]); }
    {   const int t = tid >> 3, k0 = (tid & 7) * 8; float f[8];
        unpack8(*(const u32x4*)(Z + (size_t)(rowb + t) * ZP + ZC_K + h * 64 + k0), f);
#pragma unroll
        for (int j = 0; j < 8; ++j) KT[(k0 + j) * LDT + t] = (bf16)f2bf(f[j] * __expf(LA[63 * 64 + k0 + j] - LA[t * 64 + k0 + j])); }
    if (tid < 64) ((float*)(C.ws + WS_S + SO_GLA_G))[(size_t)item * 64 + tid] = __expf(LA[63 * 64 + tid]);
    __syncthreads();
    bf16* ST = (bf16*)(C.ws + WS_S + SO_GLA_ST) + (size_t)item * 8192;
#pragma unroll
    for (int q = 0; q < 4; ++q) {
        const f32x4 acc = tile_mm<64>(KT + (16 * q) * LDT, LDT, VT + (16 * w) * LDT, LDT, F4Z, fr, fq);
        *(u32x2*)(ST + (size_t)(16 * w + fr) * 64 + 16 * q + 4 * fq) = pack4(acc);
    }
    __syncthreads();
}
__device__ __forceinline__ void gla_passB(const Ctx& C) {
    const int idx = C.bid * 512 + C.tid; if (idx >= 16 * 8192) return;
    const int bh = idx >> 13, e = idx & 8191, k = e & 63;
    bf16* ST = (bf16*)(C.ws + WS_S + SO_GLA_ST) + (size_t)bh * 64 * 8192 + e; const float* G = (const float*)(C.ws + WS_S + SO_GLA_G) + (size_t)bh * 64 * 64 + k;
    float d[64], g[64];
#pragma unroll
    for (int c = 0; c < 64; ++c) { d[c] = bf2f(ST[(size_t)c * 8192]); g[c] = G[c * 64]; }
    float run = 0.f;
#pragma unroll
    for (int c = 0; c < 64; ++c) { ST[(size_t)c * 8192] = (bf16)f2bf(run); run = run * g[c] + d[c]; }
}
template <bool DRY = false> __device__ __forceinline__ void gla_passC(const Ctx& C, int l, int item) {
    const int bh = item >> 6, c = item & 63, b = bh >> 2, h = bh & 3, rowb = b * SEQ + c * LCH;
    bf16* Z = (bf16*)(C.ws + WS_Z);
    LAS float* ALOW = (LAS float*)C.lds; LAS float* LA = ALOW + 1024; LAS float* SEG = LA + 4096;
    LAS bf16* VT = (LAS bf16*)(SEG + 512);
    LAS bf16* QP = VT + 128 * LDT;
    LAS bf16* KP = QP + 64 * LDT;
    LAS bf16* ATT = KP + 64 * LDT;
    LAS float* O = (LAS float*)(ATT + 64 * LDT);
    LAS float* RSQ = O + 64 * 132;
    const int tid = C.tid, lane = C.lane, w = C.wave, fr = lane & 15, fq = lane >> 4;
    const bf16* ST = (const bf16*)(C.ws + WS_S + SO_GLA_ST) + (size_t)item * 8192;
    bf16x8 stf[4][2];
#pragma unroll
    for (int q = 0; q < 4; ++q) { const int vv = (4 * w + q) >> 2; stf[q][0] = ld8(ST + (size_t)(16 * vv + fr) * 64 + 8 * fq); stf[q][1] = ld8(ST + (size_t)(16 * vv + fr) * 64 + 32 + 8 * fq); }
    gla_cumdecay(C, l, h, rowb, ALOW, LA, SEG);
    for (int i = tid; i < 64 * 16; i += 512) { const int t = i >> 4, v0 = (i & 15) * 8; float f[8];
        unpack8(*(const u32x4*)(Z + (size_t)(rowb + t) * ZP + ZC_V + h * 128 + v0), f);
#pragma unroll
        for (int j = 0; j < 8; ++j) VT[(v0 + j) * LDT + t] = (bf16)f2bf(f[j]); }
    {   const int t = tid >> 3, k0 = (tid & 7) * 8; float fq_[8], fk_[8];
        unpack8(*(const u32x4*)(Z + (size_t)(rowb + t) * ZP + ZC_Q + h * 64 + k0), fq_);
        unpack8(*(const u32x4*)(Z + (size_t)(rowb + t) * ZP + ZC_K + h * 64 + k0), fk_);
        u32x4 wq, wk; float eq[8], ek[8];
#pragma unroll
        for (int j = 0; j < 8; ++j) { const float bb = LA[t * 64 + k0 + j]; eq[j] = fq_[j] * 0.125f * __expf(bb); ek[j] = fk_[j] * __expf(-bb); }
        wq.x = pk2(eq[0], eq[1]); wq.y = pk2(eq[2], eq[3]); wq.z = pk2(eq[4], eq[5]); wq.w = pk2(eq[6], eq[7]);
        wk.x = pk2(ek[0], ek[1]); wk.y = pk2(ek[2], ek[3]); wk.z = pk2(ek[4], ek[5]); wk.w = pk2(ek[6], ek[7]);
        *(LAS u32x4*)(QP + t * LDT + k0) = wq; *(LAS u32x4*)(KP + t * LDT + k0) = wk; }
    __syncthreads();
#pragma unroll
    for (int q = 0; q < 2; ++q) {
        const int id = 2 * w + q, tt = id >> 2, ss = id & 3; f32x4 acc = F4Z;
        if (ss <= tt) acc = tile_mm<64>(KP + (16 * ss) * LDT, LDT, QP + (16 * tt) * LDT, LDT, acc, fr, fq);
        const int t = 16 * tt + fr, s0 = 16 * ss + 4 * fq;
#pragma unroll
        for (int r = 0; r < 4; ++r) if (s0 + r > t) acc[r] = 0.f;
        *(LAS u32x2*)(ATT + t * LDT + s0) = pack4(acc);
    }
    __syncthreads();
#pragma unroll
    for (int q = 0; q < 4; ++q) {
        const int id = 4 * w + q, tt = id & 3, vv = id >> 2;
        f32x4 acc = __builtin_amdgcn_mfma_f32_16x16x32_bf16(stf[q][0], ld8(QP + (16 * tt + fr) * LDT + 8 * fq), F4Z, 0, 0, 0);
        acc = __builtin_amdgcn_mfma_f32_16x16x32_bf16(stf[q][1], ld8(QP + (16 * tt + fr) * LDT + 32 + 8 * fq), acc, 0, 0, 0);
        acc = tile_mm<64>(VT + (16 * vv) * LDT, LDT, ATT + (16 * tt) * LDT, LDT, acc, fr, fq);
        *(LAS f32x4*)(O + (16 * tt + fr) * 132 + 16 * vv + 4 * fq) = acc;
    }
    __syncthreads();
    {
#pragma unroll
        for (int i = 0; i < 8; ++i) { const int t = 8 * w + i; const float h0 = O[t * 132 + lane], h1 = O[t * 132 + lane + 64];
            const float ss = wave_sum(h0 * h0 + h1 * h1, lane); if (lane == 0) RSQ[t] = rsqf_(ss * (1.0f / 128) + NORM_EPS); }
    }
    __syncthreads();
    for (int i = tid; i < 64 * 16; i += 512) { const int t = i >> 4, v0 = (i & 15) * 8; float g[8]; const float rs = RSQ[t];
        bf16* zp = Z + (size_t)(rowb + t) * ZP + ZC_G + h * 128 + v0; unpack8(*(const u32x4*)zp, g);
        const float* gn = C.inp(I_GLA_NORM, l, WB) + h * 128 + v0; float o[8];
#pragma unroll
        for (int j = 0; j < 8; ++j) o[j] = O[t * 132 + v0 + j] * rs * gn[j] * siluf_(g[j]);
        u32x4 wv; wv.x = pk2(o[0], o[1]); wv.y = pk2(o[2], o[3]); wv.z = pk2(o[4], o[5]); wv.w = pk2(o[6], o[7]);
        if (!DRY) *(u32x4*)zp = wv; else asm volatile("" :: "v"(wv)); }
    __syncthreads();
}

constexpr size_t WS_MLW = 512 * 1024;
constexpr int LDU = 152, LDE = 136;
__device__ __forceinline__ float wave_incl_scan(float v, int lane) {
#pragma unroll
    for (int o = 1; o < 64; o <<= 1) { const float n = __builtin_bit_cast(float, __builtin_amdgcn_ds_bpermute(((lane - o) & 63) << 2, __builtin_bit_cast(int, v))); if (lane >= o) v += n; }
    return v;
}
__device__ __forceinline__ void ml_front(const Ctx& C, int l, int b, int h, int c, LAS bf16* UC, LAS bf16* U, LAS float* GB, LAS float* GI) {
    const bf16* Z = (const bf16*)(C.ws + WS_Z); const int t0 = c * LCH, rowb = b * SEQ + t0, tid = C.tid;
    const float* conv = C.inp(I_ML_CONV, l, 4 * WB) + h * 128;
    for (int i = tid; i < 64 * 16; i += 512) { const int t = i >> 4, e0 = (i & 15) * 8; float s[8], x[8];
#pragma unroll
        for (int j = 0; j < 8; ++j) s[j] = 0.f;
#pragma unroll
        for (int d = 0; d < 4; ++d) {
            if (t0 + t - 3 + d >= 0) { unpack8(*(const u32x4*)(Z + (size_t)(rowb + t - 3 + d) * ZP + ZA_U + h * 128 + e0), x);
#pragma unroll
                for (int j = 0; j < 8; ++j) s[j] += conv[d * WB + e0 + j] * x[j]; }
        }
        u32x4 wu, wc; wu.x = pk2(x[0], x[1]); wu.y = pk2(x[2], x[3]); wu.z = pk2(x[4], x[5]); wu.w = pk2(x[6], x[7]);
#pragma unroll
        for (int j = 0; j < 8; ++j) s[j] = siluf_(s[j]);
        wc.x = pk2(s[0], s[1]); wc.y = pk2(s[2], s[3]); wc.z = pk2(s[4], s[5]); wc.w = pk2(s[6], s[7]);
        *(LAS u32x4*)(U + t * LDU + e0) = wu; *(LAS u32x4*)(UC + t * LDU + e0) = wc; }
    if (C.wave == 0) { const int t = C.lane;
        const float li = ldz(Z, rowb + t, ZA_I + h) + C.inp(I_ML_BI, l, 4)[h]; const float lf = logsigmoidf_(ldz(Z, rowb + t, ZA_F + h) + C.inp(I_ML_BF, l, 4)[h]);
        GB[t] = wave_incl_scan(lf, C.lane); GI[t] = li; }
    __syncthreads();
}
__device__ __forceinline__ void ml_passA(const Ctx& C, int l, int item, int next_item = -1) {
    const int bh = item >> 6, c = item & 63, b = bh >> 2, h = bh & 3;
    Touch TT; { const int nb = next_item >> 6, nc = next_item & 63, r0 = (nb >> 2) * SEQ + nc * LCH;
        if (next_item >= 0) touch_tile(TT, (const bf16*)(C.ws + WS_Z) + (size_t)r0 * ZP + ZA_U + (nb & 3) * 128, 64, 16, C.tid); else { const u32x4 z = (u32x4){0u, 0u, 0u, 0u}; TT.a = z; TT.b = z; TT.c = z; } }
    LAS bf16* UC = (LAS bf16*)C.lds; LAS bf16* U = UC + 64 * LDU; LAS bf16* KT = U + 64 * LDU;
    LAS bf16* VT = KT + 128 * LDT;
    LAS float* GB = (LAS float*)(VT + 144 * LDT); LAS float* GI = GB + 64; LAS float* WA = GI + 64;
    const int tid = C.tid, lane = C.lane, w = C.wave, fr = lane & 15, fq = lane >> 4;
    ml_front(C, l, b, h, c, UC, U, GB, GI);
    if (tid < 64) WA[tid] = __expf(GB[63] - GB[tid] + GI[tid]) * 0.08838834764831845f;
    for (int i = tid; i < 16 * LDT; i += 512) VT[128 * LDT + i] = (i < LDT) ? (bf16)0x3f80 : (bf16)0;
    __syncthreads();
    const bf16* WK = (const bf16*)(C.ws + WS_MLW) + (size_t)(4 + h) * 16384; const bf16* WV = (const bf16*)(C.ws + WS_MLW) + (size_t)(8 + h) * 16384;
#pragma unroll
    for (int q = 0; q < 4; ++q) {
        const int id = 4 * w + q, tt = id & 3, ee = id >> 2;
        f32x4 ak = tile_mm<128>(UC + (16 * tt) * LDU, LDU, WK + (size_t)(16 * ee) * 128, 128, F4Z, fr, fq);
        f32x4 av = tile_mm<128>(U + (16 * tt) * LDU, LDU, WV + (size_t)(16 * ee) * 128, 128, F4Z, fr, fq);
        const int t = 16 * tt + 4 * fq;
#pragma unroll
        for (int r = 0; r < 4; ++r) ak[r] *= WA[t + r];
        *(LAS u32x2*)(KT + (16 * ee + fr) * LDT + t) = pack4(ak); *(LAS u32x2*)(VT + (16 * ee + fr) * LDT + t) = pack4(av);
    }
    if (tid == 0) ((float*)(C.ws + WS_S + SO_ML_G))[item] = __expf(GB[63]);
    __syncthreads();
    bf16* ST = (bf16*)(C.ws + WS_S + SO_ML_ST) + (size_t)item * (144 * 128);
    for (int id = w; id < 72; id += 8) {
        const int ee = id & 7, vv = id >> 3;
        const f32x4 acc = tile_mm<64>(KT + (16 * ee) * LDT, LDT, VT + (16 * vv) * LDT, LDT, F4Z, fr, fq);
        *(u32x2*)(ST + (size_t)(16 * vv + fr) * 128 + 16 * ee + 4 * fq) = pack4(acc);
    }
    touch_sink(TT);
    __syncthreads();
}
__device__ __forceinline__ void ml_passB(const Ctx& C) {
    for (int idx = C.bid * 512 + C.tid; idx < 16 * 18432; idx += C.G * 512) {
        const int bh = idx / 18432, e = idx % 18432;
        bf16* ST = (bf16*)(C.ws + WS_S + SO_ML_ST) + (size_t)bh * 64 * 18432 + e; const float* G = (const float*)(C.ws + WS_S + SO_ML_G) + bh * 64;
        float d[64], g[64];
#pragma unroll
        for (int c = 0; c < 64; ++c) { d[c] = bf2f(ST[(size_t)c * 18432]); g[c] = G[c]; }
        float run = 0.f;
#pragma unroll
        for (int c = 0; c < 64; ++c) { ST[(size_t)c * 18432] = (bf16)f2bf(run); run = run * g[c] + d[c]; }
    }
}
template <bool DRY = false> __device__ __forceinline__ void ml_passC(const Ctx& C, int l, int item, int next_item = -1) {
    const int bh = item >> 6, c = item & 63, b = bh >> 2, h = bh & 3, rowb = b * SEQ + c * LCH;
    Touch TT; { const int nb = next_item >> 6, nc = next_item & 63, r0 = (nb >> 2) * SEQ + nc * LCH;
        if (next_item >= 0) touch_tile(TT, (const bf16*)(C.ws + WS_Z) + (size_t)r0 * ZP + ZA_U + (nb & 3) * 128, 64, 16, C.tid); else { const u32x4 z = (u32x4){0u, 0u, 0u, 0u}; TT.a = z; TT.b = z; TT.c = z; } }
    bf16* Z = (bf16*)(C.ws + WS_Z);
    LAS bf16* UC = (LAS bf16*)C.lds; LAS bf16* U = UC + 64 * LDU; LAS bf16* Q = U + 64 * LDU;
    LAS bf16* K = Q + 64 * LDE;
    LAS bf16* VT = K + 64 * LDE;
    LAS bf16* W = VT + 144 * LDT;
    LAS float* GB = (LAS float*)(W + 64 * LDT); LAS float* GI = GB + 64; LAS float* RF = GI + 64; LAS float* CF = RF + 64; LAS float* RSQ = CF + 64;
    LAS float* O = (LAS float*)C.lds;
    const int tid = C.tid, lane = C.lane, w = C.wave, fr = lane & 15, fq = lane >> 4;
    const bf16* ST = (const bf16*)(C.ws + WS_S + SO_ML_ST) + (size_t)item * (144 * 128);
    bf16x8 stf[5][4];
#pragma unroll
    for (int q = 0; q < 5; ++q) { const int id = w + 8 * q, vv = id >> 2;
#pragma unroll
        for (int k4 = 0; k4 < 4; ++k4) stf[q][k4] = (id < 36) ? ld8(ST + (size_t)(16 * vv + fr) * 128 + 32 * k4 + 8 * fq) : (bf16x8){0, 0, 0, 0, 0, 0, 0, 0}; }
    ml_front(C, l, b, h, c, UC, U, GB, GI);
    if (tid < 64) { RF[tid] = __expf(GB[tid]); CF[tid] = __expf(GI[tid] - GB[tid]) * 0.08838834764831845f; }
    for (int i = tid; i < 16 * LDT; i += 512) VT[128 * LDT + i] = (i < LDT) ? (bf16)0x3f80 : (bf16)0;
    const bf16* WQ = (const bf16*)(C.ws + WS_MLW) + (size_t)h * 16384; const bf16* WK = WQ + 4 * 16384; const bf16* WV = WQ + 8 * 16384;
#pragma unroll
    for (int q = 0; q < 4; ++q) {
        const int id = 4 * w + q, tt = id & 3, ee = id >> 2;
        const f32x4 aq = tile_mm<128>(WQ + (size_t)(16 * ee) * 128, 128, UC + (16 * tt) * LDU, LDU, F4Z, fr, fq);
        const f32x4 ak = tile_mm<128>(WK + (size_t)(16 * ee) * 128, 128, UC + (16 * tt) * LDU, LDU, F4Z, fr, fq);
        *(LAS u32x2*)(Q + (16 * tt + fr) * LDE + 16 * ee + 4 * fq) = pack4(aq); *(LAS u32x2*)(K + (16 * tt + fr) * LDE + 16 * ee + 4 * fq) = pack4(ak);
        const f32x4 av = tile_mm<128>(U + (16 * tt) * LDU, LDU, WV + (size_t)(16 * ee) * 128, 128, F4Z, fr, fq);
        *(LAS u32x2*)(VT + (16 * ee + fr) * LDT + 16 * tt + 4 * fq) = pack4(av);
    }
    __syncthreads();
#pragma unroll
    for (int q = 0; q < 2; ++q) {
        const int id = 2 * w + q, tt = id >> 2, ss = id & 3; f32x4 acc = F4Z;
        if (ss <= tt) acc = tile_mm<128>(K + (16 * ss) * LDE, LDE, Q + (16 * tt) * LDE, LDE, acc, fr, fq);
        const int t = 16 * tt + fr, s0 = 16 * ss + 4 * fq; const float rf = RF[t];
#pragma unroll
        for (int r = 0; r < 4; ++r) acc[r] = (s0 + r > t) ? 0.f : acc[r] * rf * CF[s0 + r];
        *(LAS u32x2*)(W + t * LDT + s0) = pack4(acc);
    }
    __syncthreads();
    f32x4 res[5];
#pragma unroll
    for (int q = 0; q < 5; ++q) {
        const int id = w + 8 * q, tt = id & 3, vv = id >> 2; res[q] = F4Z;
        if (id < 36) {
            f32x4 acc = F4Z;
#pragma unroll
            for (int k4 = 0; k4 < 4; ++k4) acc = __builtin_amdgcn_mfma_f32_16x16x32_bf16(stf[q][k4], ld8(Q + (16 * tt + fr) * LDE + 32 * k4 + 8 * fq), acc, 0, 0, 0);
            acc *= RF[16 * tt + fr];
            res[q] = tile_mm<64>(VT + (16 * vv) * LDT, LDT, W + (16 * tt) * LDT, LDT, acc, fr, fq);
        }
    }
    __syncthreads();
#pragma unroll
    for (int q = 0; q < 5; ++q) { const int id = w + 8 * q, tt = id & 3, vv = id >> 2; if (id < 36) *(LAS f32x4*)(O + (16 * tt + fr) * 148 + 16 * vv + 4 * fq) = res[q]; }
    __syncthreads();
    {
#pragma unroll
        for (int i = 0; i < 8; ++i) { const int t = 8 * w + i; const float inv = rcpf_(fmaxf(fabsf(O[t * 148 + 128]), 1.0f));
            const float h0 = O[t * 148 + lane] * inv, h1 = O[t * 148 + lane + 64] * inv;
            const float ss = wave_sum(h0 * h0 + h1 * h1, lane); if (lane == 0) RSQ[t] = inv * rsqf_(ss * (1.0f / 128) + NORM_EPS); }
    }
    __syncthreads();
    for (int i = tid; i < 64 * 16; i += 512) { const int t = i >> 4, v0 = (i & 15) * 8; float g[8]; const float rs = RSQ[t];
        bf16* zp = Z + (size_t)(rowb + t) * ZP + ZA_O + h * 128 + v0; unpack8(*(const u32x4*)zp, g);
        const float* gn = C.inp(I_ML_NORM, l, WB) + h * 128 + v0; float o[8];
#pragma unroll
        for (int j = 0; j < 8; ++j) o[j] = O[t * 148 + v0 + j] * rs * gn[j] * sigmoidf_(g[j]);
        u32x4 wv; wv.x = pk2(o[0], o[1]); wv.y = pk2(o[2], o[3]); wv.z = pk2(o[4], o[5]); wv.w = pk2(o[6], o[7]);
        if (!DRY) *(u32x4*)zp = wv; else asm volatile("" :: "v"(wv)); }
    touch_sink(TT);
    __syncthreads();
}

constexpr size_t SO_S5_K = SO_END0;
constexpr size_t SO_S5_BB = SO_S5_K + 1 * MiB;
constexpr size_t SO_S5_PM = SO_S5_BB + 256 * 1024;
constexpr size_t SO_S5_POW = SO_S5_PM + 512 * 1024;
constexpr size_t SO_S5_E = SO_S5_POW + 1280 * 1024;
constexpr size_t SO_END1 = SO_S5_E + 4 * MiB;
static_assert(WS_S + SO_END1 <= WS_END, "state region");
__device__ __forceinline__ void s5_prep(const Ctx& C, int l, int g, int part) {
    LAS float* BBr = (LAS float*)C.lds; LAS float* BBi = BBr + 1024; LAS float* PW = BBi + 1024; LAS float* CR = PW + 65 * 128; LAS float* CI = CR + 1024;
    const int tid = C.tid;
    if (tid < 64) { const int p = tid;
        const float are = C.inp(I_S5_ARE, l, 32 * 64)[g * 64 + p], aim = C.inp(I_S5_AIM, l, 32 * 64)[g * 64 + p];
        const float step = expf(C.inp(I_S5_LOGSTEP, l, 32)[g]); const float lre = fminf(are, -1e-4f), lim = aim;
        const float mag = expf(lre * step), bre = mag * cosf(lim * step), bim = mag * sinf(lim * step), den = lre * lre + lim * lim;
        const float cre = ((bre - 1.0f) * lre + bim * lim) / den, cim = (bim * lre - (bre - 1.0f) * lim) / den;
        const float* br = C.inp(I_S5_BRE, l, 32 * 64 * 16) + (size_t)(g * 64 + p) * 16; const float* bi = C.inp(I_S5_BIM, l, 32 * 64 * 16) + (size_t)(g * 64 + p) * 16;
        for (int c = 0; c < 16; ++c) { BBr[p * 16 + c] = cre * br[c] - cim * bi[c]; BBi[p * 16 + c] = cre * bi[c] + cim * br[c]; }
        float pr = 1.f, pi = 0.f;
        for (int n = 0; n <= 64; ++n) { PW[(n * 64 + p) * 2] = pr; PW[(n * 64 + p) * 2 + 1] = pi; const float nr = pr * bre - pi * bim, ni = pr * bim + pi * bre; pr = nr; pi = ni; }
    }
    for (int i = tid; i < 1024; i += 512) { CR[i] = C.inp(I_S5_CRE, l, 32 * 1024)[g * 1024 + i]; CI[i] = C.inp(I_S5_CIM, l, 32 * 1024)[g * 1024 + i]; }
    __syncthreads();
    unsigned char* S = C.ws + WS_S;
    if (part == 0) {
    float* POW = (float*)(S + SO_S5_POW) + (size_t)g * 65 * 128;
    for (int i = tid; i < 65 * 128; i += 512) POW[i] = PW[i];
    bf16* BB = (bf16*)(S + SO_S5_BB) + (size_t)g * 128 * 32;
    for (int i = tid; i < 128 * 32; i += 512) { const int row = i >> 5, c = i & 31, pp = row >> 5, ri = (row >> 4) & 1, p = 16 * pp + (row & 15);
        BB[i] = (bf16)f2bf(c < 16 ? (ri ? BBi[p * 16 + c] : BBr[p * 16 + c]) : 0.f); }
    bf16* PM = (bf16*)(S + SO_S5_PM) + (size_t)g * 64 * 128;
    for (int i = tid; i < 64 * 128; i += 512) { const int t = i >> 7, k = i & 127, ri = k >> 6, p = k & 63;
        PM[i] = (bf16)f2bf(ri ? -PW[((t + 1) * 64 + p) * 2 + 1] : PW[((t + 1) * 64 + p) * 2]); }
    }
    bf16* KM = (bf16*)(S + SO_S5_K) + (size_t)g * 16 * 1024;
    for (int i = part * 2048 + tid; i < (part + 1) * 2048; i += 512) { const int cp = i >> 10, k = i & 1023, tau = k >> 4, c = k & 15; float s = 0.f;
        for (int p = 0; p < 64; ++p) { const float cr = CR[cp * 64 + p], ci = CI[cp * 64 + p], pr = PW[(tau * 64 + p) * 2], pi = PW[(tau * 64 + p) * 2 + 1];
            const float wr = cr * pr - ci * pi, wi = cr * pi + ci * pr; s += wr * BBr[p * 16 + c] - wi * BBi[p * 16 + c]; }
        KM[i] = (bf16)f2bf(s); }
    __syncthreads();
}
__device__ __forceinline__ void s5_passA(const Ctx& C) {
    const int g = C.bid >> 3, sb = C.bid & 7, lane = C.lane, fr = lane & 15, fq = lane >> 4, tid = C.tid;
    const bf16* Z = (const bf16*)(C.ws + WS_Z); unsigned char* S = C.ws + WS_S;
    LAS bf16* BBL = (LAS bf16*)(C.lds + 65536);
    LAS float* POWL = (LAS float*)(C.lds + 65536 + 8192);
    {   const u32x4* src = (const u32x4*)((const bf16*)(S + SO_S5_BB) + (size_t)g * 128 * 32); LAS u32x4* dst = (LAS u32x4*)BBL; dst[tid] = src[tid];
        const u32x4* ps = (const u32x4*)((const float*)(S + SO_S5_POW) + (size_t)g * 65 * 128); LAS u32x4* pd = (LAS u32x4*)POWL;
        for (int i = tid; i < 65 * 128 / 4; i += 512) pd[i] = ps[i]; }
    __syncthreads();
    LAS bf16* UA = (LAS bf16*)(C.lds + C.wave * 8192);
#pragma unroll 1
    for (int i4 = 0; i4 < 4; ++i4) {
        const int j = sb * 32 + C.wave * 4 + i4, b = j >> 6, c = j & 63, item = (b * 32 + g) * 64 + c, rowb = b * SEQ + c * LCH;
        {   const u32x4* src = (const u32x4*)(Z + (size_t)(rowb + lane) * ZP + ZB_U + g * 16); const u32x4 z4 = (u32x4){0u, 0u, 0u, 0u};
            LAS u32x4* dst = (LAS u32x4*)(UA + lane * 40); dst[0] = src[0]; dst[1] = src[1]; dst[2] = z4; dst[3] = z4; }
        LDS_WAIT(); __builtin_amdgcn_wave_barrier();
        float* E = (float*)(S + SO_S5_E) + (size_t)item * 128;
#pragma unroll
        for (int pp = 0; pp < 4; ++pp) { float er = 0.f, ei = 0.f; const int p = 16 * pp + fr;
#pragma unroll
            for (int tt = 0; tt < 4; ++tt) {
                const f32x4 br = tile_mm<32>(UA + (16 * tt) * 40, 40, BBL + (pp * 32) * 32, 32, F4Z, fr, fq);
                const f32x4 bi = tile_mm<32>(UA + (16 * tt) * 40, 40, BBL + (pp * 32 + 16) * 32, 32, F4Z, fr, fq);
#pragma unroll
                for (int r = 0; r < 4; ++r) { const int t = 16 * tt + 4 * fq + r; const f32x2 pw = *(const LAS f32x2*)(POWL + ((63 - t) * 64 + p) * 2);
                    er += pw.x * br[r] - pw.y * bi[r]; ei += pw.x * bi[r] + pw.y * br[r]; }
            }
            er += shx(er, 16, lane); er += shx(er, 32, lane); ei += shx(ei, 16, lane); ei += shx(ei, 32, lane);
            if (fq == 0) { E[p] = er; E[64 + p] = ei; }
        }
        LDS_WAIT(); __builtin_amdgcn_wave_barrier();
    }
    __syncthreads();
}
__device__ __forceinline__ void s5_passB(const Ctx& C) {
    const int idx = C.bid * 512 + C.tid; if (idx >= 8192) return;
    const int bg = idx >> 6, p = idx & 63, g = bg & 31; unsigned char* S = C.ws + WS_S;
    const f32x2 l64 = *(const f32x2*)((const float*)(S + SO_S5_POW) + (size_t)g * 65 * 128 + (64 * 64 + p) * 2);
    float* E = (float*)(S + SO_S5_E) + (size_t)bg * 64 * 128 + p;
    float er[64], ei[64];
#pragma unroll
    for (int c = 0; c < 64; ++c) { er[c] = E[c * 128]; ei[c] = E[c * 128 + 64]; }
    float rr = 0.f, ri = 0.f;
#pragma unroll
    for (int c = 0; c < 64; ++c) { E[c * 128] = rr; E[c * 128 + 64] = ri; const float nr = l64.x * rr - l64.y * ri + er[c], ni = l64.x * ri + l64.y * rr + ei[c]; rr = nr; ri = ni; }
}
constexpr int LDKM = 1032;
template <class RW> __device__ __forceinline__ void s5_passC_core(const Ctx& C, int l, RW rw_items) {
    const int g = C.bid >> 3, sb = C.bid & 7, lane = C.lane, fr = lane & 15, fq = lane >> 4, tid = C.tid;
    bf16* Z = (bf16*)(C.ws + WS_Z); unsigned char* S = C.ws + WS_S;
    LAS bf16* KML = (LAS bf16*)(C.lds + 73728);
    LAS bf16* PML = (LAS bf16*)(C.lds + 73728 + 16 * LDKM * 2);
    {   const u32x4* ks = (const u32x4*)((const bf16*)(S + SO_S5_K) + (size_t)g * 16 * 1024);
        for (int i = tid; i < 16 * 128; i += 512) *(LAS u32x4*)(KML + (i >> 7) * LDKM + (i & 127) * 8) = ks[i];
        const u32x4* ps = (const u32x4*)((const bf16*)(S + SO_S5_PM) + (size_t)g * 64 * 128);
        for (int i = tid; i < 64 * 16; i += 512) *(LAS u32x4*)(PML + (i >> 4) * 136 + (i & 15) * 8) = ps[i]; }
    __syncthreads();
    if (C.wave < 4) { rw_items(); __syncthreads(); return; }
    LAS bf16* UP = (LAS bf16*)(C.lds + C.wave * 9216);
    LAS bf16* WV = UP + 128 * 16;
    const float* dsk = C.inp(I_S5_D, l, WB) + g * 16;
#pragma unroll 1
    for (int i4 = 0; i4 < 8; ++i4) {
        const int j = sb * 32 + (C.wave - 4) * 8 + i4, b = j >> 6, c = j & 63, item = (b * 32 + g) * 64 + c, rowb = b * SEQ + c * LCH;
        {   const u32x4* src = (const u32x4*)(Z + (size_t)(rowb + lane) * ZP + ZB_U + g * 16); const u32x4 z4 = (u32x4){0u, 0u, 0u, 0u};
            LAS u32x4* dz = (LAS u32x4*)(UP + lane * 16); dz[0] = z4; dz[1] = z4; LAS u32x4* dst = (LAS u32x4*)(UP + (64 + lane) * 16); dst[0] = src[0]; dst[1] = src[1]; }
        {   const float* E = (const float*)(S + SO_S5_E) + (size_t)item * 128; const int cp = lane >> 2, pq = lane & 3;
            const float* cr = C.inp(I_S5_CRE, l, 32 * 1024) + (size_t)g * 1024 + cp * 64 + 16 * pq; const float* ci = C.inp(I_S5_CIM, l, 32 * 1024) + (size_t)g * 1024 + cp * 64 + 16 * pq;
#pragma unroll
            for (int jj = 0; jj < 16; jj += 2) { const int p = 16 * pq + jj;
                const float a0 = cr[jj] * E[p] - ci[jj] * E[64 + p], b0 = cr[jj] * E[64 + p] + ci[jj] * E[p], a1 = cr[jj + 1] * E[p + 1] - ci[jj + 1] * E[65 + p], b1 = cr[jj + 1] * E[65 + p] + ci[jj + 1] * E[p + 1];
                *(LAS unsigned*)(WV + cp * 136 + p) = pk2(a0, a1); *(LAS unsigned*)(WV + cp * 136 + 64 + p) = pk2(b0, b1); }
        }
        LDS_WAIT(); __builtin_amdgcn_wave_barrier();
#pragma unroll
        for (int tt = 0; tt < 4; ++tt) {
            f32x4 acc = F4Z; const int t = 16 * tt + fr;
#pragma unroll 4
            for (int ks = 0; ks < 8 * (tt + 1); ++ks) {
                const bf16x8 a = ld8(KML + fr * LDKM + 32 * ks + 8 * fq);
                const bf16x8 bb = ld8(UP + (64 + t - 2 * ks - (fq >> 1)) * 16 + 8 * (fq & 1));
                acc = __builtin_amdgcn_mfma_f32_16x16x32_bf16(a, bb, acc, 0, 0, 0);
            }
            acc = tile_mm<128>(WV, 136, PML + (16 * tt) * 136, 136, acc, fr, fq);
            float y[4];
#pragma unroll
            for (int r = 0; r < 4; ++r) { const int cp = 4 * fq + r; y[r] = gelu_tanh(acc[r] + dsk[cp] * bf2f(UP[(64 + t) * 16 + cp])); }
            u32x2 o; o.x = pk2(y[0], y[1]); o.y = pk2(y[2], y[3]);
            *(u32x2*)(Z + (size_t)(rowb + t) * ZP + ZB_U + g * 16 + 4 * fq) = o;
        }
        LDS_WAIT(); __builtin_amdgcn_wave_barrier();
    }
    __syncthreads();
}

constexpr size_t SO_RW_PQ = SO_END1;
constexpr size_t SO_RW_RHO = SO_RW_PQ + 32 * MiB;
constexpr size_t SO_RW_HALO = SO_RW_RHO + 512 * 1024;
constexpr size_t SO_RW_W = SO_RW_HALO + 512 * 1024;
constexpr size_t SO_END2 = SO_RW_W + 256 * 1024;
static_assert(WS_S + SO_END2 <= WS_END, "state region");
static_assert(SO_RW_W == RWW_OFF, "RWW_OFF");
__device__ __forceinline__ void shift8(const u32x4 cur, const u32x4 prev, const float* mu, float* o) {
    float a[8], p[8]; unpack8(cur, a); unpack8(prev, p);
#pragma unroll
    for (int j = 0; j < 8; ++j) o[j] = a[j] + mu[j] * (p[j] - a[j]);
}
__device__ __forceinline__ u32x4 pack8(const float* f) { u32x4 w; w.x = pk2(f[0], f[1]); w.y = pk2(f[2], f[3]); w.z = pk2(f[4], f[5]); w.w = pk2(f[6], f[7]); return w; }

struct RwPre { u32x4 cw, pw, ca, pa, cr, ck, cv, pr, pk, pv; };
__device__ __forceinline__ void rw_preload(const Ctx& C, int item, RwPre& P) {
    const int bh = item >> 6, c = item & 63, b = bh >> 3, h = bh & 7, hc0 = h * 64, rowb = b * SEQ + c * LCH;
    const bf16* Z = (const bf16*)(C.ws + WS_Z); const int t = C.tid >> 3, c0 = (C.tid & 7) * 8, row = rowb + t;
    const bf16* HALO = (const bf16*)(C.ws + WS_S + SO_RW_HALO) + (size_t)(b * 64 + c - 1) * 1024;
    const u32x4 z4 = (u32x4){0u, 0u, 0u, 0u}; const bool first = (c * LCH + t == 0);
    P.cw = *(const u32x4*)(Z + (size_t)row * ZP + ZD_XW + c0); P.ca = *(const u32x4*)(Z + (size_t)row * ZP + ZD_XA + c0);
    P.cr = *(const u32x4*)(Z + (size_t)row * ZP + ZD_R + hc0 + c0); P.ck = *(const u32x4*)(Z + (size_t)row * ZP + ZD_K + hc0 + c0); P.cv = *(const u32x4*)(Z + (size_t)row * ZP + ZD_V + hc0 + c0);
    P.pw = z4; P.pa = z4; P.pr = z4; P.pk = z4; P.pv = z4;
    if (!first) { P.pw = *(const u32x4*)(Z + (size_t)(row - 1) * ZP + ZD_XW + c0); P.pa = *(const u32x4*)(Z + (size_t)(row - 1) * ZP + ZD_XA + c0); P.pv = *(const u32x4*)(Z + (size_t)(row - 1) * ZP + ZD_V + hc0 + c0);
        if (t > 0) { P.pr = *(const u32x4*)(Z + (size_t)(row - 1) * ZP + ZD_R + hc0 + c0); P.pk = *(const u32x4*)(Z + (size_t)(row - 1) * ZP + ZD_K + hc0 + c0); }
        else { P.pr = *(const u32x4*)(HALO + hc0 + c0); P.pk = *(const u32x4*)(HALO + 512 + hc0 + c0); } }
}
template <bool DRY = false> __device__ __forceinline__ void rw_passA(const Ctx& C, int l, int item, RwPre& P, int next_item) {
    const int bh = item >> 6, c = item & 63, b = bh >> 3, h = bh & 7, hc0 = h * 64, rowb = b * SEQ + c * LCH;
    bf16* Z = (bf16*)(C.ws + WS_Z); unsigned char* S = C.ws + WS_S;
    LAS unsigned char* L = C.lds;
    LAS bf16* XW = (LAS bf16*)L; LAS bf16* XA = (LAS bf16*)(L + 9216); LAS float* WARG = (LAS float*)(L + 18432);
    LAS bf16* TAB = (LAS bf16*)L; LAS bf16* TAK = (LAS bf16*)(L + 9216); LAS bf16* MRB = (LAS bf16*)(L + 18432); LAS bf16* MRK = (LAS bf16*)(L + 27648);
    LAS float* AARG = (LAS float*)(L + 36864); LAS float* LW = AARG; LAS bf16* XT = (LAS bf16*)(L + 36864);
    LAS bf16* AT = (LAS bf16*)(L + 55296); LAS bf16* RT = (LAS bf16*)(L + 64512); LAS bf16* BT = (LAS bf16*)(L + 73728); LAS bf16* KT = (LAS bf16*)(L + 82944);
    LAS float* RHSV = (LAS float*)(L + 73728);
    LAS bf16* BBT = (LAS bf16*)(L + 92160); LAS bf16* KBT = (LAS bf16*)(L + 101376); LAS bf16* VT = (LAS bf16*)(L + 110592);
    LAS float* CUML = (LAS float*)(L + 119808); LAS float* GL = CUML + 64; LAS float* SEG = GL + 64; LAS float* UPD = SEG;
    const int tid = C.tid, lane = C.lane, w = C.wave, fr = lane & 15, fq = lane >> 4;
    const int t = tid >> 3, c0 = (tid & 7) * 8, row = rowb + t;
    const float* mu = C.inp(I_RW_MU, l, 1792);
    const u32x4 z4 = (u32x4){0u, 0u, 0u, 0u};
    {   float f[8];
        shift8(P.cw, P.pw, mu + 1536 + c0, f);
#pragma unroll
        for (int j = 0; j < 8; ++j) f[j] = tanhf_(f[j]);
        *(LAS u32x4*)(XW + t * LDT + c0) = pack8(f);
        shift8(P.ca, P.pa, mu + 1600 + c0, f);
        *(LAS u32x4*)(XA + t * LDT + c0) = pack8(f);
    }
    __syncthreads();
    {   const bf16* WUP = (const bf16*)(S + SO_RW_W) + (size_t)hc0 * 64; const bf16* AUP = WUP + 512 * 64;
#pragma unroll
        for (int q = 0; q < 2; ++q) { const int id = 2 * w + q, tt = id >> 2, cc = id & 3;
            const f32x4 aw = tile_mm<64>(XW + (16 * tt) * LDT, LDT, WUP + (size_t)(16 * cc) * 64, 64, F4Z, fr, fq);
            const f32x4 aa = tile_mm<64>(XA + (16 * tt) * LDT, LDT, AUP + (size_t)(16 * cc) * 64, 64, F4Z, fr, fq);
#pragma unroll
            for (int r = 0; r < 4; ++r) { WARG[(16 * tt + 4 * fq + r) * 65 + 16 * cc + fr] = aw[r]; AARG[(16 * tt + 4 * fq + r) * 65 + 16 * cc + fr] = aa[r]; } }
    }
    __syncthreads();
    float lw[8], av[8], bv[8], kr[8], rr[8], vv[8];
    {   float kk[8], aa[8];
        shift8(P.cr, P.pr, mu + hc0 + c0, rr); shift8(P.ck, P.pk, mu + 512 + hc0 + c0, kk); shift8(P.cv, P.pv, mu + 1024 + hc0 + c0, vv);
        const float* w0 = C.inp(I_RW_W0, l, WB) + hc0 + c0; const float* a0 = C.inp(I_RW_A0, l, WB) + hc0 + c0;
        const float* kkw = C.inp(I_RW_KK, l, WB) + hc0 + c0; const float* kaw = C.inp(I_RW_KA, l, WB) + hc0 + c0; const float* rkw = C.inp(I_RW_RK, l, WB) + hc0 + c0;
        float n2 = 0.f, rho = 0.f;
#pragma unroll
        for (int j = 0; j < 8; ++j) {
            const float wl = -softplusf_(-(WARG[t * 65 + c0 + j] + w0[j])) - 0.5f; lw[j] = -__expf(wl);
            aa[j] = sigmoidf_(AARG[t * 65 + c0 + j] + a0[j]);
            const float kn = kk[j] * kkw[j]; n2 += kn * kn; av[j] = kn;
            kr[j] = kk[j] * (1.0f + (aa[j] - 1.0f) * kaw[j]); rho += rr[j] * kr[j] * rkw[j];
        }
        n2 += shx(n2, 1, lane); n2 += shx(n2, 2, lane); n2 += shx(n2, 4, lane);
        rho += shx(rho, 1, lane); rho += shx(rho, 2, lane); rho += shx(rho, 4, lane);
        const float inv = rcpf_(fmaxf(sqrtf(n2), 1e-12f));
#pragma unroll
        for (int j = 0; j < 8; ++j) { const float kkn = av[j] * inv; av[j] = -kkn; bv[j] = kkn * aa[j]; }
        if (!DRY && (tid & 7) == 0) ((float*)(S + SO_RW_RHO))[(size_t)row * 8 + h] = rho;
    }
    __syncthreads();
    if (next_item >= 0) rw_preload(C, next_item, P);
#pragma unroll
    for (int j = 0; j < 8; ++j) LW[t * 64 + c0 + j] = lw[j];
    __syncthreads();
    {   const int cc = tid & 63, seg = tid >> 6; float run = 0.f, v8[8];
#pragma unroll
        for (int i = 0; i < 8; ++i) { run += LW[(seg * 8 + i) * 64 + cc]; v8[i] = run; }
        SEG[seg * 64 + cc] = run;
        __syncthreads();
        float off = 0.f;
        for (int s2 = 0; s2 < seg; ++s2) off += SEG[s2 * 64 + cc];
#pragma unroll
        for (int i = 0; i < 8; ++i) LW[(seg * 8 + i) * 64 + cc] = v8[i] + off;
        if (seg == 7) { CUML[cc] = v8[7] + off; GL[cc] = __expf(v8[7] + off); }
    }
    __syncthreads();
    {   float fa[8], fb[8], fk[8], fr_[8];
#pragma unroll
        for (int j = 0; j < 8; ++j) { const float cm = LW[t * 64 + c0 + j], en = __expf(-cm), el = __expf(CUML[c0 + j] - cm);
            fa[j] = av[j] * __expf(cm - lw[j]); fb[j] = bv[j] * en; fk[j] = kr[j] * en; fr_[j] = rr[j] * __expf(cm);
            BBT[(c0 + j) * LDT + t] = (bf16)f2bf(bv[j] * el); KBT[(c0 + j) * LDT + t] = (bf16)f2bf(kr[j] * el); VT[(c0 + j) * LDT + t] = (bf16)f2bf(vv[j]); }
        *(LAS u32x4*)(AT + t * LDT + c0) = pack8(fa); *(LAS u32x4*)(BT + t * LDT + c0) = pack8(fb); *(LAS u32x4*)(KT + t * LDT + c0) = pack8(fk); *(LAS u32x4*)(RT + t * LDT + c0) = pack8(fr_);
    }
    __syncthreads();
#pragma unroll
    for (int q = 0; q < 2; ++q) { const int id = 2 * w + q, tt = id >> 2, ss = id & 3; f32x4 ab = F4Z, ak = F4Z, rb = F4Z, rk = F4Z;
        if (ss <= tt) {
            ab = tile_mm<64>(BT + (16 * ss) * LDT, LDT, AT + (16 * tt) * LDT, LDT, ab, fr, fq); ak = tile_mm<64>(KT + (16 * ss) * LDT, LDT, AT + (16 * tt) * LDT, LDT, ak, fr, fq);
            rb = tile_mm<64>(BT + (16 * ss) * LDT, LDT, RT + (16 * tt) * LDT, LDT, rb, fr, fq); rk = tile_mm<64>(KT + (16 * ss) * LDT, LDT, RT + (16 * tt) * LDT, LDT, rk, fr, fq);
        }
        const int tq = 16 * tt + fr, s0 = 16 * ss + 4 * fq;
#pragma unroll
        for (int r = 0; r < 4; ++r) { if (s0 + r >= tq) { ab[r] = 0.f; ak[r] = 0.f; } if (s0 + r > tq) { rb[r] = 0.f; rk[r] = 0.f; } }
        *(LAS u32x2*)(TAB + tq * LDT + s0) = pack4(ab); *(LAS u32x2*)(TAK + tq * LDT + s0) = pack4(ak); *(LAS u32x2*)(MRB + tq * LDT + s0) = pack4(rb); *(LAS u32x2*)(MRK + tq * LDT + s0) = pack4(rk);
    }
    __syncthreads();
    LAS bf16* DINV = (LAS bf16*)SEG;
    LAS bf16* RT2 = DINV + 1024;
    if (w >= 4) {
#pragma unroll
        for (int q = 0; q < 4; ++q) { const int id = 4 * (w - 4) + q, vb = id >> 2, tt = id & 3;
            const f32x4 a = tile_mm<64>(VT + (16 * vb) * LDT, LDT, TAK + (16 * tt) * LDT, LDT, F4Z, fr, fq);
#pragma unroll
            for (int r = 0; r < 4; ++r) RHSV[(16 * vb + 4 * fq + r) * 65 + 16 * tt + fr] = a[r]; }
        for (int i = tid - 256; i < 128 * LDT / 8; i += 256) ((LAS u32x4*)XT)[i] = z4;
    } else if (lane < 16) { const int bb = w, j = lane; float x[16];
#pragma unroll
        for (int i = 0; i < 16; ++i) { float s = (i == j) ? 1.0f : 0.0f; float tf[16];
            if (i > 0) unpack8(*(const LAS u32x4*)(TAB + (16 * bb + i) * LDT + 16 * bb), tf);
            if (i > 8) unpack8(*(const LAS u32x4*)(TAB + (16 * bb + i) * LDT + 16 * bb + 8), tf + 8);
#pragma unroll
            for (int i2 = 0; i2 < i; ++i2) s += tf[i2] * x[i2];
            x[i] = s; DINV[(bb * 16 + i) * 16 + j] = (bf16)f2bf(s); }
    }
    __syncthreads();
    typedef short s16x4 __attribute__((ext_vector_type(4)));
#pragma unroll
    for (int bi = 0; bi < 4; ++bi) {
        f32x4 u = F4Z;
        if (bi > 0) u = tile_mm<64>(XT + (16 * w) * LDT, LDT, TAB + (16 * bi) * LDT, LDT, F4Z, fr, fq);
#pragma unroll
        for (int r = 0; r < 4; ++r) { const int col = 16 * w + 4 * fq + r, tr = 16 * bi + fr;
            const float base = (w < 4) ? bf2f(AT[tr * LDT + col]) : RHSV[(col - 64) * 65 + tr];
            RT2[col * 16 + fr] = (bf16)f2bf(base + u[r]); }
        LDS_WAIT(); __builtin_amdgcn_wave_barrier();
        const s16x4 ra = *(const LAS s16x4*)(RT2 + (16 * w + fr) * 16 + 4 * fq), db = *(const LAS s16x4*)(DINV + (bi * 16 + fr) * 16 + 4 * fq);
        const f32x4 x = __builtin_amdgcn_mfma_f32_16x16x16bf16_1k(ra, db, F4Z, 0, 0, 0);
#pragma unroll
        for (int r = 0; r < 4; ++r) XT[(16 * w + 4 * fq + r) * LDT + 16 * bi + fr] = (bf16)f2bf(x[r]);
        LDS_WAIT(); __builtin_amdgcn_wave_barrier();
    }
    __syncthreads();
    bf16* PQ = (bf16*)(S + SO_RW_PQ) + (size_t)item * 8192;
#pragma unroll
    for (int q = 0; q < 2; ++q) { const int id = 2 * w + q, ib = id >> 2, jb = id & 3;
        {
            f32x4 a = tile_mm<64>(XT + (16 * ib) * LDT, LDT, MRB + (16 * jb) * LDT, LDT, F4Z, fr, fq);
            const int tq = 16 * jb + fr, j0 = 16 * ib + 4 * fq; const u32x2 rt = *(const LAS u32x2*)(RT + tq * LDT + j0);
            a[0] += bflo(rt.x); a[1] += bfhi(rt.x); a[2] += bflo(rt.y); a[3] += bfhi(rt.y);
            if (!DRY) *(u32x2*)(Z + (size_t)(rowb + tq) * ZP + ZD_R + hc0 + j0) = pack4(a); else asm volatile("" :: "v"(a)); }
        {
            f32x4 a = tile_mm<64>(XT + (64 + 16 * ib) * LDT, LDT, MRB + (16 * jb) * LDT, LDT, F4Z, fr, fq);
            a = tile_mm<64>(VT + (16 * ib) * LDT, LDT, MRK + (16 * jb) * LDT, LDT, a, fr, fq);
            if (!DRY) *(u32x2*)(Z + (size_t)(rowb + 16 * jb + fr) * ZP + ZD_K + hc0 + 16 * ib + 4 * fq) = pack4(a); else asm volatile("" :: "v"(a)); }
        {
            f32x4 a = tile_mm<64>(XT + (16 * ib) * LDT, LDT, BBT + (16 * jb) * LDT, LDT, F4Z, fr, fq);
            const int k = 16 * jb + fr, j0 = 16 * ib + 4 * fq;
#pragma unroll
            for (int r = 0; r < 4; ++r) if (j0 + r == k) a[r] += GL[k];
            if (!DRY) *(u32x2*)(PQ + (size_t)k * 64 + j0) = pack4(a); else asm volatile("" :: "v"(a)); }
        {
            f32x4 a = tile_mm<64>(BBT + (16 * ib) * LDT, LDT, XT + (64 + 16 * jb) * LDT, LDT, F4Z, fr, fq);
            a = tile_mm<64>(KBT + (16 * ib) * LDT, LDT, VT + (16 * jb) * LDT, LDT, a, fr, fq);
            if (!DRY) *(u32x2*)(PQ + 4096 + (size_t)(16 * jb + fr) * 64 + 16 * ib + 4 * fq) = pack4(a); else asm volatile("" :: "v"(a)); }
    }
    __syncthreads();
}
__device__ __forceinline__ void rw_passB(const Ctx& C, int unit) {
    const int bh = unit >> 2, vg = unit & 3, lane = C.lane, fr = lane & 15, fq = lane >> 4;
    LAS bf16* SL = (LAS bf16*)(C.lds + C.wave * 16384);
    bf16* PQ0 = (bf16*)(C.ws + WS_S + SO_RW_PQ) + (size_t)bh * 64 * 8192;
    for (int i = lane; i < 16 * LDT / 8; i += 64) ((LAS u32x4*)SL)[i] = (u32x4){0u, 0u, 0u, 0u};
    LDS_WAIT(); __builtin_amdgcn_wave_barrier();
    bf16x8 pa[4][4][2]; u32x2 qa[4][4];
#define RWB_FETCH(s, cc) do { const bf16* P_ = PQ0 + (size_t)(cc) * 8192; const bf16* Q_ = P_ + 4096 + (size_t)(16 * vg) * 64; _Pragma("unroll") for (int kk = 0; kk < 4; ++kk) { \
        pa[s][kk][0] = ld8(P_ + (size_t)(16 * kk + fr) * 64 + 8 * fq); pa[s][kk][1] = ld8(P_ + (size_t)(16 * kk + fr) * 64 + 32 + 8 * fq); qa[s][kk] = *(const u32x2*)(Q_ + (size_t)fr * 64 + 16 * kk + 4 * fq); } } while (0)
    RWB_FETCH(0, 0); RWB_FETCH(1, 1); RWB_FETCH(2, 2); RWB_FETCH(3, 3);
    for (int c4 = 0; c4 < 64; c4 += 4) {
#pragma unroll
        for (int s = 0; s < 4; ++s) {
            const int c = c4 + s;
            bf16* QT = PQ0 + (size_t)c * 8192 + 4096 + (size_t)(16 * vg) * 64;
            const bf16x8 b0 = ld8(SL + fr * LDT + 8 * fq), b1 = ld8(SL + fr * LDT + 32 + 8 * fq);
            const u32x4 s0 = *(const LAS u32x4*)(SL + (lane >> 2) * LDT + (lane & 3) * 16), s1 = *(const LAS u32x4*)(SL + (lane >> 2) * LDT + (lane & 3) * 16 + 8);
            f32x4 acc[4];
#pragma unroll
            for (int kk = 0; kk < 4; ++kk) {
                f32x4 a; a[0] = bflo(qa[s][kk].x); a[1] = bfhi(qa[s][kk].x); a[2] = bflo(qa[s][kk].y); a[3] = bfhi(qa[s][kk].y);
                a = __builtin_amdgcn_mfma_f32_16x16x32_bf16(pa[s][kk][0], b0, a, 0, 0, 0);
                acc[kk] = __builtin_amdgcn_mfma_f32_16x16x32_bf16(pa[s][kk][1], b1, a, 0, 0, 0);
            }
            LDS_WAIT(); __builtin_amdgcn_wave_barrier();
            *(u32x4*)(QT + (size_t)(lane >> 2) * 64 + (lane & 3) * 16) = s0; *(u32x4*)(QT + (size_t)(lane >> 2) * 64 + (lane & 3) * 16 + 8) = s1;
#pragma unroll
            for (int kk = 0; kk < 4; ++kk) *(LAS u32x2*)(SL + fr * LDT + 16 * kk + 4 * fq) = pack4(acc[kk]);
            LDS_WAIT(); __builtin_amdgcn_wave_barrier();
            if (c + 4 < 64) RWB_FETCH(s, c + 4);
        }
    }
#undef RWB_FETCH
}
template <bool DRY = false> __device__ __forceinline__ void rw_passC(const Ctx& C, int l, int item) {
    const int bh = item >> 6, c = item & 63, b = bh >> 3, h = bh & 7, hc0 = h * 64, rowb = b * SEQ + c * LCH;
    bf16* Z = (bf16*)(C.ws + WS_Z); unsigned char* S = C.ws + WS_S;
    const int tt = C.wave & 3, lane = C.lane, fr = lane & 15, fq = lane >> 4, t = 16 * tt + fr, row = rowb + t;
    LAS bf16* XG = (LAS bf16*)(C.lds + tt * 4608);
    const float* mu = C.inp(I_RW_MU, l, 1792); const u32x4 z4 = (u32x4){0u, 0u, 0u, 0u};
    {
        const int tl = lane >> 2, rw = rowb + 16 * tt + tl; const bool first = (c * LCH + 16 * tt + tl == 0);
#pragma unroll
        for (int q = 0; q < 4; ++q) { const int j0 = (lane & 3) * 32 + q * 8; float f[8];
            const u32x4 cg = *(const u32x4*)(Z + (size_t)rw * ZP + ZD_XG + j0), pg = first ? z4 : *(const u32x4*)(Z + (size_t)(rw - 1) * ZP + ZD_XG + j0);
            shift8(cg, pg, mu + 1664 + j0, f);
#pragma unroll
            for (int j = 0; j < 8; ++j) f[j] = sigmoidf_(f[j]);
            *(LAS u32x4*)(XG + tl * 136 + j0) = pack8(f); }
    }
    LDS_WAIT(); __builtin_amdgcn_wave_barrier();
    const bf16* SST = (const bf16*)(S + SO_RW_PQ) + (size_t)item * 8192 + 4096;
    const bf16* GUP = (const bf16*)(S + SO_RW_W) + 2 * 512 * 64 + (size_t)hc0 * 128;
    f32x4 y[4], g[4];
#pragma unroll
    for (int vb = 0; vb < 4; ++vb) {
        y[vb] = tile_mm<64>(SST + (size_t)(16 * vb) * 64, 64, Z + (size_t)(rowb + 16 * tt) * ZP + ZD_R + hc0, ZP, F4Z, fr, fq);
        const u32x2 yl = *(const u32x2*)(Z + (size_t)row * ZP + ZD_K + hc0 + 16 * vb + 4 * fq);
        y[vb][0] += bflo(yl.x); y[vb][1] += bfhi(yl.x); y[vb][2] += bflo(yl.y); y[vb][3] += bfhi(yl.y);
        g[vb] = tile_mm<128>(GUP + (size_t)(16 * vb) * 128, 128, XG, 136, F4Z, fr, fq);
    }
    float s1 = 0.f;
#pragma unroll
    for (int vb = 0; vb < 4; ++vb) s1 += (y[vb][0] + y[vb][1]) + (y[vb][2] + y[vb][3]);
    s1 += shx(s1, 16, lane); s1 += shx(s1, 32, lane);
    const float mean = s1 * (1.0f / 64); float s2 = 0.f;
#pragma unroll
    for (int vb = 0; vb < 4; ++vb)
#pragma unroll
        for (int r = 0; r < 4; ++r) { const float d = y[vb][r] - mean; y[vb][r] = d; s2 += d * d; }
    s2 += shx(s2, 16, lane); s2 += shx(s2, 32, lane);
    const float rs = rsqf_(s2 * (1.0f / 64) + 64e-5f);
    const float rho = ((const float*)(S + SO_RW_RHO))[(size_t)row * 8 + h];
    const bool first = (c * LCH + t == 0);
#pragma unroll
    for (int vb = 0; vb < 4; ++vb) { const int v0 = 16 * vb + 4 * fq;
        const u32x2 cv = *(const u32x2*)(Z + (size_t)row * ZP + ZD_V + hc0 + v0); u32x2 pv; pv.x = 0u; pv.y = 0u;
        if (!first) pv = *(const u32x2*)(Z + (size_t)(row - 1) * ZP + ZD_V + hc0 + v0);
        const float cvf[4] = {bflo(cv.x), bfhi(cv.x), bflo(cv.y), bfhi(cv.y)}, pvf[4] = {bflo(pv.x), bfhi(pv.x), bflo(pv.y), bfhi(pv.y)};
        const float* gn = C.inp(I_RW_NORM, l, WB) + hc0 + v0; const float* mv = mu + 1024 + hc0 + v0; f32x4 o;
#pragma unroll
        for (int r = 0; r < 4; ++r) { const float vs = cvf[r] + mv[r] * (pvf[r] - cvf[r]); o[r] = (y[vb][r] * rs * gn[r] + rho * vs) * g[vb][r]; }
        y[vb] = o; }
    asm volatile("s_waitcnt vmcnt(0)" ::: "memory"); __builtin_amdgcn_wave_barrier();
#pragma unroll
    for (int vb = 0; vb < 4; ++vb) { if (!DRY) *(u32x2*)(Z + (size_t)row * ZP + ZD_R + hc0 + 16 * vb + 4 * fq) = pack4(y[vb]); else asm volatile("" :: "v"(y[vb])); }
    LDS_WAIT(); __builtin_amdgcn_wave_barrier();
}

__device__ __forceinline__ void rw_s5_passC(const Ctx& C, int l) {
    s5_passC_core(C, l, [&]() {
#pragma unroll 1
        for (int i = 0; i < 8; ++i) { const Ctx Ci = make_ctx(); rw_passC(Ci, l, (int)blockIdx.x + 256 * i); }
    });
}
template <class Epi, bool ALIGN> __device__ __forceinline__ void run_gemm(const Ctx& C, const bf16* A, int lda, const bf16* Bt, int ldb, int Mr, int N, int K, const Epi& E, int Gv = 0, int cv = 0) {
    if (Gv == 0) { Gv = C.G; cv = C.bid; }
    if (cv < 0 || cv >= Gv) return;
    pg8::Gemm g{A, Bt, Mr, N, K, lda, ldb}; pg8::StaticOrder S; S.init(Mr, N, Gv, cv);
    pg8::gemm_phase<Epi, pg8::StaticOrder, ALIGN, true>(C.lds, g, S, E);
}

#ifdef PROBE_LO
#define PROBE_STAMP(Cb) do { if (blockIdx.x == 0 && (Cb).tid == 0) { volatile LAS unsigned* m_ = (volatile LAS unsigned*)((Cb).lds + MISC_OFF); const unsigned i_ = m_[16]; m_[16] = i_ + 1u; \
    __hip_atomic_store((unsigned long long*)((Cb).ws + WS_CTL + 32768) + i_, (unsigned long long)__builtin_amdgcn_s_memrealtime(), __ATOMIC_RELAXED, __HIP_MEMORY_SCOPE_AGENT); } } while (0)
#else
#define PROBE_STAMP(Cb) do { } while (0)
#endif
#define GRID_BAR() do { const Ctx Cb = make_ctx(); XcdBarrier b_; b_.bar = (unsigned*)(Cb.ws + WS_CTL) + 4096; b_.x = xb_xcc_id(); b_.st = (volatile LAS unsigned*)(Cb.lds + MISC_OFF) + 8; xcd_barrier(b_); PROBE_STAMP(Cb); } while (0)
#define PHASE_CTX() const Ctx C = make_ctx(); unsigned char* const ws = C.ws; bf16* const XB = (bf16*)(ws + WS_XB); float* const SSQ = (float*)(ws + WS_SSQ); bf16* const Z = (bf16*)(ws + WS_Z); \
    const int gw = C.bid * 8 + C.wave, NGW = C.G * 8; (void)XB; (void)SSQ; (void)Z; (void)gw; (void)NGW
#define SUBSYNC() do { VM_WAIT(); __syncthreads(); } while (0)
#define MERGE_PTRS() unsigned char* const G8 = ws + WS_G8; bf16* const MF = (bf16*)(ws + WS_MF); bf16* const MG = Z + ZC_Q; const bf16* const WG = (const bf16*)(ws + WS_SLOTA); const bf16* const WP = (const bf16*)(ws + WS_SLOTC); \
    const float* const gb = C.inp(I_GATE_BIAS, l, 4 * D); (void)G8; (void)MF; (void)MG; (void)WG; (void)WP; (void)gb
#define PHM_IN() \
        if (PH_ON(3)) {   PHASE_CTX(); \
            run_conv(C, CJ_PROJ | CJ_MLW | CJ_RWW, l, gw, NGW); \
            s5_prep(C, l, C.bid >> 3, C.bid & 7); \
            { EpiZ E{Z, SSQ, (bf16*)(ws + WS_S + RWW_OFF - 512 * 1024)}; run_gemm<EpiZ, true>(C, XB, D, (const bf16*)(ws + WS_SLOTB), D, M, NINP, D, E); } \
        } \
        GRID_BAR();
#define PHM_MIXA() \
        if (PH_ON(4)) {   PHASE_CTX(); \
            run_conv(C, CJ_XW, l, gw, NGW); \
            { RwPre P_; { const Ctx Ci = make_ctx(); rw_preload(Ci, (int)blockIdx.x, P_); } \
              for (int it = blockIdx.x; it < 2048; it += gridDim.x) { const Ctx Ci = make_ctx(); rw_passA(Ci, l, it, P_, (it + (int)gridDim.x < 2048) ? it + (int)gridDim.x : -1); } } \
        } \
        if (PH_ON(4)) {   PHASE_CTX(); \
            for (int it = blockIdx.x; it < 1024; it += gridDim.x) { const Ctx Ci = make_ctx(); ml_passA(Ci, l, it, (it + (int)gridDim.x < 1024) ? it + (int)gridDim.x : -1); } \
            if (DUPM == 7 && l == 0) for (int it = blockIdx.x; it < 1024; it += gridDim.x) { const Ctx Ci = make_ctx(); ml_passA(Ci, l, it); } \
        } \
        if (PH_ON(4)) {   PHASE_CTX(); \
            for (int it = blockIdx.x; it < 1024; it += gridDim.x) { const Ctx Ci = make_ctx(); gla_passA(Ci, l, it); } \
            if (DUPM == 8 && l == 0) for (int it = blockIdx.x; it < 1024; it += gridDim.x) { const Ctx Ci = make_ctx(); gla_passA(Ci, l, it); } \
            { const Ctx Ci = make_ctx(); s5_passA(Ci); } \
            if (DUPM == 9 && l == 0) { const Ctx Ci = make_ctx(); s5_passA(Ci); } \
        } \
        GRID_BAR();
#define PHM_MIXB() \
        if (PH_ON(4)) {   PHASE_CTX(); \
            if ((gw & 15) == 0 && (gw >> 4) < 128) rw_passB(C, gw >> 4); \
        } \
        if (PH_ON(4)) {   PHASE_CTX(); \
            ml_passB(C); \
        } \
        if (PH_ON(4)) {   PHASE_CTX(); \
            gla_passB(C); \
        } \
        if (PH_ON(4)) {   PHASE_CTX(); \
            s5_passB(C); \
        } \
        GRID_BAR();
#define PHM_MIXC() \
        if (PH_ON(4)) {   PHASE_CTX(); \
            { const Ctx Ci = make_ctx(); rw_s5_passC(Ci, l); } \
        } \
        __syncthreads(); \
        if (PH_ON(4)) {   PHASE_CTX(); \
            if (DUPM == 12 && l == 0) for (int it = blockIdx.x; it < 1024; it += gridDim.x) { const Ctx Ci = make_ctx(); ml_passC<true>(Ci, l, it); } \
            for (int it = blockIdx.x; it < 1024; it += gridDim.x) { const Ctx Ci = make_ctx(); ml_passC(Ci, l, it, (it + (int)gridDim.x < 1024) ? it + (int)gridDim.x : -1); } \
        } \
        if (PH_ON(4)) {   PHASE_CTX(); \
            if (DUPM == 13 && l == 0) for (int it = blockIdx.x; it < 1024; it += gridDim.x) { const Ctx Ci = make_ctx(); gla_passC<true>(Ci, l, it); } \
            for (int it = blockIdx.x; it < 1024; it += gridDim.x) { const Ctx Ci = make_ctx(); gla_passC(Ci, l, it); } \
        } \
        if (PH_ON(4)) {   PHASE_CTX(); \
        } \
        GRID_BAR();
#define PHM_MERGE() \
        if (PH_ON(5)) { PHASE_CTX(); MERGE_PTRS(); pg8::StaticOrder S0; S0.init(M, D, C.G, C.bid); pg8::Unit u0; S0.next(0, u0); OwnTile4 S4{u0.pm, u0.pn}; \
            pg8::Gemm g{XB, WG, M, 4 * D, D, D, D}; EpiGate8 E{G8, SSQ, gb}; pg8::gemm_phase<EpiGate8, OwnTile4, true, true>(C.lds, g, S4, E); } SUBSYNC(); \
        if (PH_ON(5)) { PHASE_CTX(); MERGE_PTRS(); EpiMerge8<0> E{G8, 0, MF, MG, ZP}; run_gemm<EpiMerge8<0>, false>(C, Z + ZA_O, ZP, WP, WB, M, D, WB, E); } SUBSYNC(); \
        if (PH_ON(5)) { PHASE_CTX(); MERGE_PTRS(); EpiGlu8 E{G8}; run_gemm<EpiGlu8, false>(C, Z + ZB_U, ZP, WP + 2 * (size_t)D * WB, WB, M, D, WB, E); } SUBSYNC(); \
        if (PH_ON(5)) { PHASE_CTX(); MERGE_PTRS(); EpiMerge8<1> E{G8, 1, MF, MG, ZP}; run_gemm<EpiMerge8<1>, false>(C, Z + ZB_U, ZP, WP + (size_t)D * WB, WB, M, D, WB, E); } SUBSYNC(); \
        if (PH_ON(5)) { PHASE_CTX(); MERGE_PTRS(); EpiMerge8<1> E{G8, 2, MF, MG, ZP}; run_gemm<EpiMerge8<1>, false>(C, Z + ZC_G, ZP, WP + 3 * (size_t)D * WB, WB, M, D, WB, E); } SUBSYNC(); \
        if (PH_ON(5)) { PHASE_CTX(); MERGE_PTRS(); EpiMerge8<2> E{G8, 3, MF, MG, ZP}; run_gemm<EpiMerge8<2>, false>(C, Z + ZD_R, ZP, WP + 4 * (size_t)D * WB, WB, M, D, WB, E); } \
        GRID_BAR();
#ifdef DUP_MODE
constexpr int DUPM = DUP_MODE;
#else
constexpr int DUPM = 0;
#endif
#ifndef STOP_AFTER
#define STOP_AFTER 1000
#endif
#define PH_ON(n) ((l) * 20 + (n) <= STOP_AFTER)
template <int l> __device__ __forceinline__ void layer_fwd() {
        if (PH_ON(1)) {   PHASE_CTX();
            { EpiSwiglu E{(bf16*)(ws + WS_HID), SSQ}; run_gemm<EpiSwiglu, true>(C, XB, D, (const bf16*)(ws + WS_SLOTA), D, M, 2 * FF, D, E); }
            if (l > 0 && C.bid >= 128) { run_conv(C, CJ_D1, l, (C.bid - 128) * 8 + C.wave, 128 * 8); }
            if (l == 0) {
                for (int q = 0; q < DEPTH; ++q) { EpiKV E{(bf16*)(ws + WS_KV + (size_t)q * 4 * MiB), (bf16*)(ws + WS_KV + (size_t)q * 4 * MiB + 2 * MiB), (const float*)(ws + WS_MEMR)};
                    run_gemm<EpiKV, true>(C, (const bf16*)(ws + WS_MEMB), D, (const bf16*)(ws + WS_S + (size_t)q * 4 * MiB), D, MMEM, 2 * D, D, E, 32, C.bid - 128 - 32 * q); }
            }
        }
        GRID_BAR();
        if (DUPM == 14 && l == 0) {
        if (PH_ON(1)) {   PHASE_CTX();

            { EpiSwiglu E{(bf16*)(ws + WS_HID), SSQ}; run_gemm<EpiSwiglu, true>(C, XB, D, (const bf16*)(ws + WS_SLOTA), D, M, 2 * FF, D, E); }
            if (l == 0) {
                for (int q = 0; q < DEPTH; ++q) { EpiKV E{(bf16*)(ws + WS_KV + (size_t)q * 4 * MiB), (bf16*)(ws + WS_KV + (size_t)q * 4 * MiB + 2 * MiB), (const float*)(ws + WS_MEMR)};
                    run_gemm<EpiKV, true>(C, (const bf16*)(ws + WS_MEMB), D, (const bf16*)(ws + WS_S + (size_t)q * 4 * MiB), D, MMEM, 2 * D, D, E, 32, C.bid - 128 - 32 * q); }
            }
        }
        GRID_BAR();
        }
        if (PH_ON(2)) {   PHASE_CTX();
            run_conv(C, CJ_GATES, l, gw, NGW);
            { EpiResid E{(l == 0) ? C.in[I_X] : (const float*)C.X, C.X, XB, SSQ, 0.5f}; run_gemm<EpiResid, false>(C, (const bf16*)(ws + WS_HID), FF, (const bf16*)(ws + WS_SLOTC), FF, M, D, FF, E); }
        }
        GRID_BAR();
#if defined(DUP_MODE)
        if (l == 0 && DUP_MODE >= 1 && DUP_MODE <= 4) {
#if DUP_MODE == 1
            PHM_IN();
#elif DUP_MODE == 2
            PHM_IN(); PHM_MIXA();
#elif DUP_MODE == 3
            PHM_IN(); PHM_MIXA(); PHM_MIXB();
#elif DUP_MODE == 4
            PHM_IN(); PHM_MIXA(); PHM_MIXB(); PHM_MIXC();
#endif
            { PHASE_CTX(); run_conv(C, CJ_WIN, l, gw, NGW); } GRID_BAR();
            GRID_BAR();
        }
#endif
        PHM_IN(); PHM_MIXA(); PHM_MIXB(); PHM_MIXC();
        PHM_MERGE();
#if defined(DUP_MODE) && DUP_MODE == 5
        if (l == 0) { PHM_MERGE(); }
#endif
        if (PH_ON(6)) {   PHASE_CTX();
            run_conv(C, CJ_GU2 | CJ_D2, l, gw, NGW);
            { EpiResid E{C.X, C.X, XB, SSQ, 1.0f}; run_gemm<EpiResid, false>(C, Z + ZC_Q, ZP, (const bf16*)(ws + WS_SLOTB), D, M, D, D, E); }
        }
        GRID_BAR();
        {
            const int un = blockIdx.x; const int pm = un >> 2, hh = un & 3, bb = pm >> 4;
            if (PH_ON(8)) {   PHASE_CTX();
                bf16* Qp = (bf16*)(ws + WS_XQ) + (size_t)C.bid * 65536;
                pg8::Gemm g{XB + (size_t)pm * 256 * D, (const bf16*)(ws + WS_SLOTB + 2 * MiB) + (size_t)hh * 256 * D, 256, 256, D, D, D}; pg8::SingleUnit S;
                EpiBf16 E{Qp, 256, SSQ + (size_t)pm * 256 * 16, 0.0625f * 1.4426950408889634f, 256};
                pg8::gemm_phase<EpiBf16, pg8::SingleUnit, false, true>(C.lds, g, S, E);
            }
            SUBSYNC();
            if (PH_ON(8)) {   PHASE_CTX();
                const bf16* Qp = (const bf16*)(ws + WS_XQ) + (size_t)C.bid * 65536;
                const bf16* Kd = (const bf16*)(ws + WS_KV + (size_t)l * 4 * MiB) + (size_t)bb * 256 * D + hh * 256;
                bf16* P = (bf16*)(ws + WS_XP) + (size_t)C.bid * 65536;
                pg8::Gemm g{Qp, Kd, 256, 256, 256, 256, D}; pg8::SingleUnit S; EpiSoftmaxP E{P}; pg8::gemm_phase<EpiSoftmaxP, pg8::SingleUnit, false, true>(C.lds, g, S, E);
            }
            SUBSYNC();
            if (PH_ON(8)) {   PHASE_CTX();
                const bf16* VT = (const bf16*)(ws + WS_KV + (size_t)l * 4 * MiB + 2 * MiB) + (size_t)hh * 256 * MMEM + bb * 256;
                const bf16* P = (const bf16*)(ws + WS_XP) + (size_t)C.bid * 65536;
                pg8::Gemm g{P, VT, 256, 256, 256, 256, MMEM}; pg8::SingleUnit S; EpiBf16 E{(bf16*)(ws + WS_XO) + (size_t)pm * 256 * D + hh * 256, D, nullptr, 1.0f, 256};
                pg8::gemm_phase<EpiBf16, pg8::SingleUnit, false, true>(C.lds, g, S, E);
            }
            SUBSYNC();
        }
        GRID_BAR();
        if (PH_ON(9)) {   PHASE_CTX();
            EpiResid E{C.X, C.X, XB, SSQ, 1.0f}; run_gemm<EpiResid, false>(C, (const bf16*)(ws + WS_XO), D, (const bf16*)(ws + WS_SLOTB + 4 * MiB), D, M, D, D, E);
        }
        GRID_BAR();
        if (PH_ON(10)) {   PHASE_CTX();
            { EpiSwiglu E{(bf16*)(ws + WS_HID), SSQ}; run_gemm<EpiSwiglu, true>(C, XB, D, (const bf16*)(ws + WS_SLOTA), D, M, 2 * FF, D, E); }
            if (l + 1 < DEPTH && C.bid >= 128) { run_conv(C, CJ_WIN, l + 1, (C.bid - 128) * 8 + C.wave, 128 * 8); }
        }
        GRID_BAR();
        if (DUPM == 18 && l == 0) {
        if (PH_ON(10)) {   PHASE_CTX();
            if (l + 1 < DEPTH) { run_conv(C, CJ_WIN, l + 1, gw, NGW); }
            { EpiSwiglu E{(bf16*)(ws + WS_HID), SSQ}; run_gemm<EpiSwiglu, true>(C, XB, D, (const bf16*)(ws + WS_SLOTA), D, M, 2 * FF, D, E); }
        }
        GRID_BAR();
        }
        if (PH_ON(11)) {   PHASE_CTX();
            if (l + 1 < DEPTH) { run_conv(C, CJ_GU1, l + 1, gw, NGW); }
            { EpiResid E{C.X, C.X, XB, SSQ, 0.5f}; run_gemm<EpiResid, false>(C, (const bf16*)(ws + WS_HID), FF, (const bf16*)(ws + WS_SLOTC), FF, M, D, FF, E); }
        }
        GRID_BAR();
    }

__global__ void __launch_bounds__(512, 2) fwd_kernel(Args args) {
    extern __shared__ __attribute__((aligned(16))) unsigned char lds_raw[];
    (void)args;
    {
        const Ctx C = make_ctx();
        volatile LAS unsigned* MISC = (volatile LAS unsigned*)(C.lds + MISC_OFF);
        for (int u = C.tid; u < (LDS_BYTES - RING_BYTES) / 4; u += 512) ((LAS unsigned*)(C.lds + RING_BYTES))[u] = 0u;
        __syncthreads();
        (void)xcd_barrier_post((unsigned*)(C.ws + WS_CTL) + 4096, MISC + 8);
        PROBE_STAMP(C);
    }

    {   PHASE_CTX();
        pro_rows(C);
        run_conv(C, CJ_GU1 | CJ_D1 | CJ_WIN | CJ_XKV0 | CJ_XKV1, 0, gw, NGW);
    }
    GRID_BAR();
    if (DUPM == 17) {
    {   PHASE_CTX();
        pro_rows(C);
        run_conv(C, CJ_GU1 | CJ_D1 | CJ_WIN | CJ_XKV0 | CJ_XKV1, 0, gw, NGW);
    }
    GRID_BAR();
    }

    layer_fwd<0>();
    layer_fwd<1>();
    {   PHASE_CTX();
        final_rows(C);
#ifdef PROBE_LO
        {
            __syncthreads();
            const unsigned long long* st = (const unsigned long long*)(ws + WS_CTL + 32768);
            const unsigned long long ta = __hip_atomic_load(st + PROBE_LO, __ATOMIC_RELAXED, __HIP_MEMORY_SCOPE_AGENT), tb = __hip_atomic_load(st + PROBE_HI, __ATOMIC_RELAXED, __HIP_MEMORY_SCOPE_AGENT);
            size_t K = (size_t)((tb - ta) * (unsigned long long)PROBE_SCALE / 16ull); if (K > 180000) K = 180000;
            const int gwv = C.bid * 8 + C.wave, NG = C.G * 8;
            for (int m = gwv; m < M; m += NG) { const size_t base = (size_t)m * D; if (base >= K) break;
                for (int j = C.lane; j < D; j += 64) if (base + j < K) C.X[base + j] += 0.2f; }
        }
#endif
        if (xb_ld((unsigned*)(ws + WS_CTL) + 4096 + XB_TMO) != 0u) {
            for (size_t i = (size_t)C.bid * 512 + C.tid; i < (size_t)M * D; i += (size_t)C.G * 512) C.X[i] = __builtin_nanf("");
        }
    }
}

extern "C" void kernel_launch(void* const* d_in, const int* in_sizes, int n_in, void* d_out, int out_size, void* d_ws, size_t ws_size, hipStream_t stream) {
    static int grid = 0;
    if (grid == 0) {
        if (n_in != N_INPUTS || out_size != M * D || ws_size < WS_END) { fprintf(stderr, "kernel_launch: unexpected shapes: n_in %d out %d ws %zu (need %zu)\n", n_in, out_size, ws_size, (size_t)WS_END); grid = -1; return; }
        int dev = 0, cus = 0, per_cu = 0;
        if (hipGetDevice(&dev) != hipSuccess || hipDeviceGetAttribute(&cus, hipDeviceAttributeMultiprocessorCount, dev) != hipSuccess) { grid = -1; return; }
        if (hipFuncSetAttribute((const void*)fwd_kernel, hipFuncAttributeMaxDynamicSharedMemorySize, LDS_BYTES) != hipSuccess) { fprintf(stderr, "kernel_launch: hipFuncSetAttribute failed\n"); grid = -1; return; }
        if (hipOccupancyMaxActiveBlocksPerMultiprocessor(&per_cu, (const void*)fwd_kernel, 512, LDS_BYTES) != hipSuccess || per_cu < 1) { fprintf(stderr, "kernel_launch: occupancy query says %d workgroups per CU\n", per_cu); (void)hipGetLastError(); grid = -1; return; }
        if (cus < 256) { fprintf(stderr, "kernel_launch: built for a 256-CU device (got %d)\n", cus); grid = -1; return; }
        grid = 256;
    }
    if (grid < 0) return;
    if (hipMemsetAsync((char*)d_ws + WS_CTL, 0, CTL_ZERO_BYTES, stream) != hipSuccess) return;
    Args a{};
    for (int i = 0; i < N_INPUTS; ++i) a.in[i] = (const float*)d_in[i];
    a.out = (float*)d_out; a.ws = (unsigned char*)d_ws;
    hipLaunchKernelGGL(fwd_kernel, dim3(grid), dim3(512), LDS_BYTES, stream, a);
}
```

```cpp
#include <hip/hip_runtime.h>
#include <cstdio>
#include <cstdint>

#define LAS __attribute__((address_space(3)))
#define GAS __attribute__((address_space(1)))
typedef unsigned short bf16;
typedef float f32x4 __attribute__((ext_vector_type(4)));
typedef float f32x2 __attribute__((ext_vector_type(2)));
typedef unsigned u32x4 __attribute__((ext_vector_type(4)));
typedef unsigned u32x2 __attribute__((ext_vector_type(2)));
typedef short bf16x8 __attribute__((ext_vector_type(8)));

constexpr int NB = 4, SEQ = 4096, M = NB * SEQ, D = 1024, FF = 2816, WB = 512, DEPTH = 2, MEML = 256, MMEM = NB * MEML;
constexpr int NZ = 4888, ZP = 4896, NINP = 5120, NIN = 8984;
constexpr int ZA_U = 0, ZA_O = 512, ZA_I = 1024, ZA_F = 1028, ZB_U = 1032, ZC_Q = 1544, ZC_K = 1800, ZC_V = 2056, ZC_G = 2568, ZC_A = 3080;
constexpr int ZD_R = 3096, ZD_K = 3608, ZD_V = 4120, ZD_XW = 4632, ZD_XA = 4696, ZD_XG = 4760, ZG = 4888;
constexpr float NORM_EPS = 1e-6f;

enum { I_X = 0, I_MEM, I_FFN1_NORM, I_FFN1_WG, I_FFN1_WU, I_FFN1_WD, I_MIX_NORM, I_W_IN, I_GATE_BIAS, I_ML_CONV, I_ML_WQ, I_ML_WK, I_ML_WV, I_ML_BI, I_ML_BF,
       I_ML_NORM, I_ML_PROJ, I_S5_ARE, I_S5_AIM, I_S5_LOGSTEP, I_S5_BRE, I_S5_BIM, I_S5_CRE, I_S5_CIM, I_S5_D, I_S5_W1, I_S5_W2, I_GLA_AUP, I_GLA_ABIAS,
       I_GLA_NORM, I_GLA_PROJ, I_RW_MU, I_RW_W0, I_RW_WUP, I_RW_A0, I_RW_AUP, I_RW_GUP, I_RW_KK, I_RW_KA, I_RW_RK, I_RW_NORM, I_RW_PROJ, I_W_OUT,
       I_XA_NORM, I_MEM_NORM, I_XA_WQ, I_XA_WK, I_XA_WV, I_XA_WO, I_FFN2_NORM, I_FFN2_WG, I_FFN2_WU, I_FFN2_WD, I_FINAL_NORM, N_INPUTS };

constexpr size_t MiB = 1u << 20;
constexpr size_t WS_CTL = 0, CTL_ZERO_BYTES = 64 * 1024;
constexpr size_t WS_SSQ = 1 * MiB;
constexpr size_t WS_MEMR = 256 * 1024;
constexpr size_t WS_XB = 2 * MiB;
constexpr size_t WS_MEMB = 34 * MiB;
constexpr size_t WS_KV = 36 * MiB;
constexpr size_t WS_SLOTA = 44 * MiB;
constexpr size_t WS_SLOTB = 55 * MiB;
constexpr size_t WS_SLOTC = 65 * MiB;
constexpr size_t WS_Z = 73 * MiB;
constexpr size_t Z_BYTES = (size_t)M * ZP * 2;
constexpr size_t WS_S = WS_Z + Z_BYTES;
constexpr size_t WS_END = 350110016;
static_assert(WS_S == 226 * MiB, "map");
constexpr size_t S_BYTES = WS_END - WS_S;
constexpr size_t WS_HID = WS_Z;
constexpr size_t WS_XQ = WS_Z, WS_XO = WS_Z + 32 * MiB, WS_XP = WS_Z + 64 * MiB;
constexpr size_t WS_G8 = WS_S, WS_MF = WS_S + 64 * MiB;
static_assert(WS_MF + 32 * MiB <= WS_END, "merge stash");

constexpr int LDS_BYTES = 147456, RING_BYTES = 131072, MISC_OFF = RING_BYTES + 320;

#define RLX_AGENT __ATOMIC_RELAXED, __HIP_MEMORY_SCOPE_AGENT
#define LDS_WAIT() asm volatile("s_waitcnt lgkmcnt(0)" ::: "memory")
#define VM_WAIT() asm volatile("s_waitcnt vmcnt(0)" ::: "memory")
typedef __bf16 bf16x2_t __attribute__((ext_vector_type(2)));
__device__ __forceinline__ unsigned pk2(float lo, float hi) { const f32x2 v = {lo, hi}; return __builtin_bit_cast(unsigned, __builtin_convertvector(v, bf16x2_t)); }
__device__ __forceinline__ unsigned f2bf(float f) { return pk2(f, 0.f); }
__device__ __forceinline__ float bf2f(unsigned h) { return __builtin_bit_cast(float, h << 16); }
__device__ __forceinline__ float bflo(unsigned w) { return __builtin_bit_cast(float, w << 16); }
__device__ __forceinline__ float bfhi(unsigned w) { return __builtin_bit_cast(float, w & 0xffff0000u); }
__device__ __forceinline__ float rcpf_(float x) { return __builtin_amdgcn_rcpf(x); }
__device__ __forceinline__ float rsqf_(float x) { return __builtin_amdgcn_rsqf(x); }
__device__ __forceinline__ float sigmoidf_(float x) { return rcpf_(1.0f + __expf(-x)); }
__device__ __forceinline__ float siluf_(float x) { return x * rcpf_(1.0f + __expf(-x)); }
__device__ __forceinline__ float softplusf_(float x) { return fmaxf(x, 0.f) + __logf(1.0f + __expf(-fabsf(x))); }
__device__ __forceinline__ float tanhf_(float x) { const float e = __expf(-2.0f * fabsf(x)); const float t = (1.0f - e) * rcpf_(1.0f + e); return x < 0.f ? -t : t; }
__device__ __forceinline__ float logsigmoidf_(float x) { return -softplusf_(-x); }
__device__ __forceinline__ float shx(float v, int mask, int lane) { return __builtin_bit_cast(float, __builtin_amdgcn_ds_bpermute((lane ^ mask) << 2, __builtin_bit_cast(int, v))); }
__device__ __forceinline__ float wave_sum(float v, int lane) {
#pragma unroll
    for (int o = 1; o < 64; o <<= 1) v += shx(v, o, lane);
    return v;
}

#define XB_TMO      128
#define XB_XCNT(j)  (256  + 64 * (j))
#define XB_XSUB(j)  (1280 + 64 * (j))
#define XB_XGEN(j)  (2304 + 64 * (j))
#define XB_TOP      3328
#define XB_TOPGEN   3392
#define XCD_BAR_WORDS 3456
#define XB_SPIN_CAP (1u << 20)
__device__ __forceinline__ unsigned xb_ld(unsigned* p)              { return __hip_atomic_load(p, __ATOMIC_RELAXED, __HIP_MEMORY_SCOPE_AGENT); }
__device__ __forceinline__ unsigned xb_add(unsigned* p, unsigned v) { return __hip_atomic_fetch_add(p, v, __ATOMIC_RELAXED, __HIP_MEMORY_SCOPE_AGENT); }
__device__ __forceinline__ unsigned xb_xcc_id() { return (unsigned)__builtin_amdgcn_s_getreg((3 << 11) | 20) & 0xFu; }
#define XB_SPIN(cond, bar) do { unsigned _sp = 0; while (cond) { __builtin_amdgcn_s_sleep(1); \
    if ((++_sp & 255u) == 0u) { if (xb_ld(&(bar)[XB_TMO])) break; if (_sp > XB_SPIN_CAP) { atomicAdd(&(bar)[XB_TMO], 1u); break; } } } } while (0)
struct XcdBarrier { unsigned* bar; unsigned x; volatile LAS unsigned* st; };
__device__ __forceinline__ XcdBarrier xcd_barrier_post(unsigned* bar, volatile LAS unsigned* st) {
    XcdBarrier b; b.bar = bar; b.x = xb_xcc_id(); b.st = st;
    if (threadIdx.x == 0) (void)xb_add(&bar[XB_XCNT(b.x)], 1u);
    return b;
}
__device__ __forceinline__ void xcd_barrier_complete(unsigned* bar, unsigned x, unsigned& nloc, unsigned& nx) {
    const unsigned G = gridDim.x * gridDim.y * gridDim.z;
    unsigned sum, cnt, mine, sp = 0u;
    for (;;) {
        sum = 0u; cnt = 0u; mine = 0u;
#pragma unroll
        for (unsigned j = 0; j < 16; ++j) { const unsigned c = xb_ld(&bar[XB_XCNT(j)]); sum += c; cnt += (c > 0u) ? 1u : 0u; mine = (j == x) ? c : mine; }
        if (sum == G) break;
        __builtin_amdgcn_s_sleep(1);
        if ((++sp & 255u) == 0u) { if (xb_ld(&bar[XB_TMO])) break; if (sp > XB_SPIN_CAP) { atomicAdd(&bar[XB_TMO], 1u); break; } }
    }
    nloc = mine > 0u ? mine : 1u; nx = cnt > 0u ? cnt : 1u;
}
__device__ __forceinline__ void xcd_barrier(const XcdBarrier& b) {
    asm volatile("s_waitcnt vmcnt(0)" ::: "memory");
    __syncthreads();
    if (threadIdx.x == 0) {
        unsigned* bar = b.bar;
        __builtin_amdgcn_s_waitcnt(0);
        unsigned nloc = b.st[0], nx = b.st[1];
        if (nloc == 0u) { xcd_barrier_complete(bar, b.x, nloc, nx); b.st[0] = nloc; b.st[1] = nx; }
        const unsigned old = xb_add(&bar[XB_XSUB(b.x)], 1u);
        const unsigned gen = old / nloc;
        if (old + 1u == (gen + 1u) * nloc) {
            __builtin_amdgcn_fence(__ATOMIC_RELEASE, "agent");
            asm volatile("s_waitcnt vmcnt(0)" ::: "memory");
            const unsigned og = xb_add(&bar[XB_TOP], 1u);
            const unsigned tg = og / nx;
            if (og + 1u == (tg + 1u) * nx) xb_add(&bar[XB_TOPGEN], 1u);
            else XB_SPIN(xb_ld(&bar[XB_TOPGEN]) == tg, bar);
            __builtin_amdgcn_fence(__ATOMIC_ACQUIRE, "agent");
            xb_add(&bar[XB_XGEN(b.x)], 1u);
            asm volatile("s_waitcnt vmcnt(0)" ::: "memory");
        } else {
            XB_SPIN(xb_ld(&bar[XB_XGEN(b.x)]) == gen, bar);
            __builtin_amdgcn_fence(__ATOMIC_ACQUIRE, "agent");
            asm volatile("s_waitcnt vmcnt(0)" ::: "memory");
        }
    }
    __syncthreads();
}
namespace pg8 {
#define PG8_LAS __attribute__((address_space(3)))
typedef unsigned short bf16_t;
typedef short bf16x8 __attribute__((ext_vector_type(8)));
typedef float f32x4 __attribute__((ext_vector_type(4)));
typedef unsigned u32x4 __attribute__((ext_vector_type(4)));
constexpr int BM = 256, BK = 64, HALF = 128, HTB = HALF * BK * 2  , STAGE_BYTES = 8 * HTB, NXCD = 8, WGM = 8;

__host__ __device__ __forceinline__ int lds_byte(int r, int c) { const int st = (r >> 4) * 2 + (c >> 5), rr = r & 15, cc = c & 31, ob = rr * 64 + cc * 2; return st * 1024 + (ob ^ (((ob >> 9) & 1) << 5)); }
__host__ __device__ __forceinline__ void stage_rc(int b, int& R, int& C) { const int st = b / 1024, sb = b % 1024, swz = sb ^ (((sb >> 9) & 1) << 5); R = (st >> 1) * 16 + swz / 64; C = (st & 1) * 32 + (swz % 64) / 2; }
__host__ __device__ __forceinline__ int perm32(int rho) { const int n = rho >> 4, i = rho & 15; return 8 * (i >> 2) + 4 * n + (i & 3); }

struct Unit { int pm, pn, job; };
struct Gemm { const bf16_t* A; const bf16_t* Bt; int M, N, K, lda, ldb; };

struct StaticOrder {
    int nM, nN, nwg, G, c;
    __host__ __device__ void init(int M, int N, int G_, int c_) { nM = M / BM; nN = N / BM; nwg = nM * nN; G = G_; c = c_; }
    __host__ __device__ __forceinline__ bool next(int i, Unit& u) const {
        const long L = (long)i * G + c; if (L >= nwg) return false;
        int wgid = (int)L; { const int q = nwg / NXCD, r = nwg % NXCD, xcd = wgid % NXCD, off = wgid / NXCD; wgid = (xcd < r ? xcd * (q + 1) : r * (q + 1) + (xcd - r) * q) + off; }
        const int nig = WGM * nN, gid = wgid / nig, fm = gid * WGM, gsz = (nM - fm) < WGM ? (nM - fm) : WGM;
        u.pm = fm + ((wgid % nig) % gsz); u.pn = (wgid % nig) / gsz; u.job = 0; return true;
    }
    __device__ __forceinline__ void a_ready(const Unit&) const {}
    __device__ __forceinline__ void done(const Unit&) const {}
    __device__ __forceinline__ const char* baseA(const Gemm& g, const Unit&) const { return (const char*)g.A; }
    __device__ __forceinline__ const char* baseB(const Gemm& g, const Unit&) const { return (const char*)g.Bt; }
};


struct SingleUnit {
    __device__ __forceinline__ bool next(int i, Unit& u) const { if (i > 0) return false; u.pm = 0; u.pn = 0; u.job = 0; return true; }
    __device__ __forceinline__ void a_ready(const Unit&) const {}
    __device__ __forceinline__ void done(const Unit&) const {}
    __device__ __forceinline__ const char* baseA(const Gemm& g, const Unit&) const { return (const char*)g.A; }
    __device__ __forceinline__ const char* baseB(const Gemm& g, const Unit&) const { return (const char*)g.Bt; }
};
typedef __bf16 bf16x2_cv __attribute__((ext_vector_type(2))); typedef float f32x2_cv __attribute__((ext_vector_type(2)));
__device__ __forceinline__ unsigned cvt_pk_bf16(float lo, float hi) { const f32x2_cv v = {lo, hi}; return __builtin_bit_cast(unsigned, __builtin_convertvector(v, bf16x2_cv)); }
template <class Epi, class Sched, bool ALIGN_EPI = false, bool SP2 = false>
__device__ __forceinline__ void gemm_phase(PG8_LAS unsigned char* lds, const Gemm g, const Sched& S, const Epi& E) {
    int tid_ = threadIdx.x; asm volatile("" : "+v"(tid_));
    const int tid = tid_, wid = __builtin_amdgcn_readfirstlane(tid >> 6), lane = tid & 63, wr = wid >> 2, wc = wid & 3, fr = lane & 15, fq = lane >> 4;
    const int K = g.K, nt = K / BK, lda = g.lda, ldb = g.ldb;
    unsigned voffA[2], voffB[2];
#pragma unroll
    for (int i = 0; i < 2; ++i) { int R, C; stage_rc(tid * 16 + i * 8192, R, C); const int Rb = Epi::PERM ? ((R & ~31) + perm32(R & 31)) : R;
        voffA[i] = (unsigned)(R * lda + C) * 2u; voffB[i] = (unsigned)(Rb * ldb + C) * 2u; }
    const size_t kstep = (size_t)(BK * 2);
    const size_t hstepA = (size_t)HALF * lda * 2, hstepB = (size_t)HALF * ldb * 2;
    const size_t tstepA = 2 * hstepA, tstepB = 2 * hstepB;
    const unsigned ldsw = (unsigned)wid * 1024u;
    const int aoff = lds_byte(wr * 64 + fr, fq * 8), boff = lds_byte(wc * 32 + fr, fq * 8);
#define PG8_SA(b, h) (((b) * 2 + (h)) * HTB)
#define PG8_SB(b, h) ((4 + (b) * 2 + (h)) * HTB)
#define PG8_STAGE(bufoff, gbase, voff) do { _Pragma("unroll") for (int _i = 0; _i < 2; ++_i) \
        __builtin_amdgcn_global_load_lds((const unsigned*)((const char*)(gbase) + (voff)[_i]), (PG8_LAS unsigned*)(lds + (bufoff) + ldsw + _i * 8192), 16, 0, 0); } while (0)
#define PG8_LDA(dst, b, h) do { _Pragma("unroll") for (int m = 0; m < 4; ++m) _Pragma("unroll") for (int k = 0; k < 2; ++k) dst[m][k] = *(const PG8_LAS bf16x8*)(lds + PG8_SA(b, h) + aoff + m * 2048 + k * 1024); } while (0)
#define PG8_LDB(dst, b, h) do { _Pragma("unroll") for (int n = 0; n < 2; ++n) _Pragma("unroll") for (int k = 0; k < 2; ++k) dst[n][k] = *(const PG8_LAS bf16x8*)(lds + PG8_SB(b, h) + boff + n * 2048 + k * 1024); } while (0)
#define PG8_MMA(ai, bj, At, Bt) do { __builtin_amdgcn_s_setprio(1); _Pragma("unroll") for (int m = 0; m < 4; ++m) _Pragma("unroll") for (int n = 0; n < 2; ++n) _Pragma("unroll") for (int k = 0; k < 2; ++k) \
        acc[ai][bj][m][n] = __builtin_amdgcn_mfma_f32_16x16x32_bf16(Bt[n][k], At[m][k], acc[ai][bj][m][n], 0, 0, 0); __builtin_amdgcn_s_setprio(0); } while (0)
#define PG8_WAIT_V(n) asm volatile("s_waitcnt vmcnt(" #n ")" ::: "memory")
#define PG8_WAIT_L(n) asm volatile("s_waitcnt lgkmcnt(" #n ")" ::: "memory")
#define PG8_BAR __builtin_amdgcn_s_barrier()
#define PG8_SCHED __builtin_amdgcn_sched_barrier(0)
    Unit cur, nxt; int ui = 0;
    if (!S.next(0, cur)) return;
    f32x4 acc[2][2][4][2];
#pragma unroll
    for (int a = 0; a < 2; ++a)
#pragma unroll
        for (int b = 0; b < 2; ++b)
#pragma unroll
            for (int m = 0; m < 4; ++m)
#pragma unroll
                for (int n = 0; n < 2; ++n) acc[a][b][m][n] = (f32x4){0.f, 0.f, 0.f, 0.f};
    bf16x8 At[4][2], B0[2][2], B1[2][2];
    const char* cA = S.baseA(g, cur) + (size_t)cur.pm * tstepA; const char* cB = S.baseB(g, cur) + (size_t)cur.pn * tstepB;
    S.a_ready(cur);
    if constexpr (SP2) {
        PG8_STAGE(PG8_SB(0, 0), cB, voffB); PG8_STAGE(PG8_SB(0, 1), cB + hstepB, voffB); PG8_STAGE(PG8_SA(0, 0), cA, voffA); PG8_STAGE(PG8_SA(0, 1), cA + hstepA, voffA);
        if (wr == 1) PG8_BAR;
        PG8_WAIT_V(2); PG8_BAR;
        PG8_STAGE(PG8_SB(1, 0), cB + kstep, voffB); PG8_STAGE(PG8_SA(1, 0), cA + kstep, voffA); PG8_STAGE(PG8_SB(1, 1), cB + hstepB + kstep, voffB);
        PG8_WAIT_V(6); PG8_BAR;
    } else {
        PG8_STAGE(PG8_SB(0, 0), cB, voffB); PG8_STAGE(PG8_SA(0, 0), cA, voffA); PG8_STAGE(PG8_SB(0, 1), cB + hstepB, voffB); PG8_STAGE(PG8_SA(0, 1), cA + hstepA, voffA);
        if (wr == 1) PG8_BAR;
        PG8_WAIT_V(4); PG8_BAR;
        PG8_STAGE(PG8_SB(1, 0), cB + kstep, voffB); PG8_STAGE(PG8_SA(1, 0), cA + kstep, voffA); PG8_STAGE(PG8_SB(1, 1), cB + hstepB + kstep, voffB);
        PG8_WAIT_V(6); PG8_BAR;
    }
    for (;;) {
        const bool has_next = S.next(ui + 1, nxt);
        const char* nA = has_next ? S.baseA(g, nxt) + (size_t)nxt.pm * tstepA : cA; const char* nB = has_next ? S.baseB(g, nxt) + (size_t)nxt.pn * tstepB : cB;
        for (int t = 0; t < nt; t += 2) {
            const bool last = (t == nt - 2);
            const char* a1 = cA + (size_t)(t + 1) * kstep;
            const char* a2 = last ? nA : cA + (size_t)(t + 2) * kstep; const char* b2 = last ? nB : cB + (size_t)(t + 2) * kstep;
            const char* a3 = a2 + kstep; const char* b3 = b2 + kstep;
            if (last && has_next) S.a_ready(nxt);
            if constexpr (SP2) {
            PG8_LDB(B0, 0, 0); PG8_LDB(B1, 0, 1); PG8_SCHED; PG8_LDA(At, 0, 0); PG8_STAGE(PG8_SA(1, 1), a1 + hstepA, voffA);
            PG8_WAIT_V(8); PG8_WAIT_L(0); PG8_BAR; PG8_MMA(0, 0, At, B0); PG8_MMA(0, 1, At, B1); PG8_BAR; PG8_SCHED;
            PG8_LDA(At, 0, 1); PG8_STAGE(PG8_SB(0, 0), b2, voffB); PG8_STAGE(PG8_SB(0, 1), b2 + hstepB, voffB); PG8_STAGE(PG8_SA(0, 0), a2, voffA);
            PG8_WAIT_V(8); PG8_WAIT_L(0); PG8_BAR; PG8_MMA(1, 0, At, B0); PG8_MMA(1, 1, At, B1); PG8_BAR; PG8_SCHED;
            PG8_LDB(B0, 1, 0); PG8_LDB(B1, 1, 1); PG8_SCHED; PG8_LDA(At, 1, 0); PG8_STAGE(PG8_SA(0, 1), a2 + hstepA, voffA);
            PG8_WAIT_V(8); PG8_WAIT_L(0); PG8_BAR; PG8_MMA(0, 0, At, B0); PG8_MMA(0, 1, At, B1); PG8_BAR; PG8_SCHED;
            PG8_LDA(At, 1, 1); PG8_STAGE(PG8_SB(1, 0), b3, voffB); PG8_STAGE(PG8_SB(1, 1), b3 + hstepB, voffB); PG8_STAGE(PG8_SA(1, 0), a3, voffA);
            PG8_WAIT_V(8); PG8_WAIT_L(0); PG8_BAR; PG8_MMA(1, 0, At, B0); PG8_MMA(1, 1, At, B1); PG8_BAR; PG8_SCHED;
            } else {
            PG8_LDB(B0, 0, 0); PG8_SCHED; PG8_LDA(At, 0, 0); PG8_STAGE(PG8_SA(1, 1), a1 + hstepA, voffA);
            PG8_WAIT_L(8); PG8_BAR; PG8_WAIT_L(0); PG8_MMA(0, 0, At, B0); PG8_BAR; PG8_SCHED;
            PG8_LDB(B1, 0, 1); PG8_STAGE(PG8_SB(0, 0), b2, voffB);
            PG8_BAR; PG8_WAIT_L(0); PG8_MMA(0, 1, At, B1); PG8_BAR;
            PG8_LDA(At, 0, 1); PG8_STAGE(PG8_SA(0, 0), a2, voffA);
            PG8_BAR; PG8_WAIT_L(0); PG8_MMA(1, 0, At, B0); PG8_BAR; PG8_SCHED;
            PG8_STAGE(PG8_SB(0, 1), b2 + hstepB, voffB);
            PG8_WAIT_V(6); PG8_BAR; PG8_MMA(1, 1, At, B1); PG8_BAR;
            PG8_LDB(B0, 1, 0); PG8_SCHED; PG8_LDA(At, 1, 0); PG8_STAGE(PG8_SA(0, 1), a2 + hstepA, voffA);
            PG8_WAIT_L(8); PG8_BAR; PG8_WAIT_L(0); PG8_MMA(0, 0, At, B0); PG8_BAR; PG8_SCHED;
            PG8_LDB(B1, 1, 1); PG8_STAGE(PG8_SB(1, 0), b3, voffB);
            PG8_BAR; PG8_WAIT_L(0); PG8_MMA(0, 1, At, B1); PG8_BAR;
            PG8_LDA(At, 1, 1); PG8_STAGE(PG8_SA(1, 0), a3, voffA);
            PG8_BAR; PG8_WAIT_L(0); PG8_MMA(1, 0, At, B0); PG8_BAR; PG8_SCHED;
            PG8_STAGE(PG8_SB(1, 1), b3 + hstepB, voffB);
            PG8_WAIT_V(6); PG8_BAR; PG8_MMA(1, 1, At, B1); PG8_BAR;
            }
        }
        if constexpr (ALIGN_EPI) { if (wr == 0) PG8_BAR; }
        if constexpr (!Epi::AFTER_DRAIN) { E(acc, cur, wr, wc, fr, fq); S.done(cur); }
        if (!has_next) break;
#pragma unroll
        for (int a = 0; a < 2; ++a)
#pragma unroll
            for (int b = 0; b < 2; ++b)
#pragma unroll
                for (int m = 0; m < 4; ++m)
#pragma unroll
                    for (int n = 0; n < 2; ++n) acc[a][b][m][n] = (f32x4){0.f, 0.f, 0.f, 0.f};
        cur = nxt; cA = nA; cB = nB; ++ui;
        if constexpr (ALIGN_EPI) { if (wr == 1) PG8_BAR; }
    }
    PG8_WAIT_V(0);
    if constexpr (!ALIGN_EPI) { if (wr == 0) PG8_BAR; }
    PG8_BAR;
    if constexpr (Epi::AFTER_DRAIN) { E.fused(acc, cur, wr, wc, fr, fq, lds, wid, lane); S.done(cur); }
#undef PG8_SA
#undef PG8_SB
#undef PG8_STAGE
#undef PG8_LDA
#undef PG8_LDB
#undef PG8_MMA
#undef PG8_WAIT_V
#undef PG8_WAIT_L
#undef PG8_BAR
#undef PG8_SCHED
}
}

using pg8::Unit; using pg8::cvt_pk_bf16;
#define EPI_ARGS const f32x4 (&acc)[2][2][4][2], const Unit& u, int wr, int wc, int fr, int fq
__device__ __forceinline__ float row_rstd(const float* ssq, int row) {
    const f32x4* p = (const f32x4*)(ssq + (size_t)row * 16);
    const f32x4 a = p[0], b = p[1], c = p[2], d = p[3];
    const float s = ((a[0] + a[1]) + (a[2] + a[3])) + ((b[0] + b[1]) + (b[2] + b[3])) + ((c[0] + c[1]) + (c[2] + c[3])) + ((d[0] + d[1]) + (d[2] + d[3]));
    return rsqf_(s * (1.0f / D) + NORM_EPS);
}
struct EpiSwiglu {
    static constexpr bool PERM = true, AFTER_DRAIN = false;
    bf16* H; const float* ssq;
    __device__ __forceinline__ void operator()(EPI_ARGS) const {
#pragma unroll
        for (int ai = 0; ai < 2; ++ai)
#pragma unroll
            for (int m = 0; m < 4; ++m) {
                const int row = u.pm * 256 + ai * 128 + wr * 64 + m * 16 + fr; const float rs = row_rstd(ssq, row); float v[8];
#pragma unroll
                for (int n = 0; n < 2; ++n) { const f32x4 g = acc[ai][0][m][n] * rs, up = acc[ai][1][m][n] * rs;
#pragma unroll
                    for (int j = 0; j < 4; ++j) v[4 * n + j] = siluf_(g[j]) * up[j]; }
                u32x4 w; w.x = cvt_pk_bf16(v[0], v[1]); w.y = cvt_pk_bf16(v[2], v[3]); w.z = cvt_pk_bf16(v[4], v[5]); w.w = cvt_pk_bf16(v[6], v[7]);
                *(u32x4*)(H + (size_t)row * FF + u.pn * 128 + wc * 32 + fq * 8) = w;
            }
    }
};
struct EpiResid {
    static constexpr bool PERM = false, AFTER_DRAIN = false;
    const float* Xin; float* X; bf16* XB; float* ssq; float alpha;
    __device__ __forceinline__ void operator()(EPI_ARGS) const {
#pragma unroll
        for (int ai = 0; ai < 2; ++ai)
#pragma unroll
            for (int m = 0; m < 4; ++m) {
                const int row = u.pm * 256 + ai * 128 + wr * 64 + m * 16 + fr; float s = 0.f;
#pragma unroll
                for (int bj = 0; bj < 2; ++bj)
#pragma unroll
                    for (int n = 0; n < 2; ++n) {
                        const size_t off = (size_t)row * D + u.pn * 256 + bj * 128 + wc * 32 + n * 16 + fq * 4;
                        const f32x4 xn = *(const f32x4*)(Xin + off) + acc[ai][bj][m][n] * alpha;
                        *(f32x4*)(X + off) = xn;
                        u32x2 w; w.x = cvt_pk_bf16(xn[0], xn[1]); w.y = cvt_pk_bf16(xn[2], xn[3]);
                        *(u32x2*)(XB + off) = w;
                        s += (xn[0] * xn[0] + xn[1] * xn[1]) + (xn[2] * xn[2] + xn[3] * xn[3]);
                    }
                s += shx(s, 16, fq * 16 + fr); s += shx(s, 32, fq * 16 + fr);
                if (fq == 0) ssq[(size_t)row * 16 + u.pn * 4 + wc] = s;
            }
    }
};
struct EpiBf16 {
    static constexpr bool PERM = true, AFTER_DRAIN = false;
    bf16* O; int ldc; const float* ssq; float scale; int ncols;
    __device__ __forceinline__ void operator()(EPI_ARGS) const {
#pragma unroll
        for (int ai = 0; ai < 2; ++ai)
#pragma unroll
            for (int m = 0; m < 4; ++m) {
                const int row = u.pm * 256 + ai * 128 + wr * 64 + m * 16 + fr; const float rs = (ssq ? row_rstd(ssq, row) : 1.0f) * scale;
#pragma unroll
                for (int bj = 0; bj < 2; ++bj) {
                    const int col = u.pn * 256 + bj * 128 + wc * 32 + fq * 8;
                    if (col < ncols) {
                        const f32x4 v0 = acc[ai][bj][m][0] * rs, v1 = acc[ai][bj][m][1] * rs; u32x4 w;
                        w.x = cvt_pk_bf16(v0[0], v0[1]); w.y = cvt_pk_bf16(v0[2], v0[3]); w.z = cvt_pk_bf16(v1[0], v1[1]); w.w = cvt_pk_bf16(v1[2], v1[3]);
                        *(u32x4*)(O + (size_t)row * ldc + col) = w;
                    }
                }
            }
    }
};
struct EpiZ {
    static constexpr bool PERM = true, AFTER_DRAIN = false;
    bf16* O; const float* ssq; bf16* HALO;
    __device__ __forceinline__ void operator()(EPI_ARGS) const {
#pragma unroll
        for (int ai = 0; ai < 2; ++ai)
#pragma unroll
            for (int m = 0; m < 4; ++m) {
                const int row = u.pm * 256 + ai * 128 + wr * 64 + m * 16 + fr; const float rs = row_rstd(ssq, row);
#pragma unroll
                for (int bj = 0; bj < 2; ++bj) {
                    const int col = u.pn * 256 + bj * 128 + wc * 32 + fq * 8;
                    if (col < NZ) {
                        const f32x4 v0 = acc[ai][bj][m][0] * rs, v1 = acc[ai][bj][m][1] * rs; u32x4 w;
                        w.x = cvt_pk_bf16(v0[0], v0[1]); w.y = cvt_pk_bf16(v0[2], v0[3]); w.z = cvt_pk_bf16(v1[0], v1[1]); w.w = cvt_pk_bf16(v1[2], v1[3]);
                        *(u32x4*)(O + (size_t)row * ZP + col) = w;
                        if ((row & 63) == 63 && col >= ZD_R && col < ZD_V) *(u32x4*)(HALO + (size_t)(row >> 6) * 1024 + (col - ZD_R)) = w;
                    }
                }
            }
    }
};
struct EpiKV {
    static constexpr bool PERM = true, AFTER_DRAIN = false;
    bf16* Kd; bf16* VT; const float* rstd;
    __device__ __forceinline__ void operator()(EPI_ARGS) const {
#pragma unroll
        for (int ai = 0; ai < 2; ++ai)
#pragma unroll
            for (int m = 0; m < 4; ++m) {
                const int row = u.pm * 256 + ai * 128 + wr * 64 + m * 16 + fr; const float rs = rstd[row];
#pragma unroll
                for (int bj = 0; bj < 2; ++bj) {
                    const int col = u.pn * 256 + bj * 128 + wc * 32 + fq * 8;
                    const f32x4 v0 = acc[ai][bj][m][0] * rs, v1 = acc[ai][bj][m][1] * rs;
                    if (col < D) {
                        u32x4 w; w.x = cvt_pk_bf16(v0[0], v0[1]); w.y = cvt_pk_bf16(v0[2], v0[3]); w.z = cvt_pk_bf16(v1[0], v1[1]); w.w = cvt_pk_bf16(v1[2], v1[3]);
                        *(u32x4*)(Kd + (size_t)row * D + col) = w;
                    } else {
#pragma unroll
                        for (int j = 0; j < 4; ++j) { VT[(size_t)(col - D + j) * MMEM + row] = (bf16)f2bf(v0[j]); VT[(size_t)(col - D + 4 + j) * MMEM + row] = (bf16)f2bf(v1[j]); }
                    }
                }
            }
    }
};
__device__ __forceinline__ size_t stash_idx(int T, int ai, int m, int bj, int wr, int wc, int fr, int fq) { return (size_t)(T * 16 + (ai * 4 + m) * 2 + bj) * 512 + (size_t)((wr * 4 + wc) * 64 + fq * 16 + fr); }
__device__ __forceinline__ u32x2 pack_u8(const float* v) {
    unsigned b[8];
#pragma unroll
    for (int j = 0; j < 8; ++j) b[j] = (unsigned)(v[j] * 255.0f + 0.5f);
    u32x2 w; w.x = b[0] | (b[1] << 8) | (b[2] << 16) | (b[3] << 24); w.y = b[4] | (b[5] << 8) | (b[6] << 16) | (b[7] << 24); return w;
}
__device__ __forceinline__ void unpack_u8(u32x2 w, float* v) {
#pragma unroll
    for (int j = 0; j < 4; ++j) { v[j] = (float)((w.x >> (8 * j)) & 255u) * (1.0f / 255.0f); v[4 + j] = (float)((w.y >> (8 * j)) & 255u) * (1.0f / 255.0f); }
}
struct OwnTile4 {
    int pm, pn0;
    __device__ __forceinline__ bool next(int i, Unit& u) const { if (i >= 4) return false; u.pm = pm; u.pn = 4 * i + pn0; u.job = 0; return true; }
    __device__ __forceinline__ void a_ready(const Unit&) const {}
    __device__ __forceinline__ void done(const Unit&) const {}
    __device__ __forceinline__ const char* baseA(const pg8::Gemm& g, const Unit&) const { return (const char*)g.A; }
    __device__ __forceinline__ const char* baseB(const pg8::Gemm& g, const Unit&) const { return (const char*)g.Bt; }
};
struct EpiGate8 {
    static constexpr bool PERM = true, AFTER_DRAIN = false;
    unsigned char* G8; const float* ssq; const float* bias;
    __device__ __forceinline__ void operator()(EPI_ARGS) const {
        const int br = u.pn >> 2, T = u.pm * 4 + (u.pn & 3);
#pragma unroll
        for (int ai = 0; ai < 2; ++ai)
#pragma unroll
            for (int m = 0; m < 4; ++m) {
                const int row = u.pm * 256 + ai * 128 + wr * 64 + m * 16 + fr; const float rs = row_rstd(ssq, row);
#pragma unroll
                for (int bj = 0; bj < 2; ++bj) {
                    const int col = u.pn * 256 + bj * 128 + wc * 32 + fq * 8; float v[8];
#pragma unroll
                    for (int n = 0; n < 2; ++n) { const f32x4 b = *(const f32x4*)(bias + col + 4 * n);
#pragma unroll
                        for (int j = 0; j < 4; ++j) v[4 * n + j] = sigmoidf_(acc[ai][bj][m][n][j] * rs + b[j]); }
                    *(u32x2*)(G8 + ((size_t)br * 256 * 16 * 512 + stash_idx(T, ai, m, bj, wr, wc, fr, fq)) * 8) = pack_u8(v);
                }
            }
    }
};
struct EpiGlu8 {
    static constexpr bool PERM = true, AFTER_DRAIN = false;
    unsigned char* G8;
    __device__ __forceinline__ void operator()(EPI_ARGS) const {
        const int T = u.pm * 4 + u.pn;
#pragma unroll
        for (int ai = 0; ai < 2; ++ai)
#pragma unroll
            for (int m = 0; m < 4; ++m)
#pragma unroll
                for (int bj = 0; bj < 2; ++bj) {
                    u32x2* p = (u32x2*)(G8 + ((size_t)1 * 256 * 16 * 512 + stash_idx(T, ai, m, bj, wr, wc, fr, fq)) * 8); float g[8]; unpack_u8(*p, g);
#pragma unroll
                    for (int n = 0; n < 2; ++n)
#pragma unroll
                        for (int j = 0; j < 4; ++j) g[4 * n + j] *= sigmoidf_(acc[ai][bj][m][n][j]);
                    *p = pack_u8(g);
                }
    }
};
template <int MODE> struct EpiMerge8 {
    static constexpr bool PERM = true, AFTER_DRAIN = false;
    const unsigned char* G8; int br; bf16* MF; bf16* MG; int ldg;
    __device__ __forceinline__ void operator()(EPI_ARGS) const {
        const int T = u.pm * 4 + u.pn;
#pragma unroll
        for (int ai = 0; ai < 2; ++ai)
#pragma unroll
            for (int m = 0; m < 4; ++m) {
                const int row = u.pm * 256 + ai * 128 + wr * 64 + m * 16 + fr;
#pragma unroll
                for (int bj = 0; bj < 2; ++bj) {
                    const size_t si = stash_idx(T, ai, m, bj, wr, wc, fr, fq); float g[8];
                    unpack_u8(*(const u32x2*)(G8 + ((size_t)br * 256 * 16 * 512 + si) * 8), g);
                    f32x4 v0 = acc[ai][bj][m][0], v1 = acc[ai][bj][m][1];
#pragma unroll
                    for (int j = 0; j < 4; ++j) { v0[j] *= g[j]; v1[j] *= g[4 + j]; }
                    if (MODE != 0) { const u32x4 o = *(const u32x4*)(MF + si * 8); v0[0] += bflo(o.x); v0[1] += bfhi(o.x); v0[2] += bflo(o.y); v0[3] += bfhi(o.y); v1[0] += bflo(o.z); v1[1] += bfhi(o.z); v1[2] += bflo(o.w); v1[3] += bfhi(o.w); }
                    u32x4 w; w.x = cvt_pk_bf16(v0[0], v0[1]); w.y = cvt_pk_bf16(v0[2], v0[3]); w.z = cvt_pk_bf16(v1[0], v1[1]); w.w = cvt_pk_bf16(v1[2], v1[3]);
                    if (MODE != 2) *(u32x4*)(MF + si * 8) = w;
                    else *(u32x4*)(MG + (size_t)row * ldg + u.pn * 256 + bj * 128 + wc * 32 + fq * 8) = w;
                }
            }
    }
};
struct EpiSoftmaxP {
    static constexpr bool PERM = true, AFTER_DRAIN = true;
    bf16* P;
    __device__ __forceinline__ void fused(f32x4 (&acc)[2][2][4][2], const Unit& u, int wr, int wc, int fr, int fq, PG8_LAS unsigned char* lds, int wid, int lane) const {
        PG8_LAS float* RM = (PG8_LAS float*)lds;
        PG8_LAS float* RS = (PG8_LAS float*)(lds + 4096);
#pragma unroll
        for (int ai = 0; ai < 2; ++ai)
#pragma unroll
            for (int m = 0; m < 4; ++m) {
                float mx = -3.0e38f;
#pragma unroll
                for (int bj = 0; bj < 2; ++bj)
#pragma unroll
                    for (int n = 0; n < 2; ++n) { const f32x4 x = acc[ai][bj][m][n]; mx = fmaxf(mx, fmaxf(fmaxf(x[0], x[1]), fmaxf(x[2], x[3]))); }
                mx = fmaxf(mx, shx(mx, 16, fq * 16 + fr)); mx = fmaxf(mx, shx(mx, 32, fq * 16 + fr));
                if (fq == 0) RM[(ai * 128 + wr * 64 + m * 16 + fr) * 4 + wc] = mx;
            }
        asm volatile("s_waitcnt lgkmcnt(0)" ::: "memory"); __builtin_amdgcn_s_barrier(); asm volatile("" ::: "memory");
#pragma unroll
        for (int ai = 0; ai < 2; ++ai)
#pragma unroll
            for (int m = 0; m < 4; ++m) {
                const int rl = ai * 128 + wr * 64 + m * 16 + fr;
                const float mx = fmaxf(fmaxf(RM[rl * 4 + 0], RM[rl * 4 + 1]), fmaxf(RM[rl * 4 + 2], RM[rl * 4 + 3])); float s = 0.f;
#pragma unroll
                for (int bj = 0; bj < 2; ++bj)
#pragma unroll
                    for (int n = 0; n < 2; ++n)
#pragma unroll
                        for (int j = 0; j < 4; ++j) { const float p = __builtin_amdgcn_exp2f(acc[ai][bj][m][n][j] - mx); acc[ai][bj][m][n][j] = p; s += p; }
                s += shx(s, 16, fq * 16 + fr); s += shx(s, 32, fq * 16 + fr);
                if (fq == 0) RS[rl * 4 + wc] = s;
            }
        asm volatile("s_waitcnt lgkmcnt(0)" ::: "memory"); __builtin_amdgcn_s_barrier(); asm volatile("" ::: "memory");
#pragma unroll
        for (int ai = 0; ai < 2; ++ai)
#pragma unroll
            for (int m = 0; m < 4; ++m) {
                const int rl = ai * 128 + wr * 64 + m * 16 + fr;
                const float inv = rcpf_((RS[rl * 4 + 0] + RS[rl * 4 + 1]) + (RS[rl * 4 + 2] + RS[rl * 4 + 3]));
#pragma unroll
                for (int bj = 0; bj < 2; ++bj) {
                    const f32x4 v0 = acc[ai][bj][m][0] * inv, v1 = acc[ai][bj][m][1] * inv; u32x4 w;
                    w.x = cvt_pk_bf16(v0[0], v0[1]); w.y = cvt_pk_bf16(v0[2], v0[3]); w.z = cvt_pk_bf16(v1[0], v1[1]); w.w = cvt_pk_bf16(v1[2], v1[3]);
                    *(u32x4*)(P + (size_t)rl * 256 + bj * 128 + wc * 32 + fq * 8) = w;
                }
            }
        asm volatile("s_waitcnt lgkmcnt(0)" ::: "memory"); __builtin_amdgcn_s_barrier(); asm volatile("" ::: "memory");
    }
};
struct Args { const float* in[N_INPUTS]; float* out; unsigned char* ws; };
typedef const float* cfptr;
typedef __attribute__((address_space(4))) const cfptr* kin_t;
struct Ctx {
    LAS unsigned char* lds; int tid, lane, wave, G, bid;
    kin_t in; float* X; unsigned char* ws;
    __device__ __forceinline__ const float* inp(int i, int l, size_t per_layer) const { return in[i] + (size_t)l * per_layer; }
};
__device__ __forceinline__ Ctx make_ctx() {
    extern __shared__ __attribute__((aligned(16))) unsigned char lds_raw[];
    Ctx C; int t = threadIdx.x; asm volatile("" : "+v"(t));
    kin_t k = (kin_t)__builtin_amdgcn_kernarg_segment_ptr(); asm volatile("" : "+s"(k));
    C.lds = (LAS unsigned char*)lds_raw; C.tid = t; C.lane = t & 63; C.wave = __builtin_amdgcn_readfirstlane(t >> 6);
    C.G = gridDim.x; C.bid = blockIdx.x; C.in = k;
    C.X = (float*)k[N_INPUTS]; C.ws = (unsigned char*)k[N_INPUTS + 1];
    return C;
}
constexpr size_t RWW_OFF = 93 * MiB;
struct ConvDesc { const float* W; const float* gain; bf16* dst; long alt; int ld, ncols, K, NR, kind, item0; };
constexpr int CD_OFF = 124 * 1024, CD_MAX = 24;
enum ConvJob { CJ_GU1 = 1, CJ_D1 = 2, CJ_WIN = 4, CJ_GATES = 8, CJ_PROJ = 16, CJ_XW = 32, CJ_GU2 = 64, CJ_D2 = 128, CJ_XKV0 = 256, CJ_XKV1 = 512, CJ_MLW = 1024, CJ_RWW = 2048, CJ_GU2S = 4096 };
constexpr size_t WS_GU2S = WS_S + 96 * MiB;
static_assert(WS_GU2S + 11 * MiB <= WS_END, "GU2 staging");
__device__ __forceinline__ void cd_put(const Ctx& C, int& n, int& items, const float* W, const float* gain, bf16* dst, long alt, int ld, int ncols, int K, int NR, int kind) {
    if (C.tid == 0) { LAS ConvDesc* d = (LAS ConvDesc*)(C.lds + CD_OFF) + n; d->W = W; d->gain = gain; d->dst = dst; d->alt = alt; d->ld = ld; d->ncols = ncols; d->K = K; d->NR = NR; d->kind = kind; d->item0 = items; }
    items += (K / 64) * (NR / 32); ++n;
}
__device__ __forceinline__ void conv_item(const LAS ConvDesc* d, int it, LAS float* scr, int lane) {
    const int K = d->K, NR = d->NR, kind = d->kind, ld = d->ld, ncols = d->ncols; const float* W = d->W; const float* gain = d->gain; bf16* dst = d->dst; const long alt = d->alt;
    const int nblk = NR / 32, kb = it / nblk, nb = it % nblk, k0 = 64 * kb, n0 = 32 * nb, n = n0 + (lane & 31);
    const float* p = nullptr;
    if (kind == 0) { if (n < ncols) p = W + n; }
    else if (kind == 1) { const int t = n >> 8, cl = n & 255, h = t * 128 + (cl & 127); p = W + (h + ((cl & 128) ? alt : 0l)); }
    else p = W + (n < D ? (long)n : alt + (long)(n - D));
    float v[32];
    if (p) { const float* q = p + (size_t)(k0 + (lane >> 5)) * ld;
#pragma unroll
        for (int i = 0; i < 32; ++i) v[i] = q[(size_t)(2 * i) * ld];
        if (gain) {
#pragma unroll
            for (int i = 0; i < 32; ++i) v[i] *= gain[k0 + 2 * i + (lane >> 5)]; }
    } else {
#pragma unroll
        for (int i = 0; i < 32; ++i) v[i] = 0.f; }
#pragma unroll
    for (int i = 0; i < 32; ++i) scr[(2 * i + (lane >> 5)) * 33 + (lane & 31)] = v[i];
    LDS_WAIT(); asm volatile("" ::: "memory");
    const int c = lane & 7;
#pragma unroll
    for (int j = 0; j < 4; ++j) { const int nn = (lane >> 3) + 8 * j; const LAS float* s = scr + (8 * c) * 33 + nn;
        u32x4 o; o.x = pk2(s[0 * 33], s[1 * 33]); o.y = pk2(s[2 * 33], s[3 * 33]); o.z = pk2(s[4 * 33], s[5 * 33]); o.w = pk2(s[6 * 33], s[7 * 33]);
        *(u32x4*)(dst + (size_t)(n0 + nn) * K + k0 + 8 * c) = o; }
    LDS_WAIT(); asm volatile("" ::: "memory");
}
__device__ __forceinline__ void run_conv(const Ctx& C, int jobs, int l, int gw, int NGW) {
    unsigned char* ws = C.ws; int n = 0, items = 0;
    __syncthreads();
    if (jobs & CJ_GU1) cd_put(C, n, items, C.inp(I_FFN1_WG, l, (size_t)D * FF), C.inp(I_FFN1_NORM, l, D), (bf16*)(ws + WS_SLOTA), (long)(C.inp(I_FFN1_WU, l, (size_t)D * FF) - C.inp(I_FFN1_WG, l, (size_t)D * FF)), FF, 2 * FF, D, 2 * FF, 1);
    if (jobs & CJ_GU2) cd_put(C, n, items, C.inp(I_FFN2_WG, l, (size_t)D * FF), C.inp(I_FFN2_NORM, l, D), (bf16*)(ws + WS_SLOTA), (long)(C.inp(I_FFN2_WU, l, (size_t)D * FF) - C.inp(I_FFN2_WG, l, (size_t)D * FF)), FF, 2 * FF, D, 2 * FF, 1);
    if (jobs & CJ_GU2S) cd_put(C, n, items, C.inp(I_FFN2_WG, l, (size_t)D * FF), C.inp(I_FFN2_NORM, l, D), (bf16*)(ws + WS_GU2S), (long)(C.inp(I_FFN2_WU, l, (size_t)D * FF) - C.inp(I_FFN2_WG, l, (size_t)D * FF)), FF, 2 * FF, D, 2 * FF, 1);
    if (jobs & CJ_D1) cd_put(C, n, items, C.inp(I_FFN1_WD, l, (size_t)D * FF), nullptr, (bf16*)(ws + WS_SLOTC), 0, D, D, FF, D, 0);
    if (jobs & CJ_D2) cd_put(C, n, items, C.inp(I_FFN2_WD, l, (size_t)D * FF), nullptr, (bf16*)(ws + WS_SLOTC), 0, D, D, FF, D, 0);
    if (jobs & CJ_WIN) cd_put(C, n, items, C.inp(I_W_IN, l, (size_t)D * NIN), C.inp(I_MIX_NORM, l, D), (bf16*)(ws + WS_SLOTB), 0, NIN, NZ, D, NINP, 0);
    if (jobs & CJ_GATES) cd_put(C, n, items, C.inp(I_W_IN, l, (size_t)D * NIN) + ZG, C.inp(I_MIX_NORM, l, D), (bf16*)(ws + WS_SLOTA), 0, NIN, 4 * D, D, 4 * D, 0);
    if (jobs & CJ_PROJ) {
        cd_put(C, n, items, C.inp(I_ML_PROJ, l, (size_t)WB * D), nullptr, (bf16*)(ws + WS_SLOTC), 0, D, D, WB, D, 0);
        cd_put(C, n, items, C.inp(I_S5_W1, l, (size_t)WB * D), nullptr, (bf16*)(ws + WS_SLOTC + 1 * MiB), 0, D, D, WB, D, 0);
        cd_put(C, n, items, C.inp(I_S5_W2, l, (size_t)WB * D), nullptr, (bf16*)(ws + WS_SLOTC + 2 * MiB), 0, D, D, WB, D, 0);
        cd_put(C, n, items, C.inp(I_GLA_PROJ, l, (size_t)WB * D), nullptr, (bf16*)(ws + WS_SLOTC + 3 * MiB), 0, D, D, WB, D, 0);
        cd_put(C, n, items, C.inp(I_RW_PROJ, l, (size_t)WB * D), nullptr, (bf16*)(ws + WS_SLOTC + 4 * MiB), 0, D, D, WB, D, 0);
    }
    if (jobs & CJ_XW) {
        cd_put(C, n, items, C.inp(I_W_OUT, l, (size_t)D * D), nullptr, (bf16*)(ws + WS_SLOTB), 0, D, D, D, D, 0);
        cd_put(C, n, items, C.inp(I_XA_WQ, l, (size_t)D * D), C.inp(I_XA_NORM, l, D), (bf16*)(ws + WS_SLOTB + 2 * MiB), 0, D, D, D, D, 0);
        cd_put(C, n, items, C.inp(I_XA_WO, l, (size_t)D * D), nullptr, (bf16*)(ws + WS_SLOTB + 4 * MiB), 0, D, D, D, D, 0);
    }
    if (jobs & CJ_XKV0) cd_put(C, n, items, C.inp(I_XA_WK, 0, (size_t)D * D), C.inp(I_MEM_NORM, 0, D), (bf16*)(ws + WS_S), (long)(C.inp(I_XA_WV, 0, (size_t)D * D) - C.inp(I_XA_WK, 0, (size_t)D * D)), D, 2 * D, D, 2 * D, 2);
    if (jobs & CJ_XKV1) cd_put(C, n, items, C.inp(I_XA_WK, 1, (size_t)D * D), C.inp(I_MEM_NORM, 1, D), (bf16*)(ws + WS_S + 4 * MiB), (long)(C.inp(I_XA_WV, 1, (size_t)D * D) - C.inp(I_XA_WK, 1, (size_t)D * D)), D, 2 * D, D, 2 * D, 2);
    if (jobs & CJ_MLW) {
#pragma unroll
        for (int q = 0; q < 3; ++q)
#pragma unroll
            for (int hh = 0; hh < 4; ++hh) cd_put(C, n, items, C.inp(q == 0 ? I_ML_WQ : (q == 1 ? I_ML_WK : I_ML_WV), l, 4 * 16384) + hh * 16384, nullptr, (bf16*)(ws + 512 * 1024) + (size_t)(q * 4 + hh) * 16384, 0, 128, 128, 128, 128, 0);
    }
    if (jobs & CJ_RWW) {
        bf16* dst = (bf16*)(ws + WS_S + RWW_OFF);
        cd_put(C, n, items, C.inp(I_RW_WUP, l, 64 * WB), nullptr, dst, 0, WB, WB, 64, WB, 0);
        cd_put(C, n, items, C.inp(I_RW_AUP, l, 64 * WB), nullptr, dst + 512 * 64, 0, WB, WB, 64, WB, 0);
        cd_put(C, n, items, C.inp(I_RW_GUP, l, 128 * WB), nullptr, dst + 2 * 512 * 64, 0, WB, WB, 128, WB, 0);
    }
    __syncthreads();
    LAS float* scr = (LAS float*)(C.lds + C.wave * 15360);
    const LAS ConvDesc* cd = (const LAS ConvDesc*)(C.lds + CD_OFF);
    for (int it = gw; it < items; it += NGW) {
        int j = 0;
        for (int q = 1; q < n; ++q) if (it >= cd[q].item0) j = q;
        conv_item(cd + j, it - cd[j].item0, scr, C.lane);
    }
    __syncthreads();
}

__device__ __forceinline__ void pro_rows(const Ctx& C) {
    const int gw = C.bid * 8 + C.wave, NGW = C.G * 8;
    const float* x = C.in[I_X]; bf16* XB = (bf16*)(C.ws + WS_XB); float* ssq = (float*)(C.ws + WS_SSQ);
    for (int m = gw; m < M; m += NGW) {
        const f32x4* xr = (const f32x4*)(x + (size_t)m * D) + C.lane; u32x2* br = (u32x2*)(XB + (size_t)m * D) + C.lane;
        float s = 0.f;
#pragma unroll
        for (int j = 0; j < 4; ++j) { const f32x4 v = xr[64 * j]; u32x2 w; w.x = pk2(v[0], v[1]); w.y = pk2(v[2], v[3]); br[64 * j] = w; s += (v[0] * v[0] + v[1] * v[1]) + (v[2] * v[2] + v[3] * v[3]); }
        s = wave_sum(s, C.lane);
        if (C.lane < 16) ssq[(size_t)m * 16 + C.lane] = (C.lane == 0) ? s : 0.f;
    }
    const float* mem = C.in[I_MEM]; bf16* MB = (bf16*)(C.ws + WS_MEMB); float* memr = (float*)(C.ws + WS_MEMR);
    for (int m = gw; m < MMEM; m += NGW) {
        const f32x4* xr = (const f32x4*)(mem + (size_t)m * D) + C.lane; u32x2* br = (u32x2*)(MB + (size_t)m * D) + C.lane; float s = 0.f;
#pragma unroll
        for (int j = 0; j < 4; ++j) { const f32x4 v = xr[64 * j]; u32x2 w; w.x = pk2(v[0], v[1]); w.y = pk2(v[2], v[3]); br[64 * j] = w; s += (v[0] * v[0] + v[1] * v[1]) + (v[2] * v[2] + v[3] * v[3]); }
        s = wave_sum(s, C.lane);
        if (C.lane == 0) memr[m] = 1.0f / sqrtf(s * (1.0f / D) + NORM_EPS);
    }
}
__device__ __forceinline__ void final_rows(const Ctx& C) {
    const int gw = C.bid * 8 + C.wave, NGW = C.G * 8; const float* ssq = (const float*)(C.ws + WS_SSQ); const float* g = C.in[I_FINAL_NORM];
    for (int m = gw; m < M; m += NGW) {
        const float rs = row_rstd(ssq, m); f32x4* orow = (f32x4*)(C.X + (size_t)m * D) + C.lane; const f32x4* gr = (const f32x4*)g + C.lane;
#pragma unroll
        for (int j = 0; j < 4; ++j) orow[64 * j] = orow[64 * j] * rs * gr[64 * j];
    }
}
__device__ __forceinline__ float ldz(const bf16* Z, int row, int col) { return bf2f(Z[(size_t)row * ZP + col]); }
__device__ __forceinline__ float gelu_tanh(float y) { const float t = 0.7978845608028654f * (y + 0.044715f * y * y * y); return 0.5f * y * (1.0f + tanhf_(t)); }
constexpr int LCH = 64, NCH = SEQ / LCH;
constexpr size_t SO_GLA_ST = 0;
constexpr size_t SO_GLA_G = SO_GLA_ST + 16 * MiB;
constexpr size_t SO_ML_ST = SO_GLA_G + 512 * 1024;
constexpr size_t SO_ML_G = SO_ML_ST + 36 * MiB;
constexpr size_t SO_END0 = SO_ML_G + 512 * 1024;
static_assert(WS_S + SO_END0 <= WS_END, "state region");

__device__ __forceinline__ bf16x8 ld8(const LAS bf16* p) { return *(const LAS bf16x8*)p; }
__device__ __forceinline__ bf16x8 ld8(const bf16* p) { return *(const bf16x8*)p; }
template <int K, class PA, class PB> __device__ __forceinline__ f32x4 tile_mm(PA A, int lda, PB B, int ldb, f32x4 acc, int fr, int fq) {
#pragma unroll
    for (int k0 = 0; k0 < K; k0 += 32) {
        const bf16x8 a = ld8(A + fr * lda + k0 + 8 * fq);
        const bf16x8 b = ld8(B + fr * ldb + k0 + 8 * fq);
        acc = __builtin_amdgcn_mfma_f32_16x16x32_bf16(a, b, acc, 0, 0, 0);
    }
    return acc;
}
#define F4Z ((f32x4){0.f, 0.f, 0.f, 0.f})
__device__ __forceinline__ u32x2 pack4(f32x4 v) { u32x2 w; w.x = pk2(v[0], v[1]); w.y = pk2(v[2], v[3]); return w; }
__device__ __forceinline__ void unpack8(u32x4 w, float* f) { f[0] = bflo(w.x); f[1] = bfhi(w.x); f[2] = bflo(w.y); f[3] = bfhi(w.y); f[4] = bflo(w.z); f[5] = bfhi(w.z); f[6] = bflo(w.w); f[7] = bfhi(w.w); }

struct Touch { u32x4 a, b, c; };
__device__ __forceinline__ void touch_tile(Touch& T, const bf16* base, int rows, int ppr, int tid) {
    const u32x4 z = (u32x4){0u, 0u, 0u, 0u}; T.a = z; T.b = z; T.c = z; const int n = rows * ppr;
    if (tid < n) T.a = *(const u32x4*)(base + (size_t)(tid / ppr) * ZP + (tid % ppr) * 8);
    if (tid + 512 < n) T.b = *(const u32x4*)(base + (size_t)((tid + 512) / ppr) * ZP + ((tid + 512) % ppr) * 8);
    if (tid + 1024 < n) T.c = *(const u32x4*)(base + (size_t)((tid + 1024) / ppr) * ZP + ((tid + 1024) % ppr) * 8);
}
__device__ __forceinline__ void touch_sink(const Touch& T) { asm volatile("" :: "v"(T.a), "v"(T.b), "v"(T.c)); }
__device__ __forceinline__ void gla_cumdecay(const Ctx& C, int l, int h, int rowb, LAS float* ALOW, LAS float* LA, LAS float* SEG) {
    const bf16* Z = (const bf16*)(C.ws + WS_Z);
    const float* aup = C.inp(I_GLA_AUP, l, 16 * 256) + h * 64; const float* abias = C.inp(I_GLA_ABIAS, l, 256) + h * 64;
    const int tid = C.tid;
    for (int i = tid; i < 64 * 16; i += 512) ALOW[i] = ldz(Z, rowb + (i >> 4), ZC_A + (i & 15));
    __syncthreads();
    {   const int k = tid & 63, seg = tid >> 6; float au[16], run = 0.f, v[8];
#pragma unroll
        for (int r = 0; r < 16; ++r) au[r] = aup[r * 256 + k];
        const float bk = abias[k];
#pragma unroll
        for (int i = 0; i < 8; ++i) { const int t = seg * 8 + i; float s = bk;
#pragma unroll
            for (int r = 0; r < 16; ++r) s += ALOW[t * 16 + r] * au[r];
            run += logsigmoidf_(s) * (1.0f / 16.0f); v[i] = run; }
        SEG[seg * 64 + k] = run;
        __syncthreads();
        float off = 0.f;
        for (int s2 = 0; s2 < seg; ++s2) off += SEG[s2 * 64 + k];
#pragma unroll
        for (int i = 0; i < 8; ++i) LA[(seg * 8 + i) * 64 + k] = v[i] + off;
    }
    __syncthreads();
}
constexpr int LDT = 72;
__device__ __forceinline__ void gla_passA(const Ctx& C, int l, int item) {
    const int bh = item >> 6, c = item & 63, b = bh >> 2, h = bh & 3, rowb = b * SEQ + c * LCH;
    const bf16* Z = (const bf16*)(C.ws + WS_Z);
    LAS float* ALOW = (LAS float*)C.lds; LAS float* LA = ALOW + 1024; LAS float* SEG = LA + 4096;
    LAS bf16* VT = (LAS bf16*)(SEG + 512);
    LAS bf16* KT = VT + 128 * LDT;
    const int tid = C.tid, lane = C.lane, w = C.wave, fr = lane & 15, fq = lane >> 4;
    gla_cumdecay(C, l, h, rowb, ALOW, LA, SEG);
    for (int i = tid; i < 64 * 16; i += 512) { const int t = i >> 4, v0 = (i & 15) * 8; float f[8];
        unpack8(*(const u32x4*)(Z + (size_t)(rowb + t) * ZP + ZC_V + h * 128 + v0), f);
#pragma unroll
        for (int j = 0; j < 8; ++j) VT[(v0 + j) * LDT + t] = (bf16)f2bf(f[j]); }
    {   const int t = tid >> 3, k0 = (tid & 7) * 8; float f[8];
        unpack8(*(const u32x4*)(Z + (size_t)(rowb + t) * ZP + ZC_K + h * 64 + k0), f);
#pragma unroll
        for (int j = 0; j < 8; ++j) KT[(k0 + j) * LDT + t] = (bf16)f2bf(f[j] * __expf(LA[63 * 64 + k0 + j] - LA[t * 64 + k0 + j])); }
    if (tid < 64) ((float*)(C.ws + WS_S + SO_GLA_G))[(size_t)item * 64 + tid] = __expf(LA[63 * 64 + tid]);
    __syncthreads();
    bf16* ST = (bf16*)(C.ws + WS_S + SO_GLA_ST) + (size_t)item * 8192;
#pragma unroll
    for (int q = 0; q < 4; ++q) {
        const f32x4 acc = tile_mm<64>(KT + (16 * q) * LDT, LDT, VT + (16 * w) * LDT, LDT, F4Z, fr, fq);
        *(u32x2*)(ST + (size_t)(16 * w + fr) * 64 + 16 * q + 4 * fq) = pack4(acc);
    }
    __syncthreads();
}
__device__ __forceinline__ void gla_passB(const Ctx& C, int tidx, int NT) {
    for (int idx = tidx; idx < 16 * 8192; idx += NT) {
    const int bh = idx >> 13, e = idx & 8191, k = e & 63;
    bf16* ST = (bf16*)(C.ws + WS_S + SO_GLA_ST) + (size_t)bh * 64 * 8192 + e; const float* G = (const float*)(C.ws + WS_S + SO_GLA_G) + (size_t)bh * 64 * 64 + k;
    float d[64], g[64];
#pragma unroll
    for (int c = 0; c < 64; ++c) { d[c] = bf2f(ST[(size_t)c * 8192]); g[c] = G[c * 64]; }
    float run = 0.f;
#pragma unroll
    for (int c = 0; c < 64; ++c) { ST[(size_t)c * 8192] = (bf16)f2bf(run); run = run * g[c] + d[c]; }
    }
}
template <bool DRY = false> __device__ __forceinline__ void gla_passC(const Ctx& C, int l, int item) {
    const int bh = item >> 6, c = item & 63, b = bh >> 2, h = bh & 3, rowb = b * SEQ + c * LCH;
    bf16* Z = (bf16*)(C.ws + WS_Z);
    LAS float* ALOW = (LAS float*)C.lds; LAS float* LA = ALOW + 1024; LAS float* SEG = LA + 4096;
    LAS bf16* VT = (LAS bf16*)(SEG + 512);
    LAS bf16* QP = VT + 128 * LDT;
    LAS bf16* KP = QP + 64 * LDT;
    LAS bf16* ATT = KP + 64 * LDT;
    LAS float* O = (LAS float*)(ATT + 64 * LDT);
    LAS float* RSQ = O + 64 * 132;
    const int tid = C.tid, lane = C.lane, w = C.wave, fr = lane & 15, fq = lane >> 4;
    const bf16* ST = (const bf16*)(C.ws + WS_S + SO_GLA_ST) + (size_t)item * 8192;
    bf16x8 stf[4][2];
#pragma unroll
    for (int q = 0; q < 4; ++q) { const int vv = (4 * w + q) >> 2; stf[q][0] = ld8(ST + (size_t)(16 * vv + fr) * 64 + 8 * fq); stf[q][1] = ld8(ST + (size_t)(16 * vv + fr) * 64 + 32 + 8 * fq); }
    gla_cumdecay(C, l, h, rowb, ALOW, LA, SEG);
    for (int i = tid; i < 64 * 16; i += 512) { const int t = i >> 4, v0 = (i & 15) * 8; float f[8];
        unpack8(*(const u32x4*)(Z + (size_t)(rowb + t) * ZP + ZC_V + h * 128 + v0), f);
#pragma unroll
        for (int j = 0; j < 8; ++j) VT[(v0 + j) * LDT + t] = (bf16)f2bf(f[j]); }
    {   const int t = tid >> 3, k0 = (tid & 7) * 8; float fq_[8], fk_[8];
        unpack8(*(const u32x4*)(Z + (size_t)(rowb + t) * ZP + ZC_Q + h * 64 + k0), fq_);
        unpack8(*(const u32x4*)(Z + (size_t)(rowb + t) * ZP + ZC_K + h * 64 + k0), fk_);
        u32x4 wq, wk; float eq[8], ek[8];
#pragma unroll
        for (int j = 0; j < 8; ++j) { const float bb = LA[t * 64 + k0 + j]; eq[j] = fq_[j] * 0.125f * __expf(bb); ek[j] = fk_[j] * __expf(-bb); }
        wq.x = pk2(eq[0], eq[1]); wq.y = pk2(eq[2], eq[3]); wq.z = pk2(eq[4], eq[5]); wq.w = pk2(eq[6], eq[7]);
        wk.x = pk2(ek[0], ek[1]); wk.y = pk2(ek[2], ek[3]); wk.z = pk2(ek[4], ek[5]); wk.w = pk2(ek[6], ek[7]);
        *(LAS u32x4*)(QP + t * LDT + k0) = wq; *(LAS u32x4*)(KP + t * LDT + k0) = wk; }
    __syncthreads();
#pragma unroll
    for (int q = 0; q < 2; ++q) {
        const int id = 2 * w + q, tt = id >> 2, ss = id & 3; f32x4 acc = F4Z;
        if (ss <= tt) acc = tile_mm<64>(KP + (16 * ss) * LDT, LDT, QP + (16 * tt) * LDT, LDT, acc, fr, fq);
        const int t = 16 * tt + fr, s0 = 16 * ss + 4 * fq;
#pragma unroll
        for (int r = 0; r < 4; ++r) if (s0 + r > t) acc[r] = 0.f;
        *(LAS u32x2*)(ATT + t * LDT + s0) = pack4(acc);
    }
    __syncthreads();
#pragma unroll
    for (int q = 0; q < 4; ++q) {
        const int id = 4 * w + q, tt = id & 3, vv = id >> 2;
        f32x4 acc = __builtin_amdgcn_mfma_f32_16x16x32_bf16(stf[q][0], ld8(QP + (16 * tt + fr) * LDT + 8 * fq), F4Z, 0, 0, 0);
        acc = __builtin_amdgcn_mfma_f32_16x16x32_bf16(stf[q][1], ld8(QP + (16 * tt + fr) * LDT + 32 + 8 * fq), acc, 0, 0, 0);
        acc = tile_mm<64>(VT + (16 * vv) * LDT, LDT, ATT + (16 * tt) * LDT, LDT, acc, fr, fq);
        *(LAS f32x4*)(O + (16 * tt + fr) * 132 + 16 * vv + 4 * fq) = acc;
    }
    __syncthreads();
    {
#pragma unroll
        for (int i = 0; i < 8; ++i) { const int t = 8 * w + i; const float h0 = O[t * 132 + lane], h1 = O[t * 132 + lane + 64];
            const float ss = wave_sum(h0 * h0 + h1 * h1, lane); if (lane == 0) RSQ[t] = rsqf_(ss * (1.0f / 128) + NORM_EPS); }
    }
    __syncthreads();
    for (int i = tid; i < 64 * 16; i += 512) { const int t = i >> 4, v0 = (i & 15) * 8; float g[8]; const float rs = RSQ[t];
        bf16* zp = Z + (size_t)(rowb + t) * ZP + ZC_G + h * 128 + v0; unpack8(*(const u32x4*)zp, g);
        const float* gn = C.inp(I_GLA_NORM, l, WB) + h * 128 + v0; float o[8];
#pragma unroll
        for (int j = 0; j < 8; ++j) o[j] = O[t * 132 + v0 + j] * rs * gn[j] * siluf_(g[j]);
        u32x4 wv; wv.x = pk2(o[0], o[1]); wv.y = pk2(o[2], o[3]); wv.z = pk2(o[4], o[5]); wv.w = pk2(o[6], o[7]);
        if (!DRY) *(u32x4*)zp = wv; else asm volatile("" :: "v"(wv)); }
    __syncthreads();
}

constexpr size_t WS_MLW = 512 * 1024;
constexpr int LDU = 152, LDE = 136;
__device__ __forceinline__ float wave_incl_scan(float v, int lane) {
#pragma unroll
    for (int o = 1; o < 64; o <<= 1) { const float n = __builtin_bit_cast(float, __builtin_amdgcn_ds_bpermute(((lane - o) & 63) << 2, __builtin_bit_cast(int, v))); if (lane >= o) v += n; }
    return v;
}
__device__ __forceinline__ void ml_front(const Ctx& C, int l, int b, int h, int c, LAS bf16* UC, LAS bf16* U, LAS float* GB, LAS float* GI) {
    const bf16* Z = (const bf16*)(C.ws + WS_Z); const int t0 = c * LCH, rowb = b * SEQ + t0, tid = C.tid;
    const float* conv = C.inp(I_ML_CONV, l, 4 * WB) + h * 128;
    for (int i = tid; i < 64 * 16; i += 512) { const int t = i >> 4, e0 = (i & 15) * 8; float s[8], x[8];
#pragma unroll
        for (int j = 0; j < 8; ++j) s[j] = 0.f;
#pragma unroll
        for (int d = 0; d < 4; ++d) {
            if (t0 + t - 3 + d >= 0) { unpack8(*(const u32x4*)(Z + (size_t)(rowb + t - 3 + d) * ZP + ZA_U + h * 128 + e0), x);
#pragma unroll
                for (int j = 0; j < 8; ++j) s[j] += conv[d * WB + e0 + j] * x[j]; }
        }
        u32x4 wu, wc; wu.x = pk2(x[0], x[1]); wu.y = pk2(x[2], x[3]); wu.z = pk2(x[4], x[5]); wu.w = pk2(x[6], x[7]);
#pragma unroll
        for (int j = 0; j < 8; ++j) s[j] = siluf_(s[j]);
        wc.x = pk2(s[0], s[1]); wc.y = pk2(s[2], s[3]); wc.z = pk2(s[4], s[5]); wc.w = pk2(s[6], s[7]);
        *(LAS u32x4*)(U + t * LDU + e0) = wu; *(LAS u32x4*)(UC + t * LDU + e0) = wc; }
    if (C.wave == 0) { const int t = C.lane;
        const float li = ldz(Z, rowb + t, ZA_I + h) + C.inp(I_ML_BI, l, 4)[h]; const float lf = logsigmoidf_(ldz(Z, rowb + t, ZA_F + h) + C.inp(I_ML_BF, l, 4)[h]);
        GB[t] = wave_incl_scan(lf, C.lane); GI[t] = li; }
    __syncthreads();
}
__device__ __forceinline__ void ml_passA(const Ctx& C, int l, int item, int next_item = -1) {
    const int bh = item >> 6, c = item & 63, b = bh >> 2, h = bh & 3;
    Touch TT; { const int nb = next_item >> 6, nc = next_item & 63, r0 = (nb >> 2) * SEQ + nc * LCH;
        if (next_item >= 0) touch_tile(TT, (const bf16*)(C.ws + WS_Z) + (size_t)r0 * ZP + ZA_U + (nb & 3) * 128, 64, 16, C.tid); else { const u32x4 z = (u32x4){0u, 0u, 0u, 0u}; TT.a = z; TT.b = z; TT.c = z; } }
    LAS bf16* UC = (LAS bf16*)C.lds; LAS bf16* U = UC + 64 * LDU; LAS bf16* KT = U + 64 * LDU;
    LAS bf16* VT = KT + 128 * LDT;
    LAS float* GB = (LAS float*)(VT + 144 * LDT); LAS float* GI = GB + 64; LAS float* WA = GI + 64;
    const int tid = C.tid, lane = C.lane, w = C.wave, fr = lane & 15, fq = lane >> 4;
    ml_front(C, l, b, h, c, UC, U, GB, GI);
    if (tid < 64) WA[tid] = __expf(GB[63] - GB[tid] + GI[tid]) * 0.08838834764831845f;
    for (int i = tid; i < 16 * LDT; i += 512) VT[128 * LDT + i] = (i < LDT) ? (bf16)0x3f80 : (bf16)0;
    __syncthreads();
    const bf16* WK = (const bf16*)(C.ws + WS_MLW) + (size_t)(4 + h) * 16384; const bf16* WV = (const bf16*)(C.ws + WS_MLW) + (size_t)(8 + h) * 16384;
#pragma unroll
    for (int q = 0; q < 4; ++q) {
        const int id = 4 * w + q, tt = id & 3, ee = id >> 2;
        f32x4 ak = tile_mm<128>(UC + (16 * tt) * LDU, LDU, WK + (size_t)(16 * ee) * 128, 128, F4Z, fr, fq);
        f32x4 av = tile_mm<128>(U + (16 * tt) * LDU, LDU, WV + (size_t)(16 * ee) * 128, 128, F4Z, fr, fq);
        const int t = 16 * tt + 4 * fq;
#pragma unroll
        for (int r = 0; r < 4; ++r) ak[r] *= WA[t + r];
        *(LAS u32x2*)(KT + (16 * ee + fr) * LDT + t) = pack4(ak); *(LAS u32x2*)(VT + (16 * ee + fr) * LDT + t) = pack4(av);
    }
    if (tid == 0) ((float*)(C.ws + WS_S + SO_ML_G))[item] = __expf(GB[63]);
    __syncthreads();
    bf16* ST = (bf16*)(C.ws + WS_S + SO_ML_ST) + (size_t)item * (144 * 128);
    for (int id = w; id < 72; id += 8) {
        const int ee = id & 7, vv = id >> 3;
        const f32x4 acc = tile_mm<64>(KT + (16 * ee) * LDT, LDT, VT + (16 * vv) * LDT, LDT, F4Z, fr, fq);
        *(u32x2*)(ST + (size_t)(16 * vv + fr) * 128 + 16 * ee + 4 * fq) = pack4(acc);
    }
    touch_sink(TT);
    __syncthreads();
}
__device__ __forceinline__ void ml_passB(const Ctx& C, int tidx, int NT) {
    for (int idx = tidx; idx < 16 * 18432; idx += NT) {
        const int bh = idx / 18432, e = idx % 18432;
        bf16* ST = (bf16*)(C.ws + WS_S + SO_ML_ST) + (size_t)bh * 64 * 18432 + e; const float* G = (const float*)(C.ws + WS_S + SO_ML_G) + bh * 64;
        float d[64], g[64];
#pragma unroll
        for (int c = 0; c < 64; ++c) { d[c] = bf2f(ST[(size_t)c * 18432]); g[c] = G[c]; }
        float run = 0.f;
#pragma unroll
        for (int c = 0; c < 64; ++c) { ST[(size_t)c * 18432] = (bf16)f2bf(run); run = run * g[c] + d[c]; }
    }
}
template <bool DRY = false> __device__ __forceinline__ void ml_passC(const Ctx& C, int l, int item, int next_item = -1) {
    const int bh = item >> 6, c = item & 63, b = bh >> 2, h = bh & 3, rowb = b * SEQ + c * LCH;
    Touch TT; { const int nb = next_item >> 6, nc = next_item & 63, r0 = (nb >> 2) * SEQ + nc * LCH;
        if (next_item >= 0) touch_tile(TT, (const bf16*)(C.ws + WS_Z) + (size_t)r0 * ZP + ZA_U + (nb & 3) * 128, 64, 16, C.tid); else { const u32x4 z = (u32x4){0u, 0u, 0u, 0u}; TT.a = z; TT.b = z; TT.c = z; } }
    bf16* Z = (bf16*)(C.ws + WS_Z);
    LAS bf16* UC = (LAS bf16*)C.lds; LAS bf16* U = UC + 64 * LDU; LAS bf16* Q = U + 64 * LDU;
    LAS bf16* K = Q + 64 * LDE;
    LAS bf16* VT = K + 64 * LDE;
    LAS bf16* W = VT + 144 * LDT;
    LAS float* GB = (LAS float*)(W + 64 * LDT); LAS float* GI = GB + 64; LAS float* RF = GI + 64; LAS float* CF = RF + 64; LAS float* RSQ = CF + 64;
    LAS float* O = (LAS float*)C.lds;
    const int tid = C.tid, lane = C.lane, w = C.wave, fr = lane & 15, fq = lane >> 4;
    const bf16* ST = (const bf16*)(C.ws + WS_S + SO_ML_ST) + (size_t)item * (144 * 128);
    bf16x8 stf[5][4];
#pragma unroll
    for (int q = 0; q < 5; ++q) { const int id = w + 8 * q, vv = id >> 2;
#pragma unroll
        for (int k4 = 0; k4 < 4; ++k4) stf[q][k4] = (id < 36) ? ld8(ST + (size_t)(16 * vv + fr) * 128 + 32 * k4 + 8 * fq) : (bf16x8){0, 0, 0, 0, 0, 0, 0, 0}; }
    ml_front(C, l, b, h, c, UC, U, GB, GI);
    if (tid < 64) { RF[tid] = __expf(GB[tid]); CF[tid] = __expf(GI[tid] - GB[tid]) * 0.08838834764831845f; }
    for (int i = tid; i < 16 * LDT; i += 512) VT[128 * LDT + i] = (i < LDT) ? (bf16)0x3f80 : (bf16)0;
    const bf16* WQ = (const bf16*)(C.ws + WS_MLW) + (size_t)h * 16384; const bf16* WK = WQ + 4 * 16384; const bf16* WV = WQ + 8 * 16384;
#pragma unroll
    for (int q = 0; q < 4; ++q) {
        const int id = 4 * w + q, tt = id & 3, ee = id >> 2;
        const f32x4 aq = tile_mm<128>(WQ + (size_t)(16 * ee) * 128, 128, UC + (16 * tt) * LDU, LDU, F4Z, fr, fq);
        const f32x4 ak = tile_mm<128>(WK + (size_t)(16 * ee) * 128, 128, UC + (16 * tt) * LDU, LDU, F4Z, fr, fq);
        *(LAS u32x2*)(Q + (16 * tt + fr) * LDE + 16 * ee + 4 * fq) = pack4(aq); *(LAS u32x2*)(K + (16 * tt + fr) * LDE + 16 * ee + 4 * fq) = pack4(ak);
        const f32x4 av = tile_mm<128>(U + (16 * tt) * LDU, LDU, WV + (size_t)(16 * ee) * 128, 128, F4Z, fr, fq);
        *(LAS u32x2*)(VT + (16 * ee + fr) * LDT + 16 * tt + 4 * fq) = pack4(av);
    }
    __syncthreads();
#pragma unroll
    for (int q = 0; q < 2; ++q) {
        const int id = 2 * w + q, tt = id >> 2, ss = id & 3; f32x4 acc = F4Z;
        if (ss <= tt) acc = tile_mm<128>(K + (16 * ss) * LDE, LDE, Q + (16 * tt) * LDE, LDE, acc, fr, fq);
        const int t = 16 * tt + fr, s0 = 16 * ss + 4 * fq; const float rf = RF[t];
#pragma unroll
        for (int r = 0; r < 4; ++r) acc[r] = (s0 + r > t) ? 0.f : acc[r] * rf * CF[s0 + r];
        *(LAS u32x2*)(W + t * LDT + s0) = pack4(acc);
    }
    __syncthreads();
    f32x4 res[5];
#pragma unroll
    for (int q = 0; q < 5; ++q) {
        const int id = w + 8 * q, tt = id & 3, vv = id >> 2; res[q] = F4Z;
        if (id < 36) {
            f32x4 acc = F4Z;
#pragma unroll
            for (int k4 = 0; k4 < 4; ++k4) acc = __builtin_amdgcn_mfma_f32_16x16x32_bf16(stf[q][k4], ld8(Q + (16 * tt + fr) * LDE + 32 * k4 + 8 * fq), acc, 0, 0, 0);
            acc *= RF[16 * tt + fr];
            res[q] = tile_mm<64>(VT + (16 * vv) * LDT, LDT, W + (16 * tt) * LDT, LDT, acc, fr, fq);
        }
    }
    __syncthreads();
#pragma unroll
    for (int q = 0; q < 5; ++q) { const int id = w + 8 * q, tt = id & 3, vv = id >> 2; if (id < 36) *(LAS f32x4*)(O + (16 * tt + fr) * 148 + 16 * vv + 4 * fq) = res[q]; }
    __syncthreads();
    {
#pragma unroll
        for (int i = 0; i < 8; ++i) { const int t = 8 * w + i; const float inv = rcpf_(fmaxf(fabsf(O[t * 148 + 128]), 1.0f));
            const float h0 = O[t * 148 + lane] * inv, h1 = O[t * 148 + lane + 64] * inv;
            const float ss = wave_sum(h0 * h0 + h1 * h1, lane); if (lane == 0) RSQ[t] = inv * rsqf_(ss * (1.0f / 128) + NORM_EPS); }
    }
    __syncthreads();
    for (int i = tid; i < 64 * 16; i += 512) { const int t = i >> 4, v0 = (i & 15) * 8; float g[8]; const float rs = RSQ[t];
        bf16* zp = Z + (size_t)(rowb + t) * ZP + ZA_O + h * 128 + v0; unpack8(*(const u32x4*)zp, g);
        const float* gn = C.inp(I_ML_NORM, l, WB) + h * 128 + v0; float o[8];
#pragma unroll
        for (int j = 0; j < 8; ++j) o[j] = O[t * 148 + v0 + j] * rs * gn[j] * sigmoidf_(g[j]);
        u32x4 wv; wv.x = pk2(o[0], o[1]); wv.y = pk2(o[2], o[3]); wv.z = pk2(o[4], o[5]); wv.w = pk2(o[6], o[7]);
        if (!DRY) *(u32x4*)zp = wv; else asm volatile("" :: "v"(wv)); }
    touch_sink(TT);
    __syncthreads();
}

constexpr size_t SO_S5_K = SO_END0;
constexpr size_t SO_S5_BB = SO_S5_K + 1 * MiB;
constexpr size_t SO_S5_PM = SO_S5_BB + 256 * 1024;
constexpr size_t SO_S5_POW = SO_S5_PM + 512 * 1024;
constexpr size_t SO_S5_E = SO_S5_POW + 1280 * 1024;
constexpr size_t SO_END1 = SO_S5_E + 4 * MiB;
static_assert(WS_S + SO_END1 <= WS_END, "state region");
__device__ __forceinline__ void s5_prep(const Ctx& C, int l, int g) {
    LAS float* BBr = (LAS float*)C.lds; LAS float* BBi = BBr + 1024; LAS float* PW = BBi + 1024; LAS float* CR = PW + 65 * 128; LAS float* CI = CR + 1024;
    LAS bf16* BT = (LAS bf16*)(CI + 1024);
    LAS bf16* WT = BT + 16 * 136 + C.wave * (16 * 136);
    const int tid = C.tid, lane = C.lane, w = C.wave, fr = lane & 15, fq = lane >> 4;
    if (tid < 64) { const int p = tid;
        const float are = C.inp(I_S5_ARE, l, 32 * 64)[g * 64 + p], aim = C.inp(I_S5_AIM, l, 32 * 64)[g * 64 + p];
        const float step = expf(C.inp(I_S5_LOGSTEP, l, 32)[g]); const float lre = fminf(are, -1e-4f), lim = aim;
        const float mag = expf(lre * step), bre = mag * cosf(lim * step), bim = mag * sinf(lim * step), den = lre * lre + lim * lim;
        const float cre = ((bre - 1.0f) * lre + bim * lim) / den, cim = (bim * lre - (bre - 1.0f) * lim) / den;
        const float* br = C.inp(I_S5_BRE, l, 32 * 64 * 16) + (size_t)(g * 64 + p) * 16; const float* bi = C.inp(I_S5_BIM, l, 32 * 64 * 16) + (size_t)(g * 64 + p) * 16;
        for (int c = 0; c < 16; ++c) { BBr[p * 16 + c] = cre * br[c] - cim * bi[c]; BBi[p * 16 + c] = cre * bi[c] + cim * br[c]; }
        float pr = 1.f, pi = 0.f;
        for (int n = 0; n <= 64; ++n) { PW[(n * 64 + p) * 2] = pr; PW[(n * 64 + p) * 2 + 1] = pi; const float nr = pr * bre - pi * bim, ni = pr * bim + pi * bre; pr = nr; pi = ni; }
    }
    for (int i = tid; i < 1024; i += 512) { CR[i] = C.inp(I_S5_CRE, l, 32 * 1024)[g * 1024 + i]; CI[i] = C.inp(I_S5_CIM, l, 32 * 1024)[g * 1024 + i]; }
    __syncthreads();
    unsigned char* S = C.ws + WS_S;
    float* POW = (float*)(S + SO_S5_POW) + (size_t)g * 65 * 128;
    for (int i = tid; i < 65 * 128; i += 512) POW[i] = PW[i];
    bf16* BB = (bf16*)(S + SO_S5_BB) + (size_t)g * 128 * 32;
    for (int i = tid; i < 128 * 32; i += 512) { const int row = i >> 5, c = i & 31, pp = row >> 5, ri = (row >> 4) & 1, p = 16 * pp + (row & 15);
        BB[i] = (bf16)f2bf(c < 16 ? (ri ? BBi[p * 16 + c] : BBr[p * 16 + c]) : 0.f); }
    bf16* PM = (bf16*)(S + SO_S5_PM) + (size_t)g * 64 * 128;
    for (int i = tid; i < 64 * 128; i += 512) { const int t = i >> 7, k = i & 127, ri = k >> 6, p = k & 63;
        PM[i] = (bf16)f2bf(ri ? -PW[((t + 1) * 64 + p) * 2 + 1] : PW[((t + 1) * 64 + p) * 2]); }
    for (int i = tid; i < 16 * 128; i += 512) { const int c = i >> 7, k = i & 127, ri = k >> 6, p = k & 63; BT[c * 136 + k] = (bf16)f2bf(ri ? -BBi[p * 16 + c] : BBr[p * 16 + c]); }
    __syncthreads();
    bf16* KM = (bf16*)(S + SO_S5_K) + (size_t)g * 16 * 1024;
#pragma unroll 1
    for (int tau = w; tau < 64; tau += 8) {
        const float pr = PW[(tau * 64 + lane) * 2], pi = PW[(tau * 64 + lane) * 2 + 1];
#pragma unroll
        for (int cp = 0; cp < 16; ++cp) { const float cr = CR[cp * 64 + lane], ci = CI[cp * 64 + lane];
            WT[cp * 136 + lane] = (bf16)f2bf(cr * pr - ci * pi); WT[cp * 136 + 64 + lane] = (bf16)f2bf(cr * pi + ci * pr); }
        LDS_WAIT(); __builtin_amdgcn_wave_barrier();
        const f32x4 acc = tile_mm<128>(BT, 136, WT, 136, F4Z, fr, fq);
        *(u32x2*)(KM + (size_t)fr * 1024 + tau * 16 + 4 * fq) = pack4(acc);
        LDS_WAIT(); __builtin_amdgcn_wave_barrier();
    }
    __syncthreads();
}
__device__ __forceinline__ void s5_passA(const Ctx& C) {
    const int g = C.bid >> 3, sb = C.bid & 7, lane = C.lane, fr = lane & 15, fq = lane >> 4, tid = C.tid;
    const bf16* Z = (const bf16*)(C.ws + WS_Z); unsigned char* S = C.ws + WS_S;
    LAS bf16* BBL = (LAS bf16*)(C.lds + 65536);
    LAS float* POWL = (LAS float*)(C.lds + 65536 + 8192);
    {   const u32x4* src = (const u32x4*)((const bf16*)(S + SO_S5_BB) + (size_t)g * 128 * 32); LAS u32x4* dst = (LAS u32x4*)BBL; dst[tid] = src[tid];
        const u32x4* ps = (const u32x4*)((const float*)(S + SO_S5_POW) + (size_t)g * 65 * 128); LAS u32x4* pd = (LAS u32x4*)POWL;
        for (int i = tid; i < 65 * 128 / 4; i += 512) pd[i] = ps[i]; }
    __syncthreads();
    LAS bf16* UA = (LAS bf16*)(C.lds + C.wave * 8192);
#pragma unroll 1
    for (int i4 = 0; i4 < 4; ++i4) {
        const int j = sb * 32 + C.wave * 4 + i4, b = j >> 6, c = j & 63, item = (b * 32 + g) * 64 + c, rowb = b * SEQ + c * LCH;
        {   const u32x4* src = (const u32x4*)(Z + (size_t)(rowb + lane) * ZP + ZB_U + g * 16); const u32x4 z4 = (u32x4){0u, 0u, 0u, 0u};
            LAS u32x4* dst = (LAS u32x4*)(UA + lane * 40); dst[0] = src[0]; dst[1] = src[1]; dst[2] = z4; dst[3] = z4; }
        LDS_WAIT(); __builtin_amdgcn_wave_barrier();
        float* E = (float*)(S + SO_S5_E) + (size_t)item * 128;
#pragma unroll
        for (int pp = 0; pp < 4; ++pp) { float er = 0.f, ei = 0.f; const int p = 16 * pp + fr;
#pragma unroll
            for (int tt = 0; tt < 4; ++tt) {
                const f32x4 br = tile_mm<32>(UA + (16 * tt) * 40, 40, BBL + (pp * 32) * 32, 32, F4Z, fr, fq);
                const f32x4 bi = tile_mm<32>(UA + (16 * tt) * 40, 40, BBL + (pp * 32 + 16) * 32, 32, F4Z, fr, fq);
#pragma unroll
                for (int r = 0; r < 4; ++r) { const int t = 16 * tt + 4 * fq + r; const f32x2 pw = *(const LAS f32x2*)(POWL + ((63 - t) * 64 + p) * 2);
                    er += pw.x * br[r] - pw.y * bi[r]; ei += pw.x * bi[r] + pw.y * br[r]; }
            }
            er += shx(er, 16, lane); er += shx(er, 32, lane); ei += shx(ei, 16, lane); ei += shx(ei, 32, lane);
            if (fq == 0) { E[p] = er; E[64 + p] = ei; }
        }
        LDS_WAIT(); __builtin_amdgcn_wave_barrier();
    }
    __syncthreads();
}
__device__ __forceinline__ void s5_passB(const Ctx& C, int tidx, int NT) {
    for (int idx = tidx; idx < 8192; idx += NT) {
    const int bg = idx >> 6, p = idx & 63, g = bg & 31; unsigned char* S = C.ws + WS_S;
    const f32x2 l64 = *(const f32x2*)((const float*)(S + SO_S5_POW) + (size_t)g * 65 * 128 + (64 * 64 + p) * 2);
    float* E = (float*)(S + SO_S5_E) + (size_t)bg * 64 * 128 + p;
    float er[64], ei[64];
#pragma unroll
    for (int c = 0; c < 64; ++c) { er[c] = E[c * 128]; ei[c] = E[c * 128 + 64]; }
    float rr = 0.f, ri = 0.f;
#pragma unroll
    for (int c = 0; c < 64; ++c) { E[c * 128] = rr; E[c * 128 + 64] = ri; const float nr = l64.x * rr - l64.y * ri + er[c], ni = l64.x * ri + l64.y * rr + ei[c]; rr = nr; ri = ni; }
    }
}
constexpr int LDKM = 1032;
template <class RW> __device__ __forceinline__ void s5_passC_core(const Ctx& C, int l, RW rw_items) {
    const int g = C.bid >> 3, sb = C.bid & 7, lane = C.lane, fr = lane & 15, fq = lane >> 4, tid = C.tid;
    bf16* Z = (bf16*)(C.ws + WS_Z); unsigned char* S = C.ws + WS_S;
    LAS bf16* KML = (LAS bf16*)(C.lds + 73728);
    LAS bf16* PML = (LAS bf16*)(C.lds + 73728 + 16 * LDKM * 2);
    {   const u32x4* ks = (const u32x4*)((const bf16*)(S + SO_S5_K) + (size_t)g * 16 * 1024);
        for (int i = tid; i < 16 * 128; i += 512) *(LAS u32x4*)(KML + (i >> 7) * LDKM + (i & 127) * 8) = ks[i];
        const u32x4* ps = (const u32x4*)((const bf16*)(S + SO_S5_PM) + (size_t)g * 64 * 128);
        for (int i = tid; i < 64 * 16; i += 512) *(LAS u32x4*)(PML + (i >> 4) * 136 + (i & 15) * 8) = ps[i]; }
    __syncthreads();
    if (C.wave < 4) { rw_items(); __syncthreads(); return; }
    LAS bf16* UP = (LAS bf16*)(C.lds + C.wave * 9216);
    LAS bf16* WV = UP + 128 * 16;
    const float* dsk = C.inp(I_S5_D, l, WB) + g * 16;
#pragma unroll 1
    for (int i4 = 0; i4 < 8; ++i4) {
        const int j = sb * 32 + (C.wave - 4) * 8 + i4, b = j >> 6, c = j & 63, item = (b * 32 + g) * 64 + c, rowb = b * SEQ + c * LCH;
        {   const u32x4* src = (const u32x4*)(Z + (size_t)(rowb + lane) * ZP + ZB_U + g * 16); const u32x4 z4 = (u32x4){0u, 0u, 0u, 0u};
            LAS u32x4* dz = (LAS u32x4*)(UP + lane * 16); dz[0] = z4; dz[1] = z4; LAS u32x4* dst = (LAS u32x4*)(UP + (64 + lane) * 16); dst[0] = src[0]; dst[1] = src[1]; }
        {   const float* E = (const float*)(S + SO_S5_E) + (size_t)item * 128; const int cp = lane >> 2, pq = lane & 3;
            const float* cr = C.inp(I_S5_CRE, l, 32 * 1024) + (size_t)g * 1024 + cp * 64 + 16 * pq; const float* ci = C.inp(I_S5_CIM, l, 32 * 1024) + (size_t)g * 1024 + cp * 64 + 16 * pq;
#pragma unroll
            for (int jj = 0; jj < 16; jj += 2) { const int p = 16 * pq + jj;
                const float a0 = cr[jj] * E[p] - ci[jj] * E[64 + p], b0 = cr[jj] * E[64 + p] + ci[jj] * E[p], a1 = cr[jj + 1] * E[p + 1] - ci[jj + 1] * E[65 + p], b1 = cr[jj + 1] * E[65 + p] + ci[jj + 1] * E[p + 1];
                *(LAS unsigned*)(WV + cp * 136 + p) = pk2(a0, a1); *(LAS unsigned*)(WV + cp * 136 + 64 + p) = pk2(b0, b1); }
        }
        LDS_WAIT(); __builtin_amdgcn_wave_barrier();
#pragma unroll
        for (int tt = 0; tt < 4; ++tt) {
            f32x4 acc = F4Z; const int t = 16 * tt + fr;
#pragma unroll 4
            for (int ks = 0; ks < 8 * (tt + 1); ++ks) {
                const bf16x8 a = ld8(KML + fr * LDKM + 32 * ks + 8 * fq);
                const bf16x8 bb = ld8(UP + (64 + t - 2 * ks - (fq >> 1)) * 16 + 8 * (fq & 1));
                acc = __builtin_amdgcn_mfma_f32_16x16x32_bf16(a, bb, acc, 0, 0, 0);
            }
            acc = tile_mm<128>(WV, 136, PML + (16 * tt) * 136, 136, acc, fr, fq);
            float y[4];
#pragma unroll
            for (int r = 0; r < 4; ++r) { const int cp = 4 * fq + r; y[r] = gelu_tanh(acc[r] + dsk[cp] * bf2f(UP[(64 + t) * 16 + cp])); }
            u32x2 o; o.x = pk2(y[0], y[1]); o.y = pk2(y[2], y[3]);
            *(u32x2*)(Z + (size_t)(rowb + t) * ZP + ZB_U + g * 16 + 4 * fq) = o;
        }
        LDS_WAIT(); __builtin_amdgcn_wave_barrier();
    }
    __syncthreads();
}

constexpr size_t SO_RW_PQ = SO_END1;
constexpr size_t SO_RW_RHO = SO_RW_PQ + 32 * MiB;
constexpr size_t SO_RW_HALO = SO_RW_RHO + 512 * 1024;
constexpr size_t SO_RW_W = SO_RW_HALO + 512 * 1024;
constexpr size_t SO_END2 = SO_RW_W + 256 * 1024;
static_assert(WS_S + SO_END2 <= WS_END, "state region");
static_assert(SO_RW_W == RWW_OFF, "RWW_OFF");
__device__ __forceinline__ void shift8(const u32x4 cur, const u32x4 prev, const float* mu, float* o) {
    float a[8], p[8]; unpack8(cur, a); unpack8(prev, p);
#pragma unroll
    for (int j = 0; j < 8; ++j) o[j] = a[j] + mu[j] * (p[j] - a[j]);
}
__device__ __forceinline__ u32x4 pack8(const float* f) { u32x4 w; w.x = pk2(f[0], f[1]); w.y = pk2(f[2], f[3]); w.z = pk2(f[4], f[5]); w.w = pk2(f[6], f[7]); return w; }

struct RwPre { u32x4 cw, pw, ca, pa, cr, ck, cv, pr, pk, pv; };
__device__ __forceinline__ void rw_preload(const Ctx& C, int item, RwPre& P) {
    const int bh = item >> 6, c = item & 63, b = bh >> 3, h = bh & 7, hc0 = h * 64, rowb = b * SEQ + c * LCH;
    const bf16* Z = (const bf16*)(C.ws + WS_Z); const int t = C.tid >> 3, c0 = (C.tid & 7) * 8, row = rowb + t;
    const bf16* HALO = (const bf16*)(C.ws + WS_S + SO_RW_HALO) + (size_t)(b * 64 + c - 1) * 1024;
    const u32x4 z4 = (u32x4){0u, 0u, 0u, 0u}; const bool first = (c * LCH + t == 0);
    P.cw = *(const u32x4*)(Z + (size_t)row * ZP + ZD_XW + c0); P.ca = *(const u32x4*)(Z + (size_t)row * ZP + ZD_XA + c0);
    P.cr = *(const u32x4*)(Z + (size_t)row * ZP + ZD_R + hc0 + c0); P.ck = *(const u32x4*)(Z + (size_t)row * ZP + ZD_K + hc0 + c0); P.cv = *(const u32x4*)(Z + (size_t)row * ZP + ZD_V + hc0 + c0);
    P.pw = z4; P.pa = z4; P.pr = z4; P.pk = z4; P.pv = z4;
    if (!first) { P.pw = *(const u32x4*)(Z + (size_t)(row - 1) * ZP + ZD_XW + c0); P.pa = *(const u32x4*)(Z + (size_t)(row - 1) * ZP + ZD_XA + c0); P.pv = *(const u32x4*)(Z + (size_t)(row - 1) * ZP + ZD_V + hc0 + c0);
        if (t > 0) { P.pr = *(const u32x4*)(Z + (size_t)(row - 1) * ZP + ZD_R + hc0 + c0); P.pk = *(const u32x4*)(Z + (size_t)(row - 1) * ZP + ZD_K + hc0 + c0); }
        else { P.pr = *(const u32x4*)(HALO + hc0 + c0); P.pk = *(const u32x4*)(HALO + 512 + hc0 + c0); } }
}
template <bool DRY = false> __device__ __forceinline__ void rw_passA(const Ctx& C, int l, int item, RwPre& P, int next_item) {
    const int bh = item >> 6, c = item & 63, b = bh >> 3, h = bh & 7, hc0 = h * 64, rowb = b * SEQ + c * LCH;
    bf16* Z = (bf16*)(C.ws + WS_Z); unsigned char* S = C.ws + WS_S;
    LAS unsigned char* L = C.lds;
    LAS bf16* XW = (LAS bf16*)L; LAS bf16* XA = (LAS bf16*)(L + 9216); LAS float* WARG = (LAS float*)(L + 18432);
    LAS bf16* TAB = (LAS bf16*)L; LAS bf16* TAK = (LAS bf16*)(L + 9216); LAS bf16* MRB = (LAS bf16*)(L + 18432); LAS bf16* MRK = (LAS bf16*)(L + 27648);
    LAS float* AARG = (LAS float*)(L + 36864); LAS float* LW = AARG; LAS bf16* XT = (LAS bf16*)(L + 36864);
    LAS bf16* AT = (LAS bf16*)(L + 55296); LAS bf16* RT = (LAS bf16*)(L + 64512); LAS bf16* BT = (LAS bf16*)(L + 73728); LAS bf16* KT = (LAS bf16*)(L + 82944);
    LAS float* RHSV = (LAS float*)(L + 73728);
    LAS bf16* BBT = (LAS bf16*)(L + 92160); LAS bf16* KBT = (LAS bf16*)(L + 101376); LAS bf16* VT = (LAS bf16*)(L + 110592);
    LAS float* CUML = (LAS float*)(L + 119808); LAS float* GL = CUML + 64; LAS float* SEG = GL + 64; LAS float* UPD = SEG;
    const int tid = C.tid, lane = C.lane, w = C.wave, fr = lane & 15, fq = lane >> 4;
    const int t = tid >> 3, c0 = (tid & 7) * 8, row = rowb + t;
    const float* mu = C.inp(I_RW_MU, l, 1792);
    const u32x4 z4 = (u32x4){0u, 0u, 0u, 0u};
    {   float f[8];
        shift8(P.cw, P.pw, mu + 1536 + c0, f);
#pragma unroll
        for (int j = 0; j < 8; ++j) f[j] = tanhf_(f[j]);
        *(LAS u32x4*)(XW + t * LDT + c0) = pack8(f);
        shift8(P.ca, P.pa, mu + 1600 + c0, f);
        *(LAS u32x4*)(XA + t * LDT + c0) = pack8(f);
    }
    __syncthreads();
    {   const bf16* WUP = (const bf16*)(S + SO_RW_W) + (size_t)hc0 * 64; const bf16* AUP = WUP + 512 * 64;
#pragma unroll
        for (int q = 0; q < 2; ++q) { const int id = 2 * w + q, tt = id >> 2, cc = id & 3;
            const f32x4 aw = tile_mm<64>(XW + (16 * tt) * LDT, LDT, WUP + (size_t)(16 * cc) * 64, 64, F4Z, fr, fq);
            const f32x4 aa = tile_mm<64>(XA + (16 * tt) * LDT, LDT, AUP + (size_t)(16 * cc) * 64, 64, F4Z, fr, fq);
#pragma unroll
            for (int r = 0; r < 4; ++r) { WARG[(16 * tt + 4 * fq + r) * 65 + 16 * cc + fr] = aw[r]; AARG[(16 * tt + 4 * fq + r) * 65 + 16 * cc + fr] = aa[r]; } }
    }
    __syncthreads();
    float lw[8], av[8], bv[8], kr[8], rr[8], vv[8];
    {   float kk[8], aa[8];
        shift8(P.cr, P.pr, mu + hc0 + c0, rr); shift8(P.ck, P.pk, mu + 512 + hc0 + c0, kk); shift8(P.cv, P.pv, mu + 1024 + hc0 + c0, vv);
        const float* w0 = C.inp(I_RW_W0, l, WB) + hc0 + c0; const float* a0 = C.inp(I_RW_A0, l, WB) + hc0 + c0;
        const float* kkw = C.inp(I_RW_KK, l, WB) + hc0 + c0; const float* kaw = C.inp(I_RW_KA, l, WB) + hc0 + c0; const float* rkw = C.inp(I_RW_RK, l, WB) + hc0 + c0;
        float n2 = 0.f, rho = 0.f;
#pragma unroll
        for (int j = 0; j < 8; ++j) {
            const float wl = -softplusf_(-(WARG[t * 65 + c0 + j] + w0[j])) - 0.5f; lw[j] = -__expf(wl);
            aa[j] = sigmoidf_(AARG[t * 65 + c0 + j] + a0[j]);
            const float kn = kk[j] * kkw[j]; n2 += kn * kn; av[j] = kn;
            kr[j] = kk[j] * (1.0f + (aa[j] - 1.0f) * kaw[j]); rho += rr[j] * kr[j] * rkw[j];
        }
        n2 += shx(n2, 1, lane); n2 += shx(n2, 2, lane); n2 += shx(n2, 4, lane);
        rho += shx(rho, 1, lane); rho += shx(rho, 2, lane); rho += shx(rho, 4, lane);
        const float inv = rcpf_(fmaxf(sqrtf(n2), 1e-12f));
#pragma unroll
        for (int j = 0; j < 8; ++j) { const float kkn = av[j] * inv; av[j] = -kkn; bv[j] = kkn * aa[j]; }
        if (!DRY && (tid & 7) == 0) ((float*)(S + SO_RW_RHO))[(size_t)row * 8 + h] = rho;
    }
    __syncthreads();
    if (next_item >= 0) rw_preload(C, next_item, P);
#pragma unroll
    for (int j = 0; j < 8; ++j) LW[t * 64 + c0 + j] = lw[j];
    __syncthreads();
    {   const int cc = tid & 63, seg = tid >> 6; float run = 0.f, v8[8];
#pragma unroll
        for (int i = 0; i < 8; ++i) { run += LW[(seg * 8 + i) * 64 + cc]; v8[i] = run; }
        SEG[seg * 64 + cc] = run;
        __syncthreads();
        float off = 0.f;
        for (int s2 = 0; s2 < seg; ++s2) off += SEG[s2 * 64 + cc];
#pragma unroll
        for (int i = 0; i < 8; ++i) LW[(seg * 8 + i) * 64 + cc] = v8[i] + off;
        if (seg == 7) { CUML[cc] = v8[7] + off; GL[cc] = __expf(v8[7] + off); }
    }
    __syncthreads();
    {   float fa[8], fb[8], fk[8], fr_[8];
#pragma unroll
        for (int j = 0; j < 8; ++j) { const float cm = LW[t * 64 + c0 + j], en = __expf(-cm), el = __expf(CUML[c0 + j] - cm);
            fa[j] = av[j] * __expf(cm - lw[j]); fb[j] = bv[j] * en; fk[j] = kr[j] * en; fr_[j] = rr[j] * __expf(cm);
            BBT[(c0 + j) * LDT + t] = (bf16)f2bf(bv[j] * el); KBT[(c0 + j) * LDT + t] = (bf16)f2bf(kr[j] * el); VT[(c0 + j) * LDT + t] = (bf16)f2bf(vv[j]); }
        *(LAS u32x4*)(AT + t * LDT + c0) = pack8(fa); *(LAS u32x4*)(BT + t * LDT + c0) = pack8(fb); *(LAS u32x4*)(KT + t * LDT + c0) = pack8(fk); *(LAS u32x4*)(RT + t * LDT + c0) = pack8(fr_);
    }
    __syncthreads();
#pragma unroll
    for (int q = 0; q < 2; ++q) { const int id = 2 * w + q, tt = id >> 2, ss = id & 3; f32x4 ab = F4Z, ak = F4Z, rb = F4Z, rk = F4Z;
        if (ss <= tt) {
            ab = tile_mm<64>(BT + (16 * ss) * LDT, LDT, AT + (16 * tt) * LDT, LDT, ab, fr, fq); ak = tile_mm<64>(KT + (16 * ss) * LDT, LDT, AT + (16 * tt) * LDT, LDT, ak, fr, fq);
            rb = tile_mm<64>(BT + (16 * ss) * LDT, LDT, RT + (16 * tt) * LDT, LDT, rb, fr, fq); rk = tile_mm<64>(KT + (16 * ss) * LDT, LDT, RT + (16 * tt) * LDT, LDT, rk, fr, fq);
        }
        const int tq = 16 * tt + fr, s0 = 16 * ss + 4 * fq;
#pragma unroll
        for (int r = 0; r < 4; ++r) { if (s0 + r >= tq) { ab[r] = 0.f; ak[r] = 0.f; } if (s0 + r > tq) { rb[r] = 0.f; rk[r] = 0.f; } }
        *(LAS u32x2*)(TAB + tq * LDT + s0) = pack4(ab); *(LAS u32x2*)(TAK + tq * LDT + s0) = pack4(ak); *(LAS u32x2*)(MRB + tq * LDT + s0) = pack4(rb); *(LAS u32x2*)(MRK + tq * LDT + s0) = pack4(rk);
    }
    __syncthreads();
    LAS bf16* DINV = (LAS bf16*)SEG;
    LAS bf16* RT2 = DINV + 1024;
    if (w >= 4) {
#pragma unroll
        for (int q = 0; q < 4; ++q) { const int id = 4 * (w - 4) + q, vb = id >> 2, tt = id & 3;
            const f32x4 a = tile_mm<64>(VT + (16 * vb) * LDT, LDT, TAK + (16 * tt) * LDT, LDT, F4Z, fr, fq);
#pragma unroll
            for (int r = 0; r < 4; ++r) RHSV[(16 * vb + 4 * fq + r) * 65 + 16 * tt + fr] = a[r]; }
        for (int i = tid - 256; i < 128 * LDT / 8; i += 256) ((LAS u32x4*)XT)[i] = z4;
    } else if (lane < 16) { const int bb = w, j = lane; float x[16];
#pragma unroll
        for (int i = 0; i < 16; ++i) { float s = (i == j) ? 1.0f : 0.0f; float tf[16];
            if (i > 0) unpack8(*(const LAS u32x4*)(TAB + (16 * bb + i) * LDT + 16 * bb), tf);
            if (i > 8) unpack8(*(const LAS u32x4*)(TAB + (16 * bb + i) * LDT + 16 * bb + 8), tf + 8);
#pragma unroll
            for (int i2 = 0; i2 < i; ++i2) s += tf[i2] * x[i2];
            x[i] = s; DINV[(bb * 16 + i) * 16 + j] = (bf16)f2bf(s); }
    }
    __syncthreads();
    typedef short s16x4 __attribute__((ext_vector_type(4)));
#pragma unroll
    for (int bi = 0; bi < 4; ++bi) {
        f32x4 u = F4Z;
        if (bi > 0) u = tile_mm<64>(XT + (16 * w) * LDT, LDT, TAB + (16 * bi) * LDT, LDT, F4Z, fr, fq);
#pragma unroll
        for (int r = 0; r < 4; ++r) { const int col = 16 * w + 4 * fq + r, tr = 16 * bi + fr;
            const float base = (w < 4) ? bf2f(AT[tr * LDT + col]) : RHSV[(col - 64) * 65 + tr];
            RT2[col * 16 + fr] = (bf16)f2bf(base + u[r]); }
        LDS_WAIT(); __builtin_amdgcn_wave_barrier();
        const s16x4 ra = *(const LAS s16x4*)(RT2 + (16 * w + fr) * 16 + 4 * fq), db = *(const LAS s16x4*)(DINV + (bi * 16 + fr) * 16 + 4 * fq);
        const f32x4 x = __builtin_amdgcn_mfma_f32_16x16x16bf16_1k(ra, db, F4Z, 0, 0, 0);
#pragma unroll
        for (int r = 0; r < 4; ++r) XT[(16 * w + 4 * fq + r) * LDT + 16 * bi + fr] = (bf16)f2bf(x[r]);
        LDS_WAIT(); __builtin_amdgcn_wave_barrier();
    }
    __syncthreads();
    bf16* PQ = (bf16*)(S + SO_RW_PQ) + (size_t)item * 8192;
#pragma unroll
    for (int q = 0; q < 2; ++q) { const int id = 2 * w + q, ib = id >> 2, jb = id & 3;
        {
            f32x4 a = tile_mm<64>(XT + (16 * ib) * LDT, LDT, MRB + (16 * jb) * LDT, LDT, F4Z, fr, fq);
            const int tq = 16 * jb + fr, j0 = 16 * ib + 4 * fq; const u32x2 rt = *(const LAS u32x2*)(RT + tq * LDT + j0);
            a[0] += bflo(rt.x); a[1] += bfhi(rt.x); a[2] += bflo(rt.y); a[3] += bfhi(rt.y);
            if (!DRY) *(u32x2*)(Z + (size_t)(rowb + tq) * ZP + ZD_R + hc0 + j0) = pack4(a); else asm volatile("" :: "v"(a)); }
        {
            f32x4 a = tile_mm<64>(XT + (64 + 16 * ib) * LDT, LDT, MRB + (16 * jb) * LDT, LDT, F4Z, fr, fq);
            a = tile_mm<64>(VT + (16 * ib) * LDT, LDT, MRK + (16 * jb) * LDT, LDT, a, fr, fq);
            if (!DRY) *(u32x2*)(Z + (size_t)(rowb + 16 * jb + fr) * ZP + ZD_K + hc0 + 16 * ib + 4 * fq) = pack4(a); else asm volatile("" :: "v"(a)); }
        {
            f32x4 a = tile_mm<64>(XT + (16 * ib) * LDT, LDT, BBT + (16 * jb) * LDT, LDT, F4Z, fr, fq);
            const int k = 16 * jb + fr, j0 = 16 * ib + 4 * fq;
#pragma unroll
            for (int r = 0; r < 4; ++r) if (j0 + r == k) a[r] += GL[k];
            if (!DRY) *(u32x2*)(PQ + (size_t)k * 64 + j0) = pack4(a); else asm volatile("" :: "v"(a)); }
        {
            f32x4 a = tile_mm<64>(BBT + (16 * ib) * LDT, LDT, XT + (64 + 16 * jb) * LDT, LDT, F4Z, fr, fq);
            a = tile_mm<64>(KBT + (16 * ib) * LDT, LDT, VT + (16 * jb) * LDT, LDT, a, fr, fq);
            if (!DRY) *(u32x2*)(PQ + 4096 + (size_t)(16 * jb + fr) * 64 + 16 * ib + 4 * fq) = pack4(a); else asm volatile("" :: "v"(a)); }
    }
    __syncthreads();
}
__device__ __forceinline__ void rw_passB(const Ctx& C, int unit) {
    const int bh = unit >> 2, vg = unit & 3, lane = C.lane, fr = lane & 15, fq = lane >> 4;
    LAS bf16* SL = (LAS bf16*)(C.lds + C.wave * 16384);
    bf16* PQ0 = (bf16*)(C.ws + WS_S + SO_RW_PQ) + (size_t)bh * 64 * 8192;
    for (int i = lane; i < 16 * LDT / 8; i += 64) ((LAS u32x4*)SL)[i] = (u32x4){0u, 0u, 0u, 0u};
    LDS_WAIT(); __builtin_amdgcn_wave_barrier();
    bf16x8 pa[4][4][2]; u32x2 qa[4][4];
#define RWB_FETCH(s, cc) do { const bf16* P_ = PQ0 + (size_t)(cc) * 8192; const bf16* Q_ = P_ + 4096 + (size_t)(16 * vg) * 64; _Pragma("unroll") for (int kk = 0; kk < 4; ++kk) { \
        pa[s][kk][0] = ld8(P_ + (size_t)(16 * kk + fr) * 64 + 8 * fq); pa[s][kk][1] = ld8(P_ + (size_t)(16 * kk + fr) * 64 + 32 + 8 * fq); qa[s][kk] = *(const u32x2*)(Q_ + (size_t)fr * 64 + 16 * kk + 4 * fq); } } while (0)
    RWB_FETCH(0, 0); RWB_FETCH(1, 1); RWB_FETCH(2, 2); RWB_FETCH(3, 3);
    for (int c4 = 0; c4 < 64; c4 += 4) {
#pragma unroll
        for (int s = 0; s < 4; ++s) {
            const int c = c4 + s;
            bf16* QT = PQ0 + (size_t)c * 8192 + 4096 + (size_t)(16 * vg) * 64;
            const bf16x8 b0 = ld8(SL + fr * LDT + 8 * fq), b1 = ld8(SL + fr * LDT + 32 + 8 * fq);
            const u32x4 s0 = *(const LAS u32x4*)(SL + (lane >> 2) * LDT + (lane & 3) * 16), s1 = *(const LAS u32x4*)(SL + (lane >> 2) * LDT + (lane & 3) * 16 + 8);
            f32x4 acc[4];
#pragma unroll
            for (int kk = 0; kk < 4; ++kk) {
                f32x4 a; a[0] = bflo(qa[s][kk].x); a[1] = bfhi(qa[s][kk].x); a[2] = bflo(qa[s][kk].y); a[3] = bfhi(qa[s][kk].y);
                a = __builtin_amdgcn_mfma_f32_16x16x32_bf16(pa[s][kk][0], b0, a, 0, 0, 0);
                acc[kk] = __builtin_amdgcn_mfma_f32_16x16x32_bf16(pa[s][kk][1], b1, a, 0, 0, 0);
            }
            LDS_WAIT(); __builtin_amdgcn_wave_barrier();
            *(u32x4*)(QT + (size_t)(lane >> 2) * 64 + (lane & 3) * 16) = s0; *(u32x4*)(QT + (size_t)(lane >> 2) * 64 + (lane & 3) * 16 + 8) = s1;
#pragma unroll
            for (int kk = 0; kk < 4; ++kk) *(LAS u32x2*)(SL + fr * LDT + 16 * kk + 4 * fq) = pack4(acc[kk]);
            LDS_WAIT(); __builtin_amdgcn_wave_barrier();
            if (c + 4 < 64) RWB_FETCH(s, c + 4);
        }
    }
#undef RWB_FETCH
}
template <bool DRY = false> __device__ __forceinline__ void rw_passC(const Ctx& C, int l, int item) {
    const int bh = item >> 6, c = item & 63, b = bh >> 3, h = bh & 7, hc0 = h * 64, rowb = b * SEQ + c * LCH;
    bf16* Z = (bf16*)(C.ws + WS_Z); unsigned char* S = C.ws + WS_S;
    const int tt = C.wave & 3, lane = C.lane, fr = lane & 15, fq = lane >> 4, t = 16 * tt + fr, row = rowb + t;
    LAS bf16* XG = (LAS bf16*)(C.lds + tt * 4608);
    const float* mu = C.inp(I_RW_MU, l, 1792); const u32x4 z4 = (u32x4){0u, 0u, 0u, 0u};
    {
        const int tl = lane >> 2, rw = rowb + 16 * tt + tl; const bool first = (c * LCH + 16 * tt + tl == 0);
#pragma unroll
        for (int q = 0; q < 4; ++q) { const int j0 = (lane & 3) * 32 + q * 8; float f[8];
            const u32x4 cg = *(const u32x4*)(Z + (size_t)rw * ZP + ZD_XG + j0), pg = first ? z4 : *(const u32x4*)(Z + (size_t)(rw - 1) * ZP + ZD_XG + j0);
            shift8(cg, pg, mu + 1664 + j0, f);
#pragma unroll
            for (int j = 0; j < 8; ++j) f[j] = sigmoidf_(f[j]);
            *(LAS u32x4*)(XG + tl * 136 + j0) = pack8(f); }
    }
    LDS_WAIT(); __builtin_amdgcn_wave_barrier();
    const bf16* SST = (const bf16*)(S + SO_RW_PQ) + (size_t)item * 8192 + 4096;
    const bf16* GUP = (const bf16*)(S + SO_RW_W) + 2 * 512 * 64 + (size_t)hc0 * 128;
    f32x4 y[4], g[4];
#pragma unroll
    for (int vb = 0; vb < 4; ++vb) {
        y[vb] = tile_mm<64>(SST + (size_t)(16 * vb) * 64, 64, Z + (size_t)(rowb + 16 * tt) * ZP + ZD_R + hc0, ZP, F4Z, fr, fq);
        const u32x2 yl = *(const u32x2*)(Z + (size_t)row * ZP + ZD_K + hc0 + 16 * vb + 4 * fq);
        y[vb][0] += bflo(yl.x); y[vb][1] += bfhi(yl.x); y[vb][2] += bflo(yl.y); y[vb][3] += bfhi(yl.y);
        g[vb] = tile_mm<128>(GUP + (size_t)(16 * vb) * 128, 128, XG, 136, F4Z, fr, fq);
    }
    float s1 = 0.f;
#pragma unroll
    for (int vb = 0; vb < 4; ++vb) s1 += (y[vb][0] + y[vb][1]) + (y[vb][2] + y[vb][3]);
    s1 += shx(s1, 16, lane); s1 += shx(s1, 32, lane);
    const float mean = s1 * (1.0f / 64); float s2 = 0.f;
#pragma unroll
    for (int vb = 0; vb < 4; ++vb)
#pragma unroll
        for (int r = 0; r < 4; ++r) { const float d = y[vb][r] - mean; y[vb][r] = d; s2 += d * d; }
    s2 += shx(s2, 16, lane); s2 += shx(s2, 32, lane);
    const float rs = rsqf_(s2 * (1.0f / 64) + 64e-5f);
    const float rho = ((const float*)(S + SO_RW_RHO))[(size_t)row * 8 + h];
    const bool first = (c * LCH + t == 0);
#pragma unroll
    for (int vb = 0; vb < 4; ++vb) { const int v0 = 16 * vb + 4 * fq;
        const u32x2 cv = *(const u32x2*)(Z + (size_t)row * ZP + ZD_V + hc0 + v0); u32x2 pv; pv.x = 0u; pv.y = 0u;
        if (!first) pv = *(const u32x2*)(Z + (size_t)(row - 1) * ZP + ZD_V + hc0 + v0);
        const float cvf[4] = {bflo(cv.x), bfhi(cv.x), bflo(cv.y), bfhi(cv.y)}, pvf[4] = {bflo(pv.x), bfhi(pv.x), bflo(pv.y), bfhi(pv.y)};
        const float* gn = C.inp(I_RW_NORM, l, WB) + hc0 + v0; const float* mv = mu + 1024 + hc0 + v0; f32x4 o;
#pragma unroll
        for (int r = 0; r < 4; ++r) { const float vs = cvf[r] + mv[r] * (pvf[r] - cvf[r]); o[r] = (y[vb][r] * rs * gn[r] + rho * vs) * g[vb][r]; }
        y[vb] = o; }
    asm volatile("s_waitcnt vmcnt(0)" ::: "memory"); __builtin_amdgcn_wave_barrier();
#pragma unroll
    for (int vb = 0; vb < 4; ++vb) { if (!DRY) *(u32x2*)(Z + (size_t)row * ZP + ZD_R + hc0 + 16 * vb + 4 * fq) = pack4(y[vb]); else asm volatile("" :: "v"(y[vb])); }
    LDS_WAIT(); __builtin_amdgcn_wave_barrier();
}

__device__ __forceinline__ void rw_s5_passC(const Ctx& C, int l) {
    s5_passC_core(C, l, [&]() {
#pragma unroll 1
        for (int i = 0; i < 8; ++i) { const Ctx Ci = make_ctx(); rw_passC(Ci, l, (int)blockIdx.x + 256 * i); }
    });
}
template <class Epi, bool ALIGN> __device__ __forceinline__ void run_gemm(const Ctx& C, const bf16* A, int lda, const bf16* Bt, int ldb, int Mr, int N, int K, const Epi& E, int Gv = 0, int cv = 0) {
    if (Gv == 0) { Gv = C.G; cv = C.bid; }
    if (cv < 0 || cv >= Gv) return;
    pg8::Gemm g{A, Bt, Mr, N, K, lda, ldb}; pg8::StaticOrder S; S.init(Mr, N, Gv, cv);
    pg8::gemm_phase<Epi, pg8::StaticOrder, ALIGN, true>(C.lds, g, S, E);
}

#ifdef PROBE_LO
#define PROBE_STAMP(Cb) do { if (blockIdx.x == 0 && (Cb).tid == 0) { volatile LAS unsigned* m_ = (volatile LAS unsigned*)((Cb).lds + MISC_OFF); const unsigned i_ = m_[16]; m_[16] = i_ + 1u; \
    __hip_atomic_store((unsigned long long*)((Cb).ws + WS_CTL + 32768) + i_, (unsigned long long)__builtin_amdgcn_s_memrealtime(), __ATOMIC_RELAXED, __HIP_MEMORY_SCOPE_AGENT); } } while (0)
#else
#define PROBE_STAMP(Cb) do { } while (0)
#endif
#define GRID_BAR() do { const Ctx Cb = make_ctx(); XcdBarrier b_; b_.bar = (unsigned*)(Cb.ws + WS_CTL) + 4096; b_.x = xb_xcc_id(); b_.st = (volatile LAS unsigned*)(Cb.lds + MISC_OFF) + 8; xcd_barrier(b_); PROBE_STAMP(Cb); } while (0)
#define PHASE_CTX() const Ctx C = make_ctx(); unsigned char* const ws = C.ws; bf16* const XB = (bf16*)(ws + WS_XB); float* const SSQ = (float*)(ws + WS_SSQ); bf16* const Z = (bf16*)(ws + WS_Z); \
    const int gw = C.bid * 8 + C.wave, NGW = C.G * 8; (void)XB; (void)SSQ; (void)Z; (void)gw; (void)NGW
#define SUBSYNC() do { VM_WAIT(); __syncthreads(); } while (0)
#define MERGE_PTRS() unsigned char* const G8 = ws + WS_G8; bf16* const MF = (bf16*)(ws + WS_MF); bf16* const MG = Z + ZC_Q; const bf16* const WG = (const bf16*)(ws + WS_SLOTA); const bf16* const WP = (const bf16*)(ws + WS_SLOTC); \
    const float* const gb = C.inp(I_GATE_BIAS, l, 4 * D); (void)G8; (void)MF; (void)MG; (void)WG; (void)WP; (void)gb
#define PHM_IN() \
        if (PH_ON(3)) {   PHASE_CTX(); \
            { EpiZ E{Z, SSQ, (bf16*)(ws + WS_S + RWW_OFF - 512 * 1024)}; run_gemm<EpiZ, true>(C, XB, D, (const bf16*)(ws + WS_SLOTB), D, M, NINP, D, E); } \
        } \
        GRID_BAR();
#define PHM_MIXA() \
        if (PH_ON(4)) {   PHASE_CTX(); \
            { RwPre P_; { const Ctx Ci = make_ctx(); rw_preload(Ci, (int)blockIdx.x, P_); } \
              for (int it = blockIdx.x; it < 2048; it += gridDim.x) { const Ctx Ci = make_ctx(); rw_passA(Ci, l, it, P_, (it + (int)gridDim.x < 2048) ? it + (int)gridDim.x : -1); } } \
        } \
        if (PH_ON(4)) {   PHASE_CTX(); \
            for (int it = blockIdx.x; it < 1024; it += gridDim.x) { const Ctx Ci = make_ctx(); ml_passA(Ci, l, it, (it + (int)gridDim.x < 1024) ? it + (int)gridDim.x : -1); } \
            if (DUPM == 7 && l == 0) for (int it = blockIdx.x; it < 1024; it += gridDim.x) { const Ctx Ci = make_ctx(); ml_passA(Ci, l, it); } \
        } \
        if (PH_ON(4)) {   PHASE_CTX(); \
            for (int it = blockIdx.x; it < 1024; it += gridDim.x) { const Ctx Ci = make_ctx(); gla_passA(Ci, l, it); } \
            if (DUPM == 8 && l == 0) for (int it = blockIdx.x; it < 1024; it += gridDim.x) { const Ctx Ci = make_ctx(); gla_passA(Ci, l, it); } \
            { const Ctx Ci = make_ctx(); s5_passA(Ci); } \
            if (DUPM == 9 && l == 0) { const Ctx Ci = make_ctx(); s5_passA(Ci); } \
        } \
        GRID_BAR();
#define PHM_MIXB() \
        if (PH_ON(4)) {   PHASE_CTX(); \
            const bool rwv = ((gw & 15) == 0); const int tidx = (gw - ((gw >> 4) + 1)) * 64 + C.lane, NT = (NGW - NGW / 16) * 64; \
            if (rwv) rw_passB(C, gw >> 4); else { ml_passB(C, tidx, NT); } \
        } \
        if (PH_ON(4)) {   PHASE_CTX(); \
            const bool rwv = ((gw & 15) == 0); const int tidx = (gw - ((gw >> 4) + 1)) * 64 + C.lane, NT = (NGW - NGW / 16) * 64; \
            if (!rwv) { gla_passB(C, tidx, NT); s5_passB(C, tidx, NT); } \
        } \
        if (PH_ON(4)) {   PHASE_CTX(); \
            if (C.bid & 1) run_conv(C, CJ_GATES | CJ_PROJ | CJ_XW | CJ_GU2S, l, (C.bid >> 1) * 8 + C.wave, (C.G >> 1) * 8); \
        } \
        GRID_BAR();
#define PHM_MIXC() \
        if (PH_ON(4)) {   PHASE_CTX(); \
            { const Ctx Ci = make_ctx(); rw_s5_passC(Ci, l); } \
        } \
        __syncthreads(); \
        if (PH_ON(4)) {   PHASE_CTX(); \
            if (DUPM == 12 && l == 0) for (int it = blockIdx.x; it < 1024; it += gridDim.x) { const Ctx Ci = make_ctx(); ml_passC<true>(Ci, l, it); } \
            for (int it = blockIdx.x; it < 1024; it += gridDim.x) { const Ctx Ci = make_ctx(); ml_passC(Ci, l, it, (it + (int)gridDim.x < 1024) ? it + (int)gridDim.x : -1); } \
        } \
        if (PH_ON(4)) {   PHASE_CTX(); \
            if (DUPM == 13 && l == 0) for (int it = blockIdx.x; it < 1024; it += gridDim.x) { const Ctx Ci = make_ctx(); gla_passC<true>(Ci, l, it); } \
            for (int it = blockIdx.x; it < 1024; it += gridDim.x) { const Ctx Ci = make_ctx(); gla_passC(Ci, l, it); } \
        } \
        if (PH_ON(4)) {   PHASE_CTX(); \
        } \
        GRID_BAR();
#define PHM_MERGE() \
        if (PH_ON(5)) { PHASE_CTX(); MERGE_PTRS(); pg8::StaticOrder S0; S0.init(M, D, C.G, C.bid); pg8::Unit u0; S0.next(0, u0); OwnTile4 S4{u0.pm, u0.pn}; \
            pg8::Gemm g{XB, WG, M, 4 * D, D, D, D}; EpiGate8 E{G8, SSQ, gb}; pg8::gemm_phase<EpiGate8, OwnTile4, true, true>(C.lds, g, S4, E); } SUBSYNC(); \
        if (PH_ON(5)) { PHASE_CTX(); MERGE_PTRS(); EpiMerge8<0> E{G8, 0, MF, MG, ZP}; run_gemm<EpiMerge8<0>, false>(C, Z + ZA_O, ZP, WP, WB, M, D, WB, E); } SUBSYNC(); \
        if (PH_ON(5)) { PHASE_CTX(); MERGE_PTRS(); EpiGlu8 E{G8}; run_gemm<EpiGlu8, false>(C, Z + ZB_U, ZP, WP + 2 * (size_t)D * WB, WB, M, D, WB, E); } SUBSYNC(); \
        if (PH_ON(5)) { PHASE_CTX(); MERGE_PTRS(); EpiMerge8<1> E{G8, 1, MF, MG, ZP}; run_gemm<EpiMerge8<1>, false>(C, Z + ZB_U, ZP, WP + (size_t)D * WB, WB, M, D, WB, E); } SUBSYNC(); \
        if (PH_ON(5)) { PHASE_CTX(); MERGE_PTRS(); EpiMerge8<1> E{G8, 2, MF, MG, ZP}; run_gemm<EpiMerge8<1>, false>(C, Z + ZC_G, ZP, WP + 3 * (size_t)D * WB, WB, M, D, WB, E); } SUBSYNC(); \
        if (PH_ON(5)) { PHASE_CTX(); MERGE_PTRS(); EpiMerge8<2> E{G8, 3, MF, MG, ZP}; run_gemm<EpiMerge8<2>, false>(C, Z + ZD_R, ZP, WP + 4 * (size_t)D * WB, WB, M, D, WB, E); } \
        GRID_BAR();
#ifdef DUP_MODE
constexpr int DUPM = DUP_MODE;
#else
constexpr int DUPM = 0;
#endif
#ifndef STOP_AFTER
#define STOP_AFTER 1000
#endif
#define PH_ON(n) ((l) * 20 + (n) <= STOP_AFTER)
template <int l> __device__ __forceinline__ void layer_fwd() {
        if (PH_ON(1)) {   PHASE_CTX();
            { EpiSwiglu E{(bf16*)(ws + WS_HID), SSQ}; run_gemm<EpiSwiglu, true>(C, XB, D, (const bf16*)(ws + WS_SLOTA), D, M, 2 * FF, D, E); }
            {
                const int s0 = (l == 0) ? 192 : 128, ns = 256 - s0;
                if (C.bid >= s0) {
                    run_conv(C, (l > 0 ? CJ_D1 : 0) | CJ_MLW | CJ_RWW, l, (C.bid - s0) * 8 + C.wave, ns * 8);
                    if (C.bid - s0 < 32) { const Ctx Ci = make_ctx(); s5_prep(Ci, l, C.bid - s0); }
                }
            }
            if (l == 0) {
                for (int q = 0; q < DEPTH; ++q) { EpiKV E{(bf16*)(ws + WS_KV + (size_t)q * 4 * MiB), (bf16*)(ws + WS_KV + (size_t)q * 4 * MiB + 2 * MiB), (const float*)(ws + WS_MEMR)};
                    run_gemm<EpiKV, true>(C, (const bf16*)(ws + WS_MEMB), D, (const bf16*)(ws + WS_S + (size_t)q * 4 * MiB), D, MMEM, 2 * D, D, E, 32, C.bid - 128 - 32 * q); }
            }
        }
        GRID_BAR();
        if (DUPM == 14 && l == 0) {
        if (PH_ON(1)) {   PHASE_CTX();

            { EpiSwiglu E{(bf16*)(ws + WS_HID), SSQ}; run_gemm<EpiSwiglu, true>(C, XB, D, (const bf16*)(ws + WS_SLOTA), D, M, 2 * FF, D, E); }
            if (l == 0) {
                for (int q = 0; q < DEPTH; ++q) { EpiKV E{(bf16*)(ws + WS_KV + (size_t)q * 4 * MiB), (bf16*)(ws + WS_KV + (size_t)q * 4 * MiB + 2 * MiB), (const float*)(ws + WS_MEMR)};
                    run_gemm<EpiKV, true>(C, (const bf16*)(ws + WS_MEMB), D, (const bf16*)(ws + WS_S + (size_t)q * 4 * MiB), D, MMEM, 2 * D, D, E, 32, C.bid - 128 - 32 * q); }
            }
        }
        GRID_BAR();
        }
        if (PH_ON(2)) {   PHASE_CTX();
            { EpiResid E{(l == 0) ? C.in[I_X] : (const float*)C.X, C.X, XB, SSQ, 0.5f}; run_gemm<EpiResid, false>(C, (const bf16*)(ws + WS_HID), FF, (const bf16*)(ws + WS_SLOTC), FF, M, D, FF, E); }
        }
        GRID_BAR();
#if defined(DUP_MODE)
        if (l == 0 && DUP_MODE >= 1 && DUP_MODE <= 4) {
#if DUP_MODE == 1
            PHM_IN();
#elif DUP_MODE == 2
            PHM_IN(); PHM_MIXA();
#elif DUP_MODE == 3
            PHM_IN(); PHM_MIXA(); PHM_MIXB();
#elif DUP_MODE == 4
            PHM_IN(); PHM_MIXA(); PHM_MIXB(); PHM_MIXC();
#endif
            { PHASE_CTX(); run_conv(C, CJ_WIN, l, gw, NGW); } GRID_BAR();
            GRID_BAR();
        }
#endif
        PHM_IN(); PHM_MIXA(); PHM_MIXB(); PHM_MIXC();
        PHM_MERGE();
#if defined(DUP_MODE) && DUP_MODE == 5
        if (l == 0) { PHM_MERGE(); }
#endif
        if (PH_ON(6)) {   PHASE_CTX();
            run_conv(C, CJ_D2, l, gw, NGW);
            { EpiResid E{C.X, C.X, XB, SSQ, 1.0f}; run_gemm<EpiResid, false>(C, Z + ZC_Q, ZP, (const bf16*)(ws + WS_SLOTB), D, M, D, D, E); }
        }
        GRID_BAR();
        {
            const int un = blockIdx.x; const int pm = un >> 2, hh = un & 3, bb = pm >> 4;
            if (PH_ON(8)) {   PHASE_CTX();
                bf16* Qp = (bf16*)(ws + WS_XQ) + (size_t)C.bid * 65536;
                pg8::Gemm g{XB + (size_t)pm * 256 * D, (const bf16*)(ws + WS_SLOTB + 2 * MiB) + (size_t)hh * 256 * D, 256, 256, D, D, D}; pg8::SingleUnit S;
                EpiBf16 E{Qp, 256, SSQ + (size_t)pm * 256 * 16, 0.0625f * 1.4426950408889634f, 256};
                pg8::gemm_phase<EpiBf16, pg8::SingleUnit, false, true>(C.lds, g, S, E);
            }
            SUBSYNC();
            if (PH_ON(8)) {   PHASE_CTX();
                const bf16* Qp = (const bf16*)(ws + WS_XQ) + (size_t)C.bid * 65536;
                const bf16* Kd = (const bf16*)(ws + WS_KV + (size_t)l * 4 * MiB) + (size_t)bb * 256 * D + hh * 256;
                bf16* P = (bf16*)(ws + WS_XP) + (size_t)C.bid * 65536;
                pg8::Gemm g{Qp, Kd, 256, 256, 256, 256, D}; pg8::SingleUnit S; EpiSoftmaxP E{P}; pg8::gemm_phase<EpiSoftmaxP, pg8::SingleUnit, false, true>(C.lds, g, S, E);
            }
            SUBSYNC();
            if (PH_ON(8)) {   PHASE_CTX();
                const bf16* VT = (const bf16*)(ws + WS_KV + (size_t)l * 4 * MiB + 2 * MiB) + (size_t)hh * 256 * MMEM + bb * 256;
                const bf16* P = (const bf16*)(ws + WS_XP) + (size_t)C.bid * 65536;
                pg8::Gemm g{P, VT, 256, 256, 256, 256, MMEM}; pg8::SingleUnit S; EpiBf16 E{(bf16*)(ws + WS_XO) + (size_t)pm * 256 * D + hh * 256, D, nullptr, 1.0f, 256};
                pg8::gemm_phase<EpiBf16, pg8::SingleUnit, false, true>(C.lds, g, S, E);
            }
            SUBSYNC();
        }
        GRID_BAR();
        if (PH_ON(9)) {   PHASE_CTX();
            EpiResid E{C.X, C.X, XB, SSQ, 1.0f}; run_gemm<EpiResid, false>(C, (const bf16*)(ws + WS_XO), D, (const bf16*)(ws + WS_SLOTB + 4 * MiB), D, M, D, D, E);
        }
        GRID_BAR();
        if (PH_ON(10)) {   PHASE_CTX();
            { EpiSwiglu E{(bf16*)(ws + WS_HID), SSQ}; run_gemm<EpiSwiglu, true>(C, XB, D, (const bf16*)(ws + WS_GU2S), D, M, 2 * FF, D, E); }
            if (l + 1 < DEPTH && C.bid >= 128) { run_conv(C, CJ_WIN | CJ_GU1, l + 1, (C.bid - 128) * 8 + C.wave, 128 * 8); }
        }
        GRID_BAR();
        if (DUPM == 18 && l == 0) {
        if (PH_ON(10)) {   PHASE_CTX();
            if (l + 1 < DEPTH) { run_conv(C, CJ_WIN, l + 1, gw, NGW); }
            { EpiSwiglu E{(bf16*)(ws + WS_HID), SSQ}; run_gemm<EpiSwiglu, true>(C, XB, D, (const bf16*)(ws + WS_SLOTA), D, M, 2 * FF, D, E); }
        }
        GRID_BAR();
        }
        if (PH_ON(11)) {   PHASE_CTX();
            { EpiResid E{C.X, C.X, XB, SSQ, 0.5f}; run_gemm<EpiResid, false>(C, (const bf16*)(ws + WS_HID), FF, (const bf16*)(ws + WS_SLOTC), FF, M, D, FF, E); }
        }
        GRID_BAR();
    }

__global__ void __launch_bounds__(512, 2) fwd_kernel(Args args) {
    extern __shared__ __attribute__((aligned(16))) unsigned char lds_raw[];
    (void)args;
    {
        const Ctx C = make_ctx();
        volatile LAS unsigned* MISC = (volatile LAS unsigned*)(C.lds + MISC_OFF);
        for (int u = C.tid; u < (LDS_BYTES - RING_BYTES) / 4; u += 512) ((LAS unsigned*)(C.lds + RING_BYTES))[u] = 0u;
        __syncthreads();
        (void)xcd_barrier_post((unsigned*)(C.ws + WS_CTL) + 4096, MISC + 8);
        PROBE_STAMP(C);
    }

    {   PHASE_CTX();
        pro_rows(C);
        run_conv(C, CJ_GU1 | CJ_D1 | CJ_WIN | CJ_XKV0 | CJ_XKV1, 0, gw, NGW);
    }
    GRID_BAR();
    if (DUPM == 17) {
    {   PHASE_CTX();
        pro_rows(C);
        run_conv(C, CJ_GU1 | CJ_D1 | CJ_WIN | CJ_XKV0 | CJ_XKV1, 0, gw, NGW);
    }
    GRID_BAR();
    }

    if (DUPM == 30) { for (int q = 0; q < 40; ++q) { GRID_BAR(); } }
    layer_fwd<0>();
    layer_fwd<1>();
    {   PHASE_CTX();
        final_rows(C);
#ifdef PROBE_LO
        {
            __syncthreads();
            const unsigned long long* st = (const unsigned long long*)(ws + WS_CTL + 32768);
            const unsigned long long ta = __hip_atomic_load(st + PROBE_LO, __ATOMIC_RELAXED, __HIP_MEMORY_SCOPE_AGENT), tb = __hip_atomic_load(st + PROBE_HI, __ATOMIC_RELAXED, __HIP_MEMORY_SCOPE_AGENT);
            float e = 0.08f + (float)(tb - ta) * 6e-6f; if (e > 0.31f) e = 0.31f;
            const int gwv = C.bid * 8 + C.wave;
            if (gwv == 7 && C.lane == 5) C.X[(size_t)7 * D + 5] += e;
        }
#endif
        if (xb_ld((unsigned*)(ws + WS_CTL) + 4096 + XB_TMO) != 0u) {
            for (size_t i = (size_t)C.bid * 512 + C.tid; i < (size_t)M * D; i += (size_t)C.G * 512) C.X[i] = __builtin_nanf("");
        }
    }
}

extern "C" void kernel_launch(void* const* d_in, const int* in_sizes, int n_in, void* d_out, int out_size, void* d_ws, size_t ws_size, hipStream_t stream) {
    static int grid = 0;
    if (grid == 0) {
        if (n_in != N_INPUTS || out_size != M * D || ws_size < WS_END) { fprintf(stderr, "kernel_launch: unexpected shapes: n_in %d out %d ws %zu (need %zu)\n", n_in, out_size, ws_size, (size_t)WS_END); grid = -1; return; }
        int dev = 0, cus = 0, per_cu = 0;
        if (hipGetDevice(&dev) != hipSuccess || hipDeviceGetAttribute(&cus, hipDeviceAttributeMultiprocessorCount, dev) != hipSuccess) { grid = -1; return; }
        if (hipFuncSetAttribute((const void*)fwd_kernel, hipFuncAttributeMaxDynamicSharedMemorySize, LDS_BYTES) != hipSuccess) { fprintf(stderr, "kernel_launch: hipFuncSetAttribute failed\n"); grid = -1; return; }
        if (hipOccupancyMaxActiveBlocksPerMultiprocessor(&per_cu, (const void*)fwd_kernel, 512, LDS_BYTES) != hipSuccess || per_cu < 1) { fprintf(stderr, "kernel_launch: occupancy query says %d workgroups per CU\n", per_cu); (void)hipGetLastError(); grid = -1; return; }
        if (cus < 256) { fprintf(stderr, "kernel_launch: built for a 256-CU device (got %d)\n", cus); grid = -1; return; }
        grid = 256;
    }
    if (grid < 0) return;
    if (hipMemsetAsync((char*)d_ws + WS_CTL, 0, CTL_ZERO_BYTES, stream) != hipSuccess) return;
    Args a{};
    for (int i = 0; i < N_INPUTS; ++i) a.in[i] = (const float*)d_in[i];
    a.out = (float*)d_out; a.ws = (unsigned char*)d_ws;
    hipLaunchKernelGGL(fwd_kernel, dim3(grid), dim3(512), LDS_BYTES, stream, a);
}
```

```cpp
#include <hip/hip_runtime.h>
#include <cstdio>
#include <cstdint>

#define LAS __attribute__((address_space(3)))
#define GAS __attribute__((address_space(1)))
typedef unsigned short bf16;
typedef float f32x4 __attribute__((ext_vector_type(4)));
typedef float f32x2 __attribute__((ext_vector_type(2)));
typedef unsigned u32x4 __attribute__((ext_vector_type(4)));
typedef unsigned u32x2 __attribute__((ext_vector_type(2)));
typedef short bf16x8 __attribute__((ext_vector_type(8)));

constexpr int NB = 4, SEQ = 4096, M = NB * SEQ, D = 1024, FF = 2816, WB = 512, DEPTH = 2, MEML = 256, MMEM = NB * MEML;
constexpr int NZ = 4888, ZP = 4896, NINP = 5120, NIN = 8984;
constexpr int ZA_U = 0, ZA_O = 512, ZA_I = 1024, ZA_F = 1028, ZB_U = 1032, ZC_Q = 1544, ZC_K = 1800, ZC_V = 2056, ZC_G = 2568, ZC_A = 3080;
constexpr int ZD_R = 3096, ZD_K = 3608, ZD_V = 4120, ZD_XW = 4632, ZD_XA = 4696, ZD_XG = 4760, ZG = 4888;
constexpr float NORM_EPS = 1e-6f;

enum { I_X = 0, I_MEM, I_FFN1_NORM, I_FFN1_WG, I_FFN1_WU, I_FFN1_WD, I_MIX_NORM, I_W_IN, I_GATE_BIAS, I_ML_CONV, I_ML_WQ, I_ML_WK, I_ML_WV, I_ML_BI, I_ML_BF,
       I_ML_NORM, I_ML_PROJ, I_S5_ARE, I_S5_AIM, I_S5_LOGSTEP, I_S5_BRE, I_S5_BIM, I_S5_CRE, I_S5_CIM, I_S5_D, I_S5_W1, I_S5_W2, I_GLA_AUP, I_GLA_ABIAS,
       I_GLA_NORM, I_GLA_PROJ, I_RW_MU, I_RW_W0, I_RW_WUP, I_RW_A0, I_RW_AUP, I_RW_GUP, I_RW_KK, I_RW_KA, I_RW_RK, I_RW_NORM, I_RW_PROJ, I_W_OUT,
       I_XA_NORM, I_MEM_NORM, I_XA_WQ, I_XA_WK, I_XA_WV, I_XA_WO, I_FFN2_NORM, I_FFN2_WG, I_FFN2_WU, I_FFN2_WD, I_FINAL_NORM, N_INPUTS };

constexpr size_t MiB = 1u << 20;
constexpr size_t WS_CTL = 0, CTL_ZERO_BYTES = 64 * 1024;
constexpr size_t WS_SSQ = 1 * MiB;
constexpr size_t WS_MEMR = 256 * 1024;
constexpr size_t WS_XB = 2 * MiB;
constexpr size_t WS_MEMB = 34 * MiB;
constexpr size_t WS_KV = 36 * MiB;
constexpr size_t WS_SLOTA = 44 * MiB;
constexpr size_t WS_SLOTB = 55 * MiB;
constexpr size_t WS_SLOTC = 65 * MiB;
constexpr size_t WS_Z = 73 * MiB;
constexpr size_t Z_BYTES = (size_t)M * ZP * 2;
constexpr size_t WS_S = WS_Z + Z_BYTES;
constexpr size_t WS_END = 350110016;
static_assert(WS_S == 226 * MiB, "map");
constexpr size_t S_BYTES = WS_END - WS_S;
constexpr size_t WS_HID = WS_Z;
constexpr size_t WS_XQ = WS_Z, WS_XO = WS_Z + 32 * MiB, WS_XP = WS_Z + 64 * MiB;
constexpr size_t WS_G8 = WS_S, WS_MF = WS_S + 64 * MiB;
static_assert(WS_MF + 32 * MiB <= WS_END, "merge stash");

constexpr int LDS_BYTES = 147456, RING_BYTES = 131072, MISC_OFF = RING_BYTES + 320;

#define RLX_AGENT __ATOMIC_RELAXED, __HIP_MEMORY_SCOPE_AGENT
#define LDS_WAIT() asm volatile("s_waitcnt lgkmcnt(0)" ::: "memory")
#define VM_WAIT() asm volatile("s_waitcnt vmcnt(0)" ::: "memory")
typedef __bf16 bf16x2_t __attribute__((ext_vector_type(2)));
__device__ __forceinline__ unsigned pk2(float lo, float hi) { const f32x2 v = {lo, hi}; return __builtin_bit_cast(unsigned, __builtin_convertvector(v, bf16x2_t)); }
__device__ __forceinline__ unsigned f2bf(float f) { return pk2(f, 0.f); }
__device__ __forceinline__ float bf2f(unsigned h) { return __builtin_bit_cast(float, h << 16); }
__device__ __forceinline__ float bflo(unsigned w) { return __builtin_bit_cast(float, w << 16); }
__device__ __forceinline__ float bfhi(unsigned w) { return __builtin_bit_cast(float, w & 0xffff0000u); }
__device__ __forceinline__ float rcpf_(float x) { return __builtin_amdgcn_rcpf(x); }
__device__ __forceinline__ float rsqf_(float x) { return __builtin_amdgcn_rsqf(x); }
__device__ __forceinline__ float sigmoidf_(float x) { return rcpf_(1.0f + __expf(-x)); }
__device__ __forceinline__ float siluf_(float x) { return x * rcpf_(1.0f + __expf(-x)); }
__device__ __forceinline__ float softplusf_(float x) { return fmaxf(x, 0.f) + __logf(1.0f + __expf(-fabsf(x))); }
__device__ __forceinline__ float tanhf_(float x) { const float e = __expf(-2.0f * fabsf(x)); const float t = (1.0f - e) * rcpf_(1.0f + e); return x < 0.f ? -t : t; }
__device__ __forceinline__ float logsigmoidf_(float x) { return -softplusf_(-x); }
__device__ __forceinline__ float shx(float v, int mask, int lane) { return __builtin_bit_cast(float, __builtin_amdgcn_ds_bpermute((lane ^ mask) << 2, __builtin_bit_cast(int, v))); }
__device__ __forceinline__ float wave_sum(float v, int lane) {
#pragma unroll
    for (int o = 1; o < 64; o <<= 1) v += shx(v, o, lane);
    return v;
}

#define XB_TMO      128
#define XB_XCNT(j)  (256  + 64 * (j))
#define XB_XSUB(j)  (1280 + 64 * (j))
#define XB_XGEN(j)  (2304 + 64 * (j))
#define XB_TOP      3328
#define XB_TOPGEN   3392
#define XCD_BAR_WORDS 3456
#define XB_SPIN_CAP (1u << 20)
__device__ __forceinline__ unsigned xb_ld(unsigned* p)              { return __hip_atomic_load(p, __ATOMIC_RELAXED, __HIP_MEMORY_SCOPE_AGENT); }
__device__ __forceinline__ unsigned xb_add(unsigned* p, unsigned v) { return __hip_atomic_fetch_add(p, v, __ATOMIC_RELAXED, __HIP_MEMORY_SCOPE_AGENT); }
__device__ __forceinline__ unsigned xb_xcc_id() { return (unsigned)__builtin_amdgcn_s_getreg((3 << 11) | 20) & 0xFu; }
#define XB_SPIN(cond, bar) do { unsigned _sp = 0; while (cond) { __builtin_amdgcn_s_sleep(1); \
    if ((++_sp & 255u) == 0u) { if (xb_ld(&(bar)[XB_TMO])) break; if (_sp > XB_SPIN_CAP) { atomicAdd(&(bar)[XB_TMO], 1u); break; } } } } while (0)
struct XcdBarrier { unsigned* bar; unsigned x; volatile LAS unsigned* st; };
__device__ __forceinline__ XcdBarrier xcd_barrier_post(unsigned* bar, volatile LAS unsigned* st) {
    XcdBarrier b; b.bar = bar; b.x = xb_xcc_id(); b.st = st;
    if (threadIdx.x == 0) (void)xb_add(&bar[XB_XCNT(b.x)], 1u);
    return b;
}
__device__ __forceinline__ void xcd_barrier_complete(unsigned* bar, unsigned x, unsigned& nloc, unsigned& nx) {
    const unsigned G = gridDim.x * gridDim.y * gridDim.z;
    unsigned sum, cnt, mine, sp = 0u;
    for (;;) {
        sum = 0u; cnt = 0u; mine = 0u;
#pragma unroll
        for (unsigned j = 0; j < 16; ++j) { const unsigned c = xb_ld(&bar[XB_XCNT(j)]); sum += c; cnt += (c > 0u) ? 1u : 0u; mine = (j == x) ? c : mine; }
        if (sum == G) break;
        __builtin_amdgcn_s_sleep(1);
        if ((++sp & 255u) == 0u) { if (xb_ld(&bar[XB_TMO])) break; if (sp > XB_SPIN_CAP) { atomicAdd(&bar[XB_TMO], 1u); break; } }
    }
    nloc = mine > 0u ? mine : 1u; nx = cnt > 0u ? cnt : 1u;
}
__device__ __forceinline__ void xcd_barrier(const XcdBarrier& b) {
    asm volatile("s_waitcnt vmcnt(0)" ::: "memory");
    __syncthreads();
    if (threadIdx.x == 0) {
        unsigned* bar = b.bar;
        __builtin_amdgcn_s_waitcnt(0);
        unsigned nloc = b.st[0], nx = b.st[1];
        if (nloc == 0u) { xcd_barrier_complete(bar, b.x, nloc, nx); b.st[0] = nloc; b.st[1] = nx; }
        const unsigned old = xb_add(&bar[XB_XSUB(b.x)], 1u);
        const unsigned gen = old / nloc;
        if (old + 1u == (gen + 1u) * nloc) {
            __builtin_amdgcn_fence(__ATOMIC_RELEASE, "agent");
            asm volatile("s_waitcnt vmcnt(0)" ::: "memory");
            const unsigned og = xb_add(&bar[XB_TOP], 1u);
            const unsigned tg = og / nx;
            if (og + 1u == (tg + 1u) * nx) xb_add(&bar[XB_TOPGEN], 1u);
            else XB_SPIN(xb_ld(&bar[XB_TOPGEN]) == tg, bar);
            __builtin_amdgcn_fence(__ATOMIC_ACQUIRE, "agent");
            xb_add(&bar[XB_XGEN(b.x)], 1u);
            asm volatile("s_waitcnt vmcnt(0)" ::: "memory");
        } else {
            XB_SPIN(xb_ld(&bar[XB_XGEN(b.x)]) == gen, bar);
            __builtin_amdgcn_fence(__ATOMIC_ACQUIRE, "agent");
            asm volatile("s_waitcnt vmcnt(0)" ::: "memory");
        }
    }
    __syncthreads();
}
namespace pg8 {
#define PG8_LAS __attribute__((address_space(3)))
typedef unsigned short bf16_t;
typedef short bf16x8 __attribute__((ext_vector_type(8)));
typedef float f32x4 __attribute__((ext_vector_type(4)));
typedef unsigned u32x4 __attribute__((ext_vector_type(4)));
constexpr int BM = 256, BK = 64, HALF = 128, HTB = HALF * BK * 2  , STAGE_BYTES = 8 * HTB, NXCD = 8, WGM = 8;

__host__ __device__ __forceinline__ int lds_byte(int r, int c) { const int st = (r >> 4) * 2 + (c >> 5), rr = r & 15, cc = c & 31, ob = rr * 64 + cc * 2; return st * 1024 + (ob ^ (((ob >> 9) & 1) << 5)); }
__host__ __device__ __forceinline__ void stage_rc(int b, int& R, int& C) { const int st = b / 1024, sb = b % 1024, swz = sb ^ (((sb >> 9) & 1) << 5); R = (st >> 1) * 16 + swz / 64; C = (st & 1) * 32 + (swz % 64) / 2; }
__host__ __device__ __forceinline__ int perm32(int rho) { const int n = rho >> 4, i = rho & 15; return 8 * (i >> 2) + 4 * n + (i & 3); }

struct Unit { int pm, pn, job; };
struct Gemm { const bf16_t* A; const bf16_t* Bt; int M, N, K, lda, ldb; };

struct StaticOrder {
    int nM, nN, nwg, G, c;
    __host__ __device__ void init(int M, int N, int G_, int c_) { nM = M / BM; nN = N / BM; nwg = nM * nN; G = G_; c = c_; }
    __host__ __device__ __forceinline__ bool next(int i, Unit& u) const {
        const long L = (long)i * G + c; if (L >= nwg) return false;
        int wgid = (int)L; { const int q = nwg / NXCD, r = nwg % NXCD, xcd = wgid % NXCD, off = wgid / NXCD; wgid = (xcd < r ? xcd * (q + 1) : r * (q + 1) + (xcd - r) * q) + off; }
        const int nig = WGM * nN, gid = wgid / nig, fm = gid * WGM, gsz = (nM - fm) < WGM ? (nM - fm) : WGM;
        u.pm = fm + ((wgid % nig) % gsz); u.pn = (wgid % nig) / gsz; u.job = 0; return true;
    }
    __device__ __forceinline__ void a_ready(const Unit&) const {}
    __device__ __forceinline__ void done(const Unit&) const {}
    __device__ __forceinline__ const char* baseA(const Gemm& g, const Unit&) const { return (const char*)g.A; }
    __device__ __forceinline__ const char* baseB(const Gemm& g, const Unit&) const { return (const char*)g.Bt; }
};


struct SingleUnit {
    __device__ __forceinline__ bool next(int i, Unit& u) const { if (i > 0) return false; u.pm = 0; u.pn = 0; u.job = 0; return true; }
    __device__ __forceinline__ void a_ready(const Unit&) const {}
    __device__ __forceinline__ void done(const Unit&) const {}
    __device__ __forceinline__ const char* baseA(const Gemm& g, const Unit&) const { return (const char*)g.A; }
    __device__ __forceinline__ const char* baseB(const Gemm& g, const Unit&) const { return (const char*)g.Bt; }
};
typedef __bf16 bf16x2_cv __attribute__((ext_vector_type(2))); typedef float f32x2_cv __attribute__((ext_vector_type(2)));
__device__ __forceinline__ unsigned cvt_pk_bf16(float lo, float hi) { const f32x2_cv v = {lo, hi}; return __builtin_bit_cast(unsigned, __builtin_convertvector(v, bf16x2_cv)); }
template <class Epi, class Sched, bool ALIGN_EPI = false, bool SP2 = false>
__device__ __forceinline__ void gemm_phase(PG8_LAS unsigned char* lds, const Gemm g, const Sched& S, const Epi& E) {
    int tid_ = threadIdx.x; asm volatile("" : "+v"(tid_));
    const int tid = tid_, wid = __builtin_amdgcn_readfirstlane(tid >> 6), lane = tid & 63, wr = wid >> 2, wc = wid & 3, fr = lane & 15, fq = lane >> 4;
    const int K = g.K, nt = K / BK, lda = g.lda, ldb = g.ldb;
    unsigned voffA[2], voffB[2];
#pragma unroll
    for (int i = 0; i < 2; ++i) { int R, C; stage_rc(tid * 16 + i * 8192, R, C); const int Rb = Epi::PERM ? ((R & ~31) + perm32(R & 31)) : R;
        voffA[i] = (unsigned)(R * lda + C) * 2u; voffB[i] = (unsigned)(Rb * ldb + C) * 2u; }
    const size_t kstep = (size_t)(BK * 2);
    const size_t hstepA = (size_t)HALF * lda * 2, hstepB = (size_t)HALF * ldb * 2;
    const size_t tstepA = 2 * hstepA, tstepB = 2 * hstepB;
    const unsigned ldsw = (unsigned)wid * 1024u;
    const int aoff = lds_byte(wr * 64 + fr, fq * 8), boff = lds_byte(wc * 32 + fr, fq * 8);
#define PG8_SA(b, h) (((b) * 2 + (h)) * HTB)
#define PG8_SB(b, h) ((4 + (b) * 2 + (h)) * HTB)
#define PG8_STAGE(bufoff, gbase, voff) do { _Pragma("unroll") for (int _i = 0; _i < 2; ++_i) \
        __builtin_amdgcn_global_load_lds((const unsigned*)((const char*)(gbase) + (voff)[_i]), (PG8_LAS unsigned*)(lds + (bufoff) + ldsw + _i * 8192), 16, 0, 0); } while (0)
#define PG8_LDA(dst, b, h) do { _Pragma("unroll") for (int m = 0; m < 4; ++m) _Pragma("unroll") for (int k = 0; k < 2; ++k) dst[m][k] = *(const PG8_LAS bf16x8*)(lds + PG8_SA(b, h) + aoff + m * 2048 + k * 1024); } while (0)
#define PG8_LDB(dst, b, h) do { _Pragma("unroll") for (int n = 0; n < 2; ++n) _Pragma("unroll") for (int k = 0; k < 2; ++k) dst[n][k] = *(const PG8_LAS bf16x8*)(lds + PG8_SB(b, h) + boff + n * 2048 + k * 1024); } while (0)
#define PG8_MMA(ai, bj, At, Bt) do { __builtin_amdgcn_s_setprio(1); _Pragma("unroll") for (int m = 0; m < 4; ++m) _Pragma("unroll") for (int n = 0; n < 2; ++n) _Pragma("unroll") for (int k = 0; k < 2; ++k) \
        acc[ai][bj][m][n] = __builtin_amdgcn_mfma_f32_16x16x32_bf16(Bt[n][k], At[m][k], acc[ai][bj][m][n], 0, 0, 0); __builtin_amdgcn_s_setprio(0); } while (0)
#define PG8_WAIT_V(n) asm volatile("s_waitcnt vmcnt(" #n ")" ::: "memory")
#define PG8_WAIT_L(n) asm volatile("s_waitcnt lgkmcnt(" #n ")" ::: "memory")
#define PG8_BAR __builtin_amdgcn_s_barrier()
#define PG8_SCHED __builtin_amdgcn_sched_barrier(0)
    Unit cur, nxt; int ui = 0;
    if (!S.next(0, cur)) return;
    f32x4 acc[2][2][4][2];
#pragma unroll
    for (int a = 0; a < 2; ++a)
#pragma unroll
        for (int b = 0; b < 2; ++b)
#pragma unroll
            for (int m = 0; m < 4; ++m)
#pragma unroll
                for (int n = 0; n < 2; ++n) acc[a][b][m][n] = (f32x4){0.f, 0.f, 0.f, 0.f};
    bf16x8 At[4][2], B0[2][2], B1[2][2];
    const char* cA = S.baseA(g, cur) + (size_t)cur.pm * tstepA; const char* cB = S.baseB(g, cur) + (size_t)cur.pn * tstepB;
    S.a_ready(cur);
    if constexpr (SP2) {
        PG8_STAGE(PG8_SB(0, 0), cB, voffB); PG8_STAGE(PG8_SB(0, 1), cB + hstepB, voffB); PG8_STAGE(PG8_SA(0, 0), cA, voffA); PG8_STAGE(PG8_SA(0, 1), cA + hstepA, voffA);
        if (wr == 1) PG8_BAR;
        PG8_WAIT_V(2); PG8_BAR;
        PG8_STAGE(PG8_SB(1, 0), cB + kstep, voffB); PG8_STAGE(PG8_SA(1, 0), cA + kstep, voffA); PG8_STAGE(PG8_SB(1, 1), cB + hstepB + kstep, voffB);
        PG8_WAIT_V(6); PG8_BAR;
    } else {
        PG8_STAGE(PG8_SB(0, 0), cB, voffB); PG8_STAGE(PG8_SA(0, 0), cA, voffA); PG8_STAGE(PG8_SB(0, 1), cB + hstepB, voffB); PG8_STAGE(PG8_SA(0, 1), cA + hstepA, voffA);
        if (wr == 1) PG8_BAR;
        PG8_WAIT_V(4); PG8_BAR;
        PG8_STAGE(PG8_SB(1, 0), cB + kstep, voffB); PG8_STAGE(PG8_SA(1, 0), cA + kstep, voffA); PG8_STAGE(PG8_SB(1, 1), cB + hstepB + kstep, voffB);
        PG8_WAIT_V(6); PG8_BAR;
    }
    for (;;) {
        const bool has_next = S.next(ui + 1, nxt);
        const char* nA = has_next ? S.baseA(g, nxt) + (size_t)nxt.pm * tstepA : cA; const char* nB = has_next ? S.baseB(g, nxt) + (size_t)nxt.pn * tstepB : cB;
        for (int t = 0; t < nt; t += 2) {
            const bool last = (t == nt - 2);
            const char* a1 = cA + (size_t)(t + 1) * kstep;
            const char* a2 = last ? nA : cA + (size_t)(t + 2) * kstep; const char* b2 = last ? nB : cB + (size_t)(t + 2) * kstep;
            const char* a3 = a2 + kstep; const char* b3 = b2 + kstep;
            if (last && has_next) S.a_ready(nxt);
            if constexpr (SP2) {
            PG8_LDB(B0, 0, 0); PG8_LDB(B1, 0, 1); PG8_SCHED; PG8_LDA(At, 0, 0); PG8_STAGE(PG8_SA(1, 1), a1 + hstepA, voffA);
            PG8_WAIT_V(8); PG8_WAIT_L(0); PG8_BAR; PG8_MMA(0, 0, At, B0); PG8_MMA(0, 1, At, B1); PG8_BAR; PG8_SCHED;
            PG8_LDA(At, 0, 1); PG8_STAGE(PG8_SB(0, 0), b2, voffB); PG8_STAGE(PG8_SB(0, 1), b2 + hstepB, voffB); PG8_STAGE(PG8_SA(0, 0), a2, voffA);
            PG8_WAIT_V(8); PG8_WAIT_L(0); PG8_BAR; PG8_MMA(1, 0, At, B0); PG8_MMA(1, 1, At, B1); PG8_BAR; PG8_SCHED;
            PG8_LDB(B0, 1, 0); PG8_LDB(B1, 1, 1); PG8_SCHED; PG8_LDA(At, 1, 0); PG8_STAGE(PG8_SA(0, 1), a2 + hstepA, voffA);
            PG8_WAIT_V(8); PG8_WAIT_L(0); PG8_BAR; PG8_MMA(0, 0, At, B0); PG8_MMA(0, 1, At, B1); PG8_BAR; PG8_SCHED;
            PG8_LDA(At, 1, 1); PG8_STAGE(PG8_SB(1, 0), b3, voffB); PG8_STAGE(PG8_SB(1, 1), b3 + hstepB, voffB); PG8_STAGE(PG8_SA(1, 0), a3, voffA);
            PG8_WAIT_V(8); PG8_WAIT_L(0); PG8_BAR; PG8_MMA(1, 0, At, B0); PG8_MMA(1, 1, At, B1); PG8_BAR; PG8_SCHED;
            } else {
            PG8_LDB(B0, 0, 0); PG8_SCHED; PG8_LDA(At, 0, 0); PG8_STAGE(PG8_SA(1, 1), a1 + hstepA, voffA);
            PG8_WAIT_L(8); PG8_BAR; PG8_WAIT_L(0); PG8_MMA(0, 0, At, B0); PG8_BAR; PG8_SCHED;
            PG8_LDB(B1, 0, 1); PG8_STAGE(PG8_SB(0, 0), b2, voffB);
            PG8_BAR; PG8_WAIT_L(0); PG8_MMA(0, 1, At, B1); PG8_BAR;
            PG8_LDA(At, 0, 1); PG8_STAGE(PG8_SA(0, 0), a2, voffA);
            PG8_BAR; PG8_WAIT_L(0); PG8_MMA(1, 0, At, B0); PG8_BAR; PG8_SCHED;
            PG8_STAGE(PG8_SB(0, 1), b2 + hstepB, voffB);
            PG8_WAIT_V(6); PG8_BAR; PG8_MMA(1, 1, At, B1); PG8_BAR;
            PG8_LDB(B0, 1, 0); PG8_SCHED; PG8_LDA(At, 1, 0); PG8_STAGE(PG8_SA(0, 1), a2 + hstepA, voffA);
            PG8_WAIT_L(8); PG8_BAR; PG8_WAIT_L(0); PG8_MMA(0, 0, At, B0); PG8_BAR; PG8_SCHED;
            PG8_LDB(B1, 1, 1); PG8_STAGE(PG8_SB(1, 0), b3, voffB);
            PG8_BAR; PG8_WAIT_L(0); PG8_MMA(0, 1, At, B1); PG8_BAR;
            PG8_LDA(At, 1, 1); PG8_STAGE(PG8_SA(1, 0), a3, voffA);
            PG8_BAR; PG8_WAIT_L(0); PG8_MMA(1, 0, At, B0); PG8_BAR; PG8_SCHED;
            PG8_STAGE(PG8_SB(1, 1), b3 + hstepB, voffB);
            PG8_WAIT_V(6); PG8_BAR; PG8_MMA(1, 1, At, B1); PG8_BAR;
            }
        }
        if constexpr (ALIGN_EPI) { if (wr == 0) PG8_BAR; }
        if constexpr (!Epi::AFTER_DRAIN) { E(acc, cur, wr, wc, fr, fq); S.done(cur); }
        if (!has_next) break;
#pragma unroll
        for (int a = 0; a < 2; ++a)
#pragma unroll
            for (int b = 0; b < 2; ++b)
#pragma unroll
                for (int m = 0; m < 4; ++m)
#pragma unroll
                    for (int n = 0; n < 2; ++n) acc[a][b][m][n] = (f32x4){0.f, 0.f, 0.f, 0.f};
        cur = nxt; cA = nA; cB = nB; ++ui;
        if constexpr (ALIGN_EPI) { if (wr == 1) PG8_BAR; }
    }
    PG8_WAIT_V(0);
    if constexpr (!ALIGN_EPI) { if (wr == 0) PG8_BAR; }
    PG8_BAR;
    if constexpr (Epi::AFTER_DRAIN) { E.fused(acc, cur, wr, wc, fr, fq, lds, wid, lane); S.done(cur); }
#undef PG8_SA
#undef PG8_SB
#undef PG8_STAGE
#undef PG8_LDA
#undef PG8_LDB
#undef PG8_MMA
#undef PG8_WAIT_V
#undef PG8_WAIT_L
#undef PG8_BAR
#undef PG8_SCHED
}
}

using pg8::Unit; using pg8::cvt_pk_bf16;
#define EPI_ARGS const f32x4 (&acc)[2][2][4][2], const Unit& u, int wr, int wc, int fr, int fq
__device__ __forceinline__ float row_rstd(const float* ssq, int row) {
    const f32x4* p = (const f32x4*)(ssq + (size_t)row * 16);
    const f32x4 a = p[0], b = p[1], c = p[2], d = p[3];
    const float s = ((a[0] + a[1]) + (a[2] + a[3])) + ((b[0] + b[1]) + (b[2] + b[3])) + ((c[0] + c[1]) + (c[2] + c[3])) + ((d[0] + d[1]) + (d[2] + d[3]));
    return rsqf_(s * (1.0f / D) + NORM_EPS);
}
struct EpiSwiglu {
    static constexpr bool PERM = true, AFTER_DRAIN = false;
    bf16* H; const float* ssq;
    __device__ __forceinline__ void operator()(EPI_ARGS) const {
#pragma unroll
        for (int ai = 0; ai < 2; ++ai)
#pragma unroll
            for (int m = 0; m < 4; ++m) {
                const int row = u.pm * 256 + ai * 128 + wr * 64 + m * 16 + fr; const float rs = row_rstd(ssq, row); float v[8];
#pragma unroll
                for (int n = 0; n < 2; ++n) { const f32x4 g = acc[ai][0][m][n] * rs, up = acc[ai][1][m][n] * rs;
#pragma unroll
                    for (int j = 0; j < 4; ++j) v[4 * n + j] = siluf_(g[j]) * up[j]; }
                u32x4 w; w.x = cvt_pk_bf16(v[0], v[1]); w.y = cvt_pk_bf16(v[2], v[3]); w.z = cvt_pk_bf16(v[4], v[5]); w.w = cvt_pk_bf16(v[6], v[7]);
                *(u32x4*)(H + (size_t)row * FF + u.pn * 128 + wc * 32 + fq * 8) = w;
            }
    }
};
struct EpiResid {
    static constexpr bool PERM = false, AFTER_DRAIN = false;
    const float* Xin; float* X; bf16* XB; float* ssq; float alpha;
    __device__ __forceinline__ void operator()(EPI_ARGS) const {
#pragma unroll
        for (int ai = 0; ai < 2; ++ai)
#pragma unroll
            for (int m = 0; m < 4; ++m) {
                const int row = u.pm * 256 + ai * 128 + wr * 64 + m * 16 + fr; float s = 0.f;
#pragma unroll
                for (int bj = 0; bj < 2; ++bj)
#pragma unroll
                    for (int n = 0; n < 2; ++n) {
                        const size_t off = (size_t)row * D + u.pn * 256 + bj * 128 + wc * 32 + n * 16 + fq * 4;
                        const f32x4 xn = *(const f32x4*)(Xin + off) + acc[ai][bj][m][n] * alpha;
                        *(f32x4*)(X + off) = xn;
                        u32x2 w; w.x = cvt_pk_bf16(xn[0], xn[1]); w.y = cvt_pk_bf16(xn[2], xn[3]);
                        *(u32x2*)(XB + off) = w;
                        s += (xn[0] * xn[0] + xn[1] * xn[1]) + (xn[2] * xn[2] + xn[3] * xn[3]);
                    }
                s += shx(s, 16, fq * 16 + fr); s += shx(s, 32, fq * 16 + fr);
                if (fq == 0) ssq[(size_t)row * 16 + u.pn * 4 + wc] = s;
            }
    }
};
struct EpiBf16 {
    static constexpr bool PERM = true, AFTER_DRAIN = false;
    bf16* O; int ldc; const float* ssq; float scale; int ncols;
    __device__ __forceinline__ void operator()(EPI_ARGS) const {
#pragma unroll
        for (int ai = 0; ai < 2; ++ai)
#pragma unroll
            for (int m = 0; m < 4; ++m) {
                const int row = u.pm * 256 + ai * 128 + wr * 64 + m * 16 + fr; const float rs = (ssq ? row_rstd(ssq, row) : 1.0f) * scale;
#pragma unroll
                for (int bj = 0; bj < 2; ++bj) {
                    const int col = u.pn * 256 + bj * 128 + wc * 32 + fq * 8;
                    if (col < ncols) {
                        const f32x4 v0 = acc[ai][bj][m][0] * rs, v1 = acc[ai][bj][m][1] * rs; u32x4 w;
                        w.x = cvt_pk_bf16(v0[0], v0[1]); w.y = cvt_pk_bf16(v0[2], v0[3]); w.z = cvt_pk_bf16(v1[0], v1[1]); w.w = cvt_pk_bf16(v1[2], v1[3]);
                        *(u32x4*)(O + (size_t)row * ldc + col) = w;
                    }
                }
            }
    }
};
struct EpiZ {
    static constexpr bool PERM = true, AFTER_DRAIN = false;
    bf16* O; const float* ssq; bf16* HALO;
    __device__ __forceinline__ void operator()(EPI_ARGS) const {
#pragma unroll
        for (int ai = 0; ai < 2; ++ai)
#pragma unroll
            for (int m = 0; m < 4; ++m) {
                const int row = u.pm * 256 + ai * 128 + wr * 64 + m * 16 + fr; const float rs = row_rstd(ssq, row);
#pragma unroll
                for (int bj = 0; bj < 2; ++bj) {
                    const int col = u.pn * 256 + bj * 128 + wc * 32 + fq * 8;
                    if (col < NZ) {
                        const f32x4 v0 = acc[ai][bj][m][0] * rs, v1 = acc[ai][bj][m][1] * rs; u32x4 w;
                        w.x = cvt_pk_bf16(v0[0], v0[1]); w.y = cvt_pk_bf16(v0[2], v0[3]); w.z = cvt_pk_bf16(v1[0], v1[1]); w.w = cvt_pk_bf16(v1[2], v1[3]);
                        *(u32x4*)(O + (size_t)row * ZP + col) = w;
                        if ((row & 63) == 63 && col >= ZD_R && col < ZD_V) *(u32x4*)(HALO + (size_t)(row >> 6) * 1024 + (col - ZD_R)) = w;
                    }
                }
            }
    }
};
struct EpiKV {
    static constexpr bool PERM = true, AFTER_DRAIN = false;
    bf16* Kd; bf16* VT; const float* rstd;
    __device__ __forceinline__ void operator()(EPI_ARGS) const {
#pragma unroll
        for (int ai = 0; ai < 2; ++ai)
#pragma unroll
            for (int m = 0; m < 4; ++m) {
                const int row = u.pm * 256 + ai * 128 + wr * 64 + m * 16 + fr; const float rs = rstd[row];
#pragma unroll
                for (int bj = 0; bj < 2; ++bj) {
                    const int col = u.pn * 256 + bj * 128 + wc * 32 + fq * 8;
                    const f32x4 v0 = acc[ai][bj][m][0] * rs, v1 = acc[ai][bj][m][1] * rs;
                    if (col < D) {
                        u32x4 w; w.x = cvt_pk_bf16(v0[0], v0[1]); w.y = cvt_pk_bf16(v0[2], v0[3]); w.z = cvt_pk_bf16(v1[0], v1[1]); w.w = cvt_pk_bf16(v1[2], v1[3]);
                        *(u32x4*)(Kd + (size_t)row * D + col) = w;
                    } else {
#pragma unroll
                        for (int j = 0; j < 4; ++j) { VT[(size_t)(col - D + j) * MMEM + row] = (bf16)f2bf(v0[j]); VT[(size_t)(col - D + 4 + j) * MMEM + row] = (bf16)f2bf(v1[j]); }
                    }
                }
            }
    }
};
__device__ __forceinline__ size_t stash_idx(int T, int ai, int m, int bj, int wr, int wc, int fr, int fq) { return (size_t)(T * 16 + (ai * 4 + m) * 2 + bj) * 512 + (size_t)((wr * 4 + wc) * 64 + fq * 16 + fr); }
__device__ __forceinline__ u32x2 pack_u8(const float* v) {
    unsigned b[8];
#pragma unroll
    for (int j = 0; j < 8; ++j) b[j] = (unsigned)(v[j] * 255.0f + 0.5f);
    u32x2 w; w.x = b[0] | (b[1] << 8) | (b[2] << 16) | (b[3] << 24); w.y = b[4] | (b[5] << 8) | (b[6] << 16) | (b[7] << 24); return w;
}
__device__ __forceinline__ void unpack_u8(u32x2 w, float* v) {
#pragma unroll
    for (int j = 0; j < 4; ++j) { v[j] = (float)((w.x >> (8 * j)) & 255u) * (1.0f / 255.0f); v[4 + j] = (float)((w.y >> (8 * j)) & 255u) * (1.0f / 255.0f); }
}
struct OwnTile4 {
    int pm, pn0;
    __device__ __forceinline__ bool next(int i, Unit& u) const { if (i >= 4) return false; u.pm = pm; u.pn = 4 * i + pn0; u.job = 0; return true; }
    __device__ __forceinline__ void a_ready(const Unit&) const {}
    __device__ __forceinline__ void done(const Unit&) const {}
    __device__ __forceinline__ const char* baseA(const pg8::Gemm& g, const Unit&) const { return (const char*)g.A; }
    __device__ __forceinline__ const char* baseB(const pg8::Gemm& g, const Unit&) const { return (const char*)g.Bt; }
};
struct EpiGate8 {
    static constexpr bool PERM = true, AFTER_DRAIN = false;
    unsigned char* G8; const float* ssq; const float* bias;
    __device__ __forceinline__ void operator()(EPI_ARGS) const {
        const int br = u.pn >> 2, T = u.pm * 4 + (u.pn & 3);
#pragma unroll
        for (int ai = 0; ai < 2; ++ai)
#pragma unroll
            for (int m = 0; m < 4; ++m) {
                const int row = u.pm * 256 + ai * 128 + wr * 64 + m * 16 + fr; const float rs = row_rstd(ssq, row);
#pragma unroll
                for (int bj = 0; bj < 2; ++bj) {
                    const int col = u.pn * 256 + bj * 128 + wc * 32 + fq * 8; float v[8];
#pragma unroll
                    for (int n = 0; n < 2; ++n) { const f32x4 b = *(const f32x4*)(bias + col + 4 * n);
#pragma unroll
                        for (int j = 0; j < 4; ++j) v[4 * n + j] = sigmoidf_(acc[ai][bj][m][n][j] * rs + b[j]); }
                    *(u32x2*)(G8 + ((size_t)br * 256 * 16 * 512 + stash_idx(T, ai, m, bj, wr, wc, fr, fq)) * 8) = pack_u8(v);
                }
            }
    }
};
struct EpiGlu8 {
    static constexpr bool PERM = true, AFTER_DRAIN = false;
    unsigned char* G8;
    __device__ __forceinline__ void operator()(EPI_ARGS) const {
        const int T = u.pm * 4 + u.pn;
#pragma unroll
        for (int ai = 0; ai < 2; ++ai)
#pragma unroll
            for (int m = 0; m < 4; ++m)
#pragma unroll
                for (int bj = 0; bj < 2; ++bj) {
                    u32x2* p = (u32x2*)(G8 + ((size_t)1 * 256 * 16 * 512 + stash_idx(T, ai, m, bj, wr, wc, fr, fq)) * 8); float g[8]; unpack_u8(*p, g);
#pragma unroll
                    for (int n = 0; n < 2; ++n)
#pragma unroll
                        for (int j = 0; j < 4; ++j) g[4 * n + j] *= sigmoidf_(acc[ai][bj][m][n][j]);
                    *p = pack_u8(g);
                }
    }
};
template <int MODE> struct EpiMerge8 {
    static constexpr bool PERM = true, AFTER_DRAIN = false;
    const unsigned char* G8; int br; bf16* MF; bf16* MG; int ldg;
    __device__ __forceinline__ void operator()(EPI_ARGS) const {
        const int T = u.pm * 4 + u.pn;
#pragma unroll
        for (int ai = 0; ai < 2; ++ai)
#pragma unroll
            for (int m = 0; m < 4; ++m) {
                const int row = u.pm * 256 + ai * 128 + wr * 64 + m * 16 + fr;
#pragma unroll
                for (int bj = 0; bj < 2; ++bj) {
                    const size_t si = stash_idx(T, ai, m, bj, wr, wc, fr, fq); float g[8];
                    unpack_u8(*(const u32x2*)(G8 + ((size_t)br * 256 * 16 * 512 + si) * 8), g);
                    f32x4 v0 = acc[ai][bj][m][0], v1 = acc[ai][bj][m][1];
#pragma unroll
                    for (int j = 0; j < 4; ++j) { v0[j] *= g[j]; v1[j] *= g[4 + j]; }
                    if (MODE != 0) { const u32x4 o = *(const u32x4*)(MF + si * 8); v0[0] += bflo(o.x); v0[1] += bfhi(o.x); v0[2] += bflo(o.y); v0[3] += bfhi(o.y); v1[0] += bflo(o.z); v1[1] += bfhi(o.z); v1[2] += bflo(o.w); v1[3] += bfhi(o.w); }
                    u32x4 w; w.x = cvt_pk_bf16(v0[0], v0[1]); w.y = cvt_pk_bf16(v0[2], v0[3]); w.z = cvt_pk_bf16(v1[0], v1[1]); w.w = cvt_pk_bf16(v1[2], v1[3]);
                    if (MODE != 2) *(u32x4*)(MF + si * 8) = w;
                    else *(u32x4*)(MG + (size_t)row * ldg + u.pn * 256 + bj * 128 + wc * 32 + fq * 8) = w;
                }
            }
    }
};
struct EpiSoftmaxP {
    static constexpr bool PERM = true, AFTER_DRAIN = true;
    bf16* P;
    __device__ __forceinline__ void fused(f32x4 (&acc)[2][2][4][2], const Unit& u, int wr, int wc, int fr, int fq, PG8_LAS unsigned char* lds, int wid, int lane) const {
        PG8_LAS float* RM = (PG8_LAS float*)lds;
        PG8_LAS float* RS = (PG8_LAS float*)(lds + 4096);
#pragma unroll
        for (int ai = 0; ai < 2; ++ai)
#pragma unroll
            for (int m = 0; m < 4; ++m) {
                float mx = -3.0e38f;
#pragma unroll
                for (int bj = 0; bj < 2; ++bj)
#pragma unroll
                    for (int n = 0; n < 2; ++n) { const f32x4 x = acc[ai][bj][m][n]; mx = fmaxf(mx, fmaxf(fmaxf(x[0], x[1]), fmaxf(x[2], x[3]))); }
                mx = fmaxf(mx, shx(mx, 16, fq * 16 + fr)); mx = fmaxf(mx, shx(mx, 32, fq * 16 + fr));
                if (fq == 0) RM[(ai * 128 + wr * 64 + m * 16 + fr) * 4 + wc] = mx;
            }
        asm volatile("s_waitcnt lgkmcnt(0)" ::: "memory"); __builtin_amdgcn_s_barrier(); asm volatile("" ::: "memory");
#pragma unroll
        for (int ai = 0; ai < 2; ++ai)
#pragma unroll
            for (int m = 0; m < 4; ++m) {
                const int rl = ai * 128 + wr * 64 + m * 16 + fr;
                const float mx = fmaxf(fmaxf(RM[rl * 4 + 0], RM[rl * 4 + 1]), fmaxf(RM[rl * 4 + 2], RM[rl * 4 + 3])); float s = 0.f;
#pragma unroll
                for (int bj = 0; bj < 2; ++bj)
#pragma unroll
                    for (int n = 0; n < 2; ++n)
#pragma unroll
                        for (int j = 0; j < 4; ++j) { const float p = __builtin_amdgcn_exp2f(acc[ai][bj][m][n][j] - mx); acc[ai][bj][m][n][j] = p; s += p; }
                s += shx(s, 16, fq * 16 + fr); s += shx(s, 32, fq * 16 + fr);
                if (fq == 0) RS[rl * 4 + wc] = s;
            }
        asm volatile("s_waitcnt lgkmcnt(0)" ::: "memory"); __builtin_amdgcn_s_barrier(); asm volatile("" ::: "memory");
#pragma unroll
        for (int ai = 0; ai < 2; ++ai)
#pragma unroll
            for (int m = 0; m < 4; ++m) {
                const int rl = ai * 128 + wr * 64 + m * 16 + fr;
                const float inv = rcpf_((RS[rl * 4 + 0] + RS[rl * 4 + 1]) + (RS[rl * 4 + 2] + RS[rl * 4 + 3]));
#pragma unroll
                for (int bj = 0; bj < 2; ++bj) {
                    const f32x4 v0 = acc[ai][bj][m][0] * inv, v1 = acc[ai][bj][m][1] * inv; u32x4 w;
                    w.x = cvt_pk_bf16(v0[0], v0[1]); w.y = cvt_pk_bf16(v0[2], v0[3]); w.z = cvt_pk_bf16(v1[0], v1[1]); w.w = cvt_pk_bf16(v1[2], v1[3]);
                    *(u32x4*)(P + (size_t)rl * 256 + bj * 128 + wc * 32 + fq * 8) = w;
                }
            }
        asm volatile("s_waitcnt lgkmcnt(0)" ::: "memory"); __builtin_amdgcn_s_barrier(); asm volatile("" ::: "memory");
    }
};
struct Args { const float* in[N_INPUTS]; float* out; unsigned char* ws; };
typedef const float* cfptr;
typedef __attribute__((address_space(4))) const cfptr* kin_t;
struct Ctx {
    LAS unsigned char* lds; int tid, lane, wave, G, bid;
    kin_t in; float* X; unsigned char* ws;
    __device__ __forceinline__ const float* inp(int i, int l, size_t per_layer) const { return in[i] + (size_t)l * per_layer; }
};
__device__ __forceinline__ Ctx make_ctx() {
    extern __shared__ __attribute__((aligned(16))) unsigned char lds_raw[];
    Ctx C; int t = threadIdx.x; asm volatile("" : "+v"(t));
    kin_t k = (kin_t)__builtin_amdgcn_kernarg_segment_ptr(); asm volatile("" : "+s"(k));
    C.lds = (LAS unsigned char*)lds_raw; C.tid = t; C.lane = t & 63; C.wave = __builtin_amdgcn_readfirstlane(t >> 6);
    C.G = gridDim.x; C.bid = blockIdx.x; C.in = k;
    C.X = (float*)k[N_INPUTS]; C.ws = (unsigned char*)k[N_INPUTS + 1];
    return C;
}
#ifdef PROBE_LO
#define PROBE_STAMP(Cb) do { if (blockIdx.x == 0 && (Cb).tid == 0) { volatile LAS unsigned* m_ = (volatile LAS unsigned*)((Cb).lds + MISC_OFF); const unsigned i_ = m_[16]; m_[16] = i_ + 1u; \
    __hip_atomic_store((unsigned long long*)((Cb).ws + WS_CTL + 32768) + i_, (unsigned long long)__builtin_amdgcn_s_memrealtime(), __ATOMIC_RELAXED, __HIP_MEMORY_SCOPE_AGENT); } } while (0)
#else
#define PROBE_STAMP(Cb) do { } while (0)
#endif
constexpr size_t RWW_OFF = 93 * MiB;
struct ConvDesc { const float* W; const float* gain; bf16* dst; long alt; int ld, ncols, K, NR, kind, item0; };
constexpr int CD_OFF = 124 * 1024, CD_MAX = 24;
enum ConvJob { CJ_GU1 = 1, CJ_D1 = 2, CJ_WIN = 4, CJ_GATES = 8, CJ_PROJ = 16, CJ_XW = 32, CJ_GU2 = 64, CJ_D2 = 128, CJ_XKV0 = 256, CJ_XKV1 = 512, CJ_MLW = 1024, CJ_RWW = 2048, CJ_GU2S = 4096 };
constexpr size_t WS_GU2S = WS_S + 96 * MiB;
static_assert(WS_GU2S + 11 * MiB <= WS_END, "GU2 staging");
__device__ __forceinline__ void cd_put(const Ctx& C, int& n, int& items, const float* W, const float* gain, bf16* dst, long alt, int ld, int ncols, int K, int NR, int kind) {
    if (C.tid == 0) { LAS ConvDesc* d = (LAS ConvDesc*)(C.lds + CD_OFF) + n; d->W = W; d->gain = gain; d->dst = dst; d->alt = alt; d->ld = ld; d->ncols = ncols; d->K = K; d->NR = NR; d->kind = kind; d->item0 = items; }
    items += (K / 64) * (NR / 32); ++n;
}
__device__ __forceinline__ void conv_item(const LAS ConvDesc* d, int it, LAS float* scr, int lane) {
    const int K = d->K, NR = d->NR, kind = d->kind, ld = d->ld, ncols = d->ncols; const float* W = d->W; const float* gain = d->gain; bf16* dst = d->dst; const long alt = d->alt;
    const int nblk = NR / 32, kb = it / nblk, nb = it % nblk, k0 = 64 * kb, n0 = 32 * nb, n = n0 + (lane & 31);
    const float* p = nullptr;
    if (kind == 0) { if (n < ncols) p = W + n; }
    else if (kind == 1) { const int t = n >> 8, cl = n & 255, h = t * 128 + (cl & 127); p = W + (h + ((cl & 128) ? alt : 0l)); }
    else p = W + (n < D ? (long)n : alt + (long)(n - D));
    float v[32];
    if (p) { const float* q = p + (size_t)(k0 + (lane >> 5)) * ld;
#pragma unroll
        for (int i = 0; i < 32; ++i) v[i] = q[(size_t)(2 * i) * ld];
        if (gain) {
#pragma unroll
            for (int i = 0; i < 32; ++i) v[i] *= gain[k0 + 2 * i + (lane >> 5)]; }
    } else {
#pragma unroll
        for (int i = 0; i < 32; ++i) v[i] = 0.f; }
#pragma unroll
    for (int i = 0; i < 32; ++i) scr[(2 * i + (lane >> 5)) * 33 + (lane & 31)] = v[i];
    LDS_WAIT(); asm volatile("" ::: "memory");
    const int c = lane & 7;
#pragma unroll
    for (int j = 0; j < 4; ++j) { const int nn = (lane >> 3) + 8 * j; const LAS float* s = scr + (8 * c) * 33 + nn;
        u32x4 o; o.x = pk2(s[0 * 33], s[1 * 33]); o.y = pk2(s[2 * 33], s[3 * 33]); o.z = pk2(s[4 * 33], s[5 * 33]); o.w = pk2(s[6 * 33], s[7 * 33]);
        *(u32x4*)(dst + (size_t)(n0 + nn) * K + k0 + 8 * c) = o; }
    LDS_WAIT(); asm volatile("" ::: "memory");
}
struct ConvPlan { int n, items; };
__device__ __forceinline__ ConvPlan conv_setup(const Ctx& C, int jobs, int l) {
    unsigned char* ws = C.ws; int n = 0, items = 0;
    __syncthreads();
    if (jobs & CJ_GU1) cd_put(C, n, items, C.inp(I_FFN1_WG, l, (size_t)D * FF), C.inp(I_FFN1_NORM, l, D), (bf16*)(ws + WS_SLOTA), (long)(C.inp(I_FFN1_WU, l, (size_t)D * FF) - C.inp(I_FFN1_WG, l, (size_t)D * FF)), FF, 2 * FF, D, 2 * FF, 1);
    if (jobs & CJ_GU2) cd_put(C, n, items, C.inp(I_FFN2_WG, l, (size_t)D * FF), C.inp(I_FFN2_NORM, l, D), (bf16*)(ws + WS_SLOTA), (long)(C.inp(I_FFN2_WU, l, (size_t)D * FF) - C.inp(I_FFN2_WG, l, (size_t)D * FF)), FF, 2 * FF, D, 2 * FF, 1);
    if (jobs & CJ_GU2S) cd_put(C, n, items, C.inp(I_FFN2_WG, l, (size_t)D * FF), C.inp(I_FFN2_NORM, l, D), (bf16*)(ws + WS_GU2S), (long)(C.inp(I_FFN2_WU, l, (size_t)D * FF) - C.inp(I_FFN2_WG, l, (size_t)D * FF)), FF, 2 * FF, D, 2 * FF, 1);
    if (jobs & CJ_D1) cd_put(C, n, items, C.inp(I_FFN1_WD, l, (size_t)D * FF), nullptr, (bf16*)(ws + WS_SLOTC), 0, D, D, FF, D, 0);
    if (jobs & CJ_D2) cd_put(C, n, items, C.inp(I_FFN2_WD, l, (size_t)D * FF), nullptr, (bf16*)(ws + WS_SLOTC), 0, D, D, FF, D, 0);
    if (jobs & CJ_WIN) cd_put(C, n, items, C.inp(I_W_IN, l, (size_t)D * NIN), C.inp(I_MIX_NORM, l, D), (bf16*)(ws + WS_SLOTB), 0, NIN, NZ, D, NINP, 0);
    if (jobs & CJ_GATES) cd_put(C, n, items, C.inp(I_W_IN, l, (size_t)D * NIN) + ZG, C.inp(I_MIX_NORM, l, D), (bf16*)(ws + WS_SLOTA), 0, NIN, 4 * D, D, 4 * D, 0);
    if (jobs & CJ_PROJ) {
        cd_put(C, n, items, C.inp(I_ML_PROJ, l, (size_t)WB * D), nullptr, (bf16*)(ws + WS_SLOTC), 0, D, D, WB, D, 0);
        cd_put(C, n, items, C.inp(I_S5_W1, l, (size_t)WB * D), nullptr, (bf16*)(ws + WS_SLOTC + 1 * MiB), 0, D, D, WB, D, 0);
        cd_put(C, n, items, C.inp(I_S5_W2, l, (size_t)WB * D), nullptr, (bf16*)(ws + WS_SLOTC + 2 * MiB), 0, D, D, WB, D, 0);
        cd_put(C, n, items, C.inp(I_GLA_PROJ, l, (size_t)WB * D), nullptr, (bf16*)(ws + WS_SLOTC + 3 * MiB), 0, D, D, WB, D, 0);
        cd_put(C, n, items, C.inp(I_RW_PROJ, l, (size_t)WB * D), nullptr, (bf16*)(ws + WS_SLOTC + 4 * MiB), 0, D, D, WB, D, 0);
    }
    if (jobs & CJ_XW) {
        cd_put(C, n, items, C.inp(I_W_OUT, l, (size_t)D * D), nullptr, (bf16*)(ws + WS_SLOTB), 0, D, D, D, D, 0);
        cd_put(C, n, items, C.inp(I_XA_WQ, l, (size_t)D * D), C.inp(I_XA_NORM, l, D), (bf16*)(ws + WS_SLOTB + 2 * MiB), 0, D, D, D, D, 0);
        cd_put(C, n, items, C.inp(I_XA_WO, l, (size_t)D * D), nullptr, (bf16*)(ws + WS_SLOTB + 4 * MiB), 0, D, D, D, D, 0);
    }
    if (jobs & CJ_XKV0) cd_put(C, n, items, C.inp(I_XA_WK, 0, (size_t)D * D), C.inp(I_MEM_NORM, 0, D), (bf16*)(ws + WS_S), (long)(C.inp(I_XA_WV, 0, (size_t)D * D) - C.inp(I_XA_WK, 0, (size_t)D * D)), D, 2 * D, D, 2 * D, 2);
    if (jobs & CJ_XKV1) cd_put(C, n, items, C.inp(I_XA_WK, 1, (size_t)D * D), C.inp(I_MEM_NORM, 1, D), (bf16*)(ws + WS_S + 4 * MiB), (long)(C.inp(I_XA_WV, 1, (size_t)D * D) - C.inp(I_XA_WK, 1, (size_t)D * D)), D, 2 * D, D, 2 * D, 2);
    if (jobs & CJ_MLW) {
#pragma unroll
        for (int q = 0; q < 3; ++q)
#pragma unroll
            for (int hh = 0; hh < 4; ++hh) cd_put(C, n, items, C.inp(q == 0 ? I_ML_WQ : (q == 1 ? I_ML_WK : I_ML_WV), l, 4 * 16384) + hh * 16384, nullptr, (bf16*)(ws + 512 * 1024) + (size_t)(q * 4 + hh) * 16384, 0, 128, 128, 128, 128, 0);
    }
    if (jobs & CJ_RWW) {
        bf16* dst = (bf16*)(ws + WS_S + RWW_OFF);
        cd_put(C, n, items, C.inp(I_RW_WUP, l, 64 * WB), nullptr, dst, 0, WB, WB, 64, WB, 0);
        cd_put(C, n, items, C.inp(I_RW_AUP, l, 64 * WB), nullptr, dst + 512 * 64, 0, WB, WB, 64, WB, 0);
        cd_put(C, n, items, C.inp(I_RW_GUP, l, 128 * WB), nullptr, dst + 2 * 512 * 64, 0, WB, WB, 128, WB, 0);
    }
    __syncthreads();
    ConvPlan P; P.n = n; P.items = items; return P;
}
__device__ __forceinline__ void conv_work(const Ctx& C, const ConvPlan P, int gw, int NGW) {
    LAS float* scr = (LAS float*)(C.lds + C.wave * 15360);
    const LAS ConvDesc* cd = (const LAS ConvDesc*)(C.lds + CD_OFF);
    for (int it = gw; it < P.items; it += NGW) {
        int j = 0;
        for (int q = 1; q < P.n; ++q) if (it >= cd[q].item0) j = q;
        conv_item(cd + j, it - cd[j].item0, scr, C.lane);
    }
}
__device__ __forceinline__ void run_conv(const Ctx& C, int jobs, int l, int gw, int NGW) {
    const ConvPlan P = conv_setup(C, jobs, l);
    conv_work(C, P, gw, NGW);
    __syncthreads();
}

__device__ __forceinline__ void pro_rows(const Ctx& C) {
    const int gw = C.bid * 8 + C.wave, NGW = C.G * 8;
    const float* x = C.in[I_X]; bf16* XB = (bf16*)(C.ws + WS_XB); float* ssq = (float*)(C.ws + WS_SSQ);
    for (int m = gw; m < M; m += NGW) {
        const f32x4* xr = (const f32x4*)(x + (size_t)m * D) + C.lane; u32x2* br = (u32x2*)(XB + (size_t)m * D) + C.lane;
        float s = 0.f;
#pragma unroll
        for (int j = 0; j < 4; ++j) { const f32x4 v = xr[64 * j]; u32x2 w; w.x = pk2(v[0], v[1]); w.y = pk2(v[2], v[3]); br[64 * j] = w; s += (v[0] * v[0] + v[1] * v[1]) + (v[2] * v[2] + v[3] * v[3]); }
        s = wave_sum(s, C.lane);
        if (C.lane < 16) ssq[(size_t)m * 16 + C.lane] = (C.lane == 0) ? s : 0.f;
    }
    const float* mem = C.in[I_MEM]; bf16* MB = (bf16*)(C.ws + WS_MEMB); float* memr = (float*)(C.ws + WS_MEMR);
    for (int m = gw; m < MMEM; m += NGW) {
        const f32x4* xr = (const f32x4*)(mem + (size_t)m * D) + C.lane; u32x2* br = (u32x2*)(MB + (size_t)m * D) + C.lane; float s = 0.f;
#pragma unroll
        for (int j = 0; j < 4; ++j) { const f32x4 v = xr[64 * j]; u32x2 w; w.x = pk2(v[0], v[1]); w.y = pk2(v[2], v[3]); br[64 * j] = w; s += (v[0] * v[0] + v[1] * v[1]) + (v[2] * v[2] + v[3] * v[3]); }
        s = wave_sum(s, C.lane);
        if (C.lane == 0) memr[m] = 1.0f / sqrtf(s * (1.0f / D) + NORM_EPS);
    }
}
__device__ __forceinline__ void final_rows(const Ctx& C) {
    const int gw = C.bid * 8 + C.wave, NGW = C.G * 8; const float* ssq = (const float*)(C.ws + WS_SSQ); const float* g = C.in[I_FINAL_NORM];
    for (int m = gw; m < M; m += NGW) {
        const float rs = row_rstd(ssq, m); f32x4* orow = (f32x4*)(C.X + (size_t)m * D) + C.lane; const f32x4* gr = (const f32x4*)g + C.lane;
#pragma unroll
        for (int j = 0; j < 4; ++j) orow[64 * j] = orow[64 * j] * rs * gr[64 * j];
    }
}
__device__ __forceinline__ float ldz(const bf16* Z, int row, int col) { return bf2f(Z[(size_t)row * ZP + col]); }
__device__ __forceinline__ float gelu_tanh(float y) { const float t = 0.7978845608028654f * (y + 0.044715f * y * y * y); return 0.5f * y * (1.0f + tanhf_(t)); }
constexpr int LCH = 64, NCH = SEQ / LCH;
constexpr size_t SO_GLA_ST = 0;
constexpr size_t SO_GLA_G = SO_GLA_ST + 16 * MiB;
constexpr size_t SO_ML_ST = SO_GLA_G + 512 * 1024;
constexpr size_t SO_ML_G = SO_ML_ST + 36 * MiB;
constexpr size_t SO_END0 = SO_ML_G + 512 * 1024;
static_assert(WS_S + SO_END0 <= WS_END, "state region");

__device__ __forceinline__ bf16x8 ld8(const LAS bf16* p) { return *(const LAS bf16x8*)p; }
__device__ __forceinline__ bf16x8 ld8(const bf16* p) { return *(const bf16x8*)p; }
template <int K, class PA, class PB> __device__ __forceinline__ f32x4 tile_mm(PA A, int lda, PB B, int ldb, f32x4 acc, int fr, int fq) {
#pragma unroll
    for (int k0 = 0; k0 < K; k0 += 32) {
        const bf16x8 a = ld8(A + fr * lda + k0 + 8 * fq);
        const bf16x8 b = ld8(B + fr * ldb + k0 + 8 * fq);
        acc = __builtin_amdgcn_mfma_f32_16x16x32_bf16(a, b, acc, 0, 0, 0);
    }
    return acc;
}
#ifdef PROBE_MLC
#define MLC_STAMP() PROBE_STAMP(C)
#else
#define MLC_STAMP() do { } while (0)
#endif
constexpr int LDT_ = 72;
__device__ __forceinline__ int swz(int row, int col) { return row * LDT_ + ((((col >> 3) ^ (row >> 3)) & 7) << 3) + (col & 7); }
template <int K, bool SA, bool SB, class PA, class PB> __device__ __forceinline__ f32x4 tile_mm_sw(PA A, int lda, int ra0, PB B, int ldb, int rb0, f32x4 acc, int fr, int fq) {
    const int xa = SA ? (((ra0 + fr) >> 3) & 7) : 0, xb = SB ? (((rb0 + fr) >> 3) & 7) : 0;
#pragma unroll
    for (int k0 = 0; k0 < K; k0 += 32) {
        const bf16x8 a = ld8(A + (ra0 + fr) * lda + ((((k0 >> 3) + fq) ^ xa) << 3));
        const bf16x8 b = ld8(B + (rb0 + fr) * ldb + ((((k0 >> 3) + fq) ^ xb) << 3));
        acc = __builtin_amdgcn_mfma_f32_16x16x32_bf16(a, b, acc, 0, 0, 0);
    }
    return acc;
}
#define F4Z ((f32x4){0.f, 0.f, 0.f, 0.f})
__device__ __forceinline__ u32x2 pack4(f32x4 v) { u32x2 w; w.x = pk2(v[0], v[1]); w.y = pk2(v[2], v[3]); return w; }
__device__ __forceinline__ u32x4 pack8(const float* f) { u32x4 w; w.x = pk2(f[0], f[1]); w.y = pk2(f[2], f[3]); w.z = pk2(f[4], f[5]); w.w = pk2(f[6], f[7]); return w; }
__device__ __forceinline__ void unpack8(u32x4 w, float* f) { f[0] = bflo(w.x); f[1] = bfhi(w.x); f[2] = bflo(w.y); f[3] = bfhi(w.y); f[4] = bflo(w.z); f[5] = bfhi(w.z); f[6] = bflo(w.w); f[7] = bfhi(w.w); }

struct Touch { u32x4 a, b, c; };
__device__ __forceinline__ void touch_tile(Touch& T, const bf16* base, int rows, int ppr, int tid) {
    const u32x4 z = (u32x4){0u, 0u, 0u, 0u}; T.a = z; T.b = z; T.c = z; const int n = rows * ppr;
    if (tid < n) T.a = *(const u32x4*)(base + (size_t)(tid / ppr) * ZP + (tid % ppr) * 8);
    if (tid + 512 < n) T.b = *(const u32x4*)(base + (size_t)((tid + 512) / ppr) * ZP + ((tid + 512) % ppr) * 8);
    if (tid + 1024 < n) T.c = *(const u32x4*)(base + (size_t)((tid + 1024) / ppr) * ZP + ((tid + 1024) % ppr) * 8);
}
__device__ __forceinline__ void touch_sink(const Touch& T) { asm volatile("" :: "v"(T.a), "v"(T.b), "v"(T.c)); }
struct GlaW { float au[16], bk; };
__device__ __forceinline__ void gla_loadw(const Ctx& C, int l, int h, GlaW& W) {
    const float* aup = C.inp(I_GLA_AUP, l, 16 * 256) + h * 64; const float* abias = C.inp(I_GLA_ABIAS, l, 256) + h * 64; const int k = C.tid & 63;
#pragma unroll
    for (int r = 0; r < 16; ++r) W.au[r] = aup[r * 256 + k];
    W.bk = abias[k];
}
__device__ __forceinline__ void gla_cumdecay(const Ctx& C, const GlaW& W, float al0, float al1, LAS float* ALOW, LAS float* LA, LAS float* SEG) {
    const int tid = C.tid;
    ALOW[tid] = al0; ALOW[tid + 512] = al1;
    __syncthreads();
    {   const int k = tid & 63, seg = tid >> 6; float run = 0.f, v[8];
#pragma unroll
        for (int i = 0; i < 8; ++i) { const int t = seg * 8 + i; float s = W.bk;
#pragma unroll
            for (int r = 0; r < 16; ++r) s += ALOW[t * 16 + r] * W.au[r];
            run += logsigmoidf_(s) * (1.0f / 16.0f); v[i] = run; }
        SEG[seg * 64 + k] = run;
        __syncthreads();
        float off = 0.f;
        for (int s2 = 0; s2 < seg; ++s2) off += SEG[s2 * 64 + k];
#pragma unroll
        for (int i = 0; i < 8; ++i) LA[(seg * 8 + i) * 64 + k] = v[i] + off;
    }
    __syncthreads();
}
struct GlaPre { float al0, al1; u32x4 v0, v1, q, k, g0, g1; };
__device__ __forceinline__ void gla_preload(const Ctx& C, int item, GlaPre& P, bool with_qg) {
    const int bh = item >> 6, c = item & 63, b = bh >> 2, h = bh & 3, rowb = b * SEQ + c * LCH, tid = C.tid;
    const bf16* Z = (const bf16*)(C.ws + WS_Z);
    P.al0 = ldz(Z, rowb + (tid >> 4), ZC_A + (tid & 15)); P.al1 = ldz(Z, rowb + 32 + (tid >> 4), ZC_A + (tid & 15));
    P.v0 = *(const u32x4*)(Z + (size_t)(rowb + (tid >> 4)) * ZP + ZC_V + h * 128 + (tid & 15) * 8); P.v1 = *(const u32x4*)(Z + (size_t)(rowb + 32 + (tid >> 4)) * ZP + ZC_V + h * 128 + (tid & 15) * 8);
    P.k = *(const u32x4*)(Z + (size_t)(rowb + (tid >> 3)) * ZP + ZC_K + h * 64 + (tid & 7) * 8);
    if (with_qg) { P.q = *(const u32x4*)(Z + (size_t)(rowb + (tid >> 3)) * ZP + ZC_Q + h * 64 + (tid & 7) * 8);
        P.g0 = *(const u32x4*)(Z + (size_t)(rowb + (tid >> 4)) * ZP + ZC_G + h * 128 + (tid & 15) * 8); P.g1 = *(const u32x4*)(Z + (size_t)(rowb + 32 + (tid >> 4)) * ZP + ZC_G + h * 128 + (tid & 15) * 8); }
}
constexpr int LDT = 72;
__device__ __forceinline__ void gla_passA(const Ctx& C, int l, int item, const GlaW& W, const GlaPre& P) {
    const int bh = item >> 6, c = item & 63, b = bh >> 2, h = bh & 3, rowb = b * SEQ + c * LCH;
    LAS float* ALOW = (LAS float*)C.lds; LAS float* LA = ALOW + 1024; LAS float* SEG = LA + 4096;
    LAS bf16* VT = (LAS bf16*)(SEG + 512);
    LAS bf16* KT = VT + 128 * LDT;
    const int tid = C.tid, lane = C.lane, w = C.wave, fr = lane & 15, fq = lane >> 4;
    (void)l; (void)b; (void)h; (void)rowb;
    gla_cumdecay(C, W, P.al0, P.al1, ALOW, LA, SEG);
    {   const int v0 = (tid & 15) * 8; float f[8];
        unpack8(P.v0, f);
#pragma unroll
        for (int j = 0; j < 8; ++j) VT[swz(v0 + j, tid >> 4)] = (bf16)f2bf(f[j]);
        unpack8(P.v1, f);
#pragma unroll
        for (int j = 0; j < 8; ++j) VT[swz(v0 + j, 32 + (tid >> 4))] = (bf16)f2bf(f[j]); }
    {   const int t = tid >> 3, k0 = (tid & 7) * 8; float f[8];
        unpack8(P.k, f);
        const f32x4 e0 = *(const LAS f32x4*)(LA + 63 * 64 + k0), e1 = *(const LAS f32x4*)(LA + 63 * 64 + k0 + 4), b0 = *(const LAS f32x4*)(LA + t * 64 + k0), b1 = *(const LAS f32x4*)(LA + t * 64 + k0 + 4);
#pragma unroll
        for (int j = 0; j < 8; ++j) KT[swz(k0 + j, t)] = (bf16)f2bf(f[j] * __expf(((j < 4) ? e0[j & 3] : e1[j & 3]) - ((j < 4) ? b0[j & 3] : b1[j & 3]))); }
    if (tid < 64) ((float*)(C.ws + WS_S + SO_GLA_G))[(size_t)item * 64 + tid] = __expf(LA[63 * 64 + tid]);
    __syncthreads();
    bf16* ST = (bf16*)(C.ws + WS_S + SO_GLA_ST) + (size_t)item * 8192;
#pragma unroll
    for (int q = 0; q < 4; ++q) {
        const f32x4 acc = tile_mm_sw<64, true, true>(KT, LDT, 16 * q, VT, LDT, 16 * w, F4Z, fr, fq);
        *(u32x2*)(ST + (size_t)(16 * w + fr) * 64 + 16 * q + 4 * fq) = pack4(acc);
    }
    __syncthreads();
}
__device__ __forceinline__ void gla_passB(const Ctx& C, int tidx, int NT) {
    for (int idx = tidx; idx < 16 * 8192; idx += NT) {
    const int bh = idx >> 13, e = idx & 8191, k = e & 63;
    bf16* ST = (bf16*)(C.ws + WS_S + SO_GLA_ST) + (size_t)bh * 64 * 8192 + e; const float* G = (const float*)(C.ws + WS_S + SO_GLA_G) + (size_t)bh * 64 * 64 + k;
    float d[64], g[64];
#pragma unroll
    for (int c = 0; c < 64; ++c) { d[c] = bf2f(ST[(size_t)c * 8192]); g[c] = G[c * 64]; }
    float run = 0.f;
#pragma unroll
    for (int c = 0; c < 64; ++c) { ST[(size_t)c * 8192] = (bf16)f2bf(run); run = run * g[c] + d[c]; }
    }
}
template <bool DRY = false> __device__ __forceinline__ void gla_passC(const Ctx& C, int l, int item, const GlaW& W, const GlaPre& P) {
    const int bh = item >> 6, c = item & 63, b = bh >> 2, h = bh & 3, rowb = b * SEQ + c * LCH;
    bf16* Z = (bf16*)(C.ws + WS_Z);
    LAS float* ALOW = (LAS float*)C.lds; LAS float* LA = ALOW + 1024; LAS float* SEG = LA + 4096;
    LAS bf16* VT = (LAS bf16*)(SEG + 512);
    LAS bf16* QP = VT + 128 * LDT;
    LAS bf16* KP = QP + 64 * LDT;
    LAS bf16* ATT = KP + 64 * LDT;
    LAS float* O = (LAS float*)(ATT + 64 * LDT);
    LAS float* RSQ = O + 64 * 132;
    const int tid = C.tid, lane = C.lane, w = C.wave, fr = lane & 15, fq = lane >> 4;
    const bf16* ST = (const bf16*)(C.ws + WS_S + SO_GLA_ST) + (size_t)item * 8192;
    bf16x8 stf[4][2];
#pragma unroll
    for (int q = 0; q < 4; ++q) { const int vv = (4 * w + q) >> 2; stf[q][0] = ld8(ST + (size_t)(16 * vv + fr) * 64 + 8 * fq); stf[q][1] = ld8(ST + (size_t)(16 * vv + fr) * 64 + 32 + 8 * fq); }
    gla_cumdecay(C, W, P.al0, P.al1, ALOW, LA, SEG);
    {   const int v0 = (tid & 15) * 8; float f[8];
        unpack8(P.v0, f);
#pragma unroll
        for (int j = 0; j < 8; ++j) VT[swz(v0 + j, tid >> 4)] = (bf16)f2bf(f[j]);
        unpack8(P.v1, f);
#pragma unroll
        for (int j = 0; j < 8; ++j) VT[swz(v0 + j, 32 + (tid >> 4))] = (bf16)f2bf(f[j]); }
    {   const int t = tid >> 3, k0 = (tid & 7) * 8; float fq_[8], fk_[8];
        unpack8(P.q, fq_); unpack8(P.k, fk_);
        u32x4 wq, wk; float eq[8], ek[8];
        const f32x4 b0 = *(const LAS f32x4*)(LA + t * 64 + k0), b1 = *(const LAS f32x4*)(LA + t * 64 + k0 + 4);
#pragma unroll
        for (int j = 0; j < 8; ++j) { const float bb = (j < 4) ? b0[j & 3] : b1[j & 3]; eq[j] = fq_[j] * 0.125f * __expf(bb); ek[j] = fk_[j] * __expf(-bb); }
        wq.x = pk2(eq[0], eq[1]); wq.y = pk2(eq[2], eq[3]); wq.z = pk2(eq[4], eq[5]); wq.w = pk2(eq[6], eq[7]);
        wk.x = pk2(ek[0], ek[1]); wk.y = pk2(ek[2], ek[3]); wk.z = pk2(ek[4], ek[5]); wk.w = pk2(ek[6], ek[7]);
        *(LAS u32x4*)(QP + t * LDT + k0) = wq; *(LAS u32x4*)(KP + t * LDT + k0) = wk; }
    __syncthreads();
#pragma unroll
    for (int q = 0; q < 2; ++q) {
        const int id = 2 * w + q, tt = id >> 2, ss = id & 3; f32x4 acc = F4Z;
        if (ss <= tt) acc = tile_mm<64>(KP + (16 * ss) * LDT, LDT, QP + (16 * tt) * LDT, LDT, acc, fr, fq);
        const int t = 16 * tt + fr, s0 = 16 * ss + 4 * fq;
#pragma unroll
        for (int r = 0; r < 4; ++r) if (s0 + r > t) acc[r] = 0.f;
        *(LAS u32x2*)(ATT + t * LDT + s0) = pack4(acc);
    }
    __syncthreads();
#pragma unroll
    for (int q = 0; q < 4; ++q) {
        const int id = 4 * w + q, tt = id & 3, vv = id >> 2;
        f32x4 acc = __builtin_amdgcn_mfma_f32_16x16x32_bf16(stf[q][0], ld8(QP + (16 * tt + fr) * LDT + 8 * fq), F4Z, 0, 0, 0);
        acc = __builtin_amdgcn_mfma_f32_16x16x32_bf16(stf[q][1], ld8(QP + (16 * tt + fr) * LDT + 32 + 8 * fq), acc, 0, 0, 0);
        acc = tile_mm_sw<64, true, false>(VT, LDT, 16 * vv, ATT, LDT, 16 * tt, acc, fr, fq);
        *(LAS f32x4*)(O + (16 * tt + fr) * 132 + 16 * vv + 4 * fq) = acc;
    }
    __syncthreads();
    {
        const int t = tid >> 3, v0 = (tid & 7) * 16; float hv[16]; float ss = 0.f;
#pragma unroll
        for (int q4 = 0; q4 < 4; ++q4) { const f32x4 o4 = *(const LAS f32x4*)(O + t * 132 + v0 + 4 * q4);
#pragma unroll
            for (int j = 0; j < 4; ++j) { hv[4 * q4 + j] = o4[j]; ss += o4[j] * o4[j]; } }
        ss += shx(ss, 1, lane); ss += shx(ss, 2, lane); ss += shx(ss, 4, lane);
        const float rs = rsqf_(ss * (1.0f / 128) + NORM_EPS);
        bf16* zp = Z + (size_t)(rowb + t) * ZP + ZC_G + h * 128 + v0; float g[16]; unpack8(*(const u32x4*)zp, g); unpack8(*(const u32x4*)(zp + 8), g + 8);
        const float* gn = C.inp(I_GLA_NORM, l, WB) + h * 128 + v0; float o[16];
#pragma unroll
        for (int j = 0; j < 16; ++j) o[j] = hv[j] * rs * gn[j] * siluf_(g[j]);
        const u32x4 w0 = pack8(o), w1 = pack8(o + 8);
        if (!DRY) { *(u32x4*)zp = w0; *(u32x4*)(zp + 8) = w1; } else asm volatile("" :: "v"(w0), "v"(w1));
    }
    __syncthreads();
}

constexpr size_t WS_MLW = 512 * 1024;
constexpr int LDU = 152, LDE = 136;
__device__ __forceinline__ float wave_incl_scan(float v, int lane) {
#pragma unroll
    for (int o = 1; o < 64; o <<= 1) { const float n = __builtin_bit_cast(float, __builtin_amdgcn_ds_bpermute(((lane - o) & 63) << 2, __builtin_bit_cast(int, v))); if (lane >= o) v += n; }
    return v;
}
struct MlPre { u32x4 x[2][4]; float zi, zf; };
__device__ __forceinline__ void ml_preload(const Ctx& C, int item, MlPre& P) {
    const int bh = item >> 6, c = item & 63, b = bh >> 2, h = bh & 3, t0 = c * LCH, rowb = b * SEQ + t0, tid = C.tid;
    const bf16* Z = (const bf16*)(C.ws + WS_Z); const u32x4 z4 = (u32x4){0u, 0u, 0u, 0u};
#pragma unroll
    for (int ii = 0; ii < 2; ++ii) { const int t = (tid >> 4) + 32 * ii, e0 = (tid & 15) * 8;
#pragma unroll
        for (int d = 0; d < 4; ++d) P.x[ii][d] = (t0 + t - 3 + d >= 0) ? *(const u32x4*)(Z + (size_t)(rowb + t - 3 + d) * ZP + ZA_U + h * 128 + e0) : z4; }
    P.zi = 0.f; P.zf = 0.f;
    if (C.wave == 0) { P.zi = ldz(Z, rowb + C.lane, ZA_I + h); P.zf = ldz(Z, rowb + C.lane, ZA_F + h); }
}
__device__ __forceinline__ void ml_front(const Ctx& C, int l, int h, const MlPre& P, LAS bf16* UC, LAS bf16* U, LAS float* GB, LAS float* GI) {
    const int tid = C.tid;
    const float* conv = C.inp(I_ML_CONV, l, 4 * WB) + h * 128;
#pragma unroll
    for (int ii = 0; ii < 2; ++ii) { const int t = (tid >> 4) + 32 * ii, e0 = (tid & 15) * 8; float s[8], x[8];
#pragma unroll
        for (int j = 0; j < 8; ++j) s[j] = 0.f;
#pragma unroll
        for (int d = 0; d < 4; ++d) {
            unpack8(P.x[ii][d], x);
#pragma unroll
            for (int j = 0; j < 8; ++j) s[j] += conv[d * WB + e0 + j] * x[j];
        }
        const u32x4 wu = P.x[ii][3];
#pragma unroll
        for (int j = 0; j < 8; ++j) s[j] = siluf_(s[j]);
        *(LAS u32x4*)(U + t * LDU + e0) = wu; *(LAS u32x4*)(UC + t * LDU + e0) = pack8(s); }
    if (C.wave == 0) { const int t = C.lane;
        const float li = P.zi + C.inp(I_ML_BI, l, 4)[h]; const float lf = logsigmoidf_(P.zf + C.inp(I_ML_BF, l, 4)[h]);
        GB[t] = wave_incl_scan(lf, C.lane); GI[t] = li; }
    __syncthreads();
}
__device__ __forceinline__ void ml_passA(const Ctx& C, int l, int item, const MlPre& P) {
    const int bh = item >> 6, c = item & 63, b = bh >> 2, h = bh & 3; (void)c; (void)b;
    LAS bf16* UC = (LAS bf16*)C.lds; LAS bf16* U = UC + 64 * LDU; LAS bf16* KT = U + 64 * LDU;
    LAS bf16* VT = KT + 128 * LDT;
    LAS float* GB = (LAS float*)(VT + 144 * LDT); LAS float* GI = GB + 64; LAS float* WA = GI + 64;
    const int tid = C.tid, lane = C.lane, w = C.wave, fr = lane & 15, fq = lane >> 4;
    ml_front(C, l, h, P, UC, U, GB, GI);
    if (tid < 64) WA[tid] = __expf(GB[63] - GB[tid] + GI[tid]) * 0.08838834764831845f;
    for (int i = tid; i < 16 * LDT; i += 512) VT[128 * LDT + i] = (i < LDT) ? (bf16)0x3f80 : (bf16)0;
    __syncthreads();
    const bf16* WK = (const bf16*)(C.ws + WS_MLW) + (size_t)(4 + h) * 16384; const bf16* WV = (const bf16*)(C.ws + WS_MLW) + (size_t)(8 + h) * 16384;
#pragma unroll
    for (int q = 0; q < 4; ++q) {
        const int id = 4 * w + q, tt = id & 3, ee = id >> 2;
        f32x4 ak = tile_mm<128>(UC + (16 * tt) * LDU, LDU, WK + (size_t)(16 * ee) * 128, 128, F4Z, fr, fq);
        f32x4 av = tile_mm<128>(U + (16 * tt) * LDU, LDU, WV + (size_t)(16 * ee) * 128, 128, F4Z, fr, fq);
        const int t = 16 * tt + 4 * fq;
#pragma unroll
        for (int r = 0; r < 4; ++r) ak[r] *= WA[t + r];
        *(LAS u32x2*)(KT + (16 * ee + fr) * LDT + t) = pack4(ak); *(LAS u32x2*)(VT + (16 * ee + fr) * LDT + t) = pack4(av);
    }
    if (tid == 0) ((float*)(C.ws + WS_S + SO_ML_G))[item] = __expf(GB[63]);
    __syncthreads();
    bf16* ST = (bf16*)(C.ws + WS_S + SO_ML_ST) + (size_t)item * (144 * 128);
    for (int id = w; id < 72; id += 8) {
        const int ee = id & 7, vv = id >> 3;
        const f32x4 acc = tile_mm<64>(KT + (16 * ee) * LDT, LDT, VT + (16 * vv) * LDT, LDT, F4Z, fr, fq);
        *(u32x2*)(ST + (size_t)(16 * vv + fr) * 128 + 16 * ee + 4 * fq) = pack4(acc);
    }
    __syncthreads();
}
__device__ __forceinline__ void ml_passB(const Ctx& C, int tidx, int NT) {
    for (int idx = tidx; idx < 16 * 18432; idx += NT) {
        const int bh = idx / 18432, e = idx % 18432;
        bf16* ST = (bf16*)(C.ws + WS_S + SO_ML_ST) + (size_t)bh * 64 * 18432 + e; const float* G = (const float*)(C.ws + WS_S + SO_ML_G) + bh * 64;
        float d[64], g[64];
#pragma unroll
        for (int c = 0; c < 64; ++c) { d[c] = bf2f(ST[(size_t)c * 18432]); g[c] = G[c]; }
        float run = 0.f;
#pragma unroll
        for (int c = 0; c < 64; ++c) { ST[(size_t)c * 18432] = (bf16)f2bf(run); run = run * g[c] + d[c]; }
    }
}
template <bool DRY = false> __device__ __forceinline__ void ml_passC(const Ctx& C, int l, int item, const MlPre& P) {
    const int bh = item >> 6, c = item & 63, b = bh >> 2, h = bh & 3, rowb = b * SEQ + c * LCH;
    bf16* Z = (bf16*)(C.ws + WS_Z);
    LAS bf16* UC = (LAS bf16*)C.lds; LAS bf16* U = UC + 64 * LDU; LAS bf16* Q = U + 64 * LDU;
    LAS bf16* K = Q + 64 * LDE;
    LAS bf16* VT = K + 64 * LDE;
    LAS bf16* W = VT + 144 * LDT;
    LAS float* GB = (LAS float*)(W + 64 * LDT); LAS float* GI = GB + 64; LAS float* RF = GI + 64; LAS float* CF = RF + 64; LAS float* RSQ = CF + 64;
    LAS float* O = (LAS float*)C.lds;
    const int tid = C.tid, lane = C.lane, w = C.wave, fr = lane & 15, fq = lane >> 4;
    const bf16* ST = (const bf16*)(C.ws + WS_S + SO_ML_ST) + (size_t)item * (144 * 128);
    bf16x8 stf[5][4];
#pragma unroll
    for (int q = 0; q < 5; ++q) { const int id = w + 8 * q, vv = id >> 2;
#pragma unroll
        for (int k4 = 0; k4 < 4; ++k4) stf[q][k4] = (id < 36) ? ld8(ST + (size_t)(16 * vv + fr) * 128 + 32 * k4 + 8 * fq) : (bf16x8){0, 0, 0, 0, 0, 0, 0, 0}; }
    MLC_STAMP();
    ml_front(C, l, h, P, UC, U, GB, GI);
    MLC_STAMP();
    if (tid < 64) { RF[tid] = __expf(GB[tid]); CF[tid] = __expf(GI[tid] - GB[tid]) * 0.08838834764831845f; }
    for (int i = tid; i < 16 * LDT; i += 512) VT[128 * LDT + i] = (i < LDT) ? (bf16)0x3f80 : (bf16)0;
    const bf16* WQ = (const bf16*)(C.ws + WS_MLW) + (size_t)h * 16384; const bf16* WK = WQ + 4 * 16384; const bf16* WV = WQ + 8 * 16384;
#pragma unroll
    for (int q = 0; q < 4; ++q) {
        const int id = 4 * w + q, tt = id & 3, ee = id >> 2;
        const f32x4 aq = tile_mm<128>(WQ + (size_t)(16 * ee) * 128, 128, UC + (16 * tt) * LDU, LDU, F4Z, fr, fq);
        const f32x4 ak = tile_mm<128>(WK + (size_t)(16 * ee) * 128, 128, UC + (16 * tt) * LDU, LDU, F4Z, fr, fq);
        *(LAS u32x2*)(Q + (16 * tt + fr) * LDE + 16 * ee + 4 * fq) = pack4(aq); *(LAS u32x2*)(K + (16 * tt + fr) * LDE + 16 * ee + 4 * fq) = pack4(ak);
        const f32x4 av = tile_mm<128>(U + (16 * tt) * LDU, LDU, WV + (size_t)(16 * ee) * 128, 128, F4Z, fr, fq);
        *(LAS u32x2*)(VT + (16 * ee + fr) * LDT + 16 * tt + 4 * fq) = pack4(av);
    }
    __syncthreads();
    MLC_STAMP();
#pragma unroll
    for (int q = 0; q < 2; ++q) {
        const int id = 2 * w + q, tt = id >> 2, ss = id & 3; f32x4 acc = F4Z;
        if (ss <= tt) acc = tile_mm<128>(K + (16 * ss) * LDE, LDE, Q + (16 * tt) * LDE, LDE, acc, fr, fq);
        const int t = 16 * tt + fr, s0 = 16 * ss + 4 * fq; const float rf = RF[t];
#pragma unroll
        for (int r = 0; r < 4; ++r) acc[r] = (s0 + r > t) ? 0.f : acc[r] * rf * CF[s0 + r];
        *(LAS u32x2*)(W + t * LDT + s0) = pack4(acc);
    }
    __syncthreads();
    MLC_STAMP();
    f32x4 res[5];
#pragma unroll
    for (int q = 0; q < 5; ++q) {
        const int id = w + 8 * q, tt = id & 3, vv = id >> 2; res[q] = F4Z;
        if (id < 36) {
            f32x4 acc = F4Z;
#pragma unroll
            for (int k4 = 0; k4 < 4; ++k4) acc = __builtin_amdgcn_mfma_f32_16x16x32_bf16(stf[q][k4], ld8(Q + (16 * tt + fr) * LDE + 32 * k4 + 8 * fq), acc, 0, 0, 0);
            acc *= RF[16 * tt + fr];
            res[q] = tile_mm<64>(VT + (16 * vv) * LDT, LDT, W + (16 * tt) * LDT, LDT, acc, fr, fq);
        }
    }
    __syncthreads();
    MLC_STAMP();
#pragma unroll
    for (int q = 0; q < 5; ++q) { const int id = w + 8 * q, tt = id & 3, vv = id >> 2; if (id < 36) *(LAS f32x4*)(O + (16 * tt + fr) * 148 + 16 * vv + 4 * fq) = res[q]; }
    __syncthreads();
    {
        const int t = tid >> 3, v0 = (tid & 7) * 16; float hv[16];
        const float inv = rcpf_(fmaxf(fabsf(O[t * 148 + 128]), 1.0f)); float ss = 0.f;
#pragma unroll
        for (int q4 = 0; q4 < 4; ++q4) { const f32x4 o4 = *(const LAS f32x4*)(O + t * 148 + v0 + 4 * q4);
#pragma unroll
            for (int j = 0; j < 4; ++j) { const float x = o4[j] * inv; hv[4 * q4 + j] = x; ss += x * x; } }
        ss += shx(ss, 1, lane); ss += shx(ss, 2, lane); ss += shx(ss, 4, lane);
        const float rs = rsqf_(ss * (1.0f / 128) + NORM_EPS);
        bf16* zp = Z + (size_t)(rowb + t) * ZP + ZA_O + h * 128 + v0; float g[16]; unpack8(*(const u32x4*)zp, g); unpack8(*(const u32x4*)(zp + 8), g + 8);
        const float* gn = C.inp(I_ML_NORM, l, WB) + h * 128 + v0; float o[16];
#pragma unroll
        for (int j = 0; j < 16; ++j) o[j] = hv[j] * rs * gn[j] * sigmoidf_(g[j]);
        const u32x4 w0 = pack8(o), w1 = pack8(o + 8);
        if (!DRY) { *(u32x4*)zp = w0; *(u32x4*)(zp + 8) = w1; } else asm volatile("" :: "v"(w0), "v"(w1));
    }
    __syncthreads();
    MLC_STAMP();
}

constexpr size_t SO_S5_K = SO_END0;
constexpr size_t SO_S5_BB = SO_S5_K + 1 * MiB;
constexpr size_t SO_S5_PM = SO_S5_BB + 256 * 1024;
constexpr size_t SO_S5_POW = SO_S5_PM + 512 * 1024;
constexpr size_t SO_S5_E = SO_S5_POW + 1280 * 1024;
constexpr size_t SO_END1 = SO_S5_E + 4 * MiB;
static_assert(WS_S + SO_END1 <= WS_END, "state region");
__device__ __forceinline__ void s5_prep(const Ctx& C, int l, int g) {
    LAS float* BBr = (LAS float*)C.lds; LAS float* BBi = BBr + 1024; LAS float* PW = BBi + 1024; LAS float* CR = PW + 65 * 128; LAS float* CI = CR + 1024;
    LAS bf16* BT = (LAS bf16*)(CI + 1024);
    LAS bf16* WT = BT + 16 * 136 + C.wave * (16 * 136);
    const int tid = C.tid, lane = C.lane, w = C.wave, fr = lane & 15, fq = lane >> 4;
    if (tid < 64) { const int p = tid;
        const float are = C.inp(I_S5_ARE, l, 32 * 64)[g * 64 + p], aim = C.inp(I_S5_AIM, l, 32 * 64)[g * 64 + p];
        const float step = expf(C.inp(I_S5_LOGSTEP, l, 32)[g]); const float lre = fminf(are, -1e-4f), lim = aim;
        const float mag = expf(lre * step), bre = mag * cosf(lim * step), bim = mag * sinf(lim * step), den = lre * lre + lim * lim;
        const float cre = ((bre - 1.0f) * lre + bim * lim) / den, cim = (bim * lre - (bre - 1.0f) * lim) / den;
        const float* br = C.inp(I_S5_BRE, l, 32 * 64 * 16) + (size_t)(g * 64 + p) * 16; const float* bi = C.inp(I_S5_BIM, l, 32 * 64 * 16) + (size_t)(g * 64 + p) * 16;
        for (int c = 0; c < 16; ++c) { BBr[p * 16 + c] = cre * br[c] - cim * bi[c]; BBi[p * 16 + c] = cre * bi[c] + cim * br[c]; }
        float pr = 1.f, pi = 0.f;
        for (int n = 0; n <= 64; ++n) { PW[(n * 64 + p) * 2] = pr; PW[(n * 64 + p) * 2 + 1] = pi; const float nr = pr * bre - pi * bim, ni = pr * bim + pi * bre; pr = nr; pi = ni; }
    }
    for (int i = tid; i < 1024; i += 512) { CR[i] = C.inp(I_S5_CRE, l, 32 * 1024)[g * 1024 + i]; CI[i] = C.inp(I_S5_CIM, l, 32 * 1024)[g * 1024 + i]; }
    __syncthreads();
    unsigned char* S = C.ws + WS_S;
    float* POW = (float*)(S + SO_S5_POW) + (size_t)g * 65 * 128;
    for (int i = tid; i < 65 * 128; i += 512) POW[i] = PW[i];
    bf16* BB = (bf16*)(S + SO_S5_BB) + (size_t)g * 128 * 32;
    for (int i = tid; i < 128 * 32; i += 512) { const int row = i >> 5, c = i & 31, pp = row >> 5, ri = (row >> 4) & 1, p = 16 * pp + (row & 15);
        BB[i] = (bf16)f2bf(c < 16 ? (ri ? BBi[p * 16 + c] : BBr[p * 16 + c]) : 0.f); }
    bf16* PM = (bf16*)(S + SO_S5_PM) + (size_t)g * 64 * 128;
    for (int i = tid; i < 64 * 128; i += 512) { const int t = i >> 7, k = i & 127, ri = k >> 6, p = k & 63;
        PM[i] = (bf16)f2bf(ri ? -PW[((t + 1) * 64 + p) * 2 + 1] : PW[((t + 1) * 64 + p) * 2]); }
    for (int i = tid; i < 16 * 128; i += 512) { const int c = i >> 7, k = i & 127, ri = k >> 6, p = k & 63; BT[c * 136 + k] = (bf16)f2bf(ri ? -BBi[p * 16 + c] : BBr[p * 16 + c]); }
    __syncthreads();
    bf16* KM = (bf16*)(S + SO_S5_K) + (size_t)g * 16 * 1024;
#pragma unroll 1
    for (int tau = w; tau < 64; tau += 8) {
        const float pr = PW[(tau * 64 + lane) * 2], pi = PW[(tau * 64 + lane) * 2 + 1];
#pragma unroll
        for (int cp = 0; cp < 16; ++cp) { const float cr = CR[cp * 64 + lane], ci = CI[cp * 64 + lane];
            WT[cp * 136 + lane] = (bf16)f2bf(cr * pr - ci * pi); WT[cp * 136 + 64 + lane] = (bf16)f2bf(cr * pi + ci * pr); }
        LDS_WAIT(); __builtin_amdgcn_wave_barrier();
        const f32x4 acc = tile_mm<128>(BT, 136, WT, 136, F4Z, fr, fq);
        *(u32x2*)(KM + (size_t)fr * 1024 + tau * 16 + 4 * fq) = pack4(acc);
        LDS_WAIT(); __builtin_amdgcn_wave_barrier();
    }
    __syncthreads();
}
__device__ __forceinline__ void s5_passA(const Ctx& C) {
    const int g = C.bid >> 3, sb = C.bid & 7, lane = C.lane, fr = lane & 15, fq = lane >> 4, tid = C.tid;
    const bf16* Z = (const bf16*)(C.ws + WS_Z); unsigned char* S = C.ws + WS_S;
    LAS bf16* BBL = (LAS bf16*)(C.lds + 65536);
    LAS float* POWL = (LAS float*)(C.lds + 65536 + 8192);
    {   const u32x4* src = (const u32x4*)((const bf16*)(S + SO_S5_BB) + (size_t)g * 128 * 32); LAS u32x4* dst = (LAS u32x4*)BBL; dst[tid] = src[tid];
        const u32x4* ps = (const u32x4*)((const float*)(S + SO_S5_POW) + (size_t)g * 65 * 128); LAS u32x4* pd = (LAS u32x4*)POWL;
        for (int i = tid; i < 65 * 128 / 4; i += 512) pd[i] = ps[i]; }
    __syncthreads();
    LAS bf16* UA = (LAS bf16*)(C.lds + C.wave * 8192);
#pragma unroll 1
    for (int i4 = 0; i4 < 4; ++i4) {
        const int j = sb * 32 + C.wave * 4 + i4, b = j >> 6, c = j & 63, item = (b * 32 + g) * 64 + c, rowb = b * SEQ + c * LCH;
        {   const u32x4* src = (const u32x4*)(Z + (size_t)(rowb + lane) * ZP + ZB_U + g * 16); const u32x4 z4 = (u32x4){0u, 0u, 0u, 0u};
            LAS u32x4* dst = (LAS u32x4*)(UA + lane * 40); dst[0] = src[0]; dst[1] = src[1]; dst[2] = z4; dst[3] = z4; }
        LDS_WAIT(); __builtin_amdgcn_wave_barrier();
        float* E = (float*)(S + SO_S5_E) + (size_t)item * 128;
#pragma unroll
        for (int pp = 0; pp < 4; ++pp) { float er = 0.f, ei = 0.f; const int p = 16 * pp + fr;
#pragma unroll
            for (int tt = 0; tt < 4; ++tt) {
                const f32x4 br = tile_mm<32>(UA + (16 * tt) * 40, 40, BBL + (pp * 32) * 32, 32, F4Z, fr, fq);
                const f32x4 bi = tile_mm<32>(UA + (16 * tt) * 40, 40, BBL + (pp * 32 + 16) * 32, 32, F4Z, fr, fq);
#pragma unroll
                for (int r = 0; r < 4; ++r) { const int t = 16 * tt + 4 * fq + r; const f32x2 pw = *(const LAS f32x2*)(POWL + ((63 - t) * 64 + p) * 2);
                    er += pw.x * br[r] - pw.y * bi[r]; ei += pw.x * bi[r] + pw.y * br[r]; }
            }
            er += shx(er, 16, lane); er += shx(er, 32, lane); ei += shx(ei, 16, lane); ei += shx(ei, 32, lane);
            if (fq == 0) { E[p] = er; E[64 + p] = ei; }
        }
        LDS_WAIT(); __builtin_amdgcn_wave_barrier();
    }
    __syncthreads();
}
__device__ __forceinline__ void s5_passB(const Ctx& C, int tidx, int NT) {
    for (int idx = tidx; idx < 8192; idx += NT) {
    const int bg = idx >> 6, p = idx & 63, g = bg & 31; unsigned char* S = C.ws + WS_S;
    const f32x2 l64 = *(const f32x2*)((const float*)(S + SO_S5_POW) + (size_t)g * 65 * 128 + (64 * 64 + p) * 2);
    float* E = (float*)(S + SO_S5_E) + (size_t)bg * 64 * 128 + p;
    float er[64], ei[64];
#pragma unroll
    for (int c = 0; c < 64; ++c) { er[c] = E[c * 128]; ei[c] = E[c * 128 + 64]; }
    float rr = 0.f, ri = 0.f;
#pragma unroll
    for (int c = 0; c < 64; ++c) { E[c * 128] = rr; E[c * 128 + 64] = ri; const float nr = l64.x * rr - l64.y * ri + er[c], ni = l64.x * ri + l64.y * rr + ei[c]; rr = nr; ri = ni; }
    }
}
constexpr int LDKM = 1032;
template <class RW> __device__ __forceinline__ void s5_passC_core(const Ctx& C, int l, RW rw_items) {
    const int g = C.bid >> 3, sb = C.bid & 7, lane = C.lane, fr = lane & 15, fq = lane >> 4, tid = C.tid;
    bf16* Z = (bf16*)(C.ws + WS_Z); unsigned char* S = C.ws + WS_S;
    LAS bf16* KML = (LAS bf16*)(C.lds + 73728);
    LAS bf16* PML = (LAS bf16*)(C.lds + 73728 + 16 * LDKM * 2);
    {   const u32x4* ks = (const u32x4*)((const bf16*)(S + SO_S5_K) + (size_t)g * 16 * 1024);
        for (int i = tid; i < 16 * 128; i += 512) *(LAS u32x4*)(KML + (i >> 7) * LDKM + (i & 127) * 8) = ks[i];
        const u32x4* ps = (const u32x4*)((const bf16*)(S + SO_S5_PM) + (size_t)g * 64 * 128);
        for (int i = tid; i < 64 * 16; i += 512) *(LAS u32x4*)(PML + (i >> 4) * 136 + (i & 15) * 8) = ps[i]; }
    __syncthreads();
    if (C.wave < 4) { rw_items(); __syncthreads(); return; }
    LAS bf16* UP = (LAS bf16*)(C.lds + C.wave * 9216);
    LAS bf16* WV = UP + 128 * 16;
    const float* dsk = C.inp(I_S5_D, l, WB) + g * 16;
#pragma unroll 1
    for (int i4 = 0; i4 < 8; ++i4) {
        const int j = sb * 32 + (C.wave - 4) * 8 + i4, b = j >> 6, c = j & 63, item = (b * 32 + g) * 64 + c, rowb = b * SEQ + c * LCH;
        {   const u32x4* src = (const u32x4*)(Z + (size_t)(rowb + lane) * ZP + ZB_U + g * 16); const u32x4 z4 = (u32x4){0u, 0u, 0u, 0u};
            LAS u32x4* dz = (LAS u32x4*)(UP + lane * 16); dz[0] = z4; dz[1] = z4; LAS u32x4* dst = (LAS u32x4*)(UP + (64 + lane) * 16); dst[0] = src[0]; dst[1] = src[1]; }
        {   const float* E = (const float*)(S + SO_S5_E) + (size_t)item * 128; const int cp = lane >> 2, pq = lane & 3;
            const float* cr = C.inp(I_S5_CRE, l, 32 * 1024) + (size_t)g * 1024 + cp * 64 + 16 * pq; const float* ci = C.inp(I_S5_CIM, l, 32 * 1024) + (size_t)g * 1024 + cp * 64 + 16 * pq;
#pragma unroll
            for (int jj = 0; jj < 16; jj += 2) { const int p = 16 * pq + jj;
                const float a0 = cr[jj] * E[p] - ci[jj] * E[64 + p], b0 = cr[jj] * E[64 + p] + ci[jj] * E[p], a1 = cr[jj + 1] * E[p + 1] - ci[jj + 1] * E[65 + p], b1 = cr[jj + 1] * E[65 + p] + ci[jj + 1] * E[p + 1];
                *(LAS unsigned*)(WV + cp * 136 + p) = pk2(a0, a1); *(LAS unsigned*)(WV + cp * 136 + 64 + p) = pk2(b0, b1); }
        }
        LDS_WAIT(); __builtin_amdgcn_wave_barrier();
#pragma unroll
        for (int tt = 0; tt < 4; ++tt) {
            f32x4 acc = F4Z; const int t = 16 * tt + fr;
#pragma unroll 4
            for (int ks = 0; ks < 8 * (tt + 1); ++ks) {
                const bf16x8 a = ld8(KML + fr * LDKM + 32 * ks + 8 * fq);
                const bf16x8 bb = ld8(UP + (64 + t - 2 * ks - (fq >> 1)) * 16 + 8 * (fq & 1));
                acc = __builtin_amdgcn_mfma_f32_16x16x32_bf16(a, bb, acc, 0, 0, 0);
            }
            acc = tile_mm<128>(WV, 136, PML + (16 * tt) * 136, 136, acc, fr, fq);
            float y[4];
#pragma unroll
            for (int r = 0; r < 4; ++r) { const int cp = 4 * fq + r; y[r] = gelu_tanh(acc[r] + dsk[cp] * bf2f(UP[(64 + t) * 16 + cp])); }
            u32x2 o; o.x = pk2(y[0], y[1]); o.y = pk2(y[2], y[3]);
            *(u32x2*)(Z + (size_t)(rowb + t) * ZP + ZB_U + g * 16 + 4 * fq) = o;
        }
        LDS_WAIT(); __builtin_amdgcn_wave_barrier();
    }
    __syncthreads();
}

constexpr size_t SO_RW_PQ = SO_END1;
constexpr size_t SO_RW_RHO = SO_RW_PQ + 32 * MiB;
constexpr size_t SO_RW_HALO = SO_RW_RHO + 512 * 1024;
constexpr size_t SO_RW_W = SO_RW_HALO + 512 * 1024;
constexpr size_t SO_END2 = SO_RW_W + 256 * 1024;
static_assert(WS_S + SO_END2 <= WS_END, "state region");
static_assert(SO_RW_W == RWW_OFF, "RWW_OFF");
__device__ __forceinline__ void shift8(const u32x4 cur, const u32x4 prev, const float* mu, float* o) {
    float a[8], p[8]; unpack8(cur, a); unpack8(prev, p);
#pragma unroll
    for (int j = 0; j < 8; ++j) o[j] = a[j] + mu[j] * (p[j] - a[j]);
}

struct RwPre { u32x4 cw, pw, ca, pa, cr, ck, cv, pr, pk, pv; };
__device__ __forceinline__ void rw_preload(const Ctx& C, int item, RwPre& P) {
    const int bh = item >> 6, c = item & 63, b = bh >> 3, h = bh & 7, hc0 = h * 64, rowb = b * SEQ + c * LCH;
    const bf16* Z = (const bf16*)(C.ws + WS_Z); const int t = C.tid >> 3, c0 = (C.tid & 7) * 8, row = rowb + t;
    const bf16* HALO = (const bf16*)(C.ws + WS_S + SO_RW_HALO) + (size_t)(b * 64 + c - 1) * 1024;
    const u32x4 z4 = (u32x4){0u, 0u, 0u, 0u}; const bool first = (c * LCH + t == 0);
    P.cw = *(const u32x4*)(Z + (size_t)row * ZP + ZD_XW + c0); P.ca = *(const u32x4*)(Z + (size_t)row * ZP + ZD_XA + c0);
    P.cr = *(const u32x4*)(Z + (size_t)row * ZP + ZD_R + hc0 + c0); P.ck = *(const u32x4*)(Z + (size_t)row * ZP + ZD_K + hc0 + c0); P.cv = *(const u32x4*)(Z + (size_t)row * ZP + ZD_V + hc0 + c0);
    P.pw = z4; P.pa = z4; P.pr = z4; P.pk = z4; P.pv = z4;
    if (!first) { P.pw = *(const u32x4*)(Z + (size_t)(row - 1) * ZP + ZD_XW + c0); P.pa = *(const u32x4*)(Z + (size_t)(row - 1) * ZP + ZD_XA + c0); P.pv = *(const u32x4*)(Z + (size_t)(row - 1) * ZP + ZD_V + hc0 + c0);
        if (t > 0) { P.pr = *(const u32x4*)(Z + (size_t)(row - 1) * ZP + ZD_R + hc0 + c0); P.pk = *(const u32x4*)(Z + (size_t)(row - 1) * ZP + ZD_K + hc0 + c0); }
        else { P.pr = *(const u32x4*)(HALO + hc0 + c0); P.pk = *(const u32x4*)(HALO + 512 + hc0 + c0); } }
}
template <bool DRY = false> __device__ __forceinline__ void rw_passA(const Ctx& C, int l, int item, RwPre& P, int next_item) {
    const int bh = item >> 6, c = item & 63, b = bh >> 3, h = bh & 7, hc0 = h * 64, rowb = b * SEQ + c * LCH;
    bf16* Z = (bf16*)(C.ws + WS_Z); unsigned char* S = C.ws + WS_S;
    LAS unsigned char* L = C.lds;
    LAS bf16* XW = (LAS bf16*)L; LAS bf16* XA = (LAS bf16*)(L + 9216); LAS float* WARG = (LAS float*)(L + 18432);
    LAS bf16* TAB = (LAS bf16*)L; LAS bf16* TAK = (LAS bf16*)(L + 9216); LAS bf16* MRB = (LAS bf16*)(L + 18432); LAS bf16* MRK = (LAS bf16*)(L + 27648);
    LAS float* AARG = (LAS float*)(L + 36864); LAS float* LW = AARG; LAS bf16* XT = (LAS bf16*)(L + 36864);
    LAS bf16* AT = (LAS bf16*)(L + 55296); LAS bf16* RT = (LAS bf16*)(L + 64512); LAS bf16* BT = (LAS bf16*)(L + 73728); LAS bf16* KT = (LAS bf16*)(L + 82944);
    LAS float* RHSV = (LAS float*)(L + 73728);
    LAS bf16* BBT = (LAS bf16*)(L + 92160); LAS bf16* KBT = (LAS bf16*)(L + 101376); LAS bf16* VT = (LAS bf16*)(L + 110592);
    LAS float* CUML = (LAS float*)(L + 119808); LAS float* GL = CUML + 64; LAS float* SEG = GL + 64; LAS float* UPD = SEG;
    const int tid = C.tid, lane = C.lane, w = C.wave, fr = lane & 15, fq = lane >> 4;
    const int t = tid >> 3, c0 = (tid & 7) * 8, row = rowb + t;
    const float* mu = C.inp(I_RW_MU, l, 1792);
    const u32x4 z4 = (u32x4){0u, 0u, 0u, 0u};
    {   float f[8];
        shift8(P.cw, P.pw, mu + 1536 + c0, f);
#pragma unroll
        for (int j = 0; j < 8; ++j) f[j] = tanhf_(f[j]);
        *(LAS u32x4*)(XW + t * LDT + c0) = pack8(f);
        shift8(P.ca, P.pa, mu + 1600 + c0, f);
        *(LAS u32x4*)(XA + t * LDT + c0) = pack8(f);
    }
    __syncthreads();
    {   const bf16* WUP = (const bf16*)(S + SO_RW_W) + (size_t)hc0 * 64; const bf16* AUP = WUP + 512 * 64;
#pragma unroll
        for (int q = 0; q < 2; ++q) { const int id = 2 * w + q, tt = id >> 2, cc = id & 3;
            const f32x4 aw = tile_mm<64>(XW + (16 * tt) * LDT, LDT, WUP + (size_t)(16 * cc) * 64, 64, F4Z, fr, fq);
            const f32x4 aa = tile_mm<64>(XA + (16 * tt) * LDT, LDT, AUP + (size_t)(16 * cc) * 64, 64, F4Z, fr, fq);
#pragma unroll
            for (int r = 0; r < 4; ++r) { WARG[(16 * tt + 4 * fq + r) * 65 + 16 * cc + fr] = aw[r]; AARG[(16 * tt + 4 * fq + r) * 65 + 16 * cc + fr] = aa[r]; } }
    }
    __syncthreads();
    float lw[8], av[8], bv[8], kr[8], rr[8], vv[8];
    {   float kk[8], aa[8];
        shift8(P.cr, P.pr, mu + hc0 + c0, rr); shift8(P.ck, P.pk, mu + 512 + hc0 + c0, kk); shift8(P.cv, P.pv, mu + 1024 + hc0 + c0, vv);
        const float* w0 = C.inp(I_RW_W0, l, WB) + hc0 + c0; const float* a0 = C.inp(I_RW_A0, l, WB) + hc0 + c0;
        const float* kkw = C.inp(I_RW_KK, l, WB) + hc0 + c0; const float* kaw = C.inp(I_RW_KA, l, WB) + hc0 + c0; const float* rkw = C.inp(I_RW_RK, l, WB) + hc0 + c0;
        float n2 = 0.f, rho = 0.f;
#pragma unroll
        for (int j = 0; j < 8; ++j) {
            const float wl = -softplusf_(-(WARG[t * 65 + c0 + j] + w0[j])) - 0.5f; lw[j] = -__expf(wl);
            aa[j] = sigmoidf_(AARG[t * 65 + c0 + j] + a0[j]);
            const float kn = kk[j] * kkw[j]; n2 += kn * kn; av[j] = kn;
            kr[j] = kk[j] * (1.0f + (aa[j] - 1.0f) * kaw[j]); rho += rr[j] * kr[j] * rkw[j];
        }
        n2 += shx(n2, 1, lane); n2 += shx(n2, 2, lane); n2 += shx(n2, 4, lane);
        rho += shx(rho, 1, lane); rho += shx(rho, 2, lane); rho += shx(rho, 4, lane);
        const float inv = rcpf_(fmaxf(sqrtf(n2), 1e-12f));
#pragma unroll
        for (int j = 0; j < 8; ++j) { const float kkn = av[j] * inv; av[j] = -kkn; bv[j] = kkn * aa[j]; }
        if (!DRY && (tid & 7) == 0) ((float*)(S + SO_RW_RHO))[(size_t)row * 8 + h] = rho;
    }
    __syncthreads();
    if (next_item >= 0) rw_preload(C, next_item, P);
    *(LAS f32x4*)(LW + t * 64 + c0) = (f32x4){lw[0], lw[1], lw[2], lw[3]}; *(LAS f32x4*)(LW + t * 64 + c0 + 4) = (f32x4){lw[4], lw[5], lw[6], lw[7]};
    __syncthreads();
    {   const int cc = tid & 63, seg = tid >> 6; float run = 0.f, v8[8];
#pragma unroll
        for (int i = 0; i < 8; ++i) { run += LW[(seg * 8 + i) * 64 + cc]; v8[i] = run; }
        SEG[seg * 64 + cc] = run;
        __syncthreads();
        float off = 0.f;
        for (int s2 = 0; s2 < seg; ++s2) off += SEG[s2 * 64 + cc];
#pragma unroll
        for (int i = 0; i < 8; ++i) LW[(seg * 8 + i) * 64 + cc] = v8[i] + off;
        if (seg == 7) { CUML[cc] = v8[7] + off; GL[cc] = __expf(v8[7] + off); }
    }
    __syncthreads();
    {   float fa[8], fb[8], fk[8], fr_[8];
        const f32x4 cm0 = *(const LAS f32x4*)(LW + t * 64 + c0), cm1 = *(const LAS f32x4*)(LW + t * 64 + c0 + 4), cl0 = *(const LAS f32x4*)(CUML + c0), cl1 = *(const LAS f32x4*)(CUML + c0 + 4);
#pragma unroll
        for (int j = 0; j < 8; ++j) { const float cm = (j < 4) ? cm0[j & 3] : cm1[j & 3], en = __expf(-cm), el = __expf(((j < 4) ? cl0[j & 3] : cl1[j & 3]) - cm);
            fa[j] = av[j] * __expf(cm - lw[j]); fb[j] = bv[j] * en; fk[j] = kr[j] * en; fr_[j] = rr[j] * __expf(cm);
            BBT[swz(c0 + j, t)] = (bf16)f2bf(bv[j] * el); KBT[swz(c0 + j, t)] = (bf16)f2bf(kr[j] * el); VT[swz(c0 + j, t)] = (bf16)f2bf(vv[j]); }
        *(LAS u32x4*)(AT + t * LDT + c0) = pack8(fa); *(LAS u32x4*)(BT + t * LDT + c0) = pack8(fb); *(LAS u32x4*)(KT + t * LDT + c0) = pack8(fk); *(LAS u32x4*)(RT + t * LDT + c0) = pack8(fr_);
    }
    __syncthreads();
#pragma unroll
    for (int q = 0; q < 2; ++q) { const int id = 2 * w + q, tt = id >> 2, ss = id & 3; f32x4 ab = F4Z, ak = F4Z, rb = F4Z, rk = F4Z;
        if (ss <= tt) {
            ab = tile_mm<64>(BT + (16 * ss) * LDT, LDT, AT + (16 * tt) * LDT, LDT, ab, fr, fq); ak = tile_mm<64>(KT + (16 * ss) * LDT, LDT, AT + (16 * tt) * LDT, LDT, ak, fr, fq);
            rb = tile_mm<64>(BT + (16 * ss) * LDT, LDT, RT + (16 * tt) * LDT, LDT, rb, fr, fq); rk = tile_mm<64>(KT + (16 * ss) * LDT, LDT, RT + (16 * tt) * LDT, LDT, rk, fr, fq);
        }
        const int tq = 16 * tt + fr, s0 = 16 * ss + 4 * fq;
#pragma unroll
        for (int r = 0; r < 4; ++r) { if (s0 + r >= tq) { ab[r] = 0.f; ak[r] = 0.f; } if (s0 + r > tq) { rb[r] = 0.f; rk[r] = 0.f; } }
        *(LAS u32x2*)(TAB + tq * LDT + s0) = pack4(ab); *(LAS u32x2*)(TAK + tq * LDT + s0) = pack4(ak); *(LAS u32x2*)(MRB + tq * LDT + s0) = pack4(rb); *(LAS u32x2*)(MRK + tq * LDT + s0) = pack4(rk);
    }
    __syncthreads();
    LAS bf16* DINV = (LAS bf16*)SEG;
    LAS bf16* RT2 = DINV + 1024;
    if (w >= 4) {
#pragma unroll
        for (int q = 0; q < 4; ++q) { const int id = 4 * (w - 4) + q, vb = id >> 2, tt = id & 3;
            const f32x4 a = tile_mm_sw<64, true, false>(VT, LDT, 16 * vb, TAK, LDT, 16 * tt, F4Z, fr, fq);
#pragma unroll
            for (int r = 0; r < 4; ++r) RHSV[(16 * vb + 4 * fq + r) * 65 + 16 * tt + fr] = a[r]; }
        for (int i = tid - 256; i < 128 * LDT / 8; i += 256) ((LAS u32x4*)XT)[i] = z4;
    } else if (lane < 16) { const int bb = w, j = lane; float x[16];
#pragma unroll
        for (int i = 0; i < 16; ++i) { float s = (i == j) ? 1.0f : 0.0f; float tf[16];
            if (i > 0) unpack8(*(const LAS u32x4*)(TAB + (16 * bb + i) * LDT + 16 * bb), tf);
            if (i > 8) unpack8(*(const LAS u32x4*)(TAB + (16 * bb + i) * LDT + 16 * bb + 8), tf + 8);
#pragma unroll
            for (int i2 = 0; i2 < i; ++i2) s += tf[i2] * x[i2];
            x[i] = s; DINV[(bb * 16 + i) * 16 + j] = (bf16)f2bf(s); }
    }
    __syncthreads();
    typedef short s16x4 __attribute__((ext_vector_type(4)));
#pragma unroll
    for (int bi = 0; bi < 4; ++bi) {
        f32x4 u = F4Z;
        if (bi > 0) u = tile_mm<64>(XT + (16 * w) * LDT, LDT, TAB + (16 * bi) * LDT, LDT, F4Z, fr, fq);
#pragma unroll
        for (int r = 0; r < 4; ++r) { const int col = 16 * w + 4 * fq + r, tr = 16 * bi + fr;
            const float base = (w < 4) ? bf2f(AT[tr * LDT + col]) : RHSV[(col - 64) * 65 + tr];
            RT2[col * 16 + fr] = (bf16)f2bf(base + u[r]); }
        LDS_WAIT(); __builtin_amdgcn_wave_barrier();
        const s16x4 ra = *(const LAS s16x4*)(RT2 + (16 * w + fr) * 16 + 4 * fq), db = *(const LAS s16x4*)(DINV + (bi * 16 + fr) * 16 + 4 * fq);
        const f32x4 x = __builtin_amdgcn_mfma_f32_16x16x16bf16_1k(ra, db, F4Z, 0, 0, 0);
#pragma unroll
        for (int r = 0; r < 4; ++r) XT[(16 * w + 4 * fq + r) * LDT + 16 * bi + fr] = (bf16)f2bf(x[r]);
        LDS_WAIT(); __builtin_amdgcn_wave_barrier();
    }
    __syncthreads();
    bf16* PQ = (bf16*)(S + SO_RW_PQ) + (size_t)item * 8192;
#pragma unroll
    for (int q = 0; q < 2; ++q) { const int id = 2 * w + q, ib = id >> 2, jb = id & 3;
        {
            f32x4 a = tile_mm<64>(XT + (16 * ib) * LDT, LDT, MRB + (16 * jb) * LDT, LDT, F4Z, fr, fq);
            const int tq = 16 * jb + fr, j0 = 16 * ib + 4 * fq; const u32x2 rt = *(const LAS u32x2*)(RT + tq * LDT + j0);
            a[0] += bflo(rt.x); a[1] += bfhi(rt.x); a[2] += bflo(rt.y); a[3] += bfhi(rt.y);
            if (!DRY) *(u32x2*)(Z + (size_t)(rowb + tq) * ZP + ZD_R + hc0 + j0) = pack4(a); else asm volatile("" :: "v"(a)); }
        {
            f32x4 a = tile_mm<64>(XT + (64 + 16 * ib) * LDT, LDT, MRB + (16 * jb) * LDT, LDT, F4Z, fr, fq);
            a = tile_mm_sw<64, true, false>(VT, LDT, 16 * ib, MRK, LDT, 16 * jb, a, fr, fq);
            if (!DRY) *(u32x2*)(Z + (size_t)(rowb + 16 * jb + fr) * ZP + ZD_K + hc0 + 16 * ib + 4 * fq) = pack4(a); else asm volatile("" :: "v"(a)); }
        {
            f32x4 a = tile_mm_sw<64, false, true>(XT, LDT, 16 * ib, BBT, LDT, 16 * jb, F4Z, fr, fq);
            const int k = 16 * jb + fr, j0 = 16 * ib + 4 * fq;
#pragma unroll
            for (int r = 0; r < 4; ++r) if (j0 + r == k) a[r] += GL[k];
            if (!DRY) *(u32x2*)(PQ + (size_t)k * 64 + j0) = pack4(a); else asm volatile("" :: "v"(a)); }
        {
            f32x4 a = tile_mm_sw<64, true, false>(BBT, LDT, 16 * ib, XT, LDT, 64 + 16 * jb, F4Z, fr, fq);
            a = tile_mm_sw<64, true, true>(KBT, LDT, 16 * ib, VT, LDT, 16 * jb, a, fr, fq);
            if (!DRY) *(u32x2*)(PQ + 4096 + (size_t)(16 * jb + fr) * 64 + 16 * ib + 4 * fq) = pack4(a); else asm volatile("" :: "v"(a)); }
    }
    __syncthreads();
}
__device__ __forceinline__ void rw_passB(const Ctx& C, int unit) {
    const int bh = unit >> 2, vg = unit & 3, lane = C.lane, fr = lane & 15, fq = lane >> 4;
    LAS bf16* SL = (LAS bf16*)(C.lds + C.wave * 16384);
    bf16* PQ0 = (bf16*)(C.ws + WS_S + SO_RW_PQ) + (size_t)bh * 64 * 8192;
    for (int i = lane; i < 16 * LDT / 8; i += 64) ((LAS u32x4*)SL)[i] = (u32x4){0u, 0u, 0u, 0u};
    LDS_WAIT(); __builtin_amdgcn_wave_barrier();
    bf16x8 pa[4][4][2]; u32x2 qa[4][4];
#define RWB_FETCH(s, cc) do { const bf16* P_ = PQ0 + (size_t)(cc) * 8192; const bf16* Q_ = P_ + 4096 + (size_t)(16 * vg) * 64; _Pragma("unroll") for (int kk = 0; kk < 4; ++kk) { \
        pa[s][kk][0] = ld8(P_ + (size_t)(16 * kk + fr) * 64 + 8 * fq); pa[s][kk][1] = ld8(P_ + (size_t)(16 * kk + fr) * 64 + 32 + 8 * fq); qa[s][kk] = *(const u32x2*)(Q_ + (size_t)fr * 64 + 16 * kk + 4 * fq); } } while (0)
    RWB_FETCH(0, 0); RWB_FETCH(1, 1); RWB_FETCH(2, 2); RWB_FETCH(3, 3);
    for (int c4 = 0; c4 < 64; c4 += 4) {
#pragma unroll
        for (int s = 0; s < 4; ++s) {
            const int c = c4 + s;
            bf16* QT = PQ0 + (size_t)c * 8192 + 4096 + (size_t)(16 * vg) * 64;
            const bf16x8 b0 = ld8(SL + fr * LDT + 8 * fq), b1 = ld8(SL + fr * LDT + 32 + 8 * fq);
            const u32x4 s0 = *(const LAS u32x4*)(SL + (lane >> 2) * LDT + (lane & 3) * 16), s1 = *(const LAS u32x4*)(SL + (lane >> 2) * LDT + (lane & 3) * 16 + 8);
            f32x4 acc[4];
#pragma unroll
            for (int kk = 0; kk < 4; ++kk) {
                f32x4 a; a[0] = bflo(qa[s][kk].x); a[1] = bfhi(qa[s][kk].x); a[2] = bflo(qa[s][kk].y); a[3] = bfhi(qa[s][kk].y);
                a = __builtin_amdgcn_mfma_f32_16x16x32_bf16(pa[s][kk][0], b0, a, 0, 0, 0);
                acc[kk] = __builtin_amdgcn_mfma_f32_16x16x32_bf16(pa[s][kk][1], b1, a, 0, 0, 0);
            }
            LDS_WAIT(); __builtin_amdgcn_wave_barrier();
            *(u32x4*)(QT + (size_t)(lane >> 2) * 64 + (lane & 3) * 16) = s0; *(u32x4*)(QT + (size_t)(lane >> 2) * 64 + (lane & 3) * 16 + 8) = s1;
#pragma unroll
            for (int kk = 0; kk < 4; ++kk) *(LAS u32x2*)(SL + fr * LDT + 16 * kk + 4 * fq) = pack4(acc[kk]);
            LDS_WAIT(); __builtin_amdgcn_wave_barrier();
            if (c + 4 < 64) RWB_FETCH(s, c + 4);
        }
    }
#undef RWB_FETCH
}
template <bool DRY = false> __device__ __forceinline__ void rw_passC(const Ctx& C, int l, int item) {
    const int bh = item >> 6, c = item & 63, b = bh >> 3, h = bh & 7, hc0 = h * 64, rowb = b * SEQ + c * LCH;
    bf16* Z = (bf16*)(C.ws + WS_Z); unsigned char* S = C.ws + WS_S;
    const int tt = C.wave & 3, lane = C.lane, fr = lane & 15, fq = lane >> 4, t = 16 * tt + fr, row = rowb + t;
    LAS bf16* XG = (LAS bf16*)(C.lds + tt * 4608);
    const float* mu = C.inp(I_RW_MU, l, 1792); const u32x4 z4 = (u32x4){0u, 0u, 0u, 0u};
    {
        const int tl = lane >> 2, rw = rowb + 16 * tt + tl; const bool first = (c * LCH + 16 * tt + tl == 0);
#pragma unroll
        for (int q = 0; q < 4; ++q) { const int j0 = (lane & 3) * 32 + q * 8; float f[8];
            const u32x4 cg = *(const u32x4*)(Z + (size_t)rw * ZP + ZD_XG + j0), pg = first ? z4 : *(const u32x4*)(Z + (size_t)(rw - 1) * ZP + ZD_XG + j0);
            shift8(cg, pg, mu + 1664 + j0, f);
#pragma unroll
            for (int j = 0; j < 8; ++j) f[j] = sigmoidf_(f[j]);
            *(LAS u32x4*)(XG + tl * 136 + j0) = pack8(f); }
    }
    LDS_WAIT(); __builtin_amdgcn_wave_barrier();
    const bf16* SST = (const bf16*)(S + SO_RW_PQ) + (size_t)item * 8192 + 4096;
    const bf16* GUP = (const bf16*)(S + SO_RW_W) + 2 * 512 * 64 + (size_t)hc0 * 128;
    f32x4 y[4], g[4];
#pragma unroll
    for (int vb = 0; vb < 4; ++vb) {
        y[vb] = tile_mm<64>(SST + (size_t)(16 * vb) * 64, 64, Z + (size_t)(rowb + 16 * tt) * ZP + ZD_R + hc0, ZP, F4Z, fr, fq);
        const u32x2 yl = *(const u32x2*)(Z + (size_t)row * ZP + ZD_K + hc0 + 16 * vb + 4 * fq);
        y[vb][0] += bflo(yl.x); y[vb][1] += bfhi(yl.x); y[vb][2] += bflo(yl.y); y[vb][3] += bfhi(yl.y);
        g[vb] = tile_mm<128>(GUP + (size_t)(16 * vb) * 128, 128, XG, 136, F4Z, fr, fq);
    }
    float s1 = 0.f;
#pragma unroll
    for (int vb = 0; vb < 4; ++vb) s1 += (y[vb][0] + y[vb][1]) + (y[vb][2] + y[vb][3]);
    s1 += shx(s1, 16, lane); s1 += shx(s1, 32, lane);
    const float mean = s1 * (1.0f / 64); float s2 = 0.f;
#pragma unroll
    for (int vb = 0; vb < 4; ++vb)
#pragma unroll
        for (int r = 0; r < 4; ++r) { const float d = y[vb][r] - mean; y[vb][r] = d; s2 += d * d; }
    s2 += shx(s2, 16, lane); s2 += shx(s2, 32, lane);
    const float rs = rsqf_(s2 * (1.0f / 64) + 64e-5f);
    const float rho = ((const float*)(S + SO_RW_RHO))[(size_t)row * 8 + h];
    const bool first = (c * LCH + t == 0);
#pragma unroll
    for (int vb = 0; vb < 4; ++vb) { const int v0 = 16 * vb + 4 * fq;
        const u32x2 cv = *(const u32x2*)(Z + (size_t)row * ZP + ZD_V + hc0 + v0); u32x2 pv; pv.x = 0u; pv.y = 0u;
        if (!first) pv = *(const u32x2*)(Z + (size_t)(row - 1) * ZP + ZD_V + hc0 + v0);
        const float cvf[4] = {bflo(cv.x), bfhi(cv.x), bflo(cv.y), bfhi(cv.y)}, pvf[4] = {bflo(pv.x), bfhi(pv.x), bflo(pv.y), bfhi(pv.y)};
        const float* gn = C.inp(I_RW_NORM, l, WB) + hc0 + v0; const float* mv = mu + 1024 + hc0 + v0; f32x4 o;
#pragma unroll
        for (int r = 0; r < 4; ++r) { const float vs = cvf[r] + mv[r] * (pvf[r] - cvf[r]); o[r] = (y[vb][r] * rs * gn[r] + rho * vs) * g[vb][r]; }
        y[vb] = o; }
    asm volatile("s_waitcnt vmcnt(0)" ::: "memory"); __builtin_amdgcn_wave_barrier();
#pragma unroll
    for (int vb = 0; vb < 4; ++vb) { if (!DRY) *(u32x2*)(Z + (size_t)row * ZP + ZD_R + hc0 + 16 * vb + 4 * fq) = pack4(y[vb]); else asm volatile("" :: "v"(y[vb])); }
    LDS_WAIT(); __builtin_amdgcn_wave_barrier();
}

__device__ __forceinline__ void rw_s5_passC(const Ctx& C, int l) {
    s5_passC_core(C, l, [&]() {
#pragma unroll 1
        for (int i = 0; i < 8; ++i) { const Ctx Ci = make_ctx(); rw_passC(Ci, l, (int)blockIdx.x + 256 * i); }
    });
}
template <class Epi, bool ALIGN> __device__ __forceinline__ void run_gemm(const Ctx& C, const bf16* A, int lda, const bf16* Bt, int ldb, int Mr, int N, int K, const Epi& E, int Gv = 0, int cv = 0) {
    if (Gv == 0) { Gv = C.G; cv = C.bid; }
    if (cv < 0 || cv >= Gv) return;
    pg8::Gemm g{A, Bt, Mr, N, K, lda, ldb}; pg8::StaticOrder S; S.init(Mr, N, Gv, cv);
    pg8::gemm_phase<Epi, pg8::StaticOrder, ALIGN, true>(C.lds, g, S, E);
}

#ifdef PROBE_INNER
#define INNER_STAMP() do { const Ctx Cs_ = make_ctx(); PROBE_STAMP(Cs_); } while (0)
#else
#define INNER_STAMP() do { } while (0)
#endif
#define GRID_BAR() do { const Ctx Cb = make_ctx(); XcdBarrier b_; b_.bar = (unsigned*)(Cb.ws + WS_CTL) + 4096; b_.x = xb_xcc_id(); b_.st = (volatile LAS unsigned*)(Cb.lds + MISC_OFF) + 8; xcd_barrier(b_); PROBE_STAMP(Cb); } while (0)
#define PHASE_CTX() const Ctx C = make_ctx(); unsigned char* const ws = C.ws; bf16* const XB = (bf16*)(ws + WS_XB); float* const SSQ = (float*)(ws + WS_SSQ); bf16* const Z = (bf16*)(ws + WS_Z); \
    const int gw = C.bid * 8 + C.wave, NGW = C.G * 8; (void)XB; (void)SSQ; (void)Z; (void)gw; (void)NGW
#define SUBSYNC() do { VM_WAIT(); __syncthreads(); } while (0)
#define MERGE_PTRS() unsigned char* const G8 = ws + WS_G8; bf16* const MF = (bf16*)(ws + WS_MF); bf16* const MG = Z + ZC_Q; const bf16* const WG = (const bf16*)(ws + WS_SLOTA); const bf16* const WP = (const bf16*)(ws + WS_SLOTC); \
    const float* const gb = C.inp(I_GATE_BIAS, l, 4 * D); (void)G8; (void)MF; (void)MG; (void)WG; (void)WP; (void)gb
#define PHM_IN() \
        if (PH_ON(3)) {   PHASE_CTX(); \
            { EpiZ E{Z, SSQ, (bf16*)(ws + WS_S + RWW_OFF - 512 * 1024)}; run_gemm<EpiZ, true>(C, XB, D, (const bf16*)(ws + WS_SLOTB), D, M, NINP, D, E); } \
        } \
        GRID_BAR();
#define PHM_MIXA() \
        if (PH_ON(4)) {   PHASE_CTX(); \
            { RwPre P_; { const Ctx Ci = make_ctx(); rw_preload(Ci, (int)blockIdx.x, P_); } \
              for (int it = blockIdx.x; it < 2048; it += gridDim.x) { const Ctx Ci = make_ctx(); rw_passA(Ci, l, it, P_, (it + (int)gridDim.x < 2048) ? it + (int)gridDim.x : -1); } } \
        } \
        INNER_STAMP(); \
        if (PH_ON(4)) {   PHASE_CTX(); \
            {   MlPre PA_, PB_; { const Ctx Ci = make_ctx(); ml_preload(Ci, (int)blockIdx.x, PA_); } \
                { const Ctx Ci = make_ctx(); ml_preload(Ci, (int)blockIdx.x + 256, PB_); ml_passA(Ci, l, (int)blockIdx.x, PA_); } \
                { const Ctx Ci = make_ctx(); ml_preload(Ci, (int)blockIdx.x + 512, PA_); ml_passA(Ci, l, (int)blockIdx.x + 256, PB_); } \
                { const Ctx Ci = make_ctx(); ml_preload(Ci, (int)blockIdx.x + 768, PB_); ml_passA(Ci, l, (int)blockIdx.x + 512, PA_); } \
                { const Ctx Ci = make_ctx(); ml_passA(Ci, l, (int)blockIdx.x + 768, PB_); } } \
        } \
        INNER_STAMP(); \
        if (PH_ON(4)) {   PHASE_CTX(); \
            {   GlaW W_; GlaPre PA_, PB_; { const Ctx Ci = make_ctx(); gla_loadw(Ci, l, (int)blockIdx.x >> 6, W_); gla_preload(Ci, (int)blockIdx.x, PA_, false); } \
                { const Ctx Ci = make_ctx(); gla_preload(Ci, (int)blockIdx.x + 256, PB_, false); gla_passA(Ci, l, (int)blockIdx.x, W_, PA_); } \
                { const Ctx Ci = make_ctx(); gla_preload(Ci, (int)blockIdx.x + 512, PA_, false); gla_passA(Ci, l, (int)blockIdx.x + 256, W_, PB_); } \
                { const Ctx Ci = make_ctx(); gla_preload(Ci, (int)blockIdx.x + 768, PB_, false); gla_passA(Ci, l, (int)blockIdx.x + 512, W_, PA_); } \
                { const Ctx Ci = make_ctx(); gla_passA(Ci, l, (int)blockIdx.x + 768, W_, PB_); } } \
            { const Ctx Ci = make_ctx(); s5_passA(Ci); } \
            if (DUPM == 9 && l == 0) { const Ctx Ci = make_ctx(); s5_passA(Ci); } \
        } \
        GRID_BAR();
#define PHM_MIXB() \
        if (PH_ON(4)) {   PHASE_CTX();        \
            const ConvPlan CP = conv_setup(C, CJ_GATES | CJ_PROJ | CJ_XW | CJ_GU2S, l); \
            const bool rwv = ((gw & 15) == 0); const int widx = gw - ((gw >> 4) + 1), NW = NGW - NGW / 16, tidx = widx * 64 + C.lane, NT = NW * 64; \
            if (rwv) rw_passB(C, gw >> 4); \
            else { ml_passB(C, tidx, NT); gla_passB(C, tidx, NT); s5_passB(C, tidx, NT); conv_work(C, CP, widx, NW); } \
        } \
        GRID_BAR();
#define PHM_MIXC() \
        if (PH_ON(4)) {   PHASE_CTX(); \
            { const Ctx Ci = make_ctx(); rw_s5_passC(Ci, l); } \
        } \
        __syncthreads(); \
        INNER_STAMP(); \
        if (PH_ON(4)) {   PHASE_CTX(); \
            {   MlPre PA_, PB_; { const Ctx Ci = make_ctx(); ml_preload(Ci, (int)blockIdx.x, PA_); } \
                { const Ctx Ci = make_ctx(); ml_preload(Ci, (int)blockIdx.x + 256, PB_); ml_passC(Ci, l, (int)blockIdx.x, PA_); } \
                { const Ctx Ci = make_ctx(); ml_preload(Ci, (int)blockIdx.x + 512, PA_); ml_passC(Ci, l, (int)blockIdx.x + 256, PB_); } \
                { const Ctx Ci = make_ctx(); ml_preload(Ci, (int)blockIdx.x + 768, PB_); ml_passC(Ci, l, (int)blockIdx.x + 512, PA_); } \
                { const Ctx Ci = make_ctx(); ml_passC(Ci, l, (int)blockIdx.x + 768, PB_); } } \
        } \
        INNER_STAMP(); \
        if (PH_ON(4)) {   PHASE_CTX(); \
            {   GlaW W_; GlaPre PA_, PB_; { const Ctx Ci = make_ctx(); gla_loadw(Ci, l, (int)blockIdx.x >> 6, W_); gla_preload(Ci, (int)blockIdx.x, PA_, true); } \
                { const Ctx Ci = make_ctx(); gla_preload(Ci, (int)blockIdx.x + 256, PB_, true); gla_passC(Ci, l, (int)blockIdx.x, W_, PA_); } \
                { const Ctx Ci = make_ctx(); gla_preload(Ci, (int)blockIdx.x + 512, PA_, true); gla_passC(Ci, l, (int)blockIdx.x + 256, W_, PB_); } \
                { const Ctx Ci = make_ctx(); gla_preload(Ci, (int)blockIdx.x + 768, PB_, true); gla_passC(Ci, l, (int)blockIdx.x + 512, W_, PA_); } \
                { const Ctx Ci = make_ctx(); gla_passC(Ci, l, (int)blockIdx.x + 768, W_, PB_); } } \
        } \
        if (PH_ON(4)) {   PHASE_CTX(); \
        } \
        GRID_BAR();
#define PHM_MERGE() \
        if (PH_ON(5)) { PHASE_CTX(); MERGE_PTRS(); pg8::StaticOrder S0; S0.init(M, D, C.G, C.bid); pg8::Unit u0; S0.next(0, u0); OwnTile4 S4{u0.pm, u0.pn}; \
            pg8::Gemm g{XB, WG, M, 4 * D, D, D, D}; EpiGate8 E{G8, SSQ, gb}; pg8::gemm_phase<EpiGate8, OwnTile4, true, true>(C.lds, g, S4, E); } SUBSYNC(); \
        if (PH_ON(5)) { PHASE_CTX(); MERGE_PTRS(); EpiMerge8<0> E{G8, 0, MF, MG, ZP}; run_gemm<EpiMerge8<0>, false>(C, Z + ZA_O, ZP, WP, WB, M, D, WB, E); } SUBSYNC(); \
        if (PH_ON(5)) { PHASE_CTX(); MERGE_PTRS(); EpiGlu8 E{G8}; run_gemm<EpiGlu8, false>(C, Z + ZB_U, ZP, WP + 2 * (size_t)D * WB, WB, M, D, WB, E); } SUBSYNC(); \
        if (PH_ON(5)) { PHASE_CTX(); MERGE_PTRS(); EpiMerge8<1> E{G8, 1, MF, MG, ZP}; run_gemm<EpiMerge8<1>, false>(C, Z + ZB_U, ZP, WP + (size_t)D * WB, WB, M, D, WB, E); } SUBSYNC(); \
        if (PH_ON(5)) { PHASE_CTX(); MERGE_PTRS(); EpiMerge8<1> E{G8, 2, MF, MG, ZP}; run_gemm<EpiMerge8<1>, false>(C, Z + ZC_G, ZP, WP + 3 * (size_t)D * WB, WB, M, D, WB, E); } SUBSYNC(); \
        if (PH_ON(5)) { PHASE_CTX(); MERGE_PTRS(); EpiMerge8<2> E{G8, 3, MF, MG, ZP}; run_gemm<EpiMerge8<2>, false>(C, Z + ZD_R, ZP, WP + 4 * (size_t)D * WB, WB, M, D, WB, E); } \
        GRID_BAR();
#ifdef DUP_MODE
constexpr int DUPM = DUP_MODE;
#else
constexpr int DUPM = 0;
#endif
#ifndef STOP_AFTER
#define STOP_AFTER 1000
#endif
#define PH_ON(n) ((l) * 20 + (n) <= STOP_AFTER)
template <int l> __device__ __forceinline__ void layer_fwd() {
        if (PH_ON(1)) {   PHASE_CTX();
            { EpiSwiglu E{(bf16*)(ws + WS_HID), SSQ}; run_gemm<EpiSwiglu, true>(C, XB, D, (const bf16*)(ws + WS_SLOTA), D, M, 2 * FF, D, E); }
            {
                const int s0 = (l == 0) ? 192 : 128, ns = 256 - s0;
                if (C.bid >= s0) {
                    run_conv(C, (l > 0 ? CJ_D1 : 0) | CJ_MLW | CJ_RWW, l, (C.bid - s0) * 8 + C.wave, ns * 8);
                    if (C.bid - s0 < 32) { const Ctx Ci = make_ctx(); s5_prep(Ci, l, C.bid - s0); }
                }
            }
            if (l == 0) {
                for (int q = 0; q < DEPTH; ++q) { EpiKV E{(bf16*)(ws + WS_KV + (size_t)q * 4 * MiB), (bf16*)(ws + WS_KV + (size_t)q * 4 * MiB + 2 * MiB), (const float*)(ws + WS_MEMR)};
                    run_gemm<EpiKV, true>(C, (const bf16*)(ws + WS_MEMB), D, (const bf16*)(ws + WS_S + (size_t)q * 4 * MiB), D, MMEM, 2 * D, D, E, 32, C.bid - 128 - 32 * q); }
            }
        }
        GRID_BAR();
        if (DUPM == 14 && l == 0) {
        if (PH_ON(1)) {   PHASE_CTX();

            { EpiSwiglu E{(bf16*)(ws + WS_HID), SSQ}; run_gemm<EpiSwiglu, true>(C, XB, D, (const bf16*)(ws + WS_SLOTA), D, M, 2 * FF, D, E); }
            if (l == 0) {
                for (int q = 0; q < DEPTH; ++q) { EpiKV E{(bf16*)(ws + WS_KV + (size_t)q * 4 * MiB), (bf16*)(ws + WS_KV + (size_t)q * 4 * MiB + 2 * MiB), (const float*)(ws + WS_MEMR)};
                    run_gemm<EpiKV, true>(C, (const bf16*)(ws + WS_MEMB), D, (const bf16*)(ws + WS_S + (size_t)q * 4 * MiB), D, MMEM, 2 * D, D, E, 32, C.bid - 128 - 32 * q); }
            }
        }
        GRID_BAR();
        }
        if (PH_ON(2)) {   PHASE_CTX();
            { EpiResid E{(l == 0) ? C.in[I_X] : (const float*)C.X, C.X, XB, SSQ, 0.5f}; run_gemm<EpiResid, false>(C, (const bf16*)(ws + WS_HID), FF, (const bf16*)(ws + WS_SLOTC), FF, M, D, FF, E); }
        }
        GRID_BAR();
#if defined(DUP_MODE)
        if (l == 0 && DUP_MODE >= 1 && DUP_MODE <= 4) {
#if DUP_MODE == 1
            PHM_IN();
#elif DUP_MODE == 2
            PHM_IN(); PHM_MIXA();
#elif DUP_MODE == 3
            PHM_IN(); PHM_MIXA(); PHM_MIXB();
#elif DUP_MODE == 4
            PHM_IN(); PHM_MIXA(); PHM_MIXB(); PHM_MIXC();
#endif
            { PHASE_CTX(); run_conv(C, CJ_WIN, l, gw, NGW); } GRID_BAR();
            GRID_BAR();
        }
#endif
        PHM_IN(); PHM_MIXA(); PHM_MIXB(); PHM_MIXC();
        PHM_MERGE();
#if defined(DUP_MODE) && DUP_MODE == 5
        if (l == 0) { PHM_MERGE(); }
#endif
        if (PH_ON(6)) {   PHASE_CTX();
            run_conv(C, CJ_D2, l, gw, NGW);
            { EpiResid E{C.X, C.X, XB, SSQ, 1.0f}; run_gemm<EpiResid, false>(C, Z + ZC_Q, ZP, (const bf16*)(ws + WS_SLOTB), D, M, D, D, E); }
        }
        GRID_BAR();
        {
            const int un = blockIdx.x; const int pm = un >> 2, hh = un & 3, bb = pm >> 4;
            if (PH_ON(8)) {   PHASE_CTX();
                bf16* Qp = (bf16*)(ws + WS_XQ) + (size_t)C.bid * 65536;
                pg8::Gemm g{XB + (size_t)pm * 256 * D, (const bf16*)(ws + WS_SLOTB + 2 * MiB) + (size_t)hh * 256 * D, 256, 256, D, D, D}; pg8::SingleUnit S;
                EpiBf16 E{Qp, 256, SSQ + (size_t)pm * 256 * 16, 0.0625f * 1.4426950408889634f, 256};
                pg8::gemm_phase<EpiBf16, pg8::SingleUnit, false, true>(C.lds, g, S, E);
            }
            SUBSYNC();
            if (PH_ON(8)) {   PHASE_CTX();
                const bf16* Qp = (const bf16*)(ws + WS_XQ) + (size_t)C.bid * 65536;
                const bf16* Kd = (const bf16*)(ws + WS_KV + (size_t)l * 4 * MiB) + (size_t)bb * 256 * D + hh * 256;
                bf16* P = (bf16*)(ws + WS_XP) + (size_t)C.bid * 65536;
                pg8::Gemm g{Qp, Kd, 256, 256, 256, 256, D}; pg8::SingleUnit S; EpiSoftmaxP E{P}; pg8::gemm_phase<EpiSoftmaxP, pg8::SingleUnit, false, true>(C.lds, g, S, E);
            }
            SUBSYNC();
            if (PH_ON(8)) {   PHASE_CTX();
                const bf16* VT = (const bf16*)(ws + WS_KV + (size_t)l * 4 * MiB + 2 * MiB) + (size_t)hh * 256 * MMEM + bb * 256;
                const bf16* P = (const bf16*)(ws + WS_XP) + (size_t)C.bid * 65536;
                pg8::Gemm g{P, VT, 256, 256, 256, 256, MMEM}; pg8::SingleUnit S; EpiBf16 E{(bf16*)(ws + WS_XO) + (size_t)pm * 256 * D + hh * 256, D, nullptr, 1.0f, 256};
                pg8::gemm_phase<EpiBf16, pg8::SingleUnit, false, true>(C.lds, g, S, E);
            }
            SUBSYNC();
        }
        GRID_BAR();
        if (PH_ON(9)) {   PHASE_CTX();
            EpiResid E{C.X, C.X, XB, SSQ, 1.0f}; run_gemm<EpiResid, false>(C, (const bf16*)(ws + WS_XO), D, (const bf16*)(ws + WS_SLOTB + 4 * MiB), D, M, D, D, E);
        }
        GRID_BAR();
        if (PH_ON(10)) {   PHASE_CTX();
            { EpiSwiglu E{(bf16*)(ws + WS_HID), SSQ}; run_gemm<EpiSwiglu, true>(C, XB, D, (const bf16*)(ws + WS_GU2S), D, M, 2 * FF, D, E); }
            if (l + 1 < DEPTH && C.bid >= 128) { run_conv(C, CJ_WIN | CJ_GU1, l + 1, (C.bid - 128) * 8 + C.wave, 128 * 8); }
        }
        GRID_BAR();
        if (DUPM == 18 && l == 0) {
        if (PH_ON(10)) {   PHASE_CTX();
            if (l + 1 < DEPTH) { run_conv(C, CJ_WIN, l + 1, gw, NGW); }
            { EpiSwiglu E{(bf16*)(ws + WS_HID), SSQ}; run_gemm<EpiSwiglu, true>(C, XB, D, (const bf16*)(ws + WS_SLOTA), D, M, 2 * FF, D, E); }
        }
        GRID_BAR();
        }
        if (PH_ON(11)) {   PHASE_CTX();
            { EpiResid E{C.X, C.X, XB, SSQ, 0.5f}; run_gemm<EpiResid, false>(C, (const bf16*)(ws + WS_HID), FF, (const bf16*)(ws + WS_SLOTC), FF, M, D, FF, E); }
        }
        GRID_BAR();
    }

__global__ void __launch_bounds__(512, 2) fwd_kernel(Args args) {
    extern __shared__ __attribute__((aligned(16))) unsigned char lds_raw[];
    (void)args;
    {
        const Ctx C = make_ctx();
        volatile LAS unsigned* MISC = (volatile LAS unsigned*)(C.lds + MISC_OFF);
        for (int u = C.tid; u < (LDS_BYTES - RING_BYTES) / 4; u += 512) ((LAS unsigned*)(C.lds + RING_BYTES))[u] = 0u;
        __syncthreads();
        (void)xcd_barrier_post((unsigned*)(C.ws + WS_CTL) + 4096, MISC + 8);
        PROBE_STAMP(C);
    }

    {   PHASE_CTX();
        pro_rows(C);
        run_conv(C, CJ_GU1 | CJ_D1 | CJ_WIN | CJ_XKV0 | CJ_XKV1, 0, gw, NGW);
    }
    GRID_BAR();
    if (DUPM == 17) {
    {   PHASE_CTX();
        pro_rows(C);
        run_conv(C, CJ_GU1 | CJ_D1 | CJ_WIN | CJ_XKV0 | CJ_XKV1, 0, gw, NGW);
    }
    GRID_BAR();
    }

    if (DUPM == 30) { for (int q = 0; q < 40; ++q) { GRID_BAR(); } }
    layer_fwd<0>();
    layer_fwd<1>();
    {   PHASE_CTX();
        final_rows(C);
#ifdef PROBE_LO
        {
            __syncthreads();
            const unsigned long long* st = (const unsigned long long*)(ws + WS_CTL + 32768);
            const unsigned long long ta = __hip_atomic_load(st + PROBE_LO, __ATOMIC_RELAXED, __HIP_MEMORY_SCOPE_AGENT), tb = __hip_atomic_load(st + PROBE_HI, __ATOMIC_RELAXED, __HIP_MEMORY_SCOPE_AGENT);
            float e = 0.08f + (float)(tb - ta) * PROBE_K; if (e > 0.31f) e = 0.31f;
            const int gwv = C.bid * 8 + C.wave;
            if (gwv == 7 && C.lane == 5) C.X[(size_t)7 * D + 5] += e;
        }
#endif
        if (xb_ld((unsigned*)(ws + WS_CTL) + 4096 + XB_TMO) != 0u) {
            for (size_t i = (size_t)C.bid * 512 + C.tid; i < (size_t)M * D; i += (size_t)C.G * 512) C.X[i] = __builtin_nanf("");
        }
    }
}

extern "C" void kernel_launch(void* const* d_in, const int* in_sizes, int n_in, void* d_out, int out_size, void* d_ws, size_t ws_size, hipStream_t stream) {
    static int grid = 0;
    if (grid == 0) {
        if (n_in != N_INPUTS || out_size != M * D || ws_size < WS_END) { fprintf(stderr, "kernel_launch: unexpected shapes: n_in %d out %d ws %zu (need %zu)\n", n_in, out_size, ws_size, (size_t)WS_END); grid = -1; return; }
        int dev = 0, cus = 0, per_cu = 0;
        if (hipGetDevice(&dev) != hipSuccess || hipDeviceGetAttribute(&cus, hipDeviceAttributeMultiprocessorCount, dev) != hipSuccess) { grid = -1; return; }
        if (hipFuncSetAttribute((const void*)fwd_kernel, hipFuncAttributeMaxDynamicSharedMemorySize, LDS_BYTES) != hipSuccess) { fprintf(stderr, "kernel_launch: hipFuncSetAttribute failed\n"); grid = -1; return; }
        if (hipOccupancyMaxActiveBlocksPerMultiprocessor(&per_cu, (const void*)fwd_kernel, 512, LDS_BYTES) != hipSuccess || per_cu < 1) { fprintf(stderr, "kernel_launch: occupancy query says %d workgroups per CU\n", per_cu); (void)hipGetLastError(); grid = -1; return; }
        if (cus < 256) { fprintf(stderr, "kernel_launch: built for a 256-CU device (got %d)\n", cus); grid = -1; return; }
        grid = 256;
    }
    if (grid < 0) return;
    if (hipMemsetAsync((char*)d_ws + WS_CTL, 0, CTL_ZERO_BYTES, stream) != hipSuccess) return;
    Args a{};
    for (int i = 0; i < N_INPUTS; ++i) a.in[i] = (const float*)d_in[i];
    a.out = (float*)d_out; a.ws = (unsigned char*)d_ws;
    hipLaunchKernelGGL(fwd_kernel, dim3(grid), dim3(512), LDS_BYTES, stream, a);
}
```

```cpp
#include <hip/hip_runtime.h>
#include <cstdio>
#include <cstdint>

#define LAS __attribute__((address_space(3)))
#define GAS __attribute__((address_space(1)))
typedef unsigned short bf16;
typedef float f32x4 __attribute__((ext_vector_type(4)));
typedef float f32x2 __attribute__((ext_vector_type(2)));
typedef unsigned u32x4 __attribute__((ext_vector_type(4)));
typedef unsigned u32x2 __attribute__((ext_vector_type(2)));
typedef short bf16x8 __attribute__((ext_vector_type(8)));

constexpr int NB = 4, SEQ = 4096, M = NB * SEQ, D = 1024, FF = 2816, WB = 512, DEPTH = 2, MEML = 256, MMEM = NB * MEML;
constexpr int NZ = 4888, ZP = 4896, NINP = 5120, NIN = 8984;
constexpr int ZA_U = 0, ZA_O = 512, ZA_I = 1024, ZA_F = 1028, ZB_U = 1032, ZC_Q = 1544, ZC_K = 1800, ZC_V = 2056, ZC_G = 2568, ZC_A = 3080;
constexpr int ZD_R = 3096, ZD_K = 3608, ZD_V = 4120, ZD_XW = 4632, ZD_XA = 4696, ZD_XG = 4760, ZG = 4888;
constexpr float NORM_EPS = 1e-6f;

enum { I_X = 0, I_MEM, I_FFN1_NORM, I_FFN1_WG, I_FFN1_WU, I_FFN1_WD, I_MIX_NORM, I_W_IN, I_GATE_BIAS, I_ML_CONV, I_ML_WQ, I_ML_WK, I_ML_WV, I_ML_BI, I_ML_BF,
       I_ML_NORM, I_ML_PROJ, I_S5_ARE, I_S5_AIM, I_S5_LOGSTEP, I_S5_BRE, I_S5_BIM, I_S5_CRE, I_S5_CIM, I_S5_D, I_S5_W1, I_S5_W2, I_GLA_AUP, I_GLA_ABIAS,
       I_GLA_NORM, I_GLA_PROJ, I_RW_MU, I_RW_W0, I_RW_WUP, I_RW_A0, I_RW_AUP, I_RW_GUP, I_RW_KK, I_RW_KA, I_RW_RK, I_RW_NORM, I_RW_PROJ, I_W_OUT,
       I_XA_NORM, I_MEM_NORM, I_XA_WQ, I_XA_WK, I_XA_WV, I_XA_WO, I_FFN2_NORM, I_FFN2_WG, I_FFN2_WU, I_FFN2_WD, I_FINAL_NORM, N_INPUTS };

constexpr size_t MiB = 1u << 20;
constexpr size_t WS_CTL = 0, CTL_ZERO_BYTES = 64 * 1024;
constexpr size_t WS_SSQ = 1 * MiB;
constexpr size_t WS_MEMR = 256 * 1024;
constexpr size_t WS_XB = 2 * MiB;
constexpr size_t WS_MEMB = 34 * MiB;
constexpr size_t WS_KV = 36 * MiB;
constexpr size_t WS_SLOTA = 44 * MiB;
constexpr size_t WS_SLOTB = 55 * MiB;
constexpr size_t WS_SLOTC = 65 * MiB;
constexpr size_t WS_Z = 73 * MiB;
constexpr size_t Z_BYTES = (size_t)M * ZP * 2;
constexpr size_t WS_S = WS_Z + Z_BYTES;
constexpr size_t WS_END = 350110016;
static_assert(WS_S == 226 * MiB, "map");
constexpr size_t S_BYTES = WS_END - WS_S;
constexpr size_t WS_HID = WS_Z;
constexpr size_t WS_XQ = WS_Z, WS_XO = WS_Z + 32 * MiB, WS_XP = WS_Z + 64 * MiB;
constexpr size_t WS_G8 = WS_S, WS_MF = WS_S + 64 * MiB;
static_assert(WS_MF + 32 * MiB <= WS_END, "merge stash");

constexpr int LDS_BYTES = 147456, RING_BYTES = 131072, MISC_OFF = RING_BYTES + 320;

#define RLX_AGENT __ATOMIC_RELAXED, __HIP_MEMORY_SCOPE_AGENT
#define LDS_WAIT() asm volatile("s_waitcnt lgkmcnt(0)" ::: "memory")
#define VM_WAIT() asm volatile("s_waitcnt vmcnt(0)" ::: "memory")
typedef __bf16 bf16x2_t __attribute__((ext_vector_type(2)));
__device__ __forceinline__ unsigned pk2(float lo, float hi) { const f32x2 v = {lo, hi}; return __builtin_bit_cast(unsigned, __builtin_convertvector(v, bf16x2_t)); }
__device__ __forceinline__ unsigned f2bf(float f) { return pk2(f, 0.f); }
__device__ __forceinline__ float bf2f(unsigned h) { return __builtin_bit_cast(float, h << 16); }
__device__ __forceinline__ float bflo(unsigned w) { return __builtin_bit_cast(float, w << 16); }
__device__ __forceinline__ float bfhi(unsigned w) { return __builtin_bit_cast(float, w & 0xffff0000u); }
__device__ __forceinline__ float rcpf_(float x) { return __builtin_amdgcn_rcpf(x); }
__device__ __forceinline__ float rsqf_(float x) { return __builtin_amdgcn_rsqf(x); }
__device__ __forceinline__ float sigmoidf_(float x) { return rcpf_(1.0f + __expf(-x)); }
__device__ __forceinline__ float siluf_(float x) { return x * rcpf_(1.0f + __expf(-x)); }
__device__ __forceinline__ float softplusf_(float x) { return fmaxf(x, 0.f) + __logf(1.0f + __expf(-fabsf(x))); }
__device__ __forceinline__ float tanhf_(float x) { const float e = __expf(-2.0f * fabsf(x)); const float t = (1.0f - e) * rcpf_(1.0f + e); return x < 0.f ? -t : t; }
__device__ __forceinline__ float logsigmoidf_(float x) { return -softplusf_(-x); }
__device__ __forceinline__ float shx(float v, int mask, int lane) { return __builtin_bit_cast(float, __builtin_amdgcn_ds_bpermute((lane ^ mask) << 2, __builtin_bit_cast(int, v))); }
__device__ __forceinline__ float wave_sum(float v, int lane) {
#pragma unroll
    for (int o = 1; o < 64; o <<= 1) v += shx(v, o, lane);
    return v;
}

#define XB_TMO      128
#define XB_XCNT(j)  (256  + 64 * (j))
#define XB_XSUB(j)  (1280 + 64 * (j))
#define XB_XGEN(j)  (2304 + 64 * (j))
#define XB_TOP      3328
#define XB_TOPGEN   3392
#define XCD_BAR_WORDS 3456
#define XB_SPIN_CAP (1u << 20)
__device__ __forceinline__ unsigned xb_ld(unsigned* p)              { return __hip_atomic_load(p, __ATOMIC_RELAXED, __HIP_MEMORY_SCOPE_AGENT); }
__device__ __forceinline__ unsigned xb_add(unsigned* p, unsigned v) { return __hip_atomic_fetch_add(p, v, __ATOMIC_RELAXED, __HIP_MEMORY_SCOPE_AGENT); }
__device__ __forceinline__ unsigned xb_xcc_id() { return (unsigned)__builtin_amdgcn_s_getreg((3 << 11) | 20) & 0xFu; }
#define XB_SPIN(cond, bar) do { unsigned _sp = 0; while (cond) { __builtin_amdgcn_s_sleep(1); \
    if ((++_sp & 255u) == 0u) { if (xb_ld(&(bar)[XB_TMO])) break; if (_sp > XB_SPIN_CAP) { atomicAdd(&(bar)[XB_TMO], 1u); break; } } } } while (0)
struct XcdBarrier { unsigned* bar; unsigned x; volatile LAS unsigned* st; };
__device__ __forceinline__ XcdBarrier xcd_barrier_post(unsigned* bar, volatile LAS unsigned* st) {
    XcdBarrier b; b.bar = bar; b.x = xb_xcc_id(); b.st = st;
    if (threadIdx.x == 0) (void)xb_add(&bar[XB_XCNT(b.x)], 1u);
    return b;
}
__device__ __forceinline__ void xcd_barrier_complete(unsigned* bar, unsigned x, unsigned& nloc, unsigned& nx) {
    const unsigned G = gridDim.x * gridDim.y * gridDim.z;
    unsigned sum, cnt, mine, sp = 0u;
    for (;;) {
        sum = 0u; cnt = 0u; mine = 0u;
#pragma unroll
        for (unsigned j = 0; j < 16; ++j) { const unsigned c = xb_ld(&bar[XB_XCNT(j)]); sum += c; cnt += (c > 0u) ? 1u : 0u; mine = (j == x) ? c : mine; }
        if (sum == G) break;
        __builtin_amdgcn_s_sleep(1);
        if ((++sp & 255u) == 0u) { if (xb_ld(&bar[XB_TMO])) break; if (sp > XB_SPIN_CAP) { atomicAdd(&bar[XB_TMO], 1u); break; } }
    }
    nloc = mine > 0u ? mine : 1u; nx = cnt > 0u ? cnt : 1u;
}
__device__ __forceinline__ void xcd_barrier(const XcdBarrier& b) {
    asm volatile("s_waitcnt vmcnt(0)" ::: "memory");
    __syncthreads();
    if (threadIdx.x == 0) {
        unsigned* bar = b.bar;
        __builtin_amdgcn_s_waitcnt(0);
        unsigned nloc = b.st[0], nx = b.st[1];
        if (nloc == 0u) { xcd_barrier_complete(bar, b.x, nloc, nx); b.st[0] = nloc; b.st[1] = nx; }
        const unsigned old = xb_add(&bar[XB_XSUB(b.x)], 1u);
        const unsigned gen = old / nloc;
        if (old + 1u == (gen + 1u) * nloc) {
            __builtin_amdgcn_fence(__ATOMIC_RELEASE, "agent");
            asm volatile("s_waitcnt vmcnt(0)" ::: "memory");
            const unsigned og = xb_add(&bar[XB_TOP], 1u);
            const unsigned tg = og / nx;
            if (og + 1u == (tg + 1u) * nx) xb_add(&bar[XB_TOPGEN], 1u);
            else XB_SPIN(xb_ld(&bar[XB_TOPGEN]) == tg, bar);
            __builtin_amdgcn_fence(__ATOMIC_ACQUIRE, "agent");
            xb_add(&bar[XB_XGEN(b.x)], 1u);
            asm volatile("s_waitcnt vmcnt(0)" ::: "memory");
        } else {
            XB_SPIN(xb_ld(&bar[XB_XGEN(b.x)]) == gen, bar);
            __builtin_amdgcn_fence(__ATOMIC_ACQUIRE, "agent");
            asm volatile("s_waitcnt vmcnt(0)" ::: "memory");
        }
    }
    __syncthreads();
}
namespace pg8 {
#define PG8_LAS __attribute__((address_space(3)))
typedef unsigned short bf16_t;
typedef short bf16x8 __attribute__((ext_vector_type(8)));
typedef float f32x4 __attribute__((ext_vector_type(4)));
typedef unsigned u32x4 __attribute__((ext_vector_type(4)));
constexpr int BM = 256, BK = 64, HALF = 128, HTB = HALF * BK * 2  , STAGE_BYTES = 8 * HTB, NXCD = 8, WGM = 8;

__host__ __device__ __forceinline__ int lds_byte(int r, int c) { const int st = (r >> 4) * 2 + (c >> 5), rr = r & 15, cc = c & 31, ob = rr * 64 + cc * 2; return st * 1024 + (ob ^ (((ob >> 9) & 1) << 5)); }
__host__ __device__ __forceinline__ void stage_rc(int b, int& R, int& C) { const int st = b / 1024, sb = b % 1024, swz = sb ^ (((sb >> 9) & 1) << 5); R = (st >> 1) * 16 + swz / 64; C = (st & 1) * 32 + (swz % 64) / 2; }
__host__ __device__ __forceinline__ int perm32(int rho) { const int n = rho >> 4, i = rho & 15; return 8 * (i >> 2) + 4 * n + (i & 3); }

struct Unit { int pm, pn, job; };
struct Gemm { const bf16_t* A; const bf16_t* Bt; int M, N, K, lda, ldb; };

struct StaticOrder {
    static constexpr bool CHAIN = false;
    int nM, nN, nwg, G, c;
    __host__ __device__ void init(int M, int N, int G_, int c_) { nM = M / BM; nN = N / BM; nwg = nM * nN; G = G_; c = c_; }
    __host__ __device__ __forceinline__ bool next(int i, Unit& u) const {
        const long L = (long)i * G + c; if (L >= nwg) return false;
        int wgid = (int)L; { const int q = nwg / NXCD, r = nwg % NXCD, xcd = wgid % NXCD, off = wgid / NXCD; wgid = (xcd < r ? xcd * (q + 1) : r * (q + 1) + (xcd - r) * q) + off; }
        const int nig = WGM * nN, gid = wgid / nig, fm = gid * WGM, gsz = (nM - fm) < WGM ? (nM - fm) : WGM;
        u.pm = fm + ((wgid % nig) % gsz); u.pn = (wgid % nig) / gsz; u.job = 0; return true;
    }
    __device__ __forceinline__ void a_ready(const Unit&) const {}
    __device__ __forceinline__ void done(const Unit&) const {}
    __device__ __forceinline__ const char* baseA(const Gemm& g, const Unit&) const { return (const char*)g.A; }
    __device__ __forceinline__ const char* baseB(const Gemm& g, const Unit&) const { return (const char*)g.Bt; }
};


struct SingleUnit {
    static constexpr bool CHAIN = false;
    __device__ __forceinline__ bool next(int i, Unit& u) const { if (i > 0) return false; u.pm = 0; u.pn = 0; u.job = 0; return true; }
    __device__ __forceinline__ void a_ready(const Unit&) const {}
    __device__ __forceinline__ void done(const Unit&) const {}
    __device__ __forceinline__ const char* baseA(const Gemm& g, const Unit&) const { return (const char*)g.A; }
    __device__ __forceinline__ const char* baseB(const Gemm& g, const Unit&) const { return (const char*)g.Bt; }
};
typedef __bf16 bf16x2_cv __attribute__((ext_vector_type(2))); typedef float f32x2_cv __attribute__((ext_vector_type(2)));
__device__ __forceinline__ unsigned cvt_pk_bf16(float lo, float hi) { const f32x2_cv v = {lo, hi}; return __builtin_bit_cast(unsigned, __builtin_convertvector(v, bf16x2_cv)); }
template <class Epi, class Sched, bool ALIGN_EPI = false, bool SP2 = false>
__device__ __forceinline__ void gemm_phase(PG8_LAS unsigned char* lds, const Gemm g, const Sched& S, const Epi& E) {
    int tid_ = threadIdx.x; asm volatile("" : "+v"(tid_));
    const int tid = tid_, wid = __builtin_amdgcn_readfirstlane(tid >> 6), lane = tid & 63, wr = wid >> 2, wc = wid & 3, fr = lane & 15, fq = lane >> 4;
    const int K = g.K, nt = K / BK, lda = g.lda, ldb = g.ldb;
    unsigned voffA[2], voffB[2];
#pragma unroll
    for (int i = 0; i < 2; ++i) { int R, C; stage_rc(tid * 16 + i * 8192, R, C); const int Rb = Epi::PERM ? ((R & ~31) + perm32(R & 31)) : R;
        voffA[i] = (unsigned)(R * lda + C) * 2u; voffB[i] = (unsigned)(Rb * ldb + C) * 2u; }
    const size_t kstep = (size_t)(BK * 2);
    const size_t hstepA = (size_t)HALF * lda * 2, hstepB = (size_t)HALF * ldb * 2;
    const size_t tstepA = 2 * hstepA, tstepB = 2 * hstepB;
    const unsigned ldsw = (unsigned)wid * 1024u;
    const int aoff = lds_byte(wr * 64 + fr, fq * 8), boff = lds_byte(wc * 32 + fr, fq * 8);
#define PG8_SA(b, h) (((b) * 2 + (h)) * HTB)
#define PG8_SB(b, h) ((4 + (b) * 2 + (h)) * HTB)
#define PG8_STAGE(bufoff, gbase, voff) do { _Pragma("unroll") for (int _i = 0; _i < 2; ++_i) \
        __builtin_amdgcn_global_load_lds((const unsigned*)((const char*)(gbase) + (voff)[_i]), (PG8_LAS unsigned*)(lds + (bufoff) + ldsw + _i * 8192), 16, 0, 0); } while (0)
#define PG8_LDA(dst, b, h) do { _Pragma("unroll") for (int m = 0; m < 4; ++m) _Pragma("unroll") for (int k = 0; k < 2; ++k) dst[m][k] = *(const PG8_LAS bf16x8*)(lds + PG8_SA(b, h) + aoff + m * 2048 + k * 1024); } while (0)
#define PG8_LDB(dst, b, h) do { _Pragma("unroll") for (int n = 0; n < 2; ++n) _Pragma("unroll") for (int k = 0; k < 2; ++k) dst[n][k] = *(const PG8_LAS bf16x8*)(lds + PG8_SB(b, h) + boff + n * 2048 + k * 1024); } while (0)
#define PG8_MMA(ai, bj, At, Bt) do { __builtin_amdgcn_s_setprio(1); _Pragma("unroll") for (int m = 0; m < 4; ++m) _Pragma("unroll") for (int n = 0; n < 2; ++n) _Pragma("unroll") for (int k = 0; k < 2; ++k) \
        acc[ai][bj][m][n] = __builtin_amdgcn_mfma_f32_16x16x32_bf16(Bt[n][k], At[m][k], acc[ai][bj][m][n], 0, 0, 0); __builtin_amdgcn_s_setprio(0); } while (0)
#define PG8_WAIT_V(n) asm volatile("s_waitcnt vmcnt(" #n ")" ::: "memory")
#define PG8_WAIT_L(n) asm volatile("s_waitcnt lgkmcnt(" #n ")" ::: "memory")
#define PG8_BAR __builtin_amdgcn_s_barrier()
#define PG8_SCHED __builtin_amdgcn_sched_barrier(0)
    Unit cur, nxt; int ui = 0;
    if (!S.next(0, cur)) return;
    f32x4 acc[2][2][4][2];
#pragma unroll
    for (int a = 0; a < 2; ++a)
#pragma unroll
        for (int b = 0; b < 2; ++b)
#pragma unroll
            for (int m = 0; m < 4; ++m)
#pragma unroll
                for (int n = 0; n < 2; ++n) acc[a][b][m][n] = (f32x4){0.f, 0.f, 0.f, 0.f};
    bf16x8 At[4][2], B0[2][2], B1[2][2];
    const char* cA = S.baseA(g, cur) + (size_t)cur.pm * tstepA; const char* cB = S.baseB(g, cur) + (size_t)cur.pn * tstepB;
    S.a_ready(cur);
    if constexpr (SP2) {
        PG8_STAGE(PG8_SB(0, 0), cB, voffB); PG8_STAGE(PG8_SB(0, 1), cB + hstepB, voffB); PG8_STAGE(PG8_SA(0, 0), cA, voffA); PG8_STAGE(PG8_SA(0, 1), cA + hstepA, voffA);
        if (wr == 1) PG8_BAR;
        PG8_WAIT_V(2); PG8_BAR;
        PG8_STAGE(PG8_SB(1, 0), cB + kstep, voffB); PG8_STAGE(PG8_SA(1, 0), cA + kstep, voffA); PG8_STAGE(PG8_SB(1, 1), cB + hstepB + kstep, voffB);
        PG8_WAIT_V(6); PG8_BAR;
    } else {
        PG8_STAGE(PG8_SB(0, 0), cB, voffB); PG8_STAGE(PG8_SA(0, 0), cA, voffA); PG8_STAGE(PG8_SB(0, 1), cB + hstepB, voffB); PG8_STAGE(PG8_SA(0, 1), cA + hstepA, voffA);
        if (wr == 1) PG8_BAR;
        PG8_WAIT_V(4); PG8_BAR;
        PG8_STAGE(PG8_SB(1, 0), cB + kstep, voffB); PG8_STAGE(PG8_SA(1, 0), cA + kstep, voffA); PG8_STAGE(PG8_SB(1, 1), cB + hstepB + kstep, voffB);
        PG8_WAIT_V(6); PG8_BAR;
    }
    for (;;) {
        const bool has_next = S.next(ui + 1, nxt);
        const char* nA = has_next ? S.baseA(g, nxt) + (size_t)nxt.pm * tstepA : cA; const char* nB = has_next ? S.baseB(g, nxt) + (size_t)nxt.pn * tstepB : cB;
        for (int t = 0; t < nt; t += 2) {
            const bool last = (t == nt - 2);
            const char* a1 = cA + (size_t)(t + 1) * kstep;
            const char* a2 = last ? nA : cA + (size_t)(t + 2) * kstep; const char* b2 = last ? nB : cB + (size_t)(t + 2) * kstep;
            const char* a3 = a2 + kstep; const char* b3 = b2 + kstep;
            if (last && has_next) S.a_ready(nxt);
            if constexpr (SP2) {
            PG8_LDB(B0, 0, 0); PG8_LDB(B1, 0, 1); PG8_SCHED; PG8_LDA(At, 0, 0); PG8_STAGE(PG8_SA(1, 1), a1 + hstepA, voffA);
            PG8_WAIT_V(8); PG8_WAIT_L(0); PG8_BAR; PG8_MMA(0, 0, At, B0); PG8_MMA(0, 1, At, B1); PG8_BAR; PG8_SCHED;
            PG8_LDA(At, 0, 1); PG8_STAGE(PG8_SB(0, 0), b2, voffB); PG8_STAGE(PG8_SB(0, 1), b2 + hstepB, voffB); PG8_STAGE(PG8_SA(0, 0), a2, voffA);
            PG8_WAIT_V(8); PG8_WAIT_L(0); PG8_BAR; PG8_MMA(1, 0, At, B0); PG8_MMA(1, 1, At, B1); PG8_BAR; PG8_SCHED;
            PG8_LDB(B0, 1, 0); PG8_LDB(B1, 1, 1); PG8_SCHED; PG8_LDA(At, 1, 0); PG8_STAGE(PG8_SA(0, 1), a2 + hstepA, voffA);
            PG8_WAIT_V(8); PG8_WAIT_L(0); PG8_BAR; PG8_MMA(0, 0, At, B0); PG8_MMA(0, 1, At, B1); PG8_BAR; PG8_SCHED;
            PG8_LDA(At, 1, 1); PG8_STAGE(PG8_SB(1, 0), b3, voffB); PG8_STAGE(PG8_SB(1, 1), b3 + hstepB, voffB); PG8_STAGE(PG8_SA(1, 0), a3, voffA);
            PG8_WAIT_V(8); PG8_WAIT_L(0); PG8_BAR; PG8_MMA(1, 0, At, B0); PG8_MMA(1, 1, At, B1); PG8_BAR; PG8_SCHED;
            } else {
            PG8_LDB(B0, 0, 0); PG8_SCHED; PG8_LDA(At, 0, 0); PG8_STAGE(PG8_SA(1, 1), a1 + hstepA, voffA);
            PG8_WAIT_L(8); PG8_BAR; PG8_WAIT_L(0); PG8_MMA(0, 0, At, B0); PG8_BAR; PG8_SCHED;
            PG8_LDB(B1, 0, 1); PG8_STAGE(PG8_SB(0, 0), b2, voffB);
            PG8_BAR; PG8_WAIT_L(0); PG8_MMA(0, 1, At, B1); PG8_BAR;
            PG8_LDA(At, 0, 1); PG8_STAGE(PG8_SA(0, 0), a2, voffA);
            PG8_BAR; PG8_WAIT_L(0); PG8_MMA(1, 0, At, B0); PG8_BAR; PG8_SCHED;
            PG8_STAGE(PG8_SB(0, 1), b2 + hstepB, voffB);
            PG8_WAIT_V(6); PG8_BAR; PG8_MMA(1, 1, At, B1); PG8_BAR;
            PG8_LDB(B0, 1, 0); PG8_SCHED; PG8_LDA(At, 1, 0); PG8_STAGE(PG8_SA(0, 1), a2 + hstepA, voffA);
            PG8_WAIT_L(8); PG8_BAR; PG8_WAIT_L(0); PG8_MMA(0, 0, At, B0); PG8_BAR; PG8_SCHED;
            PG8_LDB(B1, 1, 1); PG8_STAGE(PG8_SB(1, 0), b3, voffB);
            PG8_BAR; PG8_WAIT_L(0); PG8_MMA(0, 1, At, B1); PG8_BAR;
            PG8_LDA(At, 1, 1); PG8_STAGE(PG8_SA(1, 0), a3, voffA);
            PG8_BAR; PG8_WAIT_L(0); PG8_MMA(1, 0, At, B0); PG8_BAR; PG8_SCHED;
            PG8_STAGE(PG8_SB(1, 1), b3 + hstepB, voffB);
            PG8_WAIT_V(6); PG8_BAR; PG8_MMA(1, 1, At, B1); PG8_BAR;
            }
        }
        if constexpr (ALIGN_EPI) { if (wr == 0) PG8_BAR; }
        if constexpr (!Epi::AFTER_DRAIN) { E(acc, cur, wr, wc, fr, fq); S.done(cur); }
        if (!has_next) break;
        if constexpr (!Sched::CHAIN) {
#pragma unroll
        for (int a = 0; a < 2; ++a)
#pragma unroll
            for (int b = 0; b < 2; ++b)
#pragma unroll
                for (int m = 0; m < 4; ++m)
#pragma unroll
                    for (int n = 0; n < 2; ++n) acc[a][b][m][n] = (f32x4){0.f, 0.f, 0.f, 0.f};
        }
        cur = nxt; cA = nA; cB = nB; ++ui;
        if constexpr (ALIGN_EPI) { if (wr == 1) PG8_BAR; }
    }
    PG8_WAIT_V(0);
    if constexpr (!ALIGN_EPI) { if (wr == 0) PG8_BAR; }
    PG8_BAR;
    if constexpr (Epi::AFTER_DRAIN) { E.fused(acc, cur, wr, wc, fr, fq, lds, wid, lane); S.done(cur); }
#undef PG8_SA
#undef PG8_SB
#undef PG8_STAGE
#undef PG8_LDA
#undef PG8_LDB
#undef PG8_MMA
#undef PG8_WAIT_V
#undef PG8_WAIT_L
#undef PG8_BAR
#undef PG8_SCHED
}
}

using pg8::Unit; using pg8::cvt_pk_bf16;
#define EPI_ARGS const f32x4 (&acc)[2][2][4][2], const Unit& u, int wr, int wc, int fr, int fq
__device__ __forceinline__ float row_rstd(const float* ssq, int row) {
    const f32x4* p = (const f32x4*)(ssq + (size_t)row * 16);
    const f32x4 a = p[0], b = p[1], c = p[2], d = p[3];
    const float s = ((a[0] + a[1]) + (a[2] + a[3])) + ((b[0] + b[1]) + (b[2] + b[3])) + ((c[0] + c[1]) + (c[2] + c[3])) + ((d[0] + d[1]) + (d[2] + d[3]));
    return rsqf_(s * (1.0f / D) + NORM_EPS);
}
struct EpiSwiglu {
    static constexpr bool PERM = true, AFTER_DRAIN = false;
    bf16* H; const float* ssq;
    __device__ __forceinline__ void operator()(EPI_ARGS) const {
#pragma unroll
        for (int ai = 0; ai < 2; ++ai)
#pragma unroll
            for (int m = 0; m < 4; ++m) {
                const int row = u.pm * 256 + ai * 128 + wr * 64 + m * 16 + fr; const float rs = row_rstd(ssq, row); float v[8];
#pragma unroll
                for (int n = 0; n < 2; ++n) { const f32x4 g = acc[ai][0][m][n] * rs, up = acc[ai][1][m][n] * rs;
#pragma unroll
                    for (int j = 0; j < 4; ++j) v[4 * n + j] = siluf_(g[j]) * up[j]; }
                u32x4 w; w.x = cvt_pk_bf16(v[0], v[1]); w.y = cvt_pk_bf16(v[2], v[3]); w.z = cvt_pk_bf16(v[4], v[5]); w.w = cvt_pk_bf16(v[6], v[7]);
                *(u32x4*)(H + (size_t)row * FF + u.pn * 128 + wc * 32 + fq * 8) = w;
            }
    }
};
struct EpiResid {
    static constexpr bool PERM = true, AFTER_DRAIN = false;
    bf16* XB; float* ssq; float alpha;
    __device__ __forceinline__ void operator()(EPI_ARGS) const {
#pragma unroll
        for (int ai = 0; ai < 2; ++ai)
#pragma unroll
            for (int m = 0; m < 4; ++m) {
                const int row = u.pm * 256 + ai * 128 + wr * 64 + m * 16 + fr; float s = 0.f;
#pragma unroll
                for (int bj = 0; bj < 2; ++bj) {
                    const size_t off = (size_t)row * D + u.pn * 256 + bj * 128 + wc * 32 + fq * 8;
                    const u32x4 o = *(const u32x4*)(XB + off);
                    f32x4 v0 = acc[ai][bj][m][0] * alpha, v1 = acc[ai][bj][m][1] * alpha;
                    v0[0] += bflo(o.x); v0[1] += bfhi(o.x); v0[2] += bflo(o.y); v0[3] += bfhi(o.y); v1[0] += bflo(o.z); v1[1] += bfhi(o.z); v1[2] += bflo(o.w); v1[3] += bfhi(o.w);
                    u32x4 w; w.x = cvt_pk_bf16(v0[0], v0[1]); w.y = cvt_pk_bf16(v0[2], v0[3]); w.z = cvt_pk_bf16(v1[0], v1[1]); w.w = cvt_pk_bf16(v1[2], v1[3]);
                    *(u32x4*)(XB + off) = w;
                    s += ((v0[0] * v0[0] + v0[1] * v0[1]) + (v0[2] * v0[2] + v0[3] * v0[3])) + ((v1[0] * v1[0] + v1[1] * v1[1]) + (v1[2] * v1[2] + v1[3] * v1[3]));
                }
                s += shx(s, 16, fq * 16 + fr); s += shx(s, 32, fq * 16 + fr);
                if (fq == 0) ssq[(size_t)row * 16 + u.pn * 4 + wc] = s;
            }
    }
};
struct EpiBf16 {
    static constexpr bool PERM = true, AFTER_DRAIN = false;
    bf16* O; int ldc; const float* ssq; float scale; int ncols;
    __device__ __forceinline__ void operator()(EPI_ARGS) const {
#pragma unroll
        for (int ai = 0; ai < 2; ++ai)
#pragma unroll
            for (int m = 0; m < 4; ++m) {
                const int row = u.pm * 256 + ai * 128 + wr * 64 + m * 16 + fr; const float rs = (ssq ? row_rstd(ssq, row) : 1.0f) * scale;
#pragma unroll
                for (int bj = 0; bj < 2; ++bj) {
                    const int col = u.pn * 256 + bj * 128 + wc * 32 + fq * 8;
                    if (col < ncols) {
                        const f32x4 v0 = acc[ai][bj][m][0] * rs, v1 = acc[ai][bj][m][1] * rs; u32x4 w;
                        w.x = cvt_pk_bf16(v0[0], v0[1]); w.y = cvt_pk_bf16(v0[2], v0[3]); w.z = cvt_pk_bf16(v1[0], v1[1]); w.w = cvt_pk_bf16(v1[2], v1[3]);
                        *(u32x4*)(O + (size_t)row * ldc + col) = w;
                    }
                }
            }
    }
};
struct EpiZ {
    static constexpr bool PERM = true, AFTER_DRAIN = false;
    bf16* O; const float* ssq; bf16* HALO;
    __device__ __forceinline__ void operator()(EPI_ARGS) const {
#pragma unroll
        for (int ai = 0; ai < 2; ++ai)
#pragma unroll
            for (int m = 0; m < 4; ++m) {
                const int row = u.pm * 256 + ai * 128 + wr * 64 + m * 16 + fr; const float rs = row_rstd(ssq, row);
#pragma unroll
                for (int bj = 0; bj < 2; ++bj) {
                    const int col = u.pn * 256 + bj * 128 + wc * 32 + fq * 8;
                    if (col < NZ) {
                        const f32x4 v0 = acc[ai][bj][m][0] * rs, v1 = acc[ai][bj][m][1] * rs; u32x4 w;
                        w.x = cvt_pk_bf16(v0[0], v0[1]); w.y = cvt_pk_bf16(v0[2], v0[3]); w.z = cvt_pk_bf16(v1[0], v1[1]); w.w = cvt_pk_bf16(v1[2], v1[3]);
                        *(u32x4*)(O + (size_t)row * ZP + col) = w;
                        if ((row & 63) == 63 && col >= ZD_R && col < ZD_V) *(u32x4*)(HALO + (size_t)(row >> 6) * 1024 + (col - ZD_R)) = w;
                    }
                }
            }
    }
};
struct EpiKV {
    static constexpr bool PERM = true, AFTER_DRAIN = false;
    bf16* Kd; bf16* VT; const float* rstd;
    __device__ __forceinline__ void operator()(EPI_ARGS) const {
#pragma unroll
        for (int ai = 0; ai < 2; ++ai)
#pragma unroll
            for (int m = 0; m < 4; ++m) {
                const int row = u.pm * 256 + ai * 128 + wr * 64 + m * 16 + fr; const float rs = rstd[row];
#pragma unroll
                for (int bj = 0; bj < 2; ++bj) {
                    const int col = u.pn * 256 + bj * 128 + wc * 32 + fq * 8;
                    const f32x4 v0 = acc[ai][bj][m][0] * rs, v1 = acc[ai][bj][m][1] * rs;
                    if (col < D) {
                        u32x4 w; w.x = cvt_pk_bf16(v0[0], v0[1]); w.y = cvt_pk_bf16(v0[2], v0[3]); w.z = cvt_pk_bf16(v1[0], v1[1]); w.w = cvt_pk_bf16(v1[2], v1[3]);
                        *(u32x4*)(Kd + (size_t)row * D + col) = w;
                    } else {
#pragma unroll
                        for (int j = 0; j < 4; ++j) { VT[(size_t)(col - D + j) * MMEM + row] = (bf16)f2bf(v0[j]); VT[(size_t)(col - D + 4 + j) * MMEM + row] = (bf16)f2bf(v1[j]); }
                    }
                }
            }
    }
};
__device__ __forceinline__ size_t stash_idx(int T, int ai, int m, int bj, int wr, int wc, int fr, int fq) { return (size_t)(T * 16 + (ai * 4 + m) * 2 + bj) * 512 + (size_t)((wr * 4 + wc) * 64 + fq * 16 + fr); }
__device__ __forceinline__ u32x2 pack_u8(const float* v) {
    unsigned b[8];
#pragma unroll
    for (int j = 0; j < 8; ++j) b[j] = (unsigned)fmaxf(v[j] * 255.0f + 0.5f, 1.0f);
    u32x2 w; w.x = b[0] | (b[1] << 8) | (b[2] << 16) | (b[3] << 24); w.y = b[4] | (b[5] << 8) | (b[6] << 16) | (b[7] << 24); return w;
}
__device__ __forceinline__ void unpack_u8(u32x2 w, float* v) {
#pragma unroll
    for (int j = 0; j < 4; ++j) { v[j] = (float)((w.x >> (8 * j)) & 255u) * (1.0f / 255.0f); v[4 + j] = (float)((w.y >> (8 * j)) & 255u) * (1.0f / 255.0f); }
}
struct OwnTile4 {
    static constexpr bool CHAIN = false;
    int pm, pn0;
    __device__ __forceinline__ bool next(int i, Unit& u) const { if (i >= 4) return false; u.pm = pm; u.pn = 4 * i + pn0; u.job = 0; return true; }
    __device__ __forceinline__ void a_ready(const Unit&) const {}
    __device__ __forceinline__ void done(const Unit&) const {}
    __device__ __forceinline__ const char* baseA(const pg8::Gemm& g, const Unit&) const { return (const char*)g.A; }
    __device__ __forceinline__ const char* baseB(const pg8::Gemm& g, const Unit&) const { return (const char*)g.Bt; }
};
struct EpiGate8 {
    static constexpr bool PERM = true, AFTER_DRAIN = false;
    unsigned char* G8; const float* ssq; const float* bias;
    __device__ __forceinline__ void operator()(EPI_ARGS) const {
        const int br = u.pn >> 2, T = u.pm * 4 + (u.pn & 3);
#pragma unroll
        for (int ai = 0; ai < 2; ++ai)
#pragma unroll
            for (int m = 0; m < 4; ++m) {
                const int row = u.pm * 256 + ai * 128 + wr * 64 + m * 16 + fr; const float rs = row_rstd(ssq, row);
#pragma unroll
                for (int bj = 0; bj < 2; ++bj) {
                    const int col = u.pn * 256 + bj * 128 + wc * 32 + fq * 8; float v[8];
#pragma unroll
                    for (int n = 0; n < 2; ++n) { const f32x4 b = *(const f32x4*)(bias + col + 4 * n);
#pragma unroll
                        for (int j = 0; j < 4; ++j) v[4 * n + j] = sigmoidf_(acc[ai][bj][m][n][j] * rs + b[j]); }
                    *(u32x2*)(G8 + ((size_t)br * 256 * 16 * 512 + stash_idx(T, ai, m, bj, wr, wc, fr, fq)) * 8) = pack_u8(v);
                }
            }
    }
};
struct EpiGlu8 {
    static constexpr bool PERM = true, AFTER_DRAIN = false;
    unsigned char* G8;
    __device__ __forceinline__ void operator()(EPI_ARGS) const {
        const int T = u.pm * 4 + u.pn;
#pragma unroll
        for (int ai = 0; ai < 2; ++ai)
#pragma unroll
            for (int m = 0; m < 4; ++m)
#pragma unroll
                for (int bj = 0; bj < 2; ++bj) {
                    u32x2* p = (u32x2*)(G8 + ((size_t)1 * 256 * 16 * 512 + stash_idx(T, ai, m, bj, wr, wc, fr, fq)) * 8); float g[8]; unpack_u8(*p, g);
#pragma unroll
                    for (int n = 0; n < 2; ++n)
#pragma unroll
                        for (int j = 0; j < 4; ++j) g[4 * n + j] *= sigmoidf_(acc[ai][bj][m][n][j]);
                    *p = pack_u8(g);
                }
    }
};
struct ChainTile4 {
    static constexpr bool CHAIN = true;
    int pm, pn; const bf16* Z; const bf16* WP;
    __device__ __forceinline__ bool next(int i, Unit& u) const { if (i >= 4) return false; u.pm = pm; u.pn = pn; u.job = i; return true; }
    __device__ __forceinline__ void a_ready(const Unit&) const {}
    __device__ __forceinline__ void done(const Unit&) const {}
    __device__ __forceinline__ const char* baseA(const pg8::Gemm&, const Unit& u) const { const int off = (u.job == 0) ? ZA_O : (u.job == 1) ? ZB_U : (u.job == 2) ? ZC_G : ZD_R; return (const char*)(Z + off); }
    __device__ __forceinline__ const char* baseB(const pg8::Gemm&, const Unit& u) const { return (const char*)(WP + (size_t)(u.job + (u.job >= 2 ? 1 : 0)) * D * WB); }
};
struct EpiChain {
    static constexpr bool PERM = true, AFTER_DRAIN = false;
    const unsigned char* G8; bf16* MG; int ldg;
    __device__ __forceinline__ void operator()(f32x4 (&acc)[2][2][4][2], const Unit& u, int wr, int wc, int fr_, int fq_) const {
        int fr = fr_, fq = fq_; asm volatile("" : "+v"(fr), "+v"(fq));
        const int T = u.pm * 4 + u.pn, br = u.job; const bool lastb = (br == 3);
        const unsigned char* Gn = G8 + (size_t)br * 256 * 16 * 512 * 8; const unsigned char* Gd = G8 + (size_t)(lastb ? br : br + 1) * 256 * 16 * 512 * 8;
#pragma unroll
        for (int ai = 0; ai < 2; ++ai)
#pragma unroll
            for (int m = 0; m < 4; ++m) {
                const int row = u.pm * 256 + ai * 128 + wr * 64 + m * 16 + fr;
#pragma unroll
                for (int bj = 0; bj < 2; ++bj) {
                    const size_t si = stash_idx(T, ai, m, bj, wr, wc, fr, fq);
                    const u32x2 qn = *(const u32x2*)(Gn + si * 8), qd = *(const u32x2*)(Gd + si * 8);
#pragma unroll
                    for (int n = 0; n < 2; ++n)
#pragma unroll
                        for (int j = 0; j < 4; ++j) { const unsigned wn = n ? qn.y : qn.x, wd = n ? qd.y : qd.x;
                            const float gn = (float)((wn >> (8 * j)) & 255u), gd = lastb ? 255.0f : (float)((wd >> (8 * j)) & 255u);
                            acc[ai][bj][m][n][j] *= gn * rcpf_(gd); }
                    if (lastb) { const f32x4 v0 = acc[ai][bj][m][0], v1 = acc[ai][bj][m][1];
                        u32x4 w; w.x = cvt_pk_bf16(v0[0], v0[1]); w.y = cvt_pk_bf16(v0[2], v0[3]); w.z = cvt_pk_bf16(v1[0], v1[1]); w.w = cvt_pk_bf16(v1[2], v1[3]);
                        *(u32x4*)(MG + (size_t)row * ldg + u.pn * 256 + bj * 128 + wc * 32 + fq * 8) = w; }
                }
            }
    }
};
struct EpiSoftmaxP {
    static constexpr bool PERM = true, AFTER_DRAIN = true;
    bf16* P;
    __device__ __forceinline__ void fused(f32x4 (&acc)[2][2][4][2], const Unit& u, int wr, int wc, int fr, int fq, PG8_LAS unsigned char* lds, int wid, int lane) const {
        PG8_LAS float* RM = (PG8_LAS float*)lds;
        PG8_LAS float* RS = (PG8_LAS float*)(lds + 4096);
#pragma unroll
        for (int ai = 0; ai < 2; ++ai)
#pragma unroll
            for (int m = 0; m < 4; ++m) {
                float mx = -3.0e38f;
#pragma unroll
                for (int bj = 0; bj < 2; ++bj)
#pragma unroll
                    for (int n = 0; n < 2; ++n) { const f32x4 x = acc[ai][bj][m][n]; mx = fmaxf(mx, fmaxf(fmaxf(x[0], x[1]), fmaxf(x[2], x[3]))); }
                mx = fmaxf(mx, shx(mx, 16, fq * 16 + fr)); mx = fmaxf(mx, shx(mx, 32, fq * 16 + fr));
                if (fq == 0) RM[(ai * 128 + wr * 64 + m * 16 + fr) * 4 + wc] = mx;
            }
        asm volatile("s_waitcnt lgkmcnt(0)" ::: "memory"); __builtin_amdgcn_s_barrier(); asm volatile("" ::: "memory");
#pragma unroll
        for (int ai = 0; ai < 2; ++ai)
#pragma unroll
            for (int m = 0; m < 4; ++m) {
                const int rl = ai * 128 + wr * 64 + m * 16 + fr;
                const float mx = fmaxf(fmaxf(RM[rl * 4 + 0], RM[rl * 4 + 1]), fmaxf(RM[rl * 4 + 2], RM[rl * 4 + 3])); float s = 0.f;
#pragma unroll
                for (int bj = 0; bj < 2; ++bj)
#pragma unroll
                    for (int n = 0; n < 2; ++n)
#pragma unroll
                        for (int j = 0; j < 4; ++j) { const float p = __builtin_amdgcn_exp2f(acc[ai][bj][m][n][j] - mx); acc[ai][bj][m][n][j] = p; s += p; }
                s += shx(s, 16, fq * 16 + fr); s += shx(s, 32, fq * 16 + fr);
                if (fq == 0) RS[rl * 4 + wc] = s;
            }
        asm volatile("s_waitcnt lgkmcnt(0)" ::: "memory"); __builtin_amdgcn_s_barrier(); asm volatile("" ::: "memory");
#pragma unroll
        for (int ai = 0; ai < 2; ++ai)
#pragma unroll
            for (int m = 0; m < 4; ++m) {
                const int rl = ai * 128 + wr * 64 + m * 16 + fr;
                const float inv = rcpf_((RS[rl * 4 + 0] + RS[rl * 4 + 1]) + (RS[rl * 4 + 2] + RS[rl * 4 + 3]));
#pragma unroll
                for (int bj = 0; bj < 2; ++bj) {
                    const f32x4 v0 = acc[ai][bj][m][0] * inv, v1 = acc[ai][bj][m][1] * inv; u32x4 w;
                    w.x = cvt_pk_bf16(v0[0], v0[1]); w.y = cvt_pk_bf16(v0[2], v0[3]); w.z = cvt_pk_bf16(v1[0], v1[1]); w.w = cvt_pk_bf16(v1[2], v1[3]);
                    *(u32x4*)(P + (size_t)rl * 256 + bj * 128 + wc * 32 + fq * 8) = w;
                }
            }
        asm volatile("s_waitcnt lgkmcnt(0)" ::: "memory"); __builtin_amdgcn_s_barrier(); asm volatile("" ::: "memory");
    }
};
struct Args { const float* in[N_INPUTS]; float* out; unsigned char* ws; };
typedef const float* cfptr;
typedef __attribute__((address_space(4))) const cfptr* kin_t;
struct Ctx {
    LAS unsigned char* lds; int tid, lane, wave, G, bid;
    kin_t in; float* X; unsigned char* ws;
    __device__ __forceinline__ const float* inp(int i, int l, size_t per_layer) const { return in[i] + (size_t)l * per_layer; }
};
__device__ __forceinline__ Ctx make_ctx() {
    extern __shared__ __attribute__((aligned(16))) unsigned char lds_raw[];
    Ctx C; int t = threadIdx.x; asm volatile("" : "+v"(t));
    kin_t k = (kin_t)__builtin_amdgcn_kernarg_segment_ptr(); asm volatile("" : "+s"(k));
    C.lds = (LAS unsigned char*)lds_raw; C.tid = t; C.lane = t & 63; C.wave = __builtin_amdgcn_readfirstlane(t >> 6);
    C.G = gridDim.x; C.bid = blockIdx.x; C.in = k;
    C.X = (float*)k[N_INPUTS]; C.ws = (unsigned char*)k[N_INPUTS + 1];
    return C;
}
#ifdef PROBE_LO
#define PROBE_STAMP(Cb) do { if (blockIdx.x == 0 && (Cb).tid == 0) { volatile LAS unsigned* m_ = (volatile LAS unsigned*)((Cb).lds + MISC_OFF); const unsigned i_ = m_[16]; m_[16] = i_ + 1u; \
    __hip_atomic_store((unsigned long long*)((Cb).ws + WS_CTL + 32768) + i_, (unsigned long long)__builtin_amdgcn_s_memrealtime(), __ATOMIC_RELAXED, __HIP_MEMORY_SCOPE_AGENT); } } while (0)
#define TSTAMP(Cb, tag) do { if (blockIdx.x == 0 && (Cb).tid == 0) { unsigned long long* p_ = (unsigned long long*)((Cb).ws + WS_CTL + 32768) + (tag); \
    if (__hip_atomic_load(p_, __ATOMIC_RELAXED, __HIP_MEMORY_SCOPE_AGENT) == 0ull) __hip_atomic_store(p_, (unsigned long long)__builtin_amdgcn_s_memrealtime(), __ATOMIC_RELAXED, __HIP_MEMORY_SCOPE_AGENT); } } while (0)
#else
#define PROBE_STAMP(Cb) do { } while (0)
#define TSTAMP(Cb, tag) do { } while (0)
#endif
constexpr size_t RWW_OFF = 93 * MiB;
struct ConvDesc { const float* W; const float* gain; bf16* dst; long alt; int ld, ncols, K, NR, kind, item0; };
constexpr int CD_OFF = 124 * 1024, CD_MAX = 24;
enum ConvJob { CJ_GU1 = 1, CJ_D1 = 2, CJ_WIN = 4, CJ_GATES = 8, CJ_PROJ = 16, CJ_XW = 32, CJ_GU2 = 64, CJ_D2 = 128, CJ_XKV0 = 256, CJ_XKV1 = 512, CJ_MLW = 1024, CJ_RWW = 2048, CJ_GU2S = 4096 };
constexpr size_t WS_GU2S = WS_S + 96 * MiB;
static_assert(WS_GU2S + 11 * MiB <= WS_END, "GU2 staging");
__device__ __forceinline__ void cd_put(const Ctx& C, int& n, int& items, const float* W, const float* gain, bf16* dst, long alt, int ld, int ncols, int K, int NR, int kind) {
    if (C.tid == 0) { LAS ConvDesc* d = (LAS ConvDesc*)(C.lds + CD_OFF) + n; d->W = W; d->gain = gain; d->dst = dst; d->alt = alt; d->ld = ld; d->ncols = ncols; d->K = K; d->NR = NR; d->kind = kind; d->item0 = items; }
    items += (K / 64) * (NR / 32); ++n;
}
__device__ __forceinline__ void conv_item(const LAS ConvDesc* d, int it, LAS float* scr, int lane) {
    const int K = d->K, NR = d->NR, kind = d->kind, ld = d->ld, ncols = d->ncols; const float* W = d->W; const float* gain = d->gain; bf16* dst = d->dst; const long alt = d->alt;
    const int nblk = NR / 32, kb = it / nblk, nb = it % nblk, k0 = 64 * kb, n0 = 32 * nb, n = n0 + (lane & 31);
    const float* p = nullptr;
    if (kind == 0) { if (n < ncols) p = W + n; }
    else if (kind == 1) { const int t = n >> 8, cl = n & 255, h = t * 128 + (cl & 127); p = W + (h + ((cl & 128) ? alt : 0l)); }
    else p = W + (n < D ? (long)n : alt + (long)(n - D));
    float v[32];
    if (p) { const float* q = p + (size_t)(k0 + (lane >> 5)) * ld;
#pragma unroll
        for (int i = 0; i < 32; ++i) v[i] = q[(size_t)(2 * i) * ld];
        if (gain) {
#pragma unroll
            for (int i = 0; i < 32; ++i) v[i] *= gain[k0 + 2 * i + (lane >> 5)]; }
    } else {
#pragma unroll
        for (int i = 0; i < 32; ++i) v[i] = 0.f; }
#pragma unroll
    for (int i = 0; i < 32; ++i) scr[(2 * i + (lane >> 5)) * 33 + (lane & 31)] = v[i];
    LDS_WAIT(); asm volatile("" ::: "memory");
    const int c = lane & 7;
#pragma unroll
    for (int j = 0; j < 4; ++j) { const int nn = (lane >> 3) + 8 * j; const LAS float* s = scr + (8 * c) * 33 + nn;
        u32x4 o; o.x = pk2(s[0 * 33], s[1 * 33]); o.y = pk2(s[2 * 33], s[3 * 33]); o.z = pk2(s[4 * 33], s[5 * 33]); o.w = pk2(s[6 * 33], s[7 * 33]);
        *(u32x4*)(dst + (size_t)(n0 + nn) * K + k0 + 8 * c) = o; }
    LDS_WAIT(); asm volatile("" ::: "memory");
}
struct ConvPlan { int n, items; };
__device__ __forceinline__ ConvPlan conv_setup(const Ctx& C, int jobs, int l) {
    unsigned char* ws = C.ws; int n = 0, items = 0;
    __syncthreads();
    if (jobs & CJ_GU1) cd_put(C, n, items, C.inp(I_FFN1_WG, l, (size_t)D * FF), C.inp(I_FFN1_NORM, l, D), (bf16*)(ws + WS_SLOTA), (long)(C.inp(I_FFN1_WU, l, (size_t)D * FF) - C.inp(I_FFN1_WG, l, (size_t)D * FF)), FF, 2 * FF, D, 2 * FF, 1);
    if (jobs & CJ_GU2) cd_put(C, n, items, C.inp(I_FFN2_WG, l, (size_t)D * FF), C.inp(I_FFN2_NORM, l, D), (bf16*)(ws + WS_SLOTA), (long)(C.inp(I_FFN2_WU, l, (size_t)D * FF) - C.inp(I_FFN2_WG, l, (size_t)D * FF)), FF, 2 * FF, D, 2 * FF, 1);
    if (jobs & CJ_GU2S) cd_put(C, n, items, C.inp(I_FFN2_WG, l, (size_t)D * FF), C.inp(I_FFN2_NORM, l, D), (bf16*)(ws + WS_GU2S), (long)(C.inp(I_FFN2_WU, l, (size_t)D * FF) - C.inp(I_FFN2_WG, l, (size_t)D * FF)), FF, 2 * FF, D, 2 * FF, 1);
    if (jobs & CJ_D1) cd_put(C, n, items, C.inp(I_FFN1_WD, l, (size_t)D * FF), nullptr, (bf16*)(ws + WS_SLOTC), 0, D, D, FF, D, 0);
    if (jobs & CJ_D2) cd_put(C, n, items, C.inp(I_FFN2_WD, l, (size_t)D * FF), nullptr, (bf16*)(ws + WS_SLOTC), 0, D, D, FF, D, 0);
    if (jobs & CJ_WIN) cd_put(C, n, items, C.inp(I_W_IN, l, (size_t)D * NIN), C.inp(I_MIX_NORM, l, D), (bf16*)(ws + WS_SLOTB), 0, NIN, NZ, D, NINP, 0);
    if (jobs & CJ_GATES) cd_put(C, n, items, C.inp(I_W_IN, l, (size_t)D * NIN) + ZG, C.inp(I_MIX_NORM, l, D), (bf16*)(ws + WS_SLOTA), 0, NIN, 4 * D, D, 4 * D, 0);
    if (jobs & CJ_PROJ) {
        cd_put(C, n, items, C.inp(I_ML_PROJ, l, (size_t)WB * D), nullptr, (bf16*)(ws + WS_SLOTC), 0, D, D, WB, D, 0);
        cd_put(C, n, items, C.inp(I_S5_W1, l, (size_t)WB * D), nullptr, (bf16*)(ws + WS_SLOTC + 1 * MiB), 0, D, D, WB, D, 0);
        cd_put(C, n, items, C.inp(I_S5_W2, l, (size_t)WB * D), nullptr, (bf16*)(ws + WS_SLOTC + 2 * MiB), 0, D, D, WB, D, 0);
        cd_put(C, n, items, C.inp(I_GLA_PROJ, l, (size_t)WB * D), nullptr, (bf16*)(ws + WS_SLOTC + 3 * MiB), 0, D, D, WB, D, 0);
        cd_put(C, n, items, C.inp(I_RW_PROJ, l, (size_t)WB * D), nullptr, (bf16*)(ws + WS_SLOTC + 4 * MiB), 0, D, D, WB, D, 0);
    }
    if (jobs & CJ_XW) {
        cd_put(C, n, items, C.inp(I_W_OUT, l, (size_t)D * D), nullptr, (bf16*)(ws + WS_SLOTB), 0, D, D, D, D, 0);
        cd_put(C, n, items, C.inp(I_XA_WQ, l, (size_t)D * D), C.inp(I_XA_NORM, l, D), (bf16*)(ws + WS_SLOTB + 2 * MiB), 0, D, D, D, D, 0);
        cd_put(C, n, items, C.inp(I_XA_WO, l, (size_t)D * D), nullptr, (bf16*)(ws + WS_SLOTB + 4 * MiB), 0, D, D, D, D, 0);
    }
    if (jobs & CJ_XKV0) cd_put(C, n, items, C.inp(I_XA_WK, 0, (size_t)D * D), C.inp(I_MEM_NORM, 0, D), (bf16*)(ws + WS_S), (long)(C.inp(I_XA_WV, 0, (size_t)D * D) - C.inp(I_XA_WK, 0, (size_t)D * D)), D, 2 * D, D, 2 * D, 2);
    if (jobs & CJ_XKV1) cd_put(C, n, items, C.inp(I_XA_WK, 1, (size_t)D * D), C.inp(I_MEM_NORM, 1, D), (bf16*)(ws + WS_S + 4 * MiB), (long)(C.inp(I_XA_WV, 1, (size_t)D * D) - C.inp(I_XA_WK, 1, (size_t)D * D)), D, 2 * D, D, 2 * D, 2);
    if (jobs & CJ_MLW) {
#pragma unroll
        for (int q = 0; q < 3; ++q)
#pragma unroll
            for (int hh = 0; hh < 4; ++hh) cd_put(C, n, items, C.inp(q == 0 ? I_ML_WQ : (q == 1 ? I_ML_WK : I_ML_WV), l, 4 * 16384) + hh * 16384, nullptr, (bf16*)(ws + 512 * 1024) + (size_t)(q * 4 + hh) * 16384, 0, 128, 128, 128, 128, 0);
    }
    if (jobs & CJ_RWW) {
        bf16* dst = (bf16*)(ws + WS_S + RWW_OFF);
        cd_put(C, n, items, C.inp(I_RW_WUP, l, 64 * WB), nullptr, dst, 0, WB, WB, 64, WB, 0);
        cd_put(C, n, items, C.inp(I_RW_AUP, l, 64 * WB), nullptr, dst + 512 * 64, 0, WB, WB, 64, WB, 0);
        cd_put(C, n, items, C.inp(I_RW_GUP, l, 128 * WB), nullptr, dst + 2 * 512 * 64, 0, WB, WB, 128, WB, 0);
    }
    __syncthreads();
    ConvPlan P; P.n = n; P.items = items; return P;
}
__device__ __forceinline__ void conv_work(const Ctx& C, const ConvPlan P, int gw, int NGW) {
    LAS float* scr = (LAS float*)(C.lds + C.wave * 15360);
    const LAS ConvDesc* cd = (const LAS ConvDesc*)(C.lds + CD_OFF);
    for (int it = gw; it < P.items; it += NGW) {
        int j = 0;
        for (int q = 1; q < P.n; ++q) if (it >= cd[q].item0) j = q;
        conv_item(cd + j, it - cd[j].item0, scr, C.lane);
    }
}
__device__ __forceinline__ void run_conv(const Ctx& C, int jobs, int l, int gw, int NGW) {
    const ConvPlan P = conv_setup(C, jobs, l);
    conv_work(C, P, gw, NGW);
    __syncthreads();
}

__device__ __forceinline__ void pro_rows(const Ctx& C) {
    const int gw = C.bid * 8 + C.wave, NGW = C.G * 8;
    const float* x = C.in[I_X]; bf16* XB = (bf16*)(C.ws + WS_XB); float* ssq = (float*)(C.ws + WS_SSQ);
    for (int m = gw; m < M; m += NGW) {
        const f32x4* xr = (const f32x4*)(x + (size_t)m * D) + C.lane; u32x2* br = (u32x2*)(XB + (size_t)m * D) + C.lane;
        float s = 0.f;
#pragma unroll
        for (int j = 0; j < 4; ++j) { const f32x4 v = xr[64 * j]; u32x2 w; w.x = pk2(v[0], v[1]); w.y = pk2(v[2], v[3]); br[64 * j] = w; s += (v[0] * v[0] + v[1] * v[1]) + (v[2] * v[2] + v[3] * v[3]); }
        s = wave_sum(s, C.lane);
        if (C.lane < 16) ssq[(size_t)m * 16 + C.lane] = (C.lane == 0) ? s : 0.f;
    }
    const float* mem = C.in[I_MEM]; bf16* MB = (bf16*)(C.ws + WS_MEMB); float* memr = (float*)(C.ws + WS_MEMR);
    for (int m = gw; m < MMEM; m += NGW) {
        const f32x4* xr = (const f32x4*)(mem + (size_t)m * D) + C.lane; u32x2* br = (u32x2*)(MB + (size_t)m * D) + C.lane; float s = 0.f;
#pragma unroll
        for (int j = 0; j < 4; ++j) { const f32x4 v = xr[64 * j]; u32x2 w; w.x = pk2(v[0], v[1]); w.y = pk2(v[2], v[3]); br[64 * j] = w; s += (v[0] * v[0] + v[1] * v[1]) + (v[2] * v[2] + v[3] * v[3]); }
        s = wave_sum(s, C.lane);
        if (C.lane == 0) memr[m] = 1.0f / sqrtf(s * (1.0f / D) + NORM_EPS);
    }
}
__device__ __forceinline__ void final_rows(const Ctx& C) {
    const int gw = C.bid * 8 + C.wave, NGW = C.G * 8; const float* ssq = (const float*)(C.ws + WS_SSQ); const float* g = C.in[I_FINAL_NORM]; const bf16* XB = (const bf16*)(C.ws + WS_XB);
    for (int m = gw; m < M; m += NGW) {
        const float rs = row_rstd(ssq, m); f32x4* orow = (f32x4*)(C.X + (size_t)m * D) + C.lane; const f32x4* gr = (const f32x4*)g + C.lane; const u32x2* xr = (const u32x2*)(XB + (size_t)m * D) + C.lane;
#pragma unroll
        for (int j = 0; j < 4; ++j) { const u32x2 w = xr[64 * j]; const f32x4 v = (f32x4){bflo(w.x), bfhi(w.x), bflo(w.y), bfhi(w.y)}; orow[64 * j] = v * rs * gr[64 * j]; }
    }
}
__device__ __forceinline__ float ldz(const bf16* Z, int row, int col) { return bf2f(Z[(size_t)row * ZP + col]); }
__device__ __forceinline__ float gelu_tanh(float y) { const float t = 0.7978845608028654f * (y + 0.044715f * y * y * y); return 0.5f * y * (1.0f + tanhf_(t)); }
constexpr int LCH = 64, NCH = SEQ / LCH;
constexpr size_t SO_GLA_ST = 0;
constexpr size_t SO_GLA_G = SO_GLA_ST + 16 * MiB;
constexpr size_t SO_ML_ST = SO_GLA_G + 512 * 1024;
constexpr size_t SO_ML_G = SO_ML_ST + 36 * MiB;
constexpr size_t SO_END0 = SO_ML_G + 512 * 1024;
static_assert(WS_S + SO_END0 <= WS_END, "state region");

__device__ __forceinline__ bf16x8 ld8(const LAS bf16* p) { return *(const LAS bf16x8*)p; }
__device__ __forceinline__ bf16x8 ld8(const bf16* p) { return *(const bf16x8*)p; }
template <int K, class PA, class PB> __device__ __forceinline__ f32x4 tile_mm(PA A, int lda, PB B, int ldb, f32x4 acc, int fr, int fq) {
#pragma unroll
    for (int k0 = 0; k0 < K; k0 += 32) {
        const bf16x8 a = ld8(A + fr * lda + k0 + 8 * fq);
        const bf16x8 b = ld8(B + fr * ldb + k0 + 8 * fq);
        acc = __builtin_amdgcn_mfma_f32_16x16x32_bf16(a, b, acc, 0, 0, 0);
    }
    return acc;
}
#ifdef PROBE_MLC
#define MLC_STAMP() PROBE_STAMP(C)
#else
#define MLC_STAMP() do { } while (0)
#endif
constexpr int LDT_ = 72;
__device__ __forceinline__ int swz(int row, int col) { return row * LDT_ + ((((col >> 3) ^ (row >> 3)) & 7) << 3) + (col & 7); }
template <int K, bool SA, bool SB, class PA, class PB> __device__ __forceinline__ f32x4 tile_mm_sw(PA A, int lda, int ra0, PB B, int ldb, int rb0, f32x4 acc, int fr, int fq) {
    const int xa = SA ? (((ra0 + fr) >> 3) & 7) : 0, xb = SB ? (((rb0 + fr) >> 3) & 7) : 0;
#pragma unroll
    for (int k0 = 0; k0 < K; k0 += 32) {
        const bf16x8 a = ld8(A + (ra0 + fr) * lda + ((((k0 >> 3) + fq) ^ xa) << 3));
        const bf16x8 b = ld8(B + (rb0 + fr) * ldb + ((((k0 >> 3) + fq) ^ xb) << 3));
        acc = __builtin_amdgcn_mfma_f32_16x16x32_bf16(a, b, acc, 0, 0, 0);
    }
    return acc;
}
#define F4Z ((f32x4){0.f, 0.f, 0.f, 0.f})
__device__ __forceinline__ u32x2 pack4(f32x4 v) { u32x2 w; w.x = pk2(v[0], v[1]); w.y = pk2(v[2], v[3]); return w; }
__device__ __forceinline__ u32x4 pack8(const float* f) { u32x4 w; w.x = pk2(f[0], f[1]); w.y = pk2(f[2], f[3]); w.z = pk2(f[4], f[5]); w.w = pk2(f[6], f[7]); return w; }
__device__ __forceinline__ void unpack8(u32x4 w, float* f) { f[0] = bflo(w.x); f[1] = bfhi(w.x); f[2] = bflo(w.y); f[3] = bfhi(w.y); f[4] = bflo(w.z); f[5] = bfhi(w.z); f[6] = bflo(w.w); f[7] = bfhi(w.w); }

struct Touch { u32x4 a, b, c; };
__device__ __forceinline__ void touch_tile(Touch& T, const bf16* base, int rows, int ppr, int tid) {
    const u32x4 z = (u32x4){0u, 0u, 0u, 0u}; T.a = z; T.b = z; T.c = z; const int n = rows * ppr;
    if (tid < n) T.a = *(const u32x4*)(base + (size_t)(tid / ppr) * ZP + (tid % ppr) * 8);
    if (tid + 512 < n) T.b = *(const u32x4*)(base + (size_t)((tid + 512) / ppr) * ZP + ((tid + 512) % ppr) * 8);
    if (tid + 1024 < n) T.c = *(const u32x4*)(base + (size_t)((tid + 1024) / ppr) * ZP + ((tid + 1024) % ppr) * 8);
}
__device__ __forceinline__ void touch_sink(const Touch& T) { asm volatile("" :: "v"(T.a), "v"(T.b), "v"(T.c)); }
struct GlaW { float au[16], bk; };
__device__ __forceinline__ void gla_loadw(const Ctx& C, int l, int h, GlaW& W) {
    const float* aup = C.inp(I_GLA_AUP, l, 16 * 256) + h * 64; const float* abias = C.inp(I_GLA_ABIAS, l, 256) + h * 64; const int k = C.tid & 63;
#pragma unroll
    for (int r = 0; r < 16; ++r) W.au[r] = aup[r * 256 + k];
    W.bk = abias[k];
}
__device__ __forceinline__ void gla_cumdecay(const Ctx& C, const GlaW& W, float al0, float al1, LAS float* ALOW, LAS float* LA, LAS float* SEG) {
    const int tid = C.tid;
    ALOW[tid] = al0; ALOW[tid + 512] = al1;
    __syncthreads();
    {   const int k = tid & 63, seg = tid >> 6; float run = 0.f, v[8];
#pragma unroll
        for (int i = 0; i < 8; ++i) { const int t = seg * 8 + i; float s = W.bk;
#pragma unroll
            for (int r = 0; r < 16; ++r) s += ALOW[t * 16 + r] * W.au[r];
            run += logsigmoidf_(s) * (1.0f / 16.0f); v[i] = run; }
        SEG[seg * 64 + k] = run;
        __syncthreads();
        float off = 0.f;
        for (int s2 = 0; s2 < seg; ++s2) off += SEG[s2 * 64 + k];
#pragma unroll
        for (int i = 0; i < 8; ++i) LA[(seg * 8 + i) * 64 + k] = v[i] + off;
    }
    __syncthreads();
}
struct GlaPre { float al0, al1; u32x4 v0, v1, q, k, g0, g1; };
__device__ __forceinline__ void gla_preload(const Ctx& C, int item, GlaPre& P, bool with_qg) {
    const int bh = item >> 6, c = item & 63, b = bh >> 2, h = bh & 3, rowb = b * SEQ + c * LCH, tid = C.tid;
    const bf16* Z = (const bf16*)(C.ws + WS_Z);
    P.al0 = ldz(Z, rowb + (tid >> 4), ZC_A + (tid & 15)); P.al1 = ldz(Z, rowb + 32 + (tid >> 4), ZC_A + (tid & 15));
    P.v0 = *(const u32x4*)(Z + (size_t)(rowb + (tid >> 4)) * ZP + ZC_V + h * 128 + (tid & 15) * 8); P.v1 = *(const u32x4*)(Z + (size_t)(rowb + 32 + (tid >> 4)) * ZP + ZC_V + h * 128 + (tid & 15) * 8);
    P.k = *(const u32x4*)(Z + (size_t)(rowb + (tid >> 3)) * ZP + ZC_K + h * 64 + (tid & 7) * 8);
    if (with_qg) { P.q = *(const u32x4*)(Z + (size_t)(rowb + (tid >> 3)) * ZP + ZC_Q + h * 64 + (tid & 7) * 8);
        P.g0 = *(const u32x4*)(Z + (size_t)(rowb + (tid >> 4)) * ZP + ZC_G + h * 128 + (tid & 15) * 8); P.g1 = *(const u32x4*)(Z + (size_t)(rowb + 32 + (tid >> 4)) * ZP + ZC_G + h * 128 + (tid & 15) * 8); }
}
constexpr int LDT = 72;
__device__ __forceinline__ void gla_passA(const Ctx& C, int l, int item, const GlaW& W, const GlaPre& P) {
    const int bh = item >> 6, c = item & 63, b = bh >> 2, h = bh & 3, rowb = b * SEQ + c * LCH;
    LAS float* ALOW = (LAS float*)C.lds; LAS float* LA = ALOW + 1024; LAS float* SEG = LA + 4096;
    LAS bf16* VT = (LAS bf16*)(SEG + 512);
    LAS bf16* KT = VT + 128 * LDT;
    const int tid = C.tid, lane = C.lane, w = C.wave, fr = lane & 15, fq = lane >> 4;
    (void)l; (void)b; (void)h; (void)rowb;
    gla_cumdecay(C, W, P.al0, P.al1, ALOW, LA, SEG);
    {   const int v0 = (tid & 15) * 8; float f[8];
        unpack8(P.v0, f);
#pragma unroll
        for (int j = 0; j < 8; ++j) VT[swz(v0 + j, tid >> 4)] = (bf16)f2bf(f[j]);
        unpack8(P.v1, f);
#pragma unroll
        for (int j = 0; j < 8; ++j) VT[swz(v0 + j, 32 + (tid >> 4))] = (bf16)f2bf(f[j]); }
    {   const int t = tid >> 3, k0 = (tid & 7) * 8; float f[8];
        unpack8(P.k, f);
        const f32x4 e0 = *(const LAS f32x4*)(LA + 63 * 64 + k0), e1 = *(const LAS f32x4*)(LA + 63 * 64 + k0 + 4), b0 = *(const LAS f32x4*)(LA + t * 64 + k0), b1 = *(const LAS f32x4*)(LA + t * 64 + k0 + 4);
#pragma unroll
        for (int j = 0; j < 8; ++j) KT[swz(k0 + j, t)] = (bf16)f2bf(f[j] * __expf(((j < 4) ? e0[j & 3] : e1[j & 3]) - ((j < 4) ? b0[j & 3] : b1[j & 3]))); }
    if (tid < 64) ((float*)(C.ws + WS_S + SO_GLA_G))[(size_t)item * 64 + tid] = __expf(LA[63 * 64 + tid]);
    __syncthreads();
    bf16* ST = (bf16*)(C.ws + WS_S + SO_GLA_ST) + (size_t)item * 8192;
#pragma unroll
    for (int q = 0; q < 4; ++q) {
        const f32x4 acc = tile_mm_sw<64, true, true>(KT, LDT, 16 * q, VT, LDT, 16 * w, F4Z, fr, fq);
        *(u32x2*)(ST + (size_t)(16 * w + fr) * 64 + 16 * q + 4 * fq) = pack4(acc);
    }
    __syncthreads();
}
__device__ __forceinline__ void gla_passB(const Ctx& C, int tidx, int NT) {
    for (int idx = tidx; idx < 16 * 8192; idx += NT) {
    const int bh = idx >> 13, e = idx & 8191, k = e & 63;
    bf16* ST = (bf16*)(C.ws + WS_S + SO_GLA_ST) + (size_t)bh * 64 * 8192 + e; const float* G = (const float*)(C.ws + WS_S + SO_GLA_G) + (size_t)bh * 64 * 64 + k;
    float d[64], g[64];
#pragma unroll
    for (int c = 0; c < 64; ++c) { d[c] = bf2f(ST[(size_t)c * 8192]); g[c] = G[c * 64]; }
    float run = 0.f;
#pragma unroll
    for (int c = 0; c < 64; ++c) { ST[(size_t)c * 8192] = (bf16)f2bf(run); run = run * g[c] + d[c]; }
    }
}
template <bool DRY = false> __device__ __forceinline__ void gla_passC(const Ctx& C, int l, int item, const GlaW& W, const GlaPre& P) {
    const int bh = item >> 6, c = item & 63, b = bh >> 2, h = bh & 3, rowb = b * SEQ + c * LCH;
    bf16* Z = (bf16*)(C.ws + WS_Z);
    LAS float* ALOW = (LAS float*)C.lds; LAS float* LA = ALOW + 1024; LAS float* SEG = LA + 4096;
    LAS bf16* VT = (LAS bf16*)(SEG + 512);
    LAS bf16* QP = VT + 128 * LDT;
    LAS bf16* KP = QP + 64 * LDT;
    LAS bf16* ATT = KP + 64 * LDT;
    LAS float* O = (LAS float*)(ATT + 64 * LDT);
    LAS float* RSQ = O + 64 * 132;
    const int tid = C.tid, lane = C.lane, w = C.wave, fr = lane & 15, fq = lane >> 4;
    const bf16* ST = (const bf16*)(C.ws + WS_S + SO_GLA_ST) + (size_t)item * 8192;
    bf16x8 stf[4][2];
#pragma unroll
    for (int q = 0; q < 4; ++q) { const int vv = (4 * w + q) >> 2; stf[q][0] = ld8(ST + (size_t)(16 * vv + fr) * 64 + 8 * fq); stf[q][1] = ld8(ST + (size_t)(16 * vv + fr) * 64 + 32 + 8 * fq); }
    gla_cumdecay(C, W, P.al0, P.al1, ALOW, LA, SEG);
    {   const int v0 = (tid & 15) * 8; float f[8];
        unpack8(P.v0, f);
#pragma unroll
        for (int j = 0; j < 8; ++j) VT[swz(v0 + j, tid >> 4)] = (bf16)f2bf(f[j]);
        unpack8(P.v1, f);
#pragma unroll
        for (int j = 0; j < 8; ++j) VT[swz(v0 + j, 32 + (tid >> 4))] = (bf16)f2bf(f[j]); }
    {   const int t = tid >> 3, k0 = (tid & 7) * 8; float fq_[8], fk_[8];
        unpack8(P.q, fq_); unpack8(P.k, fk_);
        u32x4 wq, wk; float eq[8], ek[8];
        const f32x4 b0 = *(const LAS f32x4*)(LA + t * 64 + k0), b1 = *(const LAS f32x4*)(LA + t * 64 + k0 + 4);
#pragma unroll
        for (int j = 0; j < 8; ++j) { const float bb = (j < 4) ? b0[j & 3] : b1[j & 3]; eq[j] = fq_[j] * 0.125f * __expf(bb); ek[j] = fk_[j] * __expf(-bb); }
        wq.x = pk2(eq[0], eq[1]); wq.y = pk2(eq[2], eq[3]); wq.z = pk2(eq[4], eq[5]); wq.w = pk2(eq[6], eq[7]);
        wk.x = pk2(ek[0], ek[1]); wk.y = pk2(ek[2], ek[3]); wk.z = pk2(ek[4], ek[5]); wk.w = pk2(ek[6], ek[7]);
        *(LAS u32x4*)(QP + t * LDT + k0) = wq; *(LAS u32x4*)(KP + t * LDT + k0) = wk; }
    __syncthreads();
#pragma unroll
    for (int q = 0; q < 2; ++q) {
        const int id = 2 * w + q, tt = id >> 2, ss = id & 3; f32x4 acc = F4Z;
        if (ss <= tt) acc = tile_mm<64>(KP + (16 * ss) * LDT, LDT, QP + (16 * tt) * LDT, LDT, acc, fr, fq);
        const int t = 16 * tt + fr, s0 = 16 * ss + 4 * fq;
#pragma unroll
        for (int r = 0; r < 4; ++r) if (s0 + r > t) acc[r] = 0.f;
        *(LAS u32x2*)(ATT + t * LDT + s0) = pack4(acc);
    }
    __syncthreads();
#pragma unroll
    for (int q = 0; q < 4; ++q) {
        const int id = 4 * w + q, tt = id & 3, vv = id >> 2;
        f32x4 acc = __builtin_amdgcn_mfma_f32_16x16x32_bf16(stf[q][0], ld8(QP + (16 * tt + fr) * LDT + 8 * fq), F4Z, 0, 0, 0);
        acc = __builtin_amdgcn_mfma_f32_16x16x32_bf16(stf[q][1], ld8(QP + (16 * tt + fr) * LDT + 32 + 8 * fq), acc, 0, 0, 0);
        acc = tile_mm_sw<64, true, false>(VT, LDT, 16 * vv, ATT, LDT, 16 * tt, acc, fr, fq);
        *(LAS f32x4*)(O + (16 * tt + fr) * 132 + 16 * vv + 4 * fq) = acc;
    }
    __syncthreads();
    {
        const int t = tid >> 3, v0 = (tid & 7) * 16; float hv[16]; float ss = 0.f;
#pragma unroll
        for (int q4 = 0; q4 < 4; ++q4) { const f32x4 o4 = *(const LAS f32x4*)(O + t * 132 + v0 + 4 * q4);
#pragma unroll
            for (int j = 0; j < 4; ++j) { hv[4 * q4 + j] = o4[j]; ss += o4[j] * o4[j]; } }
        ss += shx(ss, 1, lane); ss += shx(ss, 2, lane); ss += shx(ss, 4, lane);
        const float rs = rsqf_(ss * (1.0f / 128) + NORM_EPS);
        bf16* zp = Z + (size_t)(rowb + t) * ZP + ZC_G + h * 128 + v0; float g[16]; unpack8(*(const u32x4*)zp, g); unpack8(*(const u32x4*)(zp + 8), g + 8);
        const float* gn = C.inp(I_GLA_NORM, l, WB) + h * 128 + v0; float o[16];
#pragma unroll
        for (int j = 0; j < 16; ++j) o[j] = hv[j] * rs * gn[j] * siluf_(g[j]);
        const u32x4 w0 = pack8(o), w1 = pack8(o + 8);
        if (!DRY) { *(u32x4*)zp = w0; *(u32x4*)(zp + 8) = w1; } else asm volatile("" :: "v"(w0), "v"(w1));
    }
    __syncthreads();
}

constexpr size_t WS_MLW = 512 * 1024;
constexpr int LDU = 152, LDE = 136;
__device__ __forceinline__ float wave_incl_scan(float v, int lane) {
#pragma unroll
    for (int o = 1; o < 64; o <<= 1) { const float n = __builtin_bit_cast(float, __builtin_amdgcn_ds_bpermute(((lane - o) & 63) << 2, __builtin_bit_cast(int, v))); if (lane >= o) v += n; }
    return v;
}
struct MlPre { u32x4 x[2][4]; float zi, zf; };
__device__ __forceinline__ void ml_preload(const Ctx& C, int item, MlPre& P) {
    const int bh = item >> 6, c = item & 63, b = bh >> 2, h = bh & 3, t0 = c * LCH, rowb = b * SEQ + t0, tid = C.tid;
    const bf16* Z = (const bf16*)(C.ws + WS_Z); const u32x4 z4 = (u32x4){0u, 0u, 0u, 0u};
#pragma unroll
    for (int ii = 0; ii < 2; ++ii) { const int t = (tid >> 4) + 32 * ii, e0 = (tid & 15) * 8;
#pragma unroll
        for (int d = 0; d < 4; ++d) P.x[ii][d] = (t0 + t - 3 + d >= 0) ? *(const u32x4*)(Z + (size_t)(rowb + t - 3 + d) * ZP + ZA_U + h * 128 + e0) : z4; }
    P.zi = 0.f; P.zf = 0.f;
    if (C.wave == 0) { P.zi = ldz(Z, rowb + C.lane, ZA_I + h); P.zf = ldz(Z, rowb + C.lane, ZA_F + h); }
}
__device__ __forceinline__ void ml_front(const Ctx& C, int l, int h, const MlPre& P, LAS bf16* UC, LAS bf16* U, LAS float* GB, LAS float* GI) {
    const int tid = C.tid;
    const float* conv = C.inp(I_ML_CONV, l, 4 * WB) + h * 128;
#pragma unroll
    for (int ii = 0; ii < 2; ++ii) { const int t = (tid >> 4) + 32 * ii, e0 = (tid & 15) * 8; float s[8], x[8];
#pragma unroll
        for (int j = 0; j < 8; ++j) s[j] = 0.f;
#pragma unroll
        for (int d = 0; d < 4; ++d) {
            unpack8(P.x[ii][d], x);
#pragma unroll
            for (int j = 0; j < 8; ++j) s[j] += conv[d * WB + e0 + j] * x[j];
        }
        const u32x4 wu = P.x[ii][3];
#pragma unroll
        for (int j = 0; j < 8; ++j) s[j] = siluf_(s[j]);
        *(LAS u32x4*)(U + t * LDU + e0) = wu; *(LAS u32x4*)(UC + t * LDU + e0) = pack8(s); }
    if (C.wave == 0) { const int t = C.lane;
        const float li = P.zi + C.inp(I_ML_BI, l, 4)[h]; const float lf = logsigmoidf_(P.zf + C.inp(I_ML_BF, l, 4)[h]);
        GB[t] = wave_incl_scan(lf, C.lane); GI[t] = li; }
    __syncthreads();
}
__device__ __forceinline__ void ml_passA(const Ctx& C, int l, int item, const MlPre& P) {
    const int bh = item >> 6, c = item & 63, b = bh >> 2, h = bh & 3; (void)c; (void)b;
    LAS bf16* UC = (LAS bf16*)C.lds; LAS bf16* U = UC + 64 * LDU; LAS bf16* KT = U + 64 * LDU;
    LAS bf16* VT = KT + 128 * LDT;
    LAS float* GB = (LAS float*)(VT + 144 * LDT); LAS float* GI = GB + 64; LAS float* WA = GI + 64;
    const int tid = C.tid, lane = C.lane, w = C.wave, fr = lane & 15, fq = lane >> 4;
    ml_front(C, l, h, P, UC, U, GB, GI);
    if (tid < 64) WA[tid] = __expf(GB[63] - GB[tid] + GI[tid]) * 0.08838834764831845f;
    for (int i = tid; i < 16 * LDT; i += 512) VT[128 * LDT + i] = (i < LDT) ? (bf16)0x3f80 : (bf16)0;
    __syncthreads();
    const bf16* WK = (const bf16*)(C.ws + WS_MLW) + (size_t)(4 + h) * 16384; const bf16* WV = (const bf16*)(C.ws + WS_MLW) + (size_t)(8 + h) * 16384;
#pragma unroll
    for (int q = 0; q < 4; ++q) {
        const int id = 4 * w + q, tt = id & 3, ee = id >> 2;
        f32x4 ak = tile_mm<128>(UC + (16 * tt) * LDU, LDU, WK + (size_t)(16 * ee) * 128, 128, F4Z, fr, fq);
        f32x4 av = tile_mm<128>(U + (16 * tt) * LDU, LDU, WV + (size_t)(16 * ee) * 128, 128, F4Z, fr, fq);
        const int t = 16 * tt + 4 * fq;
#pragma unroll
        for (int r = 0; r < 4; ++r) ak[r] *= WA[t + r];
        *(LAS u32x2*)(KT + (16 * ee + fr) * LDT + t) = pack4(ak); *(LAS u32x2*)(VT + (16 * ee + fr) * LDT + t) = pack4(av);
    }
    if (tid == 0) ((float*)(C.ws + WS_S + SO_ML_G))[item] = __expf(GB[63]);
    __syncthreads();
    bf16* ST = (bf16*)(C.ws + WS_S + SO_ML_ST) + (size_t)item * (144 * 128);
    for (int id = w; id < 72; id += 8) {
        const int ee = id & 7, vv = id >> 3;
        const f32x4 acc = tile_mm<64>(KT + (16 * ee) * LDT, LDT, VT + (16 * vv) * LDT, LDT, F4Z, fr, fq);
        *(u32x2*)(ST + (size_t)(16 * vv + fr) * 128 + 16 * ee + 4 * fq) = pack4(acc);
    }
    __syncthreads();
}
__device__ __forceinline__ void ml_passB(const Ctx& C, int tidx, int NT) {
    for (int idx = tidx; idx < 16 * 18432; idx += NT) {
        const int bh = idx / 18432, e = idx % 18432;
        bf16* ST = (bf16*)(C.ws + WS_S + SO_ML_ST) + (size_t)bh * 64 * 18432 + e; const float* G = (const float*)(C.ws + WS_S + SO_ML_G) + bh * 64;
        float d[64], g[64];
#pragma unroll
        for (int c = 0; c < 64; ++c) { d[c] = bf2f(ST[(size_t)c * 18432]); g[c] = G[c]; }
        float run = 0.f;
#pragma unroll
        for (int c = 0; c < 64; ++c) { ST[(size_t)c * 18432] = (bf16)f2bf(run); run = run * g[c] + d[c]; }
    }
}
template <bool DRY = false> __device__ __forceinline__ void ml_passC(const Ctx& C, int l, int item, const MlPre& P) {
    const int bh = item >> 6, c = item & 63, b = bh >> 2, h = bh & 3, rowb = b * SEQ + c * LCH;
    bf16* Z = (bf16*)(C.ws + WS_Z);
    LAS bf16* UC = (LAS bf16*)C.lds; LAS bf16* U = UC + 64 * LDU; LAS bf16* Q = U + 64 * LDU;
    LAS bf16* K = Q + 64 * LDE;
    LAS bf16* VT = K + 64 * LDE;
    LAS bf16* W = VT + 144 * LDT;
    LAS float* GB = (LAS float*)(W + 64 * LDT); LAS float* GI = GB + 64; LAS float* RF = GI + 64; LAS float* CF = RF + 64; LAS float* RSQ = CF + 64;
    LAS float* O = (LAS float*)C.lds;
    const int tid = C.tid, lane = C.lane, w = C.wave, fr = lane & 15, fq = lane >> 4;
    const bf16* ST = (const bf16*)(C.ws + WS_S + SO_ML_ST) + (size_t)item * (144 * 128);
    bf16x8 stf[5][4];
#pragma unroll
    for (int q = 0; q < 5; ++q) { const int id = w + 8 * q, vv = id >> 2;
#pragma unroll
        for (int k4 = 0; k4 < 4; ++k4) stf[q][k4] = (id < 36) ? ld8(ST + (size_t)(16 * vv + fr) * 128 + 32 * k4 + 8 * fq) : (bf16x8){0, 0, 0, 0, 0, 0, 0, 0}; }
    MLC_STAMP();
    ml_front(C, l, h, P, UC, U, GB, GI);
    MLC_STAMP();
    if (tid < 64) { RF[tid] = __expf(GB[tid]); CF[tid] = __expf(GI[tid] - GB[tid]) * 0.08838834764831845f; }
    for (int i = tid; i < 16 * LDT; i += 512) VT[128 * LDT + i] = (i < LDT) ? (bf16)0x3f80 : (bf16)0;
    const bf16* WQ = (const bf16*)(C.ws + WS_MLW) + (size_t)h * 16384; const bf16* WK = WQ + 4 * 16384; const bf16* WV = WQ + 8 * 16384;
#pragma unroll
    for (int q = 0; q < 4; ++q) {
        const int id = 4 * w + q, tt = id & 3, ee = id >> 2;
        const f32x4 aq = tile_mm<128>(WQ + (size_t)(16 * ee) * 128, 128, UC + (16 * tt) * LDU, LDU, F4Z, fr, fq);
        const f32x4 ak = tile_mm<128>(WK + (size_t)(16 * ee) * 128, 128, UC + (16 * tt) * LDU, LDU, F4Z, fr, fq);
        *(LAS u32x2*)(Q + (16 * tt + fr) * LDE + 16 * ee + 4 * fq) = pack4(aq); *(LAS u32x2*)(K + (16 * tt + fr) * LDE + 16 * ee + 4 * fq) = pack4(ak);
        const f32x4 av = tile_mm<128>(U + (16 * tt) * LDU, LDU, WV + (size_t)(16 * ee) * 128, 128, F4Z, fr, fq);
        *(LAS u32x2*)(VT + (16 * ee + fr) * LDT + 16 * tt + 4 * fq) = pack4(av);
    }
    __syncthreads();
    MLC_STAMP();
#pragma unroll
    for (int q = 0; q < 2; ++q) {
        const int id = 2 * w + q, tt = id >> 2, ss = id & 3; f32x4 acc = F4Z;
        if (ss <= tt) acc = tile_mm<128>(K + (16 * ss) * LDE, LDE, Q + (16 * tt) * LDE, LDE, acc, fr, fq);
        const int t = 16 * tt + fr, s0 = 16 * ss + 4 * fq; const float rf = RF[t];
#pragma unroll
        for (int r = 0; r < 4; ++r) acc[r] = (s0 + r > t) ? 0.f : acc[r] * rf * CF[s0 + r];
        *(LAS u32x2*)(W + t * LDT + s0) = pack4(acc);
    }
    __syncthreads();
    MLC_STAMP();
    f32x4 res[5];
#pragma unroll
    for (int q = 0; q < 5; ++q) {
        const int id = w + 8 * q, tt = id & 3, vv = id >> 2; res[q] = F4Z;
        if (id < 36) {
            f32x4 acc = F4Z;
#pragma unroll
            for (int k4 = 0; k4 < 4; ++k4) acc = __builtin_amdgcn_mfma_f32_16x16x32_bf16(stf[q][k4], ld8(Q + (16 * tt + fr) * LDE + 32 * k4 + 8 * fq), acc, 0, 0, 0);
            acc *= RF[16 * tt + fr];
            res[q] = tile_mm<64>(VT + (16 * vv) * LDT, LDT, W + (16 * tt) * LDT, LDT, acc, fr, fq);
        }
    }
    __syncthreads();
    MLC_STAMP();
#pragma unroll
    for (int q = 0; q < 5; ++q) { const int id = w + 8 * q, tt = id & 3, vv = id >> 2; if (id < 36) *(LAS f32x4*)(O + (16 * tt + fr) * 148 + 16 * vv + 4 * fq) = res[q]; }
    __syncthreads();
    {
        const int t = tid >> 3, v0 = (tid & 7) * 16; float hv[16];
        const float inv = rcpf_(fmaxf(fabsf(O[t * 148 + 128]), 1.0f)); float ss = 0.f;
#pragma unroll
        for (int q4 = 0; q4 < 4; ++q4) { const f32x4 o4 = *(const LAS f32x4*)(O + t * 148 + v0 + 4 * q4);
#pragma unroll
            for (int j = 0; j < 4; ++j) { const float x = o4[j] * inv; hv[4 * q4 + j] = x; ss += x * x; } }
        ss += shx(ss, 1, lane); ss += shx(ss, 2, lane); ss += shx(ss, 4, lane);
        const float rs = rsqf_(ss * (1.0f / 128) + NORM_EPS);
        bf16* zp = Z + (size_t)(rowb + t) * ZP + ZA_O + h * 128 + v0; float g[16]; unpack8(*(const u32x4*)zp, g); unpack8(*(const u32x4*)(zp + 8), g + 8);
        const float* gn = C.inp(I_ML_NORM, l, WB) + h * 128 + v0; float o[16];
#pragma unroll
        for (int j = 0; j < 16; ++j) o[j] = hv[j] * rs * gn[j] * sigmoidf_(g[j]);
        const u32x4 w0 = pack8(o), w1 = pack8(o + 8);
        if (!DRY) { *(u32x4*)zp = w0; *(u32x4*)(zp + 8) = w1; } else asm volatile("" :: "v"(w0), "v"(w1));
    }
    __syncthreads();
    MLC_STAMP();
}

constexpr size_t SO_S5_K = SO_END0;
constexpr size_t SO_S5_BB = SO_S5_K + 1 * MiB;
constexpr size_t SO_S5_PM = SO_S5_BB + 256 * 1024;
constexpr size_t SO_S5_POW = SO_S5_PM + 512 * 1024;
constexpr size_t SO_S5_E = SO_S5_POW + 1280 * 1024;
constexpr size_t SO_END1 = SO_S5_E + 4 * MiB;
static_assert(WS_S + SO_END1 <= WS_END, "state region");
__device__ __forceinline__ void s5_prep(const Ctx& C, int l, int g) {
    LAS float* BBr = (LAS float*)C.lds; LAS float* BBi = BBr + 1024; LAS float* PW = BBi + 1024; LAS float* CR = PW + 65 * 128; LAS float* CI = CR + 1024;
    LAS bf16* BT = (LAS bf16*)(CI + 1024);
    LAS bf16* WT = BT + 16 * 136 + C.wave * (16 * 136);
    const int tid = C.tid, lane = C.lane, w = C.wave, fr = lane & 15, fq = lane >> 4;
    if (tid < 64) { const int p = tid;
        const float are = C.inp(I_S5_ARE, l, 32 * 64)[g * 64 + p], aim = C.inp(I_S5_AIM, l, 32 * 64)[g * 64 + p];
        const float step = expf(C.inp(I_S5_LOGSTEP, l, 32)[g]); const float lre = fminf(are, -1e-4f), lim = aim;
        const float mag = expf(lre * step), bre = mag * cosf(lim * step), bim = mag * sinf(lim * step), den = lre * lre + lim * lim;
        const float cre = ((bre - 1.0f) * lre + bim * lim) / den, cim = (bim * lre - (bre - 1.0f) * lim) / den;
        const float* br = C.inp(I_S5_BRE, l, 32 * 64 * 16) + (size_t)(g * 64 + p) * 16; const float* bi = C.inp(I_S5_BIM, l, 32 * 64 * 16) + (size_t)(g * 64 + p) * 16;
        for (int c = 0; c < 16; ++c) { BBr[p * 16 + c] = cre * br[c] - cim * bi[c]; BBi[p * 16 + c] = cre * bi[c] + cim * br[c]; }
        float pr = 1.f, pi = 0.f;
        for (int n = 0; n <= 64; ++n) { PW[(n * 64 + p) * 2] = pr; PW[(n * 64 + p) * 2 + 1] = pi; const float nr = pr * bre - pi * bim, ni = pr * bim + pi * bre; pr = nr; pi = ni; }
    }
    for (int i = tid; i < 1024; i += 512) { CR[i] = C.inp(I_S5_CRE, l, 32 * 1024)[g * 1024 + i]; CI[i] = C.inp(I_S5_CIM, l, 32 * 1024)[g * 1024 + i]; }
    __syncthreads();
    unsigned char* S = C.ws + WS_S;
    float* POW = (float*)(S + SO_S5_POW) + (size_t)g * 65 * 128;
    for (int i = tid; i < 65 * 128; i += 512) POW[i] = PW[i];
    bf16* BB = (bf16*)(S + SO_S5_BB) + (size_t)g * 128 * 32;
    for (int i = tid; i < 128 * 32; i += 512) { const int row = i >> 5, c = i & 31, pp = row >> 5, ri = (row >> 4) & 1, p = 16 * pp + (row & 15);
        BB[i] = (bf16)f2bf(c < 16 ? (ri ? BBi[p * 16 + c] : BBr[p * 16 + c]) : 0.f); }
    bf16* PM = (bf16*)(S + SO_S5_PM) + (size_t)g * 64 * 128;
    for (int i = tid; i < 64 * 128; i += 512) { const int t = i >> 7, k = i & 127, ri = k >> 6, p = k & 63;
        PM[i] = (bf16)f2bf(ri ? -PW[((t + 1) * 64 + p) * 2 + 1] : PW[((t + 1) * 64 + p) * 2]); }
    for (int i = tid; i < 16 * 128; i += 512) { const int c = i >> 7, k = i & 127, ri = k >> 6, p = k & 63; BT[c * 136 + k] = (bf16)f2bf(ri ? -BBi[p * 16 + c] : BBr[p * 16 + c]); }
    __syncthreads();
    bf16* KM = (bf16*)(S + SO_S5_K) + (size_t)g * 16 * 1024;
#pragma unroll 1
    for (int tau = w; tau < 64; tau += 8) {
        const float pr = PW[(tau * 64 + lane) * 2], pi = PW[(tau * 64 + lane) * 2 + 1];
#pragma unroll
        for (int cp = 0; cp < 16; ++cp) { const float cr = CR[cp * 64 + lane], ci = CI[cp * 64 + lane];
            WT[cp * 136 + lane] = (bf16)f2bf(cr * pr - ci * pi); WT[cp * 136 + 64 + lane] = (bf16)f2bf(cr * pi + ci * pr); }
        LDS_WAIT(); __builtin_amdgcn_wave_barrier();
        const f32x4 acc = tile_mm<128>(BT, 136, WT, 136, F4Z, fr, fq);
        *(u32x2*)(KM + (size_t)fr * 1024 + tau * 16 + 4 * fq) = pack4(acc);
        LDS_WAIT(); __builtin_amdgcn_wave_barrier();
    }
    __syncthreads();
}
__device__ __forceinline__ void s5_passA(const Ctx& C) {
    const int g = C.bid >> 3, sb = C.bid & 7, lane = C.lane, fr = lane & 15, fq = lane >> 4, tid = C.tid;
    const bf16* Z = (const bf16*)(C.ws + WS_Z); unsigned char* S = C.ws + WS_S;
    LAS bf16* BBL = (LAS bf16*)(C.lds + 65536);
    LAS float* POWL = (LAS float*)(C.lds + 65536 + 8192);
    {   const u32x4* src = (const u32x4*)((const bf16*)(S + SO_S5_BB) + (size_t)g * 128 * 32); LAS u32x4* dst = (LAS u32x4*)BBL; dst[tid] = src[tid];
        const u32x4* ps = (const u32x4*)((const float*)(S + SO_S5_POW) + (size_t)g * 65 * 128); LAS u32x4* pd = (LAS u32x4*)POWL;
        for (int i = tid; i < 65 * 128 / 4; i += 512) pd[i] = ps[i]; }
    __syncthreads();
    LAS bf16* UA = (LAS bf16*)(C.lds + C.wave * 8192);
#pragma unroll 1
    for (int i4 = 0; i4 < 4; ++i4) {
        const int j = sb * 32 + C.wave * 4 + i4, b = j >> 6, c = j & 63, item = (b * 32 + g) * 64 + c, rowb = b * SEQ + c * LCH;
        {   const u32x4* src = (const u32x4*)(Z + (size_t)(rowb + lane) * ZP + ZB_U + g * 16); const u32x4 z4 = (u32x4){0u, 0u, 0u, 0u};
            LAS u32x4* dst = (LAS u32x4*)(UA + lane * 40); dst[0] = src[0]; dst[1] = src[1]; dst[2] = z4; dst[3] = z4; }
        LDS_WAIT(); __builtin_amdgcn_wave_barrier();
        float* E = (float*)(S + SO_S5_E) + (size_t)item * 128;
#pragma unroll
        for (int pp = 0; pp < 4; ++pp) { float er = 0.f, ei = 0.f; const int p = 16 * pp + fr;
#pragma unroll
            for (int tt = 0; tt < 4; ++tt) {
                const f32x4 br = tile_mm<32>(UA + (16 * tt) * 40, 40, BBL + (pp * 32) * 32, 32, F4Z, fr, fq);
                const f32x4 bi = tile_mm<32>(UA + (16 * tt) * 40, 40, BBL + (pp * 32 + 16) * 32, 32, F4Z, fr, fq);
#pragma unroll
                for (int r = 0; r < 4; ++r) { const int t = 16 * tt + 4 * fq + r; const f32x2 pw = *(const LAS f32x2*)(POWL + ((63 - t) * 64 + p) * 2);
                    er += pw.x * br[r] - pw.y * bi[r]; ei += pw.x * bi[r] + pw.y * br[r]; }
            }
            er += shx(er, 16, lane); er += shx(er, 32, lane); ei += shx(ei, 16, lane); ei += shx(ei, 32, lane);
            if (fq == 0) { E[p] = er; E[64 + p] = ei; }
        }
        LDS_WAIT(); __builtin_amdgcn_wave_barrier();
    }
    __syncthreads();
}
__device__ __forceinline__ void s5_passB(const Ctx& C, int tidx, int NT) {
    for (int idx = tidx; idx < 8192; idx += NT) {
    const int bg = idx >> 6, p = idx & 63, g = bg & 31; unsigned char* S = C.ws + WS_S;
    const f32x2 l64 = *(const f32x2*)((const float*)(S + SO_S5_POW) + (size_t)g * 65 * 128 + (64 * 64 + p) * 2);
    float* E = (float*)(S + SO_S5_E) + (size_t)bg * 64 * 128 + p;
    float er[64], ei[64];
#pragma unroll
    for (int c = 0; c < 64; ++c) { er[c] = E[c * 128]; ei[c] = E[c * 128 + 64]; }
    float rr = 0.f, ri = 0.f;
#pragma unroll
    for (int c = 0; c < 64; ++c) { E[c * 128] = rr; E[c * 128 + 64] = ri; const float nr = l64.x * rr - l64.y * ri + er[c], ni = l64.x * ri + l64.y * rr + ei[c]; rr = nr; ri = ni; }
    }
}
constexpr int LDKM = 1032;
template <class RW> __device__ __forceinline__ void s5_passC_core(const Ctx& C, int l, RW rw_items) {
    const int g = C.bid >> 3, sb = C.bid & 7, lane = C.lane, fr = lane & 15, fq = lane >> 4, tid = C.tid;
    bf16* Z = (bf16*)(C.ws + WS_Z); unsigned char* S = C.ws + WS_S;
    LAS bf16* KML = (LAS bf16*)(C.lds + 73728);
    LAS bf16* PML = (LAS bf16*)(C.lds + 73728 + 16 * LDKM * 2);
    {   const u32x4* ks = (const u32x4*)((const bf16*)(S + SO_S5_K) + (size_t)g * 16 * 1024);
        for (int i = tid; i < 16 * 128; i += 512) *(LAS u32x4*)(KML + (i >> 7) * LDKM + (i & 127) * 8) = ks[i];
        const u32x4* ps = (const u32x4*)((const bf16*)(S + SO_S5_PM) + (size_t)g * 64 * 128);
        for (int i = tid; i < 64 * 16; i += 512) *(LAS u32x4*)(PML + (i >> 4) * 136 + (i & 15) * 8) = ps[i]; }
    __syncthreads();
    if (C.wave < 4) { rw_items(); __syncthreads(); return; }
    LAS bf16* UP = (LAS bf16*)(C.lds + C.wave * 9216);
    LAS bf16* WV = UP + 128 * 16;
    const float* dsk = C.inp(I_S5_D, l, WB) + g * 16;
#pragma unroll 1
    for (int i4 = 0; i4 < 8; ++i4) {
        const int j = sb * 32 + (C.wave - 4) * 8 + i4, b = j >> 6, c = j & 63, item = (b * 32 + g) * 64 + c, rowb = b * SEQ + c * LCH;
        {   const u32x4* src = (const u32x4*)(Z + (size_t)(rowb + lane) * ZP + ZB_U + g * 16); const u32x4 z4 = (u32x4){0u, 0u, 0u, 0u};
            LAS u32x4* dz = (LAS u32x4*)(UP + lane * 16); dz[0] = z4; dz[1] = z4; LAS u32x4* dst = (LAS u32x4*)(UP + (64 + lane) * 16); dst[0] = src[0]; dst[1] = src[1]; }
        {   const float* E = (const float*)(S + SO_S5_E) + (size_t)item * 128; const int cp = lane >> 2, pq = lane & 3;
            const float* cr = C.inp(I_S5_CRE, l, 32 * 1024) + (size_t)g * 1024 + cp * 64 + 16 * pq; const float* ci = C.inp(I_S5_CIM, l, 32 * 1024) + (size_t)g * 1024 + cp * 64 + 16 * pq;
#pragma unroll
            for (int jj = 0; jj < 16; jj += 2) { const int p = 16 * pq + jj;
                const float a0 = cr[jj] * E[p] - ci[jj] * E[64 + p], b0 = cr[jj] * E[64 + p] + ci[jj] * E[p], a1 = cr[jj + 1] * E[p + 1] - ci[jj + 1] * E[65 + p], b1 = cr[jj + 1] * E[65 + p] + ci[jj + 1] * E[p + 1];
                *(LAS unsigned*)(WV + cp * 136 + p) = pk2(a0, a1); *(LAS unsigned*)(WV + cp * 136 + 64 + p) = pk2(b0, b1); }
        }
        LDS_WAIT(); __builtin_amdgcn_wave_barrier();
#pragma unroll
        for (int tt = 0; tt < 4; ++tt) {
            f32x4 acc = F4Z; const int t = 16 * tt + fr;
#pragma unroll 4
            for (int ks = 0; ks < 8 * (tt + 1); ++ks) {
                const bf16x8 a = ld8(KML + fr * LDKM + 32 * ks + 8 * fq);
                const bf16x8 bb = ld8(UP + (64 + t - 2 * ks - (fq >> 1)) * 16 + 8 * (fq & 1));
                acc = __builtin_amdgcn_mfma_f32_16x16x32_bf16(a, bb, acc, 0, 0, 0);
            }
            acc = tile_mm<128>(WV, 136, PML + (16 * tt) * 136, 136, acc, fr, fq);
            float y[4];
#pragma unroll
            for (int r = 0; r < 4; ++r) { const int cp = 4 * fq + r; y[r] = gelu_tanh(acc[r] + dsk[cp] * bf2f(UP[(64 + t) * 16 + cp])); }
            u32x2 o; o.x = pk2(y[0], y[1]); o.y = pk2(y[2], y[3]);
            *(u32x2*)(Z + (size_t)(rowb + t) * ZP + ZB_U + g * 16 + 4 * fq) = o;
        }
        LDS_WAIT(); __builtin_amdgcn_wave_barrier();
    }
    __syncthreads();
}

constexpr size_t SO_RW_PQ = SO_END1;
constexpr size_t SO_RW_RHO = SO_RW_PQ + 32 * MiB;
constexpr size_t SO_RW_HALO = SO_RW_RHO + 512 * 1024;
constexpr size_t SO_RW_W = SO_RW_HALO + 512 * 1024;
constexpr size_t SO_END2 = SO_RW_W + 256 * 1024;
static_assert(WS_S + SO_END2 <= WS_END, "state region");
static_assert(SO_RW_W == RWW_OFF, "RWW_OFF");
__device__ __forceinline__ void shift8(const u32x4 cur, const u32x4 prev, const float* mu, float* o) {
    float a[8], p[8]; unpack8(cur, a); unpack8(prev, p);
#pragma unroll
    for (int j = 0; j < 8; ++j) o[j] = a[j] + mu[j] * (p[j] - a[j]);
}

struct RwPre { u32x4 cw, pw, ca, pa, cr, ck, cv, pr, pk, pv; };
__device__ __forceinline__ void rw_preload(const Ctx& C, int item, RwPre& P) {
    const int bh = item >> 6, c = item & 63, b = bh >> 3, h = bh & 7, hc0 = h * 64, rowb = b * SEQ + c * LCH;
    const bf16* Z = (const bf16*)(C.ws + WS_Z); const int t = C.tid >> 3, c0 = (C.tid & 7) * 8, row = rowb + t;
    const bf16* HALO = (const bf16*)(C.ws + WS_S + SO_RW_HALO) + (size_t)(b * 64 + c - 1) * 1024;
    const u32x4 z4 = (u32x4){0u, 0u, 0u, 0u}; const bool first = (c * LCH + t == 0);
    P.cw = *(const u32x4*)(Z + (size_t)row * ZP + ZD_XW + c0); P.ca = *(const u32x4*)(Z + (size_t)row * ZP + ZD_XA + c0);
    P.cr = *(const u32x4*)(Z + (size_t)row * ZP + ZD_R + hc0 + c0); P.ck = *(const u32x4*)(Z + (size_t)row * ZP + ZD_K + hc0 + c0); P.cv = *(const u32x4*)(Z + (size_t)row * ZP + ZD_V + hc0 + c0);
    P.pw = z4; P.pa = z4; P.pr = z4; P.pk = z4; P.pv = z4;
    if (!first) { P.pw = *(const u32x4*)(Z + (size_t)(row - 1) * ZP + ZD_XW + c0); P.pa = *(const u32x4*)(Z + (size_t)(row - 1) * ZP + ZD_XA + c0); P.pv = *(const u32x4*)(Z + (size_t)(row - 1) * ZP + ZD_V + hc0 + c0);
        if (t > 0) { P.pr = *(const u32x4*)(Z + (size_t)(row - 1) * ZP + ZD_R + hc0 + c0); P.pk = *(const u32x4*)(Z + (size_t)(row - 1) * ZP + ZD_K + hc0 + c0); }
        else { P.pr = *(const u32x4*)(HALO + hc0 + c0); P.pk = *(const u32x4*)(HALO + 512 + hc0 + c0); } }
}
#define RWA_STAMP(k) do { if (item == 256 && l == 0) TSTAMP(C, 220 + (k)); } while (0)
template <bool DRY = false> __device__ __forceinline__ void rw_passA(const Ctx& C, int l, int item, RwPre& P, int next_item) {
    const int bh = item >> 6, c = item & 63, b = bh >> 3, h = bh & 7, hc0 = h * 64, rowb = b * SEQ + c * LCH;
    bf16* Z = (bf16*)(C.ws + WS_Z); unsigned char* S = C.ws + WS_S;
    LAS unsigned char* L = C.lds;
    LAS bf16* XW = (LAS bf16*)L; LAS bf16* XA = (LAS bf16*)(L + 9216); LAS float* WARG = (LAS float*)(L + 18432);
    LAS bf16* TAB = (LAS bf16*)L; LAS bf16* TAK = (LAS bf16*)(L + 9216); LAS bf16* MRB = (LAS bf16*)(L + 18432); LAS bf16* MRK = (LAS bf16*)(L + 27648);
    LAS float* AARG = (LAS float*)(L + 36864); LAS float* LW = AARG; LAS bf16* XT = (LAS bf16*)(L + 36864);
    LAS bf16* AT = (LAS bf16*)(L + 55296); LAS bf16* RT = (LAS bf16*)(L + 64512); LAS bf16* BT = (LAS bf16*)(L + 73728); LAS bf16* KT = (LAS bf16*)(L + 82944);
    LAS float* RHSV = (LAS float*)(L + 73728);
    LAS bf16* BBT = (LAS bf16*)(L + 92160); LAS bf16* KBT = (LAS bf16*)(L + 101376); LAS bf16* VT = (LAS bf16*)(L + 110592);
    LAS float* CUML = (LAS float*)(L + 119808); LAS float* GL = CUML + 64; LAS float* SEG = GL + 64; LAS float* UPD = SEG;
    const int tid = C.tid, lane = C.lane, w = C.wave, fr = lane & 15, fq = lane >> 4;
    const int t = tid >> 3, c0 = (tid & 7) * 8, row = rowb + t;
    const float* mu = C.inp(I_RW_MU, l, 1792);
    const u32x4 z4 = (u32x4){0u, 0u, 0u, 0u};
    RWA_STAMP(0);
    {   float f[8];
        shift8(P.cw, P.pw, mu + 1536 + c0, f);
#pragma unroll
        for (int j = 0; j < 8; ++j) f[j] = tanhf_(f[j]);
        *(LAS u32x4*)(XW + t * LDT + c0) = pack8(f);
        shift8(P.ca, P.pa, mu + 1600 + c0, f);
        *(LAS u32x4*)(XA + t * LDT + c0) = pack8(f);
    }
    __syncthreads();
    RWA_STAMP(1);
    {   const bf16* WUP = (const bf16*)(S + SO_RW_W) + (size_t)hc0 * 64; const bf16* AUP = WUP + 512 * 64;
#pragma unroll
        for (int q = 0; q < 2; ++q) { const int id = 2 * w + q, tt = id >> 2, cc = id & 3;
            const f32x4 aw = tile_mm<64>(XW + (16 * tt) * LDT, LDT, WUP + (size_t)(16 * cc) * 64, 64, F4Z, fr, fq);
            const f32x4 aa = tile_mm<64>(XA + (16 * tt) * LDT, LDT, AUP + (size_t)(16 * cc) * 64, 64, F4Z, fr, fq);
#pragma unroll
            for (int r = 0; r < 4; ++r) { WARG[(16 * tt + 4 * fq + r) * 65 + 16 * cc + fr] = aw[r]; AARG[(16 * tt + 4 * fq + r) * 65 + 16 * cc + fr] = aa[r]; } }
    }
    __syncthreads();
    RWA_STAMP(2);
    float lw[8], av[8], bv[8], kr[8], rr[8], vv[8];
    {   float kk[8], aa[8];
        shift8(P.cr, P.pr, mu + hc0 + c0, rr); shift8(P.ck, P.pk, mu + 512 + hc0 + c0, kk); shift8(P.cv, P.pv, mu + 1024 + hc0 + c0, vv);
        const float* w0 = C.inp(I_RW_W0, l, WB) + hc0 + c0; const float* a0 = C.inp(I_RW_A0, l, WB) + hc0 + c0;
        const float* kkw = C.inp(I_RW_KK, l, WB) + hc0 + c0; const float* kaw = C.inp(I_RW_KA, l, WB) + hc0 + c0; const float* rkw = C.inp(I_RW_RK, l, WB) + hc0 + c0;
        float n2 = 0.f, rho = 0.f;
#pragma unroll
        for (int j = 0; j < 8; ++j) {
            const float wl = -softplusf_(-(WARG[t * 65 + c0 + j] + w0[j])) - 0.5f; lw[j] = -__expf(wl);
            aa[j] = sigmoidf_(AARG[t * 65 + c0 + j] + a0[j]);
            const float kn = kk[j] * kkw[j]; n2 += kn * kn; av[j] = kn;
            kr[j] = kk[j] * (1.0f + (aa[j] - 1.0f) * kaw[j]); rho += rr[j] * kr[j] * rkw[j];
        }
        n2 += shx(n2, 1, lane); n2 += shx(n2, 2, lane); n2 += shx(n2, 4, lane);
        rho += shx(rho, 1, lane); rho += shx(rho, 2, lane); rho += shx(rho, 4, lane);
        const float inv = rcpf_(fmaxf(sqrtf(n2), 1e-12f));
#pragma unroll
        for (int j = 0; j < 8; ++j) { const float kkn = av[j] * inv; av[j] = -kkn; bv[j] = kkn * aa[j]; }
        if (!DRY && (tid & 7) == 0) ((float*)(S + SO_RW_RHO))[(size_t)row * 8 + h] = rho;
    }
    __syncthreads();
    RWA_STAMP(3);
    if (next_item >= 0) rw_preload(C, next_item, P);
    *(LAS f32x4*)(LW + t * 64 + c0) = (f32x4){lw[0], lw[1], lw[2], lw[3]}; *(LAS f32x4*)(LW + t * 64 + c0 + 4) = (f32x4){lw[4], lw[5], lw[6], lw[7]};
    __syncthreads();
    RWA_STAMP(4);
    {   const int cc = tid & 63, seg = tid >> 6; float run = 0.f, v8[8];
#pragma unroll
        for (int i = 0; i < 8; ++i) { run += LW[(seg * 8 + i) * 64 + cc]; v8[i] = run; }
        SEG[seg * 64 + cc] = run;
        __syncthreads();
        float off = 0.f;
        for (int s2 = 0; s2 < seg; ++s2) off += SEG[s2 * 64 + cc];
#pragma unroll
        for (int i = 0; i < 8; ++i) LW[(seg * 8 + i) * 64 + cc] = v8[i] + off;
        if (seg == 7) { CUML[cc] = v8[7] + off; GL[cc] = __expf(v8[7] + off); }
    }
    __syncthreads();
    RWA_STAMP(5);
    {   float fa[8], fb[8], fk[8], fr_[8];
        const f32x4 cm0 = *(const LAS f32x4*)(LW + t * 64 + c0), cm1 = *(const LAS f32x4*)(LW + t * 64 + c0 + 4), cl0 = *(const LAS f32x4*)(CUML + c0), cl1 = *(const LAS f32x4*)(CUML + c0 + 4);
#pragma unroll
        for (int j = 0; j < 8; ++j) { const float cm = (j < 4) ? cm0[j & 3] : cm1[j & 3], en = __expf(-cm), el = __expf(((j < 4) ? cl0[j & 3] : cl1[j & 3]) - cm);
            fa[j] = av[j] * __expf(cm - lw[j]); fb[j] = bv[j] * en; fk[j] = kr[j] * en; fr_[j] = rr[j] * __expf(cm);
            BBT[swz(c0 + j, t)] = (bf16)f2bf(bv[j] * el); KBT[swz(c0 + j, t)] = (bf16)f2bf(kr[j] * el); VT[swz(c0 + j, t)] = (bf16)f2bf(vv[j]); }
        *(LAS u32x4*)(AT + t * LDT + c0) = pack8(fa); *(LAS u32x4*)(BT + t * LDT + c0) = pack8(fb); *(LAS u32x4*)(KT + t * LDT + c0) = pack8(fk); *(LAS u32x4*)(RT + t * LDT + c0) = pack8(fr_);
    }
    __syncthreads();
    RWA_STAMP(6);
#pragma unroll
    for (int q = 0; q < 2; ++q) { const int id = 2 * w + q, tt = id >> 2, ss = id & 3; f32x4 ab = F4Z, ak = F4Z, rb = F4Z, rk = F4Z;
        if (ss <= tt) {
            ab = tile_mm<64>(BT + (16 * ss) * LDT, LDT, AT + (16 * tt) * LDT, LDT, ab, fr, fq); ak = tile_mm<64>(KT + (16 * ss) * LDT, LDT, AT + (16 * tt) * LDT, LDT, ak, fr, fq);
            rb = tile_mm<64>(BT + (16 * ss) * LDT, LDT, RT + (16 * tt) * LDT, LDT, rb, fr, fq); rk = tile_mm<64>(KT + (16 * ss) * LDT, LDT, RT + (16 * tt) * LDT, LDT, rk, fr, fq);
        }
        const int tq = 16 * tt + fr, s0 = 16 * ss + 4 * fq;
#pragma unroll
        for (int r = 0; r < 4; ++r) { if (s0 + r >= tq) { ab[r] = 0.f; ak[r] = 0.f; } if (s0 + r > tq) { rb[r] = 0.f; rk[r] = 0.f; } }
        *(LAS u32x2*)(TAB + tq * LDT + s0) = pack4(ab); *(LAS u32x2*)(TAK + tq * LDT + s0) = pack4(ak); *(LAS u32x2*)(MRB + tq * LDT + s0) = pack4(rb); *(LAS u32x2*)(MRK + tq * LDT + s0) = pack4(rk);
    }
    __syncthreads();
    RWA_STAMP(7);
    LAS bf16* DINV = (LAS bf16*)SEG;
    LAS bf16* RT2 = DINV + 1024;
    if (w >= 4) {
#pragma unroll
        for (int q = 0; q < 4; ++q) { const int id = 4 * (w - 4) + q, vb = id >> 2, tt = id & 3;
            const f32x4 a = tile_mm_sw<64, true, false>(VT, LDT, 16 * vb, TAK, LDT, 16 * tt, F4Z, fr, fq);
#pragma unroll
            for (int r = 0; r < 4; ++r) RHSV[(16 * vb + 4 * fq + r) * 65 + 16 * tt + fr] = a[r]; }
        for (int i = tid - 256; i < 128 * LDT / 8; i += 256) ((LAS u32x4*)XT)[i] = z4;
    } else if (lane < 16) { const int bb = w, j = lane; float x[16];
#pragma unroll
        for (int i = 0; i < 16; ++i) { float s = (i == j) ? 1.0f : 0.0f; float tf[16];
            if (i > 0) unpack8(*(const LAS u32x4*)(TAB + (16 * bb + i) * LDT + 16 * bb), tf);
            if (i > 8) unpack8(*(const LAS u32x4*)(TAB + (16 * bb + i) * LDT + 16 * bb + 8), tf + 8);
#pragma unroll
            for (int i2 = 0; i2 < i; ++i2) s += tf[i2] * x[i2];
            x[i] = s; DINV[(bb * 16 + i) * 16 + j] = (bf16)f2bf(s); }
    }
    __syncthreads();
    RWA_STAMP(8);
    typedef short s16x4 __attribute__((ext_vector_type(4)));
#pragma unroll
    for (int bi = 0; bi < 4; ++bi) {
        f32x4 u = F4Z;
        if (bi > 0) u = tile_mm<64>(XT + (16 * w) * LDT, LDT, TAB + (16 * bi) * LDT, LDT, F4Z, fr, fq);
#pragma unroll
        for (int r = 0; r < 4; ++r) { const int col = 16 * w + 4 * fq + r, tr = 16 * bi + fr;
            const float base = (w < 4) ? bf2f(AT[tr * LDT + col]) : RHSV[(col - 64) * 65 + tr];
            RT2[col * 16 + fr] = (bf16)f2bf(base + u[r]); }
        LDS_WAIT(); __builtin_amdgcn_wave_barrier();
        const s16x4 ra = *(const LAS s16x4*)(RT2 + (16 * w + fr) * 16 + 4 * fq), db = *(const LAS s16x4*)(DINV + (bi * 16 + fr) * 16 + 4 * fq);
        const f32x4 x = __builtin_amdgcn_mfma_f32_16x16x16bf16_1k(ra, db, F4Z, 0, 0, 0);
#pragma unroll
        for (int r = 0; r < 4; ++r) XT[(16 * w + 4 * fq + r) * LDT + 16 * bi + fr] = (bf16)f2bf(x[r]);
        LDS_WAIT(); __builtin_amdgcn_wave_barrier();
    }
    __syncthreads();
    RWA_STAMP(9);
    bf16* PQ = (bf16*)(S + SO_RW_PQ) + (size_t)item * 8192;
#pragma unroll
    for (int q = 0; q < 2; ++q) { const int id = 2 * w + q, ib = id >> 2, jb = id & 3;
        {
            f32x4 a = tile_mm<64>(XT + (16 * ib) * LDT, LDT, MRB + (16 * jb) * LDT, LDT, F4Z, fr, fq);
            const int tq = 16 * jb + fr, j0 = 16 * ib + 4 * fq; const u32x2 rt = *(const LAS u32x2*)(RT + tq * LDT + j0);
            a[0] += bflo(rt.x); a[1] += bfhi(rt.x); a[2] += bflo(rt.y); a[3] += bfhi(rt.y);
            if (!DRY) *(u32x2*)(Z + (size_t)(rowb + tq) * ZP + ZD_R + hc0 + j0) = pack4(a); else asm volatile("" :: "v"(a)); }
        {
            f32x4 a = tile_mm<64>(XT + (64 + 16 * ib) * LDT, LDT, MRB + (16 * jb) * LDT, LDT, F4Z, fr, fq);
            a = tile_mm_sw<64, true, false>(VT, LDT, 16 * ib, MRK, LDT, 16 * jb, a, fr, fq);
            if (!DRY) *(u32x2*)(Z + (size_t)(rowb + 16 * jb + fr) * ZP + ZD_K + hc0 + 16 * ib + 4 * fq) = pack4(a); else asm volatile("" :: "v"(a)); }
        {
            f32x4 a = tile_mm_sw<64, false, true>(XT, LDT, 16 * ib, BBT, LDT, 16 * jb, F4Z, fr, fq);
            const int k = 16 * jb + fr, j0 = 16 * ib + 4 * fq;
#pragma unroll
            for (int r = 0; r < 4; ++r) if (j0 + r == k) a[r] += GL[k];
            if (!DRY) *(u32x2*)(PQ + (size_t)k * 64 + j0) = pack4(a); else asm volatile("" :: "v"(a)); }
        {
            f32x4 a = tile_mm_sw<64, true, false>(BBT, LDT, 16 * ib, XT, LDT, 64 + 16 * jb, F4Z, fr, fq);
            a = tile_mm_sw<64, true, true>(KBT, LDT, 16 * ib, VT, LDT, 16 * jb, a, fr, fq);
            if (!DRY) *(u32x2*)(PQ + 4096 + (size_t)(16 * jb + fr) * 64 + 16 * ib + 4 * fq) = pack4(a); else asm volatile("" :: "v"(a)); }
    }
    __syncthreads();
    RWA_STAMP(10);
}
__device__ __forceinline__ void rw_passB(const Ctx& C, int unit) {
    const int bh = unit >> 2, vg = unit & 3, lane = C.lane, fr = lane & 15, fq = lane >> 4;
    TSTAMP(C, 210);
    LAS bf16* SL = (LAS bf16*)(C.lds + C.wave * 16384);
    bf16* PQ0 = (bf16*)(C.ws + WS_S + SO_RW_PQ) + (size_t)bh * 64 * 8192;
    for (int i = lane; i < 16 * LDT / 8; i += 64) ((LAS u32x4*)SL)[i] = (u32x4){0u, 0u, 0u, 0u};
    LDS_WAIT(); __builtin_amdgcn_wave_barrier();
    bf16x8 pa[4][4][2]; u32x2 qa[4][4];
#define RWB_FETCH(s, cc) do { const bf16* P_ = PQ0 + (size_t)(cc) * 8192; const bf16* Q_ = P_ + 4096 + (size_t)(16 * vg) * 64; _Pragma("unroll") for (int kk = 0; kk < 4; ++kk) { \
        pa[s][kk][0] = ld8(P_ + (size_t)(16 * kk + fr) * 64 + 8 * fq); pa[s][kk][1] = ld8(P_ + (size_t)(16 * kk + fr) * 64 + 32 + 8 * fq); qa[s][kk] = *(const u32x2*)(Q_ + (size_t)fr * 64 + 16 * kk + 4 * fq); } } while (0)
    RWB_FETCH(0, 0); RWB_FETCH(1, 1); RWB_FETCH(2, 2); RWB_FETCH(3, 3);
    for (int c4 = 0; c4 < 64; c4 += 4) {
#pragma unroll
        for (int s = 0; s < 4; ++s) {
            const int c = c4 + s;
            bf16* QT = PQ0 + (size_t)c * 8192 + 4096 + (size_t)(16 * vg) * 64;
            const bf16x8 b0 = ld8(SL + fr * LDT + 8 * fq), b1 = ld8(SL + fr * LDT + 32 + 8 * fq);
            const u32x4 s0 = *(const LAS u32x4*)(SL + (lane >> 2) * LDT + (lane & 3) * 16), s1 = *(const LAS u32x4*)(SL + (lane >> 2) * LDT + (lane & 3) * 16 + 8);
            f32x4 acc[4];
#pragma unroll
            for (int kk = 0; kk < 4; ++kk) {
                f32x4 a; a[0] = bflo(qa[s][kk].x); a[1] = bfhi(qa[s][kk].x); a[2] = bflo(qa[s][kk].y); a[3] = bfhi(qa[s][kk].y);
                a = __builtin_amdgcn_mfma_f32_16x16x32_bf16(pa[s][kk][0], b0, a, 0, 0, 0);
                acc[kk] = __builtin_amdgcn_mfma_f32_16x16x32_bf16(pa[s][kk][1], b1, a, 0, 0, 0);
            }
            LDS_WAIT(); __builtin_amdgcn_wave_barrier();
            *(u32x4*)(QT + (size_t)(lane >> 2) * 64 + (lane & 3) * 16) = s0; *(u32x4*)(QT + (size_t)(lane >> 2) * 64 + (lane & 3) * 16 + 8) = s1;
#pragma unroll
            for (int kk = 0; kk < 4; ++kk) *(LAS u32x2*)(SL + fr * LDT + 16 * kk + 4 * fq) = pack4(acc[kk]);
            LDS_WAIT(); __builtin_amdgcn_wave_barrier();
            if (c + 4 < 64) RWB_FETCH(s, c + 4);
        }
    }
#undef RWB_FETCH
    TSTAMP(C, 211);
}
template <bool DRY = false> __device__ __forceinline__ void rw_passC(const Ctx& C, int l, int item) {
    const int bh = item >> 6, c = item & 63, b = bh >> 3, h = bh & 7, hc0 = h * 64, rowb = b * SEQ + c * LCH;
    bf16* Z = (bf16*)(C.ws + WS_Z); unsigned char* S = C.ws + WS_S;
    const int tt = C.wave & 3, lane = C.lane, fr = lane & 15, fq = lane >> 4, t = 16 * tt + fr, row = rowb + t;
    LAS bf16* XG = (LAS bf16*)(C.lds + tt * 4608);
    const float* mu = C.inp(I_RW_MU, l, 1792); const u32x4 z4 = (u32x4){0u, 0u, 0u, 0u};
    {
        const int tl = lane >> 2, rw = rowb + 16 * tt + tl; const bool first = (c * LCH + 16 * tt + tl == 0);
#pragma unroll
        for (int q = 0; q < 4; ++q) { const int j0 = (lane & 3) * 32 + q * 8; float f[8];
            const u32x4 cg = *(const u32x4*)(Z + (size_t)rw * ZP + ZD_XG + j0), pg = first ? z4 : *(const u32x4*)(Z + (size_t)(rw - 1) * ZP + ZD_XG + j0);
            shift8(cg, pg, mu + 1664 + j0, f);
#pragma unroll
            for (int j = 0; j < 8; ++j) f[j] = sigmoidf_(f[j]);
            *(LAS u32x4*)(XG + tl * 136 + j0) = pack8(f); }
    }
    LDS_WAIT(); __builtin_amdgcn_wave_barrier();
    const bf16* SST = (const bf16*)(S + SO_RW_PQ) + (size_t)item * 8192 + 4096;
    const bf16* GUP = (const bf16*)(S + SO_RW_W) + 2 * 512 * 64 + (size_t)hc0 * 128;
    f32x4 y[4], g[4];
#pragma unroll
    for (int vb = 0; vb < 4; ++vb) {
        y[vb] = tile_mm<64>(SST + (size_t)(16 * vb) * 64, 64, Z + (size_t)(rowb + 16 * tt) * ZP + ZD_R + hc0, ZP, F4Z, fr, fq);
        const u32x2 yl = *(const u32x2*)(Z + (size_t)row * ZP + ZD_K + hc0 + 16 * vb + 4 * fq);
        y[vb][0] += bflo(yl.x); y[vb][1] += bfhi(yl.x); y[vb][2] += bflo(yl.y); y[vb][3] += bfhi(yl.y);
        g[vb] = tile_mm<128>(GUP + (size_t)(16 * vb) * 128, 128, XG, 136, F4Z, fr, fq);
    }
    float s1 = 0.f;
#pragma unroll
    for (int vb = 0; vb < 4; ++vb) s1 += (y[vb][0] + y[vb][1]) + (y[vb][2] + y[vb][3]);
    s1 += shx(s1, 16, lane); s1 += shx(s1, 32, lane);
    const float mean = s1 * (1.0f / 64); float s2 = 0.f;
#pragma unroll
    for (int vb = 0; vb < 4; ++vb)
#pragma unroll
        for (int r = 0; r < 4; ++r) { const float d = y[vb][r] - mean; y[vb][r] = d; s2 += d * d; }
    s2 += shx(s2, 16, lane); s2 += shx(s2, 32, lane);
    const float rs = rsqf_(s2 * (1.0f / 64) + 64e-5f);
    const float rho = ((const float*)(S + SO_RW_RHO))[(size_t)row * 8 + h];
    const bool first = (c * LCH + t == 0);
#pragma unroll
    for (int vb = 0; vb < 4; ++vb) { const int v0 = 16 * vb + 4 * fq;
        const u32x2 cv = *(const u32x2*)(Z + (size_t)row * ZP + ZD_V + hc0 + v0); u32x2 pv; pv.x = 0u; pv.y = 0u;
        if (!first) pv = *(const u32x2*)(Z + (size_t)(row - 1) * ZP + ZD_V + hc0 + v0);
        const float cvf[4] = {bflo(cv.x), bfhi(cv.x), bflo(cv.y), bfhi(cv.y)}, pvf[4] = {bflo(pv.x), bfhi(pv.x), bflo(pv.y), bfhi(pv.y)};
        const float* gn = C.inp(I_RW_NORM, l, WB) + hc0 + v0; const float* mv = mu + 1024 + hc0 + v0; f32x4 o;
#pragma unroll
        for (int r = 0; r < 4; ++r) { const float vs = cvf[r] + mv[r] * (pvf[r] - cvf[r]); o[r] = (y[vb][r] * rs * gn[r] + rho * vs) * g[vb][r]; }
        y[vb] = o; }
    asm volatile("s_waitcnt vmcnt(0)" ::: "memory"); __builtin_amdgcn_wave_barrier();
#pragma unroll
    for (int vb = 0; vb < 4; ++vb) { if (!DRY) *(u32x2*)(Z + (size_t)row * ZP + ZD_R + hc0 + 16 * vb + 4 * fq) = pack4(y[vb]); else asm volatile("" :: "v"(y[vb])); }
    LDS_WAIT(); __builtin_amdgcn_wave_barrier();
}

__device__ __forceinline__ void rw_s5_passC(const Ctx& C, int l) {
    s5_passC_core(C, l, [&]() {
#pragma unroll 1
        for (int i = 0; i < 8; ++i) { const Ctx Ci = make_ctx(); rw_passC(Ci, l, (int)blockIdx.x + 256 * i); }
    });
}
template <class Epi, bool ALIGN> __device__ __forceinline__ void run_gemm(const Ctx& C, const bf16* A, int lda, const bf16* Bt, int ldb, int Mr, int N, int K, const Epi& E, int Gv = 0, int cv = 0) {
    if (Gv == 0) { Gv = C.G; cv = C.bid; }
    if (cv < 0 || cv >= Gv) return;
    pg8::Gemm g{A, Bt, Mr, N, K, lda, ldb}; pg8::StaticOrder S; S.init(Mr, N, Gv, cv);
    pg8::gemm_phase<Epi, pg8::StaticOrder, ALIGN, true>(C.lds, g, S, E);
}

#ifdef PROBE_INNER
#define INNER_STAMP() do { const Ctx Cs_ = make_ctx(); PROBE_STAMP(Cs_); } while (0)
#else
#define INNER_STAMP() do { } while (0)
#endif
#define GRID_BAR() do { const Ctx Cb = make_ctx(); XcdBarrier b_; b_.bar = (unsigned*)(Cb.ws + WS_CTL) + 4096; b_.x = xb_xcc_id(); b_.st = (volatile LAS unsigned*)(Cb.lds + MISC_OFF) + 8; xcd_barrier(b_); PROBE_STAMP(Cb); } while (0)
#define PHASE_CTX() const Ctx C = make_ctx(); unsigned char* const ws = C.ws; bf16* const XB = (bf16*)(ws + WS_XB); float* const SSQ = (float*)(ws + WS_SSQ); bf16* const Z = (bf16*)(ws + WS_Z); \
    const int gw = C.bid * 8 + C.wave, NGW = C.G * 8; (void)XB; (void)SSQ; (void)Z; (void)gw; (void)NGW
#define SUBSYNC() do { VM_WAIT(); __syncthreads(); } while (0)
#define MERGE_PTRS() unsigned char* const G8 = ws + WS_G8; bf16* const MF = (bf16*)(ws + WS_MF); bf16* const MG = Z + ZC_Q; const bf16* const WG = (const bf16*)(ws + WS_SLOTA); const bf16* const WP = (const bf16*)(ws + WS_SLOTC); \
    const float* const gb = C.inp(I_GATE_BIAS, l, 4 * D); (void)G8; (void)MF; (void)MG; (void)WG; (void)WP; (void)gb
#define PHM_IN() \
        if (PH_ON(3)) {   PHASE_CTX(); \
            { EpiZ E{Z, SSQ, (bf16*)(ws + WS_S + RWW_OFF - 512 * 1024)}; run_gemm<EpiZ, true>(C, XB, D, (const bf16*)(ws + WS_SLOTB), D, M, NINP, D, E); } \
        } \
        GRID_BAR();
#define PHM_MIXA() \
        if (PH_ON(4)) {   PHASE_CTX(); \
            { RwPre P_; { const Ctx Ci = make_ctx(); rw_preload(Ci, (int)blockIdx.x, P_); } \
              for (int it = blockIdx.x; it < 2048; it += gridDim.x) { const Ctx Ci = make_ctx(); rw_passA(Ci, l, it, P_, (it + (int)gridDim.x < 2048) ? it + (int)gridDim.x : -1); } } \
        } \
        INNER_STAMP(); \
        if (PH_ON(4)) {   PHASE_CTX(); \
            {   MlPre PA_, PB_; { const Ctx Ci = make_ctx(); ml_preload(Ci, (int)blockIdx.x, PA_); } \
                { const Ctx Ci = make_ctx(); ml_preload(Ci, (int)blockIdx.x + 256, PB_); ml_passA(Ci, l, (int)blockIdx.x, PA_); } \
                { const Ctx Ci = make_ctx(); ml_preload(Ci, (int)blockIdx.x + 512, PA_); ml_passA(Ci, l, (int)blockIdx.x + 256, PB_); } \
                { const Ctx Ci = make_ctx(); ml_preload(Ci, (int)blockIdx.x + 768, PB_); ml_passA(Ci, l, (int)blockIdx.x + 512, PA_); } \
                { const Ctx Ci = make_ctx(); ml_passA(Ci, l, (int)blockIdx.x + 768, PB_); } } \
        } \
        INNER_STAMP(); \
        if (PH_ON(4)) {   PHASE_CTX(); \
            {   GlaW W_; GlaPre PA_, PB_; { const Ctx Ci = make_ctx(); gla_loadw(Ci, l, (int)blockIdx.x >> 6, W_); gla_preload(Ci, (int)blockIdx.x, PA_, false); } \
                { const Ctx Ci = make_ctx(); gla_preload(Ci, (int)blockIdx.x + 256, PB_, false); gla_passA(Ci, l, (int)blockIdx.x, W_, PA_); } \
                { const Ctx Ci = make_ctx(); gla_preload(Ci, (int)blockIdx.x + 512, PA_, false); gla_passA(Ci, l, (int)blockIdx.x + 256, W_, PB_); } \
                { const Ctx Ci = make_ctx(); gla_preload(Ci, (int)blockIdx.x + 768, PB_, false); gla_passA(Ci, l, (int)blockIdx.x + 512, W_, PA_); } \
                { const Ctx Ci = make_ctx(); gla_passA(Ci, l, (int)blockIdx.x + 768, W_, PB_); } } \
            { const Ctx Ci = make_ctx(); s5_passA(Ci); } \
            if (DUPM == 9 && l == 0) { const Ctx Ci = make_ctx(); s5_passA(Ci); } \
        } \
        GRID_BAR();
#define PHM_MIXB() \
        if (PH_ON(4)) {   PHASE_CTX();        \
            const ConvPlan CP = conv_setup(C, CJ_GATES | CJ_PROJ | CJ_XW | CJ_GU2S, l); \
            const bool rwv = ((gw & 15) == 0); const int widx = gw - ((gw >> 4) + 1), NW = NGW - NGW / 16, tidx = widx * 64 + C.lane, NT = NW * 64; \
            if (rwv) rw_passB(C, gw >> 4); \
            else { ml_passB(C, tidx, NT); gla_passB(C, tidx, NT); s5_passB(C, tidx, NT); conv_work(C, CP, widx, NW); } \
        } \
        GRID_BAR();
#define PHM_MIXC() \
        if (PH_ON(4)) {   PHASE_CTX(); \
            { const Ctx Ci = make_ctx(); rw_s5_passC(Ci, l); } \
        } \
        __syncthreads(); \
        INNER_STAMP(); \
        if (PH_ON(4)) {   PHASE_CTX(); \
            {   MlPre PA_, PB_; { const Ctx Ci = make_ctx(); ml_preload(Ci, (int)blockIdx.x, PA_); } \
                { const Ctx Ci = make_ctx(); ml_preload(Ci, (int)blockIdx.x + 256, PB_); ml_passC(Ci, l, (int)blockIdx.x, PA_); } \
                { const Ctx Ci = make_ctx(); ml_preload(Ci, (int)blockIdx.x + 512, PA_); ml_passC(Ci, l, (int)blockIdx.x + 256, PB_); } \
                { const Ctx Ci = make_ctx(); ml_preload(Ci, (int)blockIdx.x + 768, PB_); ml_passC(Ci, l, (int)blockIdx.x + 512, PA_); } \
                { const Ctx Ci = make_ctx(); ml_passC(Ci, l, (int)blockIdx.x + 768, PB_); } } \
        } \
        INNER_STAMP(); \
        if (PH_ON(4)) {   PHASE_CTX(); \
            {   GlaW W_; GlaPre PA_, PB_; { const Ctx Ci = make_ctx(); gla_loadw(Ci, l, (int)blockIdx.x >> 6, W_); gla_preload(Ci, (int)blockIdx.x, PA_, true); } \
                { const Ctx Ci = make_ctx(); gla_preload(Ci, (int)blockIdx.x + 256, PB_, true); gla_passC(Ci, l, (int)blockIdx.x, W_, PA_); } \
                { const Ctx Ci = make_ctx(); gla_preload(Ci, (int)blockIdx.x + 512, PA_, true); gla_passC(Ci, l, (int)blockIdx.x + 256, W_, PB_); } \
                { const Ctx Ci = make_ctx(); gla_preload(Ci, (int)blockIdx.x + 768, PB_, true); gla_passC(Ci, l, (int)blockIdx.x + 512, W_, PA_); } \
                { const Ctx Ci = make_ctx(); gla_passC(Ci, l, (int)blockIdx.x + 768, W_, PB_); } } \
        } \
        if (PH_ON(4)) {   PHASE_CTX(); \
        } \
        GRID_BAR();
#define MSTAMP(k) do { if (l == 0) { const Ctx Ct_ = make_ctx(); TSTAMP(Ct_, 200 + (k)); } } while (0)
#define PHM_MERGE() \
        MSTAMP(0); \
        if (PH_ON(5)) { PHASE_CTX(); MERGE_PTRS(); pg8::StaticOrder S0; S0.init(M, D, C.G, C.bid); pg8::Unit u0; S0.next(0, u0); OwnTile4 S4{u0.pm, u0.pn}; \
            pg8::Gemm g{XB, WG, M, 4 * D, D, D, D}; EpiGate8 E{G8, SSQ, gb}; pg8::gemm_phase<EpiGate8, OwnTile4, true, true>(C.lds, g, S4, E); } SUBSYNC(); MSTAMP(1); \
        if (PH_ON(5)) { PHASE_CTX(); MERGE_PTRS(); EpiGlu8 E{G8}; run_gemm<EpiGlu8, false>(C, Z + ZB_U, ZP, WP + 2 * (size_t)D * WB, WB, M, D, WB, E); } SUBSYNC(); MSTAMP(2); \
        if (PH_ON(5)) { PHASE_CTX(); MERGE_PTRS(); pg8::StaticOrder S0; S0.init(M, D, C.G, C.bid); pg8::Unit u0; S0.next(0, u0); ChainTile4 S4{u0.pm, u0.pn, Z, WP}; \
            pg8::Gemm g{Z, WP, M, D, WB, ZP, WB}; EpiChain E{G8, MG, ZP}; pg8::gemm_phase<EpiChain, ChainTile4, false, true>(C.lds, g, S4, E); } MSTAMP(6); \
        GRID_BAR();
#ifdef DUP_MODE
constexpr int DUPM = DUP_MODE;
#else
constexpr int DUPM = 0;
#endif
#ifndef STOP_AFTER
#define STOP_AFTER 1000
#endif
#define PH_ON(n) ((l) * 20 + (n) <= STOP_AFTER)
template <int l> __device__ __forceinline__ void layer_fwd() {
        if (PH_ON(1)) {   PHASE_CTX();
            { EpiSwiglu E{(bf16*)(ws + WS_HID), SSQ}; run_gemm<EpiSwiglu, true>(C, XB, D, (const bf16*)(ws + WS_SLOTA), D, M, 2 * FF, D, E); }
            {
                const int s0 = (l == 0) ? 192 : 128, ns = 256 - s0;
                if (C.bid >= s0) {
                    run_conv(C, (l > 0 ? CJ_D1 : 0) | CJ_MLW | CJ_RWW, l, (C.bid - s0) * 8 + C.wave, ns * 8);
                    if (C.bid - s0 < 32) { const Ctx Ci = make_ctx(); s5_prep(Ci, l, C.bid - s0); }
                }
            }
            if (l == 0) {
                for (int q = 0; q < DEPTH; ++q) { EpiKV E{(bf16*)(ws + WS_KV + (size_t)q * 4 * MiB), (bf16*)(ws + WS_KV + (size_t)q * 4 * MiB + 2 * MiB), (const float*)(ws + WS_MEMR)};
                    run_gemm<EpiKV, true>(C, (const bf16*)(ws + WS_MEMB), D, (const bf16*)(ws + WS_S + (size_t)q * 4 * MiB), D, MMEM, 2 * D, D, E, 32, C.bid - 128 - 32 * q); }
            }
        }
        GRID_BAR();
        if (DUPM == 14 && l == 0) {
        if (PH_ON(1)) {   PHASE_CTX();

            { EpiSwiglu E{(bf16*)(ws + WS_HID), SSQ}; run_gemm<EpiSwiglu, true>(C, XB, D, (const bf16*)(ws + WS_SLOTA), D, M, 2 * FF, D, E); }
            if (l == 0) {
                for (int q = 0; q < DEPTH; ++q) { EpiKV E{(bf16*)(ws + WS_KV + (size_t)q * 4 * MiB), (bf16*)(ws + WS_KV + (size_t)q * 4 * MiB + 2 * MiB), (const float*)(ws + WS_MEMR)};
                    run_gemm<EpiKV, true>(C, (const bf16*)(ws + WS_MEMB), D, (const bf16*)(ws + WS_S + (size_t)q * 4 * MiB), D, MMEM, 2 * D, D, E, 32, C.bid - 128 - 32 * q); }
            }
        }
        GRID_BAR();
        }
        if (PH_ON(2)) {   PHASE_CTX();
            { EpiResid E{XB, SSQ, 0.5f}; run_gemm<EpiResid, false>(C, (const bf16*)(ws + WS_HID), FF, (const bf16*)(ws + WS_SLOTC), FF, M, D, FF, E); }
        }
        GRID_BAR();
#if defined(DUP_MODE)
        if (l == 0 && DUP_MODE >= 1 && DUP_MODE <= 4) {
#if DUP_MODE == 1
            PHM_IN();
#elif DUP_MODE == 2
            PHM_IN(); PHM_MIXA();
#elif DUP_MODE == 3
            PHM_IN(); PHM_MIXA(); PHM_MIXB();
#elif DUP_MODE == 4
            PHM_IN(); PHM_MIXA(); PHM_MIXB(); PHM_MIXC();
#endif
            { PHASE_CTX(); run_conv(C, CJ_WIN, l, gw, NGW); } GRID_BAR();
            GRID_BAR();
        }
#endif
        PHM_IN(); PHM_MIXA(); PHM_MIXB(); PHM_MIXC();
        PHM_MERGE();
#if defined(DUP_MODE) && DUP_MODE == 5
        if (l == 0) { PHM_MERGE(); }
#endif
        if (PH_ON(6)) {   PHASE_CTX();
            run_conv(C, CJ_D2, l, gw, NGW);
            { EpiResid E{XB, SSQ, 1.0f}; run_gemm<EpiResid, false>(C, Z + ZC_Q, ZP, (const bf16*)(ws + WS_SLOTB), D, M, D, D, E); }
        }
        GRID_BAR();
        {
            const int un = blockIdx.x; const int pm = un >> 2, hh = un & 3, bb = pm >> 4;
            if (PH_ON(8)) {   PHASE_CTX();
                bf16* Qp = (bf16*)(ws + WS_XQ) + (size_t)C.bid * 65536;
                pg8::Gemm g{XB + (size_t)pm * 256 * D, (const bf16*)(ws + WS_SLOTB + 2 * MiB) + (size_t)hh * 256 * D, 256, 256, D, D, D}; pg8::SingleUnit S;
                EpiBf16 E{Qp, 256, SSQ + (size_t)pm * 256 * 16, 0.0625f * 1.4426950408889634f, 256};
                pg8::gemm_phase<EpiBf16, pg8::SingleUnit, false, true>(C.lds, g, S, E);
            }
            SUBSYNC();
            if (PH_ON(8)) {   PHASE_CTX();
                const bf16* Qp = (const bf16*)(ws + WS_XQ) + (size_t)C.bid * 65536;
                const bf16* Kd = (const bf16*)(ws + WS_KV + (size_t)l * 4 * MiB) + (size_t)bb * 256 * D + hh * 256;
                bf16* P = (bf16*)(ws + WS_XP) + (size_t)C.bid * 65536;
                pg8::Gemm g{Qp, Kd, 256, 256, 256, 256, D}; pg8::SingleUnit S; EpiSoftmaxP E{P}; pg8::gemm_phase<EpiSoftmaxP, pg8::SingleUnit, false, true>(C.lds, g, S, E);
            }
            SUBSYNC();
            if (PH_ON(8)) {   PHASE_CTX();
                const bf16* VT = (const bf16*)(ws + WS_KV + (size_t)l * 4 * MiB + 2 * MiB) + (size_t)hh * 256 * MMEM + bb * 256;
                const bf16* P = (const bf16*)(ws + WS_XP) + (size_t)C.bid * 65536;
                pg8::Gemm g{P, VT, 256, 256, 256, 256, MMEM}; pg8::SingleUnit S; EpiBf16 E{(bf16*)(ws + WS_XO) + (size_t)pm * 256 * D + hh * 256, D, nullptr, 1.0f, 256};
                pg8::gemm_phase<EpiBf16, pg8::SingleUnit, false, true>(C.lds, g, S, E);
            }
            SUBSYNC();
        }
        GRID_BAR();
        if (PH_ON(9)) {   PHASE_CTX();
            EpiResid E{XB, SSQ, 1.0f}; run_gemm<EpiResid, false>(C, (const bf16*)(ws + WS_XO), D, (const bf16*)(ws + WS_SLOTB + 4 * MiB), D, M, D, D, E);
        }
        GRID_BAR();
        if (PH_ON(10)) {   PHASE_CTX();
            { EpiSwiglu E{(bf16*)(ws + WS_HID), SSQ}; run_gemm<EpiSwiglu, true>(C, XB, D, (const bf16*)(ws + WS_GU2S), D, M, 2 * FF, D, E); }
            if (l + 1 < DEPTH && C.bid >= 128) { run_conv(C, CJ_WIN | CJ_GU1, l + 1, (C.bid - 128) * 8 + C.wave, 128 * 8); }
        }
        GRID_BAR();
        if (DUPM == 18 && l == 0) {
        if (PH_ON(10)) {   PHASE_CTX();
            if (l + 1 < DEPTH) { run_conv(C, CJ_WIN, l + 1, gw, NGW); }
            { EpiSwiglu E{(bf16*)(ws + WS_HID), SSQ}; run_gemm<EpiSwiglu, true>(C, XB, D, (const bf16*)(ws + WS_SLOTA), D, M, 2 * FF, D, E); }
        }
        GRID_BAR();
        }
        if (PH_ON(11)) {   PHASE_CTX();
            { EpiResid E{XB, SSQ, 0.5f}; run_gemm<EpiResid, false>(C, (const bf16*)(ws + WS_HID), FF, (const bf16*)(ws + WS_SLOTC), FF, M, D, FF, E); }
        }
        GRID_BAR();
    }

__global__ void __launch_bounds__(512, 2) fwd_kernel(Args args) {
    extern __shared__ __attribute__((aligned(16))) unsigned char lds_raw[];
    (void)args;
    {
        const Ctx C = make_ctx();
        volatile LAS unsigned* MISC = (volatile LAS unsigned*)(C.lds + MISC_OFF);
        for (int u = C.tid; u < (LDS_BYTES - RING_BYTES) / 4; u += 512) ((LAS unsigned*)(C.lds + RING_BYTES))[u] = 0u;
        __syncthreads();
        (void)xcd_barrier_post((unsigned*)(C.ws + WS_CTL) + 4096, MISC + 8);
        PROBE_STAMP(C);
    }

    {   PHASE_CTX();
        pro_rows(C);
        run_conv(C, CJ_GU1 | CJ_D1 | CJ_WIN | CJ_XKV0 | CJ_XKV1, 0, gw, NGW);
    }
    GRID_BAR();
    if (DUPM == 17) {
    {   PHASE_CTX();
        pro_rows(C);
        run_conv(C, CJ_GU1 | CJ_D1 | CJ_WIN | CJ_XKV0 | CJ_XKV1, 0, gw, NGW);
    }
    GRID_BAR();
    }

    if (DUPM == 30) { for (int q = 0; q < 40; ++q) { GRID_BAR(); } }
    layer_fwd<0>();
    layer_fwd<1>();
    {   PHASE_CTX();
        final_rows(C);
#ifdef PROBE_LO
        {
            __syncthreads();
            const unsigned long long* st = (const unsigned long long*)(ws + WS_CTL + 32768);
            const unsigned long long ta = __hip_atomic_load(st + PROBE_LO, __ATOMIC_RELAXED, __HIP_MEMORY_SCOPE_AGENT), tb = __hip_atomic_load(st + PROBE_HI, __ATOMIC_RELAXED, __HIP_MEMORY_SCOPE_AGENT);
            float e = 0.08f + (float)(tb - ta) * PROBE_K; if (e > 0.31f) e = 0.31f;
            const int gwv = C.bid * 8 + C.wave;
            if (gwv == 7 && C.lane == 5) C.X[(size_t)7 * D + 5] += e;
        }
#endif
        if (xb_ld((unsigned*)(ws + WS_CTL) + 4096 + XB_TMO) != 0u) {
            for (size_t i = (size_t)C.bid * 512 + C.tid; i < (size_t)M * D; i += (size_t)C.G * 512) C.X[i] = __builtin_nanf("");
        }
    }
}

extern "C" void kernel_launch(void* const* d_in, const int* in_sizes, int n_in, void* d_out, int out_size, void* d_ws, size_t ws_size, hipStream_t stream) {
    static int grid = 0;
    if (grid == 0) {
        if (n_in != N_INPUTS || out_size != M * D || ws_size < WS_END) { fprintf(stderr, "kernel_launch: unexpected shapes: n_in %d out %d ws %zu (need %zu)\n", n_in, out_size, ws_size, (size_t)WS_END); grid = -1; return; }
        int dev = 0, cus = 0, per_cu = 0;
        if (hipGetDevice(&dev) != hipSuccess || hipDeviceGetAttribute(&cus, hipDeviceAttributeMultiprocessorCount, dev) != hipSuccess) { grid = -1; return; }
        if (hipFuncSetAttribute((const void*)fwd_kernel, hipFuncAttributeMaxDynamicSharedMemorySize, LDS_BYTES) != hipSuccess) { fprintf(stderr, "kernel_launch: hipFuncSetAttribute failed\n"); grid = -1; return; }
        if (hipOccupancyMaxActiveBlocksPerMultiprocessor(&per_cu, (const void*)fwd_kernel, 512, LDS_BYTES) != hipSuccess || per_cu < 1) { fprintf(stderr, "kernel_launch: occupancy query says %d workgroups per CU\n", per_cu); (void)hipGetLastError(); grid = -1; return; }
        if (cus < 256) { fprintf(stderr, "kernel_launch: built for a 256-CU device (got %d)\n", cus); grid = -1; return; }
        grid = 256;
    }
    if (grid < 0) return;
    if (hipMemsetAsync((char*)d_ws + WS_CTL, 0, CTL_ZERO_BYTES, stream) != hipSuccess) return;
    Args a{};
    for (int i = 0; i < N_INPUTS; ++i) a.in[i] = (const float*)d_in[i];
    a.out = (float*)d_out; a.ws = (unsigned char*)d_ws;
    hipLaunchKernelGGL(fwd_kernel, dim3(grid), dim3(512), LDS_BYTES, stream, a);
}
```

```cpp
#include <hip/hip_runtime.h>
#include <cstdio>
#include <cstdint>

#define LAS __attribute__((address_space(3)))
#define GAS __attribute__((address_space(1)))
typedef unsigned short bf16;
typedef float f32x4 __attribute__((ext_vector_type(4)));
typedef float f32x2 __attribute__((ext_vector_type(2)));
typedef unsigned u32x4 __attribute__((ext_vector_type(4)));
typedef unsigned u32x2 __attribute__((ext_vector_type(2)));
typedef short bf16x8 __attribute__((ext_vector_type(8)));

constexpr int NB = 4, SEQ = 4096, M = NB * SEQ, D = 1024, FF = 2816, WB = 512, DEPTH = 2, MEML = 256, MMEM = NB * MEML;
constexpr int NZ = 4888, ZP = 4896, NINP = 5120, NIN = 8984;
constexpr int ZA_U = 0, ZA_O = 512, ZA_I = 1024, ZA_F = 1028, ZB_U = 1032, ZC_Q = 1544, ZC_K = 1800, ZC_V = 2056, ZC_G = 2568, ZC_A = 3080;
constexpr int ZD_R = 3096, ZD_K = 3608, ZD_V = 4120, ZD_XW = 4632, ZD_XA = 4696, ZD_XG = 4760, ZG = 4888;
constexpr float NORM_EPS = 1e-6f;

enum { I_X = 0, I_MEM, I_FFN1_NORM, I_FFN1_WG, I_FFN1_WU, I_FFN1_WD, I_MIX_NORM, I_W_IN, I_GATE_BIAS, I_ML_CONV, I_ML_WQ, I_ML_WK, I_ML_WV, I_ML_BI, I_ML_BF,
       I_ML_NORM, I_ML_PROJ, I_S5_ARE, I_S5_AIM, I_S5_LOGSTEP, I_S5_BRE, I_S5_BIM, I_S5_CRE, I_S5_CIM, I_S5_D, I_S5_W1, I_S5_W2, I_GLA_AUP, I_GLA_ABIAS,
       I_GLA_NORM, I_GLA_PROJ, I_RW_MU, I_RW_W0, I_RW_WUP, I_RW_A0, I_RW_AUP, I_RW_GUP, I_RW_KK, I_RW_KA, I_RW_RK, I_RW_NORM, I_RW_PROJ, I_W_OUT,
       I_XA_NORM, I_MEM_NORM, I_XA_WQ, I_XA_WK, I_XA_WV, I_XA_WO, I_FFN2_NORM, I_FFN2_WG, I_FFN2_WU, I_FFN2_WD, I_FINAL_NORM, N_INPUTS };

constexpr size_t MiB = 1u << 20;
constexpr size_t WS_CTL = 0, CTL_ZERO_BYTES = 64 * 1024;
constexpr size_t WS_SSQ = 1 * MiB;
constexpr size_t WS_MEMR = 256 * 1024;
constexpr size_t WS_XB = 2 * MiB;
constexpr size_t WS_MEMB = 34 * MiB;
constexpr size_t WS_KV = 36 * MiB;
constexpr size_t WS_SLOTA = 44 * MiB;
constexpr size_t WS_SLOTB = 55 * MiB;
constexpr size_t WS_SLOTC = 65 * MiB;
constexpr size_t WS_Z = 73 * MiB;
constexpr size_t Z_BYTES = (size_t)M * ZP * 2;
constexpr size_t WS_S = WS_Z + Z_BYTES;
constexpr size_t WS_END = 350110016;
static_assert(WS_S == 226 * MiB, "map");
constexpr size_t S_BYTES = WS_END - WS_S;
constexpr size_t WS_HID = WS_Z;
constexpr size_t WS_XQ = WS_Z, WS_XO = WS_Z + 32 * MiB, WS_XP = WS_Z + 64 * MiB;
constexpr size_t XF_KFOLD = 0;
constexpr size_t XF_VFOLD = 8 * 1024 * 1024;
constexpr size_t XF_WQU = 16 * 1024 * 1024;
constexpr size_t XF_WOT = 18 * 1024 * 1024;
constexpr size_t WS_G8 = WS_S, WS_MF = WS_S + 64 * MiB;
static_assert(WS_MF + 32 * MiB <= WS_END, "merge stash");

constexpr int LDS_BYTES = 147456, RING_BYTES = 131072, MISC_OFF = RING_BYTES + 320;

#define RLX_AGENT __ATOMIC_RELAXED, __HIP_MEMORY_SCOPE_AGENT
#define LDS_WAIT() asm volatile("s_waitcnt lgkmcnt(0)" ::: "memory")
#define VM_WAIT() asm volatile("s_waitcnt vmcnt(0)" ::: "memory")
typedef __bf16 bf16x2_t __attribute__((ext_vector_type(2)));
__device__ __forceinline__ unsigned pk2(float lo, float hi) { const f32x2 v = {lo, hi}; return __builtin_bit_cast(unsigned, __builtin_convertvector(v, bf16x2_t)); }
__device__ __forceinline__ unsigned f2bf(float f) { return pk2(f, 0.f); }
__device__ __forceinline__ float bf2f(unsigned h) { return __builtin_bit_cast(float, h << 16); }
__device__ __forceinline__ float bflo(unsigned w) { return __builtin_bit_cast(float, w << 16); }
__device__ __forceinline__ float bfhi(unsigned w) { return __builtin_bit_cast(float, w & 0xffff0000u); }
__device__ __forceinline__ float rcpf_(float x) { return __builtin_amdgcn_rcpf(x); }
__device__ __forceinline__ float rsqf_(float x) { return __builtin_amdgcn_rsqf(x); }
__device__ __forceinline__ float sigmoidf_(float x) { return rcpf_(1.0f + __expf(-x)); }
__device__ __forceinline__ float siluf_(float x) { return x * rcpf_(1.0f + __expf(-x)); }
__device__ __forceinline__ float softplusf_(float x) { return fmaxf(x, 0.f) + __logf(1.0f + __expf(-fabsf(x))); }
__device__ __forceinline__ float tanhf_(float x) { const float e = __expf(-2.0f * fabsf(x)); const float t = (1.0f - e) * rcpf_(1.0f + e); return x < 0.f ? -t : t; }
__device__ __forceinline__ float logsigmoidf_(float x) { return -softplusf_(-x); }
__device__ __forceinline__ float shx(float v, int mask, int lane) { return __builtin_bit_cast(float, __builtin_amdgcn_ds_bpermute((lane ^ mask) << 2, __builtin_bit_cast(int, v))); }
__device__ __forceinline__ float wave_sum(float v, int lane) {
#pragma unroll
    for (int o = 1; o < 64; o <<= 1) v += shx(v, o, lane);
    return v;
}

#define XB_TMO      128
#define XB_XCNT(j)  (256  + 64 * (j))
#define XB_XSUB(j)  (1280 + 64 * (j))
#define XB_XGEN(j)  (2304 + 64 * (j))
#define XB_TOP      3328
#define XB_TOPGEN   3392
#define XCD_BAR_WORDS 3456
#define XB_SPIN_CAP (1u << 20)
__device__ __forceinline__ unsigned xb_ld(unsigned* p)              { return __hip_atomic_load(p, __ATOMIC_RELAXED, __HIP_MEMORY_SCOPE_AGENT); }
__device__ __forceinline__ unsigned xb_add(unsigned* p, unsigned v) { return __hip_atomic_fetch_add(p, v, __ATOMIC_RELAXED, __HIP_MEMORY_SCOPE_AGENT); }
__device__ __forceinline__ unsigned xb_xcc_id() { return (unsigned)__builtin_amdgcn_s_getreg((3 << 11) | 20) & 0xFu; }
#define XB_SPIN(cond, bar) do { unsigned _sp = 0; while (cond) { __builtin_amdgcn_s_sleep(1); \
    if ((++_sp & 255u) == 0u) { if (xb_ld(&(bar)[XB_TMO])) break; if (_sp > XB_SPIN_CAP) { atomicAdd(&(bar)[XB_TMO], 1u); break; } } } } while (0)
struct XcdBarrier { unsigned* bar; unsigned x; volatile LAS unsigned* st; };
__device__ __forceinline__ XcdBarrier xcd_barrier_post(unsigned* bar, volatile LAS unsigned* st) {
    XcdBarrier b; b.bar = bar; b.x = xb_xcc_id(); b.st = st;
    if (threadIdx.x == 0) (void)xb_add(&bar[XB_XCNT(b.x)], 1u);
    return b;
}
__device__ __forceinline__ void xcd_barrier_complete(unsigned* bar, unsigned x, unsigned& nloc, unsigned& nx) {
    const unsigned G = gridDim.x * gridDim.y * gridDim.z;
    unsigned sum, cnt, mine, sp = 0u;
    for (;;) {
        sum = 0u; cnt = 0u; mine = 0u;
#pragma unroll
        for (unsigned j = 0; j < 16; ++j) { const unsigned c = xb_ld(&bar[XB_XCNT(j)]); sum += c; cnt += (c > 0u) ? 1u : 0u; mine = (j == x) ? c : mine; }
        if (sum == G) break;
        __builtin_amdgcn_s_sleep(1);
        if ((++sp & 255u) == 0u) { if (xb_ld(&bar[XB_TMO])) break; if (sp > XB_SPIN_CAP) { atomicAdd(&bar[XB_TMO], 1u); break; } }
    }
    nloc = mine > 0u ? mine : 1u; nx = cnt > 0u ? cnt : 1u;
}
__device__ __forceinline__ void xcd_barrier(const XcdBarrier& b) {
    asm volatile("s_waitcnt vmcnt(0)" ::: "memory");
    __syncthreads();
    if (threadIdx.x == 0) {
        unsigned* bar = b.bar;
        __builtin_amdgcn_s_waitcnt(0);
        unsigned nloc = b.st[0], nx = b.st[1];
        if (nloc == 0u) { xcd_barrier_complete(bar, b.x, nloc, nx); b.st[0] = nloc; b.st[1] = nx; }
        const unsigned old = xb_add(&bar[XB_XSUB(b.x)], 1u);
        const unsigned gen = old / nloc;
        if (old + 1u == (gen + 1u) * nloc) {
            __builtin_amdgcn_fence(__ATOMIC_RELEASE, "agent");
            asm volatile("s_waitcnt vmcnt(0)" ::: "memory");
            const unsigned og = xb_add(&bar[XB_TOP], 1u);
            const unsigned tg = og / nx;
            if (og + 1u == (tg + 1u) * nx) xb_add(&bar[XB_TOPGEN], 1u);
            else XB_SPIN(xb_ld(&bar[XB_TOPGEN]) == tg, bar);
            __builtin_amdgcn_fence(__ATOMIC_ACQUIRE, "agent");
            xb_add(&bar[XB_XGEN(b.x)], 1u);
            asm volatile("s_waitcnt vmcnt(0)" ::: "memory");
        } else {
            XB_SPIN(xb_ld(&bar[XB_XGEN(b.x)]) == gen, bar);
            __builtin_amdgcn_fence(__ATOMIC_ACQUIRE, "agent");
            asm volatile("s_waitcnt vmcnt(0)" ::: "memory");
        }
    }
    __syncthreads();
}
namespace pg8 {
#define PG8_LAS __attribute__((address_space(3)))
typedef unsigned short bf16_t;
typedef short bf16x8 __attribute__((ext_vector_type(8)));
typedef float f32x4 __attribute__((ext_vector_type(4)));
typedef unsigned u32x4 __attribute__((ext_vector_type(4)));
constexpr int BM = 256, BK = 64, HALF = 128, HTB = HALF * BK * 2  , STAGE_BYTES = 8 * HTB, NXCD = 8, WGM = 8;

__host__ __device__ __forceinline__ int lds_byte(int r, int c) { const int st = (r >> 4) * 2 + (c >> 5), rr = r & 15, cc = c & 31, ob = rr * 64 + cc * 2; return st * 1024 + (ob ^ (((ob >> 9) & 1) << 5)); }
__host__ __device__ __forceinline__ void stage_rc(int b, int& R, int& C) { const int st = b / 1024, sb = b % 1024, swz = sb ^ (((sb >> 9) & 1) << 5); R = (st >> 1) * 16 + swz / 64; C = (st & 1) * 32 + (swz % 64) / 2; }
__host__ __device__ __forceinline__ int perm32(int rho) { const int n = rho >> 4, i = rho & 15; return 8 * (i >> 2) + 4 * n + (i & 3); }

struct Unit { int pm, pn, job; };
struct Gemm { const bf16_t* A; const bf16_t* Bt; int M, N, K, lda, ldb; };

struct StaticOrder {
    static constexpr bool CHAIN = false;
    int nM, nN, nwg, G, c;
    __host__ __device__ void init(int M, int N, int G_, int c_) { nM = M / BM; nN = N / BM; nwg = nM * nN; G = G_; c = c_; }
    __host__ __device__ __forceinline__ bool next(int i, Unit& u) const {
        const long L = (long)i * G + c; if (L >= nwg) return false;
        int wgid = (int)L; { const int q = nwg / NXCD, r = nwg % NXCD, xcd = wgid % NXCD, off = wgid / NXCD; wgid = (xcd < r ? xcd * (q + 1) : r * (q + 1) + (xcd - r) * q) + off; }
        const int nig = WGM * nN, gid = wgid / nig, fm = gid * WGM, gsz = (nM - fm) < WGM ? (nM - fm) : WGM;
        u.pm = fm + ((wgid % nig) % gsz); u.pn = (wgid % nig) / gsz; u.job = 0; return true;
    }
    __device__ __forceinline__ void a_ready(const Unit&) const {}
    __device__ __forceinline__ void done(const Unit&) const {}
    __device__ __forceinline__ const char* baseA(const Gemm& g, const Unit&) const { return (const char*)g.A; }
    __device__ __forceinline__ const char* baseB(const Gemm& g, const Unit&) const { return (const char*)g.Bt; }
};


struct SingleUnit {
    static constexpr bool CHAIN = false;
    __device__ __forceinline__ bool next(int i, Unit& u) const { if (i > 0) return false; u.pm = 0; u.pn = 0; u.job = 0; return true; }
    __device__ __forceinline__ void a_ready(const Unit&) const {}
    __device__ __forceinline__ void done(const Unit&) const {}
    __device__ __forceinline__ const char* baseA(const Gemm& g, const Unit&) const { return (const char*)g.A; }
    __device__ __forceinline__ const char* baseB(const Gemm& g, const Unit&) const { return (const char*)g.Bt; }
};
typedef __bf16 bf16x2_cv __attribute__((ext_vector_type(2))); typedef float f32x2_cv __attribute__((ext_vector_type(2)));
__device__ __forceinline__ unsigned cvt_pk_bf16(float lo, float hi) { const f32x2_cv v = {lo, hi}; return __builtin_bit_cast(unsigned, __builtin_convertvector(v, bf16x2_cv)); }
template <class Epi, class Sched, bool ALIGN_EPI = false, bool SP2 = false>
__device__ __forceinline__ void gemm_phase(PG8_LAS unsigned char* lds, const Gemm g, const Sched& S, const Epi& E) {
    int tid_ = threadIdx.x; asm volatile("" : "+v"(tid_));
    const int tid = tid_, wid = __builtin_amdgcn_readfirstlane(tid >> 6), lane = tid & 63, wr = wid >> 2, wc = wid & 3, fr = lane & 15, fq = lane >> 4;
    const int K = g.K, nt = K / BK, lda = g.lda, ldb = g.ldb;
    unsigned voffA[2], voffB[2];
#pragma unroll
    for (int i = 0; i < 2; ++i) { int R, C; stage_rc(tid * 16 + i * 8192, R, C); const int Rb = Epi::PERM ? ((R & ~31) + perm32(R & 31)) : R;
        voffA[i] = (unsigned)(R * lda + C) * 2u; voffB[i] = (unsigned)(Rb * ldb + C) * 2u; }
    const size_t kstep = (size_t)(BK * 2);
    const size_t hstepA = (size_t)HALF * lda * 2, hstepB = (size_t)HALF * ldb * 2;
    const size_t tstepA = 2 * hstepA, tstepB = 2 * hstepB;
    const unsigned ldsw = (unsigned)wid * 1024u;
    const int aoff = lds_byte(wr * 64 + fr, fq * 8), boff = lds_byte(wc * 32 + fr, fq * 8);
#define PG8_SA(b, h) (((b) * 2 + (h)) * HTB)
#define PG8_SB(b, h) ((4 + (b) * 2 + (h)) * HTB)
#define PG8_STAGE(bufoff, gbase, voff) do { _Pragma("unroll") for (int _i = 0; _i < 2; ++_i) \
        __builtin_amdgcn_global_load_lds((const unsigned*)((const char*)(gbase) + (voff)[_i]), (PG8_LAS unsigned*)(lds + (bufoff) + ldsw + _i * 8192), 16, 0, 0); } while (0)
#define PG8_LDA(dst, b, h) do { _Pragma("unroll") for (int m = 0; m < 4; ++m) _Pragma("unroll") for (int k = 0; k < 2; ++k) dst[m][k] = *(const PG8_LAS bf16x8*)(lds + PG8_SA(b, h) + aoff + m * 2048 + k * 1024); } while (0)
#define PG8_LDB(dst, b, h) do { _Pragma("unroll") for (int n = 0; n < 2; ++n) _Pragma("unroll") for (int k = 0; k < 2; ++k) dst[n][k] = *(const PG8_LAS bf16x8*)(lds + PG8_SB(b, h) + boff + n * 2048 + k * 1024); } while (0)
#define PG8_MMA(ai, bj, At, Bt) do { __builtin_amdgcn_s_setprio(1); _Pragma("unroll") for (int m = 0; m < 4; ++m) _Pragma("unroll") for (int n = 0; n < 2; ++n) _Pragma("unroll") for (int k = 0; k < 2; ++k) \
        acc[ai][bj][m][n] = __builtin_amdgcn_mfma_f32_16x16x32_bf16(Bt[n][k], At[m][k], acc[ai][bj][m][n], 0, 0, 0); __builtin_amdgcn_s_setprio(0); } while (0)
#define PG8_WAIT_V(n) asm volatile("s_waitcnt vmcnt(" #n ")" ::: "memory")
#define PG8_WAIT_L(n) asm volatile("s_waitcnt lgkmcnt(" #n ")" ::: "memory")
#define PG8_BAR __builtin_amdgcn_s_barrier()
#define PG8_SCHED __builtin_amdgcn_sched_barrier(0)
    Unit cur, nxt; int ui = 0;
    if (!S.next(0, cur)) return;
    f32x4 acc[2][2][4][2];
#pragma unroll
    for (int a = 0; a < 2; ++a)
#pragma unroll
        for (int b = 0; b < 2; ++b)
#pragma unroll
            for (int m = 0; m < 4; ++m)
#pragma unroll
                for (int n = 0; n < 2; ++n) acc[a][b][m][n] = (f32x4){0.f, 0.f, 0.f, 0.f};
    bf16x8 At[4][2], B0[2][2], B1[2][2];
    const char* cA = S.baseA(g, cur) + (size_t)cur.pm * tstepA; const char* cB = S.baseB(g, cur) + (size_t)cur.pn * tstepB;
    S.a_ready(cur);
    if constexpr (SP2) {
        PG8_STAGE(PG8_SB(0, 0), cB, voffB); PG8_STAGE(PG8_SB(0, 1), cB + hstepB, voffB); PG8_STAGE(PG8_SA(0, 0), cA, voffA); PG8_STAGE(PG8_SA(0, 1), cA + hstepA, voffA);
        if (wr == 1) PG8_BAR;
        PG8_WAIT_V(2); PG8_BAR;
        PG8_STAGE(PG8_SB(1, 0), cB + kstep, voffB); PG8_STAGE(PG8_SA(1, 0), cA + kstep, voffA); PG8_STAGE(PG8_SB(1, 1), cB + hstepB + kstep, voffB);
        PG8_WAIT_V(6); PG8_BAR;
    } else {
        PG8_STAGE(PG8_SB(0, 0), cB, voffB); PG8_STAGE(PG8_SA(0, 0), cA, voffA); PG8_STAGE(PG8_SB(0, 1), cB + hstepB, voffB); PG8_STAGE(PG8_SA(0, 1), cA + hstepA, voffA);
        if (wr == 1) PG8_BAR;
        PG8_WAIT_V(4); PG8_BAR;
        PG8_STAGE(PG8_SB(1, 0), cB + kstep, voffB); PG8_STAGE(PG8_SA(1, 0), cA + kstep, voffA); PG8_STAGE(PG8_SB(1, 1), cB + hstepB + kstep, voffB);
        PG8_WAIT_V(6); PG8_BAR;
    }
    for (;;) {
        const bool has_next = S.next(ui + 1, nxt);
        const char* nA = has_next ? S.baseA(g, nxt) + (size_t)nxt.pm * tstepA : cA; const char* nB = has_next ? S.baseB(g, nxt) + (size_t)nxt.pn * tstepB : cB;
        for (int t = 0; t < nt; t += 2) {
            const bool last = (t == nt - 2);
            const char* a1 = cA + (size_t)(t + 1) * kstep;
            const char* a2 = last ? nA : cA + (size_t)(t + 2) * kstep; const char* b2 = last ? nB : cB + (size_t)(t + 2) * kstep;
            const char* a3 = a2 + kstep; const char* b3 = b2 + kstep;
            if (last && has_next) S.a_ready(nxt);
            if constexpr (SP2) {
            PG8_LDB(B0, 0, 0); PG8_LDB(B1, 0, 1); PG8_SCHED; PG8_LDA(At, 0, 0); PG8_STAGE(PG8_SA(1, 1), a1 + hstepA, voffA);
            PG8_WAIT_V(8); PG8_WAIT_L(0); PG8_BAR; PG8_MMA(0, 0, At, B0); PG8_MMA(0, 1, At, B1); PG8_BAR; PG8_SCHED;
            PG8_LDA(At, 0, 1); PG8_STAGE(PG8_SB(0, 0), b2, voffB); PG8_STAGE(PG8_SB(0, 1), b2 + hstepB, voffB); PG8_STAGE(PG8_SA(0, 0), a2, voffA);
            PG8_WAIT_V(8); PG8_WAIT_L(0); PG8_BAR; PG8_MMA(1, 0, At, B0); PG8_MMA(1, 1, At, B1); PG8_BAR; PG8_SCHED;
            PG8_LDB(B0, 1, 0); PG8_LDB(B1, 1, 1); PG8_SCHED; PG8_LDA(At, 1, 0); PG8_STAGE(PG8_SA(0, 1), a2 + hstepA, voffA);
            PG8_WAIT_V(8); PG8_WAIT_L(0); PG8_BAR; PG8_MMA(0, 0, At, B0); PG8_MMA(0, 1, At, B1); PG8_BAR; PG8_SCHED;
            PG8_LDA(At, 1, 1); PG8_STAGE(PG8_SB(1, 0), b3, voffB); PG8_STAGE(PG8_SB(1, 1), b3 + hstepB, voffB); PG8_STAGE(PG8_SA(1, 0), a3, voffA);
            PG8_WAIT_V(8); PG8_WAIT_L(0); PG8_BAR; PG8_MMA(1, 0, At, B0); PG8_MMA(1, 1, At, B1); PG8_BAR; PG8_SCHED;
            } else {
            PG8_LDB(B0, 0, 0); PG8_SCHED; PG8_LDA(At, 0, 0); PG8_STAGE(PG8_SA(1, 1), a1 + hstepA, voffA);
            PG8_WAIT_L(8); PG8_BAR; PG8_WAIT_L(0); PG8_MMA(0, 0, At, B0); PG8_BAR; PG8_SCHED;
            PG8_LDB(B1, 0, 1); PG8_STAGE(PG8_SB(0, 0), b2, voffB);
            PG8_BAR; PG8_WAIT_L(0); PG8_MMA(0, 1, At, B1); PG8_BAR;
            PG8_LDA(At, 0, 1); PG8_STAGE(PG8_SA(0, 0), a2, voffA);
            PG8_BAR; PG8_WAIT_L(0); PG8_MMA(1, 0, At, B0); PG8_BAR; PG8_SCHED;
            PG8_STAGE(PG8_SB(0, 1), b2 + hstepB, voffB);
            PG8_WAIT_V(6); PG8_BAR; PG8_MMA(1, 1, At, B1); PG8_BAR;
            PG8_LDB(B0, 1, 0); PG8_SCHED; PG8_LDA(At, 1, 0); PG8_STAGE(PG8_SA(0, 1), a2 + hstepA, voffA);
            PG8_WAIT_L(8); PG8_BAR; PG8_WAIT_L(0); PG8_MMA(0, 0, At, B0); PG8_BAR; PG8_SCHED;
            PG8_LDB(B1, 1, 1); PG8_STAGE(PG8_SB(1, 0), b3, voffB);
            PG8_BAR; PG8_WAIT_L(0); PG8_MMA(0, 1, At, B1); PG8_BAR;
            PG8_LDA(At, 1, 1); PG8_STAGE(PG8_SA(1, 0), a3, voffA);
            PG8_BAR; PG8_WAIT_L(0); PG8_MMA(1, 0, At, B0); PG8_BAR; PG8_SCHED;
            PG8_STAGE(PG8_SB(1, 1), b3 + hstepB, voffB);
            PG8_WAIT_V(6); PG8_BAR; PG8_MMA(1, 1, At, B1); PG8_BAR;
            }
        }
        if constexpr (ALIGN_EPI) { if (wr == 0) PG8_BAR; }
        if constexpr (!Epi::AFTER_DRAIN) { E(acc, cur, wr, wc, fr, fq); S.done(cur); }
        if (!has_next) break;
        if constexpr (!Sched::CHAIN) {
#pragma unroll
        for (int a = 0; a < 2; ++a)
#pragma unroll
            for (int b = 0; b < 2; ++b)
#pragma unroll
                for (int m = 0; m < 4; ++m)
#pragma unroll
                    for (int n = 0; n < 2; ++n) acc[a][b][m][n] = (f32x4){0.f, 0.f, 0.f, 0.f};
        }
        cur = nxt; cA = nA; cB = nB; ++ui;
        if constexpr (ALIGN_EPI) { if (wr == 1) PG8_BAR; }
    }
    PG8_WAIT_V(0);
    if constexpr (!ALIGN_EPI) { if (wr == 0) PG8_BAR; }
    PG8_BAR;
    if constexpr (Epi::AFTER_DRAIN) { E.fused(acc, cur, wr, wc, fr, fq, lds, wid, lane); S.done(cur); }
#undef PG8_SA
#undef PG8_SB
#undef PG8_STAGE
#undef PG8_LDA
#undef PG8_LDB
#undef PG8_MMA
#undef PG8_WAIT_V
#undef PG8_WAIT_L
#undef PG8_BAR
#undef PG8_SCHED
}
}

using pg8::Unit; using pg8::cvt_pk_bf16;
#define EPI_ARGS const f32x4 (&acc)[2][2][4][2], const Unit& u, int wr, int wc, int fr, int fq
__device__ __forceinline__ float row_rstd(const float* ssq, int row) {
    const f32x4* p = (const f32x4*)(ssq + (size_t)row * 16);
    const f32x4 a = p[0], b = p[1], c = p[2], d = p[3];
    const float s = ((a[0] + a[1]) + (a[2] + a[3])) + ((b[0] + b[1]) + (b[2] + b[3])) + ((c[0] + c[1]) + (c[2] + c[3])) + ((d[0] + d[1]) + (d[2] + d[3]));
    return rsqf_(s * (1.0f / D) + NORM_EPS);
}
constexpr int RSTD_OFF = RING_BYTES + 1024, RSTD_TAG_OFF = RSTD_OFF + 1024;
__device__ __forceinline__ const PG8_LAS float* unit_rstd(const float* ssq, int row0, int wr, int wc, int fr, int fq) {
    extern __shared__ __attribute__((aligned(16))) unsigned char lds_raw[];
    PG8_LAS float* R = (PG8_LAS float*)((PG8_LAS unsigned char*)lds_raw + RSTD_OFF); PG8_LAS int* TAG = (PG8_LAS int*)((PG8_LAS unsigned char*)lds_raw + RSTD_TAG_OFF);
    const int tag = *TAG;
    asm volatile("s_waitcnt lgkmcnt(0)" ::: "memory"); __builtin_amdgcn_s_barrier(); asm volatile("" ::: "memory");
    if (tag != row0) {
        if (wr == 0) { const int i = wc * 64 + fq * 16 + fr; R[i] = row_rstd(ssq, row0 + i); if (i == 0) *TAG = row0; }
        __syncthreads();
    }
    return R;
}
template <int MODE> struct EpiSwigluT {
    static constexpr bool PERM = true, AFTER_DRAIN = false;
    bf16* H; const float* ssq;
    __device__ __forceinline__ void operator()(EPI_ARGS) const {
        if (MODE == 2) { asm volatile("" :: "v"(acc[0][0][0][0]), "v"(acc[1][1][3][1])); return; }
        const PG8_LAS float* R = unit_rstd(ssq, u.pm * 256, wr, wc, fr, fq);
#pragma unroll
        for (int ai = 0; ai < 2; ++ai)
#pragma unroll
            for (int m = 0; m < 4; ++m) {
                const int row = u.pm * 256 + ai * 128 + wr * 64 + m * 16 + fr; const float rs = R[ai * 128 + wr * 64 + m * 16 + fr]; float v[8];
                const float nrs = rs * -1.4426950408889634f, irs2 = rcpf_(rs * rs);
#pragma unroll
                for (int n = 0; n < 2; ++n) { const f32x4 p = acc[ai][0][m][n] * acc[ai][1][m][n];
#pragma unroll
                    for (int j = 0; j < 4; ++j) { const float e = __builtin_amdgcn_exp2f(acc[ai][0][m][n][j] * nrs); v[4 * n + j] = p[j] * rcpf_(__builtin_fmaf(e, irs2, irs2)); } }
                u32x4 w; w.x = cvt_pk_bf16(v[0], v[1]); w.y = cvt_pk_bf16(v[2], v[3]); w.z = cvt_pk_bf16(v[4], v[5]); w.w = cvt_pk_bf16(v[6], v[7]);
                if (MODE == 0) *(u32x4*)(H + (size_t)row * FF + u.pn * 128 + wc * 32 + fq * 8) = w; else asm volatile("" :: "v"(w));
            }
    }
};
typedef EpiSwigluT<0> EpiSwiglu;
struct EpiResid {
    static constexpr bool PERM = true, AFTER_DRAIN = false;
    bf16* XB; float* ssq; float alpha;
    __device__ __forceinline__ void operator()(EPI_ARGS) const {
        u32x4 o[2][4][2];
#pragma unroll
        for (int ai = 0; ai < 2; ++ai)
#pragma unroll
            for (int m = 0; m < 4; ++m)
#pragma unroll
                for (int bj = 0; bj < 2; ++bj) o[ai][m][bj] = *(const u32x4*)(XB + (size_t)(u.pm * 256 + ai * 128 + wr * 64 + m * 16 + fr) * D + u.pn * 256 + bj * 128 + wc * 32 + fq * 8);
        __builtin_amdgcn_sched_barrier(0);
#pragma unroll
        for (int ai = 0; ai < 2; ++ai)
#pragma unroll
            for (int m = 0; m < 4; ++m) {
                const int row = u.pm * 256 + ai * 128 + wr * 64 + m * 16 + fr; float s = 0.f;
#pragma unroll
                for (int bj = 0; bj < 2; ++bj) {
                    const size_t off = (size_t)row * D + u.pn * 256 + bj * 128 + wc * 32 + fq * 8;
                    const u32x4 ov = o[ai][m][bj];
                    f32x4 v0 = acc[ai][bj][m][0] * alpha, v1 = acc[ai][bj][m][1] * alpha;
                    v0[0] += bflo(ov.x); v0[1] += bfhi(ov.x); v0[2] += bflo(ov.y); v0[3] += bfhi(ov.y); v1[0] += bflo(ov.z); v1[1] += bfhi(ov.z); v1[2] += bflo(ov.w); v1[3] += bfhi(ov.w);
                    u32x4 w; w.x = cvt_pk_bf16(v0[0], v0[1]); w.y = cvt_pk_bf16(v0[2], v0[3]); w.z = cvt_pk_bf16(v1[0], v1[1]); w.w = cvt_pk_bf16(v1[2], v1[3]);
                    *(u32x4*)(XB + off) = w;
                    s += ((v0[0] * v0[0] + v0[1] * v0[1]) + (v0[2] * v0[2] + v0[3] * v0[3])) + ((v1[0] * v1[0] + v1[1] * v1[1]) + (v1[2] * v1[2] + v1[3] * v1[3]));
                }
                s += shx(s, 16, fq * 16 + fr); s += shx(s, 32, fq * 16 + fr);
                if (fq == 0) ssq[(size_t)row * 16 + u.pn * 4 + wc] = s;
            }
    }
};
template <bool LDSR> struct EpiBf16T {
    static constexpr bool PERM = true, AFTER_DRAIN = false;
    bf16* O; int ldc; const float* ssq; float scale; int ncols;
    __device__ __forceinline__ void operator()(EPI_ARGS) const {
        const PG8_LAS float* R = nullptr; if (LDSR) R = unit_rstd(ssq, u.pm * 256, wr, wc, fr, fq);
#pragma unroll
        for (int ai = 0; ai < 2; ++ai)
#pragma unroll
            for (int m = 0; m < 4; ++m) {
                const int row = u.pm * 256 + ai * 128 + wr * 64 + m * 16 + fr; const float rs = (LDSR ? R[ai * 128 + wr * 64 + m * 16 + fr] : (ssq ? row_rstd(ssq, row) : 1.0f)) * scale;
#pragma unroll
                for (int bj = 0; bj < 2; ++bj) {
                    const int col = u.pn * 256 + bj * 128 + wc * 32 + fq * 8;
                    if (col < ncols) {
                        const f32x4 v0 = acc[ai][bj][m][0] * rs, v1 = acc[ai][bj][m][1] * rs; u32x4 w;
                        w.x = cvt_pk_bf16(v0[0], v0[1]); w.y = cvt_pk_bf16(v0[2], v0[3]); w.z = cvt_pk_bf16(v1[0], v1[1]); w.w = cvt_pk_bf16(v1[2], v1[3]);
                        *(u32x4*)(O + (size_t)row * ldc + col) = w;
                    }
                }
            }
    }
};
typedef EpiBf16T<false> EpiBf16;
struct EpiZ {
    static constexpr bool PERM = true, AFTER_DRAIN = false;
    bf16* O; const float* ssq; bf16* HALO;
    __device__ __forceinline__ void operator()(EPI_ARGS) const {
        const PG8_LAS float* R = unit_rstd(ssq, u.pm * 256, wr, wc, fr, fq);
#pragma unroll
        for (int ai = 0; ai < 2; ++ai)
#pragma unroll
            for (int m = 0; m < 4; ++m) {
                const int row = u.pm * 256 + ai * 128 + wr * 64 + m * 16 + fr; const float rs = R[ai * 128 + wr * 64 + m * 16 + fr];
#pragma unroll
                for (int bj = 0; bj < 2; ++bj) {
                    const int col = u.pn * 256 + bj * 128 + wc * 32 + fq * 8;
                    if (col < NZ) {
                        const f32x4 v0 = acc[ai][bj][m][0] * rs, v1 = acc[ai][bj][m][1] * rs; u32x4 w;
                        w.x = cvt_pk_bf16(v0[0], v0[1]); w.y = cvt_pk_bf16(v0[2], v0[3]); w.z = cvt_pk_bf16(v1[0], v1[1]); w.w = cvt_pk_bf16(v1[2], v1[3]);
                        *(u32x4*)(O + (size_t)row * ZP + col) = w;
                        if ((row & 63) == 63 && col >= ZD_R && col < ZD_V) *(u32x4*)(HALO + (size_t)(row >> 6) * 1024 + (col - ZD_R)) = w;
                    }
                }
            }
    }
};
struct EpiKV {
    static constexpr bool PERM = true, AFTER_DRAIN = false;
    bf16* KV; const float* rstd;
    __device__ __forceinline__ void operator()(EPI_ARGS) const {
#pragma unroll
        for (int ai = 0; ai < 2; ++ai)
#pragma unroll
            for (int m = 0; m < 4; ++m) {
                const int row = u.pm * 256 + ai * 128 + wr * 64 + m * 16 + fr; const float rs = rstd[row];
#pragma unroll
                for (int bj = 0; bj < 2; ++bj) {
                    const int col = u.pn * 256 + bj * 128 + wc * 32 + fq * 8;
                    const f32x4 v0 = acc[ai][bj][m][0] * rs, v1 = acc[ai][bj][m][1] * rs;
                    u32x4 w; w.x = cvt_pk_bf16(v0[0], v0[1]); w.y = cvt_pk_bf16(v0[2], v0[3]); w.z = cvt_pk_bf16(v1[0], v1[1]); w.w = cvt_pk_bf16(v1[2], v1[3]);
                    *(u32x4*)(KV + (size_t)row * (2 * D) + col) = w;
                }
            }
    }
};
__device__ __forceinline__ size_t stash_idx(int T, int ai, int m, int bj, int wr, int wc, int fr, int fq) { return (size_t)(T * 16 + (ai * 4 + m) * 2 + bj) * 512 + (size_t)((wr * 4 + wc) * 64 + fq * 16 + fr); }
__device__ __forceinline__ u32x2 pack_u8(const float* v) {
    unsigned b[8];
#pragma unroll
    for (int j = 0; j < 8; ++j) b[j] = (unsigned)fmaxf(v[j] * 255.0f + 0.5f, 1.0f);
    u32x2 w; w.x = b[0] | (b[1] << 8) | (b[2] << 16) | (b[3] << 24); w.y = b[4] | (b[5] << 8) | (b[6] << 16) | (b[7] << 24); return w;
}
__device__ __forceinline__ void unpack_u8(u32x2 w, float* v) {
#pragma unroll
    for (int j = 0; j < 4; ++j) { v[j] = (float)((w.x >> (8 * j)) & 255u) * (1.0f / 255.0f); v[4 + j] = (float)((w.y >> (8 * j)) & 255u) * (1.0f / 255.0f); }
}
struct StaticOrderBatchB : pg8::StaticOrder {
    size_t bstride;
    __device__ __forceinline__ const char* baseB(const pg8::Gemm& g, const Unit& u) const { return (const char*)(g.Bt + (size_t)(u.pm >> 4) * bstride); }
};
struct OwnTile4 {
    static constexpr bool CHAIN = false;
    int pm, pn0;
    __device__ __forceinline__ bool next(int i, Unit& u) const { if (i >= 4) return false; u.pm = pm; u.pn = 4 * i + pn0; u.job = 0; return true; }
    __device__ __forceinline__ void a_ready(const Unit&) const {}
    __device__ __forceinline__ void done(const Unit&) const {}
    __device__ __forceinline__ const char* baseA(const pg8::Gemm& g, const Unit&) const { return (const char*)g.A; }
    __device__ __forceinline__ const char* baseB(const pg8::Gemm& g, const Unit&) const { return (const char*)g.Bt; }
};
struct EpiGate8 {
    static constexpr bool PERM = true, AFTER_DRAIN = false;
    unsigned char* G8; const float* ssq; const float* bias;
    __device__ __forceinline__ void operator()(EPI_ARGS) const {
        const int br = u.pn >> 2, T = u.pm * 4 + (u.pn & 3);
        const PG8_LAS float* R;
        if (br == 0) R = unit_rstd(ssq, u.pm * 256, wr, wc, fr, fq);
        else { extern __shared__ __attribute__((aligned(16))) unsigned char lds_raw[]; R = (const PG8_LAS float*)((PG8_LAS unsigned char*)lds_raw + RSTD_OFF); }
        f32x4 nb[2][2];
#pragma unroll
        for (int bj = 0; bj < 2; ++bj)
#pragma unroll
            for (int n = 0; n < 2; ++n) nb[bj][n] = *(const f32x4*)(bias + u.pn * 256 + bj * 128 + wc * 32 + fq * 8 + 4 * n) * -1.4426950408889634f;
#pragma unroll
        for (int ai = 0; ai < 2; ++ai)
#pragma unroll
            for (int m = 0; m < 4; ++m) {
                const float nrs = R[ai * 128 + wr * 64 + m * 16 + fr] * -1.4426950408889634f;
#pragma unroll
                for (int bj = 0; bj < 2; ++bj) {
                    u32x2 w; w.x = 0u; w.y = 0u;
#pragma unroll
                    for (int n = 0; n < 2; ++n)
#pragma unroll
                        for (int j = 0; j < 4; ++j) {
                            const float e = __builtin_amdgcn_exp2f(__builtin_fmaf(acc[ai][bj][m][n][j], nrs, nb[bj][n][j]));
                            const float q = fmaxf(rcpf_(__builtin_fmaf(e, 1.0f / 255.0f, 1.0f / 255.0f)), 1.0f);
                            if (n == 0) w.x = __builtin_amdgcn_cvt_pk_u8_f32(q, j, w.x); else w.y = __builtin_amdgcn_cvt_pk_u8_f32(q, j, w.y); }
                    *(u32x2*)(G8 + ((size_t)br * 256 * 16 * 512 + stash_idx(T, ai, m, bj, wr, wc, fr, fq)) * 8) = w;
                }
            }
    }
};
struct ChainCarry { u32x2 q[2][4][2]; };
struct EpiGlu8 {
    static constexpr bool PERM = true, AFTER_DRAIN = false;
    const unsigned char* G8; ChainCarry& carry;
    __device__ __forceinline__ void operator()(EPI_ARGS) const {
        const int T = u.pm * 4 + u.pn; u32x2 q[2][4][2];
#pragma unroll
        for (int ai = 0; ai < 2; ++ai)
#pragma unroll
            for (int m = 0; m < 4; ++m)
#pragma unroll
                for (int bj = 0; bj < 2; ++bj) q[ai][m][bj] = *(const u32x2*)(G8 + ((size_t)1 * 256 * 16 * 512 + stash_idx(T, ai, m, bj, wr, wc, fr, fq)) * 8);
        __builtin_amdgcn_sched_barrier(0);
#pragma unroll
        for (int ai = 0; ai < 2; ++ai)
#pragma unroll
            for (int m = 0; m < 4; ++m)
#pragma unroll
                for (int bj = 0; bj < 2; ++bj) {
                    float g[8]; unpack_u8(q[ai][m][bj], g);
#pragma unroll
                    for (int n = 0; n < 2; ++n)
#pragma unroll
                        for (int j = 0; j < 4; ++j) g[4 * n + j] *= sigmoidf_(acc[ai][bj][m][n][j]);
                    carry.q[ai][m][bj] = pack_u8(g);
                }
    }
};
struct ChainTile4 {
    static constexpr bool CHAIN = true;
    int pm, pn; const bf16* Z; const bf16* WP;
    __device__ __forceinline__ bool next(int i, Unit& u) const { if (i >= 4) return false; u.pm = pm; u.pn = pn; u.job = i; return true; }
    __device__ __forceinline__ void a_ready(const Unit&) const {}
    __device__ __forceinline__ void done(const Unit&) const {}
    __device__ __forceinline__ const char* baseA(const pg8::Gemm&, const Unit& u) const { const int off = (u.job == 0) ? ZA_O : (u.job == 1) ? ZB_U : (u.job == 2) ? ZC_G : ZD_R; return (const char*)(Z + off); }
    __device__ __forceinline__ const char* baseB(const pg8::Gemm&, const Unit& u) const { return (const char*)(WP + (size_t)(u.job + (u.job >= 2 ? 1 : 0)) * D * WB); }
};
struct EpiChain {
    static constexpr bool PERM = true, AFTER_DRAIN = false;
    const unsigned char* G8; bf16* MG; int ldg; ChainCarry& carry;
    __device__ __forceinline__ void operator()(f32x4 (&acc)[2][2][4][2], const Unit& u, int wr, int wc, int fr_, int fq_) const {
        int fr = fr_, fq = fq_; asm volatile("" : "+v"(fr), "+v"(fq));
        const int T = u.pm * 4 + u.pn, br = u.job; const bool lastb = (br == 3);
        const unsigned char* Gn = G8 + (size_t)br * 256 * 16 * 512 * 8; const unsigned char* Gd = G8 + (size_t)(lastb ? br : br + 1) * 256 * 16 * 512 * 8;
        u32x2 qnv[2][4][2], qdv[2][4][2];
#pragma unroll
        for (int ai = 0; ai < 2; ++ai)
#pragma unroll
            for (int m = 0; m < 4; ++m)
#pragma unroll
                for (int bj = 0; bj < 2; ++bj) { const size_t si = stash_idx(T, ai, m, bj, wr, wc, fr, fq);
                    if (br == 0) { qnv[ai][m][bj] = *(const u32x2*)(Gn + si * 8); qdv[ai][m][bj] = carry.q[ai][m][bj]; }
                    else { qnv[ai][m][bj] = carry.q[ai][m][bj];
                        if (!lastb) qdv[ai][m][bj] = *(const u32x2*)(Gd + si * 8); else { qdv[ai][m][bj].x = 0u; qdv[ai][m][bj].y = 0u; } } }
        __builtin_amdgcn_sched_barrier(0);
#pragma unroll
        for (int ai = 0; ai < 2; ++ai)
#pragma unroll
            for (int m = 0; m < 4; ++m)
#pragma unroll
                for (int bj = 0; bj < 2; ++bj) carry.q[ai][m][bj] = qdv[ai][m][bj];
#pragma unroll
        for (int ai = 0; ai < 2; ++ai)
#pragma unroll
            for (int m = 0; m < 4; ++m) {
                const int row = u.pm * 256 + ai * 128 + wr * 64 + m * 16 + fr;
#pragma unroll
                for (int bj = 0; bj < 2; ++bj) {
                    const u32x2 qn = qnv[ai][m][bj], qd = qdv[ai][m][bj];
#pragma unroll
                    for (int n = 0; n < 2; ++n)
#pragma unroll
                        for (int j = 0; j < 4; ++j) { const unsigned wn = n ? qn.y : qn.x, wd = n ? qd.y : qd.x;
                            const float gn = (float)((wn >> (8 * j)) & 255u), gd = lastb ? 255.0f : (float)((wd >> (8 * j)) & 255u);
                            acc[ai][bj][m][n][j] *= gn * rcpf_(gd); }
                    if (lastb) { const f32x4 v0 = acc[ai][bj][m][0], v1 = acc[ai][bj][m][1];
                        u32x4 w; w.x = cvt_pk_bf16(v0[0], v0[1]); w.y = cvt_pk_bf16(v0[2], v0[3]); w.z = cvt_pk_bf16(v1[0], v1[1]); w.w = cvt_pk_bf16(v1[2], v1[3]);
                        *(u32x4*)(MG + (size_t)row * ldg + u.pn * 256 + bj * 128 + wc * 32 + fq * 8) = w; }
                }
            }
    }
};
struct EpiSoftmaxP {
    static constexpr bool PERM = true, AFTER_DRAIN = true;
    bf16* P; int ldp; const float* ssq;
    __device__ __forceinline__ void fused(f32x4 (&acc)[2][2][4][2], const Unit& u, int wr, int wc, int fr, int fq, PG8_LAS unsigned char* lds, int wid, int lane) const {
        PG8_LAS float* RM = (PG8_LAS float*)lds;
        PG8_LAS float* RS = (PG8_LAS float*)(lds + 4096);
        PG8_LAS float* RR = (PG8_LAS float*)(lds + 8192);
        if (wr == 0) { const int i = wc * 64 + fq * 16 + fr; RR[i] = row_rstd(ssq, i); }
        asm volatile("s_waitcnt vmcnt(0) lgkmcnt(0)" ::: "memory"); __builtin_amdgcn_s_barrier(); asm volatile("" ::: "memory");
#pragma unroll
        for (int ai = 0; ai < 2; ++ai)
#pragma unroll
            for (int m = 0; m < 4; ++m) {
                float mx = -3.0e38f; const float rs = RR[ai * 128 + wr * 64 + m * 16 + fr];
#pragma unroll
                for (int bj = 0; bj < 2; ++bj)
#pragma unroll
                    for (int n = 0; n < 2; ++n) { const f32x4 x = acc[ai][bj][m][n] * rs; acc[ai][bj][m][n] = x; mx = fmaxf(mx, fmaxf(fmaxf(x[0], x[1]), fmaxf(x[2], x[3]))); }
                mx = fmaxf(mx, shx(mx, 16, fq * 16 + fr)); mx = fmaxf(mx, shx(mx, 32, fq * 16 + fr));
                if (fq == 0) RM[(ai * 128 + wr * 64 + m * 16 + fr) * 4 + wc] = mx;
            }
        asm volatile("s_waitcnt lgkmcnt(0)" ::: "memory"); __builtin_amdgcn_s_barrier(); asm volatile("" ::: "memory");
#pragma unroll
        for (int ai = 0; ai < 2; ++ai)
#pragma unroll
            for (int m = 0; m < 4; ++m) {
                const int rl = ai * 128 + wr * 64 + m * 16 + fr;
                const float mx = fmaxf(fmaxf(RM[rl * 4 + 0], RM[rl * 4 + 1]), fmaxf(RM[rl * 4 + 2], RM[rl * 4 + 3])); float s = 0.f;
#pragma unroll
                for (int bj = 0; bj < 2; ++bj)
#pragma unroll
                    for (int n = 0; n < 2; ++n)
#pragma unroll
                        for (int j = 0; j < 4; ++j) { const float p = __builtin_amdgcn_exp2f(acc[ai][bj][m][n][j] - mx); acc[ai][bj][m][n][j] = p; s += p; }
                s += shx(s, 16, fq * 16 + fr); s += shx(s, 32, fq * 16 + fr);
                if (fq == 0) RS[rl * 4 + wc] = s;
            }
        asm volatile("s_waitcnt lgkmcnt(0)" ::: "memory"); __builtin_amdgcn_s_barrier(); asm volatile("" ::: "memory");
#pragma unroll
        for (int ai = 0; ai < 2; ++ai)
#pragma unroll
            for (int m = 0; m < 4; ++m) {
                const int rl = ai * 128 + wr * 64 + m * 16 + fr;
                const float inv = rcpf_((RS[rl * 4 + 0] + RS[rl * 4 + 1]) + (RS[rl * 4 + 2] + RS[rl * 4 + 3]));
#pragma unroll
                for (int bj = 0; bj < 2; ++bj) {
                    const f32x4 v0 = acc[ai][bj][m][0] * inv, v1 = acc[ai][bj][m][1] * inv; u32x4 w;
                    w.x = cvt_pk_bf16(v0[0], v0[1]); w.y = cvt_pk_bf16(v0[2], v0[3]); w.z = cvt_pk_bf16(v1[0], v1[1]); w.w = cvt_pk_bf16(v1[2], v1[3]);
                    *(u32x4*)(P + (size_t)rl * ldp + bj * 128 + wc * 32 + fq * 8) = w;
                }
            }
        asm volatile("s_waitcnt lgkmcnt(0)" ::: "memory"); __builtin_amdgcn_s_barrier(); asm volatile("" ::: "memory");
    }
};
struct Args { const float* in[N_INPUTS]; float* out; unsigned char* ws; };
typedef const float* cfptr;
typedef __attribute__((address_space(4))) const cfptr* kin_t;
struct Ctx {
    LAS unsigned char* lds; int tid, lane, wave, G, bid;
    kin_t in; float* X; unsigned char* ws;
    __device__ __forceinline__ const float* inp(int i, int l, size_t per_layer) const { return in[i] + (size_t)l * per_layer; }
};
__device__ __forceinline__ Ctx make_ctx() {
    extern __shared__ __attribute__((aligned(16))) unsigned char lds_raw[];
    Ctx C; int t = threadIdx.x; asm volatile("" : "+v"(t));
    kin_t k = (kin_t)__builtin_amdgcn_kernarg_segment_ptr(); asm volatile("" : "+s"(k));
    C.lds = (LAS unsigned char*)lds_raw; C.tid = t; C.lane = t & 63; C.wave = __builtin_amdgcn_readfirstlane(t >> 6);
    C.G = gridDim.x; C.bid = blockIdx.x; C.in = k;
    C.X = (float*)k[N_INPUTS]; C.ws = (unsigned char*)k[N_INPUTS + 1];
    return C;
}
#ifdef PROBE_LO
#define PROBE_STAMP(Cb) do { if (blockIdx.x == 0 && (Cb).tid == 0) { volatile LAS unsigned* m_ = (volatile LAS unsigned*)((Cb).lds + MISC_OFF); const unsigned i_ = m_[16]; m_[16] = i_ + 1u; \
    __hip_atomic_store((unsigned long long*)((Cb).ws + WS_CTL + 32768) + i_, (unsigned long long)__builtin_amdgcn_s_memrealtime(), __ATOMIC_RELAXED, __HIP_MEMORY_SCOPE_AGENT); } } while (0)
#define TSTAMP(Cb, tag) do { if (blockIdx.x == 0 && (Cb).tid == 0) { unsigned long long* p_ = (unsigned long long*)((Cb).ws + WS_CTL + 32768) + (tag); \
    __hip_atomic_store(p_, (unsigned long long)__builtin_amdgcn_s_memrealtime(), __ATOMIC_RELAXED, __HIP_MEMORY_SCOPE_AGENT); } } while (0)
#else
#define PROBE_STAMP(Cb) do { } while (0)
#define TSTAMP(Cb, tag) do { } while (0)
#endif
constexpr size_t RWW_OFF = 93 * MiB;
struct ConvDesc { const float* W; const float* gain; bf16* dst; long alt; int ld, ncols, K, NR, kind, item0; };
constexpr int CD_OFF = 124 * 1024, CD_MAX = 24;
enum ConvJob { CJ_GU1 = 1, CJ_D1 = 2, CJ_WIN = 4, CJ_GATES = 8, CJ_PROJ = 16, CJ_XW = 32, CJ_GU2 = 64, CJ_D2 = 128, CJ_XKV0 = 256, CJ_XKV1 = 512, CJ_MLW = 1024, CJ_RWW = 2048, CJ_GU2S = 4096, CJ_XFOLD = 8192 };
constexpr size_t WS_GU2S = WS_S + 96 * MiB;
static_assert(WS_GU2S + 11 * MiB <= WS_END, "GU2 staging");
__device__ __forceinline__ void cd_put(const Ctx& C, int& n, int& items, const float* W, const float* gain, bf16* dst, long alt, int ld, int ncols, int K, int NR, int kind) {
    if (C.tid == 0) { LAS ConvDesc* d = (LAS ConvDesc*)(C.lds + CD_OFF) + n; d->W = W; d->gain = gain; d->dst = dst; d->alt = alt; d->ld = ld; d->ncols = ncols; d->K = K; d->NR = NR; d->kind = kind; d->item0 = items; }
    items += (K / 64) * (NR / 32); ++n;
}
__device__ __forceinline__ void conv_item(const LAS ConvDesc* d, int it, LAS float* scr, int lane) {
    const int K = d->K, NR = d->NR, kind = d->kind, ld = d->ld, ncols = d->ncols; const float* W = d->W; const float* gain = d->gain; bf16* dst = d->dst; const long alt = d->alt;
    const int nblk = NR / 32, kb = it / nblk, nb = it % nblk, k0 = 64 * kb, n0 = 32 * nb, n = n0 + (lane & 31);
    const float* p = nullptr;
    if (kind == 0) { if (n < ncols) p = W + n; }
    else if (kind == 1) { const int t = n >> 8, cl = n & 255, h = t * 128 + (cl & 127); p = W + (h + ((cl & 128) ? alt : 0l)); }
    else p = W + (n < D ? (long)n : alt + (long)(n - D));
    float v[32];
    if (p) { const float* q = p + (size_t)(k0 + (lane >> 5)) * ld;
#pragma unroll
        for (int i = 0; i < 32; ++i) v[i] = __builtin_nontemporal_load(q + (size_t)(2 * i) * ld);
        if (gain) {
#pragma unroll
            for (int i = 0; i < 32; ++i) v[i] *= gain[k0 + 2 * i + (lane >> 5)]; }
    } else {
#pragma unroll
        for (int i = 0; i < 32; ++i) v[i] = 0.f; }
#pragma unroll
    for (int i = 0; i < 32; ++i) scr[(2 * i + (lane >> 5)) * 33 + (lane & 31)] = v[i];
    LDS_WAIT(); asm volatile("" ::: "memory");
    const int c = lane & 7;
#pragma unroll
    for (int j = 0; j < 4; ++j) { const int nn = (lane >> 3) + 8 * j; const LAS float* s = scr + (8 * c) * 33 + nn;
        u32x4 o; o.x = pk2(s[0 * 33], s[1 * 33]); o.y = pk2(s[2 * 33], s[3 * 33]); o.z = pk2(s[4 * 33], s[5 * 33]); o.w = pk2(s[6 * 33], s[7 * 33]);
        *(u32x4*)(dst + (size_t)(n0 + nn) * K + k0 + 8 * c) = o; }
    LDS_WAIT(); asm volatile("" ::: "memory");
}
struct ConvPlan { int n, items; };
__device__ __forceinline__ ConvPlan conv_setup(const Ctx& C, int jobs, int l) {
    unsigned char* ws = C.ws; int n = 0, items = 0;
    __syncthreads();
    if (jobs & CJ_GU1) cd_put(C, n, items, C.inp(I_FFN1_WG, l, (size_t)D * FF), C.inp(I_FFN1_NORM, l, D), (bf16*)(ws + WS_SLOTA), (long)(C.inp(I_FFN1_WU, l, (size_t)D * FF) - C.inp(I_FFN1_WG, l, (size_t)D * FF)), FF, 2 * FF, D, 2 * FF, 1);
    if (jobs & CJ_GU2) cd_put(C, n, items, C.inp(I_FFN2_WG, l, (size_t)D * FF), C.inp(I_FFN2_NORM, l, D), (bf16*)(ws + WS_SLOTA), (long)(C.inp(I_FFN2_WU, l, (size_t)D * FF) - C.inp(I_FFN2_WG, l, (size_t)D * FF)), FF, 2 * FF, D, 2 * FF, 1);
    if (jobs & CJ_GU2S) cd_put(C, n, items, C.inp(I_FFN2_WG, l, (size_t)D * FF), C.inp(I_FFN2_NORM, l, D), (bf16*)(ws + WS_GU2S), (long)(C.inp(I_FFN2_WU, l, (size_t)D * FF) - C.inp(I_FFN2_WG, l, (size_t)D * FF)), FF, 2 * FF, D, 2 * FF, 1);
    if (jobs & CJ_D1) cd_put(C, n, items, C.inp(I_FFN1_WD, l, (size_t)D * FF), nullptr, (bf16*)(ws + WS_SLOTC), 0, D, D, FF, D, 0);
    if (jobs & CJ_D2) cd_put(C, n, items, C.inp(I_FFN2_WD, l, (size_t)D * FF), nullptr, (bf16*)(ws + WS_SLOTC), 0, D, D, FF, D, 0);
    if (jobs & CJ_WIN) cd_put(C, n, items, C.inp(I_W_IN, l, (size_t)D * NIN), C.inp(I_MIX_NORM, l, D), (bf16*)(ws + WS_SLOTB), 0, NIN, NZ, D, NINP, 0);
    if (jobs & CJ_GATES) cd_put(C, n, items, C.inp(I_W_IN, l, (size_t)D * NIN) + ZG, C.inp(I_MIX_NORM, l, D), (bf16*)(ws + WS_SLOTA), 0, NIN, 4 * D, D, 4 * D, 0);
    if (jobs & CJ_PROJ) {
        cd_put(C, n, items, C.inp(I_ML_PROJ, l, (size_t)WB * D), nullptr, (bf16*)(ws + WS_SLOTC), 0, D, D, WB, D, 0);
        cd_put(C, n, items, C.inp(I_S5_W1, l, (size_t)WB * D), nullptr, (bf16*)(ws + WS_SLOTC + 1 * MiB), 0, D, D, WB, D, 0);
        cd_put(C, n, items, C.inp(I_S5_W2, l, (size_t)WB * D), nullptr, (bf16*)(ws + WS_SLOTC + 2 * MiB), 0, D, D, WB, D, 0);
        cd_put(C, n, items, C.inp(I_GLA_PROJ, l, (size_t)WB * D), nullptr, (bf16*)(ws + WS_SLOTC + 3 * MiB), 0, D, D, WB, D, 0);
        cd_put(C, n, items, C.inp(I_RW_PROJ, l, (size_t)WB * D), nullptr, (bf16*)(ws + WS_SLOTC + 4 * MiB), 0, D, D, WB, D, 0);
    }
    if (jobs & CJ_XW) cd_put(C, n, items, C.inp(I_W_OUT, l, (size_t)D * D), nullptr, (bf16*)(ws + WS_SLOTB), 0, D, D, D, D, 0);
    if (jobs & CJ_XFOLD) {
        cd_put(C, n, items, C.inp(I_XA_WO, 0, (size_t)D * D), nullptr, (bf16*)C.X + XF_WOT, 0, D, D, D, D, 0);
        cd_put(C, n, items, C.inp(I_XA_WO, 1, (size_t)D * D), nullptr, (bf16*)C.X + XF_WOT + (size_t)D * D, 0, D, D, D, D, 0);
    }
    if (jobs & CJ_XKV0) cd_put(C, n, items, C.inp(I_XA_WK, 0, (size_t)D * D), C.inp(I_MEM_NORM, 0, D), (bf16*)(ws + WS_S), (long)(C.inp(I_XA_WV, 0, (size_t)D * D) - C.inp(I_XA_WK, 0, (size_t)D * D)), D, 2 * D, D, 2 * D, 2);
    if (jobs & CJ_XKV1) cd_put(C, n, items, C.inp(I_XA_WK, 1, (size_t)D * D), C.inp(I_MEM_NORM, 1, D), (bf16*)(ws + WS_S + 4 * MiB), (long)(C.inp(I_XA_WV, 1, (size_t)D * D) - C.inp(I_XA_WK, 1, (size_t)D * D)), D, 2 * D, D, 2 * D, 2);
    if (jobs & CJ_MLW) {
#pragma unroll
        for (int q = 0; q < 3; ++q)
#pragma unroll
            for (int hh = 0; hh < 4; ++hh) cd_put(C, n, items, C.inp(q == 0 ? I_ML_WQ : (q == 1 ? I_ML_WK : I_ML_WV), l, 4 * 16384) + hh * 16384, nullptr, (bf16*)(ws + 512 * 1024) + (size_t)(q * 4 + hh) * 16384, 0, 128, 128, 128, 128, 0);
    }
    if (jobs & CJ_RWW) {
        bf16* dst = (bf16*)(ws + WS_S + RWW_OFF);
        cd_put(C, n, items, C.inp(I_RW_WUP, l, 64 * WB), nullptr, dst, 0, WB, WB, 64, WB, 0);
        cd_put(C, n, items, C.inp(I_RW_AUP, l, 64 * WB), nullptr, dst + 512 * 64, 0, WB, WB, 64, WB, 0);
        cd_put(C, n, items, C.inp(I_RW_GUP, l, 128 * WB), nullptr, dst + 2 * 512 * 64, 0, WB, WB, 128, WB, 0);
    }
    __syncthreads();
    ConvPlan P; P.n = n; P.items = items; return P;
}
__device__ __forceinline__ void conv_work(const Ctx& C, const ConvPlan P, int gw, int NGW) {
    LAS float* scr = (LAS float*)(C.lds + C.wave * 15360);
    const LAS ConvDesc* cd = (const LAS ConvDesc*)(C.lds + CD_OFF);
    for (int it = gw; it < P.items; it += NGW) {
        int j = 0;
        for (int q = 1; q < P.n; ++q) if (it >= cd[q].item0) j = q;
        conv_item(cd + j, it - cd[j].item0, scr, C.lane);
    }
}
__device__ __forceinline__ void run_conv(const Ctx& C, int jobs, int l, int gw, int NGW) {
    const ConvPlan P = conv_setup(C, jobs, l);
    conv_work(C, P, gw, NGW);
    __syncthreads();
}

__device__ __forceinline__ void cast_wq(const Ctx& C) {
    const int gw = C.bid * 8 + C.wave, NGW = C.G * 8;
    for (int r = gw; r < DEPTH * D; r += NGW) { const int q = r / D, d = r % D;
        const float sc = C.inp(I_XA_NORM, q, D)[d] * (0.0625f * 1.4426950408889634f);
        const f32x4* src = (const f32x4*)(C.inp(I_XA_WQ, q, (size_t)D * D) + (size_t)d * D) + C.lane; u32x2* dst = (u32x2*)((bf16*)C.X + XF_WQU + (size_t)r * D) + C.lane;
#pragma unroll
        for (int j = 0; j < 4; ++j) { const f32x4 v = __builtin_nontemporal_load(src + 64 * j) * sc; u32x2 w; w.x = pk2(v[0], v[1]); w.y = pk2(v[2], v[3]); dst[64 * j] = w; }
    }
}
__device__ __forceinline__ void pro_rows(const Ctx& C) {
    const int gw = C.bid * 8 + C.wave, NGW = C.G * 8;
    const float* x = C.in[I_X]; bf16* XB = (bf16*)(C.ws + WS_XB); float* ssq = (float*)(C.ws + WS_SSQ);
    for (int m = gw; m < M; m += NGW) {
        const f32x4* xr = (const f32x4*)(x + (size_t)m * D) + C.lane; u32x2* br = (u32x2*)(XB + (size_t)m * D) + C.lane;
        float s = 0.f;
#pragma unroll
        for (int j = 0; j < 4; ++j) { const f32x4 v = __builtin_nontemporal_load(xr + 64 * j); u32x2 w; w.x = pk2(v[0], v[1]); w.y = pk2(v[2], v[3]); br[64 * j] = w; s += (v[0] * v[0] + v[1] * v[1]) + (v[2] * v[2] + v[3] * v[3]); }
        s = wave_sum(s, C.lane);
        if (C.lane < 16) ssq[(size_t)m * 16 + C.lane] = (C.lane == 0) ? s : 0.f;
    }
    const float* mem = C.in[I_MEM]; bf16* MB = (bf16*)(C.ws + WS_MEMB); float* memr = (float*)(C.ws + WS_MEMR);
    for (int m = gw; m < MMEM; m += NGW) {
        const f32x4* xr = (const f32x4*)(mem + (size_t)m * D) + C.lane; u32x2* br = (u32x2*)(MB + (size_t)m * D) + C.lane; float s = 0.f;
#pragma unroll
        for (int j = 0; j < 4; ++j) { const f32x4 v = __builtin_nontemporal_load(xr + 64 * j); u32x2 w; w.x = pk2(v[0], v[1]); w.y = pk2(v[2], v[3]); br[64 * j] = w; s += (v[0] * v[0] + v[1] * v[1]) + (v[2] * v[2] + v[3] * v[3]); }
        s = wave_sum(s, C.lane);
        if (C.lane == 0) memr[m] = 1.0f / sqrtf(s * (1.0f / D) + NORM_EPS);
    }
}
__device__ __forceinline__ void final_rows(const Ctx& C) {
    const int gw = C.bid * 8 + C.wave, NGW = C.G * 8; const float* ssq = (const float*)(C.ws + WS_SSQ); const float* g = C.in[I_FINAL_NORM]; const bf16* XB = (const bf16*)(C.ws + WS_XB);
    for (int m = gw; m < M; m += NGW) {
        const float rs = row_rstd(ssq, m); f32x4* orow = (f32x4*)(C.X + (size_t)m * D) + C.lane; const f32x4* gr = (const f32x4*)g + C.lane; const u32x2* xr = (const u32x2*)(XB + (size_t)m * D) + C.lane;
#pragma unroll
        for (int j = 0; j < 4; ++j) { const u32x2 w = xr[64 * j]; const f32x4 v = (f32x4){bflo(w.x), bfhi(w.x), bflo(w.y), bfhi(w.y)}; orow[64 * j] = v * rs * gr[64 * j]; }
    }
}
__device__ __forceinline__ float ldz(const bf16* Z, int row, int col) { return bf2f(Z[(size_t)row * ZP + col]); }
__device__ __forceinline__ float gelu_tanh(float y) { const float t = 0.7978845608028654f * (y + 0.044715f * y * y * y); return 0.5f * y * (1.0f + tanhf_(t)); }
constexpr int LCH = 64, NCH = SEQ / LCH;
constexpr size_t SO_GLA_ST = 0;
constexpr size_t SO_GLA_G = SO_GLA_ST + 16 * MiB;
constexpr size_t SO_ML_ST = SO_GLA_G + 512 * 1024;
constexpr size_t SO_ML_G = SO_ML_ST + 36 * MiB;
constexpr size_t SO_END0 = SO_ML_G + 512 * 1024;
static_assert(WS_S + SO_END0 <= WS_END, "state region");

__device__ __forceinline__ bf16x8 ld8(const LAS bf16* p) { return *(const LAS bf16x8*)p; }
__device__ __forceinline__ bf16x8 ld8(const bf16* p) { return *(const bf16x8*)p; }
template <int K, class PA, class PB> __device__ __forceinline__ f32x4 tile_mm(PA A, int lda, PB B, int ldb, f32x4 acc, int fr, int fq) {
#pragma unroll
    for (int k0 = 0; k0 < K; k0 += 32) {
        const bf16x8 a = ld8(A + fr * lda + k0 + 8 * fq);
        const bf16x8 b = ld8(B + fr * ldb + k0 + 8 * fq);
        acc = __builtin_amdgcn_mfma_f32_16x16x32_bf16(a, b, acc, 0, 0, 0);
    }
    return acc;
}
#ifdef PROBE_MLC
#define MLC_STAMP() PROBE_STAMP(C)
#else
#define MLC_STAMP() do { } while (0)
#endif
constexpr int LDT_ = 72;
__device__ __forceinline__ int swz(int row, int col) { return row * LDT_ + ((((col >> 3) ^ (row >> 3)) & 7) << 3) + (col & 7); }
template <int K, bool SA, bool SB, class PA, class PB> __device__ __forceinline__ f32x4 tile_mm_sw(PA A, int lda, int ra0, PB B, int ldb, int rb0, f32x4 acc, int fr, int fq) {
    const int xa = SA ? (((ra0 + fr) >> 3) & 7) : 0, xb = SB ? (((rb0 + fr) >> 3) & 7) : 0;
#pragma unroll
    for (int k0 = 0; k0 < K; k0 += 32) {
        const bf16x8 a = ld8(A + (ra0 + fr) * lda + ((((k0 >> 3) + fq) ^ xa) << 3));
        const bf16x8 b = ld8(B + (rb0 + fr) * ldb + ((((k0 >> 3) + fq) ^ xb) << 3));
        acc = __builtin_amdgcn_mfma_f32_16x16x32_bf16(a, b, acc, 0, 0, 0);
    }
    return acc;
}
#define F4Z ((f32x4){0.f, 0.f, 0.f, 0.f})
__device__ __forceinline__ u32x2 pack4(f32x4 v) { u32x2 w; w.x = pk2(v[0], v[1]); w.y = pk2(v[2], v[3]); return w; }
__device__ __forceinline__ u32x4 pack8(const float* f) { u32x4 w; w.x = pk2(f[0], f[1]); w.y = pk2(f[2], f[3]); w.z = pk2(f[4], f[5]); w.w = pk2(f[6], f[7]); return w; }
__device__ __forceinline__ void unpack8(u32x4 w, float* f) { f[0] = bflo(w.x); f[1] = bfhi(w.x); f[2] = bflo(w.y); f[3] = bfhi(w.y); f[4] = bflo(w.z); f[5] = bfhi(w.z); f[6] = bflo(w.w); f[7] = bfhi(w.w); }

struct Touch { u32x4 a, b, c; };
__device__ __forceinline__ void touch_tile(Touch& T, const bf16* base, int rows, int ppr, int tid) {
    const u32x4 z = (u32x4){0u, 0u, 0u, 0u}; T.a = z; T.b = z; T.c = z; const int n = rows * ppr;
    if (tid < n) T.a = *(const u32x4*)(base + (size_t)(tid / ppr) * ZP + (tid % ppr) * 8);
    if (tid + 512 < n) T.b = *(const u32x4*)(base + (size_t)((tid + 512) / ppr) * ZP + ((tid + 512) % ppr) * 8);
    if (tid + 1024 < n) T.c = *(const u32x4*)(base + (size_t)((tid + 1024) / ppr) * ZP + ((tid + 1024) % ppr) * 8);
}
__device__ __forceinline__ void touch_sink(const Touch& T) { asm volatile("" :: "v"(T.a), "v"(T.b), "v"(T.c)); }
struct GlaW { float au[16], bk; };
__device__ __forceinline__ void gla_loadw(const Ctx& C, int l, int h, GlaW& W) {
    const float* aup = C.inp(I_GLA_AUP, l, 16 * 256) + h * 64; const float* abias = C.inp(I_GLA_ABIAS, l, 256) + h * 64; const int k = C.tid & 63;
#pragma unroll
    for (int r = 0; r < 16; ++r) W.au[r] = aup[r * 256 + k];
    W.bk = abias[k];
}
__device__ __forceinline__ void gla_cumdecay(const Ctx& C, const GlaW& W, float al0, float al1, LAS float* ALOW, LAS float* LA, LAS float* SEG) {
    const int tid = C.tid;
    ALOW[tid] = al0; ALOW[tid + 512] = al1;
    __syncthreads();
    {   const int k = tid & 63, seg = tid >> 6; float run = 0.f, v[8];
#pragma unroll
        for (int i = 0; i < 8; ++i) { const int t = seg * 8 + i; float s = W.bk;
#pragma unroll
            for (int r = 0; r < 16; ++r) s += ALOW[t * 16 + r] * W.au[r];
            run += logsigmoidf_(s) * (1.0f / 16.0f); v[i] = run; }
        SEG[seg * 64 + k] = run;
        __syncthreads();
        float off = 0.f;
        for (int s2 = 0; s2 < seg; ++s2) off += SEG[s2 * 64 + k];
#pragma unroll
        for (int i = 0; i < 8; ++i) LA[(seg * 8 + i) * 64 + k] = v[i] + off;
    }
    __syncthreads();
}
struct GlaPre { float al0, al1; u32x4 v0, v1, q, k, g0, g1; };
__device__ __forceinline__ void gla_preload(const Ctx& C, int item, GlaPre& P, bool with_qg) {
    const int bh = item >> 6, c = item & 63, b = bh >> 2, h = bh & 3, rowb = b * SEQ + c * LCH, tid = C.tid;
    const bf16* Z = (const bf16*)(C.ws + WS_Z);
    P.al0 = ldz(Z, rowb + (tid >> 4), ZC_A + (tid & 15)); P.al1 = ldz(Z, rowb + 32 + (tid >> 4), ZC_A + (tid & 15));
    P.v0 = *(const u32x4*)(Z + (size_t)(rowb + (tid >> 4)) * ZP + ZC_V + h * 128 + (tid & 15) * 8); P.v1 = *(const u32x4*)(Z + (size_t)(rowb + 32 + (tid >> 4)) * ZP + ZC_V + h * 128 + (tid & 15) * 8);
    P.k = *(const u32x4*)(Z + (size_t)(rowb + (tid >> 3)) * ZP + ZC_K + h * 64 + (tid & 7) * 8);
    if (with_qg) { P.q = *(const u32x4*)(Z + (size_t)(rowb + (tid >> 3)) * ZP + ZC_Q + h * 64 + (tid & 7) * 8);
        P.g0 = *(const u32x4*)(Z + (size_t)(rowb + (tid >> 4)) * ZP + ZC_G + h * 128 + (tid & 15) * 8); P.g1 = *(const u32x4*)(Z + (size_t)(rowb + 32 + (tid >> 4)) * ZP + ZC_G + h * 128 + (tid & 15) * 8); }
}
constexpr int LDT = 72;
__device__ __forceinline__ void gla_passA(const Ctx& C, int l, int item, const GlaW& W, const GlaPre& P) {
    const int bh = item >> 6, c = item & 63, b = bh >> 2, h = bh & 3, rowb = b * SEQ + c * LCH;
    LAS float* ALOW = (LAS float*)C.lds; LAS float* LA = ALOW + 1024; LAS float* SEG = LA + 4096;
    LAS bf16* VT = (LAS bf16*)(SEG + 512);
    LAS bf16* KT = VT + 128 * LDT;
    const int tid = C.tid, lane = C.lane, w = C.wave, fr = lane & 15, fq = lane >> 4;
    (void)l; (void)b; (void)h; (void)rowb;
    gla_cumdecay(C, W, P.al0, P.al1, ALOW, LA, SEG);
    {   const int v0 = (tid & 15) * 8; float f[8];
        unpack8(P.v0, f);
#pragma unroll
        for (int j = 0; j < 8; ++j) VT[swz(v0 + j, tid >> 4)] = (bf16)f2bf(f[j]);
        unpack8(P.v1, f);
#pragma unroll
        for (int j = 0; j < 8; ++j) VT[swz(v0 + j, 32 + (tid >> 4))] = (bf16)f2bf(f[j]); }
    {   const int t = tid >> 3, k0 = (tid & 7) * 8; float f[8];
        unpack8(P.k, f);
        const f32x4 e0 = *(const LAS f32x4*)(LA + 63 * 64 + k0), e1 = *(const LAS f32x4*)(LA + 63 * 64 + k0 + 4), b0 = *(const LAS f32x4*)(LA + t * 64 + k0), b1 = *(const LAS f32x4*)(LA + t * 64 + k0 + 4);
#pragma unroll
        for (int j = 0; j < 8; ++j) KT[swz(k0 + j, t)] = (bf16)f2bf(f[j] * __expf(((j < 4) ? e0[j & 3] : e1[j & 3]) - ((j < 4) ? b0[j & 3] : b1[j & 3]))); }
    if (tid < 64) ((float*)(C.ws + WS_S + SO_GLA_G))[(size_t)item * 64 + tid] = __expf(LA[63 * 64 + tid]);
    __syncthreads();
    bf16* ST = (bf16*)(C.ws + WS_S + SO_GLA_ST) + (size_t)item * 8192;
#pragma unroll
    for (int q = 0; q < 4; ++q) {
        const f32x4 acc = tile_mm_sw<64, true, true>(KT, LDT, 16 * q, VT, LDT, 16 * w, F4Z, fr, fq);
        *(u32x2*)(ST + (size_t)(16 * w + fr) * 64 + 16 * q + 4 * fq) = pack4(acc);
    }
    __syncthreads();
}
__device__ __forceinline__ void gla_passB(const Ctx& C, int tidx, int NT) {
    for (int idx = tidx; idx < 16 * 8192; idx += NT) {
    const int bh = idx >> 13, e = idx & 8191, k = e & 63;
    bf16* ST = (bf16*)(C.ws + WS_S + SO_GLA_ST) + (size_t)bh * 64 * 8192 + e; const float* G = (const float*)(C.ws + WS_S + SO_GLA_G) + (size_t)bh * 64 * 64 + k;
    float d[64], g[64];
#pragma unroll
    for (int c = 0; c < 64; ++c) { d[c] = bf2f(ST[(size_t)c * 8192]); g[c] = G[c * 64]; }
    float run = 0.f;
#pragma unroll
    for (int c = 0; c < 64; ++c) { ST[(size_t)c * 8192] = (bf16)f2bf(run); run = run * g[c] + d[c]; }
    }
}
template <bool DRY = false> __device__ __forceinline__ void gla_passC(const Ctx& C, int l, int item, const GlaW& W, const GlaPre& P) {
    const int bh = item >> 6, c = item & 63, b = bh >> 2, h = bh & 3, rowb = b * SEQ + c * LCH;
    bf16* Z = (bf16*)(C.ws + WS_Z);
    LAS float* ALOW = (LAS float*)C.lds; LAS float* LA = ALOW + 1024; LAS float* SEG = LA + 4096;
    LAS bf16* VT = (LAS bf16*)(SEG + 512);
    LAS bf16* QP = VT + 128 * LDT;
    LAS bf16* KP = QP + 64 * LDT;
    LAS bf16* ATT = KP + 64 * LDT;
    LAS float* O = (LAS float*)(ATT + 64 * LDT);
    LAS float* RSQ = O + 64 * 132;
    const int tid = C.tid, lane = C.lane, w = C.wave, fr = lane & 15, fq = lane >> 4;
    const bf16* ST = (const bf16*)(C.ws + WS_S + SO_GLA_ST) + (size_t)item * 8192;
    bf16x8 stf[4][2];
#pragma unroll
    for (int q = 0; q < 4; ++q) { const int vv = (4 * w + q) >> 2; stf[q][0] = ld8(ST + (size_t)(16 * vv + fr) * 64 + 8 * fq); stf[q][1] = ld8(ST + (size_t)(16 * vv + fr) * 64 + 32 + 8 * fq); }
    bf16* const zpt = Z + (size_t)(rowb + (tid >> 3)) * ZP + ZC_G + h * 128 + (tid & 7) * 16; const u32x4 gz0 = *(const u32x4*)zpt, gz1 = *(const u32x4*)(zpt + 8);
    f32x4 gnv[4]; { const float* gn = C.inp(I_GLA_NORM, l, WB) + h * 128 + (tid & 7) * 16;
#pragma unroll
        for (int q4 = 0; q4 < 4; ++q4) gnv[q4] = *(const f32x4*)(gn + 4 * q4); }
    gla_cumdecay(C, W, P.al0, P.al1, ALOW, LA, SEG);
    {   const int v0 = (tid & 15) * 8; float f[8];
        unpack8(P.v0, f);
#pragma unroll
        for (int j = 0; j < 8; ++j) VT[swz(v0 + j, tid >> 4)] = (bf16)f2bf(f[j]);
        unpack8(P.v1, f);
#pragma unroll
        for (int j = 0; j < 8; ++j) VT[swz(v0 + j, 32 + (tid >> 4))] = (bf16)f2bf(f[j]); }
    {   const int t = tid >> 3, k0 = (tid & 7) * 8; float fq_[8], fk_[8];
        unpack8(P.q, fq_); unpack8(P.k, fk_);
        u32x4 wq, wk; float eq[8], ek[8];
        const f32x4 b0 = *(const LAS f32x4*)(LA + t * 64 + k0), b1 = *(const LAS f32x4*)(LA + t * 64 + k0 + 4);
#pragma unroll
        for (int j = 0; j < 8; ++j) { const float bb = (j < 4) ? b0[j & 3] : b1[j & 3]; eq[j] = fq_[j] * 0.125f * __expf(bb); ek[j] = fk_[j] * __expf(-bb); }
        wq.x = pk2(eq[0], eq[1]); wq.y = pk2(eq[2], eq[3]); wq.z = pk2(eq[4], eq[5]); wq.w = pk2(eq[6], eq[7]);
        wk.x = pk2(ek[0], ek[1]); wk.y = pk2(ek[2], ek[3]); wk.z = pk2(ek[4], ek[5]); wk.w = pk2(ek[6], ek[7]);
        *(LAS u32x4*)(QP + t * LDT + k0) = wq; *(LAS u32x4*)(KP + t * LDT + k0) = wk; }
    __syncthreads();
#pragma unroll
    for (int q = 0; q < 2; ++q) {
        const int id = 2 * w + q, tt = id >> 2, ss = id & 3; f32x4 acc = F4Z;
        if (ss <= tt) acc = tile_mm<64>(KP + (16 * ss) * LDT, LDT, QP + (16 * tt) * LDT, LDT, acc, fr, fq);
        const int t = 16 * tt + fr, s0 = 16 * ss + 4 * fq;
#pragma unroll
        for (int r = 0; r < 4; ++r) if (s0 + r > t) acc[r] = 0.f;
        *(LAS u32x2*)(ATT + t * LDT + s0) = pack4(acc);
    }
    __syncthreads();
#pragma unroll
    for (int q = 0; q < 4; ++q) {
        const int id = 4 * w + q, tt = id & 3, vv = id >> 2;
        f32x4 acc = __builtin_amdgcn_mfma_f32_16x16x32_bf16(stf[q][0], ld8(QP + (16 * tt + fr) * LDT + 8 * fq), F4Z, 0, 0, 0);
        acc = __builtin_amdgcn_mfma_f32_16x16x32_bf16(stf[q][1], ld8(QP + (16 * tt + fr) * LDT + 32 + 8 * fq), acc, 0, 0, 0);
        acc = tile_mm_sw<64, true, false>(VT, LDT, 16 * vv, ATT, LDT, 16 * tt, acc, fr, fq);
        *(LAS f32x4*)(O + (16 * tt + fr) * 132 + 16 * vv + 4 * fq) = acc;
    }
    __syncthreads();
    {
        const int t = tid >> 3, v0 = (tid & 7) * 16; float hv[16]; float ss = 0.f;
#pragma unroll
        for (int q4 = 0; q4 < 4; ++q4) { const f32x4 o4 = *(const LAS f32x4*)(O + t * 132 + v0 + 4 * q4);
#pragma unroll
            for (int j = 0; j < 4; ++j) { hv[4 * q4 + j] = o4[j]; ss += o4[j] * o4[j]; } }
        ss += shx(ss, 1, lane); ss += shx(ss, 2, lane); ss += shx(ss, 4, lane);
        const float rs = rsqf_(ss * (1.0f / 128) + NORM_EPS);
        bf16* zp = zpt; float g[16]; unpack8(gz0, g); unpack8(gz1, g + 8); (void)v0;
        float o[16];
#pragma unroll
        for (int j = 0; j < 16; ++j) o[j] = hv[j] * rs * gnv[j >> 2][j & 3] * siluf_(g[j]);
        const u32x4 w0 = pack8(o), w1 = pack8(o + 8);
        if (!DRY) { *(u32x4*)zp = w0; *(u32x4*)(zp + 8) = w1; } else asm volatile("" :: "v"(w0), "v"(w1));
    }
    __syncthreads();
}

constexpr size_t WS_MLW = 512 * 1024;
constexpr int LDU = 152, LDE = 136;
__device__ __forceinline__ float wave_incl_scan(float v, int lane) {
#pragma unroll
    for (int o = 1; o < 64; o <<= 1) { const float n = __builtin_bit_cast(float, __builtin_amdgcn_ds_bpermute(((lane - o) & 63) << 2, __builtin_bit_cast(int, v))); if (lane >= o) v += n; }
    return v;
}
struct MlPre { u32x4 x[2][4]; float zi, zf; };
__device__ __forceinline__ void ml_preload(const Ctx& C, int item, MlPre& P) {
    const int bh = item >> 6, c = item & 63, b = bh >> 2, h = bh & 3, t0 = c * LCH, rowb = b * SEQ + t0, tid = C.tid;
    const bf16* Z = (const bf16*)(C.ws + WS_Z); const u32x4 z4 = (u32x4){0u, 0u, 0u, 0u};
#pragma unroll
    for (int ii = 0; ii < 2; ++ii) { const int t = (tid >> 4) + 32 * ii, e0 = (tid & 15) * 8;
#pragma unroll
        for (int d = 0; d < 4; ++d) P.x[ii][d] = (t0 + t - 3 + d >= 0) ? *(const u32x4*)(Z + (size_t)(rowb + t - 3 + d) * ZP + ZA_U + h * 128 + e0) : z4; }
    P.zi = 0.f; P.zf = 0.f;
    if (C.wave == 0) { P.zi = ldz(Z, rowb + C.lane, ZA_I + h); P.zf = ldz(Z, rowb + C.lane, ZA_F + h); }
}
__device__ __forceinline__ void ml_front(const Ctx& C, int l, int h, const MlPre& P, LAS bf16* UC, LAS bf16* U, LAS float* GB, LAS float* GI) {
    const int tid = C.tid;
    const float* conv = C.inp(I_ML_CONV, l, 4 * WB) + h * 128;
#pragma unroll
    for (int ii = 0; ii < 2; ++ii) { const int t = (tid >> 4) + 32 * ii, e0 = (tid & 15) * 8; float s[8], x[8];
#pragma unroll
        for (int j = 0; j < 8; ++j) s[j] = 0.f;
#pragma unroll
        for (int d = 0; d < 4; ++d) {
            unpack8(P.x[ii][d], x);
#pragma unroll
            for (int j = 0; j < 8; ++j) s[j] += conv[d * WB + e0 + j] * x[j];
        }
        const u32x4 wu = P.x[ii][3];
#pragma unroll
        for (int j = 0; j < 8; ++j) s[j] = siluf_(s[j]);
        *(LAS u32x4*)(U + t * LDU + e0) = wu; *(LAS u32x4*)(UC + t * LDU + e0) = pack8(s); }
    if (C.wave == 0) { const int t = C.lane;
        const float li = P.zi + C.inp(I_ML_BI, l, 4)[h]; const float lf = logsigmoidf_(P.zf + C.inp(I_ML_BF, l, 4)[h]);
        GB[t] = wave_incl_scan(lf, C.lane); GI[t] = li; }
    __syncthreads();
}
__device__ __forceinline__ void ml_passA(const Ctx& C, int l, int item, const MlPre& P) {
    const int bh = item >> 6, c = item & 63, b = bh >> 2, h = bh & 3; (void)c; (void)b;
    LAS bf16* UC = (LAS bf16*)C.lds; LAS bf16* U = UC + 64 * LDU; LAS bf16* KT = U + 64 * LDU;
    LAS bf16* VT = KT + 128 * LDT;
    LAS float* GB = (LAS float*)(VT + 144 * LDT); LAS float* GI = GB + 64; LAS float* WA = GI + 64;
    const int tid = C.tid, lane = C.lane, w = C.wave, fr = lane & 15, fq = lane >> 4;
    const bf16* WK = (const bf16*)(C.ws + WS_MLW) + (size_t)(4 + h) * 16384; const bf16* WV = (const bf16*)(C.ws + WS_MLW) + (size_t)(8 + h) * 16384;
    bf16x8 wkf[4], wvf[4];
#pragma unroll
    for (int k4 = 0; k4 < 4; ++k4) { wkf[k4] = ld8(WK + (size_t)(16 * w + fr) * 128 + 32 * k4 + 8 * fq); wvf[k4] = ld8(WV + (size_t)(16 * w + fr) * 128 + 32 * k4 + 8 * fq); }
    ml_front(C, l, h, P, UC, U, GB, GI);
    if (tid < 64) WA[tid] = __expf(GB[63] - GB[tid] + GI[tid]) * 0.08838834764831845f;
    for (int i = tid; i < 16 * LDT; i += 512) VT[128 * LDT + i] = (i < LDT) ? (bf16)0x3f80 : (bf16)0;
    __syncthreads();
#pragma unroll
    for (int q = 0; q < 4; ++q) {
        const int tt = q, ee = w;
        f32x4 ak = F4Z, av = F4Z;
#pragma unroll
        for (int k4 = 0; k4 < 4; ++k4) { ak = __builtin_amdgcn_mfma_f32_16x16x32_bf16(ld8(UC + (16 * tt + fr) * LDU + 32 * k4 + 8 * fq), wkf[k4], ak, 0, 0, 0);
            av = __builtin_amdgcn_mfma_f32_16x16x32_bf16(ld8(U + (16 * tt + fr) * LDU + 32 * k4 + 8 * fq), wvf[k4], av, 0, 0, 0); }
        const int t = 16 * tt + 4 * fq;
#pragma unroll
        for (int r = 0; r < 4; ++r) ak[r] *= WA[t + r];
        *(LAS u32x2*)(KT + (16 * ee + fr) * LDT + t) = pack4(ak); *(LAS u32x2*)(VT + (16 * ee + fr) * LDT + t) = pack4(av);
    }
    if (tid == 0) ((float*)(C.ws + WS_S + SO_ML_G))[item] = __expf(GB[63]);
    __syncthreads();
    bf16* ST = (bf16*)(C.ws + WS_S + SO_ML_ST) + (size_t)item * (144 * 128);
    for (int id = w; id < 72; id += 8) {
        const int ee = id & 7, vv = id >> 3;
        const f32x4 acc = tile_mm<64>(KT + (16 * ee) * LDT, LDT, VT + (16 * vv) * LDT, LDT, F4Z, fr, fq);
        *(u32x2*)(ST + (size_t)(16 * vv + fr) * 128 + 16 * ee + 4 * fq) = pack4(acc);
    }
    __syncthreads();
}
__device__ __forceinline__ void ml_passB(const Ctx& C, int tidx, int NT) {
    for (int idx = tidx; idx < 16 * 16512; idx += NT) {
        const int bh = idx / 16512, e = idx % 16512;
        bf16* ST = (bf16*)(C.ws + WS_S + SO_ML_ST) + (size_t)bh * 64 * 18432 + e; const float* G = (const float*)(C.ws + WS_S + SO_ML_G) + bh * 64;
        float d[64], g[64];
#pragma unroll
        for (int c = 0; c < 64; ++c) { d[c] = bf2f(ST[(size_t)c * 18432]); g[c] = G[c]; }
        float run = 0.f;
#pragma unroll
        for (int c = 0; c < 64; ++c) { ST[(size_t)c * 18432] = (bf16)f2bf(run); run = run * g[c] + d[c]; }
    }
}
template <bool DRY = false> __device__ __forceinline__ void ml_passC(const Ctx& C, int l, int item, const MlPre& P) {
    const int bh = item >> 6, c = item & 63, b = bh >> 2, h = bh & 3, rowb = b * SEQ + c * LCH;
    bf16* Z = (bf16*)(C.ws + WS_Z);
    LAS bf16* UC = (LAS bf16*)C.lds; LAS bf16* U = UC + 64 * LDU; LAS bf16* Q = U + 64 * LDU;
    LAS bf16* K = Q + 64 * LDE;
    LAS bf16* VT = K + 64 * LDE;
    LAS bf16* W = VT + 144 * LDT;
    LAS float* GB = (LAS float*)(W + 64 * LDT); LAS float* GI = GB + 64; LAS float* RF = GI + 64; LAS float* CF = RF + 64; LAS float* RSQ = CF + 64;
    LAS float* O = (LAS float*)C.lds;
    const int tid = C.tid, lane = C.lane, w = C.wave, fr = lane & 15, fq = lane >> 4;
    const bf16* ST = (const bf16*)(C.ws + WS_S + SO_ML_ST) + (size_t)item * (144 * 128);
    bf16x8 stf[5][4];
#pragma unroll
    for (int q = 0; q < 5; ++q) { const int id = w + 8 * q, vv = id >> 2;
#pragma unroll
        for (int k4 = 0; k4 < 4; ++k4) stf[q][k4] = (id < 36) ? ld8(ST + (size_t)(16 * vv + fr) * 128 + 32 * k4 + 8 * fq) : (bf16x8){0, 0, 0, 0, 0, 0, 0, 0}; }
    const bf16* WQ = (const bf16*)(C.ws + WS_MLW) + (size_t)h * 16384; const bf16* WK = WQ + 4 * 16384; const bf16* WV = WQ + 8 * 16384;
    bf16x8 wqf[4], wkf[4], wvf[4];
#pragma unroll
    for (int k4 = 0; k4 < 4; ++k4) { wqf[k4] = ld8(WQ + (size_t)(16 * w + fr) * 128 + 32 * k4 + 8 * fq); wkf[k4] = ld8(WK + (size_t)(16 * w + fr) * 128 + 32 * k4 + 8 * fq); }
    bf16* const zpt = Z + (size_t)(rowb + (tid >> 3)) * ZP + ZA_O + h * 128 + (tid & 7) * 16; const u32x4 gz0 = *(const u32x4*)zpt, gz1 = *(const u32x4*)(zpt + 8);
    MLC_STAMP();
    ml_front(C, l, h, P, UC, U, GB, GI);
    MLC_STAMP();
#pragma unroll
    for (int k4 = 0; k4 < 4; ++k4) wvf[k4] = ld8(WV + (size_t)(16 * w + fr) * 128 + 32 * k4 + 8 * fq);
    if (tid < 64) { RF[tid] = __expf(GB[tid]); CF[tid] = __expf(GI[tid] - GB[tid]) * 0.08838834764831845f; }
    for (int i = tid; i < 16 * LDT; i += 512) VT[128 * LDT + i] = (i < LDT) ? (bf16)0x3f80 : (bf16)0;
#pragma unroll
    for (int q = 0; q < 4; ++q) {
        const int tt = q, ee = w;
        f32x4 aq = F4Z, ak = F4Z, av = F4Z;
#pragma unroll
        for (int k4 = 0; k4 < 4; ++k4) { const bf16x8 uc = ld8(UC + (16 * tt + fr) * LDU + 32 * k4 + 8 * fq);
            aq = __builtin_amdgcn_mfma_f32_16x16x32_bf16(wqf[k4], uc, aq, 0, 0, 0); ak = __builtin_amdgcn_mfma_f32_16x16x32_bf16(wkf[k4], uc, ak, 0, 0, 0);
            av = __builtin_amdgcn_mfma_f32_16x16x32_bf16(ld8(U + (16 * tt + fr) * LDU + 32 * k4 + 8 * fq), wvf[k4], av, 0, 0, 0); }
        *(LAS u32x2*)(Q + (16 * tt + fr) * LDE + 16 * ee + 4 * fq) = pack4(aq); *(LAS u32x2*)(K + (16 * tt + fr) * LDE + 16 * ee + 4 * fq) = pack4(ak);
        *(LAS u32x2*)(VT + (16 * ee + fr) * LDT + 16 * tt + 4 * fq) = pack4(av);
    }
    __syncthreads();
    MLC_STAMP();
#pragma unroll
    for (int q = 0; q < 2; ++q) {
        const int id = 2 * w + q, tt = id >> 2, ss = id & 3; f32x4 acc = F4Z;
        if (ss <= tt) acc = tile_mm<128>(K + (16 * ss) * LDE, LDE, Q + (16 * tt) * LDE, LDE, acc, fr, fq);
        const int t = 16 * tt + fr, s0 = 16 * ss + 4 * fq; const float rf = RF[t];
#pragma unroll
        for (int r = 0; r < 4; ++r) acc[r] = (s0 + r > t) ? 0.f : acc[r] * rf * CF[s0 + r];
        *(LAS u32x2*)(W + t * LDT + s0) = pack4(acc);
    }
    __syncthreads();
    MLC_STAMP();
    f32x4 res[5];
#pragma unroll
    for (int q = 0; q < 5; ++q) {
        const int id = w + 8 * q, tt = id & 3, vv = id >> 2; res[q] = F4Z;
        if (id < 36) {
            f32x4 acc = F4Z;
#pragma unroll
            for (int k4 = 0; k4 < 4; ++k4) acc = __builtin_amdgcn_mfma_f32_16x16x32_bf16(stf[q][k4], ld8(Q + (16 * tt + fr) * LDE + 32 * k4 + 8 * fq), acc, 0, 0, 0);
            acc *= RF[16 * tt + fr];
            res[q] = tile_mm<64>(VT + (16 * vv) * LDT, LDT, W + (16 * tt) * LDT, LDT, acc, fr, fq);
        }
    }
    __syncthreads();
    MLC_STAMP();
#pragma unroll
    for (int q = 0; q < 5; ++q) { const int id = w + 8 * q, tt = id & 3, vv = id >> 2; if (id < 36) *(LAS f32x4*)(O + (16 * tt + fr) * 148 + 16 * vv + 4 * fq) = res[q]; }
    __syncthreads();
    {
        const int t = tid >> 3, v0 = (tid & 7) * 16; float hv[16];
        const float inv = rcpf_(fmaxf(fabsf(O[t * 148 + 128]), 1.0f)); float ss = 0.f;
#pragma unroll
        for (int q4 = 0; q4 < 4; ++q4) { const f32x4 o4 = *(const LAS f32x4*)(O + t * 148 + v0 + 4 * q4);
#pragma unroll
            for (int j = 0; j < 4; ++j) { const float x = o4[j] * inv; hv[4 * q4 + j] = x; ss += x * x; } }
        ss += shx(ss, 1, lane); ss += shx(ss, 2, lane); ss += shx(ss, 4, lane);
        const float rs = rsqf_(ss * (1.0f / 128) + NORM_EPS);
        bf16* zp = zpt; float g[16]; unpack8(gz0, g); unpack8(gz1, g + 8);
        const float* gn = C.inp(I_ML_NORM, l, WB) + h * 128 + v0; float o[16];
#pragma unroll
        for (int j = 0; j < 16; ++j) o[j] = hv[j] * rs * gn[j] * sigmoidf_(g[j]);
        const u32x4 w0 = pack8(o), w1 = pack8(o + 8);
        if (!DRY) { *(u32x4*)zp = w0; *(u32x4*)(zp + 8) = w1; } else asm volatile("" :: "v"(w0), "v"(w1));
    }
    __syncthreads();
    MLC_STAMP();
}

constexpr size_t SO_S5_K = SO_END0;
constexpr size_t SO_S5_BB = SO_S5_K + 1 * MiB;
constexpr size_t SO_S5_PM = SO_S5_BB + 256 * 1024;
constexpr size_t SO_S5_POW = SO_S5_PM + 512 * 1024;
constexpr size_t SO_S5_E = SO_S5_POW + 1280 * 1024;
constexpr size_t SO_END1 = SO_S5_E + 4 * MiB;
static_assert(WS_S + SO_END1 <= WS_END, "state region");
__device__ __forceinline__ void s5_prep(const Ctx& C, int l, int g) {
    LAS float* BBr = (LAS float*)C.lds; LAS float* BBi = BBr + 1024; LAS float* PW = BBi + 1024; LAS float* CR = PW + 65 * 128; LAS float* CI = CR + 1024;
    LAS bf16* BT = (LAS bf16*)(CI + 1024);
    LAS bf16* WT = BT + 16 * 136 + C.wave * (16 * 136);
    const int tid = C.tid, lane = C.lane, w = C.wave, fr = lane & 15, fq = lane >> 4;
    if (tid < 64) { const int p = tid;
        const float are = C.inp(I_S5_ARE, l, 32 * 64)[g * 64 + p], aim = C.inp(I_S5_AIM, l, 32 * 64)[g * 64 + p];
        const float step = expf(C.inp(I_S5_LOGSTEP, l, 32)[g]); const float lre = fminf(are, -1e-4f), lim = aim;
        const float mag = expf(lre * step), bre = mag * cosf(lim * step), bim = mag * sinf(lim * step), den = lre * lre + lim * lim;
        const float cre = ((bre - 1.0f) * lre + bim * lim) / den, cim = (bim * lre - (bre - 1.0f) * lim) / den;
        const float* br = C.inp(I_S5_BRE, l, 32 * 64 * 16) + (size_t)(g * 64 + p) * 16; const float* bi = C.inp(I_S5_BIM, l, 32 * 64 * 16) + (size_t)(g * 64 + p) * 16;
        for (int c = 0; c < 16; ++c) { BBr[p * 16 + c] = cre * br[c] - cim * bi[c]; BBi[p * 16 + c] = cre * bi[c] + cim * br[c]; }
        float pr = 1.f, pi = 0.f;
        for (int n = 0; n <= 64; ++n) { PW[(n * 64 + p) * 2] = pr; PW[(n * 64 + p) * 2 + 1] = pi; const float nr = pr * bre - pi * bim, ni = pr * bim + pi * bre; pr = nr; pi = ni; }
    }
    for (int i = tid; i < 1024; i += 512) { CR[i] = C.inp(I_S5_CRE, l, 32 * 1024)[g * 1024 + i]; CI[i] = C.inp(I_S5_CIM, l, 32 * 1024)[g * 1024 + i]; }
    __syncthreads();
    unsigned char* S = C.ws + WS_S;
    float* POW = (float*)(S + SO_S5_POW) + (size_t)g * 65 * 128;
    for (int i = tid; i < 65 * 128; i += 512) POW[i] = PW[i];
    bf16* BB = (bf16*)(S + SO_S5_BB) + (size_t)g * 128 * 32;
    for (int i = tid; i < 128 * 32; i += 512) { const int row = i >> 5, c = i & 31, pp = row >> 5, ri = (row >> 4) & 1, p = 16 * pp + (row & 15);
        BB[i] = (bf16)f2bf(c < 16 ? (ri ? BBi[p * 16 + c] : BBr[p * 16 + c]) : 0.f); }
    bf16* PM = (bf16*)(S + SO_S5_PM) + (size_t)g * 64 * 128;
    for (int i = tid; i < 64 * 128; i += 512) { const int t = i >> 7, k = i & 127, ri = k >> 6, p = k & 63;
        PM[i] = (bf16)f2bf(ri ? -PW[((t + 1) * 64 + p) * 2 + 1] : PW[((t + 1) * 64 + p) * 2]); }
    for (int i = tid; i < 16 * 128; i += 512) { const int c = i >> 7, k = i & 127, ri = k >> 6, p = k & 63; BT[c * 136 + k] = (bf16)f2bf(ri ? -BBi[p * 16 + c] : BBr[p * 16 + c]); }
    __syncthreads();
    bf16* KM = (bf16*)(S + SO_S5_K) + (size_t)g * 16 * 1024;
#pragma unroll 1
    for (int tau = w; tau < 64; tau += 8) {
        const float pr = PW[(tau * 64 + lane) * 2], pi = PW[(tau * 64 + lane) * 2 + 1];
#pragma unroll
        for (int cp = 0; cp < 16; ++cp) { const float cr = CR[cp * 64 + lane], ci = CI[cp * 64 + lane];
            WT[cp * 136 + lane] = (bf16)f2bf(cr * pr - ci * pi); WT[cp * 136 + 64 + lane] = (bf16)f2bf(cr * pi + ci * pr); }
        LDS_WAIT(); __builtin_amdgcn_wave_barrier();
        const f32x4 acc = tile_mm<128>(BT, 136, WT, 136, F4Z, fr, fq);
        *(u32x2*)(KM + (size_t)fr * 1024 + tau * 16 + 4 * fq) = pack4(acc);
        LDS_WAIT(); __builtin_amdgcn_wave_barrier();
    }
    __syncthreads();
}
__device__ __forceinline__ void s5_passA(const Ctx& C) {
    const int g = C.bid >> 3, sb = C.bid & 7, lane = C.lane, fr = lane & 15, fq = lane >> 4, tid = C.tid;
    const bf16* Z = (const bf16*)(C.ws + WS_Z); unsigned char* S = C.ws + WS_S;
    LAS bf16* BBL = (LAS bf16*)(C.lds + 65536);
    LAS float* POWL = (LAS float*)(C.lds + 65536 + 8192);
    {   const u32x4* src = (const u32x4*)((const bf16*)(S + SO_S5_BB) + (size_t)g * 128 * 32); LAS u32x4* dst = (LAS u32x4*)BBL; dst[tid] = src[tid];
        const u32x4* ps = (const u32x4*)((const float*)(S + SO_S5_POW) + (size_t)g * 65 * 128); LAS u32x4* pd = (LAS u32x4*)POWL;
        for (int i = tid; i < 65 * 128 / 4; i += 512) pd[i] = ps[i]; }
    __syncthreads();
    LAS bf16* UA = (LAS bf16*)(C.lds + C.wave * 8192);
#pragma unroll 1
    for (int i4 = 0; i4 < 4; ++i4) {
        const int j = sb * 32 + C.wave * 4 + i4, b = j >> 6, c = j & 63, item = (b * 32 + g) * 64 + c, rowb = b * SEQ + c * LCH;
        {   const u32x4* src = (const u32x4*)(Z + (size_t)(rowb + lane) * ZP + ZB_U + g * 16); const u32x4 z4 = (u32x4){0u, 0u, 0u, 0u};
            LAS u32x4* dst = (LAS u32x4*)(UA + lane * 40); dst[0] = src[0]; dst[1] = src[1]; dst[2] = z4; dst[3] = z4; }
        LDS_WAIT(); __builtin_amdgcn_wave_barrier();
        float* E = (float*)(S + SO_S5_E) + (size_t)item * 128;
#pragma unroll
        for (int pp = 0; pp < 4; ++pp) { float er = 0.f, ei = 0.f; const int p = 16 * pp + fr;
#pragma unroll
            for (int tt = 0; tt < 4; ++tt) {
                const f32x4 br = tile_mm<32>(UA + (16 * tt) * 40, 40, BBL + (pp * 32) * 32, 32, F4Z, fr, fq);
                const f32x4 bi = tile_mm<32>(UA + (16 * tt) * 40, 40, BBL + (pp * 32 + 16) * 32, 32, F4Z, fr, fq);
#pragma unroll
                for (int r = 0; r < 4; ++r) { const int t = 16 * tt + 4 * fq + r; const f32x2 pw = *(const LAS f32x2*)(POWL + ((63 - t) * 64 + p) * 2);
                    er += pw.x * br[r] - pw.y * bi[r]; ei += pw.x * bi[r] + pw.y * br[r]; }
            }
            er += shx(er, 16, lane); er += shx(er, 32, lane); ei += shx(ei, 16, lane); ei += shx(ei, 32, lane);
            if (fq == 0) { E[p] = er; E[64 + p] = ei; }
        }
        LDS_WAIT(); __builtin_amdgcn_wave_barrier();
    }
    __syncthreads();
}
__device__ __forceinline__ void s5_passB(const Ctx& C, int tidx, int NT) {
    for (int idx = tidx; idx < 8192; idx += NT) {
    const int bg = idx >> 6, p = idx & 63, g = bg & 31; unsigned char* S = C.ws + WS_S;
    const f32x2 l64 = *(const f32x2*)((const float*)(S + SO_S5_POW) + (size_t)g * 65 * 128 + (64 * 64 + p) * 2);
    float* E = (float*)(S + SO_S5_E) + (size_t)bg * 64 * 128 + p;
    float er[64], ei[64];
#pragma unroll
    for (int c = 0; c < 64; ++c) { er[c] = E[c * 128]; ei[c] = E[c * 128 + 64]; }
    float rr = 0.f, ri = 0.f;
#pragma unroll
    for (int c = 0; c < 64; ++c) { E[c * 128] = rr; E[c * 128 + 64] = ri; const float nr = l64.x * rr - l64.y * ri + er[c], ni = l64.x * ri + l64.y * rr + ei[c]; rr = nr; ri = ni; }
    }
}
constexpr int LDKM = 1032;
template <class RW> __device__ __forceinline__ void s5_passC_core(const Ctx& C, int l, RW rw_items) {
    const int g = C.bid >> 3, sb = C.bid & 7, lane = C.lane, fr = lane & 15, fq = lane >> 4, tid = C.tid;
    bf16* Z = (bf16*)(C.ws + WS_Z); unsigned char* S = C.ws + WS_S;
    LAS bf16* KML = (LAS bf16*)(C.lds + 73728);
    LAS bf16* PML = (LAS bf16*)(C.lds + 73728 + 16 * LDKM * 2);
    {   const u32x4* ks = (const u32x4*)((const bf16*)(S + SO_S5_K) + (size_t)g * 16 * 1024);
        for (int i = tid; i < 16 * 128; i += 512) *(LAS u32x4*)(KML + (i >> 7) * LDKM + (i & 127) * 8) = ks[i];
        const u32x4* ps = (const u32x4*)((const bf16*)(S + SO_S5_PM) + (size_t)g * 64 * 128);
        for (int i = tid; i < 64 * 16; i += 512) *(LAS u32x4*)(PML + (i >> 4) * 136 + (i & 15) * 8) = ps[i]; }
    __syncthreads();
    if (C.wave < 4) { rw_items(); __syncthreads(); return; }
    LAS bf16* UP = (LAS bf16*)(C.lds + C.wave * 9216);
    LAS bf16* WV = UP + 128 * 16;
    const float* dsk = C.inp(I_S5_D, l, WB) + g * 16;
#pragma unroll 1
    for (int i4 = 0; i4 < 8; ++i4) {
        const int j = sb * 32 + (C.wave - 4) * 8 + i4, b = j >> 6, c = j & 63, item = (b * 32 + g) * 64 + c, rowb = b * SEQ + c * LCH;
        {   const u32x4* src = (const u32x4*)(Z + (size_t)(rowb + lane) * ZP + ZB_U + g * 16); const u32x4 z4 = (u32x4){0u, 0u, 0u, 0u};
            LAS u32x4* dz = (LAS u32x4*)(UP + lane * 16); dz[0] = z4; dz[1] = z4; LAS u32x4* dst = (LAS u32x4*)(UP + (64 + lane) * 16); dst[0] = src[0]; dst[1] = src[1]; }
        {   const float* E = (const float*)(S + SO_S5_E) + (size_t)item * 128; const int cp = lane >> 2, pq = lane & 3;
            const float* cr = C.inp(I_S5_CRE, l, 32 * 1024) + (size_t)g * 1024 + cp * 64 + 16 * pq; const float* ci = C.inp(I_S5_CIM, l, 32 * 1024) + (size_t)g * 1024 + cp * 64 + 16 * pq;
#pragma unroll
            for (int jj = 0; jj < 16; jj += 2) { const int p = 16 * pq + jj;
                const float a0 = cr[jj] * E[p] - ci[jj] * E[64 + p], b0 = cr[jj] * E[64 + p] + ci[jj] * E[p], a1 = cr[jj + 1] * E[p + 1] - ci[jj + 1] * E[65 + p], b1 = cr[jj + 1] * E[65 + p] + ci[jj + 1] * E[p + 1];
                *(LAS unsigned*)(WV + cp * 136 + p) = pk2(a0, a1); *(LAS unsigned*)(WV + cp * 136 + 64 + p) = pk2(b0, b1); }
        }
        LDS_WAIT(); __builtin_amdgcn_wave_barrier();
#pragma unroll
        for (int tt = 0; tt < 4; ++tt) {
            f32x4 acc = F4Z; const int t = 16 * tt + fr;
#pragma unroll 4
            for (int ks = 0; ks < 8 * (tt + 1); ++ks) {
                const bf16x8 a = ld8(KML + fr * LDKM + 32 * ks + 8 * fq);
                const bf16x8 bb = ld8(UP + (64 + t - 2 * ks - (fq >> 1)) * 16 + 8 * (fq & 1));
                acc = __builtin_amdgcn_mfma_f32_16x16x32_bf16(a, bb, acc, 0, 0, 0);
            }
            acc = tile_mm<128>(WV, 136, PML + (16 * tt) * 136, 136, acc, fr, fq);
            float y[4];
#pragma unroll
            for (int r = 0; r < 4; ++r) { const int cp = 4 * fq + r; y[r] = gelu_tanh(acc[r] + dsk[cp] * bf2f(UP[(64 + t) * 16 + cp])); }
            u32x2 o; o.x = pk2(y[0], y[1]); o.y = pk2(y[2], y[3]);
            *(u32x2*)(Z + (size_t)(rowb + t) * ZP + ZB_U + g * 16 + 4 * fq) = o;
        }
        LDS_WAIT(); __builtin_amdgcn_wave_barrier();
    }
    __syncthreads();
}

constexpr size_t SO_RW_PQ = SO_END1;
constexpr size_t SO_RW_RHO = SO_RW_PQ + 32 * MiB;
constexpr size_t SO_RW_HALO = SO_RW_RHO + 512 * 1024;
constexpr size_t SO_RW_W = SO_RW_HALO + 512 * 1024;
constexpr size_t SO_END2 = SO_RW_W + 256 * 1024;
static_assert(WS_S + SO_END2 <= WS_END, "state region");
static_assert(SO_RW_W == RWW_OFF, "RWW_OFF");
__device__ __forceinline__ void shift8(const u32x4 cur, const u32x4 prev, const float* mu, float* o) {
    float a[8], p[8]; unpack8(cur, a); unpack8(prev, p);
#pragma unroll
    for (int j = 0; j < 8; ++j) o[j] = a[j] + mu[j] * (p[j] - a[j]);
}

struct RwPre { u32x4 cw, pw, ca, pa, cr, ck, cv, pr, pk, pv; };
__device__ __forceinline__ void rw_preload(const Ctx& C, int item, RwPre& P) {
    const int bh = item >> 6, c = item & 63, b = bh >> 3, h = bh & 7, hc0 = h * 64, rowb = b * SEQ + c * LCH;
    const bf16* Z = (const bf16*)(C.ws + WS_Z); const int t = C.tid >> 3, c0 = (C.tid & 7) * 8, row = rowb + t;
    const bf16* HALO = (const bf16*)(C.ws + WS_S + SO_RW_HALO) + (size_t)(b * 64 + c - 1) * 1024;
    const u32x4 z4 = (u32x4){0u, 0u, 0u, 0u}; const bool first = (c * LCH + t == 0);
    P.cw = *(const u32x4*)(Z + (size_t)row * ZP + ZD_XW + c0); P.ca = *(const u32x4*)(Z + (size_t)row * ZP + ZD_XA + c0);
    P.cr = *(const u32x4*)(Z + (size_t)row * ZP + ZD_R + hc0 + c0); P.ck = *(const u32x4*)(Z + (size_t)row * ZP + ZD_K + hc0 + c0); P.cv = *(const u32x4*)(Z + (size_t)row * ZP + ZD_V + hc0 + c0);
    P.pw = z4; P.pa = z4; P.pr = z4; P.pk = z4; P.pv = z4;
    if (!first) { P.pw = *(const u32x4*)(Z + (size_t)(row - 1) * ZP + ZD_XW + c0); P.pa = *(const u32x4*)(Z + (size_t)(row - 1) * ZP + ZD_XA + c0); P.pv = *(const u32x4*)(Z + (size_t)(row - 1) * ZP + ZD_V + hc0 + c0);
        if (t > 0) { P.pr = *(const u32x4*)(Z + (size_t)(row - 1) * ZP + ZD_R + hc0 + c0); P.pk = *(const u32x4*)(Z + (size_t)(row - 1) * ZP + ZD_K + hc0 + c0); }
        else { P.pr = *(const u32x4*)(HALO + hc0 + c0); P.pk = *(const u32x4*)(HALO + 512 + hc0 + c0); } }
}
#define RWA_STAMP(k) do { if (item == 256 && l == 0) TSTAMP(C, 220 + (k)); } while (0)
template <bool DRY = false> __device__ __forceinline__ void rw_passA(const Ctx& C, int l, int item, RwPre& P, int next_item) {
    const int bh = item >> 6, c = item & 63, b = bh >> 3, h = bh & 7, hc0 = h * 64, rowb = b * SEQ + c * LCH;
    bf16* Z = (bf16*)(C.ws + WS_Z); unsigned char* S = C.ws + WS_S;
    LAS unsigned char* L = C.lds;
    LAS bf16* XW = (LAS bf16*)L; LAS bf16* XA = (LAS bf16*)(L + 9216); LAS float* WARG = (LAS float*)(L + 18432);
    LAS bf16* TAB = (LAS bf16*)L; LAS bf16* TAK = (LAS bf16*)(L + 9216); LAS bf16* MRB = (LAS bf16*)(L + 18432); LAS bf16* MRK = (LAS bf16*)(L + 27648);
    LAS float* AARG = (LAS float*)(L + 36864); LAS float* LW = AARG; LAS bf16* XT = (LAS bf16*)(L + 36864);
    LAS bf16* AT = (LAS bf16*)(L + 55296); LAS bf16* RT = (LAS bf16*)(L + 64512); LAS bf16* BT = (LAS bf16*)(L + 73728); LAS bf16* KT = (LAS bf16*)(L + 82944);
    LAS float* RHSV = (LAS float*)(L + 73728);
    LAS bf16* BBT = (LAS bf16*)(L + 92160); LAS bf16* KBT = (LAS bf16*)(L + 101376); LAS bf16* VT = (LAS bf16*)(L + 110592);
    LAS float* CUML = (LAS float*)(L + 119808); LAS float* GL = CUML + 64; LAS float* SEG = GL + 64; LAS float* UPD = SEG;
    const int tid = C.tid, lane = C.lane, w = C.wave, fr = lane & 15, fq = lane >> 4;
    const int t = tid >> 3, c0 = (tid & 7) * 8, row = rowb + t;
    const float* mu = C.inp(I_RW_MU, l, 1792);
    const u32x4 z4 = (u32x4){0u, 0u, 0u, 0u};
    RWA_STAMP(0);
    float muw[8], mua[8], mur[8], muk[8], muv[8], w0r[8], a0r[8], kkr[8], kar[8], rkr[8];
    {   const float* w0 = C.inp(I_RW_W0, l, WB) + hc0 + c0; const float* a0 = C.inp(I_RW_A0, l, WB) + hc0 + c0;
        const float* kkw = C.inp(I_RW_KK, l, WB) + hc0 + c0; const float* kaw = C.inp(I_RW_KA, l, WB) + hc0 + c0; const float* rkw = C.inp(I_RW_RK, l, WB) + hc0 + c0;
#pragma unroll
        for (int q = 0; q < 2; ++q) {
            const f32x4 a = *(const f32x4*)(mu + 1536 + c0 + 4 * q), b = *(const f32x4*)(mu + 1600 + c0 + 4 * q), c_ = *(const f32x4*)(mu + hc0 + c0 + 4 * q), d = *(const f32x4*)(mu + 512 + hc0 + c0 + 4 * q), e_ = *(const f32x4*)(mu + 1024 + hc0 + c0 + 4 * q);
            const f32x4 f = *(const f32x4*)(w0 + 4 * q), g = *(const f32x4*)(a0 + 4 * q), h_ = *(const f32x4*)(kkw + 4 * q), i_ = *(const f32x4*)(kaw + 4 * q), j_ = *(const f32x4*)(rkw + 4 * q);
#pragma unroll
            for (int j = 0; j < 4; ++j) { muw[4 * q + j] = a[j]; mua[4 * q + j] = b[j]; mur[4 * q + j] = c_[j]; muk[4 * q + j] = d[j]; muv[4 * q + j] = e_[j];
                w0r[4 * q + j] = f[j]; a0r[4 * q + j] = g[j]; kkr[4 * q + j] = h_[j]; kar[4 * q + j] = i_[j]; rkr[4 * q + j] = j_[j]; }
        }
    }
    bf16x8 wupf[2][2], aupf[2][2];
    {   const bf16* WUP = (const bf16*)(S + SO_RW_W) + (size_t)hc0 * 64; const bf16* AUP = WUP + 512 * 64;
#pragma unroll
        for (int q = 0; q < 2; ++q) { const int cc = (2 * w + q) & 3;
#pragma unroll
            for (int ks = 0; ks < 2; ++ks) { wupf[q][ks] = ld8(WUP + (size_t)(16 * cc + fr) * 64 + 32 * ks + 8 * fq); aupf[q][ks] = ld8(AUP + (size_t)(16 * cc + fr) * 64 + 32 * ks + 8 * fq); } }
    }
    {   float f[8];
        shift8(P.cw, P.pw, muw, f);
#pragma unroll
        for (int j = 0; j < 8; ++j) f[j] = tanhf_(f[j]);
        *(LAS u32x4*)(XW + t * LDT + c0) = pack8(f);
        shift8(P.ca, P.pa, mua, f);
        *(LAS u32x4*)(XA + t * LDT + c0) = pack8(f);
    }
    __syncthreads();
    RWA_STAMP(1);
    {
#pragma unroll
        for (int q = 0; q < 2; ++q) { const int id = 2 * w + q, tt = id >> 2, cc = id & 3;
            f32x4 aw = F4Z, aa = F4Z;
#pragma unroll
            for (int ks = 0; ks < 2; ++ks) {
                aw = __builtin_amdgcn_mfma_f32_16x16x32_bf16(ld8(XW + (16 * tt + fr) * LDT + 32 * ks + 8 * fq), wupf[q][ks], aw, 0, 0, 0);
                aa = __builtin_amdgcn_mfma_f32_16x16x32_bf16(ld8(XA + (16 * tt + fr) * LDT + 32 * ks + 8 * fq), aupf[q][ks], aa, 0, 0, 0); }
#pragma unroll
            for (int r = 0; r < 4; ++r) { WARG[(16 * tt + 4 * fq + r) * 65 + 16 * cc + fr] = aw[r]; AARG[(16 * tt + 4 * fq + r) * 65 + 16 * cc + fr] = aa[r]; } }
    }
    __syncthreads();
    RWA_STAMP(2);
    float lw[8], av[8], bv[8], kr[8], rr[8], vv[8];
    {   float kk[8], aa[8];
        shift8(P.cr, P.pr, mur, rr); shift8(P.ck, P.pk, muk, kk); shift8(P.cv, P.pv, muv, vv);
        float n2 = 0.f, rho = 0.f;
#pragma unroll
        for (int j = 0; j < 8; ++j) {
            const float wl = -softplusf_(-(WARG[t * 65 + c0 + j] + w0r[j])) - 0.5f; lw[j] = -__expf(wl);
            aa[j] = sigmoidf_(AARG[t * 65 + c0 + j] + a0r[j]);
            const float kn = kk[j] * kkr[j]; n2 += kn * kn; av[j] = kn;
            kr[j] = kk[j] * (1.0f + (aa[j] - 1.0f) * kar[j]); rho += rr[j] * kr[j] * rkr[j];
        }
        n2 += shx(n2, 1, lane); n2 += shx(n2, 2, lane); n2 += shx(n2, 4, lane);
        rho += shx(rho, 1, lane); rho += shx(rho, 2, lane); rho += shx(rho, 4, lane);
        const float inv = rcpf_(fmaxf(sqrtf(n2), 1e-12f));
#pragma unroll
        for (int j = 0; j < 8; ++j) { const float kkn = av[j] * inv; av[j] = -kkn; bv[j] = kkn * aa[j]; }
        if (!DRY && (tid & 7) == 0) ((float*)(S + SO_RW_RHO))[(size_t)row * 8 + h] = rho;
    }
    if (next_item >= 0) rw_preload(C, next_item, P);
    RWA_STAMP(3);
    float cm[8], cl[8];
    {   const int tl = lane >> 3;
#pragma unroll
        for (int j = 0; j < 8; ++j) cm[j] = lw[j];
#pragma unroll
        for (int d = 1; d < 8; d <<= 1) {
#pragma unroll
            for (int j = 0; j < 8; ++j) { const float u = __builtin_bit_cast(float, __builtin_amdgcn_ds_bpermute(((lane - 8 * d) & 63) << 2, __builtin_bit_cast(int, cm[j]))); if (tl >= d) cm[j] += u; }
        }
        if (tl == 7) { *(LAS f32x4*)(SEG + w * 64 + c0) = (f32x4){cm[0], cm[1], cm[2], cm[3]}; *(LAS f32x4*)(SEG + w * 64 + c0 + 4) = (f32x4){cm[4], cm[5], cm[6], cm[7]}; }
        __syncthreads();
        RWA_STAMP(4);
        float off[8];
#pragma unroll
        for (int j = 0; j < 8; ++j) { off[j] = 0.f; cl[j] = 0.f; }
#pragma unroll
        for (int w2 = 0; w2 < 8; ++w2) { const f32x4 s0 = *(const LAS f32x4*)(SEG + w2 * 64 + c0), s1 = *(const LAS f32x4*)(SEG + w2 * 64 + c0 + 4);
#pragma unroll
            for (int j = 0; j < 4; ++j) { cl[j] += s0[j]; cl[4 + j] += s1[j]; if (w2 < w) { off[j] += s0[j]; off[4 + j] += s1[j]; } } }
#pragma unroll
        for (int j = 0; j < 8; ++j) cm[j] += off[j];
        if (t == 63) {
#pragma unroll
            for (int j = 0; j < 8; ++j) { CUML[c0 + j] = cl[j]; GL[c0 + j] = __expf(cl[j]); } }
    }
    {   float fa[8], fb[8], fk[8], fr_[8];
#pragma unroll
        for (int j = 0; j < 8; ++j) { const float en = __expf(-cm[j]), el = __expf(cl[j] - cm[j]);
            fa[j] = av[j] * __expf(cm[j] - lw[j]); fb[j] = bv[j] * en; fk[j] = kr[j] * en; fr_[j] = rr[j] * __expf(cm[j]);
            BBT[swz(c0 + j, t)] = (bf16)f2bf(bv[j] * el); KBT[swz(c0 + j, t)] = (bf16)f2bf(kr[j] * el); VT[swz(c0 + j, t)] = (bf16)f2bf(vv[j]); }
        *(LAS u32x4*)(AT + t * LDT + c0) = pack8(fa); *(LAS u32x4*)(BT + t * LDT + c0) = pack8(fb); *(LAS u32x4*)(KT + t * LDT + c0) = pack8(fk); *(LAS u32x4*)(RT + t * LDT + c0) = pack8(fr_);
    }
    __syncthreads();
    RWA_STAMP(5);
#pragma unroll
    for (int q = 0; q < 2; ++q) { const int id = 2 * w + q, tt = id >> 2, ss = id & 3; f32x4 ab = F4Z, ak = F4Z, rb = F4Z, rk = F4Z;
        if (ss <= tt) {
            ab = tile_mm<64>(BT + (16 * ss) * LDT, LDT, AT + (16 * tt) * LDT, LDT, ab, fr, fq); ak = tile_mm<64>(KT + (16 * ss) * LDT, LDT, AT + (16 * tt) * LDT, LDT, ak, fr, fq);
            rb = tile_mm<64>(BT + (16 * ss) * LDT, LDT, RT + (16 * tt) * LDT, LDT, rb, fr, fq); rk = tile_mm<64>(KT + (16 * ss) * LDT, LDT, RT + (16 * tt) * LDT, LDT, rk, fr, fq);
        }
        const int tq = 16 * tt + fr, s0 = 16 * ss + 4 * fq;
#pragma unroll
        for (int r = 0; r < 4; ++r) { if (s0 + r >= tq) { ab[r] = 0.f; ak[r] = 0.f; } if (s0 + r > tq) { rb[r] = 0.f; rk[r] = 0.f; } }
        *(LAS u32x2*)(TAB + tq * LDT + s0) = pack4(ab); *(LAS u32x2*)(TAK + tq * LDT + s0) = pack4(ak); *(LAS u32x2*)(MRB + tq * LDT + s0) = pack4(rb); *(LAS u32x2*)(MRK + tq * LDT + s0) = pack4(rk);
    }
    __syncthreads();
    RWA_STAMP(7);
    LAS bf16* DINV = (LAS bf16*)SEG;
    LAS bf16* RT2 = DINV + 1024;
    if (w >= 4) {
#pragma unroll
        for (int q = 0; q < 4; ++q) { const int id = 4 * (w - 4) + q, vb = id >> 2, tt = id & 3;
            const f32x4 a = tile_mm_sw<64, true, false>(VT, LDT, 16 * vb, TAK, LDT, 16 * tt, F4Z, fr, fq);
#pragma unroll
            for (int r = 0; r < 4; ++r) RHSV[(16 * vb + 4 * fq + r) * 65 + 16 * tt + fr] = a[r]; }
        for (int i = tid - 256; i < 128 * LDT / 8; i += 256) ((LAS u32x4*)XT)[i] = z4;
    } else if (lane < 16) { const int bb = w, j = lane; float x[16];
#pragma unroll
        for (int i = 0; i < 16; ++i) { float s = (i == j) ? 1.0f : 0.0f; float tf[16];
            if (i > 0) unpack8(*(const LAS u32x4*)(TAB + (16 * bb + i) * LDT + 16 * bb), tf);
            if (i > 8) unpack8(*(const LAS u32x4*)(TAB + (16 * bb + i) * LDT + 16 * bb + 8), tf + 8);
#pragma unroll
            for (int i2 = 0; i2 < i; ++i2) s += tf[i2] * x[i2];
            x[i] = s; DINV[(bb * 16 + i) * 16 + j] = (bf16)f2bf(s); }
    }
    __syncthreads();
    RWA_STAMP(8);
    typedef short s16x4 __attribute__((ext_vector_type(4)));
#pragma unroll
    for (int bi = 0; bi < 4; ++bi) {
        f32x4 u = F4Z;
        if (bi > 0) u = tile_mm<64>(XT + (16 * w) * LDT, LDT, TAB + (16 * bi) * LDT, LDT, F4Z, fr, fq);
#pragma unroll
        for (int r = 0; r < 4; ++r) { const int col = 16 * w + 4 * fq + r, tr = 16 * bi + fr;
            const float base = (w < 4) ? bf2f(AT[tr * LDT + col]) : RHSV[(col - 64) * 65 + tr];
            RT2[col * 16 + fr] = (bf16)f2bf(base + u[r]); }
        LDS_WAIT(); __builtin_amdgcn_wave_barrier();
        const s16x4 ra = *(const LAS s16x4*)(RT2 + (16 * w + fr) * 16 + 4 * fq), db = *(const LAS s16x4*)(DINV + (bi * 16 + fr) * 16 + 4 * fq);
        const f32x4 x = __builtin_amdgcn_mfma_f32_16x16x16bf16_1k(ra, db, F4Z, 0, 0, 0);
#pragma unroll
        for (int r = 0; r < 4; ++r) XT[(16 * w + 4 * fq + r) * LDT + 16 * bi + fr] = (bf16)f2bf(x[r]);
        LDS_WAIT(); __builtin_amdgcn_wave_barrier();
    }
    __syncthreads();
    RWA_STAMP(9);
    bf16* PQ = (bf16*)(S + SO_RW_PQ) + (size_t)item * 8192;
#pragma unroll
    for (int q = 0; q < 2; ++q) { const int id = 2 * w + q, ib = id >> 2, jb = id & 3;
        {
            f32x4 a = tile_mm<64>(XT + (16 * ib) * LDT, LDT, MRB + (16 * jb) * LDT, LDT, F4Z, fr, fq);
            const int tq = 16 * jb + fr, j0 = 16 * ib + 4 * fq; const u32x2 rt = *(const LAS u32x2*)(RT + tq * LDT + j0);
            a[0] += bflo(rt.x); a[1] += bfhi(rt.x); a[2] += bflo(rt.y); a[3] += bfhi(rt.y);
            if (!DRY) *(u32x2*)(Z + (size_t)(rowb + tq) * ZP + ZD_R + hc0 + j0) = pack4(a); else asm volatile("" :: "v"(a)); }
        {
            f32x4 a = tile_mm<64>(XT + (64 + 16 * ib) * LDT, LDT, MRB + (16 * jb) * LDT, LDT, F4Z, fr, fq);
            a = tile_mm_sw<64, true, false>(VT, LDT, 16 * ib, MRK, LDT, 16 * jb, a, fr, fq);
            if (!DRY) *(u32x2*)(Z + (size_t)(rowb + 16 * jb + fr) * ZP + ZD_K + hc0 + 16 * ib + 4 * fq) = pack4(a); else asm volatile("" :: "v"(a)); }
        {
            f32x4 a = tile_mm_sw<64, false, true>(XT, LDT, 16 * ib, BBT, LDT, 16 * jb, F4Z, fr, fq);
            const int k = 16 * jb + fr, j0 = 16 * ib + 4 * fq;
#pragma unroll
            for (int r = 0; r < 4; ++r) if (j0 + r == k) a[r] += GL[k];
            if (!DRY) *(u32x2*)(PQ + (size_t)k * 64 + j0) = pack4(a); else asm volatile("" :: "v"(a)); }
        {
            f32x4 a = tile_mm_sw<64, true, false>(BBT, LDT, 16 * ib, XT, LDT, 64 + 16 * jb, F4Z, fr, fq);
            a = tile_mm_sw<64, true, true>(KBT, LDT, 16 * ib, VT, LDT, 16 * jb, a, fr, fq);
            if (!DRY) *(u32x2*)(PQ + 4096 + (size_t)(16 * jb + fr) * 64 + 16 * ib + 4 * fq) = pack4(a); else asm volatile("" :: "v"(a)); }
    }
    __syncthreads();
    RWA_STAMP(10);
}
__device__ __forceinline__ void rw_passB(const Ctx& C, int unit) {
    const int bh = unit >> 2, vg = unit & 3, lane = C.lane, fr = lane & 15, fq = lane >> 4;
    TSTAMP(C, 210);
    LAS bf16* SL = (LAS bf16*)(C.lds + C.wave * 16384);
    bf16* PQ0 = (bf16*)(C.ws + WS_S + SO_RW_PQ) + (size_t)bh * 64 * 8192;
    for (int i = lane; i < 16 * LDT / 8; i += 64) ((LAS u32x4*)SL)[i] = (u32x4){0u, 0u, 0u, 0u};
    LDS_WAIT(); __builtin_amdgcn_wave_barrier();
    bf16x8 pa[4][4][2]; u32x2 qa[4][4];
#define RWB_FETCH(s, cc) do { const bf16* P_ = PQ0 + (size_t)(cc) * 8192; const bf16* Q_ = P_ + 4096 + (size_t)(16 * vg) * 64; _Pragma("unroll") for (int kk = 0; kk < 4; ++kk) { \
        pa[s][kk][0] = ld8(P_ + (size_t)(16 * kk + fr) * 64 + 8 * fq); pa[s][kk][1] = ld8(P_ + (size_t)(16 * kk + fr) * 64 + 32 + 8 * fq); qa[s][kk] = *(const u32x2*)(Q_ + (size_t)fr * 64 + 16 * kk + 4 * fq); } } while (0)
    RWB_FETCH(0, 0); RWB_FETCH(1, 1); RWB_FETCH(2, 2); RWB_FETCH(3, 3);
    for (int c4 = 0; c4 < 64; c4 += 4) {
#pragma unroll
        for (int s = 0; s < 4; ++s) {
            const int c = c4 + s;
            bf16* QT = PQ0 + (size_t)c * 8192 + 4096 + (size_t)(16 * vg) * 64;
            const bf16x8 b0 = ld8(SL + fr * LDT + 8 * fq), b1 = ld8(SL + fr * LDT + 32 + 8 * fq);
            const u32x4 s0 = *(const LAS u32x4*)(SL + (lane >> 2) * LDT + (lane & 3) * 16), s1 = *(const LAS u32x4*)(SL + (lane >> 2) * LDT + (lane & 3) * 16 + 8);
            f32x4 acc[4];
#pragma unroll
            for (int kk = 0; kk < 4; ++kk) {
                f32x4 a; a[0] = bflo(qa[s][kk].x); a[1] = bfhi(qa[s][kk].x); a[2] = bflo(qa[s][kk].y); a[3] = bfhi(qa[s][kk].y);
                a = __builtin_amdgcn_mfma_f32_16x16x32_bf16(pa[s][kk][0], b0, a, 0, 0, 0);
                acc[kk] = __builtin_amdgcn_mfma_f32_16x16x32_bf16(pa[s][kk][1], b1, a, 0, 0, 0);
            }
            LDS_WAIT(); __builtin_amdgcn_wave_barrier();
            *(u32x4*)(QT + (size_t)(lane >> 2) * 64 + (lane & 3) * 16) = s0; *(u32x4*)(QT + (size_t)(lane >> 2) * 64 + (lane & 3) * 16 + 8) = s1;
#pragma unroll
            for (int kk = 0; kk < 4; ++kk) *(LAS u32x2*)(SL + fr * LDT + 16 * kk + 4 * fq) = pack4(acc[kk]);
            LDS_WAIT(); __builtin_amdgcn_wave_barrier();
            if (c + 4 < 64) RWB_FETCH(s, c + 4);
        }
    }
#undef RWB_FETCH
    TSTAMP(C, 211);
}
__device__ __forceinline__ void rw_xg_pass(const Ctx& C, int l, int tidx, int NT) {
    bf16* Z = (bf16*)(C.ws + WS_Z); const float* mu = C.inp(I_RW_MU, l, 1792) + 1664; const u32x4 z4 = (u32x4){0u, 0u, 0u, 0u};
    for (int idx = tidx; idx < M * 16; idx += NT) { const int row = idx >> 4, j0 = (idx & 15) * 8; float f[8];
        const u32x4 cg = *(const u32x4*)(Z + (size_t)row * ZP + ZD_XG + j0), pg = ((row & (SEQ - 1)) == 0) ? z4 : *(const u32x4*)(Z + (size_t)(row - 1) * ZP + ZD_XG + j0);
        shift8(cg, pg, mu + j0, f);
#pragma unroll
        for (int j = 0; j < 8; ++j) f[j] = sigmoidf_(f[j]);
        *(u32x4*)(Z + (size_t)row * ZP + ZD_XW + j0) = pack8(f); }
}
template <bool DRY = false> __device__ __forceinline__ void rw_passC(const Ctx& C, int l, int item) {
    const int bh = item >> 6, c = item & 63, b = bh >> 3, h = bh & 7, hc0 = h * 64, rowb = b * SEQ + c * LCH;
    bf16* Z = (bf16*)(C.ws + WS_Z); unsigned char* S = C.ws + WS_S;
    const int tt = C.wave & 3, lane = C.lane, fr = lane & 15, fq = lane >> 4, t = 16 * tt + fr, row = rowb + t;
    LAS bf16* XG = (LAS bf16*)(C.lds + tt * 4608);
    const float* mu = C.inp(I_RW_MU, l, 1792); const u32x4 z4 = (u32x4){0u, 0u, 0u, 0u};
    const bf16* SST = (const bf16*)(S + SO_RW_PQ) + (size_t)item * 8192 + 4096;
    const bf16* GUP = (const bf16*)(S + SO_RW_W) + 2 * 512 * 64 + (size_t)hc0 * 128;
    const bool first = (c * LCH + t == 0);
    bf16x8 xgf[4];
#pragma unroll
    for (int ks = 0; ks < 4; ++ks) xgf[ks] = ld8(Z + (size_t)(rowb + 16 * tt + fr) * ZP + ZD_XW + 32 * ks + 8 * fq);
    bf16x8 sa[4][2], rb[2]; u32x2 ylv[4], cvv[4], pvv[4];
#pragma unroll
    for (int ks = 0; ks < 2; ++ks) rb[ks] = ld8(Z + (size_t)(rowb + 16 * tt + fr) * ZP + ZD_R + hc0 + 32 * ks + 8 * fq);
#pragma unroll
    for (int vb = 0; vb < 4; ++vb) {
#pragma unroll
        for (int ks = 0; ks < 2; ++ks) sa[vb][ks] = ld8(SST + (size_t)(16 * vb + fr) * 64 + 32 * ks + 8 * fq);
        ylv[vb] = *(const u32x2*)(Z + (size_t)row * ZP + ZD_K + hc0 + 16 * vb + 4 * fq);
        cvv[vb] = *(const u32x2*)(Z + (size_t)row * ZP + ZD_V + hc0 + 16 * vb + 4 * fq); pvv[vb].x = 0u; pvv[vb].y = 0u;
        if (!first) pvv[vb] = *(const u32x2*)(Z + (size_t)(row - 1) * ZP + ZD_V + hc0 + 16 * vb + 4 * fq);
    }
    const float rho = ((const float*)(S + SO_RW_RHO))[(size_t)row * 8 + h];
    f32x4 y[4], g[4];
#pragma unroll
    for (int vb = 0; vb < 4; ++vb) {
        f32x4 a = F4Z;
#pragma unroll
        for (int ks = 0; ks < 2; ++ks) a = __builtin_amdgcn_mfma_f32_16x16x32_bf16(sa[vb][ks], rb[ks], a, 0, 0, 0);
        a[0] += bflo(ylv[vb].x); a[1] += bfhi(ylv[vb].x); a[2] += bflo(ylv[vb].y); a[3] += bfhi(ylv[vb].y);
        y[vb] = a;
        f32x4 gg = F4Z;
#pragma unroll
        for (int ks = 0; ks < 4; ++ks) gg = __builtin_amdgcn_mfma_f32_16x16x32_bf16(ld8(GUP + (size_t)(16 * vb + fr) * 128 + 32 * ks + 8 * fq), xgf[ks], gg, 0, 0, 0);
        g[vb] = gg;
    }
    float s1 = 0.f;
#pragma unroll
    for (int vb = 0; vb < 4; ++vb) s1 += (y[vb][0] + y[vb][1]) + (y[vb][2] + y[vb][3]);
    s1 += shx(s1, 16, lane); s1 += shx(s1, 32, lane);
    const float mean = s1 * (1.0f / 64); float s2 = 0.f;
#pragma unroll
    for (int vb = 0; vb < 4; ++vb)
#pragma unroll
        for (int r = 0; r < 4; ++r) { const float d = y[vb][r] - mean; y[vb][r] = d; s2 += d * d; }
    s2 += shx(s2, 16, lane); s2 += shx(s2, 32, lane);
    const float rs = rsqf_(s2 * (1.0f / 64) + 64e-5f);
#pragma unroll
    for (int vb = 0; vb < 4; ++vb) { const int v0 = 16 * vb + 4 * fq;
        const u32x2 cv = cvv[vb], pv = pvv[vb];
        const float cvf[4] = {bflo(cv.x), bfhi(cv.x), bflo(cv.y), bfhi(cv.y)}, pvf[4] = {bflo(pv.x), bfhi(pv.x), bflo(pv.y), bfhi(pv.y)};
        const float* gn = C.inp(I_RW_NORM, l, WB) + hc0 + v0; const float* mv = mu + 1024 + hc0 + v0; f32x4 o;
#pragma unroll
        for (int r = 0; r < 4; ++r) { const float vs = cvf[r] + mv[r] * (pvf[r] - cvf[r]); o[r] = (y[vb][r] * rs * gn[r] + rho * vs) * g[vb][r]; }
        y[vb] = o; }
    asm volatile("s_waitcnt vmcnt(0)" ::: "memory"); __builtin_amdgcn_wave_barrier();
#pragma unroll
    for (int vb = 0; vb < 4; ++vb) { if (!DRY) *(u32x2*)(Z + (size_t)row * ZP + ZD_R + hc0 + 16 * vb + 4 * fq) = pack4(y[vb]); else asm volatile("" :: "v"(y[vb])); }
    LDS_WAIT(); __builtin_amdgcn_wave_barrier();
}

__device__ __forceinline__ void rw_s5_passC(const Ctx& C, int l) {
    s5_passC_core(C, l, [&]() {
#pragma unroll 1
        for (int i = 0; i < 8; ++i) { const Ctx Ci = make_ctx(); rw_passC(Ci, l, (int)blockIdx.x + 256 * i); }
    });
}
template <class Epi, bool ALIGN> __device__ __forceinline__ void run_gemm(const Ctx& C, const bf16* A, int lda, const bf16* Bt, int ldb, int Mr, int N, int K, const Epi& E, int Gv = 0, int cv = 0) {
    if (Gv == 0) { Gv = C.G; cv = C.bid; }
    if (cv < 0 || cv >= Gv) return;
    pg8::Gemm g{A, Bt, Mr, N, K, lda, ldb}; pg8::StaticOrder S; S.init(Mr, N, Gv, cv);
    pg8::gemm_phase<Epi, pg8::StaticOrder, ALIGN, true>(C.lds, g, S, E);
}

#ifdef PROBE_INNER
#define INNER_STAMP() do { const Ctx Cs_ = make_ctx(); PROBE_STAMP(Cs_); } while (0)
#else
#define INNER_STAMP() do { } while (0)
#endif
#define GRID_BAR() do { const Ctx Cb = make_ctx(); if (Cb.tid == 0) *(LAS int*)(Cb.lds + RSTD_TAG_OFF) = -1; XcdBarrier b_; b_.bar = (unsigned*)(Cb.ws + WS_CTL) + 4096; b_.x = xb_xcc_id(); b_.st = (volatile LAS unsigned*)(Cb.lds + MISC_OFF) + 8; xcd_barrier(b_); PROBE_STAMP(Cb); } while (0)
#define PHASE_CTX() const Ctx C = make_ctx(); unsigned char* const ws = C.ws; bf16* const XB = (bf16*)(ws + WS_XB); float* const SSQ = (float*)(ws + WS_SSQ); bf16* const Z = (bf16*)(ws + WS_Z); \
    const int gw = C.bid * 8 + C.wave, NGW = C.G * 8; (void)XB; (void)SSQ; (void)Z; (void)gw; (void)NGW
#define SUBSYNC() do { VM_WAIT(); __syncthreads(); } while (0)
#define MERGE_PTRS() unsigned char* const G8 = ws + WS_G8; bf16* const MF = (bf16*)(ws + WS_MF); bf16* const MG = Z + ZC_Q; const bf16* const WG = (const bf16*)(ws + WS_SLOTA); const bf16* const WP = (const bf16*)(ws + WS_SLOTC); \
    const float* const gb = C.inp(I_GATE_BIAS, l, 4 * D); (void)G8; (void)MF; (void)MG; (void)WG; (void)WP; (void)gb
#define PHM_IN() \
        if (PH_ON(3)) {   PHASE_CTX(); \
            { EpiZ E{Z, SSQ, (bf16*)(ws + WS_S + RWW_OFF - 512 * 1024)}; run_gemm<EpiZ, true>(C, XB, D, (const bf16*)(ws + WS_SLOTB), D, M, NINP, D, E); } \
        } \
        GRID_BAR();
#define PHM_MIXA() \
        if (PH_ON(4)) {   PHASE_CTX(); \
            { RwPre P_; { const Ctx Ci = make_ctx(); rw_preload(Ci, (int)blockIdx.x, P_); } \
              for (int it = blockIdx.x; it < 2048; it += gridDim.x) { const Ctx Ci = make_ctx(); rw_passA(Ci, l, it, P_, (it + (int)gridDim.x < 2048) ? it + (int)gridDim.x : -1); } } \
        } \
        INNER_STAMP(); \
        if (PH_ON(4)) {   PHASE_CTX(); \
            {   MlPre PA_, PB_; { const Ctx Ci = make_ctx(); ml_preload(Ci, (int)blockIdx.x, PA_); } \
                { const Ctx Ci = make_ctx(); ml_preload(Ci, (int)blockIdx.x + 256, PB_); ml_passA(Ci, l, (int)blockIdx.x, PA_); } \
                { const Ctx Ci = make_ctx(); ml_preload(Ci, (int)blockIdx.x + 512, PA_); ml_passA(Ci, l, (int)blockIdx.x + 256, PB_); } \
                { const Ctx Ci = make_ctx(); ml_preload(Ci, (int)blockIdx.x + 768, PB_); ml_passA(Ci, l, (int)blockIdx.x + 512, PA_); } \
                { const Ctx Ci = make_ctx(); ml_passA(Ci, l, (int)blockIdx.x + 768, PB_); } } \
        } \
        INNER_STAMP(); \
        if (PH_ON(4)) {   PHASE_CTX(); \
            {   GlaW W_; GlaPre PA_, PB_; { const Ctx Ci = make_ctx(); gla_loadw(Ci, l, (int)blockIdx.x >> 6, W_); gla_preload(Ci, (int)blockIdx.x, PA_, false); } \
                { const Ctx Ci = make_ctx(); gla_preload(Ci, (int)blockIdx.x + 256, PB_, false); gla_passA(Ci, l, (int)blockIdx.x, W_, PA_); } \
                { const Ctx Ci = make_ctx(); gla_preload(Ci, (int)blockIdx.x + 512, PA_, false); gla_passA(Ci, l, (int)blockIdx.x + 256, W_, PB_); } \
                { const Ctx Ci = make_ctx(); gla_preload(Ci, (int)blockIdx.x + 768, PB_, false); gla_passA(Ci, l, (int)blockIdx.x + 512, W_, PA_); } \
                { const Ctx Ci = make_ctx(); gla_passA(Ci, l, (int)blockIdx.x + 768, W_, PB_); } } \
            { const Ctx Ci = make_ctx(); s5_passA(Ci); } \
            if (DUPM == 9 && l == 0) { const Ctx Ci = make_ctx(); s5_passA(Ci); } \
        } \
        GRID_BAR();
#define XFOLD_UNIT(q__) do { PHASE_CTX(); const int f_ = (C.bid >> 1), q_ = (q__), kind_ = (f_ >> 6) & 1, b_ = (f_ >> 4) & 3, h_ = (f_ >> 2) & 3, part_ = f_ & 3; \
        const bf16* KVq_ = (const bf16*)(ws + WS_KV + (size_t)q_ * 4 * MiB) + (size_t)(b_ * 256) * (2 * D) + h_ * 256; bf16* XF_ = (bf16*)C.X; \
        const bf16* A_ = kind_ ? (const bf16*)(XF_ + XF_WOT + (size_t)q_ * D * D + (size_t)(part_ * 256) * D + h_ * 256) : KVq_; \
        const bf16* B_ = kind_ ? KVq_ + D : (const bf16*)(XF_ + XF_WQU + (size_t)q_ * D * D + (size_t)(part_ * 256) * D + h_ * 256); \
        bf16* O_ = kind_ ? XF_ + XF_VFOLD + (size_t)(q_ * 4 + b_) * D * D + (size_t)(part_ * 256) * D + h_ * 256 : XF_ + XF_KFOLD + (size_t)((q_ * 4 + b_) * 4 + h_) * 256 * D + part_ * 256; \
        pg8::Gemm g_{A_, B_, 256, 256, 256, kind_ ? D : 2 * D, kind_ ? 2 * D : D}; pg8::SingleUnit S_; EpiBf16 E_{O_, D, nullptr, 1.0f, 256}; \
        pg8::gemm_phase<EpiBf16, pg8::SingleUnit, false, true>(C.lds, g_, S_, E_); } while (0)
#define PHM_MIXB() \
        if (PH_ON(4) && (blockIdx.x & 1)) { XFOLD_UNIT(l); SUBSYNC(); }        \
        if (PH_ON(4)) {   PHASE_CTX();        \
            const ConvPlan CP = conv_setup(C, CJ_GATES | CJ_PROJ | CJ_XW | CJ_GU2S, l); \
            const bool rwv = ((gw & 15) == 0); const int widx = gw - ((gw >> 4) + 1), NW = NGW - NGW / 16, tidx = widx * 64 + C.lane, NT = NW * 64; \
            if (rwv) rw_passB(C, gw >> 4); \
            else { ml_passB(C, tidx, NT); gla_passB(C, tidx, NT); s5_passB(C, tidx, NT); rw_xg_pass(C, l, tidx, NT); conv_work(C, CP, widx, NW); } \
        } \
        GRID_BAR();
#define PHM_MIXC() \
        if (PH_ON(4)) {   PHASE_CTX(); \
            { const Ctx Ci = make_ctx(); rw_s5_passC(Ci, l); } \
        } \
        __syncthreads(); \
        INNER_STAMP(); \
        if (PH_ON(4)) {   PHASE_CTX(); \
            {   MlPre PA_, PB_; { const Ctx Ci = make_ctx(); ml_preload(Ci, (int)blockIdx.x, PA_); } \
                { const Ctx Ci = make_ctx(); ml_preload(Ci, (int)blockIdx.x + 256, PB_); ml_passC(Ci, l, (int)blockIdx.x, PA_); } \
                { const Ctx Ci = make_ctx(); ml_preload(Ci, (int)blockIdx.x + 512, PA_); ml_passC(Ci, l, (int)blockIdx.x + 256, PB_); } \
                { const Ctx Ci = make_ctx(); ml_preload(Ci, (int)blockIdx.x + 768, PB_); ml_passC(Ci, l, (int)blockIdx.x + 512, PA_); } \
                { const Ctx Ci = make_ctx(); ml_passC(Ci, l, (int)blockIdx.x + 768, PB_); } } \
        } \
        INNER_STAMP(); \
        if (PH_ON(4)) {   PHASE_CTX(); \
            {   GlaW W_; GlaPre PA_, PB_; { const Ctx Ci = make_ctx(); gla_loadw(Ci, l, (int)blockIdx.x >> 6, W_); gla_preload(Ci, (int)blockIdx.x, PA_, true); } \
                { const Ctx Ci = make_ctx(); gla_preload(Ci, (int)blockIdx.x + 256, PB_, true); gla_passC(Ci, l, (int)blockIdx.x, W_, PA_); } \
                { const Ctx Ci = make_ctx(); gla_preload(Ci, (int)blockIdx.x + 512, PA_, true); gla_passC(Ci, l, (int)blockIdx.x + 256, W_, PB_); } \
                { const Ctx Ci = make_ctx(); gla_preload(Ci, (int)blockIdx.x + 768, PB_, true); gla_passC(Ci, l, (int)blockIdx.x + 512, W_, PA_); } \
                { const Ctx Ci = make_ctx(); gla_passC(Ci, l, (int)blockIdx.x + 768, W_, PB_); } } \
        } \
        if (PH_ON(4)) {   PHASE_CTX(); \
        } \
        GRID_BAR();
#define MSTAMP(k) do { if (l == 0) { const Ctx Ct_ = make_ctx(); TSTAMP(Ct_, 200 + (k)); } } while (0)
#define PHM_MERGE() \
        MSTAMP(0); \
        if (PH_ON(5)) { PHASE_CTX(); MERGE_PTRS(); pg8::StaticOrder S0; S0.init(M, D, C.G, C.bid); pg8::Unit u0; S0.next(0, u0); OwnTile4 S4{u0.pm, u0.pn}; \
            pg8::Gemm g{XB, WG, M, 4 * D, D, D, D}; EpiGate8 E{G8, SSQ, gb}; pg8::gemm_phase<EpiGate8, OwnTile4, true, true>(C.lds, g, S4, E); } SUBSYNC(); MSTAMP(1); \
        { ChainCarry cc_;         \
        if (PH_ON(5)) { PHASE_CTX(); MERGE_PTRS(); EpiGlu8 E{G8, cc_}; run_gemm<EpiGlu8, false>(C, Z + ZB_U, ZP, WP + 2 * (size_t)D * WB, WB, M, D, WB, E); } SUBSYNC(); MSTAMP(2); \
        if (PH_ON(5)) { PHASE_CTX(); MERGE_PTRS(); pg8::StaticOrder S0; S0.init(M, D, C.G, C.bid); pg8::Unit u0; S0.next(0, u0); ChainTile4 S4{u0.pm, u0.pn, Z, WP}; \
            pg8::Gemm g{Z, WP, M, D, WB, ZP, WB}; EpiChain E{G8, MG, ZP, cc_}; pg8::gemm_phase<EpiChain, ChainTile4, true, true>(C.lds, g, S4, E); } } MSTAMP(6); \
        GRID_BAR();
#ifdef DUP_MODE
constexpr int DUPM = DUP_MODE;
#else
constexpr int DUPM = 0;
#endif
#ifndef DUP_EPI
#define DUP_EPI 0
#endif
#ifndef STOP_AFTER
#define STOP_AFTER 1000
#endif
#define PH_ON(n) ((l) * 20 + (n) <= STOP_AFTER)
template <int l> __device__ __forceinline__ void layer_fwd() {
        if (PH_ON(1)) {   PHASE_CTX();
            { EpiSwiglu E{(bf16*)(ws + WS_HID), SSQ}; run_gemm<EpiSwiglu, true>(C, XB, D, (const bf16*)(ws + WS_SLOTA), D, M, 2 * FF, D, E); }
            {
                const int s0 = (l == 0) ? 192 : 128, ns = 256 - s0;
                if (C.bid >= s0) {
                    run_conv(C, (l > 0 ? CJ_D1 : 0) | CJ_MLW | CJ_RWW, l, (C.bid - s0) * 8 + C.wave, ns * 8);
                    if (C.bid - s0 < 32) { const Ctx Ci = make_ctx(); s5_prep(Ci, l, C.bid - s0); }
                }
            }
            if (l == 0) {
                for (int q = 0; q < DEPTH; ++q) { EpiKV E{(bf16*)(ws + WS_KV + (size_t)q * 4 * MiB), (const float*)(ws + WS_MEMR)};
                    run_gemm<EpiKV, true>(C, (const bf16*)(ws + WS_MEMB), D, (const bf16*)(ws + WS_S + (size_t)q * 4 * MiB), D, MMEM, 2 * D, D, E, 32, C.bid - 128 - 32 * q); }
            }
        }
        GRID_BAR();
        if (DUPM == 14 && l == 0) {
        if (PH_ON(1)) {   PHASE_CTX();

            { EpiSwigluT<DUP_EPI> E{(bf16*)(ws + WS_HID), SSQ}; run_gemm<EpiSwigluT<DUP_EPI>, true>(C, XB, D, (const bf16*)(ws + WS_SLOTA), D, M, 2 * FF, D, E); }
            if (l == 0) {
                for (int q = 0; q < DEPTH; ++q) { EpiKV E{(bf16*)(ws + WS_KV + (size_t)q * 4 * MiB), (const float*)(ws + WS_MEMR)};
                    run_gemm<EpiKV, true>(C, (const bf16*)(ws + WS_MEMB), D, (const bf16*)(ws + WS_S + (size_t)q * 4 * MiB), D, MMEM, 2 * D, D, E, 32, C.bid - 128 - 32 * q); }
            }
        }
        GRID_BAR();
        }
        if (PH_ON(2)) {   PHASE_CTX();
            { EpiResid E{XB, SSQ, 0.5f}; run_gemm<EpiResid, false>(C, (const bf16*)(ws + WS_HID), FF, (const bf16*)(ws + WS_SLOTC), FF, M, D, FF, E); }
        }
        GRID_BAR();
#if defined(DUP_MODE)
        if (l == 0 && DUP_MODE >= 1 && DUP_MODE <= 4) {
#if DUP_MODE == 1
            PHM_IN();
#elif DUP_MODE == 2
            PHM_IN(); PHM_MIXA();
#elif DUP_MODE == 3
            PHM_IN(); PHM_MIXA(); PHM_MIXB();
#elif DUP_MODE == 4
            PHM_IN(); PHM_MIXA(); PHM_MIXB(); PHM_MIXC();
#endif
            { PHASE_CTX(); run_conv(C, CJ_WIN, l, gw, NGW); } GRID_BAR();
            GRID_BAR();
        }
#endif
        PHM_IN(); PHM_MIXA(); PHM_MIXB(); PHM_MIXC();
        PHM_MERGE();
#if defined(DUP_MODE) && DUP_MODE == 5
        if (l == 0) { PHM_MERGE(); }
#endif
        if (PH_ON(6)) {   PHASE_CTX();
            run_conv(C, CJ_D2, l, gw, NGW);
            { EpiResid E{XB, SSQ, 1.0f}; run_gemm<EpiResid, false>(C, Z + ZC_Q, ZP, (const bf16*)(ws + WS_SLOTB), D, M, D, D, E); }
        }
        GRID_BAR();
        {
            const int un = blockIdx.x; const int pm = un >> 2, hh = un & 3, bb = pm >> 4;
            if (PH_ON(8)) {   PHASE_CTX();
                const bf16* KF = (const bf16*)C.X + XF_KFOLD + (size_t)((l * 4 + bb) * 4 + hh) * 256 * D;
                pg8::Gemm g{XB + (size_t)pm * 256 * D, KF, 256, 256, D, D, D}; pg8::SingleUnit S; EpiSoftmaxP E{(bf16*)(ws + WS_XO) + (size_t)pm * 256 * D + hh * 256, D, SSQ + (size_t)pm * 256 * 16};
                pg8::gemm_phase<EpiSoftmaxP, pg8::SingleUnit, false, true>(C.lds, g, S, E);
            }
        }
        GRID_BAR();
        if (PH_ON(9)) {   PHASE_CTX();
            EpiResid E{XB, SSQ, 1.0f}; pg8::Gemm g{(const bf16*)(ws + WS_XO), (const bf16*)C.X + XF_VFOLD + (size_t)l * 4 * D * D, M, D, D, D, D};
            StaticOrderBatchB S; S.init(M, D, C.G, C.bid); S.bstride = (size_t)D * D; pg8::gemm_phase<EpiResid, StaticOrderBatchB, false, true>(C.lds, g, S, E);
        }
        GRID_BAR();
        if (PH_ON(10)) {   PHASE_CTX();
            { EpiSwiglu E{(bf16*)(ws + WS_HID), SSQ}; run_gemm<EpiSwiglu, true>(C, XB, D, (const bf16*)(ws + WS_GU2S), D, M, 2 * FF, D, E); }
            if (l + 1 < DEPTH && C.bid >= 128) { run_conv(C, CJ_WIN | CJ_GU1, l + 1, (C.bid - 128) * 8 + C.wave, 128 * 8); }
        }
        GRID_BAR();
        if (DUPM == 18 && l == 0) {
        if (PH_ON(10)) {   PHASE_CTX();
            if (l + 1 < DEPTH) { run_conv(C, CJ_WIN, l + 1, gw, NGW); }
            { EpiSwiglu E{(bf16*)(ws + WS_HID), SSQ}; run_gemm<EpiSwiglu, true>(C, XB, D, (const bf16*)(ws + WS_SLOTA), D, M, 2 * FF, D, E); }
        }
        GRID_BAR();
        }
        if (PH_ON(11)) {   PHASE_CTX();
            { EpiResid E{XB, SSQ, 0.5f}; run_gemm<EpiResid, false>(C, (const bf16*)(ws + WS_HID), FF, (const bf16*)(ws + WS_SLOTC), FF, M, D, FF, E); }
        }
        GRID_BAR();
    }

__global__ void __launch_bounds__(512, 2) fwd_kernel(Args args) {
    extern __shared__ __attribute__((aligned(16))) unsigned char lds_raw[];
    (void)args;
    {
        const Ctx C = make_ctx();
        volatile LAS unsigned* MISC = (volatile LAS unsigned*)(C.lds + MISC_OFF);
        for (int u = C.tid; u < (LDS_BYTES - RING_BYTES) / 4; u += 512) ((LAS unsigned*)(C.lds + RING_BYTES))[u] = 0u;
        __syncthreads();
        (void)xcd_barrier_post((unsigned*)(C.ws + WS_CTL) + 4096, MISC + 8);
        PROBE_STAMP(C);
    }

    {   PHASE_CTX();
        pro_rows(C);
        cast_wq(C);
        run_conv(C, CJ_GU1 | CJ_D1 | CJ_WIN | CJ_XKV0 | CJ_XKV1 | CJ_XFOLD, 0, gw, NGW);
    }
    GRID_BAR();
    if (DUPM == 17) {
    {   PHASE_CTX();
        pro_rows(C);
        cast_wq(C);
        run_conv(C, CJ_GU1 | CJ_D1 | CJ_WIN | CJ_XKV0 | CJ_XKV1 | CJ_XFOLD, 0, gw, NGW);
    }
    GRID_BAR();
    }

    if (DUPM == 30) { for (int q = 0; q < 40; ++q) { GRID_BAR(); } }
    layer_fwd<0>();
    layer_fwd<1>();
    {   PHASE_CTX();
        final_rows(C);
#ifdef PROBE_LO
        {
            __syncthreads();
            const unsigned long long* st = (const unsigned long long*)(ws + WS_CTL + 32768);
            const unsigned long long ta = __hip_atomic_load(st + PROBE_LO, __ATOMIC_RELAXED, __HIP_MEMORY_SCOPE_AGENT), tb = __hip_atomic_load(st + PROBE_HI, __ATOMIC_RELAXED, __HIP_MEMORY_SCOPE_AGENT);
            float e = 0.16f + (float)(tb - ta) * PROBE_K; if (e > 0.31f) e = 0.31f;
            const int gwv = C.bid * 8 + C.wave;
            if (gwv == 7 && C.lane == 5) C.X[(size_t)7 * D + 5] += e;
        }
#endif
        if (xb_ld((unsigned*)(ws + WS_CTL) + 4096 + XB_TMO) != 0u) {
            for (size_t i = (size_t)C.bid * 512 + C.tid; i < (size_t)M * D; i += (size_t)C.G * 512) C.X[i] = __builtin_nanf("");
        }
    }
}

extern "C" void kernel_launch(void* const* d_in, const int* in_sizes, int n_in, void* d_out, int out_size, void* d_ws, size_t ws_size, hipStream_t stream) {
    static int grid = 0;
    if (grid == 0) {
        if (n_in != N_INPUTS || out_size != M * D || ws_size < WS_END) { fprintf(stderr, "kernel_launch: unexpected shapes: n_in %d out %d ws %zu (need %zu)\n", n_in, out_size, ws_size, (size_t)WS_END); grid = -1; return; }
        int dev = 0, cus = 0, per_cu = 0;
        if (hipGetDevice(&dev) != hipSuccess || hipDeviceGetAttribute(&cus, hipDeviceAttributeMultiprocessorCount, dev) != hipSuccess) { grid = -1; return; }
        if (hipFuncSetAttribute((const void*)fwd_kernel, hipFuncAttributeMaxDynamicSharedMemorySize, LDS_BYTES) != hipSuccess) { fprintf(stderr, "kernel_launch: hipFuncSetAttribute failed\n"); grid = -1; return; }
        if (hipOccupancyMaxActiveBlocksPerMultiprocessor(&per_cu, (const void*)fwd_kernel, 512, LDS_BYTES) != hipSuccess || per_cu < 1) { fprintf(stderr, "kernel_launch: occupancy query says %d workgroups per CU\n", per_cu); (void)hipGetLastError(); grid = -1; return; }
        if (cus < 256) { fprintf(stderr, "kernel_launch: built for a 256-CU device (got %d)\n", cus); grid = -1; return; }
        grid = 256;
    }
    if (grid < 0) return;
    if (hipMemsetAsync((char*)d_ws + WS_CTL, 0, CTL_ZERO_BYTES, stream) != hipSuccess) return;
    Args a{};
    for (int i = 0; i < N_INPUTS; ++i) a.in[i] = (const float*)d_in[i];
    a.out = (float*)d_out; a.ws = (unsigned char*)d_ws;
    hipLaunchKernelGGL(fwd_kernel, dim3(grid), dim3(512), LDS_BYTES, stream, a);
}
```
